# Optimizing an MI355X kernel written in HIP

```python
import jax, jax.numpy as jnp
from jax import lax
import numpy as np

D_MODEL = 1024
BATCH = 8
SEQ = 4096
DEPTH = 2

GRID_W = 64
CTX_LEN = 256
HEAD_DIM = 64
D_MIX = D_MODEL
D_RWKV = D_MIX // 2
D_CONV = D_MIX // 4
D_FOURIER = D_MIX - D_RWKV - D_CONV
N_RWKV_HEADS = D_RWKV // HEAD_DIM
N_CONV_GROUPS = D_CONV // HEAD_DIM
N_FOURIER_GROUPS = D_FOURIER // HEAD_DIM
D_DECAY_LORA = 64
D_AAA_LORA = 64
D_GATE_LORA = 128
D_FF = 2816
N_EXPERTS = 8
TOP_K = 2
D_FF_EXPERT = 3584
N_DENSE = (DEPTH + 1) // 2
N_MOE = DEPTH // 2
NORM_EPS = 1e-6
GN_EPS = 64e-5
POS_BASE = 10000.0
COL_SIZES = (D_RWKV, D_RWKV, D_DECAY_LORA, D_DECAY_LORA, D_AAA_LORA, D_AAA_LORA, D_RWKV, D_GATE_LORA,
             D_CONV, D_CONV, D_CONV, D_FOURIER)
D_STATE_COLS = 2 * D_RWKV + 2 * D_DECAY_LORA + 2 * D_AAA_LORA
D_IN = 4 * D_RWKV // 2 * 1 + D_RWKV + 2 * D_DECAY_LORA + 2 * D_AAA_LORA + D_GATE_LORA + 3 * D_CONV + D_FOURIER

kernel_name = "hybrid_rwkv7_shortconv_fourier_moe_dit"


def split_cols(z, sizes):
    out, o = [], 0
    for s in sizes:
        out.append(z[..., o:o + s])
        o += s
    return out


def rms_norm(x, g):
    xf = x.astype(jnp.float32)
    y = xf * lax.rsqrt(jnp.mean(xf * xf, axis=-1, keepdims=True) + NORM_EPS)
    return (y * g.astype(jnp.float32)).astype(x.dtype)


def adaln(silu_c, w, b):
    return jnp.split(silu_c @ w + b, 6, axis=-1)


def sincos_2d(rows, cols, dim):
    quarter = dim // 4
    omega = 1.0 / (POS_BASE ** (jnp.arange(quarter, dtype=jnp.float32) / quarter))

    def axis_emb(n):
        ang = jnp.arange(n, dtype=jnp.float32)[:, None] * omega[None, :]
        return jnp.concatenate([jnp.sin(ang), jnp.cos(ang)], axis=-1)

    er, ec = axis_emb(rows), axis_emb(cols)
    emb = jnp.concatenate([jnp.broadcast_to(er[:, None, :], (rows, cols, dim // 2)),
                           jnp.broadcast_to(ec[None, :, :], (rows, cols, dim // 2))], axis=-1)
    return emb.reshape(rows * cols, dim)


def token_shift(z, reverse):
    if reverse:
        return jnp.concatenate([z[:, 1:], jnp.zeros_like(z[:, :1])], axis=1)
    return jnp.concatenate([jnp.zeros_like(z[:, :1]), z[:, :-1]], axis=1)


def to_heads(z):
    return z.reshape(z.shape[0], z.shape[1], -1, HEAD_DIM)


def rwkv_direction(k, v, wlo, alo, r, mu, mu_w, mu_a, w0, w2, a0, a2, k_k, k_a, reverse):
    f32 = jnp.float32
    lerp = lambda z, m: z + (token_shift(z, reverse) - z) * m.astype(f32)
    k = lerp(k.astype(f32), mu[0])
    v = lerp(v.astype(f32), mu[1])
    wlo = lerp(wlo.astype(f32), mu_w)
    alo = lerp(alo.astype(f32), mu_a)
    w_log = -jax.nn.softplus(-(w0.astype(f32) + jnp.tanh(wlo) @ w2.astype(f32))) - 0.5
    decay = jnp.exp(-jnp.exp(w_log))
    a = jax.nn.sigmoid(a0.astype(f32) + alo @ a2.astype(f32))
    kk = to_heads(k * k_k.astype(f32))
    kk = kk / jnp.maximum(jnp.linalg.norm(kk, axis=-1, keepdims=True), 1e-12)
    k = k * (1.0 + (a - 1.0) * k_a.astype(f32))
    rh = None if r is None else to_heads(lerp(r.astype(f32), mu[2]))
    return rh, to_heads(decay), to_heads(k), to_heads(v), -kk, kk * to_heads(a)


def wkv_scan(r, w, k, v, a, b, state0, reverse):
    def update(S, w_t, k_t, v_t, a_t, b_t):
        sa = jnp.einsum("bhvk,bhk->bhv", S, a_t)
        return S * w_t[:, :, None, :] + sa[..., None] * b_t[:, :, None, :] + v_t[..., None] * k_t[:, :, None, :]

    tm = lambda t: jnp.moveaxis(t, 1, 0)
    if r is None:
        def step_state(S, inp):
            return update(S, *inp), None
        S, _ = lax.scan(step_state, state0, tuple(map(tm, (w, k, v, a, b))), reverse=reverse)
        return None, S

    def step(S, inp):
        S = update(S, *inp[1:])
        return S, jnp.einsum("bhvk,bhk->bhv", S, inp[0])

    S, y = lax.scan(step, state0, tuple(map(tm, (r, w, k, v, a, b))), reverse=reverse)
    return jnp.moveaxis(y, 0, 1), S


def rwkv_readout(y, r, k, v, r_k, gn_w, gn_b):
    mean = jnp.mean(y, axis=-1, keepdims=True)
    var = jnp.mean(jnp.square(y - mean), axis=-1, keepdims=True)
    yn = ((y - mean) * lax.rsqrt(var + GN_EPS)).reshape(y.shape[0], y.shape[1], D_RWKV)
    yn = yn * gn_w.astype(jnp.float32) + gn_b.astype(jnp.float32)
    bonus = jnp.sum(r * k * r_k.astype(jnp.float32), axis=-1, keepdims=True) * v
    return yn + bonus.reshape(yn.shape)


def rwkv_mixer(k, v, wlos, alos, r, glo, rp, states0):
    ys, states = [], []
    for d, reverse in enumerate((False, True)):
        rh, wh, kh, vh, ah, bh = rwkv_direction(k, v, wlos[d], alos[d], r, rp["mu"][d], rp["mu_w"][d],
                                                rp["mu_a"][d], rp["w0"][d], rp["w2"][d], rp["a0"][d],
                                                rp["a2"][d], rp["k_k"], rp["k_a"], reverse)
        y, S = wkv_scan(rh, wh, kh, vh, ah, bh, states0[d], reverse)
        states.append(S)
        if r is not None:
            ys.append(rwkv_readout(y, rh, kh, vh, rp["r_k"], rp["gn_w"], rp["gn_b"]))
    if r is None:
        return None, states
    gate = jax.nn.sigmoid(glo.astype(jnp.float32)) @ rp["g2"].astype(jnp.float32)
    return ((ys[0] + ys[1]) * gate).astype(k.dtype), states


def conv3_centred(h, w):
    hp = jnp.pad(h, ((0, 0), (1, 1), (0, 0)))
    return hp[:, :-2] * w[0] + hp[:, 1:-1] * w[1] + hp[:, 2:] * w[2]


def fourier_mix(f):
    bsz, length, _ = f.shape
    fg = f.astype(jnp.float32).reshape(bsz, length, N_FOURIER_GROUPS, HEAD_DIM)
    out = jnp.fft.fft2(fg, axes=(1, 3), norm="ortho").real
    return out.reshape(bsz, length, D_FOURIER).astype(f.dtype)


def token_mixers(z, rp, conv_w, states0, on_grid):
    k, v, wlo_f, wlo_b, alo_f, alo_b, r, glo, u, gate_b, gate_c, f = split_cols(z, COL_SIZES)
    y_rwkv, states = rwkv_mixer(k, v, (wlo_f, wlo_b), (alo_f, alo_b), r, glo, rp, states0)
    hc = gate_c * u
    if on_grid:
        bsz, length, ch = hc.shape
        rows = length // GRID_W
        conv = conv3_centred(hc.reshape(bsz * rows, GRID_W, ch), conv_w).reshape(bsz, length, ch)
    else:
        conv = conv3_centred(hc, conv_w)
    y_conv = gate_b * conv
    y_four = fourier_mix(f)
    return jnp.concatenate([y_rwkv, y_conv, y_four], axis=-1), states


def swiglu(h, wg, wu, wd):
    return (jax.nn.silu(h @ wg) * (h @ wu)) @ wd


def moe_swiglu(h, router_w, router_b, wg, wu, wd):
    logits = h.astype(jnp.float32) @ router_w.astype(jnp.float32) + router_b.astype(jnp.float32)
    top_val, top_idx = lax.top_k(logits, TOP_K)
    top_p = jax.nn.softmax(top_val, axis=-1)
    gates = jnp.sum(jax.nn.one_hot(top_idx, N_EXPERTS, dtype=jnp.float32) * top_p[..., None], axis=-2)
    gates = gates.astype(h.dtype)
    out = jnp.zeros_like(h)
    for e in range(N_EXPERTS):
        out = out + gates[..., e:e + 1] * swiglu(h, wg[e], wu[e], wd[e])
    return out


def setup_inputs(seed: int = 0) -> dict:
    key = jax.random.key(seed)
    ks = iter(jax.random.split(key, 40))
    nrm = lambda shape, s: jax.random.normal(next(ks), shape, jnp.float32) * s
    uni = lambda shape, lo, hi: jax.random.uniform(next(ks), shape, jnp.float32, lo, hi)
    L = DEPTH
    return {
        "x": nrm((BATCH, SEQ, D_MODEL), 1.0),
        "c": nrm((BATCH, D_MODEL), 1.0),
        "ctx": nrm((BATCH, CTX_LEN, D_MODEL), 1.0),
        "c_ctx": nrm((D_MODEL,), 1.0),
        "ada_w": nrm((L, D_MODEL, 6 * D_MODEL), 0.5 * D_MODEL ** -0.5),
        "ada_b": nrm((L, 6 * D_MODEL), 0.02),
        "norm_g": 1.0 + nrm((L, 4, D_MODEL), 0.02),
        "w_in": nrm((L, D_MODEL, D_IN), D_MODEL ** -0.5),
        "w_out": nrm((L, D_MIX, D_MODEL), D_MIX ** -0.5),
        "rwkv_mu": uni((L, 2, 3, D_RWKV), 0.0, 1.0),
        "rwkv_mu_w": uni((L, 2, D_DECAY_LORA), 0.0, 1.0),
        "rwkv_mu_a": uni((L, 2, D_AAA_LORA), 0.0, 1.0),
        "rwkv_w0": uni((L, 2, D_RWKV), -6.0, 1.0),
        "rwkv_w2": nrm((L, 2, D_DECAY_LORA, D_RWKV), 0.1),
        "rwkv_a0": nrm((L, 2, D_RWKV), 0.5),
        "rwkv_a2": nrm((L, 2, D_AAA_LORA, D_RWKV), 0.1),
        "rwkv_g2": nrm((L, D_GATE_LORA, D_RWKV), D_GATE_LORA ** -0.5),
        "rwkv_k_k": 0.85 + nrm((L, D_RWKV), 0.05),
        "rwkv_k_a": 1.0 + nrm((L, D_RWKV), 0.05),
        "rwkv_r_k": nrm((L, N_RWKV_HEADS, HEAD_DIM), 0.1),
        "rwkv_gn_w": 1.0 + nrm((L, D_RWKV), 0.02),
        "rwkv_gn_b": nrm((L, D_RWKV), 0.02),
        "conv_w": nrm((L, 3, D_CONV), 3.0 ** -0.5),
        "ffn_w_gate": nrm((N_DENSE, D_MODEL, D_FF), D_MODEL ** -0.5),
        "ffn_w_up": nrm((N_DENSE, D_MODEL, D_FF), D_MODEL ** -0.5),
        "ffn_w_down": nrm((N_DENSE, D_FF, D_MODEL), D_FF ** -0.5),
        "router_w": nrm((N_MOE, D_MODEL, N_EXPERTS), D_MODEL ** -0.5),
        "router_b": nrm((N_MOE, N_EXPERTS), 0.01),
        "moe_w_gate": nrm((N_MOE, N_EXPERTS, D_MODEL, D_FF_EXPERT), D_MODEL ** -0.5),
        "moe_w_up": nrm((N_MOE, N_EXPERTS, D_MODEL, D_FF_EXPERT), D_MODEL ** -0.5),
        "moe_w_down": nrm((N_MOE, N_EXPERTS, D_FF_EXPERT, D_MODEL), D_FF_EXPERT ** -0.5),
    }


def reference(x, c, ctx, c_ctx, ada_w, ada_b, norm_g, w_in, w_out, rwkv_mu, rwkv_mu_w, rwkv_mu_a,
              rwkv_w0, rwkv_w2, rwkv_a0, rwkv_a2, rwkv_g2, rwkv_k_k, rwkv_k_a, rwkv_r_k, rwkv_gn_w,
              rwkv_gn_b, conv_w, ffn_w_gate, ffn_w_up, ffn_w_down, router_w, router_b, moe_w_gate,
              moe_w_up, moe_w_down):
    bsz, length, dim = x.shape
    rows = length // GRID_W
    x = x + sincos_2d(rows, GRID_W, dim).astype(x.dtype)[None]
    xc = ctx
    silu_c, silu_cc = jax.nn.silu(c), jax.nn.silu(c_ctx)
    zero_state = jnp.zeros((bsz, N_RWKV_HEADS, HEAD_DIM, HEAD_DIM), jnp.float32)

    def channel_mixer(l, h):
        if l % 2 == 0:
            i = l // 2
            return swiglu(h, ffn_w_gate[i], ffn_w_up[i], ffn_w_down[i])
        i = l // 2
        return moe_swiglu(h, router_w[i], router_b[i], moe_w_gate[i], moe_w_up[i], moe_w_down[i])

    for l in range(DEPTH):
        last = l == DEPTH - 1
        rp = {"mu": rwkv_mu[l], "mu_w": rwkv_mu_w[l], "mu_a": rwkv_mu_a[l], "w0": rwkv_w0[l],
              "w2": rwkv_w2[l], "a0": rwkv_a0[l], "a2": rwkv_a2[l], "g2": rwkv_g2[l],
              "k_k": rwkv_k_k[l], "k_a": rwkv_k_a[l], "r_k": rwkv_r_k[l], "gn_w": rwkv_gn_w[l],
              "gn_b": rwkv_gn_b[l]}
        sh1, sc1, g1, sh2, sc2, g2 = adaln(silu_c[:, None, :], ada_w[l], ada_b[l])
        csh1, csc1, cg1, csh2, csc2, cg2 = adaln(silu_cc, ada_w[l], ada_b[l])

        hc = rms_norm(xc, norm_g[l, 0]) * (1.0 + csc1) + csh1
        if last:
            kc, vc, wfc, wbc, afc, abc = split_cols(hc @ w_in[l][:, :D_STATE_COLS], COL_SIZES[:6])
            _, ctx_states = rwkv_mixer(kc, vc, (wfc, wbc), (afc, abc), None, None, rp,
                                       (zero_state, zero_state))
        else:
            yc, ctx_states = token_mixers(hc @ w_in[l], rp, conv_w[l], (zero_state, zero_state), False)
            xc = xc + cg1 * rms_norm(yc @ w_out[l], norm_g[l, 1])
            hc2 = rms_norm(xc, norm_g[l, 2]) * (1.0 + csc2) + csh2
            xc = xc + cg2 * rms_norm(channel_mixer(l, hc2), norm_g[l, 3])

        h = rms_norm(x, norm_g[l, 0]) * (1.0 + sc1) + sh1
        y, _ = token_mixers(h @ w_in[l], rp, conv_w[l], ctx_states, True)
        x = x + g1 * rms_norm(y @ w_out[l], norm_g[l, 1])
        h2 = rms_norm(x, norm_g[l, 2]) * (1.0 + sc2) + sh2
        x = x + g2 * rms_norm(channel_mixer(l, h2), norm_g[l, 3])
    return x
```

```cpp
#include <hip/hip_runtime.h>
#include <cstdio>
#include <cstdint>
namespace pg8 {
#define PG8_LAS __attribute__((address_space(3)))
typedef unsigned short bf16_t;
typedef short bf16x8 __attribute__((ext_vector_type(8)));
typedef float f32x4 __attribute__((ext_vector_type(4)));
typedef unsigned u32x4 __attribute__((ext_vector_type(4)));
constexpr int BM = 256, BK = 64, HALF = 128, HTB = HALF * BK * 2  , STAGE_BYTES = 8 * HTB, NXCD = 8, WGM = 8;

__host__ __device__ __forceinline__ int lds_byte(int r, int c) { const int st = (r >> 4) * 2 + (c >> 5), rr = r & 15, cc = c & 31, ob = rr * 64 + cc * 2; return st * 1024 + (ob ^ (((ob >> 9) & 1) << 5)); }
__host__ __device__ __forceinline__ void stage_rc(int b, int& R, int& C) { const int st = b / 1024, sb = b % 1024, swz = sb ^ (((sb >> 9) & 1) << 5); R = (st >> 1) * 16 + swz / 64; C = (st & 1) * 32 + (swz % 64) / 2; }
__host__ __device__ __forceinline__ int perm32(int rho) { const int n = rho >> 4, i = rho & 15; return 8 * (i >> 2) + 4 * n + (i & 3); }

struct Unit { int pm, pn; };
struct Gemm { const bf16_t* A; const bf16_t* Bt; int M, N, K; };

struct StaticOrder {
    int nM, nN, nwg, G, c;
    __host__ __device__ void init(int M, int N, int G_, int c_) { nM = M / BM; nN = N / BM; nwg = nM * nN; G = G_; c = c_; }
    __host__ __device__ bool next(int i, Unit& u) const {
        const long L = (long)i * G + c; if (L >= nwg) return false;
        int wgid = (int)L; { const int q = nwg / NXCD, r = nwg % NXCD, xcd = wgid % NXCD, off = wgid / NXCD; wgid = (xcd < r ? xcd * (q + 1) : r * (q + 1) + (xcd - r) * q) + off; }
        const int nig = WGM * nN, gid = wgid / nig, fm = gid * WGM, gsz = (nM - fm) < WGM ? (nM - fm) : WGM;
        u.pm = fm + ((wgid % nig) % gsz); u.pn = (wgid % nig) / gsz; return true;
    }
    __device__ __forceinline__ void a_ready(const Unit&) const {}
    __device__ __forceinline__ void done(const Unit&) const {}
};

__device__ __forceinline__ unsigned cvt_pk_bf16(float lo, float hi) { unsigned r; asm volatile("v_cvt_pk_bf16_f32 %0, %1, %2" : "=v"(r) : "v"(lo), "v"(hi)); return r; }
typedef float f32x2 __attribute__((ext_vector_type(2)));
__device__ __forceinline__ f32x2 gelu_pk(f32x2 v) {
    const f32x2 av = __builtin_elementwise_abs(v), d = av * 0.2316418882f + 1.0f;
    f32x2 t; t.x = __builtin_amdgcn_rcpf(d.x); t.y = __builtin_amdgcn_rcpf(d.y);
    f32x2 q = t * 0.5307027145f + (-0.7265760135f); q = q * t + 0.7107068705f; q = q * t + (-0.142248368f); q = q * t + 0.127414796f; q = q * t;
    const f32x2 s = (v * v) * (-0.72134752044f);
    f32x2 e; e.x = __builtin_amdgcn_exp2f(s.x); e.y = __builtin_amdgcn_exp2f(s.y);
    const f32x2 m = v * (q * e), r = v - m;
    f32x2 o; o.x = v.x < 0.f ? m.x : r.x; o.y = v.y < 0.f ? m.y : r.y; return o;
}

template <int ACT  > struct EpiBf16 {
    static constexpr bool PERM = true, AFTER_DRAIN = false; static_assert(ACT == 0 || ACT == 1, "EpiBf16: ACT is 0 (none) or 1 (gelu_pk)");
    bf16_t* O; int ldc; const float* bias; int split_cols; size_t split_stride; float scale0;
    __device__ __forceinline__ void operator()(const f32x4 (&acc)[2][2][4][2], const Unit& u, int wr, int wc, int fr, int fq) const {
        const int row0 = u.pm * BM + wr * 64 + fr; int colt = u.pn * BM; bf16_t* base = O;
        float sc = 1.f; if (split_cols) { const int t = colt / split_cols; base += (size_t)t * split_stride; colt -= t * split_cols; if (t == 0) sc = scale0; }
        const int col0 = colt + wc * 32 + 8 * fq, bcol0 = u.pn * BM + wc * 32 + 8 * fq;
        f32x4 bv[2][2];
#pragma unroll
        for (int bj = 0; bj < 2; ++bj)
#pragma unroll
            for (int n = 0; n < 2; ++n) bv[bj][n] = bias ? *(const f32x4*)(bias + bcol0 + bj * HALF + 4 * n) : (f32x4){0.f, 0.f, 0.f, 0.f};
#pragma unroll
        for (int ai = 0; ai < 2; ++ai)
#pragma unroll
            for (int m = 0; m < 4; ++m) { bf16_t* rowp = base + (size_t)(row0 + ai * HALF + m * 16) * ldc + col0;
#pragma unroll
                for (int bj = 0; bj < 2; ++bj) { f32x4 v0 = acc[ai][bj][m][0] + bv[bj][0], v1 = acc[ai][bj][m][1] + bv[bj][1];
                    if (ACT == 1) { f32x2 a = gelu_pk((f32x2){v0[0], v0[1]}), b = gelu_pk((f32x2){v0[2], v0[3]}), c = gelu_pk((f32x2){v1[0], v1[1]}), d = gelu_pk((f32x2){v1[2], v1[3]});
                        v0 = (f32x4){a.x, a.y, b.x, b.y}; v1 = (f32x4){c.x, c.y, d.x, d.y}; }
                    v0 = v0 * sc; v1 = v1 * sc; u32x4 w; w.x = cvt_pk_bf16(v0[0], v0[1]); w.y = cvt_pk_bf16(v0[2], v0[3]); w.z = cvt_pk_bf16(v1[0], v1[1]); w.w = cvt_pk_bf16(v1[2], v1[3]);
                    *(u32x4*)(rowp + bj * HALF) = w; } }
    }
};

struct EpiF32 {
    static constexpr bool PERM = false, AFTER_DRAIN = false;
    float* C; int ldc; const float* bias;
    __device__ __forceinline__ void operator()(const f32x4 (&acc)[2][2][4][2], const Unit& u, int wr, int wc, int fr, int fq) const {
        const int row0 = u.pm * BM + wr * 64 + fr, col0 = u.pn * BM + wc * 32 + 4 * fq;
        f32x4 bv[2][2];
#pragma unroll
        for (int bj = 0; bj < 2; ++bj)
#pragma unroll
            for (int n = 0; n < 2; ++n) bv[bj][n] = bias ? *(const f32x4*)(bias + col0 + bj * HALF + n * 16) : (f32x4){0.f, 0.f, 0.f, 0.f};
#pragma unroll
        for (int ai = 0; ai < 2; ++ai)
#pragma unroll
            for (int m = 0; m < 4; ++m) { float* rowp = C + (size_t)(row0 + ai * HALF + m * 16) * ldc + col0;
#pragma unroll
                for (int bj = 0; bj < 2; ++bj)
#pragma unroll
                    for (int n = 0; n < 2; ++n) *(f32x4*)(rowp + bj * HALF + n * 16) = acc[ai][bj][m][n] + bv[bj][n]; }
    }
};
template <class Epi, class Sched, bool ALIGN_EPI = false, bool SP2 = false>
__device__ __forceinline__ void gemm_phase(PG8_LAS unsigned char* lds, const Gemm g, const Sched& S, const Epi& E, const int wave_in) {
    int tid_ = wave_in * 64 + (int)__builtin_amdgcn_mbcnt_hi(~0u, __builtin_amdgcn_mbcnt_lo(~0u, 0u)); asm volatile("" : "+v"(tid_));
    const int tid = tid_, wid = __builtin_amdgcn_readfirstlane(tid >> 6), lane = tid & 63, wr = wid >> 2, wc = wid & 3, fr = lane & 15, fq = lane >> 4;
    const int K = g.K, nt = K / BK;
    unsigned voffA[2], voffB[2];
#pragma unroll
    for (int i = 0; i < 2; ++i) { int R, C; stage_rc(tid * 16 + i * 8192, R, C); const int Rb = Epi::PERM ? ((R & ~31) + perm32(R & 31)) : R;
        voffA[i] = (unsigned)(R * K + C) * 2u; voffB[i] = (unsigned)(Rb * K + C) * 2u; }
    const size_t kstep = (size_t)(BK * 2);
    const size_t hstep = (size_t)HALF * K * 2;
    const size_t tstep = 2 * hstep;
    const unsigned ldsw = (unsigned)wid * 1024u;
    const int aoff = lds_byte(wr * 64 + fr, fq * 8), boff = lds_byte(wc * 32 + fr, fq * 8);
#define PG8_SA(b, h) (((b) * 2 + (h)) * HTB)
#define PG8_SB(b, h) ((4 + (b) * 2 + (h)) * HTB)
#define PG8_STAGE(bufoff, gbase, voff) do { _Pragma("unroll") for (int _i = 0; _i < 2; ++_i) \
        __builtin_amdgcn_global_load_lds((const unsigned*)((const char*)(gbase) + (voff)[_i]), (PG8_LAS unsigned*)(lds + (bufoff) + ldsw + _i * 8192), 16, 0, 0); } while (0)
#define PG8_LDA(dst, b, h) do { _Pragma("unroll") for (int m = 0; m < 4; ++m) _Pragma("unroll") for (int k = 0; k < 2; ++k) dst[m][k] = *(const PG8_LAS bf16x8*)(lds + PG8_SA(b, h) + aoff + m * 2048 + k * 1024); } while (0)
#define PG8_LDB(dst, b, h) do { _Pragma("unroll") for (int n = 0; n < 2; ++n) _Pragma("unroll") for (int k = 0; k < 2; ++k) dst[n][k] = *(const PG8_LAS bf16x8*)(lds + PG8_SB(b, h) + boff + n * 2048 + k * 1024); } while (0)
#define PG8_MMA(ai, bj, At, Bt) do { __builtin_amdgcn_s_setprio(1); _Pragma("unroll") for (int m = 0; m < 4; ++m) _Pragma("unroll") for (int n = 0; n < 2; ++n) _Pragma("unroll") for (int k = 0; k < 2; ++k) \
        acc[ai][bj][m][n] = __builtin_amdgcn_mfma_f32_16x16x32_bf16(Bt[n][k], At[m][k], acc[ai][bj][m][n], 0, 0, 0); __builtin_amdgcn_s_setprio(0); } while (0)
#define PG8_WAIT_V(n) asm volatile("s_waitcnt vmcnt(" #n ")" ::: "memory")
#define PG8_WAIT_L(n) asm volatile("s_waitcnt lgkmcnt(" #n ")" ::: "memory")
#define PG8_BAR __builtin_amdgcn_s_barrier()
#define PG8_SCHED __builtin_amdgcn_sched_barrier(0)
    Unit cur, nxt; int ui = 0;
    if (!S.next(0, cur)) return;
    f32x4 acc[2][2][4][2];
#pragma unroll
    for (int a = 0; a < 2; ++a)
#pragma unroll
        for (int b = 0; b < 2; ++b)
#pragma unroll
            for (int m = 0; m < 4; ++m)
#pragma unroll
                for (int n = 0; n < 2; ++n) acc[a][b][m][n] = (f32x4){0.f, 0.f, 0.f, 0.f};
    bf16x8 At[4][2], B0[2][2], B1[2][2];
    const char* cA = (const char*)g.A + (size_t)cur.pm * tstep; const char* cB = (const char*)g.Bt + (size_t)cur.pn * tstep;
    S.a_ready(cur);
    if constexpr (SP2) {
        PG8_STAGE(PG8_SB(0, 0), cB, voffB); PG8_STAGE(PG8_SB(0, 1), cB + hstep, voffB); PG8_STAGE(PG8_SA(0, 0), cA, voffA); PG8_STAGE(PG8_SA(0, 1), cA + hstep, voffA);
        if (wr == 1) PG8_BAR;
        PG8_WAIT_V(2); PG8_BAR;
        PG8_STAGE(PG8_SB(1, 0), cB + kstep, voffB); PG8_STAGE(PG8_SA(1, 0), cA + kstep, voffA); PG8_STAGE(PG8_SB(1, 1), cB + hstep + kstep, voffB);
        PG8_WAIT_V(6); PG8_BAR;
    } else {
        PG8_STAGE(PG8_SB(0, 0), cB, voffB); PG8_STAGE(PG8_SA(0, 0), cA, voffA); PG8_STAGE(PG8_SB(0, 1), cB + hstep, voffB); PG8_STAGE(PG8_SA(0, 1), cA + hstep, voffA);
        if (wr == 1) PG8_BAR;
        PG8_WAIT_V(4); PG8_BAR;
        PG8_STAGE(PG8_SB(1, 0), cB + kstep, voffB); PG8_STAGE(PG8_SA(1, 0), cA + kstep, voffA); PG8_STAGE(PG8_SB(1, 1), cB + hstep + kstep, voffB);
        PG8_WAIT_V(6); PG8_BAR;
    }
    for (;;) {
        const bool has_next = S.next(ui + 1, nxt);
        const char* nA = has_next ? (const char*)g.A + (size_t)nxt.pm * tstep : cA; const char* nB = has_next ? (const char*)g.Bt + (size_t)nxt.pn * tstep : cB;
        for (int t = 0; t < nt; t += 2) {
            const bool last = (t == nt - 2);
            const char* a1 = cA + (size_t)(t + 1) * kstep;
            const char* a2 = last ? nA : cA + (size_t)(t + 2) * kstep; const char* b2 = last ? nB : cB + (size_t)(t + 2) * kstep;
            const char* a3 = a2 + kstep; const char* b3 = b2 + kstep;
            if (last && has_next) S.a_ready(nxt);
            if constexpr (SP2) {
            PG8_LDB(B0, 0, 0); PG8_LDB(B1, 0, 1); PG8_SCHED; PG8_LDA(At, 0, 0); PG8_STAGE(PG8_SA(1, 1), a1 + hstep, voffA);
            PG8_WAIT_V(8); PG8_WAIT_L(0); PG8_BAR; PG8_MMA(0, 0, At, B0); PG8_MMA(0, 1, At, B1); PG8_BAR; PG8_SCHED;
            PG8_LDA(At, 0, 1); PG8_STAGE(PG8_SB(0, 0), b2, voffB); PG8_STAGE(PG8_SB(0, 1), b2 + hstep, voffB); PG8_STAGE(PG8_SA(0, 0), a2, voffA);
            PG8_WAIT_V(8); PG8_WAIT_L(0); PG8_BAR; PG8_MMA(1, 0, At, B0); PG8_MMA(1, 1, At, B1); PG8_BAR; PG8_SCHED;
            PG8_LDB(B0, 1, 0); PG8_LDB(B1, 1, 1); PG8_SCHED; PG8_LDA(At, 1, 0); PG8_STAGE(PG8_SA(0, 1), a2 + hstep, voffA);
            PG8_WAIT_V(8); PG8_WAIT_L(0); PG8_BAR; PG8_MMA(0, 0, At, B0); PG8_MMA(0, 1, At, B1); PG8_BAR; PG8_SCHED;
            PG8_LDA(At, 1, 1); PG8_STAGE(PG8_SB(1, 0), b3, voffB); PG8_STAGE(PG8_SB(1, 1), b3 + hstep, voffB); PG8_STAGE(PG8_SA(1, 0), a3, voffA);
            PG8_WAIT_V(8); PG8_WAIT_L(0); PG8_BAR; PG8_MMA(1, 0, At, B0); PG8_MMA(1, 1, At, B1); PG8_BAR; PG8_SCHED;
            } else {
            PG8_LDB(B0, 0, 0); PG8_SCHED; PG8_LDA(At, 0, 0); PG8_STAGE(PG8_SA(1, 1), a1 + hstep, voffA);
            PG8_WAIT_L(8); PG8_BAR; PG8_WAIT_L(0); PG8_MMA(0, 0, At, B0); PG8_BAR; PG8_SCHED;
            PG8_LDB(B1, 0, 1); PG8_STAGE(PG8_SB(0, 0), b2, voffB);
            PG8_BAR; PG8_WAIT_L(0); PG8_MMA(0, 1, At, B1); PG8_BAR;
            PG8_LDA(At, 0, 1); PG8_STAGE(PG8_SA(0, 0), a2, voffA);
            PG8_BAR; PG8_WAIT_L(0); PG8_MMA(1, 0, At, B0); PG8_BAR; PG8_SCHED;
            PG8_STAGE(PG8_SB(0, 1), b2 + hstep, voffB);
            PG8_WAIT_V(6); PG8_BAR; PG8_MMA(1, 1, At, B1); PG8_BAR;
            PG8_LDB(B0, 1, 0); PG8_SCHED; PG8_LDA(At, 1, 0); PG8_STAGE(PG8_SA(0, 1), a2 + hstep, voffA);
            PG8_WAIT_L(8); PG8_BAR; PG8_WAIT_L(0); PG8_MMA(0, 0, At, B0); PG8_BAR; PG8_SCHED;
            PG8_LDB(B1, 1, 1); PG8_STAGE(PG8_SB(1, 0), b3, voffB);
            PG8_BAR; PG8_WAIT_L(0); PG8_MMA(0, 1, At, B1); PG8_BAR;
            PG8_LDA(At, 1, 1); PG8_STAGE(PG8_SA(1, 0), a3, voffA);
            PG8_BAR; PG8_WAIT_L(0); PG8_MMA(1, 0, At, B0); PG8_BAR; PG8_SCHED;
            PG8_STAGE(PG8_SB(1, 1), b3 + hstep, voffB);
            PG8_WAIT_V(6); PG8_BAR; PG8_MMA(1, 1, At, B1); PG8_BAR;
            }
        }
        if constexpr (ALIGN_EPI) { if (wr == 0) PG8_BAR; }
        if constexpr (!Epi::AFTER_DRAIN) { E(acc, cur, wr, wc, fr, fq); S.done(cur); }
        if (!has_next) break;
#pragma unroll
        for (int a = 0; a < 2; ++a)
#pragma unroll
            for (int b = 0; b < 2; ++b)
#pragma unroll
                for (int m = 0; m < 4; ++m)
#pragma unroll
                    for (int n = 0; n < 2; ++n) acc[a][b][m][n] = (f32x4){0.f, 0.f, 0.f, 0.f};
        cur = nxt; cA = nA; cB = nB; ++ui;
        if constexpr (ALIGN_EPI) { if (wr == 1) PG8_BAR; }
    }
    PG8_WAIT_V(0);
    if constexpr (!ALIGN_EPI) { if (wr == 0) PG8_BAR; }
    PG8_BAR;
    if constexpr (Epi::AFTER_DRAIN) { E.fused(acc, cur, wr, wc, fr, fq, lds, wid, lane); S.done(cur); }
#undef PG8_SA
#undef PG8_SB
#undef PG8_STAGE
#undef PG8_LDA
#undef PG8_LDB
#undef PG8_MMA
#undef PG8_WAIT_V
#undef PG8_WAIT_L
#undef PG8_BAR
#undef PG8_SCHED
}
}

namespace pg8 {
struct EpiSwiglu {
    static constexpr bool PERM = true, AFTER_DRAIN = false;
    bf16_t* O; int ldo; int p0; int nct;
    __device__ __forceinline__ void operator()(const f32x4 (&acc)[2][2][4][2], const Unit& u, int wr, int wc, int fr, int fq) const {
        const int row0 = (u.pm - p0) * BM + wr * 64 + fr, col0 = (u.pn % nct) * HALF + wc * 32 + 8 * fq;
#pragma unroll
        for (int ai = 0; ai < 2; ++ai)
#pragma unroll
            for (int m = 0; m < 4; ++m) { bf16_t* rowp = O + (size_t)(row0 + ai * HALF + m * 16) * ldo + col0;
                float a[8];
#pragma unroll
                for (int n = 0; n < 2; ++n)
#pragma unroll
                    for (int j = 0; j < 4; ++j) { const float g = acc[ai][0][m][n][j], up = acc[ai][1][m][n][j]; a[n * 4 + j] = g * __builtin_amdgcn_rcpf(1.0f + __expf(-g)) * up; }
                u32x4 w; w.x = cvt_pk_bf16(a[0], a[1]); w.y = cvt_pk_bf16(a[2], a[3]); w.z = cvt_pk_bf16(a[4], a[5]); w.w = cvt_pk_bf16(a[6], a[7]);
                *(u32x4*)rowp = w; }
    }
};
struct EpiBf16Mod {
    static constexpr bool PERM = true, AFTER_DRAIN = false;
    bf16_t* O; int ldc; int nct;
    __device__ __forceinline__ void operator()(const f32x4 (&acc)[2][2][4][2], const Unit& u, int wr, int wc, int fr, int fq) const {
        const int row0 = u.pm * BM + wr * 64 + fr, col0 = (u.pn % nct) * BM + wc * 32 + 8 * fq;
#pragma unroll
        for (int ai = 0; ai < 2; ++ai)
#pragma unroll
            for (int m = 0; m < 4; ++m) { bf16_t* rowp = O + (size_t)(row0 + ai * HALF + m * 16) * ldc + col0;
#pragma unroll
                for (int bj = 0; bj < 2; ++bj) { const f32x4 v0 = acc[ai][bj][m][0], v1 = acc[ai][bj][m][1];
                    u32x4 w; w.x = cvt_pk_bf16(v0[0], v0[1]); w.y = cvt_pk_bf16(v0[2], v0[3]); w.z = cvt_pk_bf16(v1[0], v1[1]); w.w = cvt_pk_bf16(v1[2], v1[3]);
                    *(u32x4*)(rowp + bj * HALF) = w; } }
    }
};
struct MoeOrder {
    int p0, np, nct, G, c; int pb[9];
    __device__ __forceinline__ bool next(int i, Unit& u) const {
        const int L = i * G + c; if (L >= np * nct) return false;
        const int nig = WGM * nct, gid = L / nig, fm = gid * WGM, gsz = (np - fm) < WGM ? (np - fm) : WGM, r = L % nig;
        const int pm = p0 + fm + (r % gsz), ct = r / gsz;
        int e = 0;
#pragma unroll
        for (int j = 1; j < 8; ++j) e += (pm >= pb[j]) ? 1 : 0;
        u.pm = pm; u.pn = e * nct + ct; return true;
    }
    __device__ __forceinline__ void a_ready(const Unit&) const {}
    __device__ __forceinline__ void done(const Unit&) const {}
};
}

constexpr int NWAVES = 8, NTHR = 512;
constexpr int D = 1024, NB = 8, SEQ = 4096, LC = 256, NT = NB * SEQ, NC = NB * LC, MT = NT + NC;
constexpr int DIN = 2944, NZ = 3072;
constexpr int C_K = 0, C_V = 512, C_WLO = 1024, C_ALO = 1152, C_R = 1280, C_GLO = 1792, C_U = 1920, C_GB = 2176, C_GC = 2432, C_F = 2688;
constexpr int DFF = 2816, NE = 8, DFE = 3584;
constexpr float NORM_EPS = 1e-6f, GN_EPS = 64e-5f;
constexpr int TP = 72;
enum { I_X = 0, I_C, I_CTX, I_CCTX, I_ADAW, I_ADAB, I_NORMG, I_WIN, I_WOUT, I_MU, I_MUW, I_MUA, I_W0, I_W2, I_A0, I_A2, I_G2, I_KK, I_KA, I_RK, I_GNW, I_GNB, I_CONVW,
       I_FG, I_FU, I_FD, I_RW, I_RB, I_MG, I_MUP, I_MD, N_IN };

constexpr size_t KiB = 1024, MiB = 1u << 20;
constexpr size_t WS_CTL = 0, CTL_ZERO_BYTES = 512 * KiB;
constexpr size_t WS_MOD = 512 * KiB;
constexpr size_t WS_TAB = 960 * KiB;
constexpr size_t TAB_E = WS_TAB;
constexpr size_t TAB_TWC = TAB_E + 64 * 512 * 4;
constexpr size_t TAB_TWS = TAB_TWC + 4096 * 4;
constexpr size_t TAB_C64 = TAB_TWS + 4096 * 4;
constexpr size_t TAB_S64 = TAB_C64 + 64 * 64 * 2;
constexpr size_t TAB_SN64 = TAB_S64 + 64 * 64 * 2;
constexpr size_t WS_ROUTE = 1152 * KiB;
constexpr size_t WS_TOKPOS = WS_ROUTE + (size_t)NT * 16;
static_assert(TAB_SN64 + 64 * 64 * 2 <= WS_ROUTE && WS_TOKPOS + (size_t)NT * 8 <= 2 * MiB, "low ws map");
constexpr size_t WS_Z = 2 * MiB;
constexpr size_t WS_SW = 206 * MiB;
constexpr size_t WS_WIN = WS_SW;
constexpr size_t WS_WOUT = WS_WIN + 2ull * NZ * D * 2;
constexpr size_t WS_WGU = WS_WOUT + 2ull * D * D * 2;
constexpr size_t WS_WDN = WS_WGU + 2ull * DFF * D * 2;
constexpr size_t WS_G2T = WS_WDN + (size_t)D * DFF * 2;
constexpr size_t WS_C256 = WS_G2T + 2ull * 512 * 128 * 2;
constexpr size_t WS_SN256 = WS_C256 + 256 * 256 * 2;
constexpr size_t WS_W2TG = WS_SN256 + 256 * 256 * 2;
constexpr size_t WS_A2TG = WS_W2TG + 4ull * 512 * 64 * 2;
constexpr size_t WS_XC = 244 * MiB;
static_assert(WS_A2TG + 4ull * 512 * 64 * 2 <= WS_XC, "small weights");
constexpr size_t WS_RING = 252 * MiB;
constexpr size_t WS_O32 = 381 * MiB;
constexpr size_t WS_YS = WS_O32;
constexpr size_t WS_YBUF = WS_YS + 2ull * MT * 512 * 2;
constexpr size_t WS_BONG = WS_YBUF + 32 * MiB;
constexpr size_t WS_H = 517 * MiB;
static_assert(WS_BONG + 2ull * MT * 8 * 4 <= WS_H && WS_Z + (size_t)MT * NZ * 2 <= WS_SW && WS_O32 + (size_t)MT * D * 4 <= WS_H, "ws map");
constexpr size_t WS_NEED = 585 * MiB;
static_assert(WS_H + (size_t)MT * D * 2 <= WS_NEED, "ws map end");
constexpr size_t WS_WMGU = 2 * MiB;
constexpr size_t WS_WMDN = WS_WMGU + 8ull * 2 * DFE * D * 2;
constexpr size_t WS_XG = 170 * MiB;
constexpr int XG_ROWS_CAP = 69632;
constexpr size_t WS_ACTM = 306 * MiB;
static_assert(WS_WMDN + 8ull * D * DFE * 2 <= WS_XG && WS_XG + (size_t)XG_ROWS_CAP * D * 2 <= WS_ACTM, "moe ws map");
constexpr int CW_TMO = 0;
constexpr int CW_CNT = 2048, CW_FILL = 3072;
constexpr int CW_BAR = 8192;
constexpr int MAX_LAUNCHES = 20;
constexpr int CW_PROD = 81920, CW_CONS = 81920 + 8192;

constexpr int LDS_BYTES = 163840;
constexpr int MISC_OFF = LDS_BYTES - 256;

#define GAS __attribute__((address_space(1)))
#define LAS __attribute__((address_space(3)))
typedef unsigned short bf16;
typedef unsigned v4u __attribute__((ext_vector_type(4)));
typedef unsigned v2u __attribute__((ext_vector_type(2)));
typedef float f32x4 __attribute__((ext_vector_type(4)));
typedef float f32x2 __attribute__((ext_vector_type(2)));
typedef short bf16x8 __attribute__((ext_vector_type(8)));
typedef short bf16x4 __attribute__((ext_vector_type(4)));
#define LDS_WAIT() asm volatile("s_waitcnt lgkmcnt(0)" ::: "memory")
typedef __bf16 bf16x2n __attribute__((ext_vector_type(2)));
__device__ __forceinline__ unsigned pk2(float lo, float hi) { const f32x2 v = {lo, hi}; return __builtin_bit_cast(unsigned, __builtin_convertvector(v, bf16x2n)); }
__device__ __forceinline__ unsigned f2bf(float f) { return pk2(f, f) & 0xffffu; }
__device__ __forceinline__ float bflo(unsigned w) { return __builtin_bit_cast(float, w << 16); }
__device__ __forceinline__ float bfhi(unsigned w) { return __builtin_bit_cast(float, w & 0xffff0000u); }
__device__ __forceinline__ float bf1(bf16 b) { return __builtin_bit_cast(float, (unsigned)b << 16); }
__device__ __forceinline__ float wave_sum(float v) {
#pragma unroll
    for (int o = 1; o < 64; o <<= 1) v += __shfl_xor(v, o);
    return v;
}
__device__ __forceinline__ float sigmoidf_(float x) { return __builtin_amdgcn_rcpf(1.0f + __expf(-x)); }
#define MFMA16(a, b, c) __builtin_amdgcn_mfma_f32_16x16x32_bf16((a), (b), (c), 0, 0, 0)
#define XB_TMO      128
#define XB_XCNT(j)  (256  + 64 * (j))
#define XB_XSUB(j)  (1280 + 64 * (j))
#define XB_XGEN(j)  (2304 + 64 * (j))
#define XB_TOP      3328
#define XB_TOPGEN   3392
#define XCD_BAR_WORDS 3456
#define XB_SPIN_CAP (1u << 18)
#define LAS __attribute__((address_space(3)))

__device__ __forceinline__ unsigned xb_ld(unsigned* p)              { return __hip_atomic_load(p, __ATOMIC_RELAXED, __HIP_MEMORY_SCOPE_AGENT); }
__device__ __forceinline__ unsigned xb_add(unsigned* p, unsigned v) { return __hip_atomic_fetch_add(p, v, __ATOMIC_RELAXED, __HIP_MEMORY_SCOPE_AGENT); }
__device__ __forceinline__ unsigned xb_xcc_id() { return (unsigned)__builtin_amdgcn_s_getreg((3 << 11) | 20) & 0xFu; }
#define XB_SPIN(cond, bar) do { unsigned _sp = 0; while (cond) { __builtin_amdgcn_s_sleep(1); \
    if ((++_sp & 255u) == 0u) { if (xb_ld(&(bar)[XB_TMO])) break; if (_sp > XB_SPIN_CAP) { atomicAdd(&(bar)[XB_TMO], 1u); break; } } } } while (0)

struct XcdBarrier {
    unsigned w0;
    unsigned* bar; unsigned x;
    volatile LAS unsigned* st;
};

__device__ __forceinline__ bool xb_lane0() { return __builtin_amdgcn_mbcnt_hi(~0u, __builtin_amdgcn_mbcnt_lo(~0u, 0u)) == 0u; }
__device__ __forceinline__ XcdBarrier xcd_barrier_post(unsigned* bar, volatile LAS unsigned* st, unsigned w0) {
    XcdBarrier b; b.w0 = w0; b.bar = bar; b.x = xb_xcc_id(); b.st = st;
    if (w0 && xb_lane0()) (void)xb_add(&bar[XB_XCNT(b.x)], 1u);
    return b;
}
__device__ __forceinline__ void xcd_barrier_complete(unsigned* bar, unsigned x, unsigned& nloc, unsigned& nx) {
    const unsigned G = gridDim.x * gridDim.y * gridDim.z;
    unsigned sum, cnt, mine, sp = 0u;
    for (;;) {
        sum = 0u; cnt = 0u; mine = 0u;
#pragma unroll
        for (unsigned j = 0; j < 16; ++j) { const unsigned c = xb_ld(&bar[XB_XCNT(j)]); sum += c; cnt += (c > 0u) ? 1u : 0u; mine = (j == x) ? c : mine; }
        if (sum == G) break;
        __builtin_amdgcn_s_sleep(1);
        if ((++sp & 255u) == 0u) { if (xb_ld(&bar[XB_TMO])) break; if (sp > XB_SPIN_CAP) { atomicAdd(&bar[XB_TMO], 1u); break; } }
    }
    nloc = mine > 0u ? mine : 1u; nx = cnt > 0u ? cnt : 1u;
}

__device__ __forceinline__ void xcd_barrier(const XcdBarrier& b) {
    asm volatile("s_waitcnt vmcnt(0)" ::: "memory");
    __syncthreads();
    if (b.w0 && xb_lane0()) {
        unsigned* bar = b.bar;
        __builtin_amdgcn_s_waitcnt(0);
        unsigned nloc = b.st[0], nx = b.st[1];
        if (nloc == 0u) { xcd_barrier_complete(bar, b.x, nloc, nx); b.st[0] = nloc; b.st[1] = nx; }
        const unsigned old = xb_add(&bar[XB_XSUB(b.x)], 1u);
        const unsigned gen = old / nloc;
        if (old + 1u == (gen + 1u) * nloc) {
            __builtin_amdgcn_fence(__ATOMIC_RELEASE, "agent");
            asm volatile("s_waitcnt vmcnt(0)" ::: "memory");
            const unsigned og = xb_add(&bar[XB_TOP], 1u);
            const unsigned tg = og / nx;
            if (og + 1u == (tg + 1u) * nx) xb_add(&bar[XB_TOPGEN], 1u);
            else XB_SPIN(xb_ld(&bar[XB_TOPGEN]) == tg, bar);
            __builtin_amdgcn_fence(__ATOMIC_ACQUIRE, "agent");
            xb_add(&bar[XB_XGEN(b.x)], 1u);
            asm volatile("s_waitcnt vmcnt(0)" ::: "memory");
        } else {
            XB_SPIN(xb_ld(&bar[XB_XGEN(b.x)]) == gen, bar);
            __builtin_amdgcn_fence(__ATOMIC_ACQUIRE, "agent");
            asm volatile("s_waitcnt vmcnt(0)" ::: "memory");
        }
    }
    __syncthreads();
}


struct Params {
    const float* in[N_IN];
    float* out;
    unsigned char* ws;
    int act_cap_panels;
    int ph_lo, ph_hi, li;
};
static_assert(sizeof(Params) == N_IN * 8 + 8 + 8 + 16, "Params has no padding");

struct Frame {
    LAS unsigned char* lds;
    int tid, lane, wave, G, bx;
};
#define WSP(T, off) ((T*)(P.ws + (off)))

__device__ __forceinline__ void transpose_item(const float* W, int N, bf16* WT, int ldk, int k0, int n0, int out_row0, LAS float* scr, int lane) {
#pragma unroll 8
    for (int i = 0; i < 32; ++i) { const int kk = 2 * i + (lane >> 5); scr[kk * 33 + (lane & 31)] = W[(size_t)(k0 + kk) * N + n0 + (lane & 31)]; }
    LDS_WAIT(); asm volatile("" ::: "memory");
    const int c = lane & 7;
#pragma unroll
    for (int j = 0; j < 4; ++j) { const int n = (lane >> 3) + 8 * j; const LAS float* s = scr + (8 * c) * 33 + n;
        v4u o; o.x = pk2(s[0 * 33], s[1 * 33]); o.y = pk2(s[2 * 33], s[3 * 33]); o.z = pk2(s[4 * 33], s[5 * 33]); o.w = pk2(s[6 * 33], s[7 * 33]);
        *(v4u*)(WT + (size_t)(out_row0 + n) * ldk + k0 + 8 * c) = o; }
    LDS_WAIT(); asm volatile("" ::: "memory");
}
__device__ __forceinline__ int gu_row(int n, int up) { return (n >> 7) * 256 + up * 128 + (n & 127); }

__device__ __forceinline__ void p0_small_weights(const Params& P, const Frame& F) {
    LAS float* scr = (LAS float*)(F.lds + F.wave * 16384);
    const int gw = F.bx * NWAVES + F.wave, NGW = F.G * NWAVES;
    constexpr int I_IN = 16 * 92, I_OUT = 16 * 32, I_GU = 16 * 88, I_DN = 44 * 32, I_GT = 2 * 16, I_LR = 16;
    constexpr int NITEMS = 2 * I_IN + 2 * I_OUT + 2 * I_GU + I_DN + 2 * I_GT + 8 * I_LR;
    for (int it = gw; it < NITEMS; it += NGW) {
        int r = it;
        if (r < 2 * I_IN) { const int l = r / I_IN; r %= I_IN; const int kb = r / 92, nb = r % 92;
            transpose_item(P.in[I_WIN] + (size_t)l * D * DIN, DIN, WSP(bf16, WS_WIN) + (size_t)l * NZ * D, D, 64 * kb, 32 * nb, 32 * nb, scr, F.lane); continue; } r -= 2 * I_IN;
        if (r < 2 * I_OUT) { const int l = r / I_OUT; r %= I_OUT; const int kb = r / 32, nb = r % 32;
            transpose_item(P.in[I_WOUT] + (size_t)l * D * D, D, WSP(bf16, WS_WOUT) + (size_t)l * D * D, D, 64 * kb, 32 * nb, 32 * nb, scr, F.lane); continue; } r -= 2 * I_OUT;
        if (r < 2 * I_GU) { const int up = r / I_GU; r %= I_GU; const int kb = r / 88, nb = r % 88;
            transpose_item(P.in[up ? I_FU : I_FG], DFF, WSP(bf16, WS_WGU), D, 64 * kb, 32 * nb, gu_row(32 * nb, up), scr, F.lane); continue; } r -= 2 * I_GU;
        if (r < I_DN) { const int kb = r / 32, nb = r % 32;
            transpose_item(P.in[I_FD], D, WSP(bf16, WS_WDN), DFF, 64 * kb, 32 * nb, 32 * nb, scr, F.lane); continue; } r -= I_DN;
        if (r < 2 * I_GT) { const int l = r / I_GT; r %= I_GT; const int kb = r / 16, nb = r % 16;
            transpose_item(P.in[I_G2] + (size_t)l * 128 * 512, 512, WSP(bf16, WS_G2T) + (size_t)l * 512 * 128, 128, 64 * kb, 32 * nb, 32 * nb, scr, F.lane); continue; } r -= 2 * I_GT;
        { const int which = r / (4 * I_LR); r %= 4 * I_LR; const int ldi = r / I_LR, nb = r % I_LR;
            transpose_item(P.in[which ? I_A2 : I_W2] + (size_t)ldi * 64 * 512, 512, WSP(bf16, which ? WS_A2TG : WS_W2TG) + (size_t)ldi * 512 * 64, 64, 0, 32 * nb, 32 * nb, scr, F.lane); }
    }
    { const int gt = F.bx * NTHR + F.tid, NGT = F.G * NTHR; constexpr int NV = 2 * (NZ - DIN) * D / 8;
        for (int i = gt; i < NV; i += NGT) { const int l = i / ((NZ - DIN) * D / 8), r = i % ((NZ - DIN) * D / 8);
            *(v4u*)(WSP(bf16, WS_WIN) + (size_t)l * NZ * D + (size_t)DIN * D + (size_t)r * 8) = (v4u){0u, 0u, 0u, 0u}; } }
}
__device__ __forceinline__ void p0_tables(const Params& P, const Frame& F) {
    const int gt = F.bx * NTHR + F.tid, NGT = F.G * NTHR;
    float* E = WSP(float, TAB_E);
    for (int i = gt; i < 64 * 256; i += NGT) { const int n = i >> 8, q = i & 255;
        const float omega = 1.0f / powf(10000.0f, (float)q / 256.0f), ang = (float)n * omega;
        E[n * 512 + q] = sinf(ang); E[n * 512 + 256 + q] = cosf(ang); }
    float* twc = WSP(float, TAB_TWC); float* tws = WSP(float, TAB_TWS);
    for (int i = gt; i < 4096; i += NGT) { const float a = (float)i / 2048.0f; twc[i] = cospif(a); tws[i] = sinpif(a); }
    bf16* c64 = WSP(bf16, TAB_C64); bf16* s64 = WSP(bf16, TAB_S64); bf16* sn64 = WSP(bf16, TAB_SN64);
    for (int i = gt; i < 64 * 64; i += NGT) { const int m = ((i >> 6) * (i & 63)) & 63; const float a = (float)m / 32.0f; const float c = cospif(a), s = sinpif(a);
        c64[i] = (bf16)f2bf(c); s64[i] = (bf16)f2bf(s); sn64[i] = (bf16)f2bf(-s); }
    bf16* c256 = WSP(bf16, WS_C256); bf16* sn256 = WSP(bf16, WS_SN256);
    for (int i = gt; i < 256 * 256; i += NGT) { const int m = ((i >> 8) * (i & 255)) & 255; const float a = (float)m / 128.0f;
        c256[i] = (bf16)f2bf(cospif(a)); sn256[i] = (bf16)f2bf(-sinpif(a)); }
}
__device__ __forceinline__ void p0_adaln(const Params& P, const Frame& F) {
    LAS float* sc = (LAS float*)F.lds;
    LAS float* red = sc + 9 * 1024;
    for (int u = F.bx; u < 192; u += F.G) {
        const int l = u / 96, cb = u % 96;
        for (int i = F.tid; i < 9 * 1024; i += NTHR) { const int r = i >> 10, d = i & 1023; const float v = r < 8 ? P.in[I_C][r * 1024 + d] : P.in[I_CCTX][d]; sc[i] = v / (1.0f + expf(-v)); }
        __syncthreads();
        const int col = F.tid & 63, ks = F.tid >> 6;
        float acc[9];
#pragma unroll
        for (int r = 0; r < 9; ++r) acc[r] = 0.f;
        const float* w = P.in[I_ADAW] + ((size_t)l * 1024 + ks * 128) * 6144 + cb * 64 + col;
#pragma unroll 2
        for (int k = 0; k < 128; k += 8) {
            float wv[8];
#pragma unroll
            for (int q = 0; q < 8; ++q) wv[q] = w[(size_t)(k + q) * 6144];
#pragma unroll
            for (int r = 0; r < 9; ++r) { const f32x4 s4 = *(const LAS f32x4*)(sc + r * 1024 + ks * 128 + k), s5 = *(const LAS f32x4*)(sc + r * 1024 + ks * 128 + k + 4);
                acc[r] += (s4.x * wv[0] + s4.y * wv[1] + s4.z * wv[2] + s4.w * wv[3]) + (s5.x * wv[4] + s5.y * wv[5] + s5.z * wv[6] + s5.w * wv[7]); }
        }
#pragma unroll
        for (int r = 0; r < 9; ++r) red[(ks * 9 + r) * 64 + col] = acc[r];
        __syncthreads();
        for (int i = F.tid; i < 9 * 64; i += NTHR) { const int r = i >> 6, c = i & 63; float s = 0.f;
#pragma unroll
            for (int k = 0; k < 8; ++k) s += red[(k * 9 + r) * 64 + c];
            WSP(float, WS_MOD)[(size_t)(l * 9 + r) * 6144 + cb * 64 + c] = s + P.in[I_ADAB][l * 6144 + cb * 64 + c]; }
        __syncthreads();
    }
}
__device__ __forceinline__ void convert_moe_weights(const Params& P, const Frame& F) {
    LAS float* scr = (LAS float*)(F.lds + F.wave * 16384);
    const int gw = F.bx * NWAVES + F.wave, NGW = F.G * NWAVES;
    constexpr int I_GU = 16 * 112, I_DN = 56 * 32, NITEMS = NE * (2 * I_GU + I_DN);
    for (int it = gw; it < NITEMS; it += NGW) {
        const int e = it / (2 * I_GU + I_DN); int r = it % (2 * I_GU + I_DN);
        if (r < 2 * I_GU) { const int up = r / I_GU; r %= I_GU; const int kb = r / 112, nb = r % 112;
            transpose_item(P.in[up ? I_MUP : I_MG] + (size_t)e * D * DFE, DFE, WSP(bf16, WS_WMGU) + (size_t)e * 2 * DFE * D, D, 64 * kb, 32 * nb, gu_row(32 * nb, up), scr, F.lane); }
        else { r -= 2 * I_GU; const int kb = r / 32, nb = r % 32;
            transpose_item(P.in[I_MD] + (size_t)e * DFE * D, D, WSP(bf16, WS_WMDN) + (size_t)e * D * DFE, DFE, 64 * kb, 32 * nb, 32 * nb, scr, F.lane); }
    }
}

__device__ __forceinline__ void store_h_row(bf16* hrow, int lane, const f32x4 (&h)[4]) {
#pragma unroll
    for (int j = 0; j < 4; ++j) { v2u w; w.x = pk2(h[j].x, h[j].y); w.y = pk2(h[j].z, h[j].w); *(v2u*)(hrow + 4 * lane + 256 * j) = w; }
}
__device__ __forceinline__ void norm_mod(const f32x4 (&x)[4], int lane, const float* ng, const float* sc, const float* sh, f32x4 (&h)[4]) {
    float ss = 0.f;
#pragma unroll
    for (int j = 0; j < 4; ++j) ss += (x[j].x * x[j].x + x[j].y * x[j].y) + (x[j].z * x[j].z + x[j].w * x[j].w);
    const float rs = rsqrtf(wave_sum(ss) * (1.0f / D) + NORM_EPS);
#pragma unroll
    for (int j = 0; j < 4; ++j) { const int c = 4 * lane + 256 * j; const f32x4 g = *(const f32x4*)(ng + c), s1 = *(const f32x4*)(sc + c), s0 = *(const f32x4*)(sh + c);
        h[j] = (x[j] * rs * g) * (1.0f + s1) + s0; }
}
__device__ __forceinline__ void phase_first_norm(const Params& P, const Frame& F) {
    const int gw = F.bx * NWAVES + F.wave, NGW = F.G * NWAVES, lane = F.lane;
    const float* E = WSP(float, TAB_E); const float* mod = WSP(float, WS_MOD); bf16* H = WSP(bf16, WS_H);
    const float* ng = P.in[I_NORMG];
    f32x4 xn[4];
    auto src = [&](int row) -> const float* { return row < NT ? P.in[I_X] + (size_t)row * D : P.in[I_CTX] + (size_t)(row - NT) * D; };
    if (gw < MT) { const float* xr = src(gw);
#pragma unroll
        for (int j = 0; j < 4; ++j) xn[j] = *(const f32x4*)(xr + 4 * lane + 256 * j); }
    for (int row = gw; row < MT; row += NGW) {
        f32x4 x[4];
#pragma unroll
        for (int j = 0; j < 4; ++j) x[j] = xn[j];
        if (row + NGW < MT) { const float* xr = src(row + NGW);
#pragma unroll
            for (int j = 0; j < 4; ++j) xn[j] = *(const f32x4*)(xr + 4 * lane + 256 * j); }
        int mr = 8;
        if (row < NT) { const int p = row & (SEQ - 1); mr = row >> 12;
#pragma unroll
            for (int j = 0; j < 4; ++j) { const int c = 4 * lane + 256 * j; const float* e = (j < 2) ? (E + (p >> 6) * 512 + c) : (E + (p & 63) * 512 + (c - 512));
                x[j] = x[j] + *(const f32x4*)e; }
        }
        const float* m = mod + (size_t)(0 * 9 + mr) * 6144;
        f32x4 h[4]; norm_mod(x, lane, ng, m + 1024, m, h);
        store_h_row(H + (size_t)row * D, lane, h);
    }
}
template <int MODE, bool NEXT, bool ROUTE, bool FIRST = false>
__device__ __forceinline__ void phase_post(const Params& P, const Frame& F, int nrows, int l, int goff, int ngp_idx, const float* xc_src, int ln, int ngn_idx, int scoff, int shoff) {
    const int gw = F.bx * NWAVES + F.wave, NGW = F.G * NWAVES, lane = F.lane;
    const float* mod = WSP(float, WS_MOD); bf16* H = WSP(bf16, WS_H); const bf16* O32 = WSP(bf16, WS_O32);
    const float* ngp = P.in[I_NORMG] + (size_t)(l * 4 + ngp_idx) * D;
    const float* ngn = P.in[I_NORMG] + (size_t)(ln * 4 + ngn_idx) * D;
    int cnt[NE];
#pragma unroll
    for (int e = 0; e < NE; ++e) cnt[e] = 0;
    v2u on0[4], on1[4]; f32x4 xnx[4]; float pn0 = 0.f, pn1 = 0.f;
    auto xsrc = [&](int row) -> const float* { return row < NT ? ((FIRST ? P.in[I_X] : (const float*)P.out) + (size_t)row * D) : (xc_src + (size_t)(row - NT) * D); };
    auto fetch = [&](int row) {
        if (MODE == 0) {
#pragma unroll
            for (int j = 0; j < 4; ++j) on0[j] = *(const v2u*)(O32 + (size_t)row * D + 4 * lane + 256 * j);
        } else {
            const int4 rt = *(const int4*)(P.ws + WS_ROUTE + (size_t)row * 16); const int2 tp = *(const int2*)(P.ws + WS_TOKPOS + (size_t)row * 8);
            pn0 = __builtin_bit_cast(float, rt.y); pn1 = __builtin_bit_cast(float, rt.z);
            const bf16* y0 = WSP(bf16, WS_XG) + (size_t)tp.x * D; const bf16* y1 = WSP(bf16, WS_XG) + (size_t)tp.y * D;
#pragma unroll
            for (int j = 0; j < 4; ++j) { on0[j] = *(const v2u*)(y0 + 4 * lane + 256 * j); on1[j] = *(const v2u*)(y1 + 4 * lane + 256 * j); }
        }
        const float* xs = xsrc(row);
#pragma unroll
        for (int j = 0; j < 4; ++j) xnx[j] = *(const f32x4*)(xs + 4 * lane + 256 * j);
    };
    if (gw < nrows) fetch(gw);
    for (int row = gw; row < nrows; row += NGW) {
        const int mr = row < NT ? (row >> 12) : 8;
        f32x4 o[4], xin[4];
#pragma unroll
        for (int j = 0; j < 4; ++j) { xin[j] = xnx[j];
            if (FIRST && row < NT) { const int p = row & (SEQ - 1), c = 4 * lane + 256 * j; const float* e = (j < 2) ? (WSP(float, TAB_E) + (p >> 6) * 512 + c) : (WSP(float, TAB_E) + (p & 63) * 512 + (c - 512)); xin[j] = xin[j] + *(const f32x4*)e; }
            if (MODE == 0) o[j] = (f32x4){bflo(on0[j].x), bfhi(on0[j].x), bflo(on0[j].y), bfhi(on0[j].y)};
            else o[j] = (f32x4){pn0 * bflo(on0[j].x) + pn1 * bflo(on1[j].x), pn0 * bfhi(on0[j].x) + pn1 * bfhi(on1[j].x), pn0 * bflo(on0[j].y) + pn1 * bflo(on1[j].y), pn0 * bfhi(on0[j].y) + pn1 * bfhi(on1[j].y)}; }
        if (row + NGW < nrows) fetch(row + NGW);
        float ss = 0.f;
#pragma unroll
        for (int j = 0; j < 4; ++j) ss += (o[j].x * o[j].x + o[j].y * o[j].y) + (o[j].z * o[j].z + o[j].w * o[j].w);
        const float rs = rsqrtf(wave_sum(ss) * (1.0f / D) + NORM_EPS);
        float* xd = row < NT ? (P.out + (size_t)row * D) : (WSP(float, WS_XC) + (size_t)(row - NT) * D);
        const float* m = mod + (size_t)(l * 9 + mr) * 6144;
        f32x4 x[4];
#pragma unroll
        for (int j = 0; j < 4; ++j) { const int c = 4 * lane + 256 * j; const f32x4 g = *(const f32x4*)(m + goff + c), n = *(const f32x4*)(ngp + c);
            x[j] = xin[j] + g * (o[j] * rs * n); *(f32x4*)(xd + c) = x[j]; }
        if (NEXT) {
            const float* mn = mod + (size_t)(ln * 9 + mr) * 6144;
            f32x4 h[4]; norm_mod(x, lane, ngn, mn + scoff, mn + shoff, h);
            store_h_row(H + (size_t)row * D, lane, h);
            if (ROUTE) {
                float lg[NE];
#pragma unroll
                for (int e = 0; e < NE; ++e) lg[e] = 0.f;
                const float* rw = P.in[I_RW];
#pragma unroll
                for (int j = 0; j < 4; ++j)
#pragma unroll
                    for (int q = 0; q < 4; ++q) { const int c = 4 * lane + 256 * j + q; const f32x4 w0 = *(const f32x4*)(rw + c * 8), w1 = *(const f32x4*)(rw + c * 8 + 4); const float hv = h[j][q];
                        lg[0] += hv * w0.x; lg[1] += hv * w0.y; lg[2] += hv * w0.z; lg[3] += hv * w0.w; lg[4] += hv * w1.x; lg[5] += hv * w1.y; lg[6] += hv * w1.z; lg[7] += hv * w1.w; }
#pragma unroll
                for (int e = 0; e < NE; ++e) lg[e] = wave_sum(lg[e]) + P.in[I_RB][e];
                int i0 = 0; float v0 = lg[0];
#pragma unroll
                for (int e = 1; e < NE; ++e) if (lg[e] > v0) { v0 = lg[e]; i0 = e; }
                int i1 = -1; float v1 = -3.0e38f;
#pragma unroll
                for (int e = 0; e < NE; ++e) if (e != i0 && lg[e] > v1) { v1 = lg[e]; i1 = e; }
                const float e1 = expf(v1 - v0), p0 = 1.0f / (1.0f + e1), p1 = e1 / (1.0f + e1);
                if (lane == 0) *(int4*)(P.ws + WS_ROUTE + (size_t)row * 16) = make_int4(i0 | (i1 << 8), __builtin_bit_cast(int, p0), __builtin_bit_cast(int, p1), 0);
#pragma unroll
                for (int e = 0; e < NE; ++e) cnt[e] += (e == i0 || e == i1) ? 1 : 0;
            }
        }
    }
    if (ROUTE) {
        if (lane == 0) {
#pragma unroll
            for (int e = 0; e < NE; ++e) if (cnt[e]) __hip_atomic_fetch_add(WSP(unsigned, WS_CTL) + CW_CNT + 64 * e, (unsigned)cnt[e], __ATOMIC_RELAXED, __HIP_MEMORY_SCOPE_AGENT);
        }
    }
}

constexpr int TB = 64;
typedef short bf16x4s __attribute__((ext_vector_type(4)));
#define MFMA16K(a, b, c) __builtin_amdgcn_mfma_f32_16x16x16bf16_1k((a), (b), (c), 0, 0, 0)
__device__ __forceinline__ float fexp(float x) { return __builtin_amdgcn_exp2f(x * 1.44269504089f); }
__device__ __forceinline__ float flog(float x) { return __builtin_amdgcn_logf(x) * 0.69314718056f; }
__device__ __forceinline__ float frcp(float x) { return __builtin_amdgcn_rcpf(x); }
__device__ __forceinline__ float softplusf_(float x) { return fmaxf(x, 0.f) + flog(1.0f + fexp(-fabsf(x))); }
__device__ __forceinline__ float ftanh(float x) { return 1.0f - 2.0f * frcp(1.0f + fexp(2.0f * x)); }
__device__ __forceinline__ f32x4 ld4bf(const bf16* p) { const v2u w = *(const v2u*)p; return (f32x4){bflo(w.x), bfhi(w.x), bflo(w.y), bfhi(w.y)}; }
template <int CTRL> __device__ __forceinline__ float dppf(float v) { return __builtin_bit_cast(float, __builtin_amdgcn_update_dpp(0, __builtin_bit_cast(int, v), CTRL, 0xf, 0xf, true)); }
__device__ __forceinline__ float sum8(float v) { v += dppf<0xB1>(v); v += dppf<0x4E>(v); v += dppf<0x141>(v); return v; }
__device__ __forceinline__ bf16x4s pack4(f32x4 v) { v2u w; w.x = pk2(v.x, v.y); w.y = pk2(v.z, v.w); return __builtin_bit_cast(bf16x4s, w); }
__device__ __forceinline__ void unpack8(v4u w, float (&o)[8]) {
#pragma unroll
    for (int q = 0; q < 4; ++q) { o[2 * q] = bflo(w[q]); o[2 * q + 1] = bfhi(w[q]); } }
__device__ __forceinline__ v4u pack8(const float (&o)[8]) { v4u w;
#pragma unroll
    for (int q = 0; q < 4; ++q) w[q] = pk2(o[2 * q], o[2 * q + 1]);
    return w; }
struct ScanPre { v4u kc, kp, vc, vp, rc, rp, wc, wp, ac, ap; };
__device__ __forceinline__ int scan_row(int bi, int tk, int b, int dir, bool& hp, int& prow) {
    const int seq = bi >= LC / TB, c = seq ? bi - LC / TB : bi, len = seq ? SEQ : LC, rowbase = seq ? b * SEQ : NT + b * LC;
    const int ts = c * TB + tk, t = dir ? (len - 1 - ts) : ts;
    hp = dir ? (t + 1 < len) : (t > 0);
    prow = rowbase + (hp ? (dir ? t + 1 : t - 1) : t);
    return rowbase + t;
}
__device__ __forceinline__ void scan_prefetch(const bf16* Z, int bi, int tk, int b, int dir, int gc, int c8, ScanPre& R) {
    bool hp; int prow; const int row = scan_row(bi, tk, b, dir, hp, prow);
    const bf16* zrk = Z + (size_t)row * NZ + gc; const bf16* zpk = Z + (size_t)prow * NZ + gc;
    const bf16* zrw = Z + (size_t)row * NZ + C_WLO + 64 * dir + c8; const bf16* zpw = Z + (size_t)prow * NZ + C_WLO + 64 * dir + c8;
    R.kc = *(const v4u*)(zrk + C_K); R.vc = *(const v4u*)(zrk + C_V); R.rc = *(const v4u*)(zrk + C_R); R.wc = *(const v4u*)(zrw); R.ac = *(const v4u*)(zrw + (C_ALO - C_WLO));
    R.kp = *(const v4u*)(zpk + C_K); R.vp = *(const v4u*)(zpk + C_V); R.rp = *(const v4u*)(zpk + C_R); R.wp = *(const v4u*)(zpw); R.ap = *(const v4u*)(zpw + (C_ALO - C_WLO));
}
__device__ __forceinline__ void lerp8(v4u cur, v4u prv, bool hp, const LAS float* mu, float (&o)[8]) {
    if (!hp) prv = (v4u){0u, 0u, 0u, 0u};
    const f32x4 m0 = *(const LAS f32x4*)mu, m1 = *(const LAS f32x4*)(mu + 4);
#pragma unroll
    for (int q = 0; q < 4; ++q) {
        const f32x2 c2 = {bflo(cur[q]), bfhi(cur[q])}, p2 = {bflo(prv[q]), bfhi(prv[q])};
        const f32x2 m2 = q < 2 ? (f32x2){m0[2 * q], m0[2 * q + 1]} : (f32x2){m1[2 * q - 4], m1[2 * q - 3]};
        const f32x2 r2 = c2 + (p2 - c2) * m2;
        o[2 * q] = r2.x; o[2 * q + 1] = r2.y; }
}
#define RLX_AGENT __ATOMIC_RELAXED, __HIP_MEMORY_SCOPE_AGENT
typedef GAS unsigned gu32;
constexpr unsigned kSpinCap = 1u << 17;
__device__ __forceinline__ bool wait_ge(gu32* word, unsigned want, gu32* tmo, unsigned code, int lane) {
    for (unsigned spins = 0;;) {
        if ((unsigned)__builtin_amdgcn_readfirstlane(__hip_atomic_load(word, RLX_AGENT)) >= want) return true;
        __builtin_amdgcn_s_sleep(1);
        if (++spins > kSpinCap) { if (lane == 0) { __hip_atomic_store(tmo, 1u, RLX_AGENT); __hip_atomic_fetch_max(tmo + 1, code, RLX_AGENT); } return false; }
        if ((spins & 255u) == 0u && __builtin_amdgcn_readfirstlane(__hip_atomic_load(tmo, RLX_AGENT))) return false;
    }
}
constexpr int XFER_PIECES = 3264, XFER_SLOT_BYTES = 52480, XFER_SLOTS = 6;
static_assert(WS_RING + 128ull * XFER_SLOTS * XFER_SLOT_BYTES <= WS_O32, "hand-off rings fit below the O buffer");
__device__ __forceinline__ int xfer_lds_off(int i) { return i < 1536 ? 20992 + 16 * i : (i < 2688 ? 45568 + 16 * (i - 1536) : 102912 + 16 * (i - 2688)); }
__device__ __forceinline__ void scan_unit(const Params& P, const Frame& F, int l, int b, int h, int dir, int role) {
    LAS unsigned char* L0 = F.lds;
    LAS bf16* W2T = (LAS bf16*)L0;
    LAS bf16* A2T = (LAS bf16*)(L0 + 9216);
    LAS float* CST = (LAS float*)(L0 + 18432);
    LAS bf16* TWb = (LAS bf16*)(L0 + 20992);
    LAS bf16* ALb = TWb + TB * TP;
    LAS bf16* BH = (LAS bf16*)(L0 + 20992);
    LAS bf16* KH = BH + 4 * 64 * 16;
    LAS bf16* Vt = KH + 4 * 64 * 16;
    LAS float* LW = (LAS float*)(L0 + 45568);
    constexpr int LWP = 68;
    LAS float* LA = LW + TB * LWP;
    LAS bf16* AT = (LAS bf16*)(L0 + 45568);
    LAS bf16* RT = AT + TB * TP; LAS bf16* BT = RT + TB * TP; LAS bf16* KT = BT + TB * TP;
    LAS float* CUM = (LAS float*)(L0 + 82432);
    LAS float* LabF = (LAS float*)(L0 + 98816);
    LAS bf16* LakB = (LAS bf16*)(L0 + 102912);
    LAS bf16* TtB = LakB + 1024; LAS bf16* MrbB = TtB + 1024; LAS bf16* MrkB = MrbB + 1024;
    LAS float* PCb = (LAS float*)(L0 + 111104);
    LAS float* YB = (LAS float*)(L0 + 112128);
    LAS float* BONl = (LAS float*)(L0 + 128512);
    const int tid = F.tid, lane = F.lane, w = F.wave, fr = lane & 15, fq = lane >> 4;
    const int tk = tid >> 3, c8 = (tid & 7) * 8, gc = 64 * h + c8;
    const int ld = l * 2 + dir;
    for (int i = tid; i < 4096; i += NTHR) { const int j = i >> 6, c = i & 63;
        W2T[c * TP + j] = (bf16)f2bf(P.in[I_W2][((size_t)ld * 64 + j) * 512 + 64 * h + c]); A2T[c * TP + j] = (bf16)f2bf(P.in[I_A2][((size_t)ld * 64 + j) * 512 + 64 * h + c]); }
    if (tid < 64) { const int c = 64 * h + tid;
        CST[0 * 64 + tid] = P.in[I_MU][(size_t)(ld * 3 + 0) * 512 + c]; CST[1 * 64 + tid] = P.in[I_MU][(size_t)(ld * 3 + 1) * 512 + c]; CST[2 * 64 + tid] = P.in[I_MU][(size_t)(ld * 3 + 2) * 512 + c];
        CST[3 * 64 + tid] = P.in[I_MUW][ld * 64 + tid]; CST[4 * 64 + tid] = P.in[I_MUA][ld * 64 + tid];
        CST[5 * 64 + tid] = P.in[I_W0][ld * 512 + c]; CST[6 * 64 + tid] = P.in[I_A0][ld * 512 + c];
        CST[7 * 64 + tid] = P.in[I_KK][l * 512 + c]; CST[8 * 64 + tid] = P.in[I_KA][l * 512 + c]; CST[9 * 64 + tid] = P.in[I_RK][l * 512 + c]; }
    const bf16* Z = WSP(bf16, WS_Z);
    bf16* YS = WSP(bf16, WS_YS) + (size_t)dir * MT * 512;
    float* BONG = WSP(float, WS_BONG) + (size_t)dir * MT * 8;
    f32x4 St[4];
#pragma unroll
    for (int kt = 0; kt < 4; ++kt) St[kt] = (f32x4){0.f, 0.f, 0.f, 0.f};
    constexpr int NBT = LC / TB + SEQ / TB;
    const int sid = (b * 8 + h) * 2 + dir;
    gu32* ctlw = (gu32*)WSP(unsigned, WS_CTL);
    gu32* prodw = ctlw + CW_PROD + l * 16384 + 64 * sid; gu32* consw = ctlw + CW_CONS + l * 16384 + 64 * sid;
    unsigned char* ring = P.ws + WS_RING + (size_t)sid * (XFER_SLOTS * XFER_SLOT_BYTES);
    v4u XR[7];
    ScanPre R; scan_prefetch(Z, role == 1 ? 1 : 0, tk, b, dir, gc, c8, R);
    __syncthreads();
    for (int bi = (role == 1 ? 1 : 0); bi < NBT; ++bi) {
        const bool mine = (role == 2) || ((bi % 2 == 0) == (role == 0));
        if (role == 1 && !mine) continue;
        const int hj = bi >> 1;
        const int bstep = role == 2 ? 1 : 2;
        const bool need_out = (bi >= LC / TB) || (l == 0);
        bool hp; int prow; const int row = scan_row(bi, tk, b, dir, hp, prow); (void)prow;
#ifdef PROBE_PREP2
        for (int prb_ = 0; prb_ < 2; ++prb_)
#endif
        if (mine) {
        if (role == 1 && hj >= XFER_SLOTS) { if (w == 0) wait_ge(consw, (unsigned)(hj - XFER_SLOTS + 1), ctlw + CW_TMO, 0x900u, lane); __syncthreads(); }
        float kx[8], vx[8], rx[8];
        { float wl[8], al[8];
          lerp8(R.kc, R.kp, hp, CST + 0 * 64 + c8, kx); lerp8(R.vc, R.vp, hp, CST + 1 * 64 + c8, vx); lerp8(R.rc, R.rp, hp, CST + 2 * 64 + c8, rx);
          lerp8(R.wc, R.wp, hp, CST + 3 * 64 + c8, wl); lerp8(R.ac, R.ap, hp, CST + 4 * 64 + c8, al);
#pragma unroll
          for (int j = 0; j < 8; ++j) wl[j] = ftanh(wl[j]);
          *(LAS v4u*)(TWb + tk * TP + c8) = pack8(wl); *(LAS v4u*)(ALb + tk * TP + c8) = pack8(al); }
        if (bi + bstep < NBT) scan_prefetch(Z, bi + bstep, tk, b, dir, gc, c8, R);
        __syncthreads();
        { const int mt = w & 3;
          bf16x8 yt[2], ya[2];
#pragma unroll
          for (int k2 = 0; k2 < 2; ++k2) { yt[k2] = *(const LAS bf16x8*)(TWb + (16 * mt + fr) * TP + 32 * k2 + 8 * fq); ya[k2] = *(const LAS bf16x8*)(ALb + (16 * mt + fr) * TP + 32 * k2 + 8 * fq); }
#pragma unroll
          for (int n2 = 0; n2 < 2; ++n2) { const int nt = 2 * (w >> 2) + n2;
              f32x4 cw = {0.f, 0.f, 0.f, 0.f}, ca = {0.f, 0.f, 0.f, 0.f};
#pragma unroll
              for (int k2 = 0; k2 < 2; ++k2) {
                  cw = MFMA16(*(const LAS bf16x8*)(W2T + (16 * nt + fr) * TP + 32 * k2 + 8 * fq), yt[k2], cw);
                  ca = MFMA16(*(const LAS bf16x8*)(A2T + (16 * nt + fr) * TP + 32 * k2 + 8 * fq), ya[k2], ca); }
              *(LAS f32x4*)(LW + (16 * mt + fr) * LWP + 16 * nt + 4 * fq) = cw; *(LAS f32x4*)(LA + (16 * mt + fr) * LWP + 16 * nt + 4 * fq) = ca; } }
        __syncthreads();
        float na[8], pb[8], km[8];
        {
            float n2 = 0.f, bon = 0.f, ew[8];
#pragma unroll
            for (int hf = 0; hf < 2; ++hf) {
#pragma unroll
                for (int j = 4 * hf; j < 4 * hf + 4; ++j) {
                    const float aw = LW[tk * LWP + c8 + j], aa = LA[tk * LWP + c8 + j];
                    ew[j] = 0.6065306597f * frcp(1.0f + fexp(-(CST[5 * 64 + c8 + j] + aw)));
                    const float ag = frcp(1.0f + fexp(-(CST[6 * 64 + c8 + j] + aa)));
                    const float kk = kx[j] * CST[7 * 64 + c8 + j]; n2 += kk * kk;
                    km[j] = kx[j] * (1.0f + (ag - 1.0f) * CST[8 * 64 + c8 + j]);
                    bon += rx[j] * km[j] * CST[9 * 64 + c8 + j];
                    na[j] = kk; pb[j] = ag;
                }
                __builtin_amdgcn_sched_barrier(0);
            }
            n2 = sum8(n2); bon = sum8(bon);
            const float inv = frcp(fmaxf(__builtin_amdgcn_sqrtf(n2), 1e-12f));
#pragma unroll
            for (int j = 0; j < 8; ++j) { const float kkn = na[j] * inv; na[j] = -kkn; pb[j] = kkn * pb[j]; }
            *(LAS f32x4*)(CUM + tk * 64 + c8) = (f32x4){ew[0], ew[1], ew[2], ew[3]} * 1.44269504089f; *(LAS f32x4*)(CUM + tk * 64 + c8 + 4) = (f32x4){ew[4], ew[5], ew[6], ew[7]} * 1.44269504089f;
            if ((tid & 7) == 0 && need_out) BONG[(size_t)row * 8 + h] = bon;
        }
        __syncthreads();
        if (tid < 256) { const int q = tid >> 6, ch = tid & 63; float c = 0.f;
#pragma unroll
            for (int i = 0; i < 16; ++i) { c -= CUM[(16 * q + i) * 64 + ch]; const float p = __builtin_amdgcn_exp2f(c); CUM[(16 * q + i) * 64 + ch] = p; if (i == 15) PCb[q * 64 + ch] = p; } }
        __syncthreads();
        {
            const int q = tk >> 4, tt = tk & 15;
            const f32x4 one4 = {1.f, 1.f, 1.f, 1.f};
            const f32x4 et0 = *(const LAS f32x4*)(CUM + tk * 64 + c8), et1 = *(const LAS f32x4*)(CUM + tk * 64 + c8 + 4);
            const f32x4 ep0 = tt ? *(const LAS f32x4*)(CUM + (tk - 1) * 64 + c8) : one4, ep1 = tt ? *(const LAS f32x4*)(CUM + (tk - 1) * 64 + c8 + 4) : one4;
            const f32x4 pc0 = *(const LAS f32x4*)(PCb + q * 64 + c8), pc1 = *(const LAS f32x4*)(PCb + q * 64 + c8 + 4);
            float ei8[8];
            { float t8[8];
#pragma unroll
              for (int j = 0; j < 8; ++j) t8[j] = na[j] * (j < 4 ? ep0[j & 3] : ep1[j & 3]);
              *(LAS v4u*)(AT + tk * TP + c8) = pack8(t8); }
            { float t8[8];
#pragma unroll
              for (int j = 0; j < 8; ++j) { const float et = j < 4 ? et0[j & 3] : et1[j & 3]; t8[j] = rx[j] * et; ei8[j] = frcp(et); }
              *(LAS v4u*)(RT + tk * TP + c8) = pack8(t8); }
            { float t8[8];
#pragma unroll
              for (int j = 0; j < 8; ++j) t8[j] = pb[j] * ei8[j];
              *(LAS v4u*)(BT + tk * TP + c8) = pack8(t8); }
            { float t8[8];
#pragma unroll
              for (int j = 0; j < 8; ++j) t8[j] = km[j] * ei8[j];
              *(LAS v4u*)(KT + tk * TP + c8) = pack8(t8); }
#pragma unroll
            for (int j = 0; j < 8; j += 2) { const float eh0 = (j < 4 ? pc0[j & 3] : pc1[j & 3]) * ei8[j], eh1 = (j + 1 < 4 ? pc0[(j + 1) & 3] : pc1[(j + 1) & 3]) * ei8[j + 1];
                const unsigned wb = pk2(pb[j] * eh0, pb[j + 1] * eh1), wk = pk2(km[j] * eh0, km[j + 1] * eh1), wv = pk2(vx[j], vx[j + 1]); const int o = (q * 64 + c8 + j) * 16 + (tt ^ (4 * ((tid & 7) & 3)));
                BH[o] = (bf16)(wb & 0xffffu); BH[o + 16] = (bf16)(wb >> 16); KH[o] = (bf16)(wk & 0xffffu); KH[o + 16] = (bf16)(wk >> 16); Vt[o] = (bf16)(wv & 0xffffu); Vt[o + 16] = (bf16)(wv >> 16); }
        }
        __syncthreads();
        { const int q = w >> 1, rsel = w & 1;
          const LAS bf16* YR = rsel ? RT : AT;
          f32x4 cb = {0.f, 0.f, 0.f, 0.f}, ck = {0.f, 0.f, 0.f, 0.f};
#pragma unroll
          for (int k2 = 0; k2 < 2; ++k2) { const bf16x8 yf = *(const LAS bf16x8*)(YR + (16 * q + fr) * TP + 32 * k2 + 8 * fq);
              cb = MFMA16(*(const LAS bf16x8*)(BT + (16 * q + fr) * TP + 32 * k2 + 8 * fq), yf, cb);
              ck = MFMA16(*(const LAS bf16x8*)(KT + (16 * q + fr) * TP + 32 * k2 + 8 * fq), yf, ck); }
#pragma unroll
          for (int i2 = 0; i2 < 4; ++i2) { const int i = 4 * fq + i2; const bool keep = rsel ? (i <= fr) : (i < fr); if (!keep) { cb[i2] = 0.f; ck[i2] = 0.f; } }
          if (rsel == 0) { *(LAS f32x4*)(LabF + (q * 16 + fr) * 16 + 4 * fq) = cb; *(LAS bf16x4s*)(LakB + (q * 16 + fr) * 16 + 4 * fq) = pack4(ck); }
          else { *(LAS bf16x4s*)(MrbB + (q * 16 + fr) * 16 + 4 * fq) = pack4(cb); *(LAS bf16x4s*)(MrkB + (q * 16 + fr) * 16 + 4 * fq) = pack4(ck); } }
        __syncthreads();
        if (tid < 64) { const int q = tid >> 4, c = tid & 15; float T[16];
#pragma unroll
            for (int t = 0; t < 16; ++t) { float sacc = (t == c) ? 1.f : 0.f;
#pragma unroll
                for (int i = 0; i < t; ++i) sacc += LabF[(q * 16 + t) * 16 + i] * T[i];
                T[t] = sacc; TtB[(q * 16 + t) * 16 + c] = (bf16)f2bf(sacc); } }
        __syncthreads();
        }
        if (role == 1) {
            const __amdgpu_buffer_rsrc_t rs = __builtin_amdgcn_make_buffer_rsrc(ring, 0, XFER_SLOTS * XFER_SLOT_BYTES, 0x00020000);
            const unsigned sb0 = (unsigned)((hj % XFER_SLOTS) * XFER_SLOT_BYTES);
            for (int i = tid; i < XFER_PIECES; i += NTHR) { const v4u v = *(const LAS v4u*)(L0 + xfer_lds_off(i)); __builtin_amdgcn_raw_buffer_store_b128(v, rs, sb0 + 16u * (unsigned)i, 0, 16); }
            asm volatile("s_waitcnt vmcnt(0)" ::: "memory");
            __syncthreads();
            if (tid == 0) __hip_atomic_store(prodw, (unsigned)(hj + 1), RLX_AGENT);
            continue;
        }
        if (!mine) {
#pragma unroll
            for (int k = 0; k < 7; ++k) { const int i = tid + NTHR * k; if (i < XFER_PIECES) *(LAS v4u*)(L0 + xfer_lds_off(i)) = XR[k]; }
            __syncthreads();
            if (tid == 0) __hip_atomic_store(consw, (unsigned)(hj + 1), RLX_AGENT);
        }
        if (role == 0 && bi + 1 < NBT && (bi + 1) % 2 != 0) {
            const int hn = (bi + 1) >> 1;
            if (w == 0) { wait_ge(prodw, (unsigned)(hn + 1), ctlw + CW_TMO, 0xA00u, lane); __builtin_amdgcn_fence(__ATOMIC_ACQUIRE, "agent"); asm volatile("s_waitcnt vmcnt(0)" ::: "memory"); }
            __syncthreads();
            const unsigned char* src = ring + (size_t)(hn % XFER_SLOTS) * XFER_SLOT_BYTES;
#pragma unroll
            for (int k = 0; k < 7; ++k) { int i = tid + NTHR * k; i = i < XFER_PIECES ? i : XFER_PIECES - 1; XR[k] = *(const v4u*)(src + 16 * i); }
        }
#ifdef PROBE_S2
        f32x4 Ssv[4];
#pragma unroll
        for (int kt = 0; kt < 4; ++kt) Ssv[kt] = St[kt];
        for (int prb_ = 0; prb_ < 2; ++prb_) {
        if (prb_) {
#pragma unroll
            for (int kt = 0; kt < 4; ++kt) St[kt] = Ssv[kt]; }
#endif
        if (w < 4) {
#pragma unroll 1
            for (int q = 0; q < 4; ++q) {
                const bf16x4s z4s = {0, 0, 0, 0};
#define CAT2(p0, p1) __builtin_shufflevector(*(const LAS bf16x4s*)(p0), *(const LAS bf16x4s*)(p1), 0, 1, 2, 3, 4, 5, 6, 7)
#define PAD8(p0) __builtin_shufflevector(*(const LAS bf16x4s*)(p0), z4s, 0, 1, 2, 3, 4, 5, 6, 7)
                const bf16x4s vt4 = *(const LAS bf16x4s*)(Vt + (q * 64 + 16 * w + fr) * 16 + 4 * (fq ^ ((2 * w + (fr >> 3)) & 3)));
                const LAS bf16* atp = AT + (16 * q + fr) * TP + 4 * fq; const LAS bf16* rtp = RT + (16 * q + fr) * TP + 4 * fq;
                f32x4 x1 = {0.f, 0.f, 0.f, 0.f}, yv = {0.f, 0.f, 0.f, 0.f};
                { const bf16x8 s01 = __builtin_shufflevector(pack4(St[0]), pack4(St[1]), 0, 1, 2, 3, 4, 5, 6, 7), s23 = __builtin_shufflevector(pack4(St[2]), pack4(St[3]), 0, 1, 2, 3, 4, 5, 6, 7);
                  x1 = MFMA16(CAT2(atp, atp + 16), s01, x1); x1 = MFMA16(CAT2(atp + 32, atp + 48), s23, x1);
                  yv = MFMA16(CAT2(rtp, rtp + 16), s01, yv); yv = MFMA16(CAT2(rtp + 32, rtp + 48), s23, yv); }
                x1 = MFMA16(PAD8(LakB + (q * 16 + fr) * 16 + 4 * fq), __builtin_shufflevector(vt4, z4s, 0, 1, 2, 3, 4, 5, 6, 7), x1);
                const f32x4 u = MFMA16(PAD8(TtB + (q * 16 + fr) * 16 + 4 * fq), __builtin_shufflevector(pack4(x1), z4s, 0, 1, 2, 3, 4, 5, 6, 7), ((f32x4){0.f, 0.f, 0.f, 0.f}));
                const bf16x8 vu = __builtin_shufflevector(vt4, pack4(u), 0, 1, 2, 3, 4, 5, 6, 7);
                yv = MFMA16(CAT2(MrkB + (q * 16 + fr) * 16 + 4 * fq, MrbB + (q * 16 + fr) * 16 + 4 * fq), vu, yv);
#pragma unroll
                for (int i2 = 0; i2 < 4; ++i2) YB[(16 * q + 4 * fq + i2) * 64 + 16 * w + fr] = yv[i2];
#pragma unroll
                for (int kt = 0; kt < 4; ++kt)
                    St[kt] = MFMA16(CAT2(KH + (q * 64 + 16 * kt + fr) * 16 + 4 * (fq ^ ((2 * kt + (fr >> 3)) & 3)), BH + (q * 64 + 16 * kt + fr) * 16 + 4 * (fq ^ ((2 * kt + (fr >> 3)) & 3))), vu, St[kt] * *(const LAS f32x4*)(PCb + q * 64 + 16 * kt + 4 * fq));
#undef CAT2
#undef PAD8
            }
        }
#ifdef PROBE_S2
        __syncthreads(); }
#endif
        __syncthreads();
        if (need_out) {
            float y8[8];
#pragma unroll
            for (int j = 0; j < 8; ++j) y8[j] = YB[tk * 64 + c8 + j];
            *(v4u*)(YS + (size_t)row * 512 + gc) = pack8(y8);
        }
    }
    __syncthreads();
}

constexpr int PL_CST = 0, PL_TW = 2560, PL_AL = PL_TW + 9216, PL_LW = PL_AL + 9216, PL_LA = PL_LW + 16384, PL_SET = PL_LA + 16384, PL_SETB = 52224, PL_END = PL_SET + 2 * PL_SETB;
static_assert(PL_END <= MISC_OFF, "pipelined scan LDS map");
__device__ __forceinline__ void scan_unit_pipe(const Params& P, const Frame& F, int l, int b, int h, int dir) {
    LAS unsigned char* L0 = F.lds;
    LAS float* CST = (LAS float*)(L0 + PL_CST);
    LAS bf16* TWb = (LAS bf16*)(L0 + PL_TW);
    LAS bf16* ALb = (LAS bf16*)(L0 + PL_AL);
    LAS bf16* BT = TWb; LAS bf16* KT = ALb;
    LAS float* LW = (LAS float*)(L0 + PL_LW);
    LAS float* LA = (LAS float*)(L0 + PL_LA);
    LAS float* CUM = LW; LAS float* LabF = LA;
    const int tid = F.tid, lane = F.lane, w = F.wave, fr = lane & 15, fq = lane >> 4;
    const int tk = tid >> 3, c8 = (tid & 7) * 8, gc = 64 * h + c8;
    const int ld = l * 2 + dir;
    if (tid < 64) { const int c = 64 * h + tid;
        CST[0 * 64 + tid] = P.in[I_MU][(size_t)(ld * 3 + 0) * 512 + c]; CST[1 * 64 + tid] = P.in[I_MU][(size_t)(ld * 3 + 1) * 512 + c]; CST[2 * 64 + tid] = P.in[I_MU][(size_t)(ld * 3 + 2) * 512 + c];
        CST[3 * 64 + tid] = P.in[I_MUW][ld * 64 + tid]; CST[4 * 64 + tid] = P.in[I_MUA][ld * 64 + tid];
        CST[5 * 64 + tid] = P.in[I_W0][ld * 512 + c]; CST[6 * 64 + tid] = P.in[I_A0][ld * 512 + c];
        CST[7 * 64 + tid] = P.in[I_KK][l * 512 + c]; CST[8 * 64 + tid] = P.in[I_KA][l * 512 + c]; CST[9 * 64 + tid] = P.in[I_RK][l * 512 + c]; }
    const bf16* Z = WSP(bf16, WS_Z);
    bf16* YS = WSP(bf16, WS_YS) + (size_t)dir * MT * 512;
    float* BONG = WSP(float, WS_BONG) + (size_t)dir * MT * 8;
    f32x4 St[4];
#pragma unroll
    for (int kt = 0; kt < 4; ++kt) St[kt] = (f32x4){0.f, 0.f, 0.f, 0.f};
    constexpr int NBT = LC / TB + SEQ / TB;
    ScanPre R; scan_prefetch(Z, 0, tk, b, dir, gc, c8, R);
    __syncthreads();
#define PL_CHAIN(q) do { if (w < 4 && it >= 1) { \
        const bf16x4s z4s = {0, 0, 0, 0}; \
        const LAS bf16* cBH = (const LAS bf16*)(cset); const LAS bf16* cKH = cBH + 4096; const LAS bf16* cVt = cKH + 4096; const LAS bf16* cAT = (const LAS bf16*)(cset + 24576); const LAS bf16* cRT = (const LAS bf16*)(cset + 33792); \
        const LAS bf16* cLak = (const LAS bf16*)(cset + 43008); const LAS bf16* cTt = cLak + 1024; const LAS bf16* cMrb = cTt + 1024; const LAS bf16* cMrk = cMrb + 1024; const LAS float* cPC = (const LAS float*)(cset + 51200); \
        const bf16x4s vt4 = *(const LAS bf16x4s*)(cVt + ((q) * 64 + 16 * w + fr) * 16 + 4 * fq); \
        const LAS bf16* atp = cAT + (16 * (q) + fr) * TP + 4 * fq; const LAS bf16* rtp = cRT + (16 * (q) + fr) * TP + 4 * fq; \
        f32x4 x1 = {0.f, 0.f, 0.f, 0.f}, yv = {0.f, 0.f, 0.f, 0.f}; \
        { const bf16x8 s01 = __builtin_shufflevector(pack4(St[0]), pack4(St[1]), 0, 1, 2, 3, 4, 5, 6, 7), s23 = __builtin_shufflevector(pack4(St[2]), pack4(St[3]), 0, 1, 2, 3, 4, 5, 6, 7); \
          x1 = MFMA16(PL_CAT2(atp, atp + 16), s01, x1); x1 = MFMA16(PL_CAT2(atp + 32, atp + 48), s23, x1); \
          yv = MFMA16(PL_CAT2(rtp, rtp + 16), s01, yv); yv = MFMA16(PL_CAT2(rtp + 32, rtp + 48), s23, yv); } \
        x1 = MFMA16(PL_PAD8(cLak + ((q) * 16 + fr) * 16 + 4 * fq), __builtin_shufflevector(vt4, z4s, 0, 1, 2, 3, 4, 5, 6, 7), x1); \
        const f32x4 u = MFMA16(PL_PAD8(cTt + ((q) * 16 + fr) * 16 + 4 * fq), __builtin_shufflevector(pack4(x1), z4s, 0, 1, 2, 3, 4, 5, 6, 7), ((f32x4){0.f, 0.f, 0.f, 0.f})); \
        const bf16x8 vu = __builtin_shufflevector(vt4, pack4(u), 0, 1, 2, 3, 4, 5, 6, 7); \
        yv = MFMA16(PL_CAT2(cMrk + ((q) * 16 + fr) * 16 + 4 * fq, cMrb + ((q) * 16 + fr) * 16 + 4 * fq), vu, yv); \
        _Pragma("unroll") for (int kt = 0; kt < 4; ++kt) { \
            St[kt] = MFMA16(PL_CAT2(cKH + ((q) * 64 + 16 * kt + fr) * 16 + 4 * fq, cBH + ((q) * 64 + 16 * kt + fr) * 16 + 4 * fq), vu, St[kt] * *(const LAS f32x4*)(cPC + (q) * 64 + 16 * kt + 4 * fq)); \
            if (kt & 1) __builtin_amdgcn_sched_barrier(0); } \
        if (cout_) { _Pragma("unroll") for (int i2 = 0; i2 < 4; ++i2) { bool hp2; int pr2; const int row2 = scan_row(it - 1, 16 * (q) + 4 * fq + i2, b, dir, hp2, pr2); \
            YS[(size_t)row2 * 512 + 64 * h + 16 * w + fr] = (bf16)f2bf(yv[i2]); } } \
    } } while (0)
#define PL_CAT2(p0, p1) __builtin_shufflevector(*(const LAS bf16x4s*)(p0), *(const LAS bf16x4s*)(p1), 0, 1, 2, 3, 4, 5, 6, 7)
#define PL_PAD8(p0) __builtin_shufflevector(*(const LAS bf16x4s*)(p0), z4s, 0, 1, 2, 3, 4, 5, 6, 7)
    for (int it = 0; it <= NBT; ++it) {
        const bool prep = it < NBT;
        const LAS unsigned char* cset = L0 + PL_SET + ((it - 1) & 1) * PL_SETB;
        LAS unsigned char* pset = L0 + PL_SET + (it & 1) * PL_SETB;
        const bool need_out = (it >= LC / TB) || (l == 0), cout_ = (it - 1 >= LC / TB) || (l == 0);
        LAS bf16* BH = (LAS bf16*)pset; LAS bf16* KH = BH + 4096; LAS bf16* Vt = KH + 4096; LAS bf16* AT = (LAS bf16*)(pset + 24576); LAS bf16* RT = (LAS bf16*)(pset + 33792);
        LAS bf16* LakB = (LAS bf16*)(pset + 43008); LAS bf16* TtB = LakB + 1024; LAS bf16* MrbB = TtB + 1024; LAS bf16* MrkB = MrbB + 1024; LAS float* PCb = (LAS float*)(pset + 51200);
        bool hp = false; int prow = 0; const int row = prep ? scan_row(it, tk, b, dir, hp, prow) : 0; (void)prow;
        float kx[8], vx[8], rx[8], na[8], pb[8], km[8];
#ifdef PROBE_ST1
        for (int prb_ = 0; prb_ < 2; ++prb_)
#endif
        if (prep) { float wl[8], al[8];
            lerp8(R.kc, R.kp, hp, CST + 0 * 64 + c8, kx); lerp8(R.vc, R.vp, hp, CST + 1 * 64 + c8, vx); lerp8(R.rc, R.rp, hp, CST + 2 * 64 + c8, rx);
            lerp8(R.wc, R.wp, hp, CST + 3 * 64 + c8, wl); lerp8(R.ac, R.ap, hp, CST + 4 * 64 + c8, al);
#pragma unroll
            for (int j = 0; j < 8; ++j) wl[j] = ftanh(wl[j]);
            *(LAS v4u*)(TWb + tk * TP + c8) = pack8(wl); *(LAS v4u*)(ALb + tk * TP + c8) = pack8(al);
        }
        __syncthreads();
        if (w >= 4) { if (prep) { const int nt = w - 4;
            int ll = lane; asm volatile("" : "+v"(ll));
            const size_t lo = ((size_t)ld * 512 + 64 * h + 16 * nt + (ll & 15)) * 64 + 8 * (ll >> 4);
            const bf16* w2g = WSP(bf16, WS_W2TG) + lo; const bf16* a2g = WSP(bf16, WS_A2TG) + lo;
            bf16x8 w2x[2], a2x[2];
#pragma unroll
            for (int k2 = 0; k2 < 2; ++k2) { w2x[k2] = *(const bf16x8*)(w2g + 32 * k2); a2x[k2] = *(const bf16x8*)(a2g + 32 * k2); }
#pragma unroll
            for (int mt = 0; mt < 4; ++mt) { f32x4 cw = {0.f, 0.f, 0.f, 0.f}, ca = {0.f, 0.f, 0.f, 0.f};
#pragma unroll
                for (int k2 = 0; k2 < 2; ++k2) { cw = MFMA16(w2x[k2], *(const LAS bf16x8*)(TWb + (16 * mt + fr) * TP + 32 * k2 + 8 * fq), cw); ca = MFMA16(a2x[k2], *(const LAS bf16x8*)(ALb + (16 * mt + fr) * TP + 32 * k2 + 8 * fq), ca); }
                *(LAS f32x4*)(LW + (16 * mt + fr) * 64 + 16 * nt + 4 * fq) = cw; *(LAS f32x4*)(LA + (16 * mt + fr) * 64 + 16 * nt + 4 * fq) = ca; } } }
        else PL_CHAIN(0);
        __syncthreads();
#ifdef PROBE_ST3
        float lwsv[8], lasv[8];
        if (prep) {
#pragma unroll
            for (int j = 0; j < 8; ++j) { lwsv[j] = LW[tk * 64 + c8 + j]; lasv[j] = LA[tk * 64 + c8 + j]; } }
        for (int prb_ = 0; prb_ < 2; ++prb_) {
        if (prb_ && prep) {
#pragma unroll
            for (int j = 0; j < 8; ++j) { LW[tk * 64 + c8 + j] = lwsv[j]; LA[tk * 64 + c8 + j] = lasv[j]; } }
#endif
        if (prep) {
            float n2 = 0.f, bon = 0.f, ew[8];
#pragma unroll
            for (int hf = 0; hf < 2; ++hf) {
#pragma unroll
                for (int j = 4 * hf; j < 4 * hf + 4; ++j) {
                    const float aw = LW[tk * 64 + c8 + j], aa = LA[tk * 64 + c8 + j];
                    ew[j] = 0.6065306597f * frcp(1.0f + fexp(-(CST[5 * 64 + c8 + j] + aw)));
                    const float ag = frcp(1.0f + fexp(-(CST[6 * 64 + c8 + j] + aa)));
                    const float kk = kx[j] * CST[7 * 64 + c8 + j]; n2 += kk * kk;
                    km[j] = kx[j] * (1.0f + (ag - 1.0f) * CST[8 * 64 + c8 + j]);
                    bon += rx[j] * km[j] * CST[9 * 64 + c8 + j];
                    na[j] = kk; pb[j] = ag;
                }
                __builtin_amdgcn_sched_barrier(0);
            }
            n2 = sum8(n2); bon = sum8(bon);
            const float inv = frcp(fmaxf(__builtin_amdgcn_sqrtf(n2), 1e-12f));
#pragma unroll
            for (int j = 0; j < 8; ++j) { const float kkn = na[j] * inv; na[j] = -kkn; pb[j] = kkn * pb[j]; }
            *(LAS f32x4*)(CUM + tk * 64 + c8) = (f32x4){ew[0], ew[1], ew[2], ew[3]} * 1.44269504089f; *(LAS f32x4*)(CUM + tk * 64 + c8 + 4) = (f32x4){ew[4], ew[5], ew[6], ew[7]} * 1.44269504089f;
            if ((tid & 7) == 0 && need_out) BONG[(size_t)row * 8 + h] = bon;
#pragma unroll
            for (int j = 0; j < 8; j += 2) { const unsigned wv = pk2(vx[j], vx[j + 1]); const int o = ((tk >> 4) * 64 + c8 + j) * 16 + (tk & 15); Vt[o] = (bf16)(wv & 0xffffu); Vt[o + 16] = (bf16)(wv >> 16); }
        }
#ifdef PROBE_ST3
        }
#endif
        __syncthreads();
        if (w >= 4) { if (prep) { const int t2 = tid - 256, q = t2 >> 6, ch = t2 & 63; float c = 0.f;
#pragma unroll
            for (int i = 0; i < 16; ++i) { c -= CUM[(16 * q + i) * 64 + ch]; const float p = __builtin_amdgcn_exp2f(c); CUM[(16 * q + i) * 64 + ch] = p; if (i == 15) PCb[q * 64 + ch] = p; } } }
        else PL_CHAIN(1);
        __syncthreads();
#ifdef PROBE_ST5
        for (int prb_ = 0; prb_ < 2; ++prb_)
#endif
        if (prep) {
            const int q = tk >> 4, tt = tk & 15;
            const f32x4 one4 = {1.f, 1.f, 1.f, 1.f};
            const f32x4 et0 = *(const LAS f32x4*)(CUM + tk * 64 + c8), et1 = *(const LAS f32x4*)(CUM + tk * 64 + c8 + 4);
            const f32x4 ep0 = tt ? *(const LAS f32x4*)(CUM + (tk - 1) * 64 + c8) : one4, ep1 = tt ? *(const LAS f32x4*)(CUM + (tk - 1) * 64 + c8 + 4) : one4;
            const f32x4 pc0 = *(const LAS f32x4*)(PCb + q * 64 + c8), pc1 = *(const LAS f32x4*)(PCb + q * 64 + c8 + 4);
            float ei8[8];
            { float t8[8];
#pragma unroll
              for (int j = 0; j < 8; ++j) t8[j] = na[j] * (j < 4 ? ep0[j & 3] : ep1[j & 3]);
              *(LAS v4u*)(AT + tk * TP + c8) = pack8(t8); }
            __builtin_amdgcn_sched_barrier(0);
            { float t8[8];
#pragma unroll
              for (int j = 0; j < 8; ++j) { const float et = j < 4 ? et0[j & 3] : et1[j & 3]; t8[j] = rx[j] * et; ei8[j] = frcp(et); }
              *(LAS v4u*)(RT + tk * TP + c8) = pack8(t8); }
            __builtin_amdgcn_sched_barrier(0);
            { float t8[8];
#pragma unroll
              for (int j = 0; j < 8; ++j) t8[j] = pb[j] * ei8[j];
              *(LAS v4u*)(BT + tk * TP + c8) = pack8(t8); }
            __builtin_amdgcn_sched_barrier(0);
            { float t8[8];
#pragma unroll
              for (int j = 0; j < 8; ++j) t8[j] = km[j] * ei8[j];
              *(LAS v4u*)(KT + tk * TP + c8) = pack8(t8); }
            __builtin_amdgcn_sched_barrier(0);
#pragma unroll
            for (int j = 0; j < 8; j += 2) { const float eh0 = (j < 4 ? pc0[j & 3] : pc1[j & 3]) * ei8[j], eh1 = (j + 1 < 4 ? pc0[(j + 1) & 3] : pc1[(j + 1) & 3]) * ei8[j + 1];
                const unsigned wb = pk2(pb[j] * eh0, pb[j + 1] * eh1), wk = pk2(km[j] * eh0, km[j + 1] * eh1); const int o = (q * 64 + c8 + j) * 16 + tt;
                BH[o] = (bf16)(wb & 0xffffu); BH[o + 16] = (bf16)(wb >> 16); KH[o] = (bf16)(wk & 0xffffu); KH[o + 16] = (bf16)(wk >> 16); }
        }
        __syncthreads();
        if (it + 1 < NBT) scan_prefetch(Z, it + 1, tk, b, dir, gc, c8, R);
        if (w >= 4) { if (prep) { const int q = w - 4;
#pragma unroll
            for (int rsel = 0; rsel < 2; ++rsel) {
                const LAS bf16* YR = rsel ? RT : AT;
                f32x4 cb = {0.f, 0.f, 0.f, 0.f}, ck = {0.f, 0.f, 0.f, 0.f};
#pragma unroll
                for (int k2 = 0; k2 < 2; ++k2) { const bf16x8 yf = *(const LAS bf16x8*)(YR + (16 * q + fr) * TP + 32 * k2 + 8 * fq);
                    cb = MFMA16(*(const LAS bf16x8*)(BT + (16 * q + fr) * TP + 32 * k2 + 8 * fq), yf, cb);
                    ck = MFMA16(*(const LAS bf16x8*)(KT + (16 * q + fr) * TP + 32 * k2 + 8 * fq), yf, ck); }
#pragma unroll
                for (int i2 = 0; i2 < 4; ++i2) { const int i = 4 * fq + i2; const bool keep = rsel ? (i <= fr) : (i < fr); if (!keep) { cb[i2] = 0.f; ck[i2] = 0.f; } }
                if (rsel == 0) { *(LAS f32x4*)(LabF + (q * 16 + fr) * 16 + 4 * fq) = cb; *(LAS bf16x4s*)(LakB + (q * 16 + fr) * 16 + 4 * fq) = pack4(ck); }
                else { *(LAS bf16x4s*)(MrbB + (q * 16 + fr) * 16 + 4 * fq) = pack4(cb); *(LAS bf16x4s*)(MrkB + (q * 16 + fr) * 16 + 4 * fq) = pack4(ck); } } } }
        else PL_CHAIN(2);
        __syncthreads();
        if (w == 4) { if (prep) { const int q = lane >> 4, c = lane & 15; float T[16];
#pragma unroll
            for (int t = 0; t < 16; ++t) { float sacc = (t == c) ? 1.f : 0.f;
#pragma unroll
                for (int i = 0; i < t; ++i) sacc += LabF[(q * 16 + t) * 16 + i] * T[i];
                T[t] = sacc; TtB[(q * 16 + t) * 16 + c] = (bf16)f2bf(sacc); } } }
        else if (w < 4) PL_CHAIN(3);
        __syncthreads();
    }
#undef PL_CHAIN
#undef PL_CAT2
#undef PL_PAD8
}

__device__ __forceinline__ void conv_items(const Params& P, const Frame& F, int l, int nrows, int ob, int nob) {
    const bf16* Z = WSP(bf16, WS_Z); bf16* YM = WSP(bf16, WS_H);
    const float* cw = P.in[I_CONVW] + l * 768;
    for (int idx = ob * NTHR + F.tid; idx < nrows * 32; idx += nob * NTHR) {
        const int row = idx >> 5, ch = (idx & 31) * 8;
        bool hp, hn;
        if (row < NT) { const int col = row & 63; hp = col != 0; hn = col != 63; } else { const int t = (row - NT) & 255; hp = t != 0; hn = t != 255; }
        const bf16* zr = Z + (size_t)row * NZ;
        const v4u u1 = *(const v4u*)(zr + C_U + ch), g1 = *(const v4u*)(zr + C_GC + ch), gb = *(const v4u*)(zr + C_GB + ch);
        v4u u0 = {0u, 0u, 0u, 0u}, g0 = u0, u2 = u0, g2 = u0;
        if (hp) { u0 = *(const v4u*)(zr - NZ + C_U + ch); g0 = *(const v4u*)(zr - NZ + C_GC + ch); }
        if (hn) { u2 = *(const v4u*)(zr + NZ + C_U + ch); g2 = *(const v4u*)(zr + NZ + C_GC + ch); }
        v4u o;
#pragma unroll
        for (int q = 0; q < 4; ++q) {
            const float wa0 = cw[ch + 2 * q], wa1 = cw[256 + ch + 2 * q], wa2 = cw[512 + ch + 2 * q], wb0 = cw[ch + 2 * q + 1], wb1 = cw[256 + ch + 2 * q + 1], wb2 = cw[512 + ch + 2 * q + 1];
            const float lo = bflo(gb[q]) * (wa0 * bflo(g0[q]) * bflo(u0[q]) + wa1 * bflo(g1[q]) * bflo(u1[q]) + wa2 * bflo(g2[q]) * bflo(u2[q]));
            const float hi = bfhi(gb[q]) * (wb0 * bfhi(g0[q]) * bfhi(u0[q]) + wb1 * bfhi(g1[q]) * bfhi(u1[q]) + wb2 * bfhi(g2[q]) * bfhi(u2[q]));
            o[q] = pk2(lo, hi);
        }
        *(v4u*)(YM + (size_t)row * D + 512 + ch) = o;
    }
}

__device__ __forceinline__ void load_tab64(LAS bf16* dst, const bf16* src, int tid) {
    for (int i = tid; i < 512; i += NTHR) { const int r = i >> 3, c = (i & 7) * 8; *(LAS v4u*)(dst + r * TP + c) = *(const v4u*)(src + r * 64 + c); }
}
__device__ __forceinline__ bf16x8 ldsfrag(const LAS bf16* base, int row, int col) { return *(const LAS bf16x8*)(base + row * TP + col); }
__device__ __forceinline__ void fourier_a_iter(const Params& P, const Frame& F, int it) {
    const int bg = it >> 3, j = it & 7, b = bg >> 2, g = bg & 3, w = F.wave, lane = F.lane, fr = lane & 15, fq = lane >> 4, p2 = 8 * j + w;
    LAS bf16* TC64 = (LAS bf16*)F.lds; LAS bf16* TS64 = TC64 + 64 * TP; LAS bf16* TN64 = TS64 + 64 * TP;
    LAS bf16* PT = TN64 + 64 * TP + w * (64 * TP);
    load_tab64(TC64, WSP(bf16, TAB_C64), F.tid); load_tab64(TS64, WSP(bf16, TAB_S64), F.tid); load_tab64(TN64, WSP(bf16, TAB_SN64), F.tid);
    const bf16* Z = WSP(bf16, WS_Z);
    __syncthreads();
    f32x4 Yr[4][4], Yi[4][4];
#pragma unroll
    for (int a = 0; a < 4; ++a)
#pragma unroll
        for (int c = 0; c < 4; ++c) { Yr[a][c] = (f32x4){0.f, 0.f, 0.f, 0.f}; Yi[a][c] = (f32x4){0.f, 0.f, 0.f, 0.f}; }
#pragma unroll
    for (int pass = 0; pass < 2; ++pass) {
        const LAS bf16* T1 = pass == 0 ? TC64 : TS64;
        asm volatile("" ::: "memory");
#pragma unroll
        for (int xt = 0; xt < 4; ++xt) {
            bf16x8 Ff[2];
#pragma unroll
            for (int ks = 0; ks < 2; ++ks) Ff[ks] = *(const bf16x8*)(Z + (size_t)(b * SEQ + 64 * (16 * xt + fr) + p2) * NZ + C_F + 64 * g + 32 * ks + 8 * fq);
#pragma unroll
            for (int yt = 0; yt < 4; ++yt) {
                f32x4 acc = {0.f, 0.f, 0.f, 0.f};
#pragma unroll
                for (int ks = 0; ks < 2; ++ks) acc = MFMA16(Ff[ks], ldsfrag(T1, 16 * yt + fr, 32 * ks + 8 * fq), acc);
                v2u wv; wv.x = pk2(acc.x, acc.y); wv.y = pk2(acc.z, acc.w);
                *(LAS v2u*)(PT + (16 * yt + fr) * TP + 16 * xt + 4 * fq) = wv;
            }
            __builtin_amdgcn_sched_barrier(0);
        }
        LDS_WAIT(); asm volatile("" ::: "memory");
        const LAS bf16* TA = pass == 0 ? TC64 : TN64;
        const LAS bf16* TB = pass == 0 ? TS64 : TC64;
#pragma unroll
        for (int ks = 0; ks < 2; ++ks) {
            bf16x8 pf[4];
#pragma unroll
            for (int yt = 0; yt < 4; ++yt) pf[yt] = ldsfrag(PT, 16 * yt + fr, 32 * ks + 8 * fq);
#pragma unroll
            for (int xt = 0; xt < 4; ++xt) { const bf16x8 ta = ldsfrag(TA, 16 * xt + fr, 32 * ks + 8 * fq), tb = ldsfrag(TB, 16 * xt + fr, 32 * ks + 8 * fq);
#pragma unroll
                for (int yt = 0; yt < 4; ++yt) { Yr[xt][yt] = MFMA16(ta, pf[yt], Yr[xt][yt]); Yi[xt][yt] = MFMA16(tb, pf[yt], Yi[xt][yt]); }
                __builtin_amdgcn_sched_barrier(0); }
        }
        LDS_WAIT(); asm volatile("" ::: "memory");
    }
    __syncthreads();
    LAS bf16* EX = (LAS bf16*)F.lds;
    const float* twc = WSP(float, TAB_TWC); const float* tws = WSP(float, TAB_TWS);
#pragma unroll
    for (int xt = 0; xt < 4; ++xt)
#pragma unroll
        for (int i = 0; i < 4; ++i) { const int q1 = 16 * xt + 4 * fq + i, m = (p2 * q1) & 4095; const float tc = twc[m], ts = tws[m];
#pragma unroll
            for (int yt = 0; yt < 4; ++yt) { const float yr = Yr[xt][yt][i], yi = Yi[xt][yt][i]; const int cp = 16 * yt + fr;
                EX[((q1 * 2 + 0) * 64 + cp) * 8 + w] = (bf16)f2bf(yr * tc - yi * ts);
                EX[((q1 * 2 + 1) * 64 + cp) * 8 + w] = (bf16)f2bf(-yi * tc - yr * ts); }
            __builtin_amdgcn_sched_barrier(0); }
    __syncthreads();
    bf16* YB = WSP(bf16, WS_YBUF) + (size_t)bg * (64 * 2 * 64 * 64);
#pragma unroll 4
    for (int n = 0; n < 16; ++n) { const int q = F.tid + NTHR * n; *(v4u*)(YB + (size_t)q * 64 + 8 * j) = *(const LAS v4u*)(EX + q * 8); }
    __syncthreads();
}
__device__ __forceinline__ void fourier_b_unit(const Params& P, const Frame& F, int u, const LAS bf16* TC64, const LAS bf16* TS64) {
    const int bg = u >> 6, s2 = u & 63, b = bg >> 2, g = bg & 3, lane = F.lane, fr = lane & 15, fq = lane >> 4;
    const bf16* YB = WSP(bf16, WS_YBUF) + (size_t)bg * (64 * 2 * 64 * 64) + (size_t)s2 * (2 * 64 * 64);
    f32x4 acc[4][4];
#pragma unroll
    for (int a = 0; a < 4; ++a)
#pragma unroll
        for (int c = 0; c < 4; ++c) acc[a][c] = (f32x4){0.f, 0.f, 0.f, 0.f};
#pragma unroll
    for (int ks = 0; ks < 4; ++ks) { const int ri = ks >> 1, pb = (ks & 1) * 32;
        bf16x8 xf[4];
#pragma unroll
        for (int xt = 0; xt < 4; ++xt) xf[xt] = *(const bf16x8*)(YB + (size_t)(ri * 64 + 16 * xt + fr) * 64 + pb + 8 * fq);
        const LAS bf16* T = ri ? TS64 : TC64;
#pragma unroll
        for (int yt = 0; yt < 4; ++yt) { const bf16x8 tf = ldsfrag(T, 16 * yt + fr, pb + 8 * fq);
#pragma unroll
            for (int xt = 0; xt < 4; ++xt) acc[xt][yt] = MFMA16(xf[xt], tf, acc[xt][yt]); }
    }
    bf16* YM = WSP(bf16, WS_H);
#pragma unroll
    for (int yt = 0; yt < 4; ++yt) { const int s1 = 16 * yt + fr; bf16* rowp = YM + (size_t)(b * SEQ + 64 * s1 + s2) * D + 768 + 64 * g;
#pragma unroll
        for (int xt = 0; xt < 4; ++xt) { const f32x4 a = acc[xt][yt] * (1.0f / 512.0f); v2u wv; wv.x = pk2(a.x, a.y); wv.y = pk2(a.z, a.w); *(v2u*)(rowp + 16 * xt + 4 * fq) = wv; } }
}
constexpr int TP2 = 264;
__device__ __forceinline__ void fourier_ctx_unit(const Params& P, const Frame& F, int bg) {
    const int b = bg >> 2, g = bg & 3, w = F.wave, lane = F.lane, fr = lane & 15, fq = lane >> 4;
    LAS bf16* TC64 = (LAS bf16*)F.lds; LAS bf16* TS64 = TC64 + 64 * TP;
    LAS bf16* PT = TS64 + 64 * TP; LAS bf16* QT = PT + 64 * TP2;
    load_tab64(TC64, WSP(bf16, TAB_C64), F.tid); load_tab64(TS64, WSP(bf16, TAB_S64), F.tid);
    const bf16* Z = WSP(bf16, WS_Z);
    bf16x8 Ff[2][2];
#pragma unroll
    for (int xt = 0; xt < 2; ++xt)
#pragma unroll
        for (int ks = 0; ks < 2; ++ks) Ff[xt][ks] = *(const bf16x8*)(Z + (size_t)(NT + b * LC + 32 * w + 16 * xt + fr) * NZ + C_F + 64 * g + 32 * ks + 8 * fq);
    __syncthreads();
#pragma unroll
    for (int xt = 0; xt < 2; ++xt)
#pragma unroll
        for (int yt = 0; yt < 4; ++yt) {
            f32x4 ap = {0.f, 0.f, 0.f, 0.f}, aq = {0.f, 0.f, 0.f, 0.f};
#pragma unroll
            for (int ks = 0; ks < 2; ++ks) { ap = MFMA16(Ff[xt][ks], ldsfrag(TC64, 16 * yt + fr, 32 * ks + 8 * fq), ap); aq = MFMA16(Ff[xt][ks], ldsfrag(TS64, 16 * yt + fr, 32 * ks + 8 * fq), aq); }
            v2u wp, wq; wp.x = pk2(ap.x, ap.y); wp.y = pk2(ap.z, ap.w); wq.x = pk2(aq.x, aq.y); wq.y = pk2(aq.z, aq.w);
            *(LAS v2u*)(PT + (16 * yt + fr) * TP2 + 32 * w + 16 * xt + 4 * fq) = wp; *(LAS v2u*)(QT + (16 * yt + fr) * TP2 + 32 * w + 16 * xt + 4 * fq) = wq;
        }
    __syncthreads();
    const bf16* C256 = WSP(bf16, WS_C256); const bf16* SN256 = WSP(bf16, WS_SN256);
    f32x4 acc[4][2];
#pragma unroll
    for (int a = 0; a < 4; ++a)
#pragma unroll
        for (int c = 0; c < 2; ++c) acc[a][c] = (f32x4){0.f, 0.f, 0.f, 0.f};
#pragma unroll 2
    for (int ks = 0; ks < 8; ++ks) {
        bf16x8 cf[2], sf[2];
#pragma unroll
        for (int yt = 0; yt < 2; ++yt) { cf[yt] = *(const bf16x8*)(C256 + (size_t)(32 * w + 16 * yt + fr) * 256 + 32 * ks + 8 * fq); sf[yt] = *(const bf16x8*)(SN256 + (size_t)(32 * w + 16 * yt + fr) * 256 + 32 * ks + 8 * fq); }
#pragma unroll
        for (int xt = 0; xt < 4; ++xt) { const bf16x8 pf = *(const LAS bf16x8*)(PT + (16 * xt + fr) * TP2 + 32 * ks + 8 * fq), qf = *(const LAS bf16x8*)(QT + (16 * xt + fr) * TP2 + 32 * ks + 8 * fq);
#pragma unroll
            for (int yt = 0; yt < 2; ++yt) { acc[xt][yt] = MFMA16(pf, cf[yt], acc[xt][yt]); acc[xt][yt] = MFMA16(qf, sf[yt], acc[xt][yt]); } }
    }
    bf16* YM = WSP(bf16, WS_H);
#pragma unroll
    for (int yt = 0; yt < 2; ++yt) { bf16* rowp = YM + (size_t)(NT + b * LC + 32 * w + 16 * yt + fr) * D + 768 + 64 * g;
#pragma unroll
        for (int xt = 0; xt < 4; ++xt) { const f32x4 a = acc[xt][yt] * (1.0f / 128.0f); v2u wv; wv.x = pk2(a.x, a.y); wv.y = pk2(a.z, a.w); *(v2u*)(rowp + 16 * xt + 4 * fq) = wv; } }
    __syncthreads();
}

constexpr int GP = 136;
__device__ __forceinline__ void finalize_phase(const Params& P, const Frame& F, int l, int nrows) {
    LAS bf16* G2 = (LAS bf16*)F.lds;
    const bf16* g2t = WSP(bf16, WS_G2T) + (size_t)l * 512 * 128;
    for (int i = F.tid; i < 512 * 16; i += NTHR) { const int r = i >> 4, c = (i & 15) * 8; *(LAS v4u*)(G2 + r * GP + c) = *(const v4u*)(g2t + r * 128 + c); }
    __syncthreads();
    const int gw = F.bx * NWAVES + F.wave, NGW = F.G * NWAVES, lane = F.lane, fr = lane & 15, fq = lane >> 4;
    const bf16* Z = WSP(bf16, WS_Z); const bf16* YSb = WSP(bf16, WS_YS); const float* BONG = WSP(float, WS_BONG); bf16* YM = WSP(bf16, WS_H);
    const float* gnw = P.in[I_GNW] + l * 512; const float* gnb = P.in[I_GNB] + l * 512; const float* mu = P.in[I_MU];
    const int nu = (nrows / 16) * 2;
    for (int u = gw; u < nu; u += NGW) {
        const int row = (u >> 1) * 16 + fr, half = u & 1;
        bf16x8 sf[4];
#pragma unroll
        for (int ks = 0; ks < 4; ++ks) { const v4u zv = *(const v4u*)(Z + (size_t)row * NZ + C_GLO + 32 * ks + 8 * fq); v4u o;
#pragma unroll
            for (int q = 0; q < 4; ++q) o[q] = pk2(sigmoidf_(bflo(zv[q])), sigmoidf_(bfhi(zv[q])));
            sf[ks] = __builtin_bit_cast(bf16x8, o); }
        int t, len; if (row < NT) { t = row & (SEQ - 1); len = SEQ; } else { t = (row - NT) & (LC - 1); len = LC; }
#pragma unroll 1
        for (int hh = 0; hh < 4; ++hh) {
            const int head = 4 * half + hh;
            f32x4 acc[4];
#pragma unroll
            for (int j = 0; j < 4; ++j) acc[j] = (f32x4){0.f, 0.f, 0.f, 0.f};
#pragma unroll
            for (int ks = 0; ks < 4; ++ks)
#pragma unroll
                for (int j = 0; j < 4; ++j) acc[j] = MFMA16(*(const LAS bf16x8*)(G2 + (64 * head + 16 * j + fr) * GP + 32 * ks + 8 * fq), sf[ks], acc[j]);
            f32x4 osum[4];
#pragma unroll
            for (int j = 0; j < 4; ++j) osum[j] = (f32x4){0.f, 0.f, 0.f, 0.f};
#pragma unroll
            for (int dir = 0; dir < 2; ++dir) {
                const bool hp = dir ? (t + 1 < len) : (t > 0); const int prow = hp ? (dir ? row + 1 : row - 1) : row;
                const bf16* ys = YSb + ((size_t)dir * MT + row) * 512 + 64 * head + 4 * fq;
                f32x4 y[4]; float s = 0.f;
#pragma unroll
                for (int j = 0; j < 4; ++j) { y[j] = ld4bf(ys + 16 * j); s += (y[j].x + y[j].y) + (y[j].z + y[j].w); }
                s += __shfl_xor(s, 16); s += __shfl_xor(s, 32);
                const float mean = s * (1.0f / 64.0f); float q2 = 0.f;
#pragma unroll
                for (int j = 0; j < 4; ++j) { y[j] = y[j] - mean; q2 += (y[j].x * y[j].x + y[j].y * y[j].y) + (y[j].z * y[j].z + y[j].w * y[j].w); }
                q2 += __shfl_xor(q2, 16); q2 += __shfl_xor(q2, 32);
                const float rstd = rsqrtf(q2 * (1.0f / 64.0f) + GN_EPS);
                const float bon = BONG[((size_t)dir * MT + row) * 8 + head];
#pragma unroll
                for (int j = 0; j < 4; ++j) { const int ch = 64 * head + 16 * j + 4 * fq;
                    const f32x4 vc = ld4bf(Z + (size_t)row * NZ + C_V + ch), vp = hp ? ld4bf(Z + (size_t)prow * NZ + C_V + ch) : (f32x4){0.f, 0.f, 0.f, 0.f};
                    const f32x4 mv = *(const f32x4*)(mu + (size_t)((l * 2 + dir) * 3 + 1) * 512 + ch);
                    const f32x4 vx = vc + (vp - vc) * mv;
                    osum[j] += y[j] * rstd * *(const f32x4*)(gnw + ch) + *(const f32x4*)(gnb + ch) + bon * vx; }
            }
#pragma unroll
            for (int j = 0; j < 4; ++j) { const int n = 64 * head + 16 * j + 4 * fq; const f32x4 o = osum[j] * acc[j];
                v2u wv; wv.x = pk2(o.x, o.y); wv.y = pk2(o.z, o.w); *(v2u*)(YM + (size_t)row * D + n) = wv; }
        }
    }
    __syncthreads();
}

struct MoePlan { int pb[9]; };
__device__ __forceinline__ void moe_plan(const Params& P, MoePlan& M, int (&cnt)[NE]) {
    int acc = 0;
#pragma unroll
    for (int e = 0; e < NE; ++e) { cnt[e] = (int)__hip_atomic_load(WSP(unsigned, WS_CTL) + CW_CNT + 64 * e, __ATOMIC_RELAXED, __HIP_MEMORY_SCOPE_AGENT); M.pb[e] = acc; acc += (cnt[e] + 255) >> 8; }
    M.pb[8] = acc;
}
__device__ __forceinline__ void moe_assign_gather(const Params& P, const Frame& F) {
    MoePlan M; int cnt[NE]; moe_plan(P, M, cnt);
    const int gw = F.bx * NWAVES + F.wave, NGW = F.G * NWAVES, lane = F.lane;
    const bf16* H = WSP(bf16, WS_H); bf16* XG = WSP(bf16, WS_XG);
    unsigned* fill = WSP(unsigned, WS_CTL) + CW_FILL;
    for (int it = gw; it < NT / 64; it += NGW) {
        const int tok = it * 64 + lane;
        const int4 rt = *(const int4*)(P.ws + WS_ROUTE + (size_t)tok * 16);
        const int es[2] = {rt.x & 255, (rt.x >> 8) & 255};
        int pos[2];
#pragma unroll
        for (int s = 0; s < 2; ++s) {
            pos[s] = 0;
#pragma unroll
            for (int e = 0; e < NE; ++e) {
                const unsigned long long m = __ballot(es[s] == e);
                if (m) {
                    const int n = __popcll(m), first = __ffsll((long long)m) - 1;
                    unsigned base = 0;
                    if (lane == first) base = __hip_atomic_fetch_add(fill + 64 * e, (unsigned)n, __ATOMIC_RELAXED, __HIP_MEMORY_SCOPE_AGENT);
                    base = __shfl(base, first);
                    const int rank = __popcll(m & ((1ull << lane) - 1ull));
                    if (es[s] == e) pos[s] = M.pb[e] * 256 + (int)base + rank;
                }
            }
        }
        *(int2*)(P.ws + WS_TOKPOS + (size_t)tok * 8) = make_int2(pos[0], pos[1]);
        for (int i = 0; i < 64; ++i) {
            const int t = it * 64 + i, d0 = __shfl(pos[0], i), d1 = __shfl(pos[1], i);
            const v4u a = *(const v4u*)(H + (size_t)t * D + 8 * lane), b = *(const v4u*)(H + (size_t)t * D + 512 + 8 * lane);
            *(v4u*)(XG + (size_t)d0 * D + 8 * lane) = a; *(v4u*)(XG + (size_t)d0 * D + 512 + 8 * lane) = b;
            *(v4u*)(XG + (size_t)d1 * D + 8 * lane) = a; *(v4u*)(XG + (size_t)d1 * D + 512 + 8 * lane) = b;
        }
    }
#pragma unroll
    for (int e = 0; e < NE; ++e) {
        const int r0 = M.pb[e] * 256 + cnt[e], r1 = M.pb[e + 1] * 256;
        for (int r = r0 + gw; r < r1; r += NGW) { *(v4u*)(XG + (size_t)r * D + 8 * lane) = (v4u){0u, 0u, 0u, 0u}; *(v4u*)(XG + (size_t)r * D + 512 + 8 * lane) = (v4u){0u, 0u, 0u, 0u}; }
    }
}

__device__ __forceinline__ Frame make_frame(LAS unsigned char* lds, int wave0) {
    Frame F; int tid = wave0 * 64 + (int)__builtin_amdgcn_mbcnt_hi(~0u, __builtin_amdgcn_mbcnt_lo(~0u, 0u)), G = gridDim.x, bx = blockIdx.x;
    asm volatile("" : "+v"(tid)); asm volatile("" : "+s"(G)); asm volatile("" : "+s"(bx));
    F.lds = lds; F.tid = tid; F.lane = tid & 63; F.wave = __builtin_amdgcn_readfirstlane(tid >> 6); F.G = G; F.bx = bx; return F;
}
#define CAS __attribute__((address_space(4)))
#define WSQ(T, off) ((T*)(Q.ws + (off)))
#if defined(__HIP_DEVICE_COMPILE__)
__device__ __forceinline__ Params load_params() { const CAS void* p = (const CAS void*)__builtin_amdgcn_kernarg_segment_ptr(); asm volatile("" : "+s"(p)); return *(const CAS Params*)p; }
#else
__device__ __forceinline__ Params load_params() { return Params{}; }
#endif
#ifndef PG8_SP2
#define PG8_SP2 true
#endif
#ifndef PG8_ALIGN
#define PG8_ALIGN true
#endif
#ifndef REP_MASK
#define REP_MASK 0
#endif
#define NREP(k) (1 + (((REP_MASK) >> (k)) & 1))
#ifdef PHMASK
#define IN(k) (((PHMASK) >> (k)) & 1)
#else
#define IN(k) (lo <= (k) && (k) < hi)
#endif
#define GRID_BARRIER() do { XcdBarrier b_ = bar; asm volatile("" : "+s"(b_.bar)); xcd_barrier(b_); } while (0)
#define SEAM(k) do { if (IN(k) && IN((k) + 1)) GRID_BARRIER(); } while (0)

template <int l>
__device__ __forceinline__ void layer_phases(const XcdBarrier& bar, LAS unsigned char* const lds0, volatile LAS unsigned* MISC, const int lo, const int hi, const int wave0) {
        const int pb = 1 + 8 * l;
        for (int rep_ = 0; rep_ < NREP(pb + 1); ++rep_) { if (rep_) GRID_BARRIER();
        if (IN(pb + 1)) {
            const Params Q = load_params(); const Frame F = make_frame(lds0, wave0);
            pg8::Gemm g{WSQ(bf16, WS_H), WSQ(bf16, WS_WIN) + (size_t)l * NZ * D, MT, NZ, D}; pg8::StaticOrder S; S.init(MT, NZ, F.G, F.bx);
            pg8::EpiBf16<0> E{WSQ(bf16, WS_Z), NZ, nullptr, 0, 0, 1.f};
            pg8::gemm_phase<pg8::EpiBf16<0>, pg8::StaticOrder, PG8_ALIGN, PG8_SP2>(F.lds, g, S, E, F.wave);
        } }
        SEAM(pb + 1);
        for (int rep_ = 0; rep_ < NREP(pb + 2); ++rep_) { if (rep_) GRID_BARRIER();
        if (IN(pb + 2)) {
            const Params Q = load_params(); const Frame F = make_frame(lds0, wave0);
#ifdef FORCE_SOLO
            const bool paired = false;
#else
            const bool paired = F.G >= 256;
#endif
            const int nsb = F.G > 128 ? 128 : 0;
#ifndef NO_SCAN
#ifdef SCAN_PIPE
            (void)paired;
            if (F.bx < nsb || nsb == 0) { const int st = nsb ? nsb : F.G; for (int u = F.bx; u < 128; u += st) scan_unit_pipe(Q, F, l, u >> 4, (u >> 1) & 7, u & 1); }
#else
            if (paired) { if (F.bx < 128) scan_unit(Q, F, l, F.bx >> 4, (F.bx >> 1) & 7, F.bx & 1, 0); else if (F.bx < 256) { const int u = F.bx - 128; scan_unit(Q, F, l, u >> 4, (u >> 1) & 7, u & 1, 1); } }
            else if (F.bx < nsb || nsb == 0) { const int st = nsb ? nsb : F.G; for (int u = F.bx; u < 128; u += st) scan_unit(Q, F, l, u >> 4, (u >> 1) & 7, u & 1, 2); }
#endif
#endif
#ifdef PROBE_CF2
            for (int prb_ = 0; prb_ < 2; ++prb_)
#endif
            if (F.bx >= nsb) {
                const int ob = F.bx - nsb, nob = F.G - nsb;
#ifndef NO_CONV
                conv_items(Q, F, l, l == 0 ? MT : NT, ob, nob);
#endif
#ifndef NO_FA
#ifdef PROBE_FA2
                for (int prb_ = 0; prb_ < 2; ++prb_)
#endif
                for (int it = ob; it < 256; it += nob) fourier_a_iter(Q, F, it);
#endif
#ifndef NO_FC
                if (l == 0) for (int u = ob; u < 32; u += nob) fourier_ctx_unit(Q, F, u);
#endif
            }
        } }
        SEAM(pb + 2);
        for (int rep_ = 0; rep_ < NREP(pb + 3); ++rep_) { if (rep_) GRID_BARRIER();
        if (IN(pb + 3)) {
            const Params Q = load_params(); const Frame F = make_frame(lds0, wave0);
            LAS bf16* TC64 = (LAS bf16*)F.lds; LAS bf16* TS64 = TC64 + 64 * TP;
            load_tab64(TC64, WSQ(bf16, TAB_C64), F.tid); load_tab64(TS64, WSQ(bf16, TAB_S64), F.tid);
            __syncthreads();
#ifndef NO_FB
#ifdef PROBE_FB2
            for (int prb_ = 0; prb_ < 2; ++prb_)
#endif
            for (int u = F.bx * NWAVES + F.wave; u < 2048; u += F.G * NWAVES) fourier_b_unit(Q, F, u, TC64, TS64);
#endif
            __syncthreads();
#ifndef NO_FIN
            finalize_phase(Q, F, l, l == 0 ? MT : NT);
#endif
        } }
        SEAM(pb + 3);
        for (int rep_ = 0; rep_ < NREP(pb + 4); ++rep_) { if (rep_) GRID_BARRIER();
        if (IN(pb + 4)) {
            const Params Q = load_params(); const Frame F = make_frame(lds0, wave0);
            const int M = l == 0 ? MT : NT;
            pg8::Gemm g{WSQ(bf16, WS_H), WSQ(bf16, WS_WOUT) + (size_t)l * D * D, M, D, D}; pg8::StaticOrder S; S.init(M, D, F.G, F.bx);
            pg8::EpiBf16<0> E{WSQ(bf16, WS_O32), D, nullptr, 0, 0, 1.f};
            pg8::gemm_phase<pg8::EpiBf16<0>, pg8::StaticOrder, PG8_ALIGN, PG8_SP2>(F.lds, g, S, E, F.wave);
        } }
        SEAM(pb + 4);
        if (l == 0) {
            if (IN(pb + 5)) { const Params Q = load_params(); const Frame F = make_frame(lds0, wave0); phase_post<0, true, false, true>(Q, F, MT, 0, 2048, 1, Q.in[I_CTX], 0, 2, 4096, 3072); }
            SEAM(pb + 5);
            for (int rep_ = 0; rep_ < NREP(pb + 6); ++rep_) { if (rep_) GRID_BARRIER();
            if (IN(pb + 6)) {
            const Params Q = load_params(); const Frame F = make_frame(lds0, wave0);
                pg8::Gemm g{WSQ(bf16, WS_H), WSQ(bf16, WS_WGU), MT, 2 * DFF, D}; pg8::StaticOrder S; S.init(MT, 2 * DFF, F.G, F.bx);
                pg8::EpiSwiglu E{WSQ(bf16, WS_Z), DFF, 0, 1 << 20};
                pg8::gemm_phase<pg8::EpiSwiglu, pg8::StaticOrder, PG8_ALIGN, PG8_SP2>(F.lds, g, S, E, F.wave);
            } }
            SEAM(pb + 6);
            for (int rep_ = 0; rep_ < NREP(pb + 7); ++rep_) { if (rep_) GRID_BARRIER();
            if (IN(pb + 7)) {
            const Params Q = load_params(); const Frame F = make_frame(lds0, wave0);
                pg8::Gemm g{WSQ(bf16, WS_Z), WSQ(bf16, WS_WDN), MT, D, DFF}; pg8::StaticOrder S; S.init(MT, D, F.G, F.bx);
                pg8::EpiBf16<0> E{WSQ(bf16, WS_O32), D, nullptr, 0, 0, 1.f};
                pg8::gemm_phase<pg8::EpiBf16<0>, pg8::StaticOrder, PG8_ALIGN, PG8_SP2>(F.lds, g, S, E, F.wave);
            } }
            SEAM(pb + 7);
            if (IN(pb + 8)) { const Params Q = load_params(); const Frame F = make_frame(lds0, wave0); phase_post<0, true, false>(Q, F, MT, 0, 5120, 3, (const float*)(Q.ws + WS_XC), 1, 0, 1024, 0); }
            SEAM(pb + 8);
        } else {
            if (IN(pb + 5)) { const Params Q = load_params(); const Frame F = make_frame(lds0, wave0); phase_post<0, true, true>(Q, F, NT, 1, 2048, 1, nullptr, 1, 2, 4096, 3072); }
            SEAM(pb + 5);
            if (IN(pb + 6)) { const Params Q = load_params(); const Frame F = make_frame(lds0, wave0); for (int rep_ = 0; rep_ < NREP(15); ++rep_) convert_moe_weights(Q, F); moe_assign_gather(Q, F); }
            SEAM(pb + 6);
            if (IN(pb + 7)) {
            const Params Q = load_params(); const Frame F = make_frame(lds0, wave0);
                if (F.tid == 0) { MoePlan M; int cnt[NE]; moe_plan(Q, M, cnt);
#pragma unroll
                    for (int j = 0; j < 9; ++j) MISC[16 + j] = (unsigned)M.pb[j]; }
                __syncthreads();
                const int ptot = (int)MISC[16 + 8], gq = (F.G >= 256 && Q.act_cap_panels >= 128) ? 128 : (Q.act_cap_panels < 64 ? Q.act_cap_panels : 64);
                int p0 = 0;
                while (p0 < ptot) {
                    int np = ptot - p0; if (np > Q.act_cap_panels) np = gq;
                    if (np > 0) {
                        for (int rep_ = 0; rep_ < NREP(16); ++rep_) { if (rep_) GRID_BARRIER();
                            pg8::Gemm g{WSQ(bf16, WS_XG), WSQ(bf16, WS_WMGU), 0, 0, D};
                            pg8::MoeOrder S; S.p0 = p0; S.np = np; S.nct = 2 * DFE / 256; S.G = F.G; S.c = F.bx;
#pragma unroll
                            for (int j = 0; j < 9; ++j) S.pb[j] = (int)MISC[16 + j];
                            pg8::EpiSwiglu E{WSQ(bf16, WS_ACTM), DFE, p0, 2 * DFE / 256};
                            pg8::gemm_phase<pg8::EpiSwiglu, pg8::MoeOrder, PG8_ALIGN, PG8_SP2>(F.lds, g, S, E, F.wave);
                        }
                        GRID_BARRIER();
                        for (int rep_ = 0; rep_ < NREP(17); ++rep_) { if (rep_) GRID_BARRIER();
                            pg8::Gemm g{WSQ(bf16, WS_ACTM) - (size_t)p0 * 256 * DFE, WSQ(bf16, WS_WMDN), 0, 0, DFE};
                            pg8::MoeOrder S; S.p0 = p0; S.np = np; S.nct = D / 256; S.G = F.G; S.c = F.bx;
#pragma unroll
                            for (int j = 0; j < 9; ++j) S.pb[j] = (int)MISC[16 + j];
                            pg8::EpiBf16Mod E{WSQ(bf16, WS_XG), D, D / 256};
                            pg8::gemm_phase<pg8::EpiBf16Mod, pg8::MoeOrder, PG8_ALIGN, PG8_SP2>(F.lds, g, S, E, F.wave);
                        }
                        GRID_BARRIER();
                    }
                    p0 += np;
                }
            }
            if (IN(pb + 8)) { const Params Q = load_params(); const Frame F = make_frame(lds0, wave0); phase_post<1, false, false>(Q, F, NT, 1, 5120, 3, nullptr, 1, 0, 0, 0); }
        }
    }
constexpr int N_PHASES = 18;
__global__ void __launch_bounds__(NTHR, 2) fwd_kernel(Params P) {
    extern __shared__ __attribute__((aligned(16))) unsigned char lds_raw[];
    LAS unsigned char* const lds0 = (LAS unsigned char*)lds_raw;
    volatile LAS unsigned* MISC = (volatile LAS unsigned*)(lds0 + MISC_OFF);
    const int wave0 = __builtin_amdgcn_readfirstlane((int)threadIdx.x >> 6);
    if (wave0 == 0) MISC[__builtin_amdgcn_mbcnt_hi(~0u, __builtin_amdgcn_mbcnt_lo(~0u, 0u))] = 0u;
    __syncthreads();
    unsigned* ctl = (unsigned*)(P.ws + WS_CTL);
    XcdBarrier bar = xcd_barrier_post(ctl + CW_BAR + P.li * XCD_BAR_WORDS, MISC + 8, wave0 == 0 ? 1u : 0u);
    const int lo = P.ph_lo, hi = P.ph_hi;
    for (int rep_ = 0; rep_ < NREP(0); ++rep_) { if (rep_) GRID_BARRIER(); if (IN(0)) { const Params Q = load_params(); const Frame F = make_frame(lds0, wave0); p0_adaln(Q, F); p0_small_weights(Q, F); p0_tables(Q, F); } }
    SEAM(0);
#ifdef PROBE_FN_NOSTORE
    for (int rep_ = 0; rep_ < 2; ++rep_) { if (rep_) GRID_BARRIER(); if (IN(1)) { const Params Q = load_params(); const Frame F = make_frame(lds0, wave0); phase_first_norm(Q, F); } }
#else
    for (int rep_ = 0; rep_ < NREP(1); ++rep_) { if (rep_) GRID_BARRIER(); if (IN(1)) { const Params Q = load_params(); const Frame F = make_frame(lds0, wave0); phase_first_norm(Q, F); } }
#endif
    SEAM(1);
#ifdef PROBE_BAR
    for (int prb_ = 0; prb_ < 20; ++prb_) GRID_BARRIER();
#endif
    layer_phases<0>(bar, lds0, MISC, lo, hi, wave0);
    layer_phases<1>(bar, lds0, MISC, lo, hi, wave0);
#undef IN
#undef SEAM
}

#ifndef MK_PER_PHASE
#define MK_PER_PHASE 0
#endif
extern "C" void kernel_launch(void* const* d_in, const int* in_sizes, int n_in, void* d_out, int out_size, void* d_ws, size_t ws_size, hipStream_t stream) {
    static int grid = 0;
    if (grid == 0) {
        if (n_in != N_IN || in_sizes[0] != NT * D || out_size != NT * D || ws_size < WS_NEED) {
            fprintf(stderr, "kernel_launch: unexpected shapes (n_in %d, in0 %d, out %d, ws %zu); nothing launched\n", n_in, n_in > 0 ? in_sizes[0] : -1, out_size, ws_size); grid = -1; return; }
        int dev = 0, cus = 0, per_cu = 0;
        if (hipGetDevice(&dev) != hipSuccess || hipDeviceGetAttribute(&cus, hipDeviceAttributeMultiprocessorCount, dev) != hipSuccess) { grid = -1; return; }
        if (hipFuncSetAttribute((const void*)fwd_kernel, hipFuncAttributeMaxDynamicSharedMemorySize, LDS_BYTES) != hipSuccess) { fprintf(stderr, "kernel_launch: hipFuncSetAttribute failed\n"); grid = -1; return; }
        if (hipOccupancyMaxActiveBlocksPerMultiprocessor(&per_cu, (const void*)fwd_kernel, NTHR, LDS_BYTES) != hipSuccess || per_cu < 1)
            fprintf(stderr, "kernel_launch: occupancy query reports %d workgroups per CU\n", per_cu);
        (void)hipGetLastError();
        grid = cus;
    }
    if (grid < 0) return;
    if (hipMemsetAsync((char*)d_ws + WS_CTL, 0, CTL_ZERO_BYTES, stream) != hipSuccess) return;
    Params p{};
    for (int i = 0; i < N_IN; ++i) p.in[i] = (const float*)d_in[i];
    p.out = (float*)d_out; p.ws = (unsigned char*)d_ws;
    { size_t avail = ws_size - WS_ACTM; size_t cap = avail / ((size_t)256 * DFE * 2); if (cap > 264) cap = 264; p.act_cap_panels = (int)cap; }
#if MK_PER_PHASE
    int li = 0;
    for (int ph = 0; ph < N_PHASES; ++ph) {
        p.ph_lo = ph; p.ph_hi = ph + 1; p.li = li++;
        hipLaunchKernelGGL(fwd_kernel, dim3(grid), dim3(NTHR), LDS_BYTES, stream, p);
    }
#else
    p.ph_lo = 0; p.ph_hi = N_PHASES; p.li = 0;
    hipLaunchKernelGGL(fwd_kernel, dim3(grid), dim3(NTHR), LDS_BYTES, stream, p);
#endif
}
```

```cpp
#include <hip/hip_runtime.h>
#include <cstdio>
#include <cstdint>
namespace pg8 {
#define PG8_LAS __attribute__((address_space(3)))
typedef unsigned short bf16_t;
typedef short bf16x8 __attribute__((ext_vector_type(8)));
typedef float f32x4 __attribute__((ext_vector_type(4)));
typedef unsigned u32x4 __attribute__((ext_vector_type(4)));
constexpr int BM = 256, BK = 64, HALF = 128, HTB = HALF * BK * 2  , STAGE_BYTES = 8 * HTB, NXCD = 8, WGM = 8;

__host__ __device__ __forceinline__ int lds_byte(int r, int c) { const int st = (r >> 4) * 2 + (c >> 5), rr = r & 15, cc = c & 31, ob = rr * 64 + cc * 2; return st * 1024 + (ob ^ (((ob >> 9) & 1) << 5)); }
__host__ __device__ __forceinline__ void stage_rc(int b, int& R, int& C) { const int st = b / 1024, sb = b % 1024, swz = sb ^ (((sb >> 9) & 1) << 5); R = (st >> 1) * 16 + swz / 64; C = (st & 1) * 32 + (swz % 64) / 2; }
__host__ __device__ __forceinline__ int perm32(int rho) { const int n = rho >> 4, i = rho & 15; return 8 * (i >> 2) + 4 * n + (i & 3); }

struct Unit { int pm, pn; };
struct Gemm { const bf16_t* A; const bf16_t* Bt; int M, N, K; };

struct StaticOrder {
    int nM, nN, nwg, G, c;
    __host__ __device__ void init(int M, int N, int G_, int c_) { nM = M / BM; nN = N / BM; nwg = nM * nN; G = G_; c = c_; }
    __host__ __device__ bool next(int i, Unit& u) const {
        const long L = (long)i * G + c; if (L >= nwg) return false;
        int wgid = (int)L; { const int q = nwg / NXCD, r = nwg % NXCD, xcd = wgid % NXCD, off = wgid / NXCD; wgid = (xcd < r ? xcd * (q + 1) : r * (q + 1) + (xcd - r) * q) + off; }
        const int nig = WGM * nN, gid = wgid / nig, fm = gid * WGM, gsz = (nM - fm) < WGM ? (nM - fm) : WGM;
        u.pm = fm + ((wgid % nig) % gsz); u.pn = (wgid % nig) / gsz; return true;
    }
    __device__ __forceinline__ void a_ready(const Unit&) const {}
    __device__ __forceinline__ void done(const Unit&) const {}
};

__device__ __forceinline__ unsigned cvt_pk_bf16(float lo, float hi) { unsigned r; asm volatile("v_cvt_pk_bf16_f32 %0, %1, %2" : "=v"(r) : "v"(lo), "v"(hi)); return r; }
typedef float f32x2 __attribute__((ext_vector_type(2)));
__device__ __forceinline__ f32x2 gelu_pk(f32x2 v) {
    const f32x2 av = __builtin_elementwise_abs(v), d = av * 0.2316418882f + 1.0f;
    f32x2 t; t.x = __builtin_amdgcn_rcpf(d.x); t.y = __builtin_amdgcn_rcpf(d.y);
    f32x2 q = t * 0.5307027145f + (-0.7265760135f); q = q * t + 0.7107068705f; q = q * t + (-0.142248368f); q = q * t + 0.127414796f; q = q * t;
    const f32x2 s = (v * v) * (-0.72134752044f);
    f32x2 e; e.x = __builtin_amdgcn_exp2f(s.x); e.y = __builtin_amdgcn_exp2f(s.y);
    const f32x2 m = v * (q * e), r = v - m;
    f32x2 o; o.x = v.x < 0.f ? m.x : r.x; o.y = v.y < 0.f ? m.y : r.y; return o;
}

template <int ACT  > struct EpiBf16 {
    static constexpr bool PERM = true, AFTER_DRAIN = false; static_assert(ACT == 0 || ACT == 1, "EpiBf16: ACT is 0 (none) or 1 (gelu_pk)");
    bf16_t* O; int ldc; const float* bias; int split_cols; size_t split_stride; float scale0;
    __device__ __forceinline__ void operator()(const f32x4 (&acc)[2][2][4][2], const Unit& u, int wr, int wc, int fr, int fq) const {
        const int row0 = u.pm * BM + wr * 64 + fr; int colt = u.pn * BM; bf16_t* base = O;
        float sc = 1.f; if (split_cols) { const int t = colt / split_cols; base += (size_t)t * split_stride; colt -= t * split_cols; if (t == 0) sc = scale0; }
        const int col0 = colt + wc * 32 + 8 * fq, bcol0 = u.pn * BM + wc * 32 + 8 * fq;
        f32x4 bv[2][2];
#pragma unroll
        for (int bj = 0; bj < 2; ++bj)
#pragma unroll
            for (int n = 0; n < 2; ++n) bv[bj][n] = bias ? *(const f32x4*)(bias + bcol0 + bj * HALF + 4 * n) : (f32x4){0.f, 0.f, 0.f, 0.f};
#pragma unroll
        for (int ai = 0; ai < 2; ++ai)
#pragma unroll
            for (int m = 0; m < 4; ++m) { bf16_t* rowp = base + (size_t)(row0 + ai * HALF + m * 16) * ldc + col0;
#pragma unroll
                for (int bj = 0; bj < 2; ++bj) { f32x4 v0 = acc[ai][bj][m][0] + bv[bj][0], v1 = acc[ai][bj][m][1] + bv[bj][1];
                    if (ACT == 1) { f32x2 a = gelu_pk((f32x2){v0[0], v0[1]}), b = gelu_pk((f32x2){v0[2], v0[3]}), c = gelu_pk((f32x2){v1[0], v1[1]}), d = gelu_pk((f32x2){v1[2], v1[3]});
                        v0 = (f32x4){a.x, a.y, b.x, b.y}; v1 = (f32x4){c.x, c.y, d.x, d.y}; }
                    v0 = v0 * sc; v1 = v1 * sc; u32x4 w; w.x = cvt_pk_bf16(v0[0], v0[1]); w.y = cvt_pk_bf16(v0[2], v0[3]); w.z = cvt_pk_bf16(v1[0], v1[1]); w.w = cvt_pk_bf16(v1[2], v1[3]);
                    *(u32x4*)(rowp + bj * HALF) = w; } }
    }
};

struct EpiF32 {
    static constexpr bool PERM = false, AFTER_DRAIN = false;
    float* C; int ldc; const float* bias;
    __device__ __forceinline__ void operator()(const f32x4 (&acc)[2][2][4][2], const Unit& u, int wr, int wc, int fr, int fq) const {
        const int row0 = u.pm * BM + wr * 64 + fr, col0 = u.pn * BM + wc * 32 + 4 * fq;
        f32x4 bv[2][2];
#pragma unroll
        for (int bj = 0; bj < 2; ++bj)
#pragma unroll
            for (int n = 0; n < 2; ++n) bv[bj][n] = bias ? *(const f32x4*)(bias + col0 + bj * HALF + n * 16) : (f32x4){0.f, 0.f, 0.f, 0.f};
#pragma unroll
        for (int ai = 0; ai < 2; ++ai)
#pragma unroll
            for (int m = 0; m < 4; ++m) { float* rowp = C + (size_t)(row0 + ai * HALF + m * 16) * ldc + col0;
#pragma unroll
                for (int bj = 0; bj < 2; ++bj)
#pragma unroll
                    for (int n = 0; n < 2; ++n) *(f32x4*)(rowp + bj * HALF + n * 16) = acc[ai][bj][m][n] + bv[bj][n]; }
    }
};
template <class Epi, class Sched, bool ALIGN_EPI = false, bool SP2 = false>
__device__ __forceinline__ void gemm_phase(PG8_LAS unsigned char* lds, const Gemm g, const Sched& S, const Epi& E, const int wave_in) {
    int tid_ = wave_in * 64 + (int)__builtin_amdgcn_mbcnt_hi(~0u, __builtin_amdgcn_mbcnt_lo(~0u, 0u)); asm volatile("" : "+v"(tid_));
    const int tid = tid_, wid = __builtin_amdgcn_readfirstlane(tid >> 6), lane = tid & 63, wr = wid >> 2, wc = wid & 3, fr = lane & 15, fq = lane >> 4;
    const int K = g.K, nt = K / BK;
    unsigned voffA[2], voffB[2];
#pragma unroll
    for (int i = 0; i < 2; ++i) { int R, C; stage_rc(tid * 16 + i * 8192, R, C); const int Rb = Epi::PERM ? ((R & ~31) + perm32(R & 31)) : R;
        voffA[i] = (unsigned)(R * K + C) * 2u; voffB[i] = (unsigned)(Rb * K + C) * 2u; }
    const size_t kstep = (size_t)(BK * 2);
    const size_t hstep = (size_t)HALF * K * 2;
    const size_t tstep = 2 * hstep;
    const unsigned ldsw = (unsigned)wid * 1024u;
    const int aoff = lds_byte(wr * 64 + fr, fq * 8), boff = lds_byte(wc * 32 + fr, fq * 8);
#define PG8_SA(b, h) (((b) * 2 + (h)) * HTB)
#define PG8_SB(b, h) ((4 + (b) * 2 + (h)) * HTB)
#define PG8_STAGE(bufoff, gbase, voff) do { _Pragma("unroll") for (int _i = 0; _i < 2; ++_i) \
        __builtin_amdgcn_global_load_lds((const unsigned*)((const char*)(gbase) + (voff)[_i]), (PG8_LAS unsigned*)(lds + (bufoff) + ldsw + _i * 8192), 16, 0, 0); } while (0)
#define PG8_LDA(dst, b, h) do { _Pragma("unroll") for (int m = 0; m < 4; ++m) _Pragma("unroll") for (int k = 0; k < 2; ++k) dst[m][k] = *(const PG8_LAS bf16x8*)(lds + PG8_SA(b, h) + aoff + m * 2048 + k * 1024); } while (0)
#define PG8_LDB(dst, b, h) do { _Pragma("unroll") for (int n = 0; n < 2; ++n) _Pragma("unroll") for (int k = 0; k < 2; ++k) dst[n][k] = *(const PG8_LAS bf16x8*)(lds + PG8_SB(b, h) + boff + n * 2048 + k * 1024); } while (0)
#define PG8_MMA(ai, bj, At, Bt) do { __builtin_amdgcn_s_setprio(1); _Pragma("unroll") for (int m = 0; m < 4; ++m) _Pragma("unroll") for (int n = 0; n < 2; ++n) _Pragma("unroll") for (int k = 0; k < 2; ++k) \
        acc[ai][bj][m][n] = __builtin_amdgcn_mfma_f32_16x16x32_bf16(Bt[n][k], At[m][k], acc[ai][bj][m][n], 0, 0, 0); __builtin_amdgcn_s_setprio(0); } while (0)
#define PG8_WAIT_V(n) asm volatile("s_waitcnt vmcnt(" #n ")" ::: "memory")
#define PG8_WAIT_L(n) asm volatile("s_waitcnt lgkmcnt(" #n ")" ::: "memory")
#define PG8_BAR __builtin_amdgcn_s_barrier()
#define PG8_SCHED __builtin_amdgcn_sched_barrier(0)
    Unit cur, nxt; int ui = 0;
    if (!S.next(0, cur)) return;
    f32x4 acc[2][2][4][2];
#pragma unroll
    for (int a = 0; a < 2; ++a)
#pragma unroll
        for (int b = 0; b < 2; ++b)
#pragma unroll
            for (int m = 0; m < 4; ++m)
#pragma unroll
                for (int n = 0; n < 2; ++n) acc[a][b][m][n] = (f32x4){0.f, 0.f, 0.f, 0.f};
    bf16x8 At[4][2], B0[2][2], B1[2][2];
    const char* cA = (const char*)g.A + (size_t)cur.pm * tstep; const char* cB = (const char*)g.Bt + (size_t)cur.pn * tstep;
    S.a_ready(cur);
    if constexpr (SP2) {
        PG8_STAGE(PG8_SB(0, 0), cB, voffB); PG8_STAGE(PG8_SB(0, 1), cB + hstep, voffB); PG8_STAGE(PG8_SA(0, 0), cA, voffA); PG8_STAGE(PG8_SA(0, 1), cA + hstep, voffA);
        if (wr == 1) PG8_BAR;
        PG8_WAIT_V(2); PG8_BAR;
        PG8_STAGE(PG8_SB(1, 0), cB + kstep, voffB); PG8_STAGE(PG8_SA(1, 0), cA + kstep, voffA); PG8_STAGE(PG8_SB(1, 1), cB + hstep + kstep, voffB);
        PG8_WAIT_V(6); PG8_BAR;
    } else {
        PG8_STAGE(PG8_SB(0, 0), cB, voffB); PG8_STAGE(PG8_SA(0, 0), cA, voffA); PG8_STAGE(PG8_SB(0, 1), cB + hstep, voffB); PG8_STAGE(PG8_SA(0, 1), cA + hstep, voffA);
        if (wr == 1) PG8_BAR;
        PG8_WAIT_V(4); PG8_BAR;
        PG8_STAGE(PG8_SB(1, 0), cB + kstep, voffB); PG8_STAGE(PG8_SA(1, 0), cA + kstep, voffA); PG8_STAGE(PG8_SB(1, 1), cB + hstep + kstep, voffB);
        PG8_WAIT_V(6); PG8_BAR;
    }
    for (;;) {
        const bool has_next = S.next(ui + 1, nxt);
        const char* nA = has_next ? (const char*)g.A + (size_t)nxt.pm * tstep : cA; const char* nB = has_next ? (const char*)g.Bt + (size_t)nxt.pn * tstep : cB;
        for (int t = 0; t < nt; t += 2) {
            const bool last = (t == nt - 2);
            const char* a1 = cA + (size_t)(t + 1) * kstep;
            const char* a2 = last ? nA : cA + (size_t)(t + 2) * kstep; const char* b2 = last ? nB : cB + (size_t)(t + 2) * kstep;
            const char* a3 = a2 + kstep; const char* b3 = b2 + kstep;
            if (last && has_next) S.a_ready(nxt);
            if constexpr (SP2) {
            PG8_LDB(B0, 0, 0); PG8_LDB(B1, 0, 1); PG8_SCHED; PG8_LDA(At, 0, 0); PG8_STAGE(PG8_SA(1, 1), a1 + hstep, voffA);
            PG8_WAIT_V(8); PG8_WAIT_L(0); PG8_BAR; PG8_MMA(0, 0, At, B0); PG8_MMA(0, 1, At, B1); PG8_BAR; PG8_SCHED;
            PG8_LDA(At, 0, 1); PG8_STAGE(PG8_SB(0, 0), b2, voffB); PG8_STAGE(PG8_SB(0, 1), b2 + hstep, voffB); PG8_STAGE(PG8_SA(0, 0), a2, voffA);
            PG8_WAIT_V(8); PG8_WAIT_L(0); PG8_BAR; PG8_MMA(1, 0, At, B0); PG8_MMA(1, 1, At, B1); PG8_BAR; PG8_SCHED;
            PG8_LDB(B0, 1, 0); PG8_LDB(B1, 1, 1); PG8_SCHED; PG8_LDA(At, 1, 0); PG8_STAGE(PG8_SA(0, 1), a2 + hstep, voffA);
            PG8_WAIT_V(8); PG8_WAIT_L(0); PG8_BAR; PG8_MMA(0, 0, At, B0); PG8_MMA(0, 1, At, B1); PG8_BAR; PG8_SCHED;
            PG8_LDA(At, 1, 1); PG8_STAGE(PG8_SB(1, 0), b3, voffB); PG8_STAGE(PG8_SB(1, 1), b3 + hstep, voffB); PG8_STAGE(PG8_SA(1, 0), a3, voffA);
            PG8_WAIT_V(8); PG8_WAIT_L(0); PG8_BAR; PG8_MMA(1, 0, At, B0); PG8_MMA(1, 1, At, B1); PG8_BAR; PG8_SCHED;
            } else {
            PG8_LDB(B0, 0, 0); PG8_SCHED; PG8_LDA(At, 0, 0); PG8_STAGE(PG8_SA(1, 1), a1 + hstep, voffA);
            PG8_WAIT_L(8); PG8_BAR; PG8_WAIT_L(0); PG8_MMA(0, 0, At, B0); PG8_BAR; PG8_SCHED;
            PG8_LDB(B1, 0, 1); PG8_STAGE(PG8_SB(0, 0), b2, voffB);
            PG8_BAR; PG8_WAIT_L(0); PG8_MMA(0, 1, At, B1); PG8_BAR;
            PG8_LDA(At, 0, 1); PG8_STAGE(PG8_SA(0, 0), a2, voffA);
            PG8_BAR; PG8_WAIT_L(0); PG8_MMA(1, 0, At, B0); PG8_BAR; PG8_SCHED;
            PG8_STAGE(PG8_SB(0, 1), b2 + hstep, voffB);
            PG8_WAIT_V(6); PG8_BAR; PG8_MMA(1, 1, At, B1); PG8_BAR;
            PG8_LDB(B0, 1, 0); PG8_SCHED; PG8_LDA(At, 1, 0); PG8_STAGE(PG8_SA(0, 1), a2 + hstep, voffA);
            PG8_WAIT_L(8); PG8_BAR; PG8_WAIT_L(0); PG8_MMA(0, 0, At, B0); PG8_BAR; PG8_SCHED;
            PG8_LDB(B1, 1, 1); PG8_STAGE(PG8_SB(1, 0), b3, voffB);
            PG8_BAR; PG8_WAIT_L(0); PG8_MMA(0, 1, At, B1); PG8_BAR;
            PG8_LDA(At, 1, 1); PG8_STAGE(PG8_SA(1, 0), a3, voffA);
            PG8_BAR; PG8_WAIT_L(0); PG8_MMA(1, 0, At, B0); PG8_BAR; PG8_SCHED;
            PG8_STAGE(PG8_SB(1, 1), b3 + hstep, voffB);
            PG8_WAIT_V(6); PG8_BAR; PG8_MMA(1, 1, At, B1); PG8_BAR;
            }
        }
        if constexpr (ALIGN_EPI) { if (wr == 0) PG8_BAR; }
        if constexpr (!Epi::AFTER_DRAIN) { E(acc, cur, wr, wc, fr, fq); S.done(cur); }
        if (!has_next) break;
#pragma unroll
        for (int a = 0; a < 2; ++a)
#pragma unroll
            for (int b = 0; b < 2; ++b)
#pragma unroll
                for (int m = 0; m < 4; ++m)
#pragma unroll
                    for (int n = 0; n < 2; ++n) acc[a][b][m][n] = (f32x4){0.f, 0.f, 0.f, 0.f};
        cur = nxt; cA = nA; cB = nB; ++ui;
        if constexpr (ALIGN_EPI) { if (wr == 1) PG8_BAR; }
    }
    PG8_WAIT_V(0);
    if constexpr (!ALIGN_EPI) { if (wr == 0) PG8_BAR; }
    PG8_BAR;
    if constexpr (Epi::AFTER_DRAIN) { E.fused(acc, cur, wr, wc, fr, fq, lds, wid, lane); S.done(cur); }
#undef PG8_SA
#undef PG8_SB
#undef PG8_STAGE
#undef PG8_LDA
#undef PG8_LDB
#undef PG8_MMA
#undef PG8_WAIT_V
#undef PG8_WAIT_L
#undef PG8_BAR
#undef PG8_SCHED
}
}

namespace pg8 {
struct EpiSwiglu {
    static constexpr bool PERM = true, AFTER_DRAIN = false;
    bf16_t* O; int ldo; int p0; int nct;
    __device__ __forceinline__ void operator()(const f32x4 (&acc)[2][2][4][2], const Unit& u, int wr, int wc, int fr, int fq) const {
        const int row0 = (u.pm - p0) * BM + wr * 64 + fr, col0 = (u.pn % nct) * HALF + wc * 32 + 8 * fq;
#pragma unroll
        for (int ai = 0; ai < 2; ++ai)
#pragma unroll
            for (int m = 0; m < 4; ++m) { bf16_t* rowp = O + (size_t)(row0 + ai * HALF + m * 16) * ldo + col0;
                float a[8];
#pragma unroll
                for (int n = 0; n < 2; ++n)
#pragma unroll
                    for (int j = 0; j < 4; ++j) { const float g = acc[ai][0][m][n][j], up = acc[ai][1][m][n][j]; a[n * 4 + j] = g * __builtin_amdgcn_rcpf(1.0f + __expf(-g)) * up; }
                u32x4 w; w.x = cvt_pk_bf16(a[0], a[1]); w.y = cvt_pk_bf16(a[2], a[3]); w.z = cvt_pk_bf16(a[4], a[5]); w.w = cvt_pk_bf16(a[6], a[7]);
                *(u32x4*)rowp = w; }
    }
};
struct EpiBf16Mod {
    static constexpr bool PERM = true, AFTER_DRAIN = false;
    bf16_t* O; int ldc; int nct;
    __device__ __forceinline__ void operator()(const f32x4 (&acc)[2][2][4][2], const Unit& u, int wr, int wc, int fr, int fq) const {
        const int row0 = u.pm * BM + wr * 64 + fr, col0 = (u.pn % nct) * BM + wc * 32 + 8 * fq;
#pragma unroll
        for (int ai = 0; ai < 2; ++ai)
#pragma unroll
            for (int m = 0; m < 4; ++m) { bf16_t* rowp = O + (size_t)(row0 + ai * HALF + m * 16) * ldc + col0;
#pragma unroll
                for (int bj = 0; bj < 2; ++bj) { const f32x4 v0 = acc[ai][bj][m][0], v1 = acc[ai][bj][m][1];
                    u32x4 w; w.x = cvt_pk_bf16(v0[0], v0[1]); w.y = cvt_pk_bf16(v0[2], v0[3]); w.z = cvt_pk_bf16(v1[0], v1[1]); w.w = cvt_pk_bf16(v1[2], v1[3]);
                    *(u32x4*)(rowp + bj * HALF) = w; } }
    }
};
struct MoeOrder {
    int p0, np, nct, G, c; int pb[9];
    __device__ __forceinline__ bool next(int i, Unit& u) const {
        const int L = i * G + c; if (L >= np * nct) return false;
        const int nig = WGM * nct, gid = L / nig, fm = gid * WGM, gsz = (np - fm) < WGM ? (np - fm) : WGM, r = L % nig;
        const int pm = p0 + fm + (r % gsz), ct = r / gsz;
        int e = 0;
#pragma unroll
        for (int j = 1; j < 8; ++j) e += (pm >= pb[j]) ? 1 : 0;
        u.pm = pm; u.pn = e * nct + ct; return true;
    }
    __device__ __forceinline__ void a_ready(const Unit&) const {}
    __device__ __forceinline__ void done(const Unit&) const {}
};
}

constexpr int NWAVES = 8, NTHR = 512;
constexpr int D = 1024, NB = 8, SEQ = 4096, LC = 256, NT = NB * SEQ, NC = NB * LC, MT = NT + NC;
constexpr int DIN = 2944, NZ = 3072;
constexpr int C_K = 0, C_V = 512, C_WLO = 1024, C_ALO = 1152, C_R = 1280, C_GLO = 1792, C_U = 1920, C_GB = 2176, C_GC = 2432, C_F = 2688;
constexpr int DFF = 2816, NE = 8, DFE = 3584;
constexpr float NORM_EPS = 1e-6f, GN_EPS = 64e-5f;
constexpr int TP = 72;
enum { I_X = 0, I_C, I_CTX, I_CCTX, I_ADAW, I_ADAB, I_NORMG, I_WIN, I_WOUT, I_MU, I_MUW, I_MUA, I_W0, I_W2, I_A0, I_A2, I_G2, I_KK, I_KA, I_RK, I_GNW, I_GNB, I_CONVW,
       I_FG, I_FU, I_FD, I_RW, I_RB, I_MG, I_MUP, I_MD, N_IN };

constexpr size_t KiB = 1024, MiB = 1u << 20;
constexpr size_t WS_CTL = 0, CTL_ZERO_BYTES = 512 * KiB;
constexpr size_t WS_MOD = 512 * KiB;
constexpr size_t WS_TAB = 960 * KiB;
constexpr size_t TAB_E = WS_TAB;
constexpr size_t TAB_TWC = TAB_E + 64 * 512 * 4;
constexpr size_t TAB_TWS = TAB_TWC + 4096 * 4;
constexpr size_t TAB_C64 = TAB_TWS + 4096 * 4;
constexpr size_t TAB_S64 = TAB_C64 + 64 * 64 * 2;
constexpr size_t TAB_SN64 = TAB_S64 + 64 * 64 * 2;
constexpr size_t WS_ROUTE = 1152 * KiB;
constexpr size_t WS_TOKPOS = WS_ROUTE + (size_t)NT * 16;
static_assert(TAB_SN64 + 64 * 64 * 2 <= WS_ROUTE && WS_TOKPOS + (size_t)NT * 8 <= 2 * MiB, "low ws map");
constexpr size_t WS_Z = 2 * MiB;
constexpr size_t WS_SW = 206 * MiB;
constexpr size_t WS_WIN = WS_SW;
constexpr size_t WS_WOUT = WS_WIN + 2ull * NZ * D * 2;
constexpr size_t WS_WGU = WS_WOUT + 2ull * D * D * 2;
constexpr size_t WS_WDN = WS_WGU + 2ull * DFF * D * 2;
constexpr size_t WS_G2T = WS_WDN + (size_t)D * DFF * 2;
constexpr size_t WS_C256 = WS_G2T + 2ull * 512 * 128 * 2;
constexpr size_t WS_SN256 = WS_C256 + 256 * 256 * 2;
constexpr size_t WS_W2TG = WS_SN256 + 256 * 256 * 2;
constexpr size_t WS_A2TG = WS_W2TG + 4ull * 512 * 64 * 2;
constexpr size_t WS_XC = 244 * MiB;
static_assert(WS_A2TG + 4ull * 512 * 64 * 2 <= WS_XC, "small weights");
constexpr size_t WS_RING = 252 * MiB;
constexpr size_t WS_O32 = 381 * MiB;
constexpr size_t WS_YS = WS_O32;
constexpr size_t WS_YBUF = WS_YS + 2ull * MT * 512 * 2;
constexpr size_t WS_BONG = WS_YBUF + 32 * MiB;
constexpr size_t WS_H = 517 * MiB;
static_assert(WS_BONG + 2ull * MT * 8 * 4 <= WS_H && WS_Z + (size_t)MT * NZ * 2 <= WS_SW && WS_O32 + (size_t)MT * D * 4 <= WS_H, "ws map");
constexpr size_t WS_NEED = 585 * MiB;
static_assert(WS_H + (size_t)MT * D * 2 <= WS_NEED, "ws map end");
constexpr size_t WS_WMGU = 2 * MiB;
constexpr size_t WS_WMDN = WS_WMGU + 8ull * 2 * DFE * D * 2;
constexpr size_t WS_XG = 170 * MiB;
constexpr int XG_ROWS_CAP = 69632;
constexpr size_t WS_ACTM = 306 * MiB;
static_assert(WS_WMDN + 8ull * D * DFE * 2 <= WS_XG && WS_XG + (size_t)XG_ROWS_CAP * D * 2 <= WS_ACTM, "moe ws map");
constexpr int CW_TMO = 0;
constexpr int CW_CNT = 2048, CW_FILL = 3072;
constexpr int CW_BAR = 8192;
constexpr int MAX_LAUNCHES = 20;
constexpr int CW_PROD = 81920, CW_CONS = 81920 + 8192;

constexpr int LDS_BYTES = 163840;
constexpr int MISC_OFF = LDS_BYTES - 256;

#define GAS __attribute__((address_space(1)))
#define LAS __attribute__((address_space(3)))
typedef unsigned short bf16;
typedef unsigned v4u __attribute__((ext_vector_type(4)));
typedef unsigned v2u __attribute__((ext_vector_type(2)));
typedef float f32x4 __attribute__((ext_vector_type(4)));
typedef float f32x2 __attribute__((ext_vector_type(2)));
typedef short bf16x8 __attribute__((ext_vector_type(8)));
typedef short bf16x4 __attribute__((ext_vector_type(4)));
#define LDS_WAIT() asm volatile("s_waitcnt lgkmcnt(0)" ::: "memory")
typedef __bf16 bf16x2n __attribute__((ext_vector_type(2)));
__device__ __forceinline__ unsigned pk2(float lo, float hi) { const f32x2 v = {lo, hi}; return __builtin_bit_cast(unsigned, __builtin_convertvector(v, bf16x2n)); }
__device__ __forceinline__ unsigned f2bf(float f) { return pk2(f, f) & 0xffffu; }
__device__ __forceinline__ float bflo(unsigned w) { return __builtin_bit_cast(float, w << 16); }
__device__ __forceinline__ float bfhi(unsigned w) { return __builtin_bit_cast(float, w & 0xffff0000u); }
__device__ __forceinline__ float bf1(bf16 b) { return __builtin_bit_cast(float, (unsigned)b << 16); }
template <int CTRL> __device__ __forceinline__ float dpp_mov(float v) { return __builtin_bit_cast(float, __builtin_amdgcn_update_dpp(0, __builtin_bit_cast(int, v), CTRL, 0xf, 0xf, true)); }
__device__ __forceinline__ float wave_sum(float v) {
    v += dpp_mov<0xB1>(v); v += dpp_mov<0x4E>(v); v += dpp_mov<0x141>(v); v += dpp_mov<0x140>(v);
    const int b = __builtin_bit_cast(int, v);
    const float s0 = __builtin_bit_cast(float, __builtin_amdgcn_readlane(b, 0)), s1 = __builtin_bit_cast(float, __builtin_amdgcn_readlane(b, 16));
    const float s2 = __builtin_bit_cast(float, __builtin_amdgcn_readlane(b, 32)), s3 = __builtin_bit_cast(float, __builtin_amdgcn_readlane(b, 48));
    return (s0 + s1) + (s2 + s3);
}
__device__ __forceinline__ float sigmoidf_(float x) { return __builtin_amdgcn_rcpf(1.0f + __expf(-x)); }
#define MFMA16(a, b, c) __builtin_amdgcn_mfma_f32_16x16x32_bf16((a), (b), (c), 0, 0, 0)
#define XB_TMO      128
#define XB_XCNT(j)  (256  + 64 * (j))
#define XB_XSUB(j)  (1280 + 64 * (j))
#define XB_XGEN(j)  (2304 + 64 * (j))
#define XB_TOP      3328
#define XB_TOPGEN   3392
#define XCD_BAR_WORDS 3456
#define XB_SPIN_CAP (1u << 18)
#define LAS __attribute__((address_space(3)))

__device__ __forceinline__ unsigned xb_ld(unsigned* p)              { return __hip_atomic_load(p, __ATOMIC_RELAXED, __HIP_MEMORY_SCOPE_AGENT); }
__device__ __forceinline__ unsigned xb_add(unsigned* p, unsigned v) { return __hip_atomic_fetch_add(p, v, __ATOMIC_RELAXED, __HIP_MEMORY_SCOPE_AGENT); }
__device__ __forceinline__ unsigned xb_xcc_id() { return (unsigned)__builtin_amdgcn_s_getreg((3 << 11) | 20) & 0xFu; }
#define XB_SPIN(cond, bar) do { unsigned _sp = 0; while (cond) { __builtin_amdgcn_s_sleep(1); \
    if ((++_sp & 255u) == 0u) { if (xb_ld(&(bar)[XB_TMO])) break; if (_sp > XB_SPIN_CAP) { atomicAdd(&(bar)[XB_TMO], 1u); break; } } } } while (0)

struct XcdBarrier {
    unsigned w0;
    unsigned* bar; unsigned x;
    volatile LAS unsigned* st;
};

__device__ __forceinline__ bool xb_lane0() { return __builtin_amdgcn_mbcnt_hi(~0u, __builtin_amdgcn_mbcnt_lo(~0u, 0u)) == 0u; }
__device__ __forceinline__ XcdBarrier xcd_barrier_post(unsigned* bar, volatile LAS unsigned* st, unsigned w0) {
    XcdBarrier b; b.w0 = w0; b.bar = bar; b.x = xb_xcc_id(); b.st = st;
    if (w0 && xb_lane0()) (void)xb_add(&bar[XB_XCNT(b.x)], 1u);
    return b;
}
__device__ __forceinline__ void xcd_barrier_complete(unsigned* bar, unsigned x, unsigned& nloc, unsigned& nx) {
    const unsigned G = gridDim.x * gridDim.y * gridDim.z;
    unsigned sum, cnt, mine, sp = 0u;
    for (;;) {
        sum = 0u; cnt = 0u; mine = 0u;
#pragma unroll
        for (unsigned j = 0; j < 16; ++j) { const unsigned c = xb_ld(&bar[XB_XCNT(j)]); sum += c; cnt += (c > 0u) ? 1u : 0u; mine = (j == x) ? c : mine; }
        if (sum == G) break;
        __builtin_amdgcn_s_sleep(1);
        if ((++sp & 255u) == 0u) { if (xb_ld(&bar[XB_TMO])) break; if (sp > XB_SPIN_CAP) { atomicAdd(&bar[XB_TMO], 1u); break; } }
    }
    nloc = mine > 0u ? mine : 1u; nx = cnt > 0u ? cnt : 1u;
}

__device__ __forceinline__ void xcd_barrier(const XcdBarrier& b) {
    asm volatile("s_waitcnt vmcnt(0)" ::: "memory");
    __syncthreads();
    if (b.w0 && xb_lane0()) {
        unsigned* bar = b.bar;
        __builtin_amdgcn_s_waitcnt(0);
        unsigned nloc = b.st[0], nx = b.st[1];
        if (nloc == 0u) { xcd_barrier_complete(bar, b.x, nloc, nx); b.st[0] = nloc; b.st[1] = nx; }
        const unsigned old = xb_add(&bar[XB_XSUB(b.x)], 1u);
        const unsigned gen = old / nloc;
        if (old + 1u == (gen + 1u) * nloc) {
            __builtin_amdgcn_fence(__ATOMIC_RELEASE, "agent");
            asm volatile("s_waitcnt vmcnt(0)" ::: "memory");
            const unsigned og = xb_add(&bar[XB_TOP], 1u);
            const unsigned tg = og / nx;
            if (og + 1u == (tg + 1u) * nx) xb_add(&bar[XB_TOPGEN], 1u);
            else XB_SPIN(xb_ld(&bar[XB_TOPGEN]) == tg, bar);
            __builtin_amdgcn_fence(__ATOMIC_ACQUIRE, "agent");
            xb_add(&bar[XB_XGEN(b.x)], 1u);
            asm volatile("s_waitcnt vmcnt(0)" ::: "memory");
        } else {
            XB_SPIN(xb_ld(&bar[XB_XGEN(b.x)]) == gen, bar);
            __builtin_amdgcn_fence(__ATOMIC_ACQUIRE, "agent");
            asm volatile("s_waitcnt vmcnt(0)" ::: "memory");
        }
    }
    __syncthreads();
}


struct Params {
    const float* in[N_IN];
    float* out;
    unsigned char* ws;
    int act_cap_panels;
    int ph_lo, ph_hi, li;
};
static_assert(sizeof(Params) == N_IN * 8 + 8 + 8 + 16, "Params has no padding");

struct Frame {
    LAS unsigned char* lds;
    int tid, lane, wave, G, bx;
};
#define WSP(T, off) ((T*)(P.ws + (off)))

__device__ __forceinline__ void transpose_item(const float* W, int N, bf16* WT, int ldk, int k0, int n0, int out_row0, LAS float* scr, int lane) {
#pragma unroll 8
    for (int i = 0; i < 32; ++i) { const int kk = 2 * i + (lane >> 5); scr[kk * 33 + (lane & 31)] = W[(size_t)(k0 + kk) * N + n0 + (lane & 31)]; }
    LDS_WAIT(); asm volatile("" ::: "memory");
    const int c = lane & 7;
#pragma unroll
    for (int j = 0; j < 4; ++j) { const int n = (lane >> 3) + 8 * j; const LAS float* s = scr + (8 * c) * 33 + n;
        v4u o; o.x = pk2(s[0 * 33], s[1 * 33]); o.y = pk2(s[2 * 33], s[3 * 33]); o.z = pk2(s[4 * 33], s[5 * 33]); o.w = pk2(s[6 * 33], s[7 * 33]);
        *(v4u*)(WT + (size_t)(out_row0 + n) * ldk + k0 + 8 * c) = o; }
    LDS_WAIT(); asm volatile("" ::: "memory");
}
__device__ __forceinline__ int gu_row(int n, int up) { return (n >> 7) * 256 + up * 128 + (n & 127); }

__device__ __forceinline__ void p0_small_weights(const Params& P, const Frame& F) {
    LAS float* scr = (LAS float*)(F.lds + F.wave * 16384);
    const int gw = F.bx * NWAVES + F.wave, NGW = F.G * NWAVES;
    constexpr int I_IN = 16 * 92, I_OUT = 16 * 32, I_GU = 16 * 88, I_DN = 44 * 32, I_GT = 2 * 16, I_LR = 16;
    constexpr int NITEMS = 2 * I_IN + 2 * I_OUT + 2 * I_GU + I_DN + 2 * I_GT + 8 * I_LR;
    for (int it = gw; it < NITEMS; it += NGW) {
        int r = it;
        if (r < 2 * I_IN) { const int l = r / I_IN; r %= I_IN; const int kb = r / 92, nb = r % 92;
            transpose_item(P.in[I_WIN] + (size_t)l * D * DIN, DIN, WSP(bf16, WS_WIN) + (size_t)l * NZ * D, D, 64 * kb, 32 * nb, 32 * nb, scr, F.lane); continue; } r -= 2 * I_IN;
        if (r < 2 * I_OUT) { const int l = r / I_OUT; r %= I_OUT; const int kb = r / 32, nb = r % 32;
            transpose_item(P.in[I_WOUT] + (size_t)l * D * D, D, WSP(bf16, WS_WOUT) + (size_t)l * D * D, D, 64 * kb, 32 * nb, 32 * nb, scr, F.lane); continue; } r -= 2 * I_OUT;
        if (r < 2 * I_GU) { const int up = r / I_GU; r %= I_GU; const int kb = r / 88, nb = r % 88;
            transpose_item(P.in[up ? I_FU : I_FG], DFF, WSP(bf16, WS_WGU), D, 64 * kb, 32 * nb, gu_row(32 * nb, up), scr, F.lane); continue; } r -= 2 * I_GU;
        if (r < I_DN) { const int kb = r / 32, nb = r % 32;
            transpose_item(P.in[I_FD], D, WSP(bf16, WS_WDN), DFF, 64 * kb, 32 * nb, 32 * nb, scr, F.lane); continue; } r -= I_DN;
        if (r < 2 * I_GT) { const int l = r / I_GT; r %= I_GT; const int kb = r / 16, nb = r % 16;
            transpose_item(P.in[I_G2] + (size_t)l * 128 * 512, 512, WSP(bf16, WS_G2T) + (size_t)l * 512 * 128, 128, 64 * kb, 32 * nb, 32 * nb, scr, F.lane); continue; } r -= 2 * I_GT;
        { const int which = r / (4 * I_LR); r %= 4 * I_LR; const int ldi = r / I_LR, nb = r % I_LR;
            transpose_item(P.in[which ? I_A2 : I_W2] + (size_t)ldi * 64 * 512, 512, WSP(bf16, which ? WS_A2TG : WS_W2TG) + (size_t)ldi * 512 * 64, 64, 0, 32 * nb, 32 * nb, scr, F.lane); }
    }
    { const int gt = F.bx * NTHR + F.tid, NGT = F.G * NTHR; constexpr int NV = 2 * (NZ - DIN) * D / 8;
        for (int i = gt; i < NV; i += NGT) { const int l = i / ((NZ - DIN) * D / 8), r = i % ((NZ - DIN) * D / 8);
            *(v4u*)(WSP(bf16, WS_WIN) + (size_t)l * NZ * D + (size_t)DIN * D + (size_t)r * 8) = (v4u){0u, 0u, 0u, 0u}; } }
}
__device__ __forceinline__ void p0_tables(const Params& P, const Frame& F) {
    const int gt = F.bx * NTHR + F.tid, NGT = F.G * NTHR;
    float* E = WSP(float, TAB_E);
    for (int i = gt; i < 64 * 256; i += NGT) { const int n = i >> 8, q = i & 255;
        const float omega = 1.0f / powf(10000.0f, (float)q / 256.0f), ang = (float)n * omega;
        E[n * 512 + q] = sinf(ang); E[n * 512 + 256 + q] = cosf(ang); }
    float* twc = WSP(float, TAB_TWC); float* tws = WSP(float, TAB_TWS);
    for (int i = gt; i < 4096; i += NGT) { const float a = (float)i / 2048.0f; twc[i] = cospif(a); tws[i] = sinpif(a); }
    bf16* c64 = WSP(bf16, TAB_C64); bf16* s64 = WSP(bf16, TAB_S64); bf16* sn64 = WSP(bf16, TAB_SN64);
    for (int i = gt; i < 64 * 64; i += NGT) { const int m = ((i >> 6) * (i & 63)) & 63; const float a = (float)m / 32.0f; const float c = cospif(a), s = sinpif(a);
        c64[i] = (bf16)f2bf(c); s64[i] = (bf16)f2bf(s); sn64[i] = (bf16)f2bf(-s); }
    bf16* c256 = WSP(bf16, WS_C256); bf16* sn256 = WSP(bf16, WS_SN256);
    for (int i = gt; i < 256 * 256; i += NGT) { const int m = ((i >> 8) * (i & 255)) & 255; const float a = (float)m / 128.0f;
        c256[i] = (bf16)f2bf(cospif(a)); sn256[i] = (bf16)f2bf(-sinpif(a)); }
}
__device__ __forceinline__ void p0_adaln(const Params& P, const Frame& F) {
    LAS float* sc = (LAS float*)F.lds;
    LAS float* red = sc + 9 * 1024;
    for (int u = F.bx; u < 192; u += F.G) {
        const int l = u / 96, cb = u % 96;
        for (int i = F.tid; i < 9 * 1024; i += NTHR) { const int r = i >> 10, d = i & 1023; const float v = r < 8 ? P.in[I_C][r * 1024 + d] : P.in[I_CCTX][d]; sc[i] = v / (1.0f + expf(-v)); }
        __syncthreads();
        const int col = F.tid & 63, ks = F.tid >> 6;
        float acc[9];
#pragma unroll
        for (int r = 0; r < 9; ++r) acc[r] = 0.f;
        const float* w = P.in[I_ADAW] + ((size_t)l * 1024 + ks * 128) * 6144 + cb * 64 + col;
#pragma unroll 2
        for (int k = 0; k < 128; k += 8) {
            float wv[8];
#pragma unroll
            for (int q = 0; q < 8; ++q) wv[q] = w[(size_t)(k + q) * 6144];
#pragma unroll
            for (int r = 0; r < 9; ++r) { const f32x4 s4 = *(const LAS f32x4*)(sc + r * 1024 + ks * 128 + k), s5 = *(const LAS f32x4*)(sc + r * 1024 + ks * 128 + k + 4);
                acc[r] += (s4.x * wv[0] + s4.y * wv[1] + s4.z * wv[2] + s4.w * wv[3]) + (s5.x * wv[4] + s5.y * wv[5] + s5.z * wv[6] + s5.w * wv[7]); }
        }
#pragma unroll
        for (int r = 0; r < 9; ++r) red[(ks * 9 + r) * 64 + col] = acc[r];
        __syncthreads();
        for (int i = F.tid; i < 9 * 64; i += NTHR) { const int r = i >> 6, c = i & 63; float s = 0.f;
#pragma unroll
            for (int k = 0; k < 8; ++k) s += red[(k * 9 + r) * 64 + c];
            WSP(float, WS_MOD)[(size_t)(l * 9 + r) * 6144 + cb * 64 + c] = s + P.in[I_ADAB][l * 6144 + cb * 64 + c]; }
        __syncthreads();
    }
}
__device__ __forceinline__ void convert_moe_weights(const Params& P, const Frame& F) {
    LAS float* scr = (LAS float*)(F.lds + F.wave * 16384);
    const int gw = F.bx * NWAVES + F.wave, NGW = F.G * NWAVES;
    constexpr int I_GU = 16 * 112, I_DN = 56 * 32, NITEMS = NE * (2 * I_GU + I_DN);
    for (int it = gw; it < NITEMS; it += NGW) {
        const int e = it / (2 * I_GU + I_DN); int r = it % (2 * I_GU + I_DN);
        if (r < 2 * I_GU) { const int up = r / I_GU; r %= I_GU; const int kb = r / 112, nb = r % 112;
            transpose_item(P.in[up ? I_MUP : I_MG] + (size_t)e * D * DFE, DFE, WSP(bf16, WS_WMGU) + (size_t)e * 2 * DFE * D, D, 64 * kb, 32 * nb, gu_row(32 * nb, up), scr, F.lane); }
        else { r -= 2 * I_GU; const int kb = r / 32, nb = r % 32;
            transpose_item(P.in[I_MD] + (size_t)e * DFE * D, D, WSP(bf16, WS_WMDN) + (size_t)e * D * DFE, DFE, 64 * kb, 32 * nb, 32 * nb, scr, F.lane); }
    }
}

__device__ __forceinline__ void store_h_row(bf16* hrow, int lane, const f32x4 (&h)[4]) {
#pragma unroll
    for (int j = 0; j < 4; ++j) { v2u w; w.x = pk2(h[j].x, h[j].y); w.y = pk2(h[j].z, h[j].w); *(v2u*)(hrow + 4 * lane + 256 * j) = w; }
}
__device__ __forceinline__ void norm_mod(const f32x4 (&x)[4], int lane, const float* ng, const float* sc, const float* sh, f32x4 (&h)[4]) {
    float ss = 0.f;
#pragma unroll
    for (int j = 0; j < 4; ++j) ss += (x[j].x * x[j].x + x[j].y * x[j].y) + (x[j].z * x[j].z + x[j].w * x[j].w);
    const float rs = rsqrtf(wave_sum(ss) * (1.0f / D) + NORM_EPS);
#pragma unroll
    for (int j = 0; j < 4; ++j) { const int c = 4 * lane + 256 * j; const f32x4 g = *(const f32x4*)(ng + c), s1 = *(const f32x4*)(sc + c), s0 = *(const f32x4*)(sh + c);
        h[j] = (x[j] * rs * g) * (1.0f + s1) + s0; }
}
__device__ __forceinline__ void phase_first_norm(const Params& P, const Frame& F) {
    const int gw = F.bx * NWAVES + F.wave, NGW = F.G * NWAVES, lane = F.lane;
    const float* E = WSP(float, TAB_E); const float* mod = WSP(float, WS_MOD); bf16* H = WSP(bf16, WS_H);
    const float* ng = P.in[I_NORMG];
    f32x4 xn[4];
    auto src = [&](int row) -> const float* { return row < NT ? P.in[I_X] + (size_t)row * D : P.in[I_CTX] + (size_t)(row - NT) * D; };
    if (gw < MT) { const float* xr = src(gw);
#pragma unroll
        for (int j = 0; j < 4; ++j) xn[j] = *(const f32x4*)(xr + 4 * lane + 256 * j); }
    for (int row = gw; row < MT; row += NGW) {
        f32x4 x[4];
#pragma unroll
        for (int j = 0; j < 4; ++j) x[j] = xn[j];
        if (row + NGW < MT) { const float* xr = src(row + NGW);
#pragma unroll
            for (int j = 0; j < 4; ++j) xn[j] = *(const f32x4*)(xr + 4 * lane + 256 * j); }
        int mr = 8;
        if (row < NT) { const int p = row & (SEQ - 1); mr = row >> 12;
#pragma unroll
            for (int j = 0; j < 4; ++j) { const int c = 4 * lane + 256 * j; const float* e = (j < 2) ? (E + (p >> 6) * 512 + c) : (E + (p & 63) * 512 + (c - 512));
                x[j] = x[j] + *(const f32x4*)e; }
        }
        const float* m = mod + (size_t)(0 * 9 + mr) * 6144;
        f32x4 h[4]; norm_mod(x, lane, ng, m + 1024, m, h);
        store_h_row(H + (size_t)row * D, lane, h);
    }
}
template <int MODE, bool NEXT, bool ROUTE, bool FIRST = false>
__device__ __forceinline__ void phase_post(const Params& P, const Frame& F, int nrows, int l, int goff, int ngp_idx, const float* xc_src, int ln, int ngn_idx, int scoff, int shoff) {
    const int gw = F.bx * NWAVES + F.wave, NGW = F.G * NWAVES, lane = F.lane;
    const float* mod = WSP(float, WS_MOD); bf16* H = WSP(bf16, WS_H); const bf16* O32 = WSP(bf16, WS_O32);
    const float* ngp = P.in[I_NORMG] + (size_t)(l * 4 + ngp_idx) * D;
    const float* ngn = P.in[I_NORMG] + (size_t)(ln * 4 + ngn_idx) * D;
    int cnt[NE];
#pragma unroll
    for (int e = 0; e < NE; ++e) cnt[e] = 0;
    v2u on0[4], on1[4]; f32x4 xnx[4]; float pn0 = 0.f, pn1 = 0.f;
    auto xsrc = [&](int row) -> const float* { return row < NT ? ((FIRST ? P.in[I_X] : (const float*)P.out) + (size_t)row * D) : (xc_src + (size_t)(row - NT) * D); };
    auto fetch = [&](int row) {
        if (MODE == 0) {
#pragma unroll
            for (int j = 0; j < 4; ++j) on0[j] = *(const v2u*)(O32 + (size_t)row * D + 4 * lane + 256 * j);
        } else {
            const int4 rt = *(const int4*)(P.ws + WS_ROUTE + (size_t)row * 16); const int2 tp = *(const int2*)(P.ws + WS_TOKPOS + (size_t)row * 8);
            pn0 = __builtin_bit_cast(float, rt.y); pn1 = __builtin_bit_cast(float, rt.z);
            const bf16* y0 = WSP(bf16, WS_XG) + (size_t)tp.x * D; const bf16* y1 = WSP(bf16, WS_XG) + (size_t)tp.y * D;
#pragma unroll
            for (int j = 0; j < 4; ++j) { on0[j] = *(const v2u*)(y0 + 4 * lane + 256 * j); on1[j] = *(const v2u*)(y1 + 4 * lane + 256 * j); }
        }
        const float* xs = xsrc(row);
#pragma unroll
        for (int j = 0; j < 4; ++j) xnx[j] = *(const f32x4*)(xs + 4 * lane + 256 * j);
    };
    if (gw < nrows) fetch(gw);
    for (int row = gw; row < nrows; row += NGW) {
        const int mr = row < NT ? (row >> 12) : 8;
        f32x4 o[4], xin[4];
#pragma unroll
        for (int j = 0; j < 4; ++j) { xin[j] = xnx[j];
            if (FIRST && row < NT) { const int p = row & (SEQ - 1), c = 4 * lane + 256 * j; const float* e = (j < 2) ? (WSP(float, TAB_E) + (p >> 6) * 512 + c) : (WSP(float, TAB_E) + (p & 63) * 512 + (c - 512)); xin[j] = xin[j] + *(const f32x4*)e; }
            if (MODE == 0) o[j] = (f32x4){bflo(on0[j].x), bfhi(on0[j].x), bflo(on0[j].y), bfhi(on0[j].y)};
            else o[j] = (f32x4){pn0 * bflo(on0[j].x) + pn1 * bflo(on1[j].x), pn0 * bfhi(on0[j].x) + pn1 * bfhi(on1[j].x), pn0 * bflo(on0[j].y) + pn1 * bflo(on1[j].y), pn0 * bfhi(on0[j].y) + pn1 * bfhi(on1[j].y)}; }
        if (row + NGW < nrows) fetch(row + NGW);
        float ss = 0.f;
#pragma unroll
        for (int j = 0; j < 4; ++j) ss += (o[j].x * o[j].x + o[j].y * o[j].y) + (o[j].z * o[j].z + o[j].w * o[j].w);
        const float rs = rsqrtf(wave_sum(ss) * (1.0f / D) + NORM_EPS);
        float* xd = row < NT ? (P.out + (size_t)row * D) : (WSP(float, WS_XC) + (size_t)(row - NT) * D);
        const float* m = mod + (size_t)(l * 9 + mr) * 6144;
        f32x4 x[4];
#pragma unroll
        for (int j = 0; j < 4; ++j) { const int c = 4 * lane + 256 * j; const f32x4 g = *(const f32x4*)(m + goff + c), n = *(const f32x4*)(ngp + c);
            x[j] = xin[j] + g * (o[j] * rs * n); *(f32x4*)(xd + c) = x[j]; }
        if (NEXT) {
            const float* mn = mod + (size_t)(ln * 9 + mr) * 6144;
            f32x4 h[4]; norm_mod(x, lane, ngn, mn + scoff, mn + shoff, h);
            store_h_row(H + (size_t)row * D, lane, h);
            if (ROUTE) {
                float lg[NE];
#pragma unroll
                for (int e = 0; e < NE; ++e) lg[e] = 0.f;
                const float* rw = P.in[I_RW];
#pragma unroll
                for (int j = 0; j < 4; ++j)
#pragma unroll
                    for (int q = 0; q < 4; ++q) { const int c = 4 * lane + 256 * j + q; const f32x4 w0 = *(const f32x4*)(rw + c * 8), w1 = *(const f32x4*)(rw + c * 8 + 4); const float hv = h[j][q];
                        lg[0] += hv * w0.x; lg[1] += hv * w0.y; lg[2] += hv * w0.z; lg[3] += hv * w0.w; lg[4] += hv * w1.x; lg[5] += hv * w1.y; lg[6] += hv * w1.z; lg[7] += hv * w1.w; }
#pragma unroll
                for (int e = 0; e < NE; ++e) lg[e] = wave_sum(lg[e]) + P.in[I_RB][e];
                int i0 = 0; float v0 = lg[0];
#pragma unroll
                for (int e = 1; e < NE; ++e) if (lg[e] > v0) { v0 = lg[e]; i0 = e; }
                int i1 = -1; float v1 = -3.0e38f;
#pragma unroll
                for (int e = 0; e < NE; ++e) if (e != i0 && lg[e] > v1) { v1 = lg[e]; i1 = e; }
                const float e1 = expf(v1 - v0), p0 = 1.0f / (1.0f + e1), p1 = e1 / (1.0f + e1);
                if (lane == 0) *(int4*)(P.ws + WS_ROUTE + (size_t)row * 16) = make_int4(i0 | (i1 << 8), __builtin_bit_cast(int, p0), __builtin_bit_cast(int, p1), 0);
#pragma unroll
                for (int e = 0; e < NE; ++e) cnt[e] += (e == i0 || e == i1) ? 1 : 0;
            }
        }
    }
    if (ROUTE) {
        if (lane == 0) {
#pragma unroll
            for (int e = 0; e < NE; ++e) if (cnt[e]) __hip_atomic_fetch_add(WSP(unsigned, WS_CTL) + CW_CNT + 64 * e, (unsigned)cnt[e], __ATOMIC_RELAXED, __HIP_MEMORY_SCOPE_AGENT);
        }
    }
}

constexpr int TB = 64;
typedef short bf16x4s __attribute__((ext_vector_type(4)));
#define MFMA16K(a, b, c) __builtin_amdgcn_mfma_f32_16x16x16bf16_1k((a), (b), (c), 0, 0, 0)
__device__ __forceinline__ float fexp(float x) { return __builtin_amdgcn_exp2f(x * 1.44269504089f); }
__device__ __forceinline__ float flog(float x) { return __builtin_amdgcn_logf(x) * 0.69314718056f; }
__device__ __forceinline__ float frcp(float x) { return __builtin_amdgcn_rcpf(x); }
__device__ __forceinline__ float softplusf_(float x) { return fmaxf(x, 0.f) + flog(1.0f + fexp(-fabsf(x))); }
__device__ __forceinline__ float ftanh(float x) { return 1.0f - 2.0f * frcp(1.0f + fexp(2.0f * x)); }
__device__ __forceinline__ f32x4 ld4bf(const bf16* p) { const v2u w = *(const v2u*)p; return (f32x4){bflo(w.x), bfhi(w.x), bflo(w.y), bfhi(w.y)}; }
template <int CTRL> __device__ __forceinline__ float dppf(float v) { return __builtin_bit_cast(float, __builtin_amdgcn_update_dpp(0, __builtin_bit_cast(int, v), CTRL, 0xf, 0xf, true)); }
__device__ __forceinline__ float sum8(float v) { v += dppf<0xB1>(v); v += dppf<0x4E>(v); v += dppf<0x141>(v); return v; }
__device__ __forceinline__ bf16x4s pack4(f32x4 v) { v2u w; w.x = pk2(v.x, v.y); w.y = pk2(v.z, v.w); return __builtin_bit_cast(bf16x4s, w); }
__device__ __forceinline__ void unpack8(v4u w, float (&o)[8]) {
#pragma unroll
    for (int q = 0; q < 4; ++q) { o[2 * q] = bflo(w[q]); o[2 * q + 1] = bfhi(w[q]); } }
__device__ __forceinline__ v4u pack8(const float (&o)[8]) { v4u w;
#pragma unroll
    for (int q = 0; q < 4; ++q) w[q] = pk2(o[2 * q], o[2 * q + 1]);
    return w; }
struct ScanPre { v4u kc, kp, vc, vp, rc, rp, wc, wp, ac, ap; };
__device__ __forceinline__ int scan_row(int bi, int tk, int b, int dir, bool& hp, int& prow) {
    const int seq = bi >= LC / TB, c = seq ? bi - LC / TB : bi, len = seq ? SEQ : LC, rowbase = seq ? b * SEQ : NT + b * LC;
    const int ts = c * TB + tk, t = dir ? (len - 1 - ts) : ts;
    hp = dir ? (t + 1 < len) : (t > 0);
    prow = rowbase + (hp ? (dir ? t + 1 : t - 1) : t);
    return rowbase + t;
}
__device__ __forceinline__ void scan_prefetch(const bf16* Z, int bi, int tk, int b, int dir, int gc, int c8, ScanPre& R) {
    bool hp; int prow; const int row = scan_row(bi, tk, b, dir, hp, prow);
    const bf16* zrk = Z + (size_t)row * NZ + gc; const bf16* zpk = Z + (size_t)prow * NZ + gc;
    const bf16* zrw = Z + (size_t)row * NZ + C_WLO + 64 * dir + c8; const bf16* zpw = Z + (size_t)prow * NZ + C_WLO + 64 * dir + c8;
    R.kc = *(const v4u*)(zrk + C_K); R.vc = *(const v4u*)(zrk + C_V); R.rc = *(const v4u*)(zrk + C_R); R.wc = *(const v4u*)(zrw); R.ac = *(const v4u*)(zrw + (C_ALO - C_WLO));
    R.kp = *(const v4u*)(zpk + C_K); R.vp = *(const v4u*)(zpk + C_V); R.rp = *(const v4u*)(zpk + C_R); R.wp = *(const v4u*)(zpw); R.ap = *(const v4u*)(zpw + (C_ALO - C_WLO));
}
__device__ __forceinline__ void lerp8(v4u cur, v4u prv, bool hp, const LAS float* mu, float (&o)[8]) {
    if (!hp) prv = (v4u){0u, 0u, 0u, 0u};
    const f32x4 m0 = *(const LAS f32x4*)mu, m1 = *(const LAS f32x4*)(mu + 4);
#pragma unroll
    for (int q = 0; q < 4; ++q) {
        const f32x2 c2 = {bflo(cur[q]), bfhi(cur[q])}, p2 = {bflo(prv[q]), bfhi(prv[q])};
        const f32x2 m2 = q < 2 ? (f32x2){m0[2 * q], m0[2 * q + 1]} : (f32x2){m1[2 * q - 4], m1[2 * q - 3]};
        const f32x2 r2 = c2 + (p2 - c2) * m2;
        o[2 * q] = r2.x; o[2 * q + 1] = r2.y; }
}
#define RLX_AGENT __ATOMIC_RELAXED, __HIP_MEMORY_SCOPE_AGENT
typedef GAS unsigned gu32;
constexpr unsigned kSpinCap = 1u << 17;
__device__ __forceinline__ bool wait_ge(gu32* word, unsigned want, gu32* tmo, unsigned code, int lane) {
    for (unsigned spins = 0;;) {
        if ((unsigned)__builtin_amdgcn_readfirstlane(__hip_atomic_load(word, RLX_AGENT)) >= want) return true;
        __builtin_amdgcn_s_sleep(1);
        if (++spins > kSpinCap) { if (lane == 0) { __hip_atomic_store(tmo, 1u, RLX_AGENT); __hip_atomic_fetch_max(tmo + 1, code, RLX_AGENT); } return false; }
        if ((spins & 255u) == 0u && __builtin_amdgcn_readfirstlane(__hip_atomic_load(tmo, RLX_AGENT))) return false;
    }
}
constexpr int XFER_PIECES = 3264, XFER_SLOT_BYTES = 52480, XFER_SLOTS = 6;
static_assert(WS_RING + 128ull * XFER_SLOTS * XFER_SLOT_BYTES <= WS_O32, "hand-off rings fit below the O buffer");
__device__ __forceinline__ int xfer_lds_off(int i) { return i < 1536 ? 20992 + 16 * i : (i < 2688 ? 45568 + 16 * (i - 1536) : 102912 + 16 * (i - 2688)); }
__device__ __forceinline__ void scan_unit(const Params& P, const Frame& F, int l, int b, int h, int dir, int role) {
    LAS unsigned char* L0 = F.lds;
    LAS bf16* W2T = (LAS bf16*)L0;
    LAS bf16* A2T = (LAS bf16*)(L0 + 9216);
    LAS float* CST = (LAS float*)(L0 + 18432);
    LAS bf16* TWb = (LAS bf16*)(L0 + 20992);
    LAS bf16* ALb = TWb + TB * TP;
    LAS bf16* BH = (LAS bf16*)(L0 + 20992);
    LAS bf16* KH = BH + 4 * 64 * 16;
    LAS bf16* Vt = KH + 4 * 64 * 16;
    LAS float* LW = (LAS float*)(L0 + 45568);
    constexpr int LWP = 68;
    LAS float* LA = LW + TB * LWP;
    LAS bf16* AT = (LAS bf16*)(L0 + 45568);
    LAS bf16* RT = AT + TB * TP; LAS bf16* BT = RT + TB * TP; LAS bf16* KT = BT + TB * TP;
    LAS float* CUM = (LAS float*)(L0 + 82432);
    LAS float* LabF = (LAS float*)(L0 + 98816);
    LAS bf16* LakB = (LAS bf16*)(L0 + 102912);
    LAS bf16* TtB = LakB + 1024; LAS bf16* MrbB = TtB + 1024; LAS bf16* MrkB = MrbB + 1024;
    LAS float* PCb = (LAS float*)(L0 + 111104);
    LAS float* YB = (LAS float*)(L0 + 112128);
    LAS float* BONl = (LAS float*)(L0 + 128512);
    const int tid = F.tid, lane = F.lane, w = F.wave, fr = lane & 15, fq = lane >> 4;
    const int tk = tid >> 3, c8 = (tid & 7) * 8, gc = 64 * h + c8;
    const int ld = l * 2 + dir;
    for (int i = tid; i < 4096; i += NTHR) { const int j = i >> 6, c = i & 63;
        W2T[c * TP + j] = (bf16)f2bf(P.in[I_W2][((size_t)ld * 64 + j) * 512 + 64 * h + c]); A2T[c * TP + j] = (bf16)f2bf(P.in[I_A2][((size_t)ld * 64 + j) * 512 + 64 * h + c]); }
    if (tid < 64) { const int c = 64 * h + tid;
        CST[0 * 64 + tid] = P.in[I_MU][(size_t)(ld * 3 + 0) * 512 + c]; CST[1 * 64 + tid] = P.in[I_MU][(size_t)(ld * 3 + 1) * 512 + c]; CST[2 * 64 + tid] = P.in[I_MU][(size_t)(ld * 3 + 2) * 512 + c];
        CST[3 * 64 + tid] = P.in[I_MUW][ld * 64 + tid]; CST[4 * 64 + tid] = P.in[I_MUA][ld * 64 + tid];
        CST[5 * 64 + tid] = P.in[I_W0][ld * 512 + c]; CST[6 * 64 + tid] = P.in[I_A0][ld * 512 + c];
        CST[7 * 64 + tid] = P.in[I_KK][l * 512 + c]; CST[8 * 64 + tid] = P.in[I_KA][l * 512 + c]; CST[9 * 64 + tid] = P.in[I_RK][l * 512 + c]; }
    const bf16* Z = WSP(bf16, WS_Z);
    bf16* YS = WSP(bf16, WS_YS) + (size_t)dir * MT * 512;
    float* BONG = WSP(float, WS_BONG) + (size_t)dir * MT * 8;
    f32x4 St[4];
#pragma unroll
    for (int kt = 0; kt < 4; ++kt) St[kt] = (f32x4){0.f, 0.f, 0.f, 0.f};
    constexpr int NBT = LC / TB + SEQ / TB;
    const int sid = (b * 8 + h) * 2 + dir;
    gu32* ctlw = (gu32*)WSP(unsigned, WS_CTL);
    gu32* prodw = ctlw + CW_PROD + l * 16384 + 64 * sid; gu32* consw = ctlw + CW_CONS + l * 16384 + 64 * sid;
    unsigned char* ring = P.ws + WS_RING + (size_t)sid * (XFER_SLOTS * XFER_SLOT_BYTES);
    v4u XR[7];
    ScanPre R; scan_prefetch(Z, role == 1 ? 1 : 0, tk, b, dir, gc, c8, R);
    __syncthreads();
    for (int bi = (role == 1 ? 1 : 0); bi < NBT; ++bi) {
        const bool mine = (role == 2) || ((bi % 2 == 0) == (role == 0));
        if (role == 1 && !mine) continue;
        const int hj = bi >> 1;
        const int bstep = role == 2 ? 1 : 2;
        const bool need_out = (bi >= LC / TB) || (l == 0);
        bool hp; int prow; const int row = scan_row(bi, tk, b, dir, hp, prow); (void)prow;
#ifdef PROBE_PREP2
        for (int prb_ = 0; prb_ < 2; ++prb_)
#endif
        if (mine) {
        if (role == 1 && hj >= XFER_SLOTS) { if (w == 0) wait_ge(consw, (unsigned)(hj - XFER_SLOTS + 1), ctlw + CW_TMO, 0x900u, lane); __syncthreads(); }
        float kx[8], vx[8], rx[8];
        { float wl[8], al[8];
          lerp8(R.kc, R.kp, hp, CST + 0 * 64 + c8, kx); lerp8(R.vc, R.vp, hp, CST + 1 * 64 + c8, vx); lerp8(R.rc, R.rp, hp, CST + 2 * 64 + c8, rx);
          lerp8(R.wc, R.wp, hp, CST + 3 * 64 + c8, wl); lerp8(R.ac, R.ap, hp, CST + 4 * 64 + c8, al);
#pragma unroll
          for (int j = 0; j < 8; ++j) wl[j] = ftanh(wl[j]);
          *(LAS v4u*)(TWb + tk * TP + c8) = pack8(wl); *(LAS v4u*)(ALb + tk * TP + c8) = pack8(al); }
        if (bi + bstep < NBT) scan_prefetch(Z, bi + bstep, tk, b, dir, gc, c8, R);
        __syncthreads();
        { const int mt = w & 3;
          bf16x8 yt[2], ya[2];
#pragma unroll
          for (int k2 = 0; k2 < 2; ++k2) { yt[k2] = *(const LAS bf16x8*)(TWb + (16 * mt + fr) * TP + 32 * k2 + 8 * fq); ya[k2] = *(const LAS bf16x8*)(ALb + (16 * mt + fr) * TP + 32 * k2 + 8 * fq); }
#pragma unroll
          for (int n2 = 0; n2 < 2; ++n2) { const int nt = 2 * (w >> 2) + n2;
              f32x4 cw = {0.f, 0.f, 0.f, 0.f}, ca = {0.f, 0.f, 0.f, 0.f};
#pragma unroll
              for (int k2 = 0; k2 < 2; ++k2) {
                  cw = MFMA16(*(const LAS bf16x8*)(W2T + (16 * nt + fr) * TP + 32 * k2 + 8 * fq), yt[k2], cw);
                  ca = MFMA16(*(const LAS bf16x8*)(A2T + (16 * nt + fr) * TP + 32 * k2 + 8 * fq), ya[k2], ca); }
              *(LAS f32x4*)(LW + (16 * mt + fr) * LWP + 16 * nt + 4 * fq) = cw; *(LAS f32x4*)(LA + (16 * mt + fr) * LWP + 16 * nt + 4 * fq) = ca; } }
        __syncthreads();
        float na[8], pb[8], km[8];
        {
            float n2 = 0.f, bon = 0.f, ew[8];
#pragma unroll
            for (int hf = 0; hf < 2; ++hf) {
#pragma unroll
                for (int j = 4 * hf; j < 4 * hf + 4; ++j) {
                    const float aw = LW[tk * LWP + c8 + j], aa = LA[tk * LWP + c8 + j];
                    ew[j] = 0.6065306597f * frcp(1.0f + fexp(-(CST[5 * 64 + c8 + j] + aw)));
                    const float ag = frcp(1.0f + fexp(-(CST[6 * 64 + c8 + j] + aa)));
                    const float kk = kx[j] * CST[7 * 64 + c8 + j]; n2 += kk * kk;
                    km[j] = kx[j] * (1.0f + (ag - 1.0f) * CST[8 * 64 + c8 + j]);
                    bon += rx[j] * km[j] * CST[9 * 64 + c8 + j];
                    na[j] = kk; pb[j] = ag;
                }
                __builtin_amdgcn_sched_barrier(0);
            }
            n2 = sum8(n2); bon = sum8(bon);
            const float inv = frcp(fmaxf(__builtin_amdgcn_sqrtf(n2), 1e-12f));
#pragma unroll
            for (int j = 0; j < 8; ++j) { const float kkn = na[j] * inv; na[j] = -kkn; pb[j] = kkn * pb[j]; }
            *(LAS f32x4*)(CUM + tk * 64 + c8) = (f32x4){ew[0], ew[1], ew[2], ew[3]} * 1.44269504089f; *(LAS f32x4*)(CUM + tk * 64 + c8 + 4) = (f32x4){ew[4], ew[5], ew[6], ew[7]} * 1.44269504089f;
            if ((tid & 7) == 0 && need_out) BONG[(size_t)row * 8 + h] = bon;
        }
        __syncthreads();
        if (tid < 256) { const int q = tid >> 6, ch = tid & 63; float c = 0.f;
#pragma unroll
            for (int i = 0; i < 16; ++i) { c -= CUM[(16 * q + i) * 64 + ch]; const float p = __builtin_amdgcn_exp2f(c); CUM[(16 * q + i) * 64 + ch] = p; if (i == 15) PCb[q * 64 + ch] = p; } }
        __syncthreads();
        {
            const int q = tk >> 4, tt = tk & 15;
            const f32x4 one4 = {1.f, 1.f, 1.f, 1.f};
            const f32x4 et0 = *(const LAS f32x4*)(CUM + tk * 64 + c8), et1 = *(const LAS f32x4*)(CUM + tk * 64 + c8 + 4);
            const f32x4 ep0 = tt ? *(const LAS f32x4*)(CUM + (tk - 1) * 64 + c8) : one4, ep1 = tt ? *(const LAS f32x4*)(CUM + (tk - 1) * 64 + c8 + 4) : one4;
            const f32x4 pc0 = *(const LAS f32x4*)(PCb + q * 64 + c8), pc1 = *(const LAS f32x4*)(PCb + q * 64 + c8 + 4);
            float ei8[8];
            { float t8[8];
#pragma unroll
              for (int j = 0; j < 8; ++j) t8[j] = na[j] * (j < 4 ? ep0[j & 3] : ep1[j & 3]);
              *(LAS v4u*)(AT + tk * TP + c8) = pack8(t8); }
            { float t8[8];
#pragma unroll
              for (int j = 0; j < 8; ++j) { const float et = j < 4 ? et0[j & 3] : et1[j & 3]; t8[j] = rx[j] * et; ei8[j] = frcp(et); }
              *(LAS v4u*)(RT + tk * TP + c8) = pack8(t8); }
            { float t8[8];
#pragma unroll
              for (int j = 0; j < 8; ++j) t8[j] = pb[j] * ei8[j];
              *(LAS v4u*)(BT + tk * TP + c8) = pack8(t8); }
            { float t8[8];
#pragma unroll
              for (int j = 0; j < 8; ++j) t8[j] = km[j] * ei8[j];
              *(LAS v4u*)(KT + tk * TP + c8) = pack8(t8); }
#pragma unroll
            for (int j = 0; j < 8; j += 2) { const float eh0 = (j < 4 ? pc0[j & 3] : pc1[j & 3]) * ei8[j], eh1 = (j + 1 < 4 ? pc0[(j + 1) & 3] : pc1[(j + 1) & 3]) * ei8[j + 1];
                const unsigned wb = pk2(pb[j] * eh0, pb[j + 1] * eh1), wk = pk2(km[j] * eh0, km[j + 1] * eh1), wv = pk2(vx[j], vx[j + 1]); const int o = (q * 64 + c8 + j) * 16 + (tt ^ (4 * ((tid & 7) & 3)));
                BH[o] = (bf16)(wb & 0xffffu); BH[o + 16] = (bf16)(wb >> 16); KH[o] = (bf16)(wk & 0xffffu); KH[o + 16] = (bf16)(wk >> 16); Vt[o] = (bf16)(wv & 0xffffu); Vt[o + 16] = (bf16)(wv >> 16); }
        }
        __syncthreads();
        { const int q = w >> 1, rsel = w & 1;
          const LAS bf16* YR = rsel ? RT : AT;
          f32x4 cb = {0.f, 0.f, 0.f, 0.f}, ck = {0.f, 0.f, 0.f, 0.f};
#pragma unroll
          for (int k2 = 0; k2 < 2; ++k2) { const bf16x8 yf = *(const LAS bf16x8*)(YR + (16 * q + fr) * TP + 32 * k2 + 8 * fq);
              cb = MFMA16(*(const LAS bf16x8*)(BT + (16 * q + fr) * TP + 32 * k2 + 8 * fq), yf, cb);
              ck = MFMA16(*(const LAS bf16x8*)(KT + (16 * q + fr) * TP + 32 * k2 + 8 * fq), yf, ck); }
#pragma unroll
          for (int i2 = 0; i2 < 4; ++i2) { const int i = 4 * fq + i2; const bool keep = rsel ? (i <= fr) : (i < fr); if (!keep) { cb[i2] = 0.f; ck[i2] = 0.f; } }
          if (rsel == 0) { *(LAS f32x4*)(LabF + (q * 16 + fr) * 16 + 4 * fq) = cb; *(LAS bf16x4s*)(LakB + (q * 16 + fr) * 16 + 4 * fq) = pack4(ck); }
          else { *(LAS bf16x4s*)(MrbB + (q * 16 + fr) * 16 + 4 * fq) = pack4(cb); *(LAS bf16x4s*)(MrkB + (q * 16 + fr) * 16 + 4 * fq) = pack4(ck); } }
        __syncthreads();
        if (tid < 64) { const int q = tid >> 4, c = tid & 15; float T[16];
#pragma unroll
            for (int t = 0; t < 16; ++t) { float sacc = (t == c) ? 1.f : 0.f;
#pragma unroll
                for (int i = 0; i < t; ++i) sacc += LabF[(q * 16 + t) * 16 + i] * T[i];
                T[t] = sacc; TtB[(q * 16 + t) * 16 + c] = (bf16)f2bf(sacc); } }
        __syncthreads();
        }
        if (role == 1) {
            const __amdgpu_buffer_rsrc_t rs = __builtin_amdgcn_make_buffer_rsrc(ring, 0, XFER_SLOTS * XFER_SLOT_BYTES, 0x00020000);
            const unsigned sb0 = (unsigned)((hj % XFER_SLOTS) * XFER_SLOT_BYTES);
            for (int i = tid; i < XFER_PIECES; i += NTHR) { const v4u v = *(const LAS v4u*)(L0 + xfer_lds_off(i)); __builtin_amdgcn_raw_buffer_store_b128(v, rs, sb0 + 16u * (unsigned)i, 0, 16); }
            asm volatile("s_waitcnt vmcnt(0)" ::: "memory");
            __syncthreads();
            if (tid == 0) __hip_atomic_store(prodw, (unsigned)(hj + 1), RLX_AGENT);
            continue;
        }
        if (!mine) {
#pragma unroll
            for (int k = 0; k < 7; ++k) { const int i = tid + NTHR * k; if (i < XFER_PIECES) *(LAS v4u*)(L0 + xfer_lds_off(i)) = XR[k]; }
            __syncthreads();
            if (tid == 0) __hip_atomic_store(consw, (unsigned)(hj + 1), RLX_AGENT);
        }
        if (role == 0 && bi + 1 < NBT && (bi + 1) % 2 != 0) {
            const int hn = (bi + 1) >> 1;
            if (w == 0) { wait_ge(prodw, (unsigned)(hn + 1), ctlw + CW_TMO, 0xA00u, lane); __builtin_amdgcn_fence(__ATOMIC_ACQUIRE, "agent"); asm volatile("s_waitcnt vmcnt(0)" ::: "memory"); }
            __syncthreads();
            const unsigned char* src = ring + (size_t)(hn % XFER_SLOTS) * XFER_SLOT_BYTES;
#pragma unroll
            for (int k = 0; k < 7; ++k) { int i = tid + NTHR * k; i = i < XFER_PIECES ? i : XFER_PIECES - 1; XR[k] = *(const v4u*)(src + 16 * i); }
        }
#ifdef PROBE_S2
        f32x4 Ssv[4];
#pragma unroll
        for (int kt = 0; kt < 4; ++kt) Ssv[kt] = St[kt];
        for (int prb_ = 0; prb_ < 2; ++prb_) {
        if (prb_) {
#pragma unroll
            for (int kt = 0; kt < 4; ++kt) St[kt] = Ssv[kt]; }
#endif
        if (w < 4) {
#pragma unroll 1
            for (int q = 0; q < 4; ++q) {
                const bf16x4s z4s = {0, 0, 0, 0};
#define CAT2(p0, p1) __builtin_shufflevector(*(const LAS bf16x4s*)(p0), *(const LAS bf16x4s*)(p1), 0, 1, 2, 3, 4, 5, 6, 7)
#define PAD8(p0) __builtin_shufflevector(*(const LAS bf16x4s*)(p0), z4s, 0, 1, 2, 3, 4, 5, 6, 7)
                const bf16x4s vt4 = *(const LAS bf16x4s*)(Vt + (q * 64 + 16 * w + fr) * 16 + 4 * (fq ^ ((2 * w + (fr >> 3)) & 3)));
                const LAS bf16* atp = AT + (16 * q + fr) * TP + 4 * fq; const LAS bf16* rtp = RT + (16 * q + fr) * TP + 4 * fq;
                f32x4 x1 = {0.f, 0.f, 0.f, 0.f}, yv = {0.f, 0.f, 0.f, 0.f};
                { const bf16x8 s01 = __builtin_shufflevector(pack4(St[0]), pack4(St[1]), 0, 1, 2, 3, 4, 5, 6, 7), s23 = __builtin_shufflevector(pack4(St[2]), pack4(St[3]), 0, 1, 2, 3, 4, 5, 6, 7);
                  x1 = MFMA16(CAT2(atp, atp + 16), s01, x1); x1 = MFMA16(CAT2(atp + 32, atp + 48), s23, x1);
                  yv = MFMA16(CAT2(rtp, rtp + 16), s01, yv); yv = MFMA16(CAT2(rtp + 32, rtp + 48), s23, yv); }
                x1 = MFMA16(PAD8(LakB + (q * 16 + fr) * 16 + 4 * fq), __builtin_shufflevector(vt4, z4s, 0, 1, 2, 3, 4, 5, 6, 7), x1);
                const f32x4 u = MFMA16(PAD8(TtB + (q * 16 + fr) * 16 + 4 * fq), __builtin_shufflevector(pack4(x1), z4s, 0, 1, 2, 3, 4, 5, 6, 7), ((f32x4){0.f, 0.f, 0.f, 0.f}));
                const bf16x8 vu = __builtin_shufflevector(vt4, pack4(u), 0, 1, 2, 3, 4, 5, 6, 7);
                yv = MFMA16(CAT2(MrkB + (q * 16 + fr) * 16 + 4 * fq, MrbB + (q * 16 + fr) * 16 + 4 * fq), vu, yv);
#pragma unroll
                for (int i2 = 0; i2 < 4; ++i2) YB[(16 * q + 4 * fq + i2) * 64 + 16 * w + fr] = yv[i2];
#pragma unroll
                for (int kt = 0; kt < 4; ++kt)
                    St[kt] = MFMA16(CAT2(KH + (q * 64 + 16 * kt + fr) * 16 + 4 * (fq ^ ((2 * kt + (fr >> 3)) & 3)), BH + (q * 64 + 16 * kt + fr) * 16 + 4 * (fq ^ ((2 * kt + (fr >> 3)) & 3))), vu, St[kt] * *(const LAS f32x4*)(PCb + q * 64 + 16 * kt + 4 * fq));
#undef CAT2
#undef PAD8
            }
        }
#ifdef PROBE_S2
        __syncthreads(); }
#endif
        __syncthreads();
        if (need_out) {
            float y8[8];
#pragma unroll
            for (int j = 0; j < 8; ++j) y8[j] = YB[tk * 64 + c8 + j];
            *(v4u*)(YS + (size_t)row * 512 + gc) = pack8(y8);
        }
    }
    __syncthreads();
}

constexpr int PL_CST = 0, PL_TW = 2560, PL_AL = PL_TW + 9216, PL_LW = PL_AL + 9216, PL_LA = PL_LW + 16384, PL_SET = PL_LA + 16384, PL_SETB = 52224, PL_END = PL_SET + 2 * PL_SETB;
static_assert(PL_END <= MISC_OFF, "pipelined scan LDS map");
__device__ __forceinline__ void scan_unit_pipe(const Params& P, const Frame& F, int l, int b, int h, int dir) {
    LAS unsigned char* L0 = F.lds;
    LAS float* CST = (LAS float*)(L0 + PL_CST);
    LAS bf16* TWb = (LAS bf16*)(L0 + PL_TW);
    LAS bf16* ALb = (LAS bf16*)(L0 + PL_AL);
    LAS bf16* BT = TWb; LAS bf16* KT = ALb;
    LAS float* LW = (LAS float*)(L0 + PL_LW);
    LAS float* LA = (LAS float*)(L0 + PL_LA);
    LAS float* CUM = LW; LAS float* LabF = LA;
    const int tid = F.tid, lane = F.lane, w = F.wave, fr = lane & 15, fq = lane >> 4;
    const int tk = tid >> 3, c8 = (tid & 7) * 8, gc = 64 * h + c8;
    const int ld = l * 2 + dir;
    if (tid < 64) { const int c = 64 * h + tid;
        CST[0 * 64 + tid] = P.in[I_MU][(size_t)(ld * 3 + 0) * 512 + c]; CST[1 * 64 + tid] = P.in[I_MU][(size_t)(ld * 3 + 1) * 512 + c]; CST[2 * 64 + tid] = P.in[I_MU][(size_t)(ld * 3 + 2) * 512 + c];
        CST[3 * 64 + tid] = P.in[I_MUW][ld * 64 + tid]; CST[4 * 64 + tid] = P.in[I_MUA][ld * 64 + tid];
        CST[5 * 64 + tid] = P.in[I_W0][ld * 512 + c]; CST[6 * 64 + tid] = P.in[I_A0][ld * 512 + c];
        CST[7 * 64 + tid] = P.in[I_KK][l * 512 + c]; CST[8 * 64 + tid] = P.in[I_KA][l * 512 + c]; CST[9 * 64 + tid] = P.in[I_RK][l * 512 + c]; }
    const bf16* Z = WSP(bf16, WS_Z);
    bf16* YS = WSP(bf16, WS_YS) + (size_t)dir * MT * 512;
    float* BONG = WSP(float, WS_BONG) + (size_t)dir * MT * 8;
    f32x4 St[4];
#pragma unroll
    for (int kt = 0; kt < 4; ++kt) St[kt] = (f32x4){0.f, 0.f, 0.f, 0.f};
    constexpr int NBT = LC / TB + SEQ / TB;
    ScanPre R; scan_prefetch(Z, 0, tk, b, dir, gc, c8, R);
    __syncthreads();
#define PL_CHAIN(q) do { if (w < 4 && it >= 1) { \
        const bf16x4s z4s = {0, 0, 0, 0}; \
        const LAS bf16* cBH = (const LAS bf16*)(cset); const LAS bf16* cKH = cBH + 4096; const LAS bf16* cVt = cKH + 4096; const LAS bf16* cAT = (const LAS bf16*)(cset + 24576); const LAS bf16* cRT = (const LAS bf16*)(cset + 33792); \
        const LAS bf16* cLak = (const LAS bf16*)(cset + 43008); const LAS bf16* cTt = cLak + 1024; const LAS bf16* cMrb = cTt + 1024; const LAS bf16* cMrk = cMrb + 1024; const LAS float* cPC = (const LAS float*)(cset + 51200); \
        const bf16x4s vt4 = *(const LAS bf16x4s*)(cVt + ((q) * 64 + 16 * w + fr) * 16 + 4 * fq); \
        const LAS bf16* atp = cAT + (16 * (q) + fr) * TP + 4 * fq; const LAS bf16* rtp = cRT + (16 * (q) + fr) * TP + 4 * fq; \
        f32x4 x1 = {0.f, 0.f, 0.f, 0.f}, yv = {0.f, 0.f, 0.f, 0.f}; \
        { const bf16x8 s01 = __builtin_shufflevector(pack4(St[0]), pack4(St[1]), 0, 1, 2, 3, 4, 5, 6, 7), s23 = __builtin_shufflevector(pack4(St[2]), pack4(St[3]), 0, 1, 2, 3, 4, 5, 6, 7); \
          x1 = MFMA16(PL_CAT2(atp, atp + 16), s01, x1); x1 = MFMA16(PL_CAT2(atp + 32, atp + 48), s23, x1); \
          yv = MFMA16(PL_CAT2(rtp, rtp + 16), s01, yv); yv = MFMA16(PL_CAT2(rtp + 32, rtp + 48), s23, yv); } \
        x1 = MFMA16(PL_PAD8(cLak + ((q) * 16 + fr) * 16 + 4 * fq), __builtin_shufflevector(vt4, z4s, 0, 1, 2, 3, 4, 5, 6, 7), x1); \
        const f32x4 u = MFMA16(PL_PAD8(cTt + ((q) * 16 + fr) * 16 + 4 * fq), __builtin_shufflevector(pack4(x1), z4s, 0, 1, 2, 3, 4, 5, 6, 7), ((f32x4){0.f, 0.f, 0.f, 0.f})); \
        const bf16x8 vu = __builtin_shufflevector(vt4, pack4(u), 0, 1, 2, 3, 4, 5, 6, 7); \
        yv = MFMA16(PL_CAT2(cMrk + ((q) * 16 + fr) * 16 + 4 * fq, cMrb + ((q) * 16 + fr) * 16 + 4 * fq), vu, yv); \
        _Pragma("unroll") for (int kt = 0; kt < 4; ++kt) { \
            St[kt] = MFMA16(PL_CAT2(cKH + ((q) * 64 + 16 * kt + fr) * 16 + 4 * fq, cBH + ((q) * 64 + 16 * kt + fr) * 16 + 4 * fq), vu, St[kt] * *(const LAS f32x4*)(cPC + (q) * 64 + 16 * kt + 4 * fq)); \
            if (kt & 1) __builtin_amdgcn_sched_barrier(0); } \
        if (cout_) { _Pragma("unroll") for (int i2 = 0; i2 < 4; ++i2) { bool hp2; int pr2; const int row2 = scan_row(it - 1, 16 * (q) + 4 * fq + i2, b, dir, hp2, pr2); \
            YS[(size_t)row2 * 512 + 64 * h + 16 * w + fr] = (bf16)f2bf(yv[i2]); } } \
    } } while (0)
#define PL_CAT2(p0, p1) __builtin_shufflevector(*(const LAS bf16x4s*)(p0), *(const LAS bf16x4s*)(p1), 0, 1, 2, 3, 4, 5, 6, 7)
#define PL_PAD8(p0) __builtin_shufflevector(*(const LAS bf16x4s*)(p0), z4s, 0, 1, 2, 3, 4, 5, 6, 7)
    for (int it = 0; it <= NBT; ++it) {
        const bool prep = it < NBT;
        const LAS unsigned char* cset = L0 + PL_SET + ((it - 1) & 1) * PL_SETB;
        LAS unsigned char* pset = L0 + PL_SET + (it & 1) * PL_SETB;
        const bool need_out = (it >= LC / TB) || (l == 0), cout_ = (it - 1 >= LC / TB) || (l == 0);
        LAS bf16* BH = (LAS bf16*)pset; LAS bf16* KH = BH + 4096; LAS bf16* Vt = KH + 4096; LAS bf16* AT = (LAS bf16*)(pset + 24576); LAS bf16* RT = (LAS bf16*)(pset + 33792);
        LAS bf16* LakB = (LAS bf16*)(pset + 43008); LAS bf16* TtB = LakB + 1024; LAS bf16* MrbB = TtB + 1024; LAS bf16* MrkB = MrbB + 1024; LAS float* PCb = (LAS float*)(pset + 51200);
        bool hp = false; int prow = 0; const int row = prep ? scan_row(it, tk, b, dir, hp, prow) : 0; (void)prow;
        float kx[8], vx[8], rx[8], na[8], pb[8], km[8];
#ifdef PROBE_ST1
        for (int prb_ = 0; prb_ < 2; ++prb_)
#endif
        if (prep) { float wl[8], al[8];
            lerp8(R.kc, R.kp, hp, CST + 0 * 64 + c8, kx); lerp8(R.vc, R.vp, hp, CST + 1 * 64 + c8, vx); lerp8(R.rc, R.rp, hp, CST + 2 * 64 + c8, rx);
            lerp8(R.wc, R.wp, hp, CST + 3 * 64 + c8, wl); lerp8(R.ac, R.ap, hp, CST + 4 * 64 + c8, al);
#pragma unroll
            for (int j = 0; j < 8; ++j) wl[j] = ftanh(wl[j]);
            *(LAS v4u*)(TWb + tk * TP + c8) = pack8(wl); *(LAS v4u*)(ALb + tk * TP + c8) = pack8(al);
        }
        __syncthreads();
        if (w >= 4) { if (prep) { const int nt = w - 4;
            int ll = lane; asm volatile("" : "+v"(ll));
            const size_t lo = ((size_t)ld * 512 + 64 * h + 16 * nt + (ll & 15)) * 64 + 8 * (ll >> 4);
            const bf16* w2g = WSP(bf16, WS_W2TG) + lo; const bf16* a2g = WSP(bf16, WS_A2TG) + lo;
            bf16x8 w2x[2], a2x[2];
#pragma unroll
            for (int k2 = 0; k2 < 2; ++k2) { w2x[k2] = *(const bf16x8*)(w2g + 32 * k2); a2x[k2] = *(const bf16x8*)(a2g + 32 * k2); }
#pragma unroll
            for (int mt = 0; mt < 4; ++mt) { f32x4 cw = {0.f, 0.f, 0.f, 0.f}, ca = {0.f, 0.f, 0.f, 0.f};
#pragma unroll
                for (int k2 = 0; k2 < 2; ++k2) { cw = MFMA16(w2x[k2], *(const LAS bf16x8*)(TWb + (16 * mt + fr) * TP + 32 * k2 + 8 * fq), cw); ca = MFMA16(a2x[k2], *(const LAS bf16x8*)(ALb + (16 * mt + fr) * TP + 32 * k2 + 8 * fq), ca); }
                *(LAS f32x4*)(LW + (16 * mt + fr) * 64 + 16 * nt + 4 * fq) = cw; *(LAS f32x4*)(LA + (16 * mt + fr) * 64 + 16 * nt + 4 * fq) = ca; } } }
        else PL_CHAIN(0);
        __syncthreads();
#ifdef PROBE_ST3
        float lwsv[8], lasv[8];
        if (prep) {
#pragma unroll
            for (int j = 0; j < 8; ++j) { lwsv[j] = LW[tk * 64 + c8 + j]; lasv[j] = LA[tk * 64 + c8 + j]; } }
        for (int prb_ = 0; prb_ < 2; ++prb_) {
        if (prb_ && prep) {
#pragma unroll
            for (int j = 0; j < 8; ++j) { LW[tk * 64 + c8 + j] = lwsv[j]; LA[tk * 64 + c8 + j] = lasv[j]; } }
#endif
        if (prep) {
            float n2 = 0.f, bon = 0.f, ew[8];
#pragma unroll
            for (int hf = 0; hf < 2; ++hf) {
#pragma unroll
                for (int j = 4 * hf; j < 4 * hf + 4; ++j) {
                    const float aw = LW[tk * 64 + c8 + j], aa = LA[tk * 64 + c8 + j];
                    ew[j] = 0.6065306597f * frcp(1.0f + fexp(-(CST[5 * 64 + c8 + j] + aw)));
                    const float ag = frcp(1.0f + fexp(-(CST[6 * 64 + c8 + j] + aa)));
                    const float kk = kx[j] * CST[7 * 64 + c8 + j]; n2 += kk * kk;
                    km[j] = kx[j] * (1.0f + (ag - 1.0f) * CST[8 * 64 + c8 + j]);
                    bon += rx[j] * km[j] * CST[9 * 64 + c8 + j];
                    na[j] = kk; pb[j] = ag;
                }
                __builtin_amdgcn_sched_barrier(0);
            }
            n2 = sum8(n2); bon = sum8(bon);
            const float inv = frcp(fmaxf(__builtin_amdgcn_sqrtf(n2), 1e-12f));
#pragma unroll
            for (int j = 0; j < 8; ++j) { const float kkn = na[j] * inv; na[j] = -kkn; pb[j] = kkn * pb[j]; }
            *(LAS f32x4*)(CUM + tk * 64 + c8) = (f32x4){ew[0], ew[1], ew[2], ew[3]} * 1.44269504089f; *(LAS f32x4*)(CUM + tk * 64 + c8 + 4) = (f32x4){ew[4], ew[5], ew[6], ew[7]} * 1.44269504089f;
            if ((tid & 7) == 0 && need_out) BONG[(size_t)row * 8 + h] = bon;
#pragma unroll
            for (int j = 0; j < 8; j += 2) { const unsigned wv = pk2(vx[j], vx[j + 1]); const int o = ((tk >> 4) * 64 + c8 + j) * 16 + (tk & 15); Vt[o] = (bf16)(wv & 0xffffu); Vt[o + 16] = (bf16)(wv >> 16); }
        }
#ifdef PROBE_ST3
        }
#endif
        __syncthreads();
        if (w >= 4) { if (prep) { const int t2 = tid - 256, q = t2 >> 6, ch = t2 & 63; float c = 0.f;
#pragma unroll
            for (int i = 0; i < 16; ++i) { c -= CUM[(16 * q + i) * 64 + ch]; const float p = __builtin_amdgcn_exp2f(c); CUM[(16 * q + i) * 64 + ch] = p; if (i == 15) PCb[q * 64 + ch] = p; } } }
        else PL_CHAIN(1);
        __syncthreads();
#ifdef PROBE_ST5
        for (int prb_ = 0; prb_ < 2; ++prb_)
#endif
        if (prep) {
            const int q = tk >> 4, tt = tk & 15;
            const f32x4 one4 = {1.f, 1.f, 1.f, 1.f};
            const f32x4 et0 = *(const LAS f32x4*)(CUM + tk * 64 + c8), et1 = *(const LAS f32x4*)(CUM + tk * 64 + c8 + 4);
            const f32x4 ep0 = tt ? *(const LAS f32x4*)(CUM + (tk - 1) * 64 + c8) : one4, ep1 = tt ? *(const LAS f32x4*)(CUM + (tk - 1) * 64 + c8 + 4) : one4;
            const f32x4 pc0 = *(const LAS f32x4*)(PCb + q * 64 + c8), pc1 = *(const LAS f32x4*)(PCb + q * 64 + c8 + 4);
            float ei8[8];
            { float t8[8];
#pragma unroll
              for (int j = 0; j < 8; ++j) t8[j] = na[j] * (j < 4 ? ep0[j & 3] : ep1[j & 3]);
              *(LAS v4u*)(AT + tk * TP + c8) = pack8(t8); }
            __builtin_amdgcn_sched_barrier(0);
            { float t8[8];
#pragma unroll
              for (int j = 0; j < 8; ++j) { const float et = j < 4 ? et0[j & 3] : et1[j & 3]; t8[j] = rx[j] * et; ei8[j] = frcp(et); }
              *(LAS v4u*)(RT + tk * TP + c8) = pack8(t8); }
            __builtin_amdgcn_sched_barrier(0);
            { float t8[8];
#pragma unroll
              for (int j = 0; j < 8; ++j) t8[j] = pb[j] * ei8[j];
              *(LAS v4u*)(BT + tk * TP + c8) = pack8(t8); }
            __builtin_amdgcn_sched_barrier(0);
            { float t8[8];
#pragma unroll
              for (int j = 0; j < 8; ++j) t8[j] = km[j] * ei8[j];
              *(LAS v4u*)(KT + tk * TP + c8) = pack8(t8); }
            __builtin_amdgcn_sched_barrier(0);
#pragma unroll
            for (int j = 0; j < 8; j += 2) { const float eh0 = (j < 4 ? pc0[j & 3] : pc1[j & 3]) * ei8[j], eh1 = (j + 1 < 4 ? pc0[(j + 1) & 3] : pc1[(j + 1) & 3]) * ei8[j + 1];
                const unsigned wb = pk2(pb[j] * eh0, pb[j + 1] * eh1), wk = pk2(km[j] * eh0, km[j + 1] * eh1); const int o = (q * 64 + c8 + j) * 16 + tt;
                BH[o] = (bf16)(wb & 0xffffu); BH[o + 16] = (bf16)(wb >> 16); KH[o] = (bf16)(wk & 0xffffu); KH[o + 16] = (bf16)(wk >> 16); }
        }
        __syncthreads();
        if (it + 1 < NBT) scan_prefetch(Z, it + 1, tk, b, dir, gc, c8, R);
        if (w >= 4) { if (prep) { const int q = w - 4;
#pragma unroll
            for (int rsel = 0; rsel < 2; ++rsel) {
                const LAS bf16* YR = rsel ? RT : AT;
                f32x4 cb = {0.f, 0.f, 0.f, 0.f}, ck = {0.f, 0.f, 0.f, 0.f};
#pragma unroll
                for (int k2 = 0; k2 < 2; ++k2) { const bf16x8 yf = *(const LAS bf16x8*)(YR + (16 * q + fr) * TP + 32 * k2 + 8 * fq);
                    cb = MFMA16(*(const LAS bf16x8*)(BT + (16 * q + fr) * TP + 32 * k2 + 8 * fq), yf, cb);
                    ck = MFMA16(*(const LAS bf16x8*)(KT + (16 * q + fr) * TP + 32 * k2 + 8 * fq), yf, ck); }
#pragma unroll
                for (int i2 = 0; i2 < 4; ++i2) { const int i = 4 * fq + i2; const bool keep = rsel ? (i <= fr) : (i < fr); if (!keep) { cb[i2] = 0.f; ck[i2] = 0.f; } }
                if (rsel == 0) { *(LAS f32x4*)(LabF + (q * 16 + fr) * 16 + 4 * fq) = cb; *(LAS bf16x4s*)(LakB + (q * 16 + fr) * 16 + 4 * fq) = pack4(ck); }
                else { *(LAS bf16x4s*)(MrbB + (q * 16 + fr) * 16 + 4 * fq) = pack4(cb); *(LAS bf16x4s*)(MrkB + (q * 16 + fr) * 16 + 4 * fq) = pack4(ck); } } } }
        else PL_CHAIN(2);
        __syncthreads();
        if (w == 4) { if (prep) { const int q = lane >> 4, c = lane & 15; float T[16];
#pragma unroll
            for (int t = 0; t < 16; ++t) { float sacc = (t == c) ? 1.f : 0.f;
#pragma unroll
                for (int i = 0; i < t; ++i) sacc += LabF[(q * 16 + t) * 16 + i] * T[i];
                T[t] = sacc; TtB[(q * 16 + t) * 16 + c] = (bf16)f2bf(sacc); } } }
        else if (w < 4) PL_CHAIN(3);
        __syncthreads();
    }
#undef PL_CHAIN
#undef PL_CAT2
#undef PL_PAD8
}

__device__ __forceinline__ void conv_items(const Params& P, const Frame& F, int l, int nrows, int ob, int nob) {
    const bf16* Z = WSP(bf16, WS_Z); bf16* YM = WSP(bf16, WS_H);
    const float* cw = P.in[I_CONVW] + l * 768;
    for (int idx = ob * NTHR + F.tid; idx < nrows * 32; idx += nob * NTHR) {
        const int row = idx >> 5, ch = (idx & 31) * 8;
        bool hp, hn;
        if (row < NT) { const int col = row & 63; hp = col != 0; hn = col != 63; } else { const int t = (row - NT) & 255; hp = t != 0; hn = t != 255; }
        const bf16* zr = Z + (size_t)row * NZ;
        const v4u u1 = *(const v4u*)(zr + C_U + ch), g1 = *(const v4u*)(zr + C_GC + ch), gb = *(const v4u*)(zr + C_GB + ch);
        v4u u0 = {0u, 0u, 0u, 0u}, g0 = u0, u2 = u0, g2 = u0;
        if (hp) { u0 = *(const v4u*)(zr - NZ + C_U + ch); g0 = *(const v4u*)(zr - NZ + C_GC + ch); }
        if (hn) { u2 = *(const v4u*)(zr + NZ + C_U + ch); g2 = *(const v4u*)(zr + NZ + C_GC + ch); }
        v4u o;
#pragma unroll
        for (int q = 0; q < 4; ++q) {
            const float wa0 = cw[ch + 2 * q], wa1 = cw[256 + ch + 2 * q], wa2 = cw[512 + ch + 2 * q], wb0 = cw[ch + 2 * q + 1], wb1 = cw[256 + ch + 2 * q + 1], wb2 = cw[512 + ch + 2 * q + 1];
            const float lo = bflo(gb[q]) * (wa0 * bflo(g0[q]) * bflo(u0[q]) + wa1 * bflo(g1[q]) * bflo(u1[q]) + wa2 * bflo(g2[q]) * bflo(u2[q]));
            const float hi = bfhi(gb[q]) * (wb0 * bfhi(g0[q]) * bfhi(u0[q]) + wb1 * bfhi(g1[q]) * bfhi(u1[q]) + wb2 * bfhi(g2[q]) * bfhi(u2[q]));
            o[q] = pk2(lo, hi);
        }
        *(v4u*)(YM + (size_t)row * D + 512 + ch) = o;
    }
}

__device__ __forceinline__ void load_tab64(LAS bf16* dst, const bf16* src, int tid) {
    for (int i = tid; i < 512; i += NTHR) { const int r = i >> 3, c = (i & 7) * 8; *(LAS v4u*)(dst + r * TP + c) = *(const v4u*)(src + r * 64 + c); }
}
__device__ __forceinline__ bf16x8 ldsfrag(const LAS bf16* base, int row, int col) { return *(const LAS bf16x8*)(base + row * TP + col); }
__device__ __forceinline__ void fourier_a_iter(const Params& P, const Frame& F, int it) {
    const int bg = it >> 3, j = it & 7, b = bg >> 2, g = bg & 3, w = F.wave, lane = F.lane, fr = lane & 15, fq = lane >> 4, p2 = 8 * j + w;
    LAS bf16* TC64 = (LAS bf16*)F.lds; LAS bf16* TS64 = TC64 + 64 * TP; LAS bf16* TN64 = TS64 + 64 * TP;
    LAS bf16* PT = TN64 + 64 * TP + w * (64 * TP);
    load_tab64(TC64, WSP(bf16, TAB_C64), F.tid); load_tab64(TS64, WSP(bf16, TAB_S64), F.tid); load_tab64(TN64, WSP(bf16, TAB_SN64), F.tid);
    const bf16* Z = WSP(bf16, WS_Z);
    __syncthreads();
    f32x4 Yr[4][4], Yi[4][4];
#pragma unroll
    for (int a = 0; a < 4; ++a)
#pragma unroll
        for (int c = 0; c < 4; ++c) { Yr[a][c] = (f32x4){0.f, 0.f, 0.f, 0.f}; Yi[a][c] = (f32x4){0.f, 0.f, 0.f, 0.f}; }
#pragma unroll
    for (int pass = 0; pass < 2; ++pass) {
        const LAS bf16* T1 = pass == 0 ? TC64 : TS64;
        asm volatile("" ::: "memory");
#pragma unroll
        for (int xt = 0; xt < 4; ++xt) {
            bf16x8 Ff[2];
#pragma unroll
            for (int ks = 0; ks < 2; ++ks) Ff[ks] = *(const bf16x8*)(Z + (size_t)(b * SEQ + 64 * (16 * xt + fr) + p2) * NZ + C_F + 64 * g + 32 * ks + 8 * fq);
#pragma unroll
            for (int yt = 0; yt < 4; ++yt) {
                f32x4 acc = {0.f, 0.f, 0.f, 0.f};
#pragma unroll
                for (int ks = 0; ks < 2; ++ks) acc = MFMA16(Ff[ks], ldsfrag(T1, 16 * yt + fr, 32 * ks + 8 * fq), acc);
                v2u wv; wv.x = pk2(acc.x, acc.y); wv.y = pk2(acc.z, acc.w);
                *(LAS v2u*)(PT + (16 * yt + fr) * TP + 16 * xt + 4 * fq) = wv;
            }
            __builtin_amdgcn_sched_barrier(0);
        }
        LDS_WAIT(); asm volatile("" ::: "memory");
        const LAS bf16* TA = pass == 0 ? TC64 : TN64;
        const LAS bf16* TB = pass == 0 ? TS64 : TC64;
#pragma unroll
        for (int ks = 0; ks < 2; ++ks) {
            bf16x8 pf[4];
#pragma unroll
            for (int yt = 0; yt < 4; ++yt) pf[yt] = ldsfrag(PT, 16 * yt + fr, 32 * ks + 8 * fq);
#pragma unroll
            for (int xt = 0; xt < 4; ++xt) { const bf16x8 ta = ldsfrag(TA, 16 * xt + fr, 32 * ks + 8 * fq), tb = ldsfrag(TB, 16 * xt + fr, 32 * ks + 8 * fq);
#pragma unroll
                for (int yt = 0; yt < 4; ++yt) { Yr[xt][yt] = MFMA16(ta, pf[yt], Yr[xt][yt]); Yi[xt][yt] = MFMA16(tb, pf[yt], Yi[xt][yt]); }
                __builtin_amdgcn_sched_barrier(0); }
        }
        LDS_WAIT(); asm volatile("" ::: "memory");
    }
    __syncthreads();
    LAS bf16* EX = (LAS bf16*)F.lds;
    const float* twc = WSP(float, TAB_TWC); const float* tws = WSP(float, TAB_TWS);
#pragma unroll
    for (int xt = 0; xt < 4; ++xt)
#pragma unroll
        for (int i = 0; i < 4; ++i) { const int q1 = 16 * xt + 4 * fq + i, m = (p2 * q1) & 4095; const float tc = twc[m], ts = tws[m];
#pragma unroll
            for (int yt = 0; yt < 4; ++yt) { const float yr = Yr[xt][yt][i], yi = Yi[xt][yt][i]; const int cp = 16 * yt + fr;
                EX[((q1 * 2 + 0) * 64 + cp) * 8 + w] = (bf16)f2bf(yr * tc - yi * ts);
                EX[((q1 * 2 + 1) * 64 + cp) * 8 + w] = (bf16)f2bf(-yi * tc - yr * ts); }
            __builtin_amdgcn_sched_barrier(0); }
    __syncthreads();
    bf16* YB = WSP(bf16, WS_YBUF) + (size_t)bg * (64 * 2 * 64 * 64);
#pragma unroll 4
    for (int n = 0; n < 16; ++n) { const int q = F.tid + NTHR * n; *(v4u*)(YB + (size_t)q * 64 + 8 * j) = *(const LAS v4u*)(EX + q * 8); }
    __syncthreads();
}
__device__ __forceinline__ void fourier_b_unit(const Params& P, const Frame& F, int u, const LAS bf16* TC64, const LAS bf16* TS64) {
    const int bg = u >> 6, s2 = u & 63, b = bg >> 2, g = bg & 3, lane = F.lane, fr = lane & 15, fq = lane >> 4;
    const bf16* YB = WSP(bf16, WS_YBUF) + (size_t)bg * (64 * 2 * 64 * 64) + (size_t)s2 * (2 * 64 * 64);
    f32x4 acc[4][4];
#pragma unroll
    for (int a = 0; a < 4; ++a)
#pragma unroll
        for (int c = 0; c < 4; ++c) acc[a][c] = (f32x4){0.f, 0.f, 0.f, 0.f};
#pragma unroll
    for (int ks = 0; ks < 4; ++ks) { const int ri = ks >> 1, pb = (ks & 1) * 32;
        bf16x8 xf[4];
#pragma unroll
        for (int xt = 0; xt < 4; ++xt) xf[xt] = *(const bf16x8*)(YB + (size_t)(ri * 64 + 16 * xt + fr) * 64 + pb + 8 * fq);
        const LAS bf16* T = ri ? TS64 : TC64;
#pragma unroll
        for (int yt = 0; yt < 4; ++yt) { const bf16x8 tf = ldsfrag(T, 16 * yt + fr, pb + 8 * fq);
#pragma unroll
            for (int xt = 0; xt < 4; ++xt) acc[xt][yt] = MFMA16(xf[xt], tf, acc[xt][yt]); }
    }
    bf16* YM = WSP(bf16, WS_H);
#pragma unroll
    for (int yt = 0; yt < 4; ++yt) { const int s1 = 16 * yt + fr; bf16* rowp = YM + (size_t)(b * SEQ + 64 * s1 + s2) * D + 768 + 64 * g;
#pragma unroll
        for (int xt = 0; xt < 4; ++xt) { const f32x4 a = acc[xt][yt] * (1.0f / 512.0f); v2u wv; wv.x = pk2(a.x, a.y); wv.y = pk2(a.z, a.w); *(v2u*)(rowp + 16 * xt + 4 * fq) = wv; } }
}
constexpr int TP2 = 264;
__device__ __forceinline__ void fourier_ctx_unit(const Params& P, const Frame& F, int bg) {
    const int b = bg >> 2, g = bg & 3, w = F.wave, lane = F.lane, fr = lane & 15, fq = lane >> 4;
    LAS bf16* TC64 = (LAS bf16*)F.lds; LAS bf16* TS64 = TC64 + 64 * TP;
    LAS bf16* PT = TS64 + 64 * TP; LAS bf16* QT = PT + 64 * TP2;
    load_tab64(TC64, WSP(bf16, TAB_C64), F.tid); load_tab64(TS64, WSP(bf16, TAB_S64), F.tid);
    const bf16* Z = WSP(bf16, WS_Z);
    bf16x8 Ff[2][2];
#pragma unroll
    for (int xt = 0; xt < 2; ++xt)
#pragma unroll
        for (int ks = 0; ks < 2; ++ks) Ff[xt][ks] = *(const bf16x8*)(Z + (size_t)(NT + b * LC + 32 * w + 16 * xt + fr) * NZ + C_F + 64 * g + 32 * ks + 8 * fq);
    __syncthreads();
#pragma unroll
    for (int xt = 0; xt < 2; ++xt)
#pragma unroll
        for (int yt = 0; yt < 4; ++yt) {
            f32x4 ap = {0.f, 0.f, 0.f, 0.f}, aq = {0.f, 0.f, 0.f, 0.f};
#pragma unroll
            for (int ks = 0; ks < 2; ++ks) { ap = MFMA16(Ff[xt][ks], ldsfrag(TC64, 16 * yt + fr, 32 * ks + 8 * fq), ap); aq = MFMA16(Ff[xt][ks], ldsfrag(TS64, 16 * yt + fr, 32 * ks + 8 * fq), aq); }
            v2u wp, wq; wp.x = pk2(ap.x, ap.y); wp.y = pk2(ap.z, ap.w); wq.x = pk2(aq.x, aq.y); wq.y = pk2(aq.z, aq.w);
            *(LAS v2u*)(PT + (16 * yt + fr) * TP2 + 32 * w + 16 * xt + 4 * fq) = wp; *(LAS v2u*)(QT + (16 * yt + fr) * TP2 + 32 * w + 16 * xt + 4 * fq) = wq;
        }
    __syncthreads();
    const bf16* C256 = WSP(bf16, WS_C256); const bf16* SN256 = WSP(bf16, WS_SN256);
    f32x4 acc[4][2];
#pragma unroll
    for (int a = 0; a < 4; ++a)
#pragma unroll
        for (int c = 0; c < 2; ++c) acc[a][c] = (f32x4){0.f, 0.f, 0.f, 0.f};
#pragma unroll 2
    for (int ks = 0; ks < 8; ++ks) {
        bf16x8 cf[2], sf[2];
#pragma unroll
        for (int yt = 0; yt < 2; ++yt) { cf[yt] = *(const bf16x8*)(C256 + (size_t)(32 * w + 16 * yt + fr) * 256 + 32 * ks + 8 * fq); sf[yt] = *(const bf16x8*)(SN256 + (size_t)(32 * w + 16 * yt + fr) * 256 + 32 * ks + 8 * fq); }
#pragma unroll
        for (int xt = 0; xt < 4; ++xt) { const bf16x8 pf = *(const LAS bf16x8*)(PT + (16 * xt + fr) * TP2 + 32 * ks + 8 * fq), qf = *(const LAS bf16x8*)(QT + (16 * xt + fr) * TP2 + 32 * ks + 8 * fq);
#pragma unroll
            for (int yt = 0; yt < 2; ++yt) { acc[xt][yt] = MFMA16(pf, cf[yt], acc[xt][yt]); acc[xt][yt] = MFMA16(qf, sf[yt], acc[xt][yt]); } }
    }
    bf16* YM = WSP(bf16, WS_H);
#pragma unroll
    for (int yt = 0; yt < 2; ++yt) { bf16* rowp = YM + (size_t)(NT + b * LC + 32 * w + 16 * yt + fr) * D + 768 + 64 * g;
#pragma unroll
        for (int xt = 0; xt < 4; ++xt) { const f32x4 a = acc[xt][yt] * (1.0f / 128.0f); v2u wv; wv.x = pk2(a.x, a.y); wv.y = pk2(a.z, a.w); *(v2u*)(rowp + 16 * xt + 4 * fq) = wv; } }
    __syncthreads();
}

constexpr int GP = 136;
__device__ __forceinline__ void finalize_phase(const Params& P, const Frame& F, int l, int nrows) {
    LAS bf16* G2 = (LAS bf16*)F.lds;
    const bf16* g2t = WSP(bf16, WS_G2T) + (size_t)l * 512 * 128;
    for (int i = F.tid; i < 512 * 16; i += NTHR) { const int r = i >> 4, c = (i & 15) * 8; *(LAS v4u*)(G2 + r * GP + c) = *(const v4u*)(g2t + r * 128 + c); }
    __syncthreads();
    const int gw = F.bx * NWAVES + F.wave, NGW = F.G * NWAVES, lane = F.lane, fr = lane & 15, fq = lane >> 4;
    const bf16* Z = WSP(bf16, WS_Z); const bf16* YSb = WSP(bf16, WS_YS); const float* BONG = WSP(float, WS_BONG); bf16* YM = WSP(bf16, WS_H);
    const float* gnw = P.in[I_GNW] + l * 512; const float* gnb = P.in[I_GNB] + l * 512; const float* mu = P.in[I_MU];
    const int nu = (nrows / 16) * 2;
    for (int u = gw; u < nu; u += NGW) {
        const int row = (u >> 1) * 16 + fr, half = u & 1;
        bf16x8 sf[4];
#pragma unroll
        for (int ks = 0; ks < 4; ++ks) { const v4u zv = *(const v4u*)(Z + (size_t)row * NZ + C_GLO + 32 * ks + 8 * fq); v4u o;
#pragma unroll
            for (int q = 0; q < 4; ++q) o[q] = pk2(sigmoidf_(bflo(zv[q])), sigmoidf_(bfhi(zv[q])));
            sf[ks] = __builtin_bit_cast(bf16x8, o); }
        int t, len; if (row < NT) { t = row & (SEQ - 1); len = SEQ; } else { t = (row - NT) & (LC - 1); len = LC; }
#pragma unroll 1
        for (int hh = 0; hh < 4; ++hh) {
            const int head = 4 * half + hh;
            f32x4 acc[4];
#pragma unroll
            for (int j = 0; j < 4; ++j) acc[j] = (f32x4){0.f, 0.f, 0.f, 0.f};
#pragma unroll
            for (int ks = 0; ks < 4; ++ks)
#pragma unroll
                for (int j = 0; j < 4; ++j) acc[j] = MFMA16(*(const LAS bf16x8*)(G2 + (64 * head + 16 * j + fr) * GP + 32 * ks + 8 * fq), sf[ks], acc[j]);
            f32x4 osum[4];
#pragma unroll
            for (int j = 0; j < 4; ++j) osum[j] = (f32x4){0.f, 0.f, 0.f, 0.f};
#pragma unroll
            for (int dir = 0; dir < 2; ++dir) {
                const bool hp = dir ? (t + 1 < len) : (t > 0); const int prow = hp ? (dir ? row + 1 : row - 1) : row;
                const bf16* ys = YSb + ((size_t)dir * MT + row) * 512 + 64 * head + 4 * fq;
                f32x4 y[4]; float s = 0.f;
#pragma unroll
                for (int j = 0; j < 4; ++j) { y[j] = ld4bf(ys + 16 * j); s += (y[j].x + y[j].y) + (y[j].z + y[j].w); }
                s += __shfl_xor(s, 16); s += __shfl_xor(s, 32);
                const float mean = s * (1.0f / 64.0f); float q2 = 0.f;
#pragma unroll
                for (int j = 0; j < 4; ++j) { y[j] = y[j] - mean; q2 += (y[j].x * y[j].x + y[j].y * y[j].y) + (y[j].z * y[j].z + y[j].w * y[j].w); }
                q2 += __shfl_xor(q2, 16); q2 += __shfl_xor(q2, 32);
                const float rstd = rsqrtf(q2 * (1.0f / 64.0f) + GN_EPS);
                const float bon = BONG[((size_t)dir * MT + row) * 8 + head];
#pragma unroll
                for (int j = 0; j < 4; ++j) { const int ch = 64 * head + 16 * j + 4 * fq;
                    const f32x4 vc = ld4bf(Z + (size_t)row * NZ + C_V + ch), vp = hp ? ld4bf(Z + (size_t)prow * NZ + C_V + ch) : (f32x4){0.f, 0.f, 0.f, 0.f};
                    const f32x4 mv = *(const f32x4*)(mu + (size_t)((l * 2 + dir) * 3 + 1) * 512 + ch);
                    const f32x4 vx = vc + (vp - vc) * mv;
                    osum[j] += y[j] * rstd * *(const f32x4*)(gnw + ch) + *(const f32x4*)(gnb + ch) + bon * vx; }
            }
#pragma unroll
            for (int j = 0; j < 4; ++j) { const int n = 64 * head + 16 * j + 4 * fq; const f32x4 o = osum[j] * acc[j];
                v2u wv; wv.x = pk2(o.x, o.y); wv.y = pk2(o.z, o.w); *(v2u*)(YM + (size_t)row * D + n) = wv; }
        }
    }
    __syncthreads();
}

struct MoePlan { int pb[9]; };
__device__ __forceinline__ void moe_plan(const Params& P, MoePlan& M, int (&cnt)[NE]) {
    int acc = 0;
#pragma unroll
    for (int e = 0; e < NE; ++e) { cnt[e] = (int)__hip_atomic_load(WSP(unsigned, WS_CTL) + CW_CNT + 64 * e, __ATOMIC_RELAXED, __HIP_MEMORY_SCOPE_AGENT); M.pb[e] = acc; acc += (cnt[e] + 255) >> 8; }
    M.pb[8] = acc;
}
__device__ __forceinline__ void moe_assign_gather(const Params& P, const Frame& F) {
    MoePlan M; int cnt[NE]; moe_plan(P, M, cnt);
    const int gw = F.bx * NWAVES + F.wave, NGW = F.G * NWAVES, lane = F.lane;
    const bf16* H = WSP(bf16, WS_H); bf16* XG = WSP(bf16, WS_XG);
    unsigned* fill = WSP(unsigned, WS_CTL) + CW_FILL;
    for (int it = gw; it < NT / 64; it += NGW) {
        const int tok = it * 64 + lane;
        const int4 rt = *(const int4*)(P.ws + WS_ROUTE + (size_t)tok * 16);
        const int es[2] = {rt.x & 255, (rt.x >> 8) & 255};
        int pos[2];
#pragma unroll
        for (int s = 0; s < 2; ++s) {
            pos[s] = 0;
#pragma unroll
            for (int e = 0; e < NE; ++e) {
                const unsigned long long m = __ballot(es[s] == e);
                if (m) {
                    const int n = __popcll(m), first = __ffsll((long long)m) - 1;
                    unsigned base = 0;
                    if (lane == first) base = __hip_atomic_fetch_add(fill + 64 * e, (unsigned)n, __ATOMIC_RELAXED, __HIP_MEMORY_SCOPE_AGENT);
                    base = __shfl(base, first);
                    const int rank = __popcll(m & ((1ull << lane) - 1ull));
                    if (es[s] == e) pos[s] = M.pb[e] * 256 + (int)base + rank;
                }
            }
        }
        *(int2*)(P.ws + WS_TOKPOS + (size_t)tok * 8) = make_int2(pos[0], pos[1]);
        for (int i = 0; i < 64; ++i) {
            const int t = it * 64 + i, d0 = __shfl(pos[0], i), d1 = __shfl(pos[1], i);
            const v4u a = *(const v4u*)(H + (size_t)t * D + 8 * lane), b = *(const v4u*)(H + (size_t)t * D + 512 + 8 * lane);
            *(v4u*)(XG + (size_t)d0 * D + 8 * lane) = a; *(v4u*)(XG + (size_t)d0 * D + 512 + 8 * lane) = b;
            *(v4u*)(XG + (size_t)d1 * D + 8 * lane) = a; *(v4u*)(XG + (size_t)d1 * D + 512 + 8 * lane) = b;
        }
    }
#pragma unroll
    for (int e = 0; e < NE; ++e) {
        const int r0 = M.pb[e] * 256 + cnt[e], r1 = M.pb[e + 1] * 256;
        for (int r = r0 + gw; r < r1; r += NGW) { *(v4u*)(XG + (size_t)r * D + 8 * lane) = (v4u){0u, 0u, 0u, 0u}; *(v4u*)(XG + (size_t)r * D + 512 + 8 * lane) = (v4u){0u, 0u, 0u, 0u}; }
    }
}

__device__ __forceinline__ Frame make_frame(LAS unsigned char* lds, int wave0) {
    Frame F; int tid = wave0 * 64 + (int)__builtin_amdgcn_mbcnt_hi(~0u, __builtin_amdgcn_mbcnt_lo(~0u, 0u)), G = gridDim.x, bx = blockIdx.x;
    asm volatile("" : "+v"(tid)); asm volatile("" : "+s"(G)); asm volatile("" : "+s"(bx));
    F.lds = lds; F.tid = tid; F.lane = tid & 63; F.wave = __builtin_amdgcn_readfirstlane(tid >> 6); F.G = G; F.bx = bx; return F;
}
#define CAS __attribute__((address_space(4)))
#define WSQ(T, off) ((T*)(Q.ws + (off)))
#if defined(__HIP_DEVICE_COMPILE__)
__device__ __forceinline__ Params load_params() { const CAS void* p = (const CAS void*)__builtin_amdgcn_kernarg_segment_ptr(); asm volatile("" : "+s"(p)); return *(const CAS Params*)p; }
#else
__device__ __forceinline__ Params load_params() { return Params{}; }
#endif
#ifndef PG8_SP2
#define PG8_SP2 true
#endif
#ifndef PG8_ALIGN
#define PG8_ALIGN true
#endif
#ifndef REP_MASK
#define REP_MASK 0
#endif
#define NREP(k) (1 + (((REP_MASK) >> (k)) & 1))
#ifdef PHMASK
#define IN(k) (((PHMASK) >> (k)) & 1)
#else
#define IN(k) (lo <= (k) && (k) < hi)
#endif
#define GRID_BARRIER() do { XcdBarrier b_ = bar; asm volatile("" : "+s"(b_.bar)); xcd_barrier(b_); } while (0)
#define SEAM(k) do { if (IN(k) && IN((k) + 1)) GRID_BARRIER(); } while (0)

template <int l>
__device__ __forceinline__ void layer_phases(const XcdBarrier& bar, LAS unsigned char* const lds0, volatile LAS unsigned* MISC, const int lo, const int hi, const int wave0) {
        const int pb = 1 + 8 * l;
        for (int rep_ = 0; rep_ < NREP(pb + 1); ++rep_) { if (rep_) GRID_BARRIER();
        if (IN(pb + 1)) {
            const Params Q = load_params(); const Frame F = make_frame(lds0, wave0);
            pg8::Gemm g{WSQ(bf16, WS_H), WSQ(bf16, WS_WIN) + (size_t)l * NZ * D, MT, NZ, D}; pg8::StaticOrder S; S.init(MT, NZ, F.G, F.bx);
            pg8::EpiBf16<0> E{WSQ(bf16, WS_Z), NZ, nullptr, 0, 0, 1.f};
            pg8::gemm_phase<pg8::EpiBf16<0>, pg8::StaticOrder, PG8_ALIGN, PG8_SP2>(F.lds, g, S, E, F.wave);
        } }
        SEAM(pb + 1);
        for (int rep_ = 0; rep_ < NREP(pb + 2); ++rep_) { if (rep_) GRID_BARRIER();
        if (IN(pb + 2)) {
            const Params Q = load_params(); const Frame F = make_frame(lds0, wave0);
#ifdef FORCE_SOLO
            const bool paired = false;
#else
            const bool paired = F.G >= 256;
#endif
            const int nsb = F.G > 128 ? 128 : 0;
#ifndef NO_SCAN
#ifdef SCAN_PIPE
            (void)paired;
            if (F.bx < nsb || nsb == 0) { const int st = nsb ? nsb : F.G; for (int u = F.bx; u < 128; u += st) scan_unit_pipe(Q, F, l, u >> 4, (u >> 1) & 7, u & 1); }
#else
            if (paired) { if (F.bx < 128) scan_unit(Q, F, l, F.bx >> 4, (F.bx >> 1) & 7, F.bx & 1, 0); else if (F.bx < 256) { const int u = F.bx - 128; scan_unit(Q, F, l, u >> 4, (u >> 1) & 7, u & 1, 1); } }
            else if (F.bx < nsb || nsb == 0) { const int st = nsb ? nsb : F.G; for (int u = F.bx; u < 128; u += st) scan_unit(Q, F, l, u >> 4, (u >> 1) & 7, u & 1, 2); }
#endif
#endif
#ifdef PROBE_CF2
            for (int prb_ = 0; prb_ < 2; ++prb_)
#endif
            if (F.bx >= nsb) {
                const int ob = F.bx - nsb, nob = F.G - nsb;
#ifndef NO_CONV
                conv_items(Q, F, l, l == 0 ? MT : NT, ob, nob);
#endif
#ifndef NO_FA
#ifdef PROBE_FA2
                for (int prb_ = 0; prb_ < 2; ++prb_)
#endif
                for (int it = ob; it < 256; it += nob) fourier_a_iter(Q, F, it);
#endif
#ifndef NO_FC
                if (l == 0) for (int u = ob; u < 32; u += nob) fourier_ctx_unit(Q, F, u);
#endif
            }
        } }
        SEAM(pb + 2);
        for (int rep_ = 0; rep_ < NREP(pb + 3); ++rep_) { if (rep_) GRID_BARRIER();
        if (IN(pb + 3)) {
            const Params Q = load_params(); const Frame F = make_frame(lds0, wave0);
            LAS bf16* TC64 = (LAS bf16*)F.lds; LAS bf16* TS64 = TC64 + 64 * TP;
            load_tab64(TC64, WSQ(bf16, TAB_C64), F.tid); load_tab64(TS64, WSQ(bf16, TAB_S64), F.tid);
            __syncthreads();
#ifndef NO_FB
#ifdef PROBE_FB2
            for (int prb_ = 0; prb_ < 2; ++prb_)
#endif
            for (int u = F.bx * NWAVES + F.wave; u < 2048; u += F.G * NWAVES) fourier_b_unit(Q, F, u, TC64, TS64);
#endif
            __syncthreads();
#ifndef NO_FIN
            finalize_phase(Q, F, l, l == 0 ? MT : NT);
#endif
        } }
        SEAM(pb + 3);
        for (int rep_ = 0; rep_ < NREP(pb + 4); ++rep_) { if (rep_) GRID_BARRIER();
        if (IN(pb + 4)) {
            const Params Q = load_params(); const Frame F = make_frame(lds0, wave0);
            const int M = l == 0 ? MT : NT;
            pg8::Gemm g{WSQ(bf16, WS_H), WSQ(bf16, WS_WOUT) + (size_t)l * D * D, M, D, D}; pg8::StaticOrder S; S.init(M, D, F.G, F.bx);
            pg8::EpiBf16<0> E{WSQ(bf16, WS_O32), D, nullptr, 0, 0, 1.f};
            pg8::gemm_phase<pg8::EpiBf16<0>, pg8::StaticOrder, PG8_ALIGN, PG8_SP2>(F.lds, g, S, E, F.wave);
        } }
        SEAM(pb + 4);
        if (l == 0) {
            if (IN(pb + 5)) { const Params Q = load_params(); const Frame F = make_frame(lds0, wave0); phase_post<0, true, false, true>(Q, F, MT, 0, 2048, 1, Q.in[I_CTX], 0, 2, 4096, 3072); }
            SEAM(pb + 5);
            for (int rep_ = 0; rep_ < NREP(pb + 6); ++rep_) { if (rep_) GRID_BARRIER();
            if (IN(pb + 6)) {
            const Params Q = load_params(); const Frame F = make_frame(lds0, wave0);
                pg8::Gemm g{WSQ(bf16, WS_H), WSQ(bf16, WS_WGU), MT, 2 * DFF, D}; pg8::StaticOrder S; S.init(MT, 2 * DFF, F.G, F.bx);
                pg8::EpiSwiglu E{WSQ(bf16, WS_Z), DFF, 0, 1 << 20};
                pg8::gemm_phase<pg8::EpiSwiglu, pg8::StaticOrder, PG8_ALIGN, PG8_SP2>(F.lds, g, S, E, F.wave);
            } }
            SEAM(pb + 6);
            for (int rep_ = 0; rep_ < NREP(pb + 7); ++rep_) { if (rep_) GRID_BARRIER();
            if (IN(pb + 7)) {
            const Params Q = load_params(); const Frame F = make_frame(lds0, wave0);
                pg8::Gemm g{WSQ(bf16, WS_Z), WSQ(bf16, WS_WDN), MT, D, DFF}; pg8::StaticOrder S; S.init(MT, D, F.G, F.bx);
                pg8::EpiBf16<0> E{WSQ(bf16, WS_O32), D, nullptr, 0, 0, 1.f};
                pg8::gemm_phase<pg8::EpiBf16<0>, pg8::StaticOrder, PG8_ALIGN, PG8_SP2>(F.lds, g, S, E, F.wave);
            } }
            SEAM(pb + 7);
            if (IN(pb + 8)) { const Params Q = load_params(); const Frame F = make_frame(lds0, wave0); phase_post<0, true, false>(Q, F, MT, 0, 5120, 3, (const float*)(Q.ws + WS_XC), 1, 0, 1024, 0); }
            SEAM(pb + 8);
        } else {
            if (IN(pb + 5)) { const Params Q = load_params(); const Frame F = make_frame(lds0, wave0); phase_post<0, true, true>(Q, F, NT, 1, 2048, 1, nullptr, 1, 2, 4096, 3072); }
            SEAM(pb + 5);
            if (IN(pb + 6)) { const Params Q = load_params(); const Frame F = make_frame(lds0, wave0); for (int rep_ = 0; rep_ < NREP(15); ++rep_) convert_moe_weights(Q, F); moe_assign_gather(Q, F); }
            SEAM(pb + 6);
            if (IN(pb + 7)) {
            const Params Q = load_params(); const Frame F = make_frame(lds0, wave0);
                if (F.tid == 0) { MoePlan M; int cnt[NE]; moe_plan(Q, M, cnt);
#pragma unroll
                    for (int j = 0; j < 9; ++j) MISC[16 + j] = (unsigned)M.pb[j]; }
                __syncthreads();
                const int ptot = (int)MISC[16 + 8], gq = (F.G >= 256 && Q.act_cap_panels >= 128) ? 128 : (Q.act_cap_panels < 64 ? Q.act_cap_panels : 64);
                int p0 = 0;
                while (p0 < ptot) {
                    int np = ptot - p0; if (np > Q.act_cap_panels) np = gq;
                    if (np > 0) {
                        for (int rep_ = 0; rep_ < NREP(16); ++rep_) { if (rep_) GRID_BARRIER();
                            pg8::Gemm g{WSQ(bf16, WS_XG), WSQ(bf16, WS_WMGU), 0, 0, D};
                            pg8::MoeOrder S; S.p0 = p0; S.np = np; S.nct = 2 * DFE / 256; S.G = F.G; S.c = F.bx;
#pragma unroll
                            for (int j = 0; j < 9; ++j) S.pb[j] = (int)MISC[16 + j];
                            pg8::EpiSwiglu E{WSQ(bf16, WS_ACTM), DFE, p0, 2 * DFE / 256};
                            pg8::gemm_phase<pg8::EpiSwiglu, pg8::MoeOrder, PG8_ALIGN, PG8_SP2>(F.lds, g, S, E, F.wave);
                        }
                        GRID_BARRIER();
                        for (int rep_ = 0; rep_ < NREP(17); ++rep_) { if (rep_) GRID_BARRIER();
                            pg8::Gemm g{WSQ(bf16, WS_ACTM) - (size_t)p0 * 256 * DFE, WSQ(bf16, WS_WMDN), 0, 0, DFE};
                            pg8::MoeOrder S; S.p0 = p0; S.np = np; S.nct = D / 256; S.G = F.G; S.c = F.bx;
#pragma unroll
                            for (int j = 0; j < 9; ++j) S.pb[j] = (int)MISC[16 + j];
                            pg8::EpiBf16Mod E{WSQ(bf16, WS_XG), D, D / 256};
                            pg8::gemm_phase<pg8::EpiBf16Mod, pg8::MoeOrder, PG8_ALIGN, PG8_SP2>(F.lds, g, S, E, F.wave);
                        }
                        GRID_BARRIER();
                    }
                    p0 += np;
                }
            }
            if (IN(pb + 8)) { const Params Q = load_params(); const Frame F = make_frame(lds0, wave0); phase_post<1, false, false>(Q, F, NT, 1, 5120, 3, nullptr, 1, 0, 0, 0); }
        }
    }
constexpr int N_PHASES = 18;
__global__ void __launch_bounds__(NTHR, 2) fwd_kernel(Params P) {
    extern __shared__ __attribute__((aligned(16))) unsigned char lds_raw[];
    LAS unsigned char* const lds0 = (LAS unsigned char*)lds_raw;
    volatile LAS unsigned* MISC = (volatile LAS unsigned*)(lds0 + MISC_OFF);
    const int wave0 = __builtin_amdgcn_readfirstlane((int)threadIdx.x >> 6);
    if (wave0 == 0) MISC[__builtin_amdgcn_mbcnt_hi(~0u, __builtin_amdgcn_mbcnt_lo(~0u, 0u))] = 0u;
    __syncthreads();
    unsigned* ctl = (unsigned*)(P.ws + WS_CTL);
    XcdBarrier bar = xcd_barrier_post(ctl + CW_BAR + P.li * XCD_BAR_WORDS, MISC + 8, wave0 == 0 ? 1u : 0u);
    const int lo = P.ph_lo, hi = P.ph_hi;
    for (int rep_ = 0; rep_ < NREP(0); ++rep_) { if (rep_) GRID_BARRIER(); if (IN(0)) { const Params Q = load_params(); const Frame F = make_frame(lds0, wave0); p0_adaln(Q, F); p0_small_weights(Q, F); p0_tables(Q, F); } }
    SEAM(0);
#ifdef PROBE_FN_NOSTORE
    for (int rep_ = 0; rep_ < 2; ++rep_) { if (rep_) GRID_BARRIER(); if (IN(1)) { const Params Q = load_params(); const Frame F = make_frame(lds0, wave0); phase_first_norm(Q, F); } }
#else
    for (int rep_ = 0; rep_ < NREP(1); ++rep_) { if (rep_) GRID_BARRIER(); if (IN(1)) { const Params Q = load_params(); const Frame F = make_frame(lds0, wave0); phase_first_norm(Q, F); } }
#endif
    SEAM(1);
#ifdef PROBE_BAR
    for (int prb_ = 0; prb_ < 20; ++prb_) GRID_BARRIER();
#endif
    layer_phases<0>(bar, lds0, MISC, lo, hi, wave0);
    layer_phases<1>(bar, lds0, MISC, lo, hi, wave0);
#undef IN
#undef SEAM
}

#ifndef MK_PER_PHASE
#define MK_PER_PHASE 0
#endif
extern "C" void kernel_launch(void* const* d_in, const int* in_sizes, int n_in, void* d_out, int out_size, void* d_ws, size_t ws_size, hipStream_t stream) {
    static int grid = 0;
    if (grid == 0) {
        if (n_in != N_IN || in_sizes[0] != NT * D || out_size != NT * D || ws_size < WS_NEED) {
            fprintf(stderr, "kernel_launch: unexpected shapes (n_in %d, in0 %d, out %d, ws %zu); nothing launched\n", n_in, n_in > 0 ? in_sizes[0] : -1, out_size, ws_size); grid = -1; return; }
        int dev = 0, cus = 0, per_cu = 0;
        if (hipGetDevice(&dev) != hipSuccess || hipDeviceGetAttribute(&cus, hipDeviceAttributeMultiprocessorCount, dev) != hipSuccess) { grid = -1; return; }
        if (hipFuncSetAttribute((const void*)fwd_kernel, hipFuncAttributeMaxDynamicSharedMemorySize, LDS_BYTES) != hipSuccess) { fprintf(stderr, "kernel_launch: hipFuncSetAttribute failed\n"); grid = -1; return; }
        if (hipOccupancyMaxActiveBlocksPerMultiprocessor(&per_cu, (const void*)fwd_kernel, NTHR, LDS_BYTES) != hipSuccess || per_cu < 1)
            fprintf(stderr, "kernel_launch: occupancy query reports %d workgroups per CU\n", per_cu);
        (void)hipGetLastError();
        grid = cus;
    }
    if (grid < 0) return;
    if (hipMemsetAsync((char*)d_ws + WS_CTL, 0, CTL_ZERO_BYTES, stream) != hipSuccess) return;
    Params p{};
    for (int i = 0; i < N_IN; ++i) p.in[i] = (const float*)d_in[i];
    p.out = (float*)d_out; p.ws = (unsigned char*)d_ws;
    { size_t avail = ws_size - WS_ACTM; size_t cap = avail / ((size_t)256 * DFE * 2); if (cap > 264) cap = 264; p.act_cap_panels = (int)cap; }
#if MK_PER_PHASE
    int li = 0;
    for (int ph = 0; ph < N_PHASES; ++ph) {
        p.ph_lo = ph; p.ph_hi = ph + 1; p.li = li++;
        hipLaunchKernelGGL(fwd_kernel, dim3(grid), dim3(NTHR), LDS_BYTES, stream, p);
    }
#else
    p.ph_lo = 0; p.ph_hi = N_PHASES; p.li = 0;
    hipLaunchKernelGGL(fwd_kernel, dim3(grid), dim3(NTHR), LDS_BYTES, stream, p);
#endif
}
```

```cpp
#include <hip/hip_runtime.h>
#include <cstdio>
#include <cstdint>
namespace pg8 {
#define PG8_LAS __attribute__((address_space(3)))
typedef unsigned short bf16_t;
typedef short bf16x8 __attribute__((ext_vector_type(8)));
typedef float f32x4 __attribute__((ext_vector_type(4)));
typedef unsigned u32x4 __attribute__((ext_vector_type(4)));
constexpr int BM = 256, BK = 64, HALF = 128, HTB = HALF * BK * 2  , STAGE_BYTES = 8 * HTB, NXCD = 8, WGM = 8;

__host__ __device__ __forceinline__ int lds_byte(int r, int c) { const int st = (r >> 4) * 2 + (c >> 5), rr = r & 15, cc = c & 31, ob = rr * 64 + cc * 2; return st * 1024 + (ob ^ (((ob >> 9) & 1) << 5)); }
__host__ __device__ __forceinline__ void stage_rc(int b, int& R, int& C) { const int st = b / 1024, sb = b % 1024, swz = sb ^ (((sb >> 9) & 1) << 5); R = (st >> 1) * 16 + swz / 64; C = (st & 1) * 32 + (swz % 64) / 2; }
__host__ __device__ __forceinline__ int perm32(int rho) { const int n = rho >> 4, i = rho & 15; return 8 * (i >> 2) + 4 * n + (i & 3); }

struct Unit { int pm, pn; };
struct Gemm { const bf16_t* A; const bf16_t* Bt; int M, N, K; };

struct StaticOrder {
    int nM, nN, nwg, G, c;
    __host__ __device__ void init(int M, int N, int G_, int c_) { nM = M / BM; nN = N / BM; nwg = nM * nN; G = G_; c = c_; }
    __host__ __device__ bool next(int i, Unit& u) const {
        const long L = (long)i * G + c; if (L >= nwg) return false;
        int wgid = (int)L; { const int q = nwg / NXCD, r = nwg % NXCD, xcd = wgid % NXCD, off = wgid / NXCD; wgid = (xcd < r ? xcd * (q + 1) : r * (q + 1) + (xcd - r) * q) + off; }
        const int nig = WGM * nN, gid = wgid / nig, fm = gid * WGM, gsz = (nM - fm) < WGM ? (nM - fm) : WGM;
        u.pm = fm + ((wgid % nig) % gsz); u.pn = (wgid % nig) / gsz; return true;
    }
    __device__ __forceinline__ void a_ready(const Unit&) const {}
    __device__ __forceinline__ void done(const Unit&) const {}
    __device__ __forceinline__ void flush() const {}
};

__device__ __forceinline__ unsigned cvt_pk_bf16(float lo, float hi) { unsigned r; asm volatile("v_cvt_pk_bf16_f32 %0, %1, %2" : "=v"(r) : "v"(lo), "v"(hi)); return r; }
typedef float f32x2 __attribute__((ext_vector_type(2)));
__device__ __forceinline__ f32x2 gelu_pk(f32x2 v) {
    const f32x2 av = __builtin_elementwise_abs(v), d = av * 0.2316418882f + 1.0f;
    f32x2 t; t.x = __builtin_amdgcn_rcpf(d.x); t.y = __builtin_amdgcn_rcpf(d.y);
    f32x2 q = t * 0.5307027145f + (-0.7265760135f); q = q * t + 0.7107068705f; q = q * t + (-0.142248368f); q = q * t + 0.127414796f; q = q * t;
    const f32x2 s = (v * v) * (-0.72134752044f);
    f32x2 e; e.x = __builtin_amdgcn_exp2f(s.x); e.y = __builtin_amdgcn_exp2f(s.y);
    const f32x2 m = v * (q * e), r = v - m;
    f32x2 o; o.x = v.x < 0.f ? m.x : r.x; o.y = v.y < 0.f ? m.y : r.y; return o;
}

template <int ACT  > struct EpiBf16 {
    static constexpr bool PERM = true, AFTER_DRAIN = false; static_assert(ACT == 0 || ACT == 1, "EpiBf16: ACT is 0 (none) or 1 (gelu_pk)");
    bf16_t* O; int ldc; const float* bias; int split_cols; size_t split_stride; float scale0;
    __device__ __forceinline__ void operator()(const f32x4 (&acc)[2][2][4][2], const Unit& u, int wr, int wc, int fr, int fq) const {
        const int row0 = u.pm * BM + wr * 64 + fr; int colt = u.pn * BM; bf16_t* base = O;
        float sc = 1.f; if (split_cols) { const int t = colt / split_cols; base += (size_t)t * split_stride; colt -= t * split_cols; if (t == 0) sc = scale0; }
        const int col0 = colt + wc * 32 + 8 * fq, bcol0 = u.pn * BM + wc * 32 + 8 * fq;
        f32x4 bv[2][2];
#pragma unroll
        for (int bj = 0; bj < 2; ++bj)
#pragma unroll
            for (int n = 0; n < 2; ++n) bv[bj][n] = bias ? *(const f32x4*)(bias + bcol0 + bj * HALF + 4 * n) : (f32x4){0.f, 0.f, 0.f, 0.f};
#pragma unroll
        for (int ai = 0; ai < 2; ++ai)
#pragma unroll
            for (int m = 0; m < 4; ++m) { bf16_t* rowp = base + (size_t)(row0 + ai * HALF + m * 16) * ldc + col0;
#pragma unroll
                for (int bj = 0; bj < 2; ++bj) { f32x4 v0 = acc[ai][bj][m][0] + bv[bj][0], v1 = acc[ai][bj][m][1] + bv[bj][1];
                    if (ACT == 1) { f32x2 a = gelu_pk((f32x2){v0[0], v0[1]}), b = gelu_pk((f32x2){v0[2], v0[3]}), c = gelu_pk((f32x2){v1[0], v1[1]}), d = gelu_pk((f32x2){v1[2], v1[3]});
                        v0 = (f32x4){a.x, a.y, b.x, b.y}; v1 = (f32x4){c.x, c.y, d.x, d.y}; }
                    v0 = v0 * sc; v1 = v1 * sc; u32x4 w; w.x = cvt_pk_bf16(v0[0], v0[1]); w.y = cvt_pk_bf16(v0[2], v0[3]); w.z = cvt_pk_bf16(v1[0], v1[1]); w.w = cvt_pk_bf16(v1[2], v1[3]);
                    *(u32x4*)(rowp + bj * HALF) = w; } }
    }
};

struct EpiF32 {
    static constexpr bool PERM = false, AFTER_DRAIN = false;
    float* C; int ldc; const float* bias;
    __device__ __forceinline__ void operator()(const f32x4 (&acc)[2][2][4][2], const Unit& u, int wr, int wc, int fr, int fq) const {
        const int row0 = u.pm * BM + wr * 64 + fr, col0 = u.pn * BM + wc * 32 + 4 * fq;
        f32x4 bv[2][2];
#pragma unroll
        for (int bj = 0; bj < 2; ++bj)
#pragma unroll
            for (int n = 0; n < 2; ++n) bv[bj][n] = bias ? *(const f32x4*)(bias + col0 + bj * HALF + n * 16) : (f32x4){0.f, 0.f, 0.f, 0.f};
#pragma unroll
        for (int ai = 0; ai < 2; ++ai)
#pragma unroll
            for (int m = 0; m < 4; ++m) { float* rowp = C + (size_t)(row0 + ai * HALF + m * 16) * ldc + col0;
#pragma unroll
                for (int bj = 0; bj < 2; ++bj)
#pragma unroll
                    for (int n = 0; n < 2; ++n) *(f32x4*)(rowp + bj * HALF + n * 16) = acc[ai][bj][m][n] + bv[bj][n]; }
    }
};
template <class Epi, class Sched, bool ALIGN_EPI = false, bool SP2 = false>
__device__ __forceinline__ void gemm_phase(PG8_LAS unsigned char* lds, const Gemm g, const Sched& S, const Epi& E, const int wave_in) {
    int tid_ = wave_in * 64 + (int)__builtin_amdgcn_mbcnt_hi(~0u, __builtin_amdgcn_mbcnt_lo(~0u, 0u)); asm volatile("" : "+v"(tid_));
    const int tid = tid_, wid = __builtin_amdgcn_readfirstlane(tid >> 6), lane = tid & 63, wr = wid >> 2, wc = wid & 3, fr = lane & 15, fq = lane >> 4;
    const int K = g.K, nt = K / BK;
    unsigned voffA[2], voffB[2];
#pragma unroll
    for (int i = 0; i < 2; ++i) { int R, C; stage_rc(tid * 16 + i * 8192, R, C); const int Rb = Epi::PERM ? ((R & ~31) + perm32(R & 31)) : R;
        voffA[i] = (unsigned)(R * K + C) * 2u; voffB[i] = (unsigned)(Rb * K + C) * 2u; }
    const size_t kstep = (size_t)(BK * 2);
    const size_t hstep = (size_t)HALF * K * 2;
    const size_t tstep = 2 * hstep;
    const unsigned ldsw = (unsigned)wid * 1024u;
    const int aoff = lds_byte(wr * 64 + fr, fq * 8), boff = lds_byte(wc * 32 + fr, fq * 8);
#define PG8_SA(b, h) (((b) * 2 + (h)) * HTB)
#define PG8_SB(b, h) ((4 + (b) * 2 + (h)) * HTB)
#define PG8_STAGE(bufoff, gbase, voff) do { _Pragma("unroll") for (int _i = 0; _i < 2; ++_i) \
        __builtin_amdgcn_global_load_lds((const unsigned*)((const char*)(gbase) + (voff)[_i]), (PG8_LAS unsigned*)(lds + (bufoff) + ldsw + _i * 8192), 16, 0, 0); } while (0)
#define PG8_LDA(dst, b, h) do { _Pragma("unroll") for (int m = 0; m < 4; ++m) _Pragma("unroll") for (int k = 0; k < 2; ++k) dst[m][k] = *(const PG8_LAS bf16x8*)(lds + PG8_SA(b, h) + aoff + m * 2048 + k * 1024); } while (0)
#define PG8_LDB(dst, b, h) do { _Pragma("unroll") for (int n = 0; n < 2; ++n) _Pragma("unroll") for (int k = 0; k < 2; ++k) dst[n][k] = *(const PG8_LAS bf16x8*)(lds + PG8_SB(b, h) + boff + n * 2048 + k * 1024); } while (0)
#define PG8_MMA(ai, bj, At, Bt) do { __builtin_amdgcn_s_setprio(1); _Pragma("unroll") for (int m = 0; m < 4; ++m) _Pragma("unroll") for (int n = 0; n < 2; ++n) _Pragma("unroll") for (int k = 0; k < 2; ++k) \
        acc[ai][bj][m][n] = __builtin_amdgcn_mfma_f32_16x16x32_bf16(Bt[n][k], At[m][k], acc[ai][bj][m][n], 0, 0, 0); __builtin_amdgcn_s_setprio(0); } while (0)
#define PG8_WAIT_V(n) asm volatile("s_waitcnt vmcnt(" #n ")" ::: "memory")
#define PG8_WAIT_L(n) asm volatile("s_waitcnt lgkmcnt(" #n ")" ::: "memory")
#define PG8_BAR __builtin_amdgcn_s_barrier()
#define PG8_SCHED __builtin_amdgcn_sched_barrier(0)
    Unit cur, nxt; int ui = 0;
    if (!S.next(0, cur)) return;
    f32x4 acc[2][2][4][2];
#pragma unroll
    for (int a = 0; a < 2; ++a)
#pragma unroll
        for (int b = 0; b < 2; ++b)
#pragma unroll
            for (int m = 0; m < 4; ++m)
#pragma unroll
                for (int n = 0; n < 2; ++n) acc[a][b][m][n] = (f32x4){0.f, 0.f, 0.f, 0.f};
    bf16x8 At[4][2], B0[2][2], B1[2][2];
    const char* cA = (const char*)g.A + (size_t)cur.pm * tstep; const char* cB = (const char*)g.Bt + (size_t)cur.pn * tstep;
    S.a_ready(cur);
    if constexpr (SP2) {
        PG8_STAGE(PG8_SB(0, 0), cB, voffB); PG8_STAGE(PG8_SB(0, 1), cB + hstep, voffB); PG8_STAGE(PG8_SA(0, 0), cA, voffA); PG8_STAGE(PG8_SA(0, 1), cA + hstep, voffA);
        if (wr == 1) PG8_BAR;
        PG8_WAIT_V(2); PG8_BAR;
        PG8_STAGE(PG8_SB(1, 0), cB + kstep, voffB); PG8_STAGE(PG8_SA(1, 0), cA + kstep, voffA); PG8_STAGE(PG8_SB(1, 1), cB + hstep + kstep, voffB);
        PG8_WAIT_V(6); PG8_BAR;
    } else {
        PG8_STAGE(PG8_SB(0, 0), cB, voffB); PG8_STAGE(PG8_SA(0, 0), cA, voffA); PG8_STAGE(PG8_SB(0, 1), cB + hstep, voffB); PG8_STAGE(PG8_SA(0, 1), cA + hstep, voffA);
        if (wr == 1) PG8_BAR;
        PG8_WAIT_V(4); PG8_BAR;
        PG8_STAGE(PG8_SB(1, 0), cB + kstep, voffB); PG8_STAGE(PG8_SA(1, 0), cA + kstep, voffA); PG8_STAGE(PG8_SB(1, 1), cB + hstep + kstep, voffB);
        PG8_WAIT_V(6); PG8_BAR;
    }
    for (;;) {
        const bool has_next = S.next(ui + 1, nxt);
        const char* nA = has_next ? (const char*)g.A + (size_t)nxt.pm * tstep : cA; const char* nB = has_next ? (const char*)g.Bt + (size_t)nxt.pn * tstep : cB;
        for (int t = 0; t < nt; t += 2) {
            const bool last = (t == nt - 2);
            const char* a1 = cA + (size_t)(t + 1) * kstep;
            const char* a2 = last ? nA : cA + (size_t)(t + 2) * kstep; const char* b2 = last ? nB : cB + (size_t)(t + 2) * kstep;
            const char* a3 = a2 + kstep; const char* b3 = b2 + kstep;
            if (last && has_next) S.a_ready(nxt);
            if constexpr (SP2) {
            PG8_LDB(B0, 0, 0); PG8_LDB(B1, 0, 1); PG8_SCHED; PG8_LDA(At, 0, 0); PG8_STAGE(PG8_SA(1, 1), a1 + hstep, voffA);
            PG8_WAIT_V(8); PG8_WAIT_L(0); PG8_BAR; PG8_MMA(0, 0, At, B0); PG8_MMA(0, 1, At, B1); PG8_BAR; PG8_SCHED;
            PG8_LDA(At, 0, 1); PG8_STAGE(PG8_SB(0, 0), b2, voffB); PG8_STAGE(PG8_SB(0, 1), b2 + hstep, voffB); PG8_STAGE(PG8_SA(0, 0), a2, voffA);
            PG8_WAIT_V(8); PG8_WAIT_L(0); PG8_BAR; PG8_MMA(1, 0, At, B0); PG8_MMA(1, 1, At, B1); PG8_BAR; PG8_SCHED;
            PG8_LDB(B0, 1, 0); PG8_LDB(B1, 1, 1); PG8_SCHED; PG8_LDA(At, 1, 0); PG8_STAGE(PG8_SA(0, 1), a2 + hstep, voffA);
            PG8_WAIT_V(8); PG8_WAIT_L(0); PG8_BAR; PG8_MMA(0, 0, At, B0); PG8_MMA(0, 1, At, B1); PG8_BAR; PG8_SCHED;
            PG8_LDA(At, 1, 1); PG8_STAGE(PG8_SB(1, 0), b3, voffB); PG8_STAGE(PG8_SB(1, 1), b3 + hstep, voffB); PG8_STAGE(PG8_SA(1, 0), a3, voffA);
            PG8_WAIT_V(8); PG8_WAIT_L(0); PG8_BAR; PG8_MMA(1, 0, At, B0); PG8_MMA(1, 1, At, B1); PG8_BAR; PG8_SCHED;
            } else {
            PG8_LDB(B0, 0, 0); PG8_SCHED; PG8_LDA(At, 0, 0); PG8_STAGE(PG8_SA(1, 1), a1 + hstep, voffA);
            PG8_WAIT_L(8); PG8_BAR; PG8_WAIT_L(0); PG8_MMA(0, 0, At, B0); PG8_BAR; PG8_SCHED;
            PG8_LDB(B1, 0, 1); PG8_STAGE(PG8_SB(0, 0), b2, voffB);
            PG8_BAR; PG8_WAIT_L(0); PG8_MMA(0, 1, At, B1); PG8_BAR;
            PG8_LDA(At, 0, 1); PG8_STAGE(PG8_SA(0, 0), a2, voffA);
            PG8_BAR; PG8_WAIT_L(0); PG8_MMA(1, 0, At, B0); PG8_BAR; PG8_SCHED;
            PG8_STAGE(PG8_SB(0, 1), b2 + hstep, voffB);
            PG8_WAIT_V(6); PG8_BAR; PG8_MMA(1, 1, At, B1); PG8_BAR;
            PG8_LDB(B0, 1, 0); PG8_SCHED; PG8_LDA(At, 1, 0); PG8_STAGE(PG8_SA(0, 1), a2 + hstep, voffA);
            PG8_WAIT_L(8); PG8_BAR; PG8_WAIT_L(0); PG8_MMA(0, 0, At, B0); PG8_BAR; PG8_SCHED;
            PG8_LDB(B1, 1, 1); PG8_STAGE(PG8_SB(1, 0), b3, voffB);
            PG8_BAR; PG8_WAIT_L(0); PG8_MMA(0, 1, At, B1); PG8_BAR;
            PG8_LDA(At, 1, 1); PG8_STAGE(PG8_SA(1, 0), a3, voffA);
            PG8_BAR; PG8_WAIT_L(0); PG8_MMA(1, 0, At, B0); PG8_BAR; PG8_SCHED;
            PG8_STAGE(PG8_SB(1, 1), b3 + hstep, voffB);
            PG8_WAIT_V(6); PG8_BAR; PG8_MMA(1, 1, At, B1); PG8_BAR;
            }
        }
        if constexpr (ALIGN_EPI) { if (wr == 0) PG8_BAR; }
        if constexpr (!Epi::AFTER_DRAIN) { E(acc, cur, wr, wc, fr, fq); S.done(cur); }
        if (!has_next) break;
#pragma unroll
        for (int a = 0; a < 2; ++a)
#pragma unroll
            for (int b = 0; b < 2; ++b)
#pragma unroll
                for (int m = 0; m < 4; ++m)
#pragma unroll
                    for (int n = 0; n < 2; ++n) acc[a][b][m][n] = (f32x4){0.f, 0.f, 0.f, 0.f};
        cur = nxt; cA = nA; cB = nB; ++ui;
        if constexpr (ALIGN_EPI) { if (wr == 1) PG8_BAR; }
    }
    PG8_WAIT_V(0);
    S.flush();
    if constexpr (!ALIGN_EPI) { if (wr == 0) PG8_BAR; }
    PG8_BAR;
    if constexpr (Epi::AFTER_DRAIN) { E.fused(acc, cur, wr, wc, fr, fq, lds, wid, lane); S.done(cur); }
#undef PG8_SA
#undef PG8_SB
#undef PG8_STAGE
#undef PG8_LDA
#undef PG8_LDB
#undef PG8_MMA
#undef PG8_WAIT_V
#undef PG8_WAIT_L
#undef PG8_BAR
#undef PG8_SCHED
}
}

namespace pg8 {
struct EpiSwiglu {
    static constexpr bool PERM = true, AFTER_DRAIN = false;
    bf16_t* O; int ldo; int p0; int nct;
    __device__ __forceinline__ void operator()(const f32x4 (&acc)[2][2][4][2], const Unit& u, int wr, int wc, int fr, int fq) const {
        const int row0 = (u.pm - p0) * BM + wr * 64 + fr, col0 = (u.pn % nct) * HALF + wc * 32 + 8 * fq;
#pragma unroll
        for (int ai = 0; ai < 2; ++ai)
#pragma unroll
            for (int m = 0; m < 4; ++m) { bf16_t* rowp = O + (size_t)(row0 + ai * HALF + m * 16) * ldo + col0;
                float a[8];
#pragma unroll
                for (int n = 0; n < 2; ++n)
#pragma unroll
                    for (int j = 0; j < 4; ++j) { const float g = acc[ai][0][m][n][j], up = acc[ai][1][m][n][j]; a[n * 4 + j] = g * __builtin_amdgcn_rcpf(1.0f + __expf(-g)) * up; }
                u32x4 w; w.x = cvt_pk_bf16(a[0], a[1]); w.y = cvt_pk_bf16(a[2], a[3]); w.z = cvt_pk_bf16(a[4], a[5]); w.w = cvt_pk_bf16(a[6], a[7]);
                *(u32x4*)rowp = w; }
    }
};
struct EpiBf16Mod {
    static constexpr bool PERM = true, AFTER_DRAIN = false;
    bf16_t* O; int ldc; int nct;
    __device__ __forceinline__ void operator()(const f32x4 (&acc)[2][2][4][2], const Unit& u, int wr, int wc, int fr, int fq) const {
        const int row0 = u.pm * BM + wr * 64 + fr, col0 = (u.pn % nct) * BM + wc * 32 + 8 * fq;
#pragma unroll
        for (int ai = 0; ai < 2; ++ai)
#pragma unroll
            for (int m = 0; m < 4; ++m) { bf16_t* rowp = O + (size_t)(row0 + ai * HALF + m * 16) * ldc + col0;
#pragma unroll
                for (int bj = 0; bj < 2; ++bj) { const f32x4 v0 = acc[ai][bj][m][0], v1 = acc[ai][bj][m][1];
                    u32x4 w; w.x = cvt_pk_bf16(v0[0], v0[1]); w.y = cvt_pk_bf16(v0[2], v0[3]); w.z = cvt_pk_bf16(v1[0], v1[1]); w.w = cvt_pk_bf16(v1[2], v1[3]);
                    *(u32x4*)(rowp + bj * HALF) = w; } }
    }
};
struct MoeOrder {
    int p0, np, nct, G, c; int pb[9];
    __device__ __forceinline__ bool next(int i, Unit& u) const {
        const int L = i * G + c; if (L >= np * nct) return false;
        const int nig = WGM * nct, gid = L / nig, fm = gid * WGM, gsz = (np - fm) < WGM ? (np - fm) : WGM, r = L % nig;
        const int pm = p0 + fm + (r % gsz), ct = r / gsz;
        int e = 0;
#pragma unroll
        for (int j = 1; j < 8; ++j) e += (pm >= pb[j]) ? 1 : 0;
        u.pm = pm; u.pn = e * nct + ct; return true;
    }
    __device__ __forceinline__ void a_ready(const Unit&) const {}
    __device__ __forceinline__ void done(const Unit&) const {}
    __device__ __forceinline__ void flush() const {}
};
#ifndef WT_AUX
#define WT_AUX 16
#endif
struct EpiBf16WT {
    static constexpr bool PERM = true, AFTER_DRAIN = false;
    bf16_t* O; int ldc; int nct;
    __device__ __forceinline__ void operator()(const f32x4 (&acc)[2][2][4][2], const Unit& u, int wr, int wc, int fr, int fq) const {
        const __amdgpu_buffer_rsrc_t rs = __builtin_amdgcn_make_buffer_rsrc(O, 0, 0x7ffffff0, 0x00020000);
        const unsigned row0 = (unsigned)(u.pm * BM + wr * 64 + fr), col0 = (unsigned)((u.pn % nct) * BM + wc * 32 + 8 * fq);
#pragma unroll
        for (int ai = 0; ai < 2; ++ai)
#pragma unroll
            for (int m = 0; m < 4; ++m) { const unsigned off = ((row0 + (unsigned)(ai * HALF + m * 16)) * (unsigned)ldc + col0) * 2u;
#pragma unroll
                for (int bj = 0; bj < 2; ++bj) { const f32x4 v0 = acc[ai][bj][m][0], v1 = acc[ai][bj][m][1];
                    u32x4 w; w.x = cvt_pk_bf16(v0[0], v0[1]); w.y = cvt_pk_bf16(v0[2], v0[3]); w.z = cvt_pk_bf16(v1[0], v1[1]); w.w = cvt_pk_bf16(v1[2], v1[3]);
                    __builtin_amdgcn_raw_buffer_store_b128(w, rs, off + (unsigned)(bj * HALF * 2), 0, WT_AUX); } }
    }
};
template <class Base> struct PubOrder : Base {
    unsigned* cntr; mutable int pend;
    __device__ __forceinline__ void pub() const {
        if (pend >= 0) { if (__builtin_amdgcn_mbcnt_hi(~0u, __builtin_amdgcn_mbcnt_lo(~0u, 0u)) == 0u) __hip_atomic_fetch_add(cntr + 16 * pend, 1u, __ATOMIC_RELAXED, __HIP_MEMORY_SCOPE_AGENT); pend = -1; }
    }
    __device__ __forceinline__ void a_ready(const Unit& u) const { Base::a_ready(u); pub(); }
    __device__ __forceinline__ void done(const Unit& u) const {
#ifdef PUB_EAGER
        asm volatile("s_waitcnt vmcnt(0)" ::: "memory"); pend = u.pm; pub();
#else
        pub(); pend = u.pm;
#endif
    }
    __device__ __forceinline__ void flush() const { pub(); }
};
}

constexpr int NWAVES = 8, NTHR = 512;
constexpr int D = 1024, NB = 8, SEQ = 4096, LC = 256, NT = NB * SEQ, NC = NB * LC, MT = NT + NC;
constexpr int DIN = 2944, NZ = 3072;
constexpr int C_K = 0, C_V = 512, C_WLO = 1024, C_ALO = 1152, C_R = 1280, C_GLO = 1792, C_U = 1920, C_GB = 2176, C_GC = 2432, C_F = 2688;
constexpr int DFF = 2816, NE = 8, DFE = 3584;
constexpr float NORM_EPS = 1e-6f, GN_EPS = 64e-5f;
constexpr int TP = 72;
enum { I_X = 0, I_C, I_CTX, I_CCTX, I_ADAW, I_ADAB, I_NORMG, I_WIN, I_WOUT, I_MU, I_MUW, I_MUA, I_W0, I_W2, I_A0, I_A2, I_G2, I_KK, I_KA, I_RK, I_GNW, I_GNB, I_CONVW,
       I_FG, I_FU, I_FD, I_RW, I_RB, I_MG, I_MUP, I_MD, N_IN };

constexpr size_t KiB = 1024, MiB = 1u << 20;
constexpr size_t WS_CTL = 0, CTL_ZERO_BYTES = 512 * KiB;
constexpr size_t WS_MOD = 512 * KiB;
constexpr size_t WS_TAB = 960 * KiB;
constexpr size_t TAB_E = WS_TAB;
constexpr size_t TAB_TWC = TAB_E + 64 * 512 * 4;
constexpr size_t TAB_TWS = TAB_TWC + 4096 * 4;
constexpr size_t TAB_C64 = TAB_TWS + 4096 * 4;
constexpr size_t TAB_S64 = TAB_C64 + 64 * 64 * 2;
constexpr size_t TAB_SN64 = TAB_S64 + 64 * 64 * 2;
constexpr size_t WS_ROUTE = 1152 * KiB;
constexpr size_t WS_TOKPOS = WS_ROUTE + (size_t)NT * 16;
static_assert(TAB_SN64 + 64 * 64 * 2 <= WS_ROUTE && WS_TOKPOS + (size_t)NT * 8 <= 2 * MiB, "low ws map");
constexpr size_t WS_Z = 2 * MiB;
constexpr size_t WS_SW = 206 * MiB;
constexpr size_t WS_WIN = WS_SW;
constexpr size_t WS_WOUT = WS_WIN + 2ull * NZ * D * 2;
constexpr size_t WS_WGU = WS_WOUT + 2ull * D * D * 2;
constexpr size_t WS_WDN = WS_WGU + 2ull * DFF * D * 2;
constexpr size_t WS_G2T = WS_WDN + (size_t)D * DFF * 2;
constexpr size_t WS_C256 = WS_G2T + 2ull * 512 * 128 * 2;
constexpr size_t WS_SN256 = WS_C256 + 256 * 256 * 2;
constexpr size_t WS_W2TG = WS_SN256 + 256 * 256 * 2;
constexpr size_t WS_A2TG = WS_W2TG + 4ull * 512 * 64 * 2;
constexpr size_t WS_XC = 244 * MiB;
static_assert(WS_A2TG + 4ull * 512 * 64 * 2 <= WS_XC, "small weights");
constexpr size_t WS_RING = 252 * MiB;
constexpr size_t WS_O32 = 381 * MiB;
constexpr size_t WS_YS = WS_O32;
constexpr size_t WS_YBUF = WS_YS + 2ull * MT * 512 * 2;
constexpr size_t WS_BONG = WS_YBUF + 32 * MiB;
constexpr size_t WS_H = 517 * MiB;
static_assert(WS_BONG + 2ull * MT * 8 * 4 <= WS_H && WS_Z + (size_t)MT * NZ * 2 <= WS_SW && WS_O32 + (size_t)MT * D * 4 <= WS_H, "ws map");
constexpr size_t WS_NEED = 585 * MiB;
static_assert(WS_H + (size_t)MT * D * 2 <= WS_NEED, "ws map end");
constexpr size_t WS_WMGU = 2 * MiB;
constexpr size_t WS_WMDN = WS_WMGU + 8ull * 2 * DFE * D * 2;
constexpr size_t WS_XG = 170 * MiB;
constexpr int XG_ROWS_CAP = 69632;
constexpr size_t WS_ACTM = 306 * MiB;
static_assert(WS_WMDN + 8ull * D * DFE * 2 <= WS_XG && WS_XG + (size_t)XG_ROWS_CAP * D * 2 <= WS_ACTM, "moe ws map");
constexpr int CW_TMO = 0;
constexpr int CW_CNT = 2048, CW_FILL = 3072;
constexpr int CW_BAR = 8192;
constexpr int MAX_LAUNCHES = 20;
constexpr int CW_PROD = 81920, CW_CONS = 81920 + 8192;
constexpr int CW_PCNT = 114688;
constexpr int PC_WOUT0 = 0, PC_DOWN0 = 2176, PC_WOUT1 = 4352, PC_MOE = 6528;
static_assert(CW_CONS + 16384 + 64 * 128 <= CW_PCNT && (CW_PCNT + PC_MOE + 16 * 272) * 4 <= (int)CTL_ZERO_BYTES, "control words");

constexpr int LDS_BYTES = 163840;
constexpr int MISC_OFF = LDS_BYTES - 256;

#define GAS __attribute__((address_space(1)))
#define LAS __attribute__((address_space(3)))
typedef unsigned short bf16;
typedef unsigned v4u __attribute__((ext_vector_type(4)));
typedef unsigned v2u __attribute__((ext_vector_type(2)));
typedef float f32x4 __attribute__((ext_vector_type(4)));
typedef float f32x2 __attribute__((ext_vector_type(2)));
typedef short bf16x8 __attribute__((ext_vector_type(8)));
typedef short bf16x4 __attribute__((ext_vector_type(4)));
#define LDS_WAIT() asm volatile("s_waitcnt lgkmcnt(0)" ::: "memory")
typedef __bf16 bf16x2n __attribute__((ext_vector_type(2)));
__device__ __forceinline__ unsigned pk2(float lo, float hi) { const f32x2 v = {lo, hi}; return __builtin_bit_cast(unsigned, __builtin_convertvector(v, bf16x2n)); }
__device__ __forceinline__ unsigned f2bf(float f) { return pk2(f, f) & 0xffffu; }
__device__ __forceinline__ float bflo(unsigned w) { return __builtin_bit_cast(float, w << 16); }
__device__ __forceinline__ float bfhi(unsigned w) { return __builtin_bit_cast(float, w & 0xffff0000u); }
__device__ __forceinline__ float bf1(bf16 b) { return __builtin_bit_cast(float, (unsigned)b << 16); }
template <int CTRL> __device__ __forceinline__ float dpp_mov(float v) { return __builtin_bit_cast(float, __builtin_amdgcn_update_dpp(0, __builtin_bit_cast(int, v), CTRL, 0xf, 0xf, true)); }
__device__ __forceinline__ float wave_sum(float v) {
    v += dpp_mov<0xB1>(v); v += dpp_mov<0x4E>(v); v += dpp_mov<0x141>(v); v += dpp_mov<0x140>(v);
    const int b = __builtin_bit_cast(int, v);
    const float s0 = __builtin_bit_cast(float, __builtin_amdgcn_readlane(b, 0)), s1 = __builtin_bit_cast(float, __builtin_amdgcn_readlane(b, 16));
    const float s2 = __builtin_bit_cast(float, __builtin_amdgcn_readlane(b, 32)), s3 = __builtin_bit_cast(float, __builtin_amdgcn_readlane(b, 48));
    return (s0 + s1) + (s2 + s3);
}
__device__ __forceinline__ float sigmoidf_(float x) { return __builtin_amdgcn_rcpf(1.0f + __expf(-x)); }
#define MFMA16(a, b, c) __builtin_amdgcn_mfma_f32_16x16x32_bf16((a), (b), (c), 0, 0, 0)
#define XB_TMO      128
#define XB_XCNT(j)  (256  + 64 * (j))
#define XB_XSUB(j)  (1280 + 64 * (j))
#define XB_XGEN(j)  (2304 + 64 * (j))
#define XB_TOP      3328
#define XB_TOPGEN   3392
#define XCD_BAR_WORDS 3456
#define XB_SPIN_CAP (1u << 18)
#define LAS __attribute__((address_space(3)))

__device__ __forceinline__ unsigned xb_ld(unsigned* p)              { return __hip_atomic_load(p, __ATOMIC_RELAXED, __HIP_MEMORY_SCOPE_AGENT); }
__device__ __forceinline__ unsigned xb_add(unsigned* p, unsigned v) { return __hip_atomic_fetch_add(p, v, __ATOMIC_RELAXED, __HIP_MEMORY_SCOPE_AGENT); }
__device__ __forceinline__ unsigned xb_xcc_id() { return (unsigned)__builtin_amdgcn_s_getreg((3 << 11) | 20) & 0xFu; }
#define XB_SPIN(cond, bar) do { unsigned _sp = 0; while (cond) { __builtin_amdgcn_s_sleep(1); \
    if ((++_sp & 255u) == 0u) { if (xb_ld(&(bar)[XB_TMO])) break; if (_sp > XB_SPIN_CAP) { atomicAdd(&(bar)[XB_TMO], 1u); break; } } } } while (0)

struct XcdBarrier {
    unsigned w0;
    unsigned* bar; unsigned x;
    volatile LAS unsigned* st;
};

__device__ __forceinline__ bool xb_lane0() { return __builtin_amdgcn_mbcnt_hi(~0u, __builtin_amdgcn_mbcnt_lo(~0u, 0u)) == 0u; }
__device__ __forceinline__ XcdBarrier xcd_barrier_post(unsigned* bar, volatile LAS unsigned* st, unsigned w0) {
    XcdBarrier b; b.w0 = w0; b.bar = bar; b.x = xb_xcc_id(); b.st = st;
    if (w0 && xb_lane0()) (void)xb_add(&bar[XB_XCNT(b.x)], 1u);
    return b;
}
__device__ __forceinline__ void xcd_barrier_complete(unsigned* bar, unsigned x, unsigned& nloc, unsigned& nx) {
    const unsigned G = gridDim.x * gridDim.y * gridDim.z;
    unsigned sum, cnt, mine, sp = 0u;
    for (;;) {
        sum = 0u; cnt = 0u; mine = 0u;
#pragma unroll
        for (unsigned j = 0; j < 16; ++j) { const unsigned c = xb_ld(&bar[XB_XCNT(j)]); sum += c; cnt += (c > 0u) ? 1u : 0u; mine = (j == x) ? c : mine; }
        if (sum == G) break;
        __builtin_amdgcn_s_sleep(1);
        if ((++sp & 255u) == 0u) { if (xb_ld(&bar[XB_TMO])) break; if (sp > XB_SPIN_CAP) { atomicAdd(&bar[XB_TMO], 1u); break; } }
    }
    nloc = mine > 0u ? mine : 1u; nx = cnt > 0u ? cnt : 1u;
}

__device__ __forceinline__ void xcd_barrier(const XcdBarrier& b) {
    asm volatile("s_waitcnt vmcnt(0)" ::: "memory");
    __syncthreads();
    if (b.w0 && xb_lane0()) {
        unsigned* bar = b.bar;
        __builtin_amdgcn_s_waitcnt(0);
        unsigned nloc = b.st[0], nx = b.st[1];
        if (nloc == 0u) { xcd_barrier_complete(bar, b.x, nloc, nx); b.st[0] = nloc; b.st[1] = nx; }
        const unsigned old = xb_add(&bar[XB_XSUB(b.x)], 1u);
        const unsigned gen = old / nloc;
        if (old + 1u == (gen + 1u) * nloc) {
            __builtin_amdgcn_fence(__ATOMIC_RELEASE, "agent");
            asm volatile("s_waitcnt vmcnt(0)" ::: "memory");
            const unsigned og = xb_add(&bar[XB_TOP], 1u);
            const unsigned tg = og / nx;
            if (og + 1u == (tg + 1u) * nx) xb_add(&bar[XB_TOPGEN], 1u);
            else XB_SPIN(xb_ld(&bar[XB_TOPGEN]) == tg, bar);
            __builtin_amdgcn_fence(__ATOMIC_ACQUIRE, "agent");
            xb_add(&bar[XB_XGEN(b.x)], 1u);
            asm volatile("s_waitcnt vmcnt(0)" ::: "memory");
        } else {
            XB_SPIN(xb_ld(&bar[XB_XGEN(b.x)]) == gen, bar);
            __builtin_amdgcn_fence(__ATOMIC_ACQUIRE, "agent");
            asm volatile("s_waitcnt vmcnt(0)" ::: "memory");
        }
    }
    __syncthreads();
}


struct Params {
    const float* in[N_IN];
    float* out;
    unsigned char* ws;
    int act_cap_panels;
    int ph_lo, ph_hi, li;
};
static_assert(sizeof(Params) == N_IN * 8 + 8 + 8 + 16, "Params has no padding");

struct Frame {
    LAS unsigned char* lds;
    int tid, lane, wave, G, bx;
};
#define WSP(T, off) ((T*)(P.ws + (off)))

__device__ __forceinline__ void transpose_item(const float* W, int N, bf16* WT, int ldk, int k0, int n0, int out_row0, LAS float* scr, int lane) {
#pragma unroll 8
    for (int i = 0; i < 32; ++i) { const int kk = 2 * i + (lane >> 5); scr[kk * 33 + (lane & 31)] = W[(size_t)(k0 + kk) * N + n0 + (lane & 31)]; }
    LDS_WAIT(); asm volatile("" ::: "memory");
    const int c = lane & 7;
#pragma unroll
    for (int j = 0; j < 4; ++j) { const int n = (lane >> 3) + 8 * j; const LAS float* s = scr + (8 * c) * 33 + n;
        v4u o; o.x = pk2(s[0 * 33], s[1 * 33]); o.y = pk2(s[2 * 33], s[3 * 33]); o.z = pk2(s[4 * 33], s[5 * 33]); o.w = pk2(s[6 * 33], s[7 * 33]);
        *(v4u*)(WT + (size_t)(out_row0 + n) * ldk + k0 + 8 * c) = o; }
    LDS_WAIT(); asm volatile("" ::: "memory");
}
__device__ __forceinline__ int gu_row(int n, int up) { return (n >> 7) * 256 + up * 128 + (n & 127); }

__device__ __forceinline__ void p0_small_weights(const Params& P, const Frame& F) {
    LAS float* scr = (LAS float*)(F.lds + F.wave * 16384);
    const int gw = F.bx * NWAVES + F.wave, NGW = F.G * NWAVES;
    constexpr int I_IN = 16 * 92, I_OUT = 16 * 32, I_GU = 16 * 88, I_DN = 44 * 32, I_GT = 2 * 16, I_LR = 16;
    constexpr int NITEMS = 2 * I_IN + 2 * I_OUT + 2 * I_GU + I_DN + 2 * I_GT + 8 * I_LR;
    for (int it = gw; it < NITEMS; it += NGW) {
        int r = it;
        if (r < 2 * I_IN) { const int l = r / I_IN; r %= I_IN; const int kb = r / 92, nb = r % 92;
            transpose_item(P.in[I_WIN] + (size_t)l * D * DIN, DIN, WSP(bf16, WS_WIN) + (size_t)l * NZ * D, D, 64 * kb, 32 * nb, 32 * nb, scr, F.lane); continue; } r -= 2 * I_IN;
        if (r < 2 * I_OUT) { const int l = r / I_OUT; r %= I_OUT; const int kb = r / 32, nb = r % 32;
            transpose_item(P.in[I_WOUT] + (size_t)l * D * D, D, WSP(bf16, WS_WOUT) + (size_t)l * D * D, D, 64 * kb, 32 * nb, 32 * nb, scr, F.lane); continue; } r -= 2 * I_OUT;
        if (r < 2 * I_GU) { const int up = r / I_GU; r %= I_GU; const int kb = r / 88, nb = r % 88;
            transpose_item(P.in[up ? I_FU : I_FG], DFF, WSP(bf16, WS_WGU), D, 64 * kb, 32 * nb, gu_row(32 * nb, up), scr, F.lane); continue; } r -= 2 * I_GU;
        if (r < I_DN) { const int kb = r / 32, nb = r % 32;
            transpose_item(P.in[I_FD], D, WSP(bf16, WS_WDN), DFF, 64 * kb, 32 * nb, 32 * nb, scr, F.lane); continue; } r -= I_DN;
        if (r < 2 * I_GT) { const int l = r / I_GT; r %= I_GT; const int kb = r / 16, nb = r % 16;
            transpose_item(P.in[I_G2] + (size_t)l * 128 * 512, 512, WSP(bf16, WS_G2T) + (size_t)l * 512 * 128, 128, 64 * kb, 32 * nb, 32 * nb, scr, F.lane); continue; } r -= 2 * I_GT;
        { const int which = r / (4 * I_LR); r %= 4 * I_LR; const int ldi = r / I_LR, nb = r % I_LR;
            transpose_item(P.in[which ? I_A2 : I_W2] + (size_t)ldi * 64 * 512, 512, WSP(bf16, which ? WS_A2TG : WS_W2TG) + (size_t)ldi * 512 * 64, 64, 0, 32 * nb, 32 * nb, scr, F.lane); }
    }
    { const int gt = F.bx * NTHR + F.tid, NGT = F.G * NTHR; constexpr int NV = 2 * (NZ - DIN) * D / 8;
        for (int i = gt; i < NV; i += NGT) { const int l = i / ((NZ - DIN) * D / 8), r = i % ((NZ - DIN) * D / 8);
            *(v4u*)(WSP(bf16, WS_WIN) + (size_t)l * NZ * D + (size_t)DIN * D + (size_t)r * 8) = (v4u){0u, 0u, 0u, 0u}; } }
}
__device__ __forceinline__ void p0_tables(const Params& P, const Frame& F) {
    const int gt = F.bx * NTHR + F.tid, NGT = F.G * NTHR;
    float* E = WSP(float, TAB_E);
    for (int i = gt; i < 64 * 256; i += NGT) { const int n = i >> 8, q = i & 255;
        const float omega = 1.0f / powf(10000.0f, (float)q / 256.0f), ang = (float)n * omega;
        E[n * 512 + q] = sinf(ang); E[n * 512 + 256 + q] = cosf(ang); }
    float* twc = WSP(float, TAB_TWC); float* tws = WSP(float, TAB_TWS);
    for (int i = gt; i < 4096; i += NGT) { const float a = (float)i / 2048.0f; twc[i] = cospif(a); tws[i] = sinpif(a); }
    bf16* c64 = WSP(bf16, TAB_C64); bf16* s64 = WSP(bf16, TAB_S64); bf16* sn64 = WSP(bf16, TAB_SN64);
    for (int i = gt; i < 64 * 64; i += NGT) { const int m = ((i >> 6) * (i & 63)) & 63; const float a = (float)m / 32.0f; const float c = cospif(a), s = sinpif(a);
        c64[i] = (bf16)f2bf(c); s64[i] = (bf16)f2bf(s); sn64[i] = (bf16)f2bf(-s); }
    bf16* c256 = WSP(bf16, WS_C256); bf16* sn256 = WSP(bf16, WS_SN256);
    for (int i = gt; i < 256 * 256; i += NGT) { const int m = ((i >> 8) * (i & 255)) & 255; const float a = (float)m / 128.0f;
        c256[i] = (bf16)f2bf(cospif(a)); sn256[i] = (bf16)f2bf(-sinpif(a)); }
}
__device__ __forceinline__ void p0_adaln(const Params& P, const Frame& F) {
    LAS float* sc = (LAS float*)F.lds;
    LAS float* red = sc + 9 * 1024;
    for (int u = F.bx; u < 192; u += F.G) {
        const int l = u / 96, cb = u % 96;
        for (int i = F.tid; i < 9 * 1024; i += NTHR) { const int r = i >> 10, d = i & 1023; const float v = r < 8 ? P.in[I_C][r * 1024 + d] : P.in[I_CCTX][d]; sc[i] = v / (1.0f + expf(-v)); }
        __syncthreads();
        const int col = F.tid & 63, ks = F.tid >> 6;
        float acc[9];
#pragma unroll
        for (int r = 0; r < 9; ++r) acc[r] = 0.f;
        const float* w = P.in[I_ADAW] + ((size_t)l * 1024 + ks * 128) * 6144 + cb * 64 + col;
#pragma unroll 2
        for (int k = 0; k < 128; k += 8) {
            float wv[8];
#pragma unroll
            for (int q = 0; q < 8; ++q) wv[q] = w[(size_t)(k + q) * 6144];
#pragma unroll
            for (int r = 0; r < 9; ++r) { const f32x4 s4 = *(const LAS f32x4*)(sc + r * 1024 + ks * 128 + k), s5 = *(const LAS f32x4*)(sc + r * 1024 + ks * 128 + k + 4);
                acc[r] += (s4.x * wv[0] + s4.y * wv[1] + s4.z * wv[2] + s4.w * wv[3]) + (s5.x * wv[4] + s5.y * wv[5] + s5.z * wv[6] + s5.w * wv[7]); }
        }
#pragma unroll
        for (int r = 0; r < 9; ++r) red[(ks * 9 + r) * 64 + col] = acc[r];
        __syncthreads();
        for (int i = F.tid; i < 9 * 64; i += NTHR) { const int r = i >> 6, c = i & 63; float s = 0.f;
#pragma unroll
            for (int k = 0; k < 8; ++k) s += red[(k * 9 + r) * 64 + c];
            WSP(float, WS_MOD)[(size_t)(l * 9 + r) * 6144 + cb * 64 + c] = s + P.in[I_ADAB][l * 6144 + cb * 64 + c]; }
        __syncthreads();
    }
}
__device__ __forceinline__ void convert_moe_weights(const Params& P, const Frame& F) {
    LAS float* scr = (LAS float*)(F.lds + F.wave * 16384);
    const int gw = F.bx * NWAVES + F.wave, NGW = F.G * NWAVES;
    constexpr int I_GU = 16 * 112, I_DN = 56 * 32, NITEMS = NE * (2 * I_GU + I_DN);
    for (int it = gw; it < NITEMS; it += NGW) {
        const int e = it / (2 * I_GU + I_DN); int r = it % (2 * I_GU + I_DN);
        if (r < 2 * I_GU) { const int up = r / I_GU; r %= I_GU; const int kb = r / 112, nb = r % 112;
            transpose_item(P.in[up ? I_MUP : I_MG] + (size_t)e * D * DFE, DFE, WSP(bf16, WS_WMGU) + (size_t)e * 2 * DFE * D, D, 64 * kb, 32 * nb, gu_row(32 * nb, up), scr, F.lane); }
        else { r -= 2 * I_GU; const int kb = r / 32, nb = r % 32;
            transpose_item(P.in[I_MD] + (size_t)e * DFE * D, D, WSP(bf16, WS_WMDN) + (size_t)e * D * DFE, DFE, 64 * kb, 32 * nb, 32 * nb, scr, F.lane); }
    }
}

__device__ __forceinline__ void store_h_row(bf16* hrow, int lane, const f32x4 (&h)[4]) {
#pragma unroll
    for (int j = 0; j < 4; ++j) { v2u w; w.x = pk2(h[j].x, h[j].y); w.y = pk2(h[j].z, h[j].w); *(v2u*)(hrow + 4 * lane + 256 * j) = w; }
}
__device__ __forceinline__ void norm_mod(const f32x4 (&x)[4], int lane, const float* ng, const float* sc, const float* sh, f32x4 (&h)[4]) {
    float ss = 0.f;
#pragma unroll
    for (int j = 0; j < 4; ++j) ss += (x[j].x * x[j].x + x[j].y * x[j].y) + (x[j].z * x[j].z + x[j].w * x[j].w);
    const float rs = rsqrtf(wave_sum(ss) * (1.0f / D) + NORM_EPS);
#pragma unroll
    for (int j = 0; j < 4; ++j) { const int c = 4 * lane + 256 * j; const f32x4 g = *(const f32x4*)(ng + c), s1 = *(const f32x4*)(sc + c), s0 = *(const f32x4*)(sh + c);
        h[j] = (x[j] * rs * g) * (1.0f + s1) + s0; }
}
__device__ __forceinline__ void phase_first_norm(const Params& P, const Frame& F) {
    const int gw = F.bx * NWAVES + F.wave, NGW = F.G * NWAVES, lane = F.lane;
    const float* E = WSP(float, TAB_E); const float* mod = WSP(float, WS_MOD); bf16* H = WSP(bf16, WS_H);
    const float* ng = P.in[I_NORMG];
    f32x4 xn[4];
    auto src = [&](int row) -> const float* { return row < NT ? P.in[I_X] + (size_t)row * D : P.in[I_CTX] + (size_t)(row - NT) * D; };
    if (gw < MT) { const float* xr = src(gw);
#pragma unroll
        for (int j = 0; j < 4; ++j) xn[j] = *(const f32x4*)(xr + 4 * lane + 256 * j); }
    for (int row = gw; row < MT; row += NGW) {
        f32x4 x[4];
#pragma unroll
        for (int j = 0; j < 4; ++j) x[j] = xn[j];
        if (row + NGW < MT) { const float* xr = src(row + NGW);
#pragma unroll
            for (int j = 0; j < 4; ++j) xn[j] = *(const f32x4*)(xr + 4 * lane + 256 * j); }
        int mr = 8;
        if (row < NT) { const int p = row & (SEQ - 1); mr = row >> 12;
#pragma unroll
            for (int j = 0; j < 4; ++j) { const int c = 4 * lane + 256 * j; const float* e = (j < 2) ? (E + (p >> 6) * 512 + c) : (E + (p & 63) * 512 + (c - 512));
                x[j] = x[j] + *(const f32x4*)e; }
        }
        const float* m = mod + (size_t)(0 * 9 + mr) * 6144;
        f32x4 h[4]; norm_mod(x, lane, ng, m + 1024, m, h);
        store_h_row(H + (size_t)row * D, lane, h);
    }
}
__device__ __forceinline__ v2u ld8_agent(const void* p) { return __builtin_bit_cast(v2u, __hip_atomic_load((const unsigned long long*)p, __ATOMIC_RELAXED, __HIP_MEMORY_SCOPE_AGENT)); }
template <int MODE, bool NEXT, bool ROUTE, bool FIRST = false>
__device__ __forceinline__ void phase_post(const Params& P, const Frame& F, int nrows, int l, int goff, int ngp_idx, const float* xc_src, int ln, int ngn_idx, int scoff, int shoff,
                                           const unsigned* pcnt, unsigned need, int nbusy) {
    if (F.bx < nbusy) return;
    const int gw = (F.bx - nbusy) * NWAVES + F.wave, NGW = (F.G - nbusy) * NWAVES, lane = F.lane;
    const float* mod = WSP(float, WS_MOD); bf16* H = WSP(bf16, WS_H); const bf16* O32 = WSP(bf16, WS_O32);
    const float* ngp = P.in[I_NORMG] + (size_t)(l * 4 + ngp_idx) * D;
    const float* ngn = P.in[I_NORMG] + (size_t)(ln * 4 + ngn_idx) * D;
    int cnt[NE];
#pragma unroll
    for (int e = 0; e < NE; ++e) cnt[e] = 0;
    v2u on0[4], on1[4]; f32x4 xnx[4]; float pn0 = 0.f, pn1 = 0.f;
    auto xsrc = [&](int row) -> const float* { return row < NT ? ((FIRST ? P.in[I_X] : (const float*)P.out) + (size_t)row * D) : (xc_src + (size_t)(row - NT) * D); };
    auto fetch = [&](int row) {
        if (MODE == 0) {
#pragma unroll
            for (int j = 0; j < 4; ++j) on0[j] = ld8_agent(O32 + (size_t)row * D + 4 * lane + 256 * j);
        } else {
            const int4 rt = *(const int4*)(P.ws + WS_ROUTE + (size_t)row * 16); const int2 tp = *(const int2*)(P.ws + WS_TOKPOS + (size_t)row * 8);
            pn0 = __builtin_bit_cast(float, rt.y); pn1 = __builtin_bit_cast(float, rt.z);
            const bf16* y0 = WSP(bf16, WS_XG) + (size_t)tp.x * D; const bf16* y1 = WSP(bf16, WS_XG) + (size_t)tp.y * D;
#pragma unroll
            for (int j = 0; j < 4; ++j) { on0[j] = ld8_agent(y0 + 4 * lane + 256 * j); on1[j] = ld8_agent(y1 + 4 * lane + 256 * j); }
        }
        const float* xs = xsrc(row);
#pragma unroll
        for (int j = 0; j < 4; ++j) xnx[j] = *(const f32x4*)(xs + 4 * lane + 256 * j);
    };
    for (int rbase = gw; rbase < nrows; rbase += 64 * NGW) {
    const int myrow = rbase + lane * NGW; const bool valid = myrow < nrows;
    const unsigned* w0 = pcnt; const unsigned* w1 = pcnt;
    if (valid) { if (MODE == 0) { w0 = w1 = pcnt + 16 * (myrow >> 8); } else { const int2 tp = *(const int2*)(P.ws + WS_TOKPOS + (size_t)myrow * 8); w0 = pcnt + 16 * (tp.x >> 8); w1 = pcnt + 16 * (tp.y >> 8); } }
    unsigned long long rem = __ballot(valid); unsigned spins = 0;
    while (rem) {
        bool rdy = false;
        if ((rem >> lane) & 1ull) { rdy = __hip_atomic_load(w0, __ATOMIC_RELAXED, __HIP_MEMORY_SCOPE_AGENT) >= need; if (MODE != 0) rdy = rdy && __hip_atomic_load(w1, __ATOMIC_RELAXED, __HIP_MEMORY_SCOPE_AGENT) >= need; }
        unsigned long long now = __ballot(rdy);
        if (!now) {
            __builtin_amdgcn_s_sleep(4);
            if (++spins <= (1u << 16)) continue;
            if (lane == 0) { unsigned* tmo = WSP(unsigned, WS_CTL) + CW_TMO; __hip_atomic_store(tmo, 1u, __ATOMIC_RELAXED, __HIP_MEMORY_SCOPE_AGENT); __hip_atomic_fetch_max(tmo + 1, 0xB00u, __ATOMIC_RELAXED, __HIP_MEMORY_SCOPE_AGENT); }
            now = rem;
        }
        asm volatile("" ::: "memory");
        rem &= ~now;
        int kcur = __ffsll((long long)now) - 1; now &= now - 1ull;
        fetch(rbase + kcur * NGW);
    for (;;) {
        const int row = rbase + kcur * NGW;
        const int knext = now ? (__ffsll((long long)now) - 1) : -1; now &= now - 1ull;
        const int mr = row < NT ? (row >> 12) : 8;
        f32x4 o[4], xin[4];
#pragma unroll
        for (int j = 0; j < 4; ++j) { xin[j] = xnx[j];
            if (FIRST && row < NT) { const int p = row & (SEQ - 1), c = 4 * lane + 256 * j; const float* e = (j < 2) ? (WSP(float, TAB_E) + (p >> 6) * 512 + c) : (WSP(float, TAB_E) + (p & 63) * 512 + (c - 512)); xin[j] = xin[j] + *(const f32x4*)e; }
            if (MODE == 0) o[j] = (f32x4){bflo(on0[j].x), bfhi(on0[j].x), bflo(on0[j].y), bfhi(on0[j].y)};
            else o[j] = (f32x4){pn0 * bflo(on0[j].x) + pn1 * bflo(on1[j].x), pn0 * bfhi(on0[j].x) + pn1 * bfhi(on1[j].x), pn0 * bflo(on0[j].y) + pn1 * bflo(on1[j].y), pn0 * bfhi(on0[j].y) + pn1 * bfhi(on1[j].y)}; }
        if (knext >= 0) fetch(rbase + knext * NGW);
        float ss = 0.f;
#pragma unroll
        for (int j = 0; j < 4; ++j) ss += (o[j].x * o[j].x + o[j].y * o[j].y) + (o[j].z * o[j].z + o[j].w * o[j].w);
        const float rs = rsqrtf(wave_sum(ss) * (1.0f / D) + NORM_EPS);
        float* xd = row < NT ? (P.out + (size_t)row * D) : (WSP(float, WS_XC) + (size_t)(row - NT) * D);
        const float* m = mod + (size_t)(l * 9 + mr) * 6144;
        f32x4 x[4];
#pragma unroll
        for (int j = 0; j < 4; ++j) { const int c = 4 * lane + 256 * j; const f32x4 g = *(const f32x4*)(m + goff + c), n = *(const f32x4*)(ngp + c);
            x[j] = xin[j] + g * (o[j] * rs * n); *(f32x4*)(xd + c) = x[j]; }
        if (NEXT) {
            const float* mn = mod + (size_t)(ln * 9 + mr) * 6144;
            f32x4 h[4]; norm_mod(x, lane, ngn, mn + scoff, mn + shoff, h);
            store_h_row(H + (size_t)row * D, lane, h);
            if (ROUTE) {
                float lg[NE];
#pragma unroll
                for (int e = 0; e < NE; ++e) lg[e] = 0.f;
                const float* rw = P.in[I_RW];
#pragma unroll
                for (int j = 0; j < 4; ++j)
#pragma unroll
                    for (int q = 0; q < 4; ++q) { const int c = 4 * lane + 256 * j + q; const f32x4 w0 = *(const f32x4*)(rw + c * 8), w1 = *(const f32x4*)(rw + c * 8 + 4); const float hv = h[j][q];
                        lg[0] += hv * w0.x; lg[1] += hv * w0.y; lg[2] += hv * w0.z; lg[3] += hv * w0.w; lg[4] += hv * w1.x; lg[5] += hv * w1.y; lg[6] += hv * w1.z; lg[7] += hv * w1.w; }
#pragma unroll
                for (int e = 0; e < NE; ++e) lg[e] = wave_sum(lg[e]) + P.in[I_RB][e];
                int i0 = 0; float v0 = lg[0];
#pragma unroll
                for (int e = 1; e < NE; ++e) if (lg[e] > v0) { v0 = lg[e]; i0 = e; }
                int i1 = -1; float v1 = -3.0e38f;
#pragma unroll
                for (int e = 0; e < NE; ++e) if (e != i0 && lg[e] > v1) { v1 = lg[e]; i1 = e; }
                const float e1 = expf(v1 - v0), p0 = 1.0f / (1.0f + e1), p1 = e1 / (1.0f + e1);
                if (lane == 0) *(int4*)(P.ws + WS_ROUTE + (size_t)row * 16) = make_int4(i0 | (i1 << 8), __builtin_bit_cast(int, p0), __builtin_bit_cast(int, p1), 0);
#pragma unroll
                for (int e = 0; e < NE; ++e) cnt[e] += (e == i0 || e == i1) ? 1 : 0;
            }
        }
        if (knext < 0) break;
        kcur = knext;
    }
    }
    }
    if (ROUTE) {
        if (lane == 0) {
#pragma unroll
            for (int e = 0; e < NE; ++e) if (cnt[e]) __hip_atomic_fetch_add(WSP(unsigned, WS_CTL) + CW_CNT + 64 * e, (unsigned)cnt[e], __ATOMIC_RELAXED, __HIP_MEMORY_SCOPE_AGENT);
        }
    }
}

constexpr int TB = 64;
typedef short bf16x4s __attribute__((ext_vector_type(4)));
#define MFMA16K(a, b, c) __builtin_amdgcn_mfma_f32_16x16x16bf16_1k((a), (b), (c), 0, 0, 0)
__device__ __forceinline__ float fexp(float x) { return __builtin_amdgcn_exp2f(x * 1.44269504089f); }
__device__ __forceinline__ float flog(float x) { return __builtin_amdgcn_logf(x) * 0.69314718056f; }
__device__ __forceinline__ float frcp(float x) { return __builtin_amdgcn_rcpf(x); }
__device__ __forceinline__ float softplusf_(float x) { return fmaxf(x, 0.f) + flog(1.0f + fexp(-fabsf(x))); }
__device__ __forceinline__ float ftanh(float x) { return 1.0f - 2.0f * frcp(1.0f + fexp(2.0f * x)); }
__device__ __forceinline__ f32x4 ld4bf(const bf16* p) { const v2u w = *(const v2u*)p; return (f32x4){bflo(w.x), bfhi(w.x), bflo(w.y), bfhi(w.y)}; }
template <int CTRL> __device__ __forceinline__ float dppf(float v) { return __builtin_bit_cast(float, __builtin_amdgcn_update_dpp(0, __builtin_bit_cast(int, v), CTRL, 0xf, 0xf, true)); }
__device__ __forceinline__ float sum8(float v) { v += dppf<0xB1>(v); v += dppf<0x4E>(v); v += dppf<0x141>(v); return v; }
__device__ __forceinline__ bf16x4s pack4(f32x4 v) { v2u w; w.x = pk2(v.x, v.y); w.y = pk2(v.z, v.w); return __builtin_bit_cast(bf16x4s, w); }
__device__ __forceinline__ void unpack8(v4u w, float (&o)[8]) {
#pragma unroll
    for (int q = 0; q < 4; ++q) { o[2 * q] = bflo(w[q]); o[2 * q + 1] = bfhi(w[q]); } }
__device__ __forceinline__ v4u pack8(const float (&o)[8]) { v4u w;
#pragma unroll
    for (int q = 0; q < 4; ++q) w[q] = pk2(o[2 * q], o[2 * q + 1]);
    return w; }
struct ScanPre { v4u kc, kp, vc, vp, rc, rp, wc, wp, ac, ap; };
__device__ __forceinline__ int scan_row(int bi, int tk, int b, int dir, bool& hp, int& prow) {
    const int seq = bi >= LC / TB, c = seq ? bi - LC / TB : bi, len = seq ? SEQ : LC, rowbase = seq ? b * SEQ : NT + b * LC;
    const int ts = c * TB + tk, t = dir ? (len - 1 - ts) : ts;
    hp = dir ? (t + 1 < len) : (t > 0);
    prow = rowbase + (hp ? (dir ? t + 1 : t - 1) : t);
    return rowbase + t;
}
__device__ __forceinline__ void scan_prefetch(const bf16* Z, int bi, int tk, int b, int dir, int gc, int c8, ScanPre& R) {
    bool hp; int prow; const int row = scan_row(bi, tk, b, dir, hp, prow);
    const bf16* zrk = Z + (size_t)row * NZ + gc; const bf16* zpk = Z + (size_t)prow * NZ + gc;
    const bf16* zrw = Z + (size_t)row * NZ + C_WLO + 64 * dir + c8; const bf16* zpw = Z + (size_t)prow * NZ + C_WLO + 64 * dir + c8;
    R.kc = *(const v4u*)(zrk + C_K); R.vc = *(const v4u*)(zrk + C_V); R.rc = *(const v4u*)(zrk + C_R); R.wc = *(const v4u*)(zrw); R.ac = *(const v4u*)(zrw + (C_ALO - C_WLO));
    R.kp = *(const v4u*)(zpk + C_K); R.vp = *(const v4u*)(zpk + C_V); R.rp = *(const v4u*)(zpk + C_R); R.wp = *(const v4u*)(zpw); R.ap = *(const v4u*)(zpw + (C_ALO - C_WLO));
}
__device__ __forceinline__ void lerp8(v4u cur, v4u prv, bool hp, const LAS float* mu, float (&o)[8]) {
    if (!hp) prv = (v4u){0u, 0u, 0u, 0u};
    const f32x4 m0 = *(const LAS f32x4*)mu, m1 = *(const LAS f32x4*)(mu + 4);
#pragma unroll
    for (int q = 0; q < 4; ++q) {
        const f32x2 c2 = {bflo(cur[q]), bfhi(cur[q])}, p2 = {bflo(prv[q]), bfhi(prv[q])};
        const f32x2 m2 = q < 2 ? (f32x2){m0[2 * q], m0[2 * q + 1]} : (f32x2){m1[2 * q - 4], m1[2 * q - 3]};
        const f32x2 r2 = c2 + (p2 - c2) * m2;
        o[2 * q] = r2.x; o[2 * q + 1] = r2.y; }
}
#define RLX_AGENT __ATOMIC_RELAXED, __HIP_MEMORY_SCOPE_AGENT
typedef GAS unsigned gu32;
constexpr unsigned kSpinCap = 1u << 17;
__device__ __forceinline__ bool wait_ge(gu32* word, unsigned want, gu32* tmo, unsigned code, int lane) {
    for (unsigned spins = 0;;) {
        if ((unsigned)__builtin_amdgcn_readfirstlane(__hip_atomic_load(word, RLX_AGENT)) >= want) return true;
        __builtin_amdgcn_s_sleep(1);
        if (++spins > kSpinCap) { if (lane == 0) { __hip_atomic_store(tmo, 1u, RLX_AGENT); __hip_atomic_fetch_max(tmo + 1, code, RLX_AGENT); } return false; }
        if ((spins & 255u) == 0u && __builtin_amdgcn_readfirstlane(__hip_atomic_load(tmo, RLX_AGENT))) return false;
    }
}
constexpr int XFER_PIECES = 3264, XFER_SLOT_BYTES = 52480, XFER_SLOTS = 6;
static_assert(WS_RING + 128ull * XFER_SLOTS * XFER_SLOT_BYTES <= WS_O32, "hand-off rings fit below the O buffer");
__device__ __forceinline__ int xfer_lds_off(int i) { return i < 1536 ? 20992 + 16 * i : (i < 2688 ? 45568 + 16 * (i - 1536) : 102912 + 16 * (i - 2688)); }
__device__ __forceinline__ void scan_unit(const Params& P, const Frame& F, int l, int b, int h, int dir, int role) {
    LAS unsigned char* L0 = F.lds;
    LAS bf16* W2T = (LAS bf16*)L0;
    LAS bf16* A2T = (LAS bf16*)(L0 + 9216);
    LAS float* CST = (LAS float*)(L0 + 18432);
    LAS bf16* TWb = (LAS bf16*)(L0 + 20992);
    LAS bf16* ALb = TWb + TB * TP;
    LAS bf16* BH = (LAS bf16*)(L0 + 20992);
    LAS bf16* KH = BH + 4 * 64 * 16;
    LAS bf16* Vt = KH + 4 * 64 * 16;
    LAS float* LW = (LAS float*)(L0 + 45568);
    constexpr int LWP = 68;
    LAS float* LA = LW + TB * LWP;
    LAS bf16* AT = (LAS bf16*)(L0 + 45568);
    LAS bf16* RT = AT + TB * TP; LAS bf16* BT = RT + TB * TP; LAS bf16* KT = BT + TB * TP;
    LAS float* CUM = (LAS float*)(L0 + 82432);
    LAS float* LabF = (LAS float*)(L0 + 98816);
    LAS bf16* LakB = (LAS bf16*)(L0 + 102912);
    LAS bf16* TtB = LakB + 1024; LAS bf16* MrbB = TtB + 1024; LAS bf16* MrkB = MrbB + 1024;
    LAS float* PCb = (LAS float*)(L0 + 111104);
    LAS float* YB = (LAS float*)(L0 + 112128);
    LAS float* BONl = (LAS float*)(L0 + 128512);
    const int tid = F.tid, lane = F.lane, w = F.wave, fr = lane & 15, fq = lane >> 4;
    const int tk = tid >> 3, c8 = (tid & 7) * 8, gc = 64 * h + c8;
    const int ld = l * 2 + dir;
    for (int i = tid; i < 4096; i += NTHR) { const int j = i >> 6, c = i & 63;
        W2T[c * TP + j] = (bf16)f2bf(P.in[I_W2][((size_t)ld * 64 + j) * 512 + 64 * h + c]); A2T[c * TP + j] = (bf16)f2bf(P.in[I_A2][((size_t)ld * 64 + j) * 512 + 64 * h + c]); }
    if (tid < 64) { const int c = 64 * h + tid;
        CST[0 * 64 + tid] = P.in[I_MU][(size_t)(ld * 3 + 0) * 512 + c]; CST[1 * 64 + tid] = P.in[I_MU][(size_t)(ld * 3 + 1) * 512 + c]; CST[2 * 64 + tid] = P.in[I_MU][(size_t)(ld * 3 + 2) * 512 + c];
        CST[3 * 64 + tid] = P.in[I_MUW][ld * 64 + tid]; CST[4 * 64 + tid] = P.in[I_MUA][ld * 64 + tid];
        CST[5 * 64 + tid] = P.in[I_W0][ld * 512 + c]; CST[6 * 64 + tid] = P.in[I_A0][ld * 512 + c];
        CST[7 * 64 + tid] = P.in[I_KK][l * 512 + c]; CST[8 * 64 + tid] = P.in[I_KA][l * 512 + c]; CST[9 * 64 + tid] = P.in[I_RK][l * 512 + c]; }
    const bf16* Z = WSP(bf16, WS_Z);
    bf16* YS = WSP(bf16, WS_YS) + (size_t)dir * MT * 512;
    float* BONG = WSP(float, WS_BONG) + (size_t)dir * MT * 8;
    f32x4 St[4];
#pragma unroll
    for (int kt = 0; kt < 4; ++kt) St[kt] = (f32x4){0.f, 0.f, 0.f, 0.f};
    constexpr int NBT = LC / TB + SEQ / TB;
    const int sid = (b * 8 + h) * 2 + dir;
    gu32* ctlw = (gu32*)WSP(unsigned, WS_CTL);
    gu32* prodw = ctlw + CW_PROD + l * 16384 + 64 * sid; gu32* consw = ctlw + CW_CONS + l * 16384 + 64 * sid;
    unsigned char* ring = P.ws + WS_RING + (size_t)sid * (XFER_SLOTS * XFER_SLOT_BYTES);
    v4u XR[7];
    ScanPre R; scan_prefetch(Z, role == 1 ? 1 : 0, tk, b, dir, gc, c8, R);
    __syncthreads();
    for (int bi = (role == 1 ? 1 : 0); bi < NBT; ++bi) {
        const bool mine = (role == 2) || ((bi % 2 == 0) == (role == 0));
        if (role == 1 && !mine) continue;
        const int hj = bi >> 1;
        const int bstep = role == 2 ? 1 : 2;
        const bool need_out = (bi >= LC / TB) || (l == 0);
        bool hp; int prow; const int row = scan_row(bi, tk, b, dir, hp, prow); (void)prow;
#ifdef PROBE_PREP2
        for (int prb_ = 0; prb_ < 2; ++prb_)
#endif
        if (mine) {
        if (role == 1 && hj >= XFER_SLOTS) { if (w == 0) wait_ge(consw, (unsigned)(hj - XFER_SLOTS + 1), ctlw + CW_TMO, 0x900u, lane); __syncthreads(); }
        float kx[8], vx[8], rx[8];
        { float wl[8], al[8];
          lerp8(R.kc, R.kp, hp, CST + 0 * 64 + c8, kx); lerp8(R.vc, R.vp, hp, CST + 1 * 64 + c8, vx); lerp8(R.rc, R.rp, hp, CST + 2 * 64 + c8, rx);
          lerp8(R.wc, R.wp, hp, CST + 3 * 64 + c8, wl); lerp8(R.ac, R.ap, hp, CST + 4 * 64 + c8, al);
#pragma unroll
          for (int j = 0; j < 8; ++j) wl[j] = ftanh(wl[j]);
          *(LAS v4u*)(TWb + tk * TP + c8) = pack8(wl); *(LAS v4u*)(ALb + tk * TP + c8) = pack8(al); }
        if (bi + bstep < NBT) scan_prefetch(Z, bi + bstep, tk, b, dir, gc, c8, R);
        __syncthreads();
        { const int mt = w & 3;
          bf16x8 yt[2], ya[2];
#pragma unroll
          for (int k2 = 0; k2 < 2; ++k2) { yt[k2] = *(const LAS bf16x8*)(TWb + (16 * mt + fr) * TP + 32 * k2 + 8 * fq); ya[k2] = *(const LAS bf16x8*)(ALb + (16 * mt + fr) * TP + 32 * k2 + 8 * fq); }
#pragma unroll
          for (int n2 = 0; n2 < 2; ++n2) { const int nt = 2 * (w >> 2) + n2;
              f32x4 cw = {0.f, 0.f, 0.f, 0.f}, ca = {0.f, 0.f, 0.f, 0.f};
#pragma unroll
              for (int k2 = 0; k2 < 2; ++k2) {
                  cw = MFMA16(*(const LAS bf16x8*)(W2T + (16 * nt + fr) * TP + 32 * k2 + 8 * fq), yt[k2], cw);
                  ca = MFMA16(*(const LAS bf16x8*)(A2T + (16 * nt + fr) * TP + 32 * k2 + 8 * fq), ya[k2], ca); }
              *(LAS f32x4*)(LW + (16 * mt + fr) * LWP + 16 * nt + 4 * fq) = cw; *(LAS f32x4*)(LA + (16 * mt + fr) * LWP + 16 * nt + 4 * fq) = ca; } }
        __syncthreads();
        float na[8], pb[8], km[8];
        {
            float n2 = 0.f, bon = 0.f, ew[8];
#pragma unroll
            for (int hf = 0; hf < 2; ++hf) {
#pragma unroll
                for (int j = 4 * hf; j < 4 * hf + 4; ++j) {
                    const float aw = LW[tk * LWP + c8 + j], aa = LA[tk * LWP + c8 + j];
                    ew[j] = 0.6065306597f * frcp(1.0f + fexp(-(CST[5 * 64 + c8 + j] + aw)));
                    const float ag = frcp(1.0f + fexp(-(CST[6 * 64 + c8 + j] + aa)));
                    const float kk = kx[j] * CST[7 * 64 + c8 + j]; n2 += kk * kk;
                    km[j] = kx[j] * (1.0f + (ag - 1.0f) * CST[8 * 64 + c8 + j]);
                    bon += rx[j] * km[j] * CST[9 * 64 + c8 + j];
                    na[j] = kk; pb[j] = ag;
                }
                __builtin_amdgcn_sched_barrier(0);
            }
            n2 = sum8(n2); bon = sum8(bon);
            const float inv = frcp(fmaxf(__builtin_amdgcn_sqrtf(n2), 1e-12f));
#pragma unroll
            for (int j = 0; j < 8; ++j) { const float kkn = na[j] * inv; na[j] = -kkn; pb[j] = kkn * pb[j]; }
            *(LAS f32x4*)(CUM + tk * 64 + c8) = (f32x4){ew[0], ew[1], ew[2], ew[3]} * 1.44269504089f; *(LAS f32x4*)(CUM + tk * 64 + c8 + 4) = (f32x4){ew[4], ew[5], ew[6], ew[7]} * 1.44269504089f;
            if ((tid & 7) == 0 && need_out) BONG[(size_t)row * 8 + h] = bon;
        }
        __syncthreads();
        if (tid < 256) { const int q = tid >> 6, ch = tid & 63; float c = 0.f;
#pragma unroll
            for (int i = 0; i < 16; ++i) { c -= CUM[(16 * q + i) * 64 + ch]; const float p = __builtin_amdgcn_exp2f(c); CUM[(16 * q + i) * 64 + ch] = p; if (i == 15) PCb[q * 64 + ch] = p; } }
        __syncthreads();
        {
            const int q = tk >> 4, tt = tk & 15;
            const f32x4 one4 = {1.f, 1.f, 1.f, 1.f};
            const f32x4 et0 = *(const LAS f32x4*)(CUM + tk * 64 + c8), et1 = *(const LAS f32x4*)(CUM + tk * 64 + c8 + 4);
            const f32x4 ep0 = tt ? *(const LAS f32x4*)(CUM + (tk - 1) * 64 + c8) : one4, ep1 = tt ? *(const LAS f32x4*)(CUM + (tk - 1) * 64 + c8 + 4) : one4;
            const f32x4 pc0 = *(const LAS f32x4*)(PCb + q * 64 + c8), pc1 = *(const LAS f32x4*)(PCb + q * 64 + c8 + 4);
            float ei8[8];
            { float t8[8];
#pragma unroll
              for (int j = 0; j < 8; ++j) t8[j] = na[j] * (j < 4 ? ep0[j & 3] : ep1[j & 3]);
              *(LAS v4u*)(AT + tk * TP + c8) = pack8(t8); }
            { float t8[8];
#pragma unroll
              for (int j = 0; j < 8; ++j) { const float et = j < 4 ? et0[j & 3] : et1[j & 3]; t8[j] = rx[j] * et; ei8[j] = frcp(et); }
              *(LAS v4u*)(RT + tk * TP + c8) = pack8(t8); }
            { float t8[8];
#pragma unroll
              for (int j = 0; j < 8; ++j) t8[j] = pb[j] * ei8[j];
              *(LAS v4u*)(BT + tk * TP + c8) = pack8(t8); }
            { float t8[8];
#pragma unroll
              for (int j = 0; j < 8; ++j) t8[j] = km[j] * ei8[j];
              *(LAS v4u*)(KT + tk * TP + c8) = pack8(t8); }
#pragma unroll
            for (int j = 0; j < 8; j += 2) { const float eh0 = (j < 4 ? pc0[j & 3] : pc1[j & 3]) * ei8[j], eh1 = (j + 1 < 4 ? pc0[(j + 1) & 3] : pc1[(j + 1) & 3]) * ei8[j + 1];
                const unsigned wb = pk2(pb[j] * eh0, pb[j + 1] * eh1), wk = pk2(km[j] * eh0, km[j + 1] * eh1), wv = pk2(vx[j], vx[j + 1]); const int o = (q * 64 + c8 + j) * 16 + (tt ^ (4 * ((tid & 7) & 3)));
                BH[o] = (bf16)(wb & 0xffffu); BH[o + 16] = (bf16)(wb >> 16); KH[o] = (bf16)(wk & 0xffffu); KH[o + 16] = (bf16)(wk >> 16); Vt[o] = (bf16)(wv & 0xffffu); Vt[o + 16] = (bf16)(wv >> 16); }
        }
        __syncthreads();
        { const int q = w >> 1, rsel = w & 1;
          const LAS bf16* YR = rsel ? RT : AT;
          f32x4 cb = {0.f, 0.f, 0.f, 0.f}, ck = {0.f, 0.f, 0.f, 0.f};
#pragma unroll
          for (int k2 = 0; k2 < 2; ++k2) { const bf16x8 yf = *(const LAS bf16x8*)(YR + (16 * q + fr) * TP + 32 * k2 + 8 * fq);
              cb = MFMA16(*(const LAS bf16x8*)(BT + (16 * q + fr) * TP + 32 * k2 + 8 * fq), yf, cb);
              ck = MFMA16(*(const LAS bf16x8*)(KT + (16 * q + fr) * TP + 32 * k2 + 8 * fq), yf, ck); }
#pragma unroll
          for (int i2 = 0; i2 < 4; ++i2) { const int i = 4 * fq + i2; const bool keep = rsel ? (i <= fr) : (i < fr); if (!keep) { cb[i2] = 0.f; ck[i2] = 0.f; } }
          if (rsel == 0) { *(LAS f32x4*)(LabF + (q * 16 + fr) * 16 + 4 * fq) = cb; *(LAS bf16x4s*)(LakB + (q * 16 + fr) * 16 + 4 * fq) = pack4(ck); }
          else { *(LAS bf16x4s*)(MrbB + (q * 16 + fr) * 16 + 4 * fq) = pack4(cb); *(LAS bf16x4s*)(MrkB + (q * 16 + fr) * 16 + 4 * fq) = pack4(ck); } }
        __syncthreads();
        if (tid < 64) { const int q = tid >> 4, c = tid & 15; float T[16];
#pragma unroll
            for (int t = 0; t < 16; ++t) { float sacc = (t == c) ? 1.f : 0.f;
#pragma unroll
                for (int i = 0; i < t; ++i) sacc += LabF[(q * 16 + t) * 16 + i] * T[i];
                T[t] = sacc; TtB[(q * 16 + t) * 16 + c] = (bf16)f2bf(sacc); } }
        __syncthreads();
        }
        if (role == 1) {
            const __amdgpu_buffer_rsrc_t rs = __builtin_amdgcn_make_buffer_rsrc(ring, 0, XFER_SLOTS * XFER_SLOT_BYTES, 0x00020000);
            const unsigned sb0 = (unsigned)((hj % XFER_SLOTS) * XFER_SLOT_BYTES);
            for (int i = tid; i < XFER_PIECES; i += NTHR) { const v4u v = *(const LAS v4u*)(L0 + xfer_lds_off(i)); __builtin_amdgcn_raw_buffer_store_b128(v, rs, sb0 + 16u * (unsigned)i, 0, 16); }
            asm volatile("s_waitcnt vmcnt(0)" ::: "memory");
            __syncthreads();
            if (tid == 0) __hip_atomic_store(prodw, (unsigned)(hj + 1), RLX_AGENT);
            continue;
        }
        if (!mine) {
#pragma unroll
            for (int k = 0; k < 7; ++k) { const int i = tid + NTHR * k; if (i < XFER_PIECES) *(LAS v4u*)(L0 + xfer_lds_off(i)) = XR[k]; }
            __syncthreads();
            if (tid == 0) __hip_atomic_store(consw, (unsigned)(hj + 1), RLX_AGENT);
        }
        if (role == 0 && bi + 1 < NBT && (bi + 1) % 2 != 0) {
            const int hn = (bi + 1) >> 1;
            if (w == 0) { wait_ge(prodw, (unsigned)(hn + 1), ctlw + CW_TMO, 0xA00u, lane); __builtin_amdgcn_fence(__ATOMIC_ACQUIRE, "agent"); asm volatile("s_waitcnt vmcnt(0)" ::: "memory"); }
            __syncthreads();
            const unsigned char* src = ring + (size_t)(hn % XFER_SLOTS) * XFER_SLOT_BYTES;
#pragma unroll
            for (int k = 0; k < 7; ++k) { int i = tid + NTHR * k; i = i < XFER_PIECES ? i : XFER_PIECES - 1; XR[k] = *(const v4u*)(src + 16 * i); }
        }
#ifdef PROBE_S2
        f32x4 Ssv[4];
#pragma unroll
        for (int kt = 0; kt < 4; ++kt) Ssv[kt] = St[kt];
        for (int prb_ = 0; prb_ < 2; ++prb_) {
        if (prb_) {
#pragma unroll
            for (int kt = 0; kt < 4; ++kt) St[kt] = Ssv[kt]; }
#endif
        if (w < 4) {
#pragma unroll 1
            for (int q = 0; q < 4; ++q) {
                const bf16x4s z4s = {0, 0, 0, 0};
#define CAT2(p0, p1) __builtin_shufflevector(*(const LAS bf16x4s*)(p0), *(const LAS bf16x4s*)(p1), 0, 1, 2, 3, 4, 5, 6, 7)
#define PAD8(p0) __builtin_shufflevector(*(const LAS bf16x4s*)(p0), z4s, 0, 1, 2, 3, 4, 5, 6, 7)
                const bf16x4s vt4 = *(const LAS bf16x4s*)(Vt + (q * 64 + 16 * w + fr) * 16 + 4 * (fq ^ ((2 * w + (fr >> 3)) & 3)));
                const LAS bf16* atp = AT + (16 * q + fr) * TP + 4 * fq; const LAS bf16* rtp = RT + (16 * q + fr) * TP + 4 * fq;
                f32x4 x1 = {0.f, 0.f, 0.f, 0.f}, yv = {0.f, 0.f, 0.f, 0.f};
                { const bf16x8 s01 = __builtin_shufflevector(pack4(St[0]), pack4(St[1]), 0, 1, 2, 3, 4, 5, 6, 7), s23 = __builtin_shufflevector(pack4(St[2]), pack4(St[3]), 0, 1, 2, 3, 4, 5, 6, 7);
                  x1 = MFMA16(CAT2(atp, atp + 16), s01, x1); x1 = MFMA16(CAT2(atp + 32, atp + 48), s23, x1);
                  yv = MFMA16(CAT2(rtp, rtp + 16), s01, yv); yv = MFMA16(CAT2(rtp + 32, rtp + 48), s23, yv); }
                x1 = MFMA16(PAD8(LakB + (q * 16 + fr) * 16 + 4 * fq), __builtin_shufflevector(vt4, z4s, 0, 1, 2, 3, 4, 5, 6, 7), x1);
                const f32x4 u = MFMA16(PAD8(TtB + (q * 16 + fr) * 16 + 4 * fq), __builtin_shufflevector(pack4(x1), z4s, 0, 1, 2, 3, 4, 5, 6, 7), ((f32x4){0.f, 0.f, 0.f, 0.f}));
                const bf16x8 vu = __builtin_shufflevector(vt4, pack4(u), 0, 1, 2, 3, 4, 5, 6, 7);
                yv = MFMA16(CAT2(MrkB + (q * 16 + fr) * 16 + 4 * fq, MrbB + (q * 16 + fr) * 16 + 4 * fq), vu, yv);
#pragma unroll
                for (int i2 = 0; i2 < 4; ++i2) YB[(16 * q + 4 * fq + i2) * 64 + 16 * w + fr] = yv[i2];
#pragma unroll
                for (int kt = 0; kt < 4; ++kt)
                    St[kt] = MFMA16(CAT2(KH + (q * 64 + 16 * kt + fr) * 16 + 4 * (fq ^ ((2 * kt + (fr >> 3)) & 3)), BH + (q * 64 + 16 * kt + fr) * 16 + 4 * (fq ^ ((2 * kt + (fr >> 3)) & 3))), vu, St[kt] * *(const LAS f32x4*)(PCb + q * 64 + 16 * kt + 4 * fq));
#undef CAT2
#undef PAD8
            }
        }
#ifdef PROBE_S2
        __syncthreads(); }
#endif
        __syncthreads();
        if (need_out) {
            float y8[8];
#pragma unroll
            for (int j = 0; j < 8; ++j) y8[j] = YB[tk * 64 + c8 + j];
            *(v4u*)(YS + (size_t)row * 512 + gc) = pack8(y8);
        }
    }
    __syncthreads();
}

constexpr int PL_CST = 0, PL_TW = 2560, PL_AL = PL_TW + 9216, PL_LW = PL_AL + 9216, PL_LA = PL_LW + 16384, PL_SET = PL_LA + 16384, PL_SETB = 52224, PL_END = PL_SET + 2 * PL_SETB;
static_assert(PL_END <= MISC_OFF, "pipelined scan LDS map");
__device__ __forceinline__ void scan_unit_pipe(const Params& P, const Frame& F, int l, int b, int h, int dir) {
    LAS unsigned char* L0 = F.lds;
    LAS float* CST = (LAS float*)(L0 + PL_CST);
    LAS bf16* TWb = (LAS bf16*)(L0 + PL_TW);
    LAS bf16* ALb = (LAS bf16*)(L0 + PL_AL);
    LAS bf16* BT = TWb; LAS bf16* KT = ALb;
    LAS float* LW = (LAS float*)(L0 + PL_LW);
    LAS float* LA = (LAS float*)(L0 + PL_LA);
    LAS float* CUM = LW; LAS float* LabF = LA;
    const int tid = F.tid, lane = F.lane, w = F.wave, fr = lane & 15, fq = lane >> 4;
    const int tk = tid >> 3, c8 = (tid & 7) * 8, gc = 64 * h + c8;
    const int ld = l * 2 + dir;
    if (tid < 64) { const int c = 64 * h + tid;
        CST[0 * 64 + tid] = P.in[I_MU][(size_t)(ld * 3 + 0) * 512 + c]; CST[1 * 64 + tid] = P.in[I_MU][(size_t)(ld * 3 + 1) * 512 + c]; CST[2 * 64 + tid] = P.in[I_MU][(size_t)(ld * 3 + 2) * 512 + c];
        CST[3 * 64 + tid] = P.in[I_MUW][ld * 64 + tid]; CST[4 * 64 + tid] = P.in[I_MUA][ld * 64 + tid];
        CST[5 * 64 + tid] = P.in[I_W0][ld * 512 + c]; CST[6 * 64 + tid] = P.in[I_A0][ld * 512 + c];
        CST[7 * 64 + tid] = P.in[I_KK][l * 512 + c]; CST[8 * 64 + tid] = P.in[I_KA][l * 512 + c]; CST[9 * 64 + tid] = P.in[I_RK][l * 512 + c]; }
    const bf16* Z = WSP(bf16, WS_Z);
    bf16* YS = WSP(bf16, WS_YS) + (size_t)dir * MT * 512;
    float* BONG = WSP(float, WS_BONG) + (size_t)dir * MT * 8;
    f32x4 St[4];
#pragma unroll
    for (int kt = 0; kt < 4; ++kt) St[kt] = (f32x4){0.f, 0.f, 0.f, 0.f};
    constexpr int NBT = LC / TB + SEQ / TB;
    ScanPre R; scan_prefetch(Z, 0, tk, b, dir, gc, c8, R);
    __syncthreads();
#define PL_CHAIN(q) do { if (w < 4 && it >= 1) { \
        const bf16x4s z4s = {0, 0, 0, 0}; \
        const LAS bf16* cBH = (const LAS bf16*)(cset); const LAS bf16* cKH = cBH + 4096; const LAS bf16* cVt = cKH + 4096; const LAS bf16* cAT = (const LAS bf16*)(cset + 24576); const LAS bf16* cRT = (const LAS bf16*)(cset + 33792); \
        const LAS bf16* cLak = (const LAS bf16*)(cset + 43008); const LAS bf16* cTt = cLak + 1024; const LAS bf16* cMrb = cTt + 1024; const LAS bf16* cMrk = cMrb + 1024; const LAS float* cPC = (const LAS float*)(cset + 51200); \
        const bf16x4s vt4 = *(const LAS bf16x4s*)(cVt + ((q) * 64 + 16 * w + fr) * 16 + 4 * fq); \
        const LAS bf16* atp = cAT + (16 * (q) + fr) * TP + 4 * fq; const LAS bf16* rtp = cRT + (16 * (q) + fr) * TP + 4 * fq; \
        f32x4 x1 = {0.f, 0.f, 0.f, 0.f}, yv = {0.f, 0.f, 0.f, 0.f}; \
        { const bf16x8 s01 = __builtin_shufflevector(pack4(St[0]), pack4(St[1]), 0, 1, 2, 3, 4, 5, 6, 7), s23 = __builtin_shufflevector(pack4(St[2]), pack4(St[3]), 0, 1, 2, 3, 4, 5, 6, 7); \
          x1 = MFMA16(PL_CAT2(atp, atp + 16), s01, x1); x1 = MFMA16(PL_CAT2(atp + 32, atp + 48), s23, x1); \
          yv = MFMA16(PL_CAT2(rtp, rtp + 16), s01, yv); yv = MFMA16(PL_CAT2(rtp + 32, rtp + 48), s23, yv); } \
        x1 = MFMA16(PL_PAD8(cLak + ((q) * 16 + fr) * 16 + 4 * fq), __builtin_shufflevector(vt4, z4s, 0, 1, 2, 3, 4, 5, 6, 7), x1); \
        const f32x4 u = MFMA16(PL_PAD8(cTt + ((q) * 16 + fr) * 16 + 4 * fq), __builtin_shufflevector(pack4(x1), z4s, 0, 1, 2, 3, 4, 5, 6, 7), ((f32x4){0.f, 0.f, 0.f, 0.f})); \
        const bf16x8 vu = __builtin_shufflevector(vt4, pack4(u), 0, 1, 2, 3, 4, 5, 6, 7); \
        yv = MFMA16(PL_CAT2(cMrk + ((q) * 16 + fr) * 16 + 4 * fq, cMrb + ((q) * 16 + fr) * 16 + 4 * fq), vu, yv); \
        _Pragma("unroll") for (int kt = 0; kt < 4; ++kt) { \
            St[kt] = MFMA16(PL_CAT2(cKH + ((q) * 64 + 16 * kt + fr) * 16 + 4 * fq, cBH + ((q) * 64 + 16 * kt + fr) * 16 + 4 * fq), vu, St[kt] * *(const LAS f32x4*)(cPC + (q) * 64 + 16 * kt + 4 * fq)); \
            if (kt & 1) __builtin_amdgcn_sched_barrier(0); } \
        if (cout_) { _Pragma("unroll") for (int i2 = 0; i2 < 4; ++i2) { bool hp2; int pr2; const int row2 = scan_row(it - 1, 16 * (q) + 4 * fq + i2, b, dir, hp2, pr2); \
            YS[(size_t)row2 * 512 + 64 * h + 16 * w + fr] = (bf16)f2bf(yv[i2]); } } \
    } } while (0)
#define PL_CAT2(p0, p1) __builtin_shufflevector(*(const LAS bf16x4s*)(p0), *(const LAS bf16x4s*)(p1), 0, 1, 2, 3, 4, 5, 6, 7)
#define PL_PAD8(p0) __builtin_shufflevector(*(const LAS bf16x4s*)(p0), z4s, 0, 1, 2, 3, 4, 5, 6, 7)
    for (int it = 0; it <= NBT; ++it) {
        const bool prep = it < NBT;
        const LAS unsigned char* cset = L0 + PL_SET + ((it - 1) & 1) * PL_SETB;
        LAS unsigned char* pset = L0 + PL_SET + (it & 1) * PL_SETB;
        const bool need_out = (it >= LC / TB) || (l == 0), cout_ = (it - 1 >= LC / TB) || (l == 0);
        LAS bf16* BH = (LAS bf16*)pset; LAS bf16* KH = BH + 4096; LAS bf16* Vt = KH + 4096; LAS bf16* AT = (LAS bf16*)(pset + 24576); LAS bf16* RT = (LAS bf16*)(pset + 33792);
        LAS bf16* LakB = (LAS bf16*)(pset + 43008); LAS bf16* TtB = LakB + 1024; LAS bf16* MrbB = TtB + 1024; LAS bf16* MrkB = MrbB + 1024; LAS float* PCb = (LAS float*)(pset + 51200);
        bool hp = false; int prow = 0; const int row = prep ? scan_row(it, tk, b, dir, hp, prow) : 0; (void)prow;
        float kx[8], vx[8], rx[8], na[8], pb[8], km[8];
#ifdef PROBE_ST1
        for (int prb_ = 0; prb_ < 2; ++prb_)
#endif
        if (prep) { float wl[8], al[8];
            lerp8(R.kc, R.kp, hp, CST + 0 * 64 + c8, kx); lerp8(R.vc, R.vp, hp, CST + 1 * 64 + c8, vx); lerp8(R.rc, R.rp, hp, CST + 2 * 64 + c8, rx);
            lerp8(R.wc, R.wp, hp, CST + 3 * 64 + c8, wl); lerp8(R.ac, R.ap, hp, CST + 4 * 64 + c8, al);
#pragma unroll
            for (int j = 0; j < 8; ++j) wl[j] = ftanh(wl[j]);
            *(LAS v4u*)(TWb + tk * TP + c8) = pack8(wl); *(LAS v4u*)(ALb + tk * TP + c8) = pack8(al);
        }
        __syncthreads();
        if (w >= 4) { if (prep) { const int nt = w - 4;
            int ll = lane; asm volatile("" : "+v"(ll));
            const size_t lo = ((size_t)ld * 512 + 64 * h + 16 * nt + (ll & 15)) * 64 + 8 * (ll >> 4);
            const bf16* w2g = WSP(bf16, WS_W2TG) + lo; const bf16* a2g = WSP(bf16, WS_A2TG) + lo;
            bf16x8 w2x[2], a2x[2];
#pragma unroll
            for (int k2 = 0; k2 < 2; ++k2) { w2x[k2] = *(const bf16x8*)(w2g + 32 * k2); a2x[k2] = *(const bf16x8*)(a2g + 32 * k2); }
#pragma unroll
            for (int mt = 0; mt < 4; ++mt) { f32x4 cw = {0.f, 0.f, 0.f, 0.f}, ca = {0.f, 0.f, 0.f, 0.f};
#pragma unroll
                for (int k2 = 0; k2 < 2; ++k2) { cw = MFMA16(w2x[k2], *(const LAS bf16x8*)(TWb + (16 * mt + fr) * TP + 32 * k2 + 8 * fq), cw); ca = MFMA16(a2x[k2], *(const LAS bf16x8*)(ALb + (16 * mt + fr) * TP + 32 * k2 + 8 * fq), ca); }
                *(LAS f32x4*)(LW + (16 * mt + fr) * 64 + 16 * nt + 4 * fq) = cw; *(LAS f32x4*)(LA + (16 * mt + fr) * 64 + 16 * nt + 4 * fq) = ca; } } }
        else PL_CHAIN(0);
        __syncthreads();
#ifdef PROBE_ST3
        float lwsv[8], lasv[8];
        if (prep) {
#pragma unroll
            for (int j = 0; j < 8; ++j) { lwsv[j] = LW[tk * 64 + c8 + j]; lasv[j] = LA[tk * 64 + c8 + j]; } }
        for (int prb_ = 0; prb_ < 2; ++prb_) {
        if (prb_ && prep) {
#pragma unroll
            for (int j = 0; j < 8; ++j) { LW[tk * 64 + c8 + j] = lwsv[j]; LA[tk * 64 + c8 + j] = lasv[j]; } }
#endif
        if (prep) {
            float n2 = 0.f, bon = 0.f, ew[8];
#pragma unroll
            for (int hf = 0; hf < 2; ++hf) {
#pragma unroll
                for (int j = 4 * hf; j < 4 * hf + 4; ++j) {
                    const float aw = LW[tk * 64 + c8 + j], aa = LA[tk * 64 + c8 + j];
                    ew[j] = 0.6065306597f * frcp(1.0f + fexp(-(CST[5 * 64 + c8 + j] + aw)));
                    const float ag = frcp(1.0f + fexp(-(CST[6 * 64 + c8 + j] + aa)));
                    const float kk = kx[j] * CST[7 * 64 + c8 + j]; n2 += kk * kk;
                    km[j] = kx[j] * (1.0f + (ag - 1.0f) * CST[8 * 64 + c8 + j]);
                    bon += rx[j] * km[j] * CST[9 * 64 + c8 + j];
                    na[j] = kk; pb[j] = ag;
                }
                __builtin_amdgcn_sched_barrier(0);
            }
            n2 = sum8(n2); bon = sum8(bon);
            const float inv = frcp(fmaxf(__builtin_amdgcn_sqrtf(n2), 1e-12f));
#pragma unroll
            for (int j = 0; j < 8; ++j) { const float kkn = na[j] * inv; na[j] = -kkn; pb[j] = kkn * pb[j]; }
            *(LAS f32x4*)(CUM + tk * 64 + c8) = (f32x4){ew[0], ew[1], ew[2], ew[3]} * 1.44269504089f; *(LAS f32x4*)(CUM + tk * 64 + c8 + 4) = (f32x4){ew[4], ew[5], ew[6], ew[7]} * 1.44269504089f;
            if ((tid & 7) == 0 && need_out) BONG[(size_t)row * 8 + h] = bon;
#pragma unroll
            for (int j = 0; j < 8; j += 2) { const unsigned wv = pk2(vx[j], vx[j + 1]); const int o = ((tk >> 4) * 64 + c8 + j) * 16 + (tk & 15); Vt[o] = (bf16)(wv & 0xffffu); Vt[o + 16] = (bf16)(wv >> 16); }
        }
#ifdef PROBE_ST3
        }
#endif
        __syncthreads();
        if (w >= 4) { if (prep) { const int t2 = tid - 256, q = t2 >> 6, ch = t2 & 63; float c = 0.f;
#pragma unroll
            for (int i = 0; i < 16; ++i) { c -= CUM[(16 * q + i) * 64 + ch]; const float p = __builtin_amdgcn_exp2f(c); CUM[(16 * q + i) * 64 + ch] = p; if (i == 15) PCb[q * 64 + ch] = p; } } }
        else PL_CHAIN(1);
        __syncthreads();
#ifdef PROBE_ST5
        for (int prb_ = 0; prb_ < 2; ++prb_)
#endif
        if (prep) {
            const int q = tk >> 4, tt = tk & 15;
            const f32x4 one4 = {1.f, 1.f, 1.f, 1.f};
            const f32x4 et0 = *(const LAS f32x4*)(CUM + tk * 64 + c8), et1 = *(const LAS f32x4*)(CUM + tk * 64 + c8 + 4);
            const f32x4 ep0 = tt ? *(const LAS f32x4*)(CUM + (tk - 1) * 64 + c8) : one4, ep1 = tt ? *(const LAS f32x4*)(CUM + (tk - 1) * 64 + c8 + 4) : one4;
            const f32x4 pc0 = *(const LAS f32x4*)(PCb + q * 64 + c8), pc1 = *(const LAS f32x4*)(PCb + q * 64 + c8 + 4);
            float ei8[8];
            { float t8[8];
#pragma unroll
              for (int j = 0; j < 8; ++j) t8[j] = na[j] * (j < 4 ? ep0[j & 3] : ep1[j & 3]);
              *(LAS v4u*)(AT + tk * TP + c8) = pack8(t8); }
            __builtin_amdgcn_sched_barrier(0);
            { float t8[8];
#pragma unroll
              for (int j = 0; j < 8; ++j) { const float et = j < 4 ? et0[j & 3] : et1[j & 3]; t8[j] = rx[j] * et; ei8[j] = frcp(et); }
              *(LAS v4u*)(RT + tk * TP + c8) = pack8(t8); }
            __builtin_amdgcn_sched_barrier(0);
            { float t8[8];
#pragma unroll
              for (int j = 0; j < 8; ++j) t8[j] = pb[j] * ei8[j];
              *(LAS v4u*)(BT + tk * TP + c8) = pack8(t8); }
            __builtin_amdgcn_sched_barrier(0);
            { float t8[8];
#pragma unroll
              for (int j = 0; j < 8; ++j) t8[j] = km[j] * ei8[j];
              *(LAS v4u*)(KT + tk * TP + c8) = pack8(t8); }
            __builtin_amdgcn_sched_barrier(0);
#pragma unroll
            for (int j = 0; j < 8; j += 2) { const float eh0 = (j < 4 ? pc0[j & 3] : pc1[j & 3]) * ei8[j], eh1 = (j + 1 < 4 ? pc0[(j + 1) & 3] : pc1[(j + 1) & 3]) * ei8[j + 1];
                const unsigned wb = pk2(pb[j] * eh0, pb[j + 1] * eh1), wk = pk2(km[j] * eh0, km[j + 1] * eh1); const int o = (q * 64 + c8 + j) * 16 + tt;
                BH[o] = (bf16)(wb & 0xffffu); BH[o + 16] = (bf16)(wb >> 16); KH[o] = (bf16)(wk & 0xffffu); KH[o + 16] = (bf16)(wk >> 16); }
        }
        __syncthreads();
        if (it + 1 < NBT) scan_prefetch(Z, it + 1, tk, b, dir, gc, c8, R);
        if (w >= 4) { if (prep) { const int q = w - 4;
#pragma unroll
            for (int rsel = 0; rsel < 2; ++rsel) {
                const LAS bf16* YR = rsel ? RT : AT;
                f32x4 cb = {0.f, 0.f, 0.f, 0.f}, ck = {0.f, 0.f, 0.f, 0.f};
#pragma unroll
                for (int k2 = 0; k2 < 2; ++k2) { const bf16x8 yf = *(const LAS bf16x8*)(YR + (16 * q + fr) * TP + 32 * k2 + 8 * fq);
                    cb = MFMA16(*(const LAS bf16x8*)(BT + (16 * q + fr) * TP + 32 * k2 + 8 * fq), yf, cb);
                    ck = MFMA16(*(const LAS bf16x8*)(KT + (16 * q + fr) * TP + 32 * k2 + 8 * fq), yf, ck); }
#pragma unroll
                for (int i2 = 0; i2 < 4; ++i2) { const int i = 4 * fq + i2; const bool keep = rsel ? (i <= fr) : (i < fr); if (!keep) { cb[i2] = 0.f; ck[i2] = 0.f; } }
                if (rsel == 0) { *(LAS f32x4*)(LabF + (q * 16 + fr) * 16 + 4 * fq) = cb; *(LAS bf16x4s*)(LakB + (q * 16 + fr) * 16 + 4 * fq) = pack4(ck); }
                else { *(LAS bf16x4s*)(MrbB + (q * 16 + fr) * 16 + 4 * fq) = pack4(cb); *(LAS bf16x4s*)(MrkB + (q * 16 + fr) * 16 + 4 * fq) = pack4(ck); } } } }
        else PL_CHAIN(2);
        __syncthreads();
        if (w == 4) { if (prep) { const int q = lane >> 4, c = lane & 15; float T[16];
#pragma unroll
            for (int t = 0; t < 16; ++t) { float sacc = (t == c) ? 1.f : 0.f;
#pragma unroll
                for (int i = 0; i < t; ++i) sacc += LabF[(q * 16 + t) * 16 + i] * T[i];
                T[t] = sacc; TtB[(q * 16 + t) * 16 + c] = (bf16)f2bf(sacc); } } }
        else if (w < 4) PL_CHAIN(3);
        __syncthreads();
    }
#undef PL_CHAIN
#undef PL_CAT2
#undef PL_PAD8
}

__device__ __forceinline__ void conv_items(const Params& P, const Frame& F, int l, int nrows, int ob, int nob) {
    const bf16* Z = WSP(bf16, WS_Z); bf16* YM = WSP(bf16, WS_H);
    const float* cw = P.in[I_CONVW] + l * 768;
    for (int idx = ob * NTHR + F.tid; idx < nrows * 32; idx += nob * NTHR) {
        const int row = idx >> 5, ch = (idx & 31) * 8;
        bool hp, hn;
        if (row < NT) { const int col = row & 63; hp = col != 0; hn = col != 63; } else { const int t = (row - NT) & 255; hp = t != 0; hn = t != 255; }
        const bf16* zr = Z + (size_t)row * NZ;
        const v4u u1 = *(const v4u*)(zr + C_U + ch), g1 = *(const v4u*)(zr + C_GC + ch), gb = *(const v4u*)(zr + C_GB + ch);
        v4u u0 = {0u, 0u, 0u, 0u}, g0 = u0, u2 = u0, g2 = u0;
        if (hp) { u0 = *(const v4u*)(zr - NZ + C_U + ch); g0 = *(const v4u*)(zr - NZ + C_GC + ch); }
        if (hn) { u2 = *(const v4u*)(zr + NZ + C_U + ch); g2 = *(const v4u*)(zr + NZ + C_GC + ch); }
        v4u o;
#pragma unroll
        for (int q = 0; q < 4; ++q) {
            const float wa0 = cw[ch + 2 * q], wa1 = cw[256 + ch + 2 * q], wa2 = cw[512 + ch + 2 * q], wb0 = cw[ch + 2 * q + 1], wb1 = cw[256 + ch + 2 * q + 1], wb2 = cw[512 + ch + 2 * q + 1];
            const float lo = bflo(gb[q]) * (wa0 * bflo(g0[q]) * bflo(u0[q]) + wa1 * bflo(g1[q]) * bflo(u1[q]) + wa2 * bflo(g2[q]) * bflo(u2[q]));
            const float hi = bfhi(gb[q]) * (wb0 * bfhi(g0[q]) * bfhi(u0[q]) + wb1 * bfhi(g1[q]) * bfhi(u1[q]) + wb2 * bfhi(g2[q]) * bfhi(u2[q]));
            o[q] = pk2(lo, hi);
        }
        *(v4u*)(YM + (size_t)row * D + 512 + ch) = o;
    }
}

__device__ __forceinline__ void load_tab64(LAS bf16* dst, const bf16* src, int tid) {
    for (int i = tid; i < 512; i += NTHR) { const int r = i >> 3, c = (i & 7) * 8; *(LAS v4u*)(dst + r * TP + c) = *(const v4u*)(src + r * 64 + c); }
}
__device__ __forceinline__ bf16x8 ldsfrag(const LAS bf16* base, int row, int col) { return *(const LAS bf16x8*)(base + row * TP + col); }
__device__ __forceinline__ void fourier_a_iter(const Params& P, const Frame& F, int it) {
    const int bg = it >> 3, j = it & 7, b = bg >> 2, g = bg & 3, w = F.wave, lane = F.lane, fr = lane & 15, fq = lane >> 4, p2 = 8 * j + w;
    LAS bf16* TC64 = (LAS bf16*)F.lds; LAS bf16* TS64 = TC64 + 64 * TP; LAS bf16* TN64 = TS64 + 64 * TP;
    LAS bf16* PT = TN64 + 64 * TP + w * (64 * TP);
    load_tab64(TC64, WSP(bf16, TAB_C64), F.tid); load_tab64(TS64, WSP(bf16, TAB_S64), F.tid); load_tab64(TN64, WSP(bf16, TAB_SN64), F.tid);
    const bf16* Z = WSP(bf16, WS_Z);
    __syncthreads();
    f32x4 Yr[4][4], Yi[4][4];
#pragma unroll
    for (int a = 0; a < 4; ++a)
#pragma unroll
        for (int c = 0; c < 4; ++c) { Yr[a][c] = (f32x4){0.f, 0.f, 0.f, 0.f}; Yi[a][c] = (f32x4){0.f, 0.f, 0.f, 0.f}; }
#pragma unroll
    for (int pass = 0; pass < 2; ++pass) {
        const LAS bf16* T1 = pass == 0 ? TC64 : TS64;
        asm volatile("" ::: "memory");
#pragma unroll
        for (int xt = 0; xt < 4; ++xt) {
            bf16x8 Ff[2];
#pragma unroll
            for (int ks = 0; ks < 2; ++ks) Ff[ks] = *(const bf16x8*)(Z + (size_t)(b * SEQ + 64 * (16 * xt + fr) + p2) * NZ + C_F + 64 * g + 32 * ks + 8 * fq);
#pragma unroll
            for (int yt = 0; yt < 4; ++yt) {
                f32x4 acc = {0.f, 0.f, 0.f, 0.f};
#pragma unroll
                for (int ks = 0; ks < 2; ++ks) acc = MFMA16(Ff[ks], ldsfrag(T1, 16 * yt + fr, 32 * ks + 8 * fq), acc);
                v2u wv; wv.x = pk2(acc.x, acc.y); wv.y = pk2(acc.z, acc.w);
                *(LAS v2u*)(PT + (16 * yt + fr) * TP + 16 * xt + 4 * fq) = wv;
            }
            __builtin_amdgcn_sched_barrier(0);
        }
        LDS_WAIT(); asm volatile("" ::: "memory");
        const LAS bf16* TA = pass == 0 ? TC64 : TN64;
        const LAS bf16* TB = pass == 0 ? TS64 : TC64;
#pragma unroll
        for (int ks = 0; ks < 2; ++ks) {
            bf16x8 pf[4];
#pragma unroll
            for (int yt = 0; yt < 4; ++yt) pf[yt] = ldsfrag(PT, 16 * yt + fr, 32 * ks + 8 * fq);
#pragma unroll
            for (int xt = 0; xt < 4; ++xt) { const bf16x8 ta = ldsfrag(TA, 16 * xt + fr, 32 * ks + 8 * fq), tb = ldsfrag(TB, 16 * xt + fr, 32 * ks + 8 * fq);
#pragma unroll
                for (int yt = 0; yt < 4; ++yt) { Yr[xt][yt] = MFMA16(ta, pf[yt], Yr[xt][yt]); Yi[xt][yt] = MFMA16(tb, pf[yt], Yi[xt][yt]); }
                __builtin_amdgcn_sched_barrier(0); }
        }
        LDS_WAIT(); asm volatile("" ::: "memory");
    }
    __syncthreads();
    LAS bf16* EX = (LAS bf16*)F.lds;
    const float* twc = WSP(float, TAB_TWC); const float* tws = WSP(float, TAB_TWS);
#pragma unroll
    for (int xt = 0; xt < 4; ++xt)
#pragma unroll
        for (int i = 0; i < 4; ++i) { const int q1 = 16 * xt + 4 * fq + i, m = (p2 * q1) & 4095; const float tc = twc[m], ts = tws[m];
#pragma unroll
            for (int yt = 0; yt < 4; ++yt) { const float yr = Yr[xt][yt][i], yi = Yi[xt][yt][i]; const int cp = 16 * yt + fr;
                EX[((q1 * 2 + 0) * 64 + cp) * 8 + w] = (bf16)f2bf(yr * tc - yi * ts);
                EX[((q1 * 2 + 1) * 64 + cp) * 8 + w] = (bf16)f2bf(-yi * tc - yr * ts); }
            __builtin_amdgcn_sched_barrier(0); }
    __syncthreads();
    bf16* YB = WSP(bf16, WS_YBUF) + (size_t)bg * (64 * 2 * 64 * 64);
#pragma unroll 4
    for (int n = 0; n < 16; ++n) { const int q = F.tid + NTHR * n; *(v4u*)(YB + (size_t)q * 64 + 8 * j) = *(const LAS v4u*)(EX + q * 8); }
    __syncthreads();
}
__device__ __forceinline__ void fourier_b_unit(const Params& P, const Frame& F, int u, const LAS bf16* TC64, const LAS bf16* TS64) {
    const int bg = u >> 6, s2 = u & 63, b = bg >> 2, g = bg & 3, lane = F.lane, fr = lane & 15, fq = lane >> 4;
    const bf16* YB = WSP(bf16, WS_YBUF) + (size_t)bg * (64 * 2 * 64 * 64) + (size_t)s2 * (2 * 64 * 64);
    f32x4 acc[4][4];
#pragma unroll
    for (int a = 0; a < 4; ++a)
#pragma unroll
        for (int c = 0; c < 4; ++c) acc[a][c] = (f32x4){0.f, 0.f, 0.f, 0.f};
#pragma unroll
    for (int ks = 0; ks < 4; ++ks) { const int ri = ks >> 1, pb = (ks & 1) * 32;
        bf16x8 xf[4];
#pragma unroll
        for (int xt = 0; xt < 4; ++xt) xf[xt] = *(const bf16x8*)(YB + (size_t)(ri * 64 + 16 * xt + fr) * 64 + pb + 8 * fq);
        const LAS bf16* T = ri ? TS64 : TC64;
#pragma unroll
        for (int yt = 0; yt < 4; ++yt) { const bf16x8 tf = ldsfrag(T, 16 * yt + fr, pb + 8 * fq);
#pragma unroll
            for (int xt = 0; xt < 4; ++xt) acc[xt][yt] = MFMA16(xf[xt], tf, acc[xt][yt]); }
    }
    bf16* YM = WSP(bf16, WS_H);
#pragma unroll
    for (int yt = 0; yt < 4; ++yt) { const int s1 = 16 * yt + fr; bf16* rowp = YM + (size_t)(b * SEQ + 64 * s1 + s2) * D + 768 + 64 * g;
#pragma unroll
        for (int xt = 0; xt < 4; ++xt) { const f32x4 a = acc[xt][yt] * (1.0f / 512.0f); v2u wv; wv.x = pk2(a.x, a.y); wv.y = pk2(a.z, a.w); *(v2u*)(rowp + 16 * xt + 4 * fq) = wv; } }
}
constexpr int TP2 = 264;
__device__ __forceinline__ void fourier_ctx_unit(const Params& P, const Frame& F, int bg) {
    const int b = bg >> 2, g = bg & 3, w = F.wave, lane = F.lane, fr = lane & 15, fq = lane >> 4;
    LAS bf16* TC64 = (LAS bf16*)F.lds; LAS bf16* TS64 = TC64 + 64 * TP;
    LAS bf16* PT = TS64 + 64 * TP; LAS bf16* QT = PT + 64 * TP2;
    load_tab64(TC64, WSP(bf16, TAB_C64), F.tid); load_tab64(TS64, WSP(bf16, TAB_S64), F.tid);
    const bf16* Z = WSP(bf16, WS_Z);
    bf16x8 Ff[2][2];
#pragma unroll
    for (int xt = 0; xt < 2; ++xt)
#pragma unroll
        for (int ks = 0; ks < 2; ++ks) Ff[xt][ks] = *(const bf16x8*)(Z + (size_t)(NT + b * LC + 32 * w + 16 * xt + fr) * NZ + C_F + 64 * g + 32 * ks + 8 * fq);
    __syncthreads();
#pragma unroll
    for (int xt = 0; xt < 2; ++xt)
#pragma unroll
        for (int yt = 0; yt < 4; ++yt) {
            f32x4 ap = {0.f, 0.f, 0.f, 0.f}, aq = {0.f, 0.f, 0.f, 0.f};
#pragma unroll
            for (int ks = 0; ks < 2; ++ks) { ap = MFMA16(Ff[xt][ks], ldsfrag(TC64, 16 * yt + fr, 32 * ks + 8 * fq), ap); aq = MFMA16(Ff[xt][ks], ldsfrag(TS64, 16 * yt + fr, 32 * ks + 8 * fq), aq); }
            v2u wp, wq; wp.x = pk2(ap.x, ap.y); wp.y = pk2(ap.z, ap.w); wq.x = pk2(aq.x, aq.y); wq.y = pk2(aq.z, aq.w);
            *(LAS v2u*)(PT + (16 * yt + fr) * TP2 + 32 * w + 16 * xt + 4 * fq) = wp; *(LAS v2u*)(QT + (16 * yt + fr) * TP2 + 32 * w + 16 * xt + 4 * fq) = wq;
        }
    __syncthreads();
    const bf16* C256 = WSP(bf16, WS_C256); const bf16* SN256 = WSP(bf16, WS_SN256);
    f32x4 acc[4][2];
#pragma unroll
    for (int a = 0; a < 4; ++a)
#pragma unroll
        for (int c = 0; c < 2; ++c) acc[a][c] = (f32x4){0.f, 0.f, 0.f, 0.f};
#pragma unroll 2
    for (int ks = 0; ks < 8; ++ks) {
        bf16x8 cf[2], sf[2];
#pragma unroll
        for (int yt = 0; yt < 2; ++yt) { cf[yt] = *(const bf16x8*)(C256 + (size_t)(32 * w + 16 * yt + fr) * 256 + 32 * ks + 8 * fq); sf[yt] = *(const bf16x8*)(SN256 + (size_t)(32 * w + 16 * yt + fr) * 256 + 32 * ks + 8 * fq); }
#pragma unroll
        for (int xt = 0; xt < 4; ++xt) { const bf16x8 pf = *(const LAS bf16x8*)(PT + (16 * xt + fr) * TP2 + 32 * ks + 8 * fq), qf = *(const LAS bf16x8*)(QT + (16 * xt + fr) * TP2 + 32 * ks + 8 * fq);
#pragma unroll
            for (int yt = 0; yt < 2; ++yt) { acc[xt][yt] = MFMA16(pf, cf[yt], acc[xt][yt]); acc[xt][yt] = MFMA16(qf, sf[yt], acc[xt][yt]); } }
    }
    bf16* YM = WSP(bf16, WS_H);
#pragma unroll
    for (int yt = 0; yt < 2; ++yt) { bf16* rowp = YM + (size_t)(NT + b * LC + 32 * w + 16 * yt + fr) * D + 768 + 64 * g;
#pragma unroll
        for (int xt = 0; xt < 4; ++xt) { const f32x4 a = acc[xt][yt] * (1.0f / 128.0f); v2u wv; wv.x = pk2(a.x, a.y); wv.y = pk2(a.z, a.w); *(v2u*)(rowp + 16 * xt + 4 * fq) = wv; } }
    __syncthreads();
}

constexpr int GP = 136;
__device__ __forceinline__ void finalize_phase(const Params& P, const Frame& F, int l, int nrows) {
    LAS bf16* G2 = (LAS bf16*)F.lds;
    const bf16* g2t = WSP(bf16, WS_G2T) + (size_t)l * 512 * 128;
    for (int i = F.tid; i < 512 * 16; i += NTHR) { const int r = i >> 4, c = (i & 15) * 8; *(LAS v4u*)(G2 + r * GP + c) = *(const v4u*)(g2t + r * 128 + c); }
    __syncthreads();
    const int gw = F.bx * NWAVES + F.wave, NGW = F.G * NWAVES, lane = F.lane, fr = lane & 15, fq = lane >> 4;
    const bf16* Z = WSP(bf16, WS_Z); const bf16* YSb = WSP(bf16, WS_YS); const float* BONG = WSP(float, WS_BONG); bf16* YM = WSP(bf16, WS_H);
    const float* gnw = P.in[I_GNW] + l * 512; const float* gnb = P.in[I_GNB] + l * 512; const float* mu = P.in[I_MU];
    const int nu = (nrows / 16) * 2;
    for (int u = gw; u < nu; u += NGW) {
        const int row = (u >> 1) * 16 + fr, half = u & 1;
        bf16x8 sf[4];
#pragma unroll
        for (int ks = 0; ks < 4; ++ks) { const v4u zv = *(const v4u*)(Z + (size_t)row * NZ + C_GLO + 32 * ks + 8 * fq); v4u o;
#pragma unroll
            for (int q = 0; q < 4; ++q) o[q] = pk2(sigmoidf_(bflo(zv[q])), sigmoidf_(bfhi(zv[q])));
            sf[ks] = __builtin_bit_cast(bf16x8, o); }
        int t, len; if (row < NT) { t = row & (SEQ - 1); len = SEQ; } else { t = (row - NT) & (LC - 1); len = LC; }
#pragma unroll 1
        for (int hh = 0; hh < 4; ++hh) {
            const int head = 4 * half + hh;
            f32x4 acc[4];
#pragma unroll
            for (int j = 0; j < 4; ++j) acc[j] = (f32x4){0.f, 0.f, 0.f, 0.f};
#pragma unroll
            for (int ks = 0; ks < 4; ++ks)
#pragma unroll
                for (int j = 0; j < 4; ++j) acc[j] = MFMA16(*(const LAS bf16x8*)(G2 + (64 * head + 16 * j + fr) * GP + 32 * ks + 8 * fq), sf[ks], acc[j]);
            f32x4 osum[4];
#pragma unroll
            for (int j = 0; j < 4; ++j) osum[j] = (f32x4){0.f, 0.f, 0.f, 0.f};
#pragma unroll
            for (int dir = 0; dir < 2; ++dir) {
                const bool hp = dir ? (t + 1 < len) : (t > 0); const int prow = hp ? (dir ? row + 1 : row - 1) : row;
                const bf16* ys = YSb + ((size_t)dir * MT + row) * 512 + 64 * head + 4 * fq;
                f32x4 y[4]; float s = 0.f;
#pragma unroll
                for (int j = 0; j < 4; ++j) { y[j] = ld4bf(ys + 16 * j); s += (y[j].x + y[j].y) + (y[j].z + y[j].w); }
                s += __shfl_xor(s, 16); s += __shfl_xor(s, 32);
                const float mean = s * (1.0f / 64.0f); float q2 = 0.f;
#pragma unroll
                for (int j = 0; j < 4; ++j) { y[j] = y[j] - mean; q2 += (y[j].x * y[j].x + y[j].y * y[j].y) + (y[j].z * y[j].z + y[j].w * y[j].w); }
                q2 += __shfl_xor(q2, 16); q2 += __shfl_xor(q2, 32);
                const float rstd = rsqrtf(q2 * (1.0f / 64.0f) + GN_EPS);
                const float bon = BONG[((size_t)dir * MT + row) * 8 + head];
#pragma unroll
                for (int j = 0; j < 4; ++j) { const int ch = 64 * head + 16 * j + 4 * fq;
                    const f32x4 vc = ld4bf(Z + (size_t)row * NZ + C_V + ch), vp = hp ? ld4bf(Z + (size_t)prow * NZ + C_V + ch) : (f32x4){0.f, 0.f, 0.f, 0.f};
                    const f32x4 mv = *(const f32x4*)(mu + (size_t)((l * 2 + dir) * 3 + 1) * 512 + ch);
                    const f32x4 vx = vc + (vp - vc) * mv;
                    osum[j] += y[j] * rstd * *(const f32x4*)(gnw + ch) + *(const f32x4*)(gnb + ch) + bon * vx; }
            }
#pragma unroll
            for (int j = 0; j < 4; ++j) { const int n = 64 * head + 16 * j + 4 * fq; const f32x4 o = osum[j] * acc[j];
                v2u wv; wv.x = pk2(o.x, o.y); wv.y = pk2(o.z, o.w); *(v2u*)(YM + (size_t)row * D + n) = wv; }
        }
    }
    __syncthreads();
}

struct MoePlan { int pb[9]; };
__device__ __forceinline__ void moe_plan(const Params& P, MoePlan& M, int (&cnt)[NE]) {
    int acc = 0;
#pragma unroll
    for (int e = 0; e < NE; ++e) { cnt[e] = (int)__hip_atomic_load(WSP(unsigned, WS_CTL) + CW_CNT + 64 * e, __ATOMIC_RELAXED, __HIP_MEMORY_SCOPE_AGENT); M.pb[e] = acc; acc += (cnt[e] + 255) >> 8; }
    M.pb[8] = acc;
}
__device__ __forceinline__ void moe_assign_gather(const Params& P, const Frame& F) {
    MoePlan M; int cnt[NE]; moe_plan(P, M, cnt);
    const int gw = F.bx * NWAVES + F.wave, NGW = F.G * NWAVES, lane = F.lane;
    const bf16* H = WSP(bf16, WS_H); bf16* XG = WSP(bf16, WS_XG);
    unsigned* fill = WSP(unsigned, WS_CTL) + CW_FILL;
    for (int it = gw; it < NT / 64; it += NGW) {
        const int tok = it * 64 + lane;
        const int4 rt = *(const int4*)(P.ws + WS_ROUTE + (size_t)tok * 16);
        const int es[2] = {rt.x & 255, (rt.x >> 8) & 255};
        int pos[2];
#pragma unroll
        for (int s = 0; s < 2; ++s) {
            pos[s] = 0;
#pragma unroll
            for (int e = 0; e < NE; ++e) {
                const unsigned long long m = __ballot(es[s] == e);
                if (m) {
                    const int n = __popcll(m), first = __ffsll((long long)m) - 1;
                    unsigned base = 0;
                    if (lane == first) base = __hip_atomic_fetch_add(fill + 64 * e, (unsigned)n, __ATOMIC_RELAXED, __HIP_MEMORY_SCOPE_AGENT);
                    base = __shfl(base, first);
                    const int rank = __popcll(m & ((1ull << lane) - 1ull));
                    if (es[s] == e) pos[s] = M.pb[e] * 256 + (int)base + rank;
                }
            }
        }
        *(int2*)(P.ws + WS_TOKPOS + (size_t)tok * 8) = make_int2(pos[0], pos[1]);
        for (int i = 0; i < 64; ++i) {
            const int t = it * 64 + i, d0 = __shfl(pos[0], i), d1 = __shfl(pos[1], i);
            const v4u a = *(const v4u*)(H + (size_t)t * D + 8 * lane), b = *(const v4u*)(H + (size_t)t * D + 512 + 8 * lane);
            *(v4u*)(XG + (size_t)d0 * D + 8 * lane) = a; *(v4u*)(XG + (size_t)d0 * D + 512 + 8 * lane) = b;
            *(v4u*)(XG + (size_t)d1 * D + 8 * lane) = a; *(v4u*)(XG + (size_t)d1 * D + 512 + 8 * lane) = b;
        }
    }
#pragma unroll
    for (int e = 0; e < NE; ++e) {
        const int r0 = M.pb[e] * 256 + cnt[e], r1 = M.pb[e + 1] * 256;
        for (int r = r0 + gw; r < r1; r += NGW) { *(v4u*)(XG + (size_t)r * D + 8 * lane) = (v4u){0u, 0u, 0u, 0u}; *(v4u*)(XG + (size_t)r * D + 512 + 8 * lane) = (v4u){0u, 0u, 0u, 0u}; }
    }
}

__device__ __forceinline__ Frame make_frame(LAS unsigned char* lds, int wave0) {
    Frame F; int tid = wave0 * 64 + (int)__builtin_amdgcn_mbcnt_hi(~0u, __builtin_amdgcn_mbcnt_lo(~0u, 0u)), G = gridDim.x, bx = blockIdx.x;
    asm volatile("" : "+v"(tid)); asm volatile("" : "+s"(G)); asm volatile("" : "+s"(bx));
    F.lds = lds; F.tid = tid; F.lane = tid & 63; F.wave = __builtin_amdgcn_readfirstlane(tid >> 6); F.G = G; F.bx = bx; return F;
}
#define CAS __attribute__((address_space(4)))
#define WSQ(T, off) ((T*)(Q.ws + (off)))
#if defined(__HIP_DEVICE_COMPILE__)
__device__ __forceinline__ Params load_params() { const CAS void* p = (const CAS void*)__builtin_amdgcn_kernarg_segment_ptr(); asm volatile("" : "+s"(p)); return *(const CAS Params*)p; }
#else
__device__ __forceinline__ Params load_params() { return Params{}; }
#endif
#ifndef PG8_SP2
#define PG8_SP2 true
#endif
#ifndef PG8_ALIGN
#define PG8_ALIGN true
#endif
#ifndef REP_MASK
#define REP_MASK 0
#endif
#define NREP(k) (1 + (((REP_MASK) >> (k)) & 1))
#ifdef PHMASK
#define IN(k) (((PHMASK) >> (k)) & 1)
#else
#define IN(k) (lo <= (k) && (k) < hi)
#endif
#define GRID_BARRIER() do { XcdBarrier b_ = bar; asm volatile("" : "+s"(b_.bar)); xcd_barrier(b_); } while (0)
#define SEAM(k) do { if (IN(k) && IN((k) + 1)) GRID_BARRIER(); } while (0)

__device__ __forceinline__ int tail_busy(int nwg, int G) {
#ifdef KEEP_SEAMS
    return 0;
#endif
    const int R = nwg / G, T = nwg - R * G; return (R >= 1 && 2 * T <= G) ? T : 0; }
#define PCNT(base) (WSQ(unsigned, WS_CTL) + CW_PCNT + (base))
#ifdef PROD_OLD
#define PNEED 0u
#else
#define PNEED 32u
#endif
template <int l>
__device__ __forceinline__ void layer_phases(const XcdBarrier& bar, LAS unsigned char* const lds0, volatile LAS unsigned* MISC, const int lo, const int hi, const int wave0) {
        const int pb = 1 + 8 * l;
        for (int rep_ = 0; rep_ < NREP(pb + 1); ++rep_) { if (rep_) GRID_BARRIER();
        if (IN(pb + 1)) {
            const Params Q = load_params(); const Frame F = make_frame(lds0, wave0);
            pg8::Gemm g{WSQ(bf16, WS_H), WSQ(bf16, WS_WIN) + (size_t)l * NZ * D, MT, NZ, D}; pg8::StaticOrder S; S.init(MT, NZ, F.G, F.bx);
            pg8::EpiBf16<0> E{WSQ(bf16, WS_Z), NZ, nullptr, 0, 0, 1.f};
            pg8::gemm_phase<pg8::EpiBf16<0>, pg8::StaticOrder, PG8_ALIGN, PG8_SP2>(F.lds, g, S, E, F.wave);
        } }
        SEAM(pb + 1);
        for (int rep_ = 0; rep_ < NREP(pb + 2); ++rep_) { if (rep_) GRID_BARRIER();
        if (IN(pb + 2)) {
            const Params Q = load_params(); const Frame F = make_frame(lds0, wave0);
#ifdef FORCE_SOLO
            const bool paired = false;
#else
            const bool paired = F.G >= 256;
#endif
            const int nsb = F.G > 128 ? 128 : 0;
#ifndef NO_SCAN
#ifdef SCAN_PIPE
            (void)paired;
            if (F.bx < nsb || nsb == 0) { const int st = nsb ? nsb : F.G; for (int u = F.bx; u < 128; u += st) scan_unit_pipe(Q, F, l, u >> 4, (u >> 1) & 7, u & 1); }
#else
            if (paired) { if (F.bx < 128) scan_unit(Q, F, l, F.bx >> 4, (F.bx >> 1) & 7, F.bx & 1, 0); else if (F.bx < 256) { const int u = F.bx - 128; scan_unit(Q, F, l, u >> 4, (u >> 1) & 7, u & 1, 1); } }
            else if (F.bx < nsb || nsb == 0) { const int st = nsb ? nsb : F.G; for (int u = F.bx; u < 128; u += st) scan_unit(Q, F, l, u >> 4, (u >> 1) & 7, u & 1, 2); }
#endif
#endif
#ifdef PROBE_CF2
            for (int prb_ = 0; prb_ < 2; ++prb_)
#endif
            if (F.bx >= nsb) {
                const int ob = F.bx - nsb, nob = F.G - nsb;
#ifndef NO_CONV
                conv_items(Q, F, l, l == 0 ? MT : NT, ob, nob);
#endif
#ifndef NO_FA
#ifdef PROBE_FA2
                for (int prb_ = 0; prb_ < 2; ++prb_)
#endif
                for (int it = ob; it < 256; it += nob) fourier_a_iter(Q, F, it);
#endif
#ifndef NO_FC
                if (l == 0) for (int u = ob; u < 32; u += nob) fourier_ctx_unit(Q, F, u);
#endif
            }
        } }
        SEAM(pb + 2);
        for (int rep_ = 0; rep_ < NREP(pb + 3); ++rep_) { if (rep_) GRID_BARRIER();
        if (IN(pb + 3)) {
            const Params Q = load_params(); const Frame F = make_frame(lds0, wave0);
            LAS bf16* TC64 = (LAS bf16*)F.lds; LAS bf16* TS64 = TC64 + 64 * TP;
            load_tab64(TC64, WSQ(bf16, TAB_C64), F.tid); load_tab64(TS64, WSQ(bf16, TAB_S64), F.tid);
            __syncthreads();
#ifndef NO_FB
#ifdef PROBE_FB2
            for (int prb_ = 0; prb_ < 2; ++prb_)
#endif
            for (int u = F.bx * NWAVES + F.wave; u < 2048; u += F.G * NWAVES) fourier_b_unit(Q, F, u, TC64, TS64);
#endif
            __syncthreads();
#ifndef NO_FIN
            finalize_phase(Q, F, l, l == 0 ? MT : NT);
#endif
        } }
        SEAM(pb + 3);
        for (int rep_ = 0; rep_ < NREP(pb + 4); ++rep_) { if (rep_) GRID_BARRIER();
        if (IN(pb + 4)) {
            const Params Q = load_params(); const Frame F = make_frame(lds0, wave0);
            const int M = l == 0 ? MT : NT;
#ifdef PROD_OLD
            pg8::Gemm g{WSQ(bf16, WS_H), WSQ(bf16, WS_WOUT) + (size_t)l * D * D, M, D, D}; pg8::StaticOrder S; S.init(M, D, F.G, F.bx);
            pg8::EpiBf16<0> E{WSQ(bf16, WS_O32), D, nullptr, 0, 0, 1.f};
            pg8::gemm_phase<pg8::EpiBf16<0>, pg8::StaticOrder, PG8_ALIGN, PG8_SP2>(F.lds, g, S, E, F.wave);
#else
            pg8::Gemm g{WSQ(bf16, WS_H), WSQ(bf16, WS_WOUT) + (size_t)l * D * D, M, D, D}; pg8::PubOrder<pg8::StaticOrder> S; S.init(M, D, F.G, F.bx); S.cntr = PCNT(l == 0 ? PC_WOUT0 : PC_WOUT1); S.pend = -1;
            pg8::EpiBf16WT E{WSQ(bf16, WS_O32), D, 1 << 20};
            pg8::gemm_phase<pg8::EpiBf16WT, pg8::PubOrder<pg8::StaticOrder>, PG8_ALIGN, PG8_SP2>(F.lds, g, S, E, F.wave);
#endif
        } }
#ifdef KEEP_SEAMS
        SEAM(pb + 4);
#endif
        if (l == 0) {
            if (IN(pb + 5)) { const Params Q = load_params(); const Frame F = make_frame(lds0, wave0); phase_post<0, true, false, true>(Q, F, MT, 0, 2048, 1, Q.in[I_CTX], 0, 2, 4096, 3072, PCNT(PC_WOUT0), PNEED, tail_busy((MT / 256) * (D / 256), F.G)); }
            SEAM(pb + 5);
            for (int rep_ = 0; rep_ < NREP(pb + 6); ++rep_) { if (rep_) GRID_BARRIER();
            if (IN(pb + 6)) {
            const Params Q = load_params(); const Frame F = make_frame(lds0, wave0);
                pg8::Gemm g{WSQ(bf16, WS_H), WSQ(bf16, WS_WGU), MT, 2 * DFF, D}; pg8::StaticOrder S; S.init(MT, 2 * DFF, F.G, F.bx);
                pg8::EpiSwiglu E{WSQ(bf16, WS_Z), DFF, 0, 1 << 20};
                pg8::gemm_phase<pg8::EpiSwiglu, pg8::StaticOrder, PG8_ALIGN, PG8_SP2>(F.lds, g, S, E, F.wave);
            } }
            SEAM(pb + 6);
            for (int rep_ = 0; rep_ < NREP(pb + 7); ++rep_) { if (rep_) GRID_BARRIER();
            if (IN(pb + 7)) {
            const Params Q = load_params(); const Frame F = make_frame(lds0, wave0);
#ifdef PROD_OLD
                pg8::Gemm g{WSQ(bf16, WS_Z), WSQ(bf16, WS_WDN), MT, D, DFF}; pg8::StaticOrder S; S.init(MT, D, F.G, F.bx);
                pg8::EpiBf16<0> E{WSQ(bf16, WS_O32), D, nullptr, 0, 0, 1.f};
                pg8::gemm_phase<pg8::EpiBf16<0>, pg8::StaticOrder, PG8_ALIGN, PG8_SP2>(F.lds, g, S, E, F.wave);
#else
                pg8::Gemm g{WSQ(bf16, WS_Z), WSQ(bf16, WS_WDN), MT, D, DFF}; pg8::PubOrder<pg8::StaticOrder> S; S.init(MT, D, F.G, F.bx); S.cntr = PCNT(PC_DOWN0); S.pend = -1;
                pg8::EpiBf16WT E{WSQ(bf16, WS_O32), D, 1 << 20};
                pg8::gemm_phase<pg8::EpiBf16WT, pg8::PubOrder<pg8::StaticOrder>, PG8_ALIGN, PG8_SP2>(F.lds, g, S, E, F.wave);
#endif
            } }
#ifdef KEEP_SEAMS
            SEAM(pb + 7);
#endif
            if (IN(pb + 8)) { const Params Q = load_params(); const Frame F = make_frame(lds0, wave0); phase_post<0, true, false>(Q, F, MT, 0, 5120, 3, (const float*)(Q.ws + WS_XC), 1, 0, 1024, 0, PCNT(PC_DOWN0), PNEED, tail_busy((MT / 256) * (D / 256), F.G)); }
            SEAM(pb + 8);
        } else {
            if (IN(pb + 5)) { const Params Q = load_params(); const Frame F = make_frame(lds0, wave0); phase_post<0, true, true>(Q, F, NT, 1, 2048, 1, nullptr, 1, 2, 4096, 3072, PCNT(PC_WOUT1), PNEED, tail_busy((NT / 256) * (D / 256), F.G)); }
            SEAM(pb + 5);
            if (IN(pb + 6)) { const Params Q = load_params(); const Frame F = make_frame(lds0, wave0); for (int rep_ = 0; rep_ < NREP(15); ++rep_) convert_moe_weights(Q, F); moe_assign_gather(Q, F); }
            SEAM(pb + 6);
            if (IN(pb + 7)) {
            const Params Q = load_params(); const Frame F = make_frame(lds0, wave0);
                if (F.tid == 0) { MoePlan M; int cnt[NE]; moe_plan(Q, M, cnt);
#pragma unroll
                    for (int j = 0; j < 9; ++j) MISC[16 + j] = (unsigned)M.pb[j]; }
                __syncthreads();
                const int ptot = (int)MISC[16 + 8], gq = (F.G >= 256 && Q.act_cap_panels >= 128) ? 128 : (Q.act_cap_panels < 64 ? Q.act_cap_panels : 64);
                int p0 = 0;
                while (p0 < ptot) {
                    int np = ptot - p0; if (np > Q.act_cap_panels) np = gq;
                    if (np > 0) {
                        for (int rep_ = 0; rep_ < NREP(16); ++rep_) { if (rep_) GRID_BARRIER();
                            pg8::Gemm g{WSQ(bf16, WS_XG), WSQ(bf16, WS_WMGU), 0, 0, D};
                            pg8::MoeOrder S; S.p0 = p0; S.np = np; S.nct = 2 * DFE / 256; S.G = F.G; S.c = F.bx;
#pragma unroll
                            for (int j = 0; j < 9; ++j) S.pb[j] = (int)MISC[16 + j];
                            pg8::EpiSwiglu E{WSQ(bf16, WS_ACTM), DFE, p0, 2 * DFE / 256};
                            pg8::gemm_phase<pg8::EpiSwiglu, pg8::MoeOrder, PG8_ALIGN, PG8_SP2>(F.lds, g, S, E, F.wave);
                        }
                        GRID_BARRIER();
                        for (int rep_ = 0; rep_ < NREP(17); ++rep_) { if (rep_) GRID_BARRIER();
                            pg8::Gemm g{WSQ(bf16, WS_ACTM) - (size_t)p0 * 256 * DFE, WSQ(bf16, WS_WMDN), 0, 0, DFE};
#ifdef PROD_OLD
                            pg8::MoeOrder S; S.p0 = p0; S.np = np; S.nct = D / 256; S.G = F.G; S.c = F.bx;
#pragma unroll
                            for (int j = 0; j < 9; ++j) S.pb[j] = (int)MISC[16 + j];
                            pg8::EpiBf16Mod E{WSQ(bf16, WS_XG), D, D / 256};
                            pg8::gemm_phase<pg8::EpiBf16Mod, pg8::MoeOrder, PG8_ALIGN, PG8_SP2>(F.lds, g, S, E, F.wave);
#else
                            pg8::PubOrder<pg8::MoeOrder> S; S.p0 = p0; S.np = np; S.nct = D / 256; S.G = F.G; S.c = F.bx; S.cntr = PCNT(PC_MOE); S.pend = -1;
#pragma unroll
                            for (int j = 0; j < 9; ++j) S.pb[j] = (int)MISC[16 + j];
                            pg8::EpiBf16WT E{WSQ(bf16, WS_XG), D, D / 256};
                            pg8::gemm_phase<pg8::EpiBf16WT, pg8::PubOrder<pg8::MoeOrder>, PG8_ALIGN, PG8_SP2>(F.lds, g, S, E, F.wave);
#endif
                        }
#ifdef KEEP_SEAMS
                        GRID_BARRIER();
#else
                        if (p0 + np < ptot) GRID_BARRIER();
#endif
                    }
                    p0 += np;
                }
            }
            if (IN(pb + 8)) { const Params Q = load_params(); const Frame F = make_frame(lds0, wave0);
                MoePlan M; int cnt[NE]; moe_plan(Q, M, cnt);
                const int ptot = M.pb[8], gq = (F.G >= 256 && Q.act_cap_panels >= 128) ? 128 : (Q.act_cap_panels < 64 ? Q.act_cap_panels : 64);
                int p0 = 0, np = 0; while (p0 < ptot) { np = ptot - p0; if (np > Q.act_cap_panels) np = gq; if (np <= 0) break; p0 += np; }
                phase_post<1, false, false>(Q, F, NT, 1, 5120, 3, nullptr, 1, 0, 0, 0, PCNT(PC_MOE), PNEED, tail_busy(np * (D / 256), F.G)); }
        }
    }
constexpr int N_PHASES = 18;
__global__ void __launch_bounds__(NTHR, 2) fwd_kernel(Params P) {
    extern __shared__ __attribute__((aligned(16))) unsigned char lds_raw[];
    LAS unsigned char* const lds0 = (LAS unsigned char*)lds_raw;
    volatile LAS unsigned* MISC = (volatile LAS unsigned*)(lds0 + MISC_OFF);
    const int wave0 = __builtin_amdgcn_readfirstlane((int)threadIdx.x >> 6);
    if (wave0 == 0) MISC[__builtin_amdgcn_mbcnt_hi(~0u, __builtin_amdgcn_mbcnt_lo(~0u, 0u))] = 0u;
    __syncthreads();
    unsigned* ctl = (unsigned*)(P.ws + WS_CTL);
    XcdBarrier bar = xcd_barrier_post(ctl + CW_BAR + P.li * XCD_BAR_WORDS, MISC + 8, wave0 == 0 ? 1u : 0u);
    const int lo = P.ph_lo, hi = P.ph_hi;
    for (int rep_ = 0; rep_ < NREP(0); ++rep_) { if (rep_) GRID_BARRIER(); if (IN(0)) { const Params Q = load_params(); const Frame F = make_frame(lds0, wave0); p0_adaln(Q, F); p0_small_weights(Q, F); p0_tables(Q, F); } }
    SEAM(0);
#ifdef PROBE_FN_NOSTORE
    for (int rep_ = 0; rep_ < 2; ++rep_) { if (rep_) GRID_BARRIER(); if (IN(1)) { const Params Q = load_params(); const Frame F = make_frame(lds0, wave0); phase_first_norm(Q, F); } }
#else
    for (int rep_ = 0; rep_ < NREP(1); ++rep_) { if (rep_) GRID_BARRIER(); if (IN(1)) { const Params Q = load_params(); const Frame F = make_frame(lds0, wave0); phase_first_norm(Q, F); } }
#endif
    SEAM(1);
#ifdef PROBE_BAR
    for (int prb_ = 0; prb_ < 20; ++prb_) GRID_BARRIER();
#endif
    layer_phases<0>(bar, lds0, MISC, lo, hi, wave0);
    layer_phases<1>(bar, lds0, MISC, lo, hi, wave0);
#undef IN
#undef SEAM
}

#ifndef MK_PER_PHASE
#define MK_PER_PHASE 0
#endif
extern "C" void kernel_launch(void* const* d_in, const int* in_sizes, int n_in, void* d_out, int out_size, void* d_ws, size_t ws_size, hipStream_t stream) {
    static int grid = 0;
    if (grid == 0) {
        if (n_in != N_IN || in_sizes[0] != NT * D || out_size != NT * D || ws_size < WS_NEED) {
            fprintf(stderr, "kernel_launch: unexpected shapes (n_in %d, in0 %d, out %d, ws %zu); nothing launched\n", n_in, n_in > 0 ? in_sizes[0] : -1, out_size, ws_size); grid = -1; return; }
        int dev = 0, cus = 0, per_cu = 0;
        if (hipGetDevice(&dev) != hipSuccess || hipDeviceGetAttribute(&cus, hipDeviceAttributeMultiprocessorCount, dev) != hipSuccess) { grid = -1; return; }
        if (hipFuncSetAttribute((const void*)fwd_kernel, hipFuncAttributeMaxDynamicSharedMemorySize, LDS_BYTES) != hipSuccess) { fprintf(stderr, "kernel_launch: hipFuncSetAttribute failed\n"); grid = -1; return; }
        if (hipOccupancyMaxActiveBlocksPerMultiprocessor(&per_cu, (const void*)fwd_kernel, NTHR, LDS_BYTES) != hipSuccess || per_cu < 1)
            fprintf(stderr, "kernel_launch: occupancy query reports %d workgroups per CU\n", per_cu);
        (void)hipGetLastError();
        grid = cus;
    }
    if (grid < 0) return;
    if (hipMemsetAsync((char*)d_ws + WS_CTL, 0, CTL_ZERO_BYTES, stream) != hipSuccess) return;
    Params p{};
    for (int i = 0; i < N_IN; ++i) p.in[i] = (const float*)d_in[i];
    p.out = (float*)d_out; p.ws = (unsigned char*)d_ws;
    { size_t avail = ws_size - WS_ACTM; size_t cap = avail / ((size_t)256 * DFE * 2); if (cap > 264) cap = 264; p.act_cap_panels = (int)cap; }
#if MK_PER_PHASE
    int li = 0;
    for (int ph = 0; ph < N_PHASES; ++ph) {
        p.ph_lo = ph; p.ph_hi = ph + 1; p.li = li++;
        hipLaunchKernelGGL(fwd_kernel, dim3(grid), dim3(NTHR), LDS_BYTES, stream, p);
    }
#else
    p.ph_lo = 0; p.ph_hi = N_PHASES; p.li = 0;
    hipLaunchKernelGGL(fwd_kernel, dim3(grid), dim3(NTHR), LDS_BYTES, stream, p);
#endif
}
```

```cpp
#define POST_PLAINLD 1
#include <hip/hip_runtime.h>
#include <cstdio>
#include <cstdint>
namespace pg8 {
#define PG8_LAS __attribute__((address_space(3)))
typedef unsigned short bf16_t;
typedef short bf16x8 __attribute__((ext_vector_type(8)));
typedef float f32x4 __attribute__((ext_vector_type(4)));
typedef unsigned u32x4 __attribute__((ext_vector_type(4)));
constexpr int BM = 256, BK = 64, HALF = 128, HTB = HALF * BK * 2  , STAGE_BYTES = 8 * HTB, NXCD = 8, WGM = 8;

__host__ __device__ __forceinline__ int lds_byte(int r, int c) { const int st = (r >> 4) * 2 + (c >> 5), rr = r & 15, cc = c & 31, ob = rr * 64 + cc * 2; return st * 1024 + (ob ^ (((ob >> 9) & 1) << 5)); }
__host__ __device__ __forceinline__ void stage_rc(int b, int& R, int& C) { const int st = b / 1024, sb = b % 1024, swz = sb ^ (((sb >> 9) & 1) << 5); R = (st >> 1) * 16 + swz / 64; C = (st & 1) * 32 + (swz % 64) / 2; }
__host__ __device__ __forceinline__ int perm32(int rho) { const int n = rho >> 4, i = rho & 15; return 8 * (i >> 2) + 4 * n + (i & 3); }

struct Unit { int pm, pn; };
struct Gemm { const bf16_t* A; const bf16_t* Bt; int M, N, K; };

struct StaticOrder {
    static constexpr bool SPLITK = false;
    int nM, nN, nwg, G, c;
    __host__ __device__ void init(int M, int N, int G_, int c_) { nM = M / BM; nN = N / BM; nwg = nM * nN; G = G_; c = c_; }
    __host__ __device__ bool next(int i, Unit& u) const {
        const long L = (long)i * G + c; if (L >= nwg) return false;
        int wgid = (int)L; { const int q = nwg / NXCD, r = nwg % NXCD, xcd = wgid % NXCD, off = wgid / NXCD; wgid = (xcd < r ? xcd * (q + 1) : r * (q + 1) + (xcd - r) * q) + off; }
        const int nig = WGM * nN, gid = wgid / nig, fm = gid * WGM, gsz = (nM - fm) < WGM ? (nM - fm) : WGM;
        u.pm = fm + ((wgid % nig) % gsz); u.pn = (wgid % nig) / gsz; return true;
    }
    __device__ __forceinline__ void a_ready(const Unit&) const {}
    __device__ __forceinline__ void done(const Unit&) const {}
    __device__ __forceinline__ void flush() const {}
};

__device__ __forceinline__ unsigned cvt_pk_bf16(float lo, float hi) { unsigned r; asm volatile("v_cvt_pk_bf16_f32 %0, %1, %2" : "=v"(r) : "v"(lo), "v"(hi)); return r; }
typedef float f32x2 __attribute__((ext_vector_type(2)));
__device__ __forceinline__ f32x2 gelu_pk(f32x2 v) {
    const f32x2 av = __builtin_elementwise_abs(v), d = av * 0.2316418882f + 1.0f;
    f32x2 t; t.x = __builtin_amdgcn_rcpf(d.x); t.y = __builtin_amdgcn_rcpf(d.y);
    f32x2 q = t * 0.5307027145f + (-0.7265760135f); q = q * t + 0.7107068705f; q = q * t + (-0.142248368f); q = q * t + 0.127414796f; q = q * t;
    const f32x2 s = (v * v) * (-0.72134752044f);
    f32x2 e; e.x = __builtin_amdgcn_exp2f(s.x); e.y = __builtin_amdgcn_exp2f(s.y);
    const f32x2 m = v * (q * e), r = v - m;
    f32x2 o; o.x = v.x < 0.f ? m.x : r.x; o.y = v.y < 0.f ? m.y : r.y; return o;
}

template <int ACT  > struct EpiBf16 {
    static constexpr bool PERM = true, AFTER_DRAIN = false; static_assert(ACT == 0 || ACT == 1, "EpiBf16: ACT is 0 (none) or 1 (gelu_pk)");
    bf16_t* O; int ldc; const float* bias; int split_cols; size_t split_stride; float scale0;
    __device__ __forceinline__ void operator()(const f32x4 (&acc)[2][2][4][2], const Unit& u, int wr, int wc, int fr, int fq) const {
        const int row0 = u.pm * BM + wr * 64 + fr; int colt = u.pn * BM; bf16_t* base = O;
        float sc = 1.f; if (split_cols) { const int t = colt / split_cols; base += (size_t)t * split_stride; colt -= t * split_cols; if (t == 0) sc = scale0; }
        const int col0 = colt + wc * 32 + 8 * fq, bcol0 = u.pn * BM + wc * 32 + 8 * fq;
        f32x4 bv[2][2];
#pragma unroll
        for (int bj = 0; bj < 2; ++bj)
#pragma unroll
            for (int n = 0; n < 2; ++n) bv[bj][n] = bias ? *(const f32x4*)(bias + bcol0 + bj * HALF + 4 * n) : (f32x4){0.f, 0.f, 0.f, 0.f};
#pragma unroll
        for (int ai = 0; ai < 2; ++ai)
#pragma unroll
            for (int m = 0; m < 4; ++m) { bf16_t* rowp = base + (size_t)(row0 + ai * HALF + m * 16) * ldc + col0;
#pragma unroll
                for (int bj = 0; bj < 2; ++bj) { f32x4 v0 = acc[ai][bj][m][0] + bv[bj][0], v1 = acc[ai][bj][m][1] + bv[bj][1];
                    if (ACT == 1) { f32x2 a = gelu_pk((f32x2){v0[0], v0[1]}), b = gelu_pk((f32x2){v0[2], v0[3]}), c = gelu_pk((f32x2){v1[0], v1[1]}), d = gelu_pk((f32x2){v1[2], v1[3]});
                        v0 = (f32x4){a.x, a.y, b.x, b.y}; v1 = (f32x4){c.x, c.y, d.x, d.y}; }
                    v0 = v0 * sc; v1 = v1 * sc; u32x4 w; w.x = cvt_pk_bf16(v0[0], v0[1]); w.y = cvt_pk_bf16(v0[2], v0[3]); w.z = cvt_pk_bf16(v1[0], v1[1]); w.w = cvt_pk_bf16(v1[2], v1[3]);
                    *(u32x4*)(rowp + bj * HALF) = w; } }
    }
};

struct EpiF32 {
    static constexpr bool PERM = false, AFTER_DRAIN = false;
    float* C; int ldc; const float* bias;
    __device__ __forceinline__ void operator()(const f32x4 (&acc)[2][2][4][2], const Unit& u, int wr, int wc, int fr, int fq) const {
        const int row0 = u.pm * BM + wr * 64 + fr, col0 = u.pn * BM + wc * 32 + 4 * fq;
        f32x4 bv[2][2];
#pragma unroll
        for (int bj = 0; bj < 2; ++bj)
#pragma unroll
            for (int n = 0; n < 2; ++n) bv[bj][n] = bias ? *(const f32x4*)(bias + col0 + bj * HALF + n * 16) : (f32x4){0.f, 0.f, 0.f, 0.f};
#pragma unroll
        for (int ai = 0; ai < 2; ++ai)
#pragma unroll
            for (int m = 0; m < 4; ++m) { float* rowp = C + (size_t)(row0 + ai * HALF + m * 16) * ldc + col0;
#pragma unroll
                for (int bj = 0; bj < 2; ++bj)
#pragma unroll
                    for (int n = 0; n < 2; ++n) *(f32x4*)(rowp + bj * HALF + n * 16) = acc[ai][bj][m][n] + bv[bj][n]; }
    }
};
template <class Epi, class Sched, bool ALIGN_EPI = false, bool SP2 = false>
__device__ __forceinline__ void gemm_phase(PG8_LAS unsigned char* lds, const Gemm g, const Sched& S, const Epi& E, const int wave_in) {
    int tid_ = wave_in * 64 + (int)__builtin_amdgcn_mbcnt_hi(~0u, __builtin_amdgcn_mbcnt_lo(~0u, 0u)); asm volatile("" : "+v"(tid_));
    const int tid = tid_, wid = __builtin_amdgcn_readfirstlane(tid >> 6), lane = tid & 63, wr = wid >> 2, wc = wid & 3, fr = lane & 15, fq = lane >> 4;
    const int K = g.K, nt = K / BK;
    unsigned voffA[2], voffB[2];
#pragma unroll
    for (int i = 0; i < 2; ++i) { int R, C; stage_rc(tid * 16 + i * 8192, R, C); const int Rb = Epi::PERM ? ((R & ~31) + perm32(R & 31)) : R;
        voffA[i] = (unsigned)(R * K + C) * 2u; voffB[i] = (unsigned)(Rb * K + C) * 2u; }
    const size_t kstep = (size_t)(BK * 2);
    const size_t hstep = (size_t)HALF * K * 2;
    const size_t tstep = 2 * hstep;
    const unsigned ldsw = (unsigned)wid * 1024u;
    const int aoff = lds_byte(wr * 64 + fr, fq * 8), boff = lds_byte(wc * 32 + fr, fq * 8);
#define PG8_SA(b, h) (((b) * 2 + (h)) * HTB)
#define PG8_SB(b, h) ((4 + (b) * 2 + (h)) * HTB)
#define PG8_STAGE(bufoff, gbase, voff) do { _Pragma("unroll") for (int _i = 0; _i < 2; ++_i) \
        __builtin_amdgcn_global_load_lds((const unsigned*)((const char*)(gbase) + (voff)[_i]), (PG8_LAS unsigned*)(lds + (bufoff) + ldsw + _i * 8192), 16, 0, 0); } while (0)
#define PG8_LDA(dst, b, h) do { _Pragma("unroll") for (int m = 0; m < 4; ++m) _Pragma("unroll") for (int k = 0; k < 2; ++k) dst[m][k] = *(const PG8_LAS bf16x8*)(lds + PG8_SA(b, h) + aoff + m * 2048 + k * 1024); } while (0)
#define PG8_LDB(dst, b, h) do { _Pragma("unroll") for (int n = 0; n < 2; ++n) _Pragma("unroll") for (int k = 0; k < 2; ++k) dst[n][k] = *(const PG8_LAS bf16x8*)(lds + PG8_SB(b, h) + boff + n * 2048 + k * 1024); } while (0)
#define PG8_MMA(ai, bj, At, Bt) do { __builtin_amdgcn_s_setprio(1); _Pragma("unroll") for (int m = 0; m < 4; ++m) _Pragma("unroll") for (int n = 0; n < 2; ++n) _Pragma("unroll") for (int k = 0; k < 2; ++k) \
        acc[ai][bj][m][n] = __builtin_amdgcn_mfma_f32_16x16x32_bf16(Bt[n][k], At[m][k], acc[ai][bj][m][n], 0, 0, 0); __builtin_amdgcn_s_setprio(0); } while (0)
#define PG8_WAIT_V(n) asm volatile("s_waitcnt vmcnt(" #n ")" ::: "memory")
#define PG8_WAIT_L(n) asm volatile("s_waitcnt lgkmcnt(" #n ")" ::: "memory")
#define PG8_BAR __builtin_amdgcn_s_barrier()
#define PG8_SCHED __builtin_amdgcn_sched_barrier(0)
    Unit cur, nxt; int ui = 0;
    if (!S.next(0, cur)) return;
    f32x4 acc[2][2][4][2];
#pragma unroll
    for (int a = 0; a < 2; ++a)
#pragma unroll
        for (int b = 0; b < 2; ++b)
#pragma unroll
            for (int m = 0; m < 4; ++m)
#pragma unroll
                for (int n = 0; n < 2; ++n) acc[a][b][m][n] = (f32x4){0.f, 0.f, 0.f, 0.f};
    bf16x8 At[4][2], B0[2][2], B1[2][2];
    const char* cA = (const char*)g.A + (size_t)cur.pm * tstep; const char* cB = (const char*)g.Bt + (size_t)cur.pn * tstep;
    int cnt = nt;
    if constexpr (Sched::SPLITK) { cnt = S.ktiles(cur, nt); cA += S.kbyte(cur, nt); cB = (const char*)g.Bt + (size_t)S.btile(cur) * tstep + S.kbyte(cur, nt); }
    S.a_ready(cur);
    if constexpr (SP2) {
        PG8_STAGE(PG8_SB(0, 0), cB, voffB); PG8_STAGE(PG8_SB(0, 1), cB + hstep, voffB); PG8_STAGE(PG8_SA(0, 0), cA, voffA); PG8_STAGE(PG8_SA(0, 1), cA + hstep, voffA);
        if (wr == 1) PG8_BAR;
        PG8_WAIT_V(2); PG8_BAR;
        PG8_STAGE(PG8_SB(1, 0), cB + kstep, voffB); PG8_STAGE(PG8_SA(1, 0), cA + kstep, voffA); PG8_STAGE(PG8_SB(1, 1), cB + hstep + kstep, voffB);
        PG8_WAIT_V(6); PG8_BAR;
    } else {
        PG8_STAGE(PG8_SB(0, 0), cB, voffB); PG8_STAGE(PG8_SA(0, 0), cA, voffA); PG8_STAGE(PG8_SB(0, 1), cB + hstep, voffB); PG8_STAGE(PG8_SA(0, 1), cA + hstep, voffA);
        if (wr == 1) PG8_BAR;
        PG8_WAIT_V(4); PG8_BAR;
        PG8_STAGE(PG8_SB(1, 0), cB + kstep, voffB); PG8_STAGE(PG8_SA(1, 0), cA + kstep, voffA); PG8_STAGE(PG8_SB(1, 1), cB + hstep + kstep, voffB);
        PG8_WAIT_V(6); PG8_BAR;
    }
    for (;;) {
        const bool has_next = S.next(ui + 1, nxt);
        const char* nA = has_next ? (const char*)g.A + (size_t)nxt.pm * tstep : cA; const char* nB = has_next ? (const char*)g.Bt + (size_t)nxt.pn * tstep : cB;
        if constexpr (Sched::SPLITK) { if (has_next) { nA += S.kbyte(nxt, nt); nB = (const char*)g.Bt + (size_t)S.btile(nxt) * tstep + S.kbyte(nxt, nt); } }
        for (int t = 0; t < cnt; t += 2) {
            const bool last = (t == cnt - 2);
            const char* a1 = cA + (size_t)(t + 1) * kstep;
            const char* a2 = last ? nA : cA + (size_t)(t + 2) * kstep; const char* b2 = last ? nB : cB + (size_t)(t + 2) * kstep;
            const char* a3 = a2 + kstep; const char* b3 = b2 + kstep;
            if (last && has_next) S.a_ready(nxt);
            if constexpr (SP2) {
            PG8_LDB(B0, 0, 0); PG8_LDB(B1, 0, 1); PG8_SCHED; PG8_LDA(At, 0, 0); PG8_STAGE(PG8_SA(1, 1), a1 + hstep, voffA);
            PG8_WAIT_V(8); PG8_WAIT_L(0); PG8_BAR; PG8_MMA(0, 0, At, B0); PG8_MMA(0, 1, At, B1); PG8_BAR; PG8_SCHED;
            PG8_LDA(At, 0, 1); PG8_STAGE(PG8_SB(0, 0), b2, voffB); PG8_STAGE(PG8_SB(0, 1), b2 + hstep, voffB); PG8_STAGE(PG8_SA(0, 0), a2, voffA);
            PG8_WAIT_V(8); PG8_WAIT_L(0); PG8_BAR; PG8_MMA(1, 0, At, B0); PG8_MMA(1, 1, At, B1); PG8_BAR; PG8_SCHED;
            PG8_LDB(B0, 1, 0); PG8_LDB(B1, 1, 1); PG8_SCHED; PG8_LDA(At, 1, 0); PG8_STAGE(PG8_SA(0, 1), a2 + hstep, voffA);
            PG8_WAIT_V(8); PG8_WAIT_L(0); PG8_BAR; PG8_MMA(0, 0, At, B0); PG8_MMA(0, 1, At, B1); PG8_BAR; PG8_SCHED;
            PG8_LDA(At, 1, 1); PG8_STAGE(PG8_SB(1, 0), b3, voffB); PG8_STAGE(PG8_SB(1, 1), b3 + hstep, voffB); PG8_STAGE(PG8_SA(1, 0), a3, voffA);
            PG8_WAIT_V(8); PG8_WAIT_L(0); PG8_BAR; PG8_MMA(1, 0, At, B0); PG8_MMA(1, 1, At, B1); PG8_BAR; PG8_SCHED;
            } else {
            PG8_LDB(B0, 0, 0); PG8_SCHED; PG8_LDA(At, 0, 0); PG8_STAGE(PG8_SA(1, 1), a1 + hstep, voffA);
            PG8_WAIT_L(8); PG8_BAR; PG8_WAIT_L(0); PG8_MMA(0, 0, At, B0); PG8_BAR; PG8_SCHED;
            PG8_LDB(B1, 0, 1); PG8_STAGE(PG8_SB(0, 0), b2, voffB);
            PG8_BAR; PG8_WAIT_L(0); PG8_MMA(0, 1, At, B1); PG8_BAR;
            PG8_LDA(At, 0, 1); PG8_STAGE(PG8_SA(0, 0), a2, voffA);
            PG8_BAR; PG8_WAIT_L(0); PG8_MMA(1, 0, At, B0); PG8_BAR; PG8_SCHED;
            PG8_STAGE(PG8_SB(0, 1), b2 + hstep, voffB);
            PG8_WAIT_V(6); PG8_BAR; PG8_MMA(1, 1, At, B1); PG8_BAR;
            PG8_LDB(B0, 1, 0); PG8_SCHED; PG8_LDA(At, 1, 0); PG8_STAGE(PG8_SA(0, 1), a2 + hstep, voffA);
            PG8_WAIT_L(8); PG8_BAR; PG8_WAIT_L(0); PG8_MMA(0, 0, At, B0); PG8_BAR; PG8_SCHED;
            PG8_LDB(B1, 1, 1); PG8_STAGE(PG8_SB(1, 0), b3, voffB);
            PG8_BAR; PG8_WAIT_L(0); PG8_MMA(0, 1, At, B1); PG8_BAR;
            PG8_LDA(At, 1, 1); PG8_STAGE(PG8_SA(1, 0), a3, voffA);
            PG8_BAR; PG8_WAIT_L(0); PG8_MMA(1, 0, At, B0); PG8_BAR; PG8_SCHED;
            PG8_STAGE(PG8_SB(1, 1), b3 + hstep, voffB);
            PG8_WAIT_V(6); PG8_BAR; PG8_MMA(1, 1, At, B1); PG8_BAR;
            }
        }
        if constexpr (ALIGN_EPI) { if (wr == 0) PG8_BAR; }
        if constexpr (!Epi::AFTER_DRAIN) { E(acc, cur, wr, wc, fr, fq); S.done(cur); }
        if (!has_next) break;
#pragma unroll
        for (int a = 0; a < 2; ++a)
#pragma unroll
            for (int b = 0; b < 2; ++b)
#pragma unroll
                for (int m = 0; m < 4; ++m)
#pragma unroll
                    for (int n = 0; n < 2; ++n) acc[a][b][m][n] = (f32x4){0.f, 0.f, 0.f, 0.f};
        cur = nxt; cA = nA; cB = nB; ++ui;
        if constexpr (Sched::SPLITK) cnt = S.ktiles(cur, nt);
        if constexpr (ALIGN_EPI) { if (wr == 1) PG8_BAR; }
    }
    PG8_WAIT_V(0);
    S.flush();
    if constexpr (!ALIGN_EPI) { if (wr == 0) PG8_BAR; }
    PG8_BAR;
    if constexpr (Epi::AFTER_DRAIN) { E.fused(acc, cur, wr, wc, fr, fq, lds, wid, lane); S.done(cur); }
#undef PG8_SA
#undef PG8_SB
#undef PG8_STAGE
#undef PG8_LDA
#undef PG8_LDB
#undef PG8_MMA
#undef PG8_WAIT_V
#undef PG8_WAIT_L
#undef PG8_BAR
#undef PG8_SCHED
}
}

namespace pg8 {
struct EpiSwiglu {
    static constexpr bool PERM = true, AFTER_DRAIN = false;
    bf16_t* O; int ldo; int p0; int nct;
    __device__ __forceinline__ void operator()(const f32x4 (&acc)[2][2][4][2], const Unit& u, int wr, int wc, int fr, int fq) const {
        const int row0 = (u.pm - p0) * BM + wr * 64 + fr, col0 = (u.pn % nct) * HALF + wc * 32 + 8 * fq;
#pragma unroll
        for (int ai = 0; ai < 2; ++ai)
#pragma unroll
            for (int m = 0; m < 4; ++m) { bf16_t* rowp = O + (size_t)(row0 + ai * HALF + m * 16) * ldo + col0;
                float a[8];
#pragma unroll
                for (int n = 0; n < 2; ++n)
#pragma unroll
                    for (int j = 0; j < 4; ++j) { const float g = acc[ai][0][m][n][j], up = acc[ai][1][m][n][j]; a[n * 4 + j] = g * __builtin_amdgcn_rcpf(1.0f + __expf(-g)) * up; }
                u32x4 w; w.x = cvt_pk_bf16(a[0], a[1]); w.y = cvt_pk_bf16(a[2], a[3]); w.z = cvt_pk_bf16(a[4], a[5]); w.w = cvt_pk_bf16(a[6], a[7]);
                *(u32x4*)rowp = w; }
    }
};
struct EpiBf16Mod {
    static constexpr bool PERM = true, AFTER_DRAIN = false;
    bf16_t* O; int ldc; int nct;
    __device__ __forceinline__ void operator()(const f32x4 (&acc)[2][2][4][2], const Unit& u, int wr, int wc, int fr, int fq) const {
        const int row0 = u.pm * BM + wr * 64 + fr, col0 = (u.pn % nct) * BM + wc * 32 + 8 * fq;
#pragma unroll
        for (int ai = 0; ai < 2; ++ai)
#pragma unroll
            for (int m = 0; m < 4; ++m) { bf16_t* rowp = O + (size_t)(row0 + ai * HALF + m * 16) * ldc + col0;
#pragma unroll
                for (int bj = 0; bj < 2; ++bj) { const f32x4 v0 = acc[ai][bj][m][0], v1 = acc[ai][bj][m][1];
                    u32x4 w; w.x = cvt_pk_bf16(v0[0], v0[1]); w.y = cvt_pk_bf16(v0[2], v0[3]); w.z = cvt_pk_bf16(v1[0], v1[1]); w.w = cvt_pk_bf16(v1[2], v1[3]);
                    *(u32x4*)(rowp + bj * HALF) = w; } }
    }
};
struct MoeOrder {
    static constexpr bool SPLITK = false;
    int p0, np, nct, G, c; int pb[9];
    __device__ __forceinline__ bool next(int i, Unit& u) const {
        const int L = i * G + c; if (L >= np * nct) return false;
        const int nig = WGM * nct, gid = L / nig, fm = gid * WGM, gsz = (np - fm) < WGM ? (np - fm) : WGM, r = L % nig;
        const int pm = p0 + fm + (r % gsz), ct = r / gsz;
        int e = 0;
#pragma unroll
        for (int j = 1; j < 8; ++j) e += (pm >= pb[j]) ? 1 : 0;
        u.pm = pm; u.pn = e * nct + ct; return true;
    }
    __device__ __forceinline__ void a_ready(const Unit&) const {}
    __device__ __forceinline__ void done(const Unit&) const {}
    __device__ __forceinline__ void flush() const {}
};
#ifndef WT_AUX
#define WT_AUX 16
#endif
struct EpiBf16WT {
    static constexpr bool PERM = true, AFTER_DRAIN = false;
    bf16_t* O; int ldc; int nct;
    __device__ __forceinline__ void operator()(const f32x4 (&acc)[2][2][4][2], const Unit& u, int wr, int wc, int fr, int fq) const {
        const __amdgpu_buffer_rsrc_t rs = __builtin_amdgcn_make_buffer_rsrc(O, 0, 0x7ffffff0, 0x00020000);
        const unsigned row0 = (unsigned)(u.pm * BM + wr * 64 + fr), col0 = (unsigned)((u.pn % nct) * BM + wc * 32 + 8 * fq);
#pragma unroll
        for (int ai = 0; ai < 2; ++ai)
#pragma unroll
            for (int m = 0; m < 4; ++m) { const unsigned off = ((row0 + (unsigned)(ai * HALF + m * 16)) * (unsigned)ldc + col0) * 2u;
#pragma unroll
                for (int bj = 0; bj < 2; ++bj) { const f32x4 v0 = acc[ai][bj][m][0], v1 = acc[ai][bj][m][1];
                    u32x4 w; w.x = cvt_pk_bf16(v0[0], v0[1]); w.y = cvt_pk_bf16(v0[2], v0[3]); w.z = cvt_pk_bf16(v1[0], v1[1]); w.w = cvt_pk_bf16(v1[2], v1[3]);
                    __builtin_amdgcn_raw_buffer_store_b128(w, rs, off + (unsigned)(bj * HALF * 2), 0, WT_AUX); } }
    }
};
constexpr int SPLIT_FLAG = 1 << 14;
struct SplitOrder {
    static constexpr bool SPLITK = true;
    int p0, np, nct, G, c; int pb[9];
    int nfull, S;
    __device__ __forceinline__ void init_split(int S_) { const int nu = np * nct, R = nu / G, T = nu - R * G; if (S_ > 1 && R >= 1 && T > 0 && T * S_ <= G && (T % nct) == 0) { nfull = R * G; S = S_; } else { nfull = nu; S = 1; } }
    __device__ __forceinline__ int tail_panels() const { return (np * nct - nfull) / nct; }
    __device__ __forceinline__ bool next(int i, Unit& u) const {
        const int L = i * G + c; int pm, ct, ks = -1;
        if (L < nfull) { const int nig = WGM * nct, gid = L / nig, fm = gid * WGM, gsz = (np - fm) < WGM ? (np - fm) : WGM, r = L % nig; pm = p0 + fm + (r % gsz); ct = r / gsz; }
        else { if (S == 1) return false; const int j = L - nfull, tp = tail_panels(); if (j >= tp * nct * S) return false; const int rest = j / tp; pm = p0 + nfull / nct + (j % tp); ct = rest % nct; ks = rest / nct; }
        int e = 0;
#pragma unroll
        for (int j = 1; j < 8; ++j) e += (pm >= pb[j]) ? 1 : 0;
        u.pm = pm; u.pn = ks < 0 ? (e * nct + ct) : (SPLIT_FLAG | (ks << 6) | (e * nct + ct)); return true;
    }
    __device__ __forceinline__ int ktiles(const Unit& u, int nt) const { if (!(u.pn & SPLIT_FLAG)) return nt; const int ks = (u.pn >> 6) & 15, pairs = nt >> 1, q = pairs / S, r = pairs - q * S; return 2 * (q + (ks < r ? 1 : 0)); }
    __device__ __forceinline__ size_t kbyte(const Unit& u, int nt) const { if (!(u.pn & SPLIT_FLAG)) return 0; const int ks = (u.pn >> 6) & 15, pairs = nt >> 1, q = pairs / S, r = pairs - q * S; return (size_t)(ks * q + (ks < r ? ks : r)) * (2 * BK * 2); }
    __device__ __forceinline__ int btile(const Unit& u) const { return u.pn & 63; }
    __device__ __forceinline__ void a_ready(const Unit&) const {}
    __device__ __forceinline__ void done(const Unit&) const {}
    __device__ __forceinline__ void flush() const {}
};
struct EpiSplitWT {
    static constexpr bool PERM = true, AFTER_DRAIN = false;
    bf16_t* O; int ldc; int nct; float* part; int ptail0; int tail_rows;
    __device__ __forceinline__ void operator()(const f32x4 (&acc)[2][2][4][2], const Unit& u, int wr, int wc, int fr, int fq) const {
        const unsigned col0 = (unsigned)(((u.pn & 63) % nct) * BM + wc * 32 + 8 * fq);
        if (!(u.pn & SPLIT_FLAG)) {
            const __amdgpu_buffer_rsrc_t rs = __builtin_amdgcn_make_buffer_rsrc(O, 0, 0x7ffffff0, 0x00020000);
            const unsigned row0 = (unsigned)(u.pm * BM + wr * 64 + fr);
#pragma unroll
            for (int ai = 0; ai < 2; ++ai)
#pragma unroll
                for (int m = 0; m < 4; ++m) { const unsigned off = ((row0 + (unsigned)(ai * HALF + m * 16)) * (unsigned)ldc + col0) * 2u;
#pragma unroll
                    for (int bj = 0; bj < 2; ++bj) { const f32x4 v0 = acc[ai][bj][m][0], v1 = acc[ai][bj][m][1];
                        u32x4 w; w.x = cvt_pk_bf16(v0[0], v0[1]); w.y = cvt_pk_bf16(v0[2], v0[3]); w.z = cvt_pk_bf16(v1[0], v1[1]); w.w = cvt_pk_bf16(v1[2], v1[3]);
                        __builtin_amdgcn_raw_buffer_store_b128(w, rs, off + (unsigned)(bj * HALF * 2), 0, WT_AUX); } }
        } else {
            const __amdgpu_buffer_rsrc_t rs = __builtin_amdgcn_make_buffer_rsrc(part, 0, 0x7ffffff0, 0x00020000);
            const unsigned row0 = (unsigned)(((u.pn >> 6) & 15) * tail_rows + (u.pm - ptail0) * BM + wr * 64 + fr);
#pragma unroll
            for (int ai = 0; ai < 2; ++ai)
#pragma unroll
                for (int m = 0; m < 4; ++m) { const unsigned off = ((row0 + (unsigned)(ai * HALF + m * 16)) * (unsigned)ldc + col0) * 4u;
#pragma unroll
                    for (int bj = 0; bj < 2; ++bj) {
                        __builtin_amdgcn_raw_buffer_store_b128(__builtin_bit_cast(u32x4, acc[ai][bj][m][0]), rs, off + (unsigned)(bj * HALF * 4), 0, WT_AUX);
                        __builtin_amdgcn_raw_buffer_store_b128(__builtin_bit_cast(u32x4, acc[ai][bj][m][1]), rs, off + (unsigned)(bj * HALF * 4 + 16), 0, WT_AUX); } }
        }
    }
};
template <class Base> struct PubOrder : Base {
    unsigned* cntr; mutable int pend;
    __device__ __forceinline__ void pub() const {
        if (pend >= 0) { if (__builtin_amdgcn_mbcnt_hi(~0u, __builtin_amdgcn_mbcnt_lo(~0u, 0u)) == 0u) __hip_atomic_fetch_add(cntr + 16 * pend, 1u, __ATOMIC_RELAXED, __HIP_MEMORY_SCOPE_AGENT); pend = -1; }
    }
    __device__ __forceinline__ void a_ready(const Unit& u) const { Base::a_ready(u); pub(); }
    __device__ __forceinline__ void done(const Unit& u) const {
#ifdef PUB_EAGER
        asm volatile("s_waitcnt vmcnt(0)" ::: "memory"); pend = u.pm; pub();
#else
        pub(); pend = u.pm;
#endif
    }
    __device__ __forceinline__ void flush() const { pub(); }
};
}

constexpr int NWAVES = 8, NTHR = 512;
constexpr int D = 1024, NB = 8, SEQ = 4096, LC = 256, NT = NB * SEQ, NC = NB * LC, MT = NT + NC;
constexpr int DIN = 2944, NZ = 3072;
constexpr int C_K = 0, C_V = 512, C_WLO = 1024, C_ALO = 1152, C_R = 1280, C_GLO = 1792, C_U = 1920, C_GB = 2176, C_GC = 2432, C_F = 2688;
constexpr int DFF = 2816, NE = 8, DFE = 3584;
constexpr float NORM_EPS = 1e-6f, GN_EPS = 64e-5f;
constexpr int TP = 72;
enum { I_X = 0, I_C, I_CTX, I_CCTX, I_ADAW, I_ADAB, I_NORMG, I_WIN, I_WOUT, I_MU, I_MUW, I_MUA, I_W0, I_W2, I_A0, I_A2, I_G2, I_KK, I_KA, I_RK, I_GNW, I_GNB, I_CONVW,
       I_FG, I_FU, I_FD, I_RW, I_RB, I_MG, I_MUP, I_MD, N_IN };

constexpr size_t KiB = 1024, MiB = 1u << 20;
constexpr size_t WS_CTL = 0, CTL_ZERO_BYTES = 512 * KiB;
constexpr size_t WS_MOD = 512 * KiB;
constexpr size_t WS_TAB = 960 * KiB;
constexpr size_t TAB_E = WS_TAB;
constexpr size_t TAB_TWC = TAB_E + 64 * 512 * 4;
constexpr size_t TAB_TWS = TAB_TWC + 4096 * 4;
constexpr size_t TAB_C64 = TAB_TWS + 4096 * 4;
constexpr size_t TAB_S64 = TAB_C64 + 64 * 64 * 2;
constexpr size_t TAB_SN64 = TAB_S64 + 64 * 64 * 2;
constexpr size_t WS_ROUTE = 1152 * KiB;
constexpr size_t WS_TOKPOS = WS_ROUTE + (size_t)NT * 16;
static_assert(TAB_SN64 + 64 * 64 * 2 <= WS_ROUTE && WS_TOKPOS + (size_t)NT * 8 <= 2 * MiB, "low ws map");
constexpr size_t WS_Z = 2 * MiB;
constexpr size_t WS_SW = 206 * MiB;
constexpr size_t WS_WIN = WS_SW;
constexpr size_t WS_WOUT = WS_WIN + 2ull * NZ * D * 2;
constexpr size_t WS_WGU = WS_WOUT + 2ull * D * D * 2;
constexpr size_t WS_WDN = WS_WGU + 2ull * DFF * D * 2;
constexpr size_t WS_G2T = WS_WDN + (size_t)D * DFF * 2;
constexpr size_t WS_C256 = WS_G2T + 2ull * 512 * 128 * 2;
constexpr size_t WS_SN256 = WS_C256 + 256 * 256 * 2;
constexpr size_t WS_W2TG = WS_SN256 + 256 * 256 * 2;
constexpr size_t WS_A2TG = WS_W2TG + 4ull * 512 * 64 * 2;
constexpr size_t WS_XC = 244 * MiB;
static_assert(WS_A2TG + 4ull * 512 * 64 * 2 <= WS_XC, "small weights");
constexpr size_t WS_RING = 252 * MiB;
constexpr size_t WS_O32 = 381 * MiB;
constexpr size_t WS_YS = WS_O32;
constexpr size_t WS_YBUF = WS_YS + 2ull * MT * 512 * 2;
constexpr size_t WS_PARTD = WS_YBUF;
constexpr size_t WS_BONG = WS_YBUF + 32 * MiB;
constexpr size_t WS_H = 517 * MiB;
static_assert(WS_BONG + 2ull * MT * 8 * 4 <= WS_H && WS_Z + (size_t)MT * NZ * 2 <= WS_SW && WS_O32 + (size_t)MT * D * 4 <= WS_H, "ws map");
constexpr size_t WS_NEED = 585 * MiB;
static_assert(WS_H + (size_t)MT * D * 2 <= WS_NEED, "ws map end");
constexpr size_t WS_WMGU = 2 * MiB;
constexpr size_t WS_WMDN = WS_WMGU + 8ull * 2 * DFE * D * 2;
constexpr size_t WS_XG = 170 * MiB;
constexpr int XG_ROWS_CAP = 69632;
constexpr size_t WS_ACTM = 306 * MiB;
static_assert(WS_WMDN + 8ull * D * DFE * 2 <= WS_XG && WS_XG + (size_t)XG_ROWS_CAP * D * 2 <= WS_ACTM, "moe ws map");
constexpr int CW_TMO = 0;
constexpr int CW_CNT = 2048, CW_FILL = 3072;
constexpr int CW_BAR = 8192;
constexpr int MAX_LAUNCHES = 20;
constexpr int CW_PROD = 81920, CW_CONS = 81920 + 8192;
constexpr int CW_PCNT = 114688;
constexpr int PC_WOUT0 = 0, PC_DOWN0 = 2176, PC_WOUT1 = 4352, PC_MOE = 6528;
static_assert(CW_CONS + 16384 + 64 * 128 <= CW_PCNT && (CW_PCNT + PC_MOE + 16 * 272) * 4 <= (int)CTL_ZERO_BYTES, "control words");

constexpr int LDS_BYTES = 163840;
constexpr int MISC_OFF = LDS_BYTES - 256;

#define GAS __attribute__((address_space(1)))
#define LAS __attribute__((address_space(3)))
typedef unsigned short bf16;
typedef unsigned v4u __attribute__((ext_vector_type(4)));
typedef unsigned v2u __attribute__((ext_vector_type(2)));
typedef float f32x4 __attribute__((ext_vector_type(4)));
typedef float f32x2 __attribute__((ext_vector_type(2)));
typedef short bf16x8 __attribute__((ext_vector_type(8)));
typedef short bf16x4 __attribute__((ext_vector_type(4)));
#define LDS_WAIT() asm volatile("s_waitcnt lgkmcnt(0)" ::: "memory")
typedef __bf16 bf16x2n __attribute__((ext_vector_type(2)));
__device__ __forceinline__ unsigned pk2(float lo, float hi) { const f32x2 v = {lo, hi}; return __builtin_bit_cast(unsigned, __builtin_convertvector(v, bf16x2n)); }
__device__ __forceinline__ unsigned f2bf(float f) { return pk2(f, f) & 0xffffu; }
__device__ __forceinline__ float bflo(unsigned w) { return __builtin_bit_cast(float, w << 16); }
__device__ __forceinline__ float bfhi(unsigned w) { return __builtin_bit_cast(float, w & 0xffff0000u); }
__device__ __forceinline__ float bf1(bf16 b) { return __builtin_bit_cast(float, (unsigned)b << 16); }
template <int CTRL> __device__ __forceinline__ float dpp_mov(float v) { return __builtin_bit_cast(float, __builtin_amdgcn_update_dpp(0, __builtin_bit_cast(int, v), CTRL, 0xf, 0xf, true)); }
__device__ __forceinline__ float wave_sum(float v) {
    v += dpp_mov<0xB1>(v); v += dpp_mov<0x4E>(v); v += dpp_mov<0x141>(v); v += dpp_mov<0x140>(v);
    const int b = __builtin_bit_cast(int, v);
    const float s0 = __builtin_bit_cast(float, __builtin_amdgcn_readlane(b, 0)), s1 = __builtin_bit_cast(float, __builtin_amdgcn_readlane(b, 16));
    const float s2 = __builtin_bit_cast(float, __builtin_amdgcn_readlane(b, 32)), s3 = __builtin_bit_cast(float, __builtin_amdgcn_readlane(b, 48));
    return (s0 + s1) + (s2 + s3);
}
__device__ __forceinline__ float sigmoidf_(float x) { return __builtin_amdgcn_rcpf(1.0f + __expf(-x)); }
#define MFMA16(a, b, c) __builtin_amdgcn_mfma_f32_16x16x32_bf16((a), (b), (c), 0, 0, 0)
#define XB_TMO      128
#define XB_XCNT(j)  (256  + 64 * (j))
#define XB_XSUB(j)  (1280 + 64 * (j))
#define XB_XGEN(j)  (2304 + 64 * (j))
#define XB_TOP      3328
#define XB_TOPGEN   3392
#define XCD_BAR_WORDS 3456
#define XB_SPIN_CAP (1u << 18)
#define LAS __attribute__((address_space(3)))

__device__ __forceinline__ unsigned xb_ld(unsigned* p)              { return __hip_atomic_load(p, __ATOMIC_RELAXED, __HIP_MEMORY_SCOPE_AGENT); }
__device__ __forceinline__ unsigned xb_add(unsigned* p, unsigned v) { return __hip_atomic_fetch_add(p, v, __ATOMIC_RELAXED, __HIP_MEMORY_SCOPE_AGENT); }
__device__ __forceinline__ unsigned xb_xcc_id() { return (unsigned)__builtin_amdgcn_s_getreg((3 << 11) | 20) & 0xFu; }
#define XB_SPIN(cond, bar) do { unsigned _sp = 0; while (cond) { __builtin_amdgcn_s_sleep(1); \
    if ((++_sp & 255u) == 0u) { if (xb_ld(&(bar)[XB_TMO])) break; if (_sp > XB_SPIN_CAP) { atomicAdd(&(bar)[XB_TMO], 1u); break; } } } } while (0)

struct XcdBarrier {
    unsigned w0;
    unsigned* bar; unsigned x;
    volatile LAS unsigned* st;
};

__device__ __forceinline__ bool xb_lane0() { return __builtin_amdgcn_mbcnt_hi(~0u, __builtin_amdgcn_mbcnt_lo(~0u, 0u)) == 0u; }
__device__ __forceinline__ XcdBarrier xcd_barrier_post(unsigned* bar, volatile LAS unsigned* st, unsigned w0) {
    XcdBarrier b; b.w0 = w0; b.bar = bar; b.x = xb_xcc_id(); b.st = st;
    if (w0 && xb_lane0()) (void)xb_add(&bar[XB_XCNT(b.x)], 1u);
    return b;
}
__device__ __forceinline__ void xcd_barrier_complete(unsigned* bar, unsigned x, unsigned& nloc, unsigned& nx) {
    const unsigned G = gridDim.x * gridDim.y * gridDim.z;
    unsigned sum, cnt, mine, sp = 0u;
    for (;;) {
        sum = 0u; cnt = 0u; mine = 0u;
#pragma unroll
        for (unsigned j = 0; j < 16; ++j) { const unsigned c = xb_ld(&bar[XB_XCNT(j)]); sum += c; cnt += (c > 0u) ? 1u : 0u; mine = (j == x) ? c : mine; }
        if (sum == G) break;
        __builtin_amdgcn_s_sleep(1);
        if ((++sp & 255u) == 0u) { if (xb_ld(&bar[XB_TMO])) break; if (sp > XB_SPIN_CAP) { atomicAdd(&bar[XB_TMO], 1u); break; } }
    }
    nloc = mine > 0u ? mine : 1u; nx = cnt > 0u ? cnt : 1u;
}

__device__ __forceinline__ void xcd_barrier(const XcdBarrier& b) {
    asm volatile("s_waitcnt vmcnt(0)" ::: "memory");
    __syncthreads();
    if (b.w0 && xb_lane0()) {
        unsigned* bar = b.bar;
        __builtin_amdgcn_s_waitcnt(0);
        unsigned nloc = b.st[0], nx = b.st[1];
        if (nloc == 0u) { xcd_barrier_complete(bar, b.x, nloc, nx); b.st[0] = nloc; b.st[1] = nx; }
        const unsigned old = xb_add(&bar[XB_XSUB(b.x)], 1u);
        const unsigned gen = old / nloc;
        if (old + 1u == (gen + 1u) * nloc) {
            __builtin_amdgcn_fence(__ATOMIC_RELEASE, "agent");
            asm volatile("s_waitcnt vmcnt(0)" ::: "memory");
            const unsigned og = xb_add(&bar[XB_TOP], 1u);
            const unsigned tg = og / nx;
            if (og + 1u == (tg + 1u) * nx) xb_add(&bar[XB_TOPGEN], 1u);
            else XB_SPIN(xb_ld(&bar[XB_TOPGEN]) == tg, bar);
            __builtin_amdgcn_fence(__ATOMIC_ACQUIRE, "agent");
            xb_add(&bar[XB_XGEN(b.x)], 1u);
            asm volatile("s_waitcnt vmcnt(0)" ::: "memory");
        } else {
            XB_SPIN(xb_ld(&bar[XB_XGEN(b.x)]) == gen, bar);
            __builtin_amdgcn_fence(__ATOMIC_ACQUIRE, "agent");
            asm volatile("s_waitcnt vmcnt(0)" ::: "memory");
        }
    }
    __syncthreads();
}


struct Params {
    const float* in[N_IN];
    float* out;
    unsigned char* ws;
    int act_cap_panels;
    int ph_lo, ph_hi, li;
};
static_assert(sizeof(Params) == N_IN * 8 + 8 + 8 + 16, "Params has no padding");

struct Frame {
    LAS unsigned char* lds;
    int tid, lane, wave, G, bx;
};
#define WSP(T, off) ((T*)(P.ws + (off)))

__device__ __forceinline__ void transpose_item(const float* W, int N, bf16* WT, int ldk, int k0, int n0, int out_row0, LAS float* scr, int lane) {
#pragma unroll 8
    for (int i = 0; i < 32; ++i) { const int kk = 2 * i + (lane >> 5); scr[kk * 33 + (lane & 31)] = W[(size_t)(k0 + kk) * N + n0 + (lane & 31)]; }
    LDS_WAIT(); asm volatile("" ::: "memory");
    const int c = lane & 7;
#pragma unroll
    for (int j = 0; j < 4; ++j) { const int n = (lane >> 3) + 8 * j; const LAS float* s = scr + (8 * c) * 33 + n;
        v4u o; o.x = pk2(s[0 * 33], s[1 * 33]); o.y = pk2(s[2 * 33], s[3 * 33]); o.z = pk2(s[4 * 33], s[5 * 33]); o.w = pk2(s[6 * 33], s[7 * 33]);
        *(v4u*)(WT + (size_t)(out_row0 + n) * ldk + k0 + 8 * c) = o; }
    LDS_WAIT(); asm volatile("" ::: "memory");
}
__device__ __forceinline__ int gu_row(int n, int up) { return (n >> 7) * 256 + up * 128 + (n & 127); }

__device__ __forceinline__ void p0_small_weights(const Params& P, const Frame& F) {
    LAS float* scr = (LAS float*)(F.lds + F.wave * 16384);
    const int gw = F.bx * NWAVES + F.wave, NGW = F.G * NWAVES;
    constexpr int I_IN = 16 * 92, I_OUT = 16 * 32, I_GU = 16 * 88, I_DN = 44 * 32, I_GT = 2 * 16, I_LR = 16;
    constexpr int NITEMS = 2 * I_IN + 2 * I_OUT + 2 * I_GU + I_DN + 2 * I_GT + 8 * I_LR;
    for (int it = gw; it < NITEMS; it += NGW) {
        int r = it;
        if (r < 2 * I_IN) { const int l = r / I_IN; r %= I_IN; const int kb = r / 92, nb = r % 92;
            transpose_item(P.in[I_WIN] + (size_t)l * D * DIN, DIN, WSP(bf16, WS_WIN) + (size_t)l * NZ * D, D, 64 * kb, 32 * nb, 32 * nb, scr, F.lane); continue; } r -= 2 * I_IN;
        if (r < 2 * I_OUT) { const int l = r / I_OUT; r %= I_OUT; const int kb = r / 32, nb = r % 32;
            transpose_item(P.in[I_WOUT] + (size_t)l * D * D, D, WSP(bf16, WS_WOUT) + (size_t)l * D * D, D, 64 * kb, 32 * nb, 32 * nb, scr, F.lane); continue; } r -= 2 * I_OUT;
        if (r < 2 * I_GU) { const int up = r / I_GU; r %= I_GU; const int kb = r / 88, nb = r % 88;
            transpose_item(P.in[up ? I_FU : I_FG], DFF, WSP(bf16, WS_WGU), D, 64 * kb, 32 * nb, gu_row(32 * nb, up), scr, F.lane); continue; } r -= 2 * I_GU;
        if (r < I_DN) { const int kb = r / 32, nb = r % 32;
            transpose_item(P.in[I_FD], D, WSP(bf16, WS_WDN), DFF, 64 * kb, 32 * nb, 32 * nb, scr, F.lane); continue; } r -= I_DN;
        if (r < 2 * I_GT) { const int l = r / I_GT; r %= I_GT; const int kb = r / 16, nb = r % 16;
            transpose_item(P.in[I_G2] + (size_t)l * 128 * 512, 512, WSP(bf16, WS_G2T) + (size_t)l * 512 * 128, 128, 64 * kb, 32 * nb, 32 * nb, scr, F.lane); continue; } r -= 2 * I_GT;
        { const int which = r / (4 * I_LR); r %= 4 * I_LR; const int ldi = r / I_LR, nb = r % I_LR;
            transpose_item(P.in[which ? I_A2 : I_W2] + (size_t)ldi * 64 * 512, 512, WSP(bf16, which ? WS_A2TG : WS_W2TG) + (size_t)ldi * 512 * 64, 64, 0, 32 * nb, 32 * nb, scr, F.lane); }
    }
    { const int gt = F.bx * NTHR + F.tid, NGT = F.G * NTHR; constexpr int NV = 2 * (NZ - DIN) * D / 8;
        for (int i = gt; i < NV; i += NGT) { const int l = i / ((NZ - DIN) * D / 8), r = i % ((NZ - DIN) * D / 8);
            *(v4u*)(WSP(bf16, WS_WIN) + (size_t)l * NZ * D + (size_t)DIN * D + (size_t)r * 8) = (v4u){0u, 0u, 0u, 0u}; } }
}
__device__ __forceinline__ void p0_tables(const Params& P, const Frame& F) {
    const int gt = F.bx * NTHR + F.tid, NGT = F.G * NTHR;
    float* E = WSP(float, TAB_E);
    for (int i = gt; i < 64 * 256; i += NGT) { const int n = i >> 8, q = i & 255;
        const float omega = 1.0f / powf(10000.0f, (float)q / 256.0f), ang = (float)n * omega;
        E[n * 512 + q] = sinf(ang); E[n * 512 + 256 + q] = cosf(ang); }
    float* twc = WSP(float, TAB_TWC); float* tws = WSP(float, TAB_TWS);
    for (int i = gt; i < 4096; i += NGT) { const float a = (float)i / 2048.0f; twc[i] = cospif(a); tws[i] = sinpif(a); }
    bf16* c64 = WSP(bf16, TAB_C64); bf16* s64 = WSP(bf16, TAB_S64); bf16* sn64 = WSP(bf16, TAB_SN64);
    for (int i = gt; i < 64 * 64; i += NGT) { const int m = ((i >> 6) * (i & 63)) & 63; const float a = (float)m / 32.0f; const float c = cospif(a), s = sinpif(a);
        c64[i] = (bf16)f2bf(c); s64[i] = (bf16)f2bf(s); sn64[i] = (bf16)f2bf(-s); }
    bf16* c256 = WSP(bf16, WS_C256); bf16* sn256 = WSP(bf16, WS_SN256);
    for (int i = gt; i < 256 * 256; i += NGT) { const int m = ((i >> 8) * (i & 255)) & 255; const float a = (float)m / 128.0f;
        c256[i] = (bf16)f2bf(cospif(a)); sn256[i] = (bf16)f2bf(-sinpif(a)); }
}
__device__ __forceinline__ void p0_adaln(const Params& P, const Frame& F) {
    LAS float* sc = (LAS float*)F.lds;
    LAS float* red = sc + 9 * 1024;
    for (int u = F.bx; u < 192; u += F.G) {
        const int l = u / 96, cb = u % 96;
        for (int i = F.tid; i < 9 * 1024; i += NTHR) { const int r = i >> 10, d = i & 1023; const float v = r < 8 ? P.in[I_C][r * 1024 + d] : P.in[I_CCTX][d]; sc[i] = v / (1.0f + expf(-v)); }
        __syncthreads();
        const int col = F.tid & 63, ks = F.tid >> 6;
        float acc[9];
#pragma unroll
        for (int r = 0; r < 9; ++r) acc[r] = 0.f;
        const float* w = P.in[I_ADAW] + ((size_t)l * 1024 + ks * 128) * 6144 + cb * 64 + col;
#pragma unroll 2
        for (int k = 0; k < 128; k += 8) {
            float wv[8];
#pragma unroll
            for (int q = 0; q < 8; ++q) wv[q] = w[(size_t)(k + q) * 6144];
#pragma unroll
            for (int r = 0; r < 9; ++r) { const f32x4 s4 = *(const LAS f32x4*)(sc + r * 1024 + ks * 128 + k), s5 = *(const LAS f32x4*)(sc + r * 1024 + ks * 128 + k + 4);
                acc[r] += (s4.x * wv[0] + s4.y * wv[1] + s4.z * wv[2] + s4.w * wv[3]) + (s5.x * wv[4] + s5.y * wv[5] + s5.z * wv[6] + s5.w * wv[7]); }
        }
#pragma unroll
        for (int r = 0; r < 9; ++r) red[(ks * 9 + r) * 64 + col] = acc[r];
        __syncthreads();
        for (int i = F.tid; i < 9 * 64; i += NTHR) { const int r = i >> 6, c = i & 63; float s = 0.f;
#pragma unroll
            for (int k = 0; k < 8; ++k) s += red[(k * 9 + r) * 64 + c];
            WSP(float, WS_MOD)[(size_t)(l * 9 + r) * 6144 + cb * 64 + c] = s + P.in[I_ADAB][l * 6144 + cb * 64 + c]; }
        __syncthreads();
    }
}
__device__ __forceinline__ void convert_moe_weights(const Params& P, const Frame& F) {
    LAS float* scr = (LAS float*)(F.lds + F.wave * 16384);
    const int gw = F.bx * NWAVES + F.wave, NGW = F.G * NWAVES;
    constexpr int I_GU = 16 * 112, I_DN = 56 * 32, NITEMS = NE * (2 * I_GU + I_DN);
    for (int it = gw; it < NITEMS; it += NGW) {
        const int e = it / (2 * I_GU + I_DN); int r = it % (2 * I_GU + I_DN);
        if (r < 2 * I_GU) { const int up = r / I_GU; r %= I_GU; const int kb = r / 112, nb = r % 112;
            transpose_item(P.in[up ? I_MUP : I_MG] + (size_t)e * D * DFE, DFE, WSP(bf16, WS_WMGU) + (size_t)e * 2 * DFE * D, D, 64 * kb, 32 * nb, gu_row(32 * nb, up), scr, F.lane); }
        else { r -= 2 * I_GU; const int kb = r / 32, nb = r % 32;
            transpose_item(P.in[I_MD] + (size_t)e * DFE * D, D, WSP(bf16, WS_WMDN) + (size_t)e * D * DFE, DFE, 64 * kb, 32 * nb, 32 * nb, scr, F.lane); }
    }
}

__device__ __forceinline__ void store_h_row(bf16* hrow, int lane, const f32x4 (&h)[4]) {
#pragma unroll
    for (int j = 0; j < 4; ++j) { v2u w; w.x = pk2(h[j].x, h[j].y); w.y = pk2(h[j].z, h[j].w); *(v2u*)(hrow + 4 * lane + 256 * j) = w; }
}
__device__ __forceinline__ void norm_mod(const f32x4 (&x)[4], int lane, const float* ng, const float* sc, const float* sh, f32x4 (&h)[4]) {
    float ss = 0.f;
#pragma unroll
    for (int j = 0; j < 4; ++j) ss += (x[j].x * x[j].x + x[j].y * x[j].y) + (x[j].z * x[j].z + x[j].w * x[j].w);
    const float rs = rsqrtf(wave_sum(ss) * (1.0f / D) + NORM_EPS);
#pragma unroll
    for (int j = 0; j < 4; ++j) { const int c = 4 * lane + 256 * j; const f32x4 g = *(const f32x4*)(ng + c), s1 = *(const f32x4*)(sc + c), s0 = *(const f32x4*)(sh + c);
        h[j] = (x[j] * rs * g) * (1.0f + s1) + s0; }
}
__device__ __forceinline__ void phase_first_norm(const Params& P, const Frame& F) {
    const int gw = F.bx * NWAVES + F.wave, NGW = F.G * NWAVES, lane = F.lane;
    const float* E = WSP(float, TAB_E); const float* mod = WSP(float, WS_MOD); bf16* H = WSP(bf16, WS_H);
    const float* ng = P.in[I_NORMG];
    f32x4 xn[4];
    auto src = [&](int row) -> const float* { return row < NT ? P.in[I_X] + (size_t)row * D : P.in[I_CTX] + (size_t)(row - NT) * D; };
    if (gw < MT) { const float* xr = src(gw);
#pragma unroll
        for (int j = 0; j < 4; ++j) xn[j] = *(const f32x4*)(xr + 4 * lane + 256 * j); }
    for (int row = gw; row < MT; row += NGW) {
        f32x4 x[4];
#pragma unroll
        for (int j = 0; j < 4; ++j) x[j] = xn[j];
        if (row + NGW < MT) { const float* xr = src(row + NGW);
#pragma unroll
            for (int j = 0; j < 4; ++j) xn[j] = *(const f32x4*)(xr + 4 * lane + 256 * j); }
        int mr = 8;
        if (row < NT) { const int p = row & (SEQ - 1); mr = row >> 12;
#pragma unroll
            for (int j = 0; j < 4; ++j) { const int c = 4 * lane + 256 * j; const float* e = (j < 2) ? (E + (p >> 6) * 512 + c) : (E + (p & 63) * 512 + (c - 512));
                x[j] = x[j] + *(const f32x4*)e; }
        }
        const float* m = mod + (size_t)(0 * 9 + mr) * 6144;
        f32x4 h[4]; norm_mod(x, lane, ng, m + 1024, m, h);
        store_h_row(H + (size_t)row * D, lane, h);
    }
}
#ifndef POST_SLEEP
#define POST_SLEEP 4
#endif
#ifdef POST_PLAINLD
__device__ __forceinline__ v2u ld8_agent(const void* p) { return *(const v2u*)p; }
#else
__device__ __forceinline__ v2u ld8_agent(const void* p) { return __builtin_bit_cast(v2u, __hip_atomic_load((const unsigned long long*)p, __ATOMIC_RELAXED, __HIP_MEMORY_SCOPE_AGENT)); }
#endif
template <int MODE, bool NEXT, bool ROUTE, bool FIRST = false>
__device__ __forceinline__ void phase_post(const Params& P, const Frame& F, int nrows, int l, int goff, int ngp_idx, const float* xc_src, int ln, int ngn_idx, int scoff, int shoff,
                                           const unsigned* pcnt, unsigned need, int nbusy, int nexcl, const float* part = nullptr, int srow0 = 0x7fffffff, int S = 1, int tail_rows = 0) {
    const bool busy = F.bx < nbusy; const int lane = F.lane;
    const int gwa = F.bx * NWAVES + F.wave, NGWA = F.G * NWAVES, gwf = (F.bx - nbusy) * NWAVES + F.wave, NGWF = (F.G - nbusy) * NWAVES;
    const int KE = busy ? 0 : (nexcl + NGWF - 1) / NGWF, KS = (nrows - nexcl + NGWA - 1) / NGWA;
    auto rowq = [&](int q) -> int { return q < KE ? (gwf + q * NGWF) : (nexcl + gwa + (q - KE) * NGWA); };
    const float* mod = WSP(float, WS_MOD); bf16* H = WSP(bf16, WS_H); const bf16* O32 = WSP(bf16, WS_O32);
    const float* ngp = P.in[I_NORMG] + (size_t)(l * 4 + ngp_idx) * D;
    const float* ngn = P.in[I_NORMG] + (size_t)(ln * 4 + ngn_idx) * D;
    int cnt[NE];
#pragma unroll
    for (int e = 0; e < NE; ++e) cnt[e] = 0;
    v2u on0[4], on1[4]; f32x4 xnx[4]; float pn0 = 0.f, pn1 = 0.f;
    auto xsrc = [&](int row) -> const float* { return row < NT ? ((FIRST ? P.in[I_X] : (const float*)P.out) + (size_t)row * D) : (xc_src + (size_t)(row - NT) * D); };
    auto ldrow = [&](v2u (&dst)[4], const bf16* orow, int srow) {
        if (srow < 0) {
#pragma unroll
            for (int j = 0; j < 4; ++j) dst[j] = ld8_agent(orow + 4 * lane + 256 * j);
        } else {
            f32x4 a[4];
#pragma unroll
            for (int j = 0; j < 4; ++j) a[j] = (f32x4){0.f, 0.f, 0.f, 0.f};
            for (int ks = 0; ks < S; ++ks) { const float* pr = part + ((size_t)ks * tail_rows + srow) * D;
#pragma unroll
                for (int j = 0; j < 4; ++j) a[j] = a[j] + *(const f32x4*)(pr + 4 * lane + 256 * j); }
#pragma unroll
            for (int j = 0; j < 4; ++j) { dst[j].x = pk2(a[j].x, a[j].y); dst[j].y = pk2(a[j].z, a[j].w); }
        }
    };
    auto fetch = [&](int row) {
        if (MODE == 0) {
            ldrow(on0, O32 + (size_t)row * D, row >= srow0 ? row - srow0 : -1);
        } else {
            const int4 rt = *(const int4*)(P.ws + WS_ROUTE + (size_t)row * 16); const int2 tp = *(const int2*)(P.ws + WS_TOKPOS + (size_t)row * 8);
            pn0 = __builtin_bit_cast(float, rt.y); pn1 = __builtin_bit_cast(float, rt.z);
            ldrow(on0, WSP(bf16, WS_XG) + (size_t)tp.x * D, tp.x >= srow0 ? tp.x - srow0 : -1); ldrow(on1, WSP(bf16, WS_XG) + (size_t)tp.y * D, tp.y >= srow0 ? tp.y - srow0 : -1);
        }
        const float* xs = xsrc(row);
#pragma unroll
        for (int j = 0; j < 4; ++j) xnx[j] = *(const f32x4*)(xs + 4 * lane + 256 * j);
    };
    for (int qb = 0; qb < KE + KS; qb += 64) {
    const int myq = qb + lane, myrow = rowq(myq); const bool valid = myq < KE ? (myrow < nexcl) : (myq < KE + KS && myrow < nrows);
    const unsigned* w0 = pcnt; const unsigned* w1 = pcnt; unsigned nd0 = need, nd1 = need;
    if (valid) { if (MODE == 0) { w0 = w1 = pcnt + 16 * (myrow >> 8); if (myrow >= srow0) nd0 = need * (unsigned)S; }
                 else { const int2 tp = *(const int2*)(P.ws + WS_TOKPOS + (size_t)myrow * 8); w0 = pcnt + 16 * (tp.x >> 8); w1 = pcnt + 16 * (tp.y >> 8); if (tp.x >= srow0) nd0 = need * (unsigned)S; if (tp.y >= srow0) nd1 = need * (unsigned)S; } }
    unsigned long long rem = __ballot(valid); unsigned spins = 0;
    while (rem) {
        bool rdy = false;
        if ((rem >> lane) & 1ull) { rdy = __hip_atomic_load(w0, __ATOMIC_RELAXED, __HIP_MEMORY_SCOPE_AGENT) >= nd0; if (MODE != 0) rdy = rdy && __hip_atomic_load(w1, __ATOMIC_RELAXED, __HIP_MEMORY_SCOPE_AGENT) >= nd1; }
        unsigned long long now = __ballot(rdy);
        if (!now) {
            __builtin_amdgcn_s_sleep(POST_SLEEP);
            if (++spins <= (1u << 15)) continue;
            if (lane == 0) { unsigned* tmo = WSP(unsigned, WS_CTL) + CW_TMO; __hip_atomic_store(tmo, 1u, __ATOMIC_RELAXED, __HIP_MEMORY_SCOPE_AGENT); __hip_atomic_fetch_max(tmo + 1, 0xB00u, __ATOMIC_RELAXED, __HIP_MEMORY_SCOPE_AGENT); }
            now = rem;
        }
        asm volatile("" ::: "memory");
        rem &= ~now;
        int kcur = __ffsll((long long)now) - 1; now &= now - 1ull;
        fetch(rowq(qb + kcur));
    for (;;) {
        const int row = rowq(qb + kcur);
        const int knext = now ? (__ffsll((long long)now) - 1) : -1; now &= now - 1ull;
        const int mr = row < NT ? (row >> 12) : 8;
        f32x4 o[4], xin[4];
#pragma unroll
        for (int j = 0; j < 4; ++j) { xin[j] = xnx[j];
            if (FIRST && row < NT) { const int p = row & (SEQ - 1), c = 4 * lane + 256 * j; const float* e = (j < 2) ? (WSP(float, TAB_E) + (p >> 6) * 512 + c) : (WSP(float, TAB_E) + (p & 63) * 512 + (c - 512)); xin[j] = xin[j] + *(const f32x4*)e; }
            if (MODE == 0) o[j] = (f32x4){bflo(on0[j].x), bfhi(on0[j].x), bflo(on0[j].y), bfhi(on0[j].y)};
            else o[j] = (f32x4){pn0 * bflo(on0[j].x) + pn1 * bflo(on1[j].x), pn0 * bfhi(on0[j].x) + pn1 * bfhi(on1[j].x), pn0 * bflo(on0[j].y) + pn1 * bflo(on1[j].y), pn0 * bfhi(on0[j].y) + pn1 * bfhi(on1[j].y)}; }
        if (knext >= 0) fetch(rowq(qb + knext));
        float ss = 0.f;
#pragma unroll
        for (int j = 0; j < 4; ++j) ss += (o[j].x * o[j].x + o[j].y * o[j].y) + (o[j].z * o[j].z + o[j].w * o[j].w);
        const float rs = rsqrtf(wave_sum(ss) * (1.0f / D) + NORM_EPS);
        float* xd = row < NT ? (P.out + (size_t)row * D) : (WSP(float, WS_XC) + (size_t)(row - NT) * D);
        const float* m = mod + (size_t)(l * 9 + mr) * 6144;
        f32x4 x[4];
#pragma unroll
        for (int j = 0; j < 4; ++j) { const int c = 4 * lane + 256 * j; const f32x4 g = *(const f32x4*)(m + goff + c), n = *(const f32x4*)(ngp + c);
            x[j] = xin[j] + g * (o[j] * rs * n); *(f32x4*)(xd + c) = x[j]; }
        if (NEXT) {
            const float* mn = mod + (size_t)(ln * 9 + mr) * 6144;
            f32x4 h[4]; norm_mod(x, lane, ngn, mn + scoff, mn + shoff, h);
            store_h_row(H + (size_t)row * D, lane, h);
            if (ROUTE) {
                float lg[NE];
#pragma unroll
                for (int e = 0; e < NE; ++e) lg[e] = 0.f;
                const float* rw = P.in[I_RW];
#pragma unroll
                for (int j = 0; j < 4; ++j)
#pragma unroll
                    for (int q = 0; q < 4; ++q) { const int c = 4 * lane + 256 * j + q; const f32x4 w0 = *(const f32x4*)(rw + c * 8), w1 = *(const f32x4*)(rw + c * 8 + 4); const float hv = h[j][q];
                        lg[0] += hv * w0.x; lg[1] += hv * w0.y; lg[2] += hv * w0.z; lg[3] += hv * w0.w; lg[4] += hv * w1.x; lg[5] += hv * w1.y; lg[6] += hv * w1.z; lg[7] += hv * w1.w; }
#pragma unroll
                for (int e = 0; e < NE; ++e) lg[e] = wave_sum(lg[e]) + P.in[I_RB][e];
                int i0 = 0; float v0 = lg[0];
#pragma unroll
                for (int e = 1; e < NE; ++e) if (lg[e] > v0) { v0 = lg[e]; i0 = e; }
                int i1 = -1; float v1 = -3.0e38f;
#pragma unroll
                for (int e = 0; e < NE; ++e) if (e != i0 && lg[e] > v1) { v1 = lg[e]; i1 = e; }
                const float e1 = expf(v1 - v0), p0 = 1.0f / (1.0f + e1), p1 = e1 / (1.0f + e1);
                if (lane == 0) *(int4*)(P.ws + WS_ROUTE + (size_t)row * 16) = make_int4(i0 | (i1 << 8), __builtin_bit_cast(int, p0), __builtin_bit_cast(int, p1), 0);
#pragma unroll
                for (int e = 0; e < NE; ++e) cnt[e] += (e == i0 || e == i1) ? 1 : 0;
            }
        }
        if (knext < 0) break;
        kcur = knext;
    }
    }
    }
    if (ROUTE) {
        if (lane == 0) {
#pragma unroll
            for (int e = 0; e < NE; ++e) if (cnt[e]) __hip_atomic_fetch_add(WSP(unsigned, WS_CTL) + CW_CNT + 64 * e, (unsigned)cnt[e], __ATOMIC_RELAXED, __HIP_MEMORY_SCOPE_AGENT);
        }
    }
}

constexpr int TB = 64;
typedef short bf16x4s __attribute__((ext_vector_type(4)));
#define MFMA16K(a, b, c) __builtin_amdgcn_mfma_f32_16x16x16bf16_1k((a), (b), (c), 0, 0, 0)
__device__ __forceinline__ float fexp(float x) { return __builtin_amdgcn_exp2f(x * 1.44269504089f); }
__device__ __forceinline__ float flog(float x) { return __builtin_amdgcn_logf(x) * 0.69314718056f; }
__device__ __forceinline__ float frcp(float x) { return __builtin_amdgcn_rcpf(x); }
__device__ __forceinline__ float softplusf_(float x) { return fmaxf(x, 0.f) + flog(1.0f + fexp(-fabsf(x))); }
__device__ __forceinline__ float ftanh(float x) { return 1.0f - 2.0f * frcp(1.0f + fexp(2.0f * x)); }
__device__ __forceinline__ f32x4 ld4bf(const bf16* p) { const v2u w = *(const v2u*)p; return (f32x4){bflo(w.x), bfhi(w.x), bflo(w.y), bfhi(w.y)}; }
template <int CTRL> __device__ __forceinline__ float dppf(float v) { return __builtin_bit_cast(float, __builtin_amdgcn_update_dpp(0, __builtin_bit_cast(int, v), CTRL, 0xf, 0xf, true)); }
__device__ __forceinline__ float sum8(float v) { v += dppf<0xB1>(v); v += dppf<0x4E>(v); v += dppf<0x141>(v); return v; }
__device__ __forceinline__ bf16x4s pack4(f32x4 v) { v2u w; w.x = pk2(v.x, v.y); w.y = pk2(v.z, v.w); return __builtin_bit_cast(bf16x4s, w); }
__device__ __forceinline__ void unpack8(v4u w, float (&o)[8]) {
#pragma unroll
    for (int q = 0; q < 4; ++q) { o[2 * q] = bflo(w[q]); o[2 * q + 1] = bfhi(w[q]); } }
__device__ __forceinline__ v4u pack8(const float (&o)[8]) { v4u w;
#pragma unroll
    for (int q = 0; q < 4; ++q) w[q] = pk2(o[2 * q], o[2 * q + 1]);
    return w; }
struct ScanPre { v4u kc, kp, vc, vp, rc, rp, wc, wp, ac, ap; };
__device__ __forceinline__ int scan_row(int bi, int tk, int b, int dir, bool& hp, int& prow) {
    const int seq = bi >= LC / TB, c = seq ? bi - LC / TB : bi, len = seq ? SEQ : LC, rowbase = seq ? b * SEQ : NT + b * LC;
    const int ts = c * TB + tk, t = dir ? (len - 1 - ts) : ts;
    hp = dir ? (t + 1 < len) : (t > 0);
    prow = rowbase + (hp ? (dir ? t + 1 : t - 1) : t);
    return rowbase + t;
}
__device__ __forceinline__ void scan_prefetch(const bf16* Z, int bi, int tk, int b, int dir, int gc, int c8, ScanPre& R) {
    bool hp; int prow; const int row = scan_row(bi, tk, b, dir, hp, prow);
    const bf16* zrk = Z + (size_t)row * NZ + gc; const bf16* zpk = Z + (size_t)prow * NZ + gc;
    const bf16* zrw = Z + (size_t)row * NZ + C_WLO + 64 * dir + c8; const bf16* zpw = Z + (size_t)prow * NZ + C_WLO + 64 * dir + c8;
    R.kc = *(const v4u*)(zrk + C_K); R.vc = *(const v4u*)(zrk + C_V); R.rc = *(const v4u*)(zrk + C_R); R.wc = *(const v4u*)(zrw); R.ac = *(const v4u*)(zrw + (C_ALO - C_WLO));
    R.kp = *(const v4u*)(zpk + C_K); R.vp = *(const v4u*)(zpk + C_V); R.rp = *(const v4u*)(zpk + C_R); R.wp = *(const v4u*)(zpw); R.ap = *(const v4u*)(zpw + (C_ALO - C_WLO));
}
__device__ __forceinline__ void lerp8(v4u cur, v4u prv, bool hp, const LAS float* mu, float (&o)[8]) {
    if (!hp) prv = (v4u){0u, 0u, 0u, 0u};
    const f32x4 m0 = *(const LAS f32x4*)mu, m1 = *(const LAS f32x4*)(mu + 4);
#pragma unroll
    for (int q = 0; q < 4; ++q) {
        const f32x2 c2 = {bflo(cur[q]), bfhi(cur[q])}, p2 = {bflo(prv[q]), bfhi(prv[q])};
        const f32x2 m2 = q < 2 ? (f32x2){m0[2 * q], m0[2 * q + 1]} : (f32x2){m1[2 * q - 4], m1[2 * q - 3]};
        const f32x2 r2 = c2 + (p2 - c2) * m2;
        o[2 * q] = r2.x; o[2 * q + 1] = r2.y; }
}
#define RLX_AGENT __ATOMIC_RELAXED, __HIP_MEMORY_SCOPE_AGENT
typedef GAS unsigned gu32;
constexpr unsigned kSpinCap = 1u << 17;
__device__ __forceinline__ bool wait_ge(gu32* word, unsigned want, gu32* tmo, unsigned code, int lane) {
    for (unsigned spins = 0;;) {
        if ((unsigned)__builtin_amdgcn_readfirstlane(__hip_atomic_load(word, RLX_AGENT)) >= want) return true;
        __builtin_amdgcn_s_sleep(1);
        if (++spins > kSpinCap) { if (lane == 0) { __hip_atomic_store(tmo, 1u, RLX_AGENT); __hip_atomic_fetch_max(tmo + 1, code, RLX_AGENT); } return false; }
        if ((spins & 255u) == 0u && __builtin_amdgcn_readfirstlane(__hip_atomic_load(tmo, RLX_AGENT))) return false;
    }
}
constexpr int XFER_PIECES = 3264, XFER_SLOT_BYTES = 52480, XFER_SLOTS = 6;
static_assert(WS_RING + 128ull * XFER_SLOTS * XFER_SLOT_BYTES <= WS_O32, "hand-off rings fit below the O buffer");
__device__ __forceinline__ int xfer_lds_off(int i) { return i < 1536 ? 20992 + 16 * i : (i < 2688 ? 45568 + 16 * (i - 1536) : 102912 + 16 * (i - 2688)); }
__device__ __forceinline__ void scan_unit(const Params& P, const Frame& F, int l, int b, int h, int dir, int role) {
    LAS unsigned char* L0 = F.lds;
    LAS bf16* W2T = (LAS bf16*)L0;
    LAS bf16* A2T = (LAS bf16*)(L0 + 9216);
    LAS float* CST = (LAS float*)(L0 + 18432);
    LAS bf16* TWb = (LAS bf16*)(L0 + 20992);
    LAS bf16* ALb = TWb + TB * TP;
    LAS bf16* BH = (LAS bf16*)(L0 + 20992);
    LAS bf16* KH = BH + 4 * 64 * 16;
    LAS bf16* Vt = KH + 4 * 64 * 16;
    LAS float* LW = (LAS float*)(L0 + 45568);
    constexpr int LWP = 68;
    LAS float* LA = LW + TB * LWP;
    LAS bf16* AT = (LAS bf16*)(L0 + 45568);
    LAS bf16* RT = AT + TB * TP; LAS bf16* BT = RT + TB * TP; LAS bf16* KT = BT + TB * TP;
    LAS float* CUM = (LAS float*)(L0 + 82432);
    LAS float* LabF = (LAS float*)(L0 + 98816);
    LAS bf16* LakB = (LAS bf16*)(L0 + 102912);
    LAS bf16* TtB = LakB + 1024; LAS bf16* MrbB = TtB + 1024; LAS bf16* MrkB = MrbB + 1024;
    LAS float* PCb = (LAS float*)(L0 + 111104);
    LAS float* YB = (LAS float*)(L0 + 112128);
    LAS float* BONl = (LAS float*)(L0 + 128512);
    const int tid = F.tid, lane = F.lane, w = F.wave, fr = lane & 15, fq = lane >> 4;
    const int tk = tid >> 3, c8 = (tid & 7) * 8, gc = 64 * h + c8;
    const int ld = l * 2 + dir;
    for (int i = tid; i < 4096; i += NTHR) { const int j = i >> 6, c = i & 63;
        W2T[c * TP + j] = (bf16)f2bf(P.in[I_W2][((size_t)ld * 64 + j) * 512 + 64 * h + c]); A2T[c * TP + j] = (bf16)f2bf(P.in[I_A2][((size_t)ld * 64 + j) * 512 + 64 * h + c]); }
    if (tid < 64) { const int c = 64 * h + tid;
        CST[0 * 64 + tid] = P.in[I_MU][(size_t)(ld * 3 + 0) * 512 + c]; CST[1 * 64 + tid] = P.in[I_MU][(size_t)(ld * 3 + 1) * 512 + c]; CST[2 * 64 + tid] = P.in[I_MU][(size_t)(ld * 3 + 2) * 512 + c];
        CST[3 * 64 + tid] = P.in[I_MUW][ld * 64 + tid]; CST[4 * 64 + tid] = P.in[I_MUA][ld * 64 + tid];
        CST[5 * 64 + tid] = P.in[I_W0][ld * 512 + c]; CST[6 * 64 + tid] = P.in[I_A0][ld * 512 + c];
        CST[7 * 64 + tid] = P.in[I_KK][l * 512 + c]; CST[8 * 64 + tid] = P.in[I_KA][l * 512 + c]; CST[9 * 64 + tid] = P.in[I_RK][l * 512 + c]; }
    const bf16* Z = WSP(bf16, WS_Z);
    bf16* YS = WSP(bf16, WS_YS) + (size_t)dir * MT * 512;
    float* BONG = WSP(float, WS_BONG) + (size_t)dir * MT * 8;
    f32x4 St[4];
#pragma unroll
    for (int kt = 0; kt < 4; ++kt) St[kt] = (f32x4){0.f, 0.f, 0.f, 0.f};
    constexpr int NBT = LC / TB + SEQ / TB;
    const int sid = (b * 8 + h) * 2 + dir;
    gu32* ctlw = (gu32*)WSP(unsigned, WS_CTL);
    gu32* prodw = ctlw + CW_PROD + l * 16384 + 64 * sid; gu32* consw = ctlw + CW_CONS + l * 16384 + 64 * sid;
    unsigned char* ring = P.ws + WS_RING + (size_t)sid * (XFER_SLOTS * XFER_SLOT_BYTES);
    v4u XR[7];
    ScanPre R; scan_prefetch(Z, role == 1 ? 1 : 0, tk, b, dir, gc, c8, R);
    __syncthreads();
    for (int bi = (role == 1 ? 1 : 0); bi < NBT; ++bi) {
        const bool mine = (role == 2) || ((bi % 2 == 0) == (role == 0));
        if (role == 1 && !mine) continue;
        const int hj = bi >> 1;
        const int bstep = role == 2 ? 1 : 2;
        const bool need_out = (bi >= LC / TB) || (l == 0);
        bool hp; int prow; const int row = scan_row(bi, tk, b, dir, hp, prow); (void)prow;
#ifdef PROBE_PREP2
        for (int prb_ = 0; prb_ < 2; ++prb_)
#endif
        if (mine) {
        if (role == 1 && hj >= XFER_SLOTS) { if (w == 0) wait_ge(consw, (unsigned)(hj - XFER_SLOTS + 1), ctlw + CW_TMO, 0x900u, lane); __syncthreads(); }
        float kx[8], vx[8], rx[8];
        { float wl[8], al[8];
          lerp8(R.kc, R.kp, hp, CST + 0 * 64 + c8, kx); lerp8(R.vc, R.vp, hp, CST + 1 * 64 + c8, vx); lerp8(R.rc, R.rp, hp, CST + 2 * 64 + c8, rx);
          lerp8(R.wc, R.wp, hp, CST + 3 * 64 + c8, wl); lerp8(R.ac, R.ap, hp, CST + 4 * 64 + c8, al);
#pragma unroll
          for (int j = 0; j < 8; ++j) wl[j] = ftanh(wl[j]);
          *(LAS v4u*)(TWb + tk * TP + c8) = pack8(wl); *(LAS v4u*)(ALb + tk * TP + c8) = pack8(al); }
        if (bi + bstep < NBT) scan_prefetch(Z, bi + bstep, tk, b, dir, gc, c8, R);
        __syncthreads();
        { const int mt = w & 3;
          bf16x8 yt[2], ya[2];
#pragma unroll
          for (int k2 = 0; k2 < 2; ++k2) { yt[k2] = *(const LAS bf16x8*)(TWb + (16 * mt + fr) * TP + 32 * k2 + 8 * fq); ya[k2] = *(const LAS bf16x8*)(ALb + (16 * mt + fr) * TP + 32 * k2 + 8 * fq); }
#pragma unroll
          for (int n2 = 0; n2 < 2; ++n2) { const int nt = 2 * (w >> 2) + n2;
              f32x4 cw = {0.f, 0.f, 0.f, 0.f}, ca = {0.f, 0.f, 0.f, 0.f};
#pragma unroll
              for (int k2 = 0; k2 < 2; ++k2) {
                  cw = MFMA16(*(const LAS bf16x8*)(W2T + (16 * nt + fr) * TP + 32 * k2 + 8 * fq), yt[k2], cw);
                  ca = MFMA16(*(const LAS bf16x8*)(A2T + (16 * nt + fr) * TP + 32 * k2 + 8 * fq), ya[k2], ca); }
              *(LAS f32x4*)(LW + (16 * mt + fr) * LWP + 16 * nt + 4 * fq) = cw; *(LAS f32x4*)(LA + (16 * mt + fr) * LWP + 16 * nt + 4 * fq) = ca; } }
        __syncthreads();
        float na[8], pb[8], km[8];
        {
            float n2 = 0.f, bon = 0.f, ew[8];
#pragma unroll
            for (int hf = 0; hf < 2; ++hf) {
#pragma unroll
                for (int j = 4 * hf; j < 4 * hf + 4; ++j) {
                    const float aw = LW[tk * LWP + c8 + j], aa = LA[tk * LWP + c8 + j];
                    ew[j] = 0.6065306597f * frcp(1.0f + fexp(-(CST[5 * 64 + c8 + j] + aw)));
                    const float ag = frcp(1.0f + fexp(-(CST[6 * 64 + c8 + j] + aa)));
                    const float kk = kx[j] * CST[7 * 64 + c8 + j]; n2 += kk * kk;
                    km[j] = kx[j] * (1.0f + (ag - 1.0f) * CST[8 * 64 + c8 + j]);
                    bon += rx[j] * km[j] * CST[9 * 64 + c8 + j];
                    na[j] = kk; pb[j] = ag;
                }
                __builtin_amdgcn_sched_barrier(0);
            }
            n2 = sum8(n2); bon = sum8(bon);
            const float inv = frcp(fmaxf(__builtin_amdgcn_sqrtf(n2), 1e-12f));
#pragma unroll
            for (int j = 0; j < 8; ++j) { const float kkn = na[j] * inv; na[j] = -kkn; pb[j] = kkn * pb[j]; }
            *(LAS f32x4*)(CUM + tk * 64 + c8) = (f32x4){ew[0], ew[1], ew[2], ew[3]} * 1.44269504089f; *(LAS f32x4*)(CUM + tk * 64 + c8 + 4) = (f32x4){ew[4], ew[5], ew[6], ew[7]} * 1.44269504089f;
            if ((tid & 7) == 0 && need_out) BONG[(size_t)row * 8 + h] = bon;
        }
        __syncthreads();
        if (tid < 256) { const int q = tid >> 6, ch = tid & 63; float c = 0.f;
#pragma unroll
            for (int i = 0; i < 16; ++i) { c -= CUM[(16 * q + i) * 64 + ch]; const float p = __builtin_amdgcn_exp2f(c); CUM[(16 * q + i) * 64 + ch] = p; if (i == 15) PCb[q * 64 + ch] = p; } }
        __syncthreads();
        {
            const int q = tk >> 4, tt = tk & 15;
            const f32x4 one4 = {1.f, 1.f, 1.f, 1.f};
            const f32x4 et0 = *(const LAS f32x4*)(CUM + tk * 64 + c8), et1 = *(const LAS f32x4*)(CUM + tk * 64 + c8 + 4);
            const f32x4 ep0 = tt ? *(const LAS f32x4*)(CUM + (tk - 1) * 64 + c8) : one4, ep1 = tt ? *(const LAS f32x4*)(CUM + (tk - 1) * 64 + c8 + 4) : one4;
            const f32x4 pc0 = *(const LAS f32x4*)(PCb + q * 64 + c8), pc1 = *(const LAS f32x4*)(PCb + q * 64 + c8 + 4);
            float ei8[8];
            { float t8[8];
#pragma unroll
              for (int j = 0; j < 8; ++j) t8[j] = na[j] * (j < 4 ? ep0[j & 3] : ep1[j & 3]);
              *(LAS v4u*)(AT + tk * TP + c8) = pack8(t8); }
            { float t8[8];
#pragma unroll
              for (int j = 0; j < 8; ++j) { const float et = j < 4 ? et0[j & 3] : et1[j & 3]; t8[j] = rx[j] * et; ei8[j] = frcp(et); }
              *(LAS v4u*)(RT + tk * TP + c8) = pack8(t8); }
            { float t8[8];
#pragma unroll
              for (int j = 0; j < 8; ++j) t8[j] = pb[j] * ei8[j];
              *(LAS v4u*)(BT + tk * TP + c8) = pack8(t8); }
            { float t8[8];
#pragma unroll
              for (int j = 0; j < 8; ++j) t8[j] = km[j] * ei8[j];
              *(LAS v4u*)(KT + tk * TP + c8) = pack8(t8); }
#pragma unroll
            for (int j = 0; j < 8; j += 2) { const float eh0 = (j < 4 ? pc0[j & 3] : pc1[j & 3]) * ei8[j], eh1 = (j + 1 < 4 ? pc0[(j + 1) & 3] : pc1[(j + 1) & 3]) * ei8[j + 1];
                const unsigned wb = pk2(pb[j] * eh0, pb[j + 1] * eh1), wk = pk2(km[j] * eh0, km[j + 1] * eh1), wv = pk2(vx[j], vx[j + 1]); const int o = (q * 64 + c8 + j) * 16 + (tt ^ (4 * ((tid & 7) & 3)));
                BH[o] = (bf16)(wb & 0xffffu); BH[o + 16] = (bf16)(wb >> 16); KH[o] = (bf16)(wk & 0xffffu); KH[o + 16] = (bf16)(wk >> 16); Vt[o] = (bf16)(wv & 0xffffu); Vt[o + 16] = (bf16)(wv >> 16); }
        }
        __syncthreads();
        { const int q = w >> 1, rsel = w & 1;
          const LAS bf16* YR = rsel ? RT : AT;
          f32x4 cb = {0.f, 0.f, 0.f, 0.f}, ck = {0.f, 0.f, 0.f, 0.f};
#pragma unroll
          for (int k2 = 0; k2 < 2; ++k2) { const bf16x8 yf = *(const LAS bf16x8*)(YR + (16 * q + fr) * TP + 32 * k2 + 8 * fq);
              cb = MFMA16(*(const LAS bf16x8*)(BT + (16 * q + fr) * TP + 32 * k2 + 8 * fq), yf, cb);
              ck = MFMA16(*(const LAS bf16x8*)(KT + (16 * q + fr) * TP + 32 * k2 + 8 * fq), yf, ck); }
#pragma unroll
          for (int i2 = 0; i2 < 4; ++i2) { const int i = 4 * fq + i2; const bool keep = rsel ? (i <= fr) : (i < fr); if (!keep) { cb[i2] = 0.f; ck[i2] = 0.f; } }
          if (rsel == 0) { *(LAS f32x4*)(LabF + (q * 16 + fr) * 16 + 4 * fq) = cb; *(LAS bf16x4s*)(LakB + (q * 16 + fr) * 16 + 4 * fq) = pack4(ck); }
          else { *(LAS bf16x4s*)(MrbB + (q * 16 + fr) * 16 + 4 * fq) = pack4(cb); *(LAS bf16x4s*)(MrkB + (q * 16 + fr) * 16 + 4 * fq) = pack4(ck); } }
        __syncthreads();
        if (tid < 64) { const int q = tid >> 4, c = tid & 15; float T[16];
#pragma unroll
            for (int t = 0; t < 16; ++t) { float sacc = (t == c) ? 1.f : 0.f;
#pragma unroll
                for (int i = 0; i < t; ++i) sacc += LabF[(q * 16 + t) * 16 + i] * T[i];
                T[t] = sacc; TtB[(q * 16 + t) * 16 + c] = (bf16)f2bf(sacc); } }
        __syncthreads();
        }
        if (role == 1) {
            const __amdgpu_buffer_rsrc_t rs = __builtin_amdgcn_make_buffer_rsrc(ring, 0, XFER_SLOTS * XFER_SLOT_BYTES, 0x00020000);
            const unsigned sb0 = (unsigned)((hj % XFER_SLOTS) * XFER_SLOT_BYTES);
            for (int i = tid; i < XFER_PIECES; i += NTHR) { const v4u v = *(const LAS v4u*)(L0 + xfer_lds_off(i)); __builtin_amdgcn_raw_buffer_store_b128(v, rs, sb0 + 16u * (unsigned)i, 0, 16); }
            asm volatile("s_waitcnt vmcnt(0)" ::: "memory");
            __syncthreads();
            if (tid == 0) __hip_atomic_store(prodw, (unsigned)(hj + 1), RLX_AGENT);
            continue;
        }
        if (!mine) {
#pragma unroll
            for (int k = 0; k < 7; ++k) { const int i = tid + NTHR * k; if (i < XFER_PIECES) *(LAS v4u*)(L0 + xfer_lds_off(i)) = XR[k]; }
            __syncthreads();
            if (tid == 0) __hip_atomic_store(consw, (unsigned)(hj + 1), RLX_AGENT);
        }
        if (role == 0 && bi + 1 < NBT && (bi + 1) % 2 != 0) {
            const int hn = (bi + 1) >> 1;
            if (w == 0) { wait_ge(prodw, (unsigned)(hn + 1), ctlw + CW_TMO, 0xA00u, lane); __builtin_amdgcn_fence(__ATOMIC_ACQUIRE, "agent"); asm volatile("s_waitcnt vmcnt(0)" ::: "memory"); }
            __syncthreads();
            const unsigned char* src = ring + (size_t)(hn % XFER_SLOTS) * XFER_SLOT_BYTES;
#pragma unroll
            for (int k = 0; k < 7; ++k) { int i = tid + NTHR * k; i = i < XFER_PIECES ? i : XFER_PIECES - 1; XR[k] = *(const v4u*)(src + 16 * i); }
        }
#ifdef PROBE_S2
        f32x4 Ssv[4];
#pragma unroll
        for (int kt = 0; kt < 4; ++kt) Ssv[kt] = St[kt];
        for (int prb_ = 0; prb_ < 2; ++prb_) {
        if (prb_) {
#pragma unroll
            for (int kt = 0; kt < 4; ++kt) St[kt] = Ssv[kt]; }
#endif
        if (w < 4) {
#pragma unroll 1
            for (int q = 0; q < 4; ++q) {
                const bf16x4s z4s = {0, 0, 0, 0};
#define CAT2(p0, p1) __builtin_shufflevector(*(const LAS bf16x4s*)(p0), *(const LAS bf16x4s*)(p1), 0, 1, 2, 3, 4, 5, 6, 7)
#define PAD8(p0) __builtin_shufflevector(*(const LAS bf16x4s*)(p0), z4s, 0, 1, 2, 3, 4, 5, 6, 7)
                const bf16x4s vt4 = *(const LAS bf16x4s*)(Vt + (q * 64 + 16 * w + fr) * 16 + 4 * (fq ^ ((2 * w + (fr >> 3)) & 3)));
                const LAS bf16* atp = AT + (16 * q + fr) * TP + 4 * fq; const LAS bf16* rtp = RT + (16 * q + fr) * TP + 4 * fq;
                f32x4 x1 = {0.f, 0.f, 0.f, 0.f}, yv = {0.f, 0.f, 0.f, 0.f};
                { const bf16x8 s01 = __builtin_shufflevector(pack4(St[0]), pack4(St[1]), 0, 1, 2, 3, 4, 5, 6, 7), s23 = __builtin_shufflevector(pack4(St[2]), pack4(St[3]), 0, 1, 2, 3, 4, 5, 6, 7);
                  x1 = MFMA16(CAT2(atp, atp + 16), s01, x1); x1 = MFMA16(CAT2(atp + 32, atp + 48), s23, x1);
                  yv = MFMA16(CAT2(rtp, rtp + 16), s01, yv); yv = MFMA16(CAT2(rtp + 32, rtp + 48), s23, yv); }
                x1 = MFMA16(PAD8(LakB + (q * 16 + fr) * 16 + 4 * fq), __builtin_shufflevector(vt4, z4s, 0, 1, 2, 3, 4, 5, 6, 7), x1);
                const f32x4 u = MFMA16(PAD8(TtB + (q * 16 + fr) * 16 + 4 * fq), __builtin_shufflevector(pack4(x1), z4s, 0, 1, 2, 3, 4, 5, 6, 7), ((f32x4){0.f, 0.f, 0.f, 0.f}));
                const bf16x8 vu = __builtin_shufflevector(vt4, pack4(u), 0, 1, 2, 3, 4, 5, 6, 7);
                yv = MFMA16(CAT2(MrkB + (q * 16 + fr) * 16 + 4 * fq, MrbB + (q * 16 + fr) * 16 + 4 * fq), vu, yv);
#pragma unroll
                for (int i2 = 0; i2 < 4; ++i2) YB[(16 * q + 4 * fq + i2) * 64 + 16 * w + fr] = yv[i2];
#pragma unroll
                for (int kt = 0; kt < 4; ++kt)
                    St[kt] = MFMA16(CAT2(KH + (q * 64 + 16 * kt + fr) * 16 + 4 * (fq ^ ((2 * kt + (fr >> 3)) & 3)), BH + (q * 64 + 16 * kt + fr) * 16 + 4 * (fq ^ ((2 * kt + (fr >> 3)) & 3))), vu, St[kt] * *(const LAS f32x4*)(PCb + q * 64 + 16 * kt + 4 * fq));
#undef CAT2
#undef PAD8
            }
        }
#ifdef PROBE_S2
        __syncthreads(); }
#endif
        __syncthreads();
        if (need_out) {
            float y8[8];
#pragma unroll
            for (int j = 0; j < 8; ++j) y8[j] = YB[tk * 64 + c8 + j];
            *(v4u*)(YS + (size_t)row * 512 + gc) = pack8(y8);
        }
    }
    __syncthreads();
}

constexpr int PL_CST = 0, PL_TW = 2560, PL_AL = PL_TW + 9216, PL_LW = PL_AL + 9216, PL_LA = PL_LW + 16384, PL_SET = PL_LA + 16384, PL_SETB = 52224, PL_END = PL_SET + 2 * PL_SETB;
static_assert(PL_END <= MISC_OFF, "pipelined scan LDS map");
__device__ __forceinline__ void scan_unit_pipe(const Params& P, const Frame& F, int l, int b, int h, int dir) {
    LAS unsigned char* L0 = F.lds;
    LAS float* CST = (LAS float*)(L0 + PL_CST);
    LAS bf16* TWb = (LAS bf16*)(L0 + PL_TW);
    LAS bf16* ALb = (LAS bf16*)(L0 + PL_AL);
    LAS bf16* BT = TWb; LAS bf16* KT = ALb;
    LAS float* LW = (LAS float*)(L0 + PL_LW);
    LAS float* LA = (LAS float*)(L0 + PL_LA);
    LAS float* CUM = LW; LAS float* LabF = LA;
    const int tid = F.tid, lane = F.lane, w = F.wave, fr = lane & 15, fq = lane >> 4;
    const int tk = tid >> 3, c8 = (tid & 7) * 8, gc = 64 * h + c8;
    const int ld = l * 2 + dir;
    if (tid < 64) { const int c = 64 * h + tid;
        CST[0 * 64 + tid] = P.in[I_MU][(size_t)(ld * 3 + 0) * 512 + c]; CST[1 * 64 + tid] = P.in[I_MU][(size_t)(ld * 3 + 1) * 512 + c]; CST[2 * 64 + tid] = P.in[I_MU][(size_t)(ld * 3 + 2) * 512 + c];
        CST[3 * 64 + tid] = P.in[I_MUW][ld * 64 + tid]; CST[4 * 64 + tid] = P.in[I_MUA][ld * 64 + tid];
        CST[5 * 64 + tid] = P.in[I_W0][ld * 512 + c]; CST[6 * 64 + tid] = P.in[I_A0][ld * 512 + c];
        CST[7 * 64 + tid] = P.in[I_KK][l * 512 + c]; CST[8 * 64 + tid] = P.in[I_KA][l * 512 + c]; CST[9 * 64 + tid] = P.in[I_RK][l * 512 + c]; }
    const bf16* Z = WSP(bf16, WS_Z);
    bf16* YS = WSP(bf16, WS_YS) + (size_t)dir * MT * 512;
    float* BONG = WSP(float, WS_BONG) + (size_t)dir * MT * 8;
    f32x4 St[4];
#pragma unroll
    for (int kt = 0; kt < 4; ++kt) St[kt] = (f32x4){0.f, 0.f, 0.f, 0.f};
    constexpr int NBT = LC / TB + SEQ / TB;
    ScanPre R; scan_prefetch(Z, 0, tk, b, dir, gc, c8, R);
    __syncthreads();
#define PL_CHAIN(q) do { if (w < 4 && it >= 1) { \
        const bf16x4s z4s = {0, 0, 0, 0}; \
        const LAS bf16* cBH = (const LAS bf16*)(cset); const LAS bf16* cKH = cBH + 4096; const LAS bf16* cVt = cKH + 4096; const LAS bf16* cAT = (const LAS bf16*)(cset + 24576); const LAS bf16* cRT = (const LAS bf16*)(cset + 33792); \
        const LAS bf16* cLak = (const LAS bf16*)(cset + 43008); const LAS bf16* cTt = cLak + 1024; const LAS bf16* cMrb = cTt + 1024; const LAS bf16* cMrk = cMrb + 1024; const LAS float* cPC = (const LAS float*)(cset + 51200); \
        const bf16x4s vt4 = *(const LAS bf16x4s*)(cVt + ((q) * 64 + 16 * w + fr) * 16 + 4 * fq); \
        const LAS bf16* atp = cAT + (16 * (q) + fr) * TP + 4 * fq; const LAS bf16* rtp = cRT + (16 * (q) + fr) * TP + 4 * fq; \
        f32x4 x1 = {0.f, 0.f, 0.f, 0.f}, yv = {0.f, 0.f, 0.f, 0.f}; \
        { const bf16x8 s01 = __builtin_shufflevector(pack4(St[0]), pack4(St[1]), 0, 1, 2, 3, 4, 5, 6, 7), s23 = __builtin_shufflevector(pack4(St[2]), pack4(St[3]), 0, 1, 2, 3, 4, 5, 6, 7); \
          x1 = MFMA16(PL_CAT2(atp, atp + 16), s01, x1); x1 = MFMA16(PL_CAT2(atp + 32, atp + 48), s23, x1); \
          yv = MFMA16(PL_CAT2(rtp, rtp + 16), s01, yv); yv = MFMA16(PL_CAT2(rtp + 32, rtp + 48), s23, yv); } \
        x1 = MFMA16(PL_PAD8(cLak + ((q) * 16 + fr) * 16 + 4 * fq), __builtin_shufflevector(vt4, z4s, 0, 1, 2, 3, 4, 5, 6, 7), x1); \
        const f32x4 u = MFMA16(PL_PAD8(cTt + ((q) * 16 + fr) * 16 + 4 * fq), __builtin_shufflevector(pack4(x1), z4s, 0, 1, 2, 3, 4, 5, 6, 7), ((f32x4){0.f, 0.f, 0.f, 0.f})); \
        const bf16x8 vu = __builtin_shufflevector(vt4, pack4(u), 0, 1, 2, 3, 4, 5, 6, 7); \
        yv = MFMA16(PL_CAT2(cMrk + ((q) * 16 + fr) * 16 + 4 * fq, cMrb + ((q) * 16 + fr) * 16 + 4 * fq), vu, yv); \
        _Pragma("unroll") for (int kt = 0; kt < 4; ++kt) { \
            St[kt] = MFMA16(PL_CAT2(cKH + ((q) * 64 + 16 * kt + fr) * 16 + 4 * fq, cBH + ((q) * 64 + 16 * kt + fr) * 16 + 4 * fq), vu, St[kt] * *(const LAS f32x4*)(cPC + (q) * 64 + 16 * kt + 4 * fq)); \
            if (kt & 1) __builtin_amdgcn_sched_barrier(0); } \
        if (cout_) { _Pragma("unroll") for (int i2 = 0; i2 < 4; ++i2) { bool hp2; int pr2; const int row2 = scan_row(it - 1, 16 * (q) + 4 * fq + i2, b, dir, hp2, pr2); \
            YS[(size_t)row2 * 512 + 64 * h + 16 * w + fr] = (bf16)f2bf(yv[i2]); } } \
    } } while (0)
#define PL_CAT2(p0, p1) __builtin_shufflevector(*(const LAS bf16x4s*)(p0), *(const LAS bf16x4s*)(p1), 0, 1, 2, 3, 4, 5, 6, 7)
#define PL_PAD8(p0) __builtin_shufflevector(*(const LAS bf16x4s*)(p0), z4s, 0, 1, 2, 3, 4, 5, 6, 7)
    for (int it = 0; it <= NBT; ++it) {
        const bool prep = it < NBT;
        const LAS unsigned char* cset = L0 + PL_SET + ((it - 1) & 1) * PL_SETB;
        LAS unsigned char* pset = L0 + PL_SET + (it & 1) * PL_SETB;
        const bool need_out = (it >= LC / TB) || (l == 0), cout_ = (it - 1 >= LC / TB) || (l == 0);
        LAS bf16* BH = (LAS bf16*)pset; LAS bf16* KH = BH + 4096; LAS bf16* Vt = KH + 4096; LAS bf16* AT = (LAS bf16*)(pset + 24576); LAS bf16* RT = (LAS bf16*)(pset + 33792);
        LAS bf16* LakB = (LAS bf16*)(pset + 43008); LAS bf16* TtB = LakB + 1024; LAS bf16* MrbB = TtB + 1024; LAS bf16* MrkB = MrbB + 1024; LAS float* PCb = (LAS float*)(pset + 51200);
        bool hp = false; int prow = 0; const int row = prep ? scan_row(it, tk, b, dir, hp, prow) : 0; (void)prow;
        float kx[8], vx[8], rx[8], na[8], pb[8], km[8];
#ifdef PROBE_ST1
        for (int prb_ = 0; prb_ < 2; ++prb_)
#endif
        if (prep) { float wl[8], al[8];
            lerp8(R.kc, R.kp, hp, CST + 0 * 64 + c8, kx); lerp8(R.vc, R.vp, hp, CST + 1 * 64 + c8, vx); lerp8(R.rc, R.rp, hp, CST + 2 * 64 + c8, rx);
            lerp8(R.wc, R.wp, hp, CST + 3 * 64 + c8, wl); lerp8(R.ac, R.ap, hp, CST + 4 * 64 + c8, al);
#pragma unroll
            for (int j = 0; j < 8; ++j) wl[j] = ftanh(wl[j]);
            *(LAS v4u*)(TWb + tk * TP + c8) = pack8(wl); *(LAS v4u*)(ALb + tk * TP + c8) = pack8(al);
        }
        __syncthreads();
        if (w >= 4) { if (prep) { const int nt = w - 4;
            int ll = lane; asm volatile("" : "+v"(ll));
            const size_t lo = ((size_t)ld * 512 + 64 * h + 16 * nt + (ll & 15)) * 64 + 8 * (ll >> 4);
            const bf16* w2g = WSP(bf16, WS_W2TG) + lo; const bf16* a2g = WSP(bf16, WS_A2TG) + lo;
            bf16x8 w2x[2], a2x[2];
#pragma unroll
            for (int k2 = 0; k2 < 2; ++k2) { w2x[k2] = *(const bf16x8*)(w2g + 32 * k2); a2x[k2] = *(const bf16x8*)(a2g + 32 * k2); }
#pragma unroll
            for (int mt = 0; mt < 4; ++mt) { f32x4 cw = {0.f, 0.f, 0.f, 0.f}, ca = {0.f, 0.f, 0.f, 0.f};
#pragma unroll
                for (int k2 = 0; k2 < 2; ++k2) { cw = MFMA16(w2x[k2], *(const LAS bf16x8*)(TWb + (16 * mt + fr) * TP + 32 * k2 + 8 * fq), cw); ca = MFMA16(a2x[k2], *(const LAS bf16x8*)(ALb + (16 * mt + fr) * TP + 32 * k2 + 8 * fq), ca); }
                *(LAS f32x4*)(LW + (16 * mt + fr) * 64 + 16 * nt + 4 * fq) = cw; *(LAS f32x4*)(LA + (16 * mt + fr) * 64 + 16 * nt + 4 * fq) = ca; } } }
        else PL_CHAIN(0);
        __syncthreads();
#ifdef PROBE_ST3
        float lwsv[8], lasv[8];
        if (prep) {
#pragma unroll
            for (int j = 0; j < 8; ++j) { lwsv[j] = LW[tk * 64 + c8 + j]; lasv[j] = LA[tk * 64 + c8 + j]; } }
        for (int prb_ = 0; prb_ < 2; ++prb_) {
        if (prb_ && prep) {
#pragma unroll
            for (int j = 0; j < 8; ++j) { LW[tk * 64 + c8 + j] = lwsv[j]; LA[tk * 64 + c8 + j] = lasv[j]; } }
#endif
        if (prep) {
            float n2 = 0.f, bon = 0.f, ew[8];
#pragma unroll
            for (int hf = 0; hf < 2; ++hf) {
#pragma unroll
                for (int j = 4 * hf; j < 4 * hf + 4; ++j) {
                    const float aw = LW[tk * 64 + c8 + j], aa = LA[tk * 64 + c8 + j];
                    ew[j] = 0.6065306597f * frcp(1.0f + fexp(-(CST[5 * 64 + c8 + j] + aw)));
                    const float ag = frcp(1.0f + fexp(-(CST[6 * 64 + c8 + j] + aa)));
                    const float kk = kx[j] * CST[7 * 64 + c8 + j]; n2 += kk * kk;
                    km[j] = kx[j] * (1.0f + (ag - 1.0f) * CST[8 * 64 + c8 + j]);
                    bon += rx[j] * km[j] * CST[9 * 64 + c8 + j];
                    na[j] = kk; pb[j] = ag;
                }
                __builtin_amdgcn_sched_barrier(0);
            }
            n2 = sum8(n2); bon = sum8(bon);
            const float inv = frcp(fmaxf(__builtin_amdgcn_sqrtf(n2), 1e-12f));
#pragma unroll
            for (int j = 0; j < 8; ++j) { const float kkn = na[j] * inv; na[j] = -kkn; pb[j] = kkn * pb[j]; }
            *(LAS f32x4*)(CUM + tk * 64 + c8) = (f32x4){ew[0], ew[1], ew[2], ew[3]} * 1.44269504089f; *(LAS f32x4*)(CUM + tk * 64 + c8 + 4) = (f32x4){ew[4], ew[5], ew[6], ew[7]} * 1.44269504089f;
            if ((tid & 7) == 0 && need_out) BONG[(size_t)row * 8 + h] = bon;
#pragma unroll
            for (int j = 0; j < 8; j += 2) { const unsigned wv = pk2(vx[j], vx[j + 1]); const int o = ((tk >> 4) * 64 + c8 + j) * 16 + (tk & 15); Vt[o] = (bf16)(wv & 0xffffu); Vt[o + 16] = (bf16)(wv >> 16); }
        }
#ifdef PROBE_ST3
        }
#endif
        __syncthreads();
        if (w >= 4) { if (prep) { const int t2 = tid - 256, q = t2 >> 6, ch = t2 & 63; float c = 0.f;
#pragma unroll
            for (int i = 0; i < 16; ++i) { c -= CUM[(16 * q + i) * 64 + ch]; const float p = __builtin_amdgcn_exp2f(c); CUM[(16 * q + i) * 64 + ch] = p; if (i == 15) PCb[q * 64 + ch] = p; } } }
        else PL_CHAIN(1);
        __syncthreads();
#ifdef PROBE_ST5
        for (int prb_ = 0; prb_ < 2; ++prb_)
#endif
        if (prep) {
            const int q = tk >> 4, tt = tk & 15;
            const f32x4 one4 = {1.f, 1.f, 1.f, 1.f};
            const f32x4 et0 = *(const LAS f32x4*)(CUM + tk * 64 + c8), et1 = *(const LAS f32x4*)(CUM + tk * 64 + c8 + 4);
            const f32x4 ep0 = tt ? *(const LAS f32x4*)(CUM + (tk - 1) * 64 + c8) : one4, ep1 = tt ? *(const LAS f32x4*)(CUM + (tk - 1) * 64 + c8 + 4) : one4;
            const f32x4 pc0 = *(const LAS f32x4*)(PCb + q * 64 + c8), pc1 = *(const LAS f32x4*)(PCb + q * 64 + c8 + 4);
            float ei8[8];
            { float t8[8];
#pragma unroll
              for (int j = 0; j < 8; ++j) t8[j] = na[j] * (j < 4 ? ep0[j & 3] : ep1[j & 3]);
              *(LAS v4u*)(AT + tk * TP + c8) = pack8(t8); }
            __builtin_amdgcn_sched_barrier(0);
            { float t8[8];
#pragma unroll
              for (int j = 0; j < 8; ++j) { const float et = j < 4 ? et0[j & 3] : et1[j & 3]; t8[j] = rx[j] * et; ei8[j] = frcp(et); }
              *(LAS v4u*)(RT + tk * TP + c8) = pack8(t8); }
            __builtin_amdgcn_sched_barrier(0);
            { float t8[8];
#pragma unroll
              for (int j = 0; j < 8; ++j) t8[j] = pb[j] * ei8[j];
              *(LAS v4u*)(BT + tk * TP + c8) = pack8(t8); }
            __builtin_amdgcn_sched_barrier(0);
            { float t8[8];
#pragma unroll
              for (int j = 0; j < 8; ++j) t8[j] = km[j] * ei8[j];
              *(LAS v4u*)(KT + tk * TP + c8) = pack8(t8); }
            __builtin_amdgcn_sched_barrier(0);
#pragma unroll
            for (int j = 0; j < 8; j += 2) { const float eh0 = (j < 4 ? pc0[j & 3] : pc1[j & 3]) * ei8[j], eh1 = (j + 1 < 4 ? pc0[(j + 1) & 3] : pc1[(j + 1) & 3]) * ei8[j + 1];
                const unsigned wb = pk2(pb[j] * eh0, pb[j + 1] * eh1), wk = pk2(km[j] * eh0, km[j + 1] * eh1); const int o = (q * 64 + c8 + j) * 16 + tt;
                BH[o] = (bf16)(wb & 0xffffu); BH[o + 16] = (bf16)(wb >> 16); KH[o] = (bf16)(wk & 0xffffu); KH[o + 16] = (bf16)(wk >> 16); }
        }
        __syncthreads();
        if (it + 1 < NBT) scan_prefetch(Z, it + 1, tk, b, dir, gc, c8, R);
        if (w >= 4) { if (prep) { const int q = w - 4;
#pragma unroll
            for (int rsel = 0; rsel < 2; ++rsel) {
                const LAS bf16* YR = rsel ? RT : AT;
                f32x4 cb = {0.f, 0.f, 0.f, 0.f}, ck = {0.f, 0.f, 0.f, 0.f};
#pragma unroll
                for (int k2 = 0; k2 < 2; ++k2) { const bf16x8 yf = *(const LAS bf16x8*)(YR + (16 * q + fr) * TP + 32 * k2 + 8 * fq);
                    cb = MFMA16(*(const LAS bf16x8*)(BT + (16 * q + fr) * TP + 32 * k2 + 8 * fq), yf, cb);
                    ck = MFMA16(*(const LAS bf16x8*)(KT + (16 * q + fr) * TP + 32 * k2 + 8 * fq), yf, ck); }
#pragma unroll
                for (int i2 = 0; i2 < 4; ++i2) { const int i = 4 * fq + i2; const bool keep = rsel ? (i <= fr) : (i < fr); if (!keep) { cb[i2] = 0.f; ck[i2] = 0.f; } }
                if (rsel == 0) { *(LAS f32x4*)(LabF + (q * 16 + fr) * 16 + 4 * fq) = cb; *(LAS bf16x4s*)(LakB + (q * 16 + fr) * 16 + 4 * fq) = pack4(ck); }
                else { *(LAS bf16x4s*)(MrbB + (q * 16 + fr) * 16 + 4 * fq) = pack4(cb); *(LAS bf16x4s*)(MrkB + (q * 16 + fr) * 16 + 4 * fq) = pack4(ck); } } } }
        else PL_CHAIN(2);
        __syncthreads();
        if (w == 4) { if (prep) { const int q = lane >> 4, c = lane & 15; float T[16];
#pragma unroll
            for (int t = 0; t < 16; ++t) { float sacc = (t == c) ? 1.f : 0.f;
#pragma unroll
                for (int i = 0; i < t; ++i) sacc += LabF[(q * 16 + t) * 16 + i] * T[i];
                T[t] = sacc; TtB[(q * 16 + t) * 16 + c] = (bf16)f2bf(sacc); } } }
        else if (w < 4) PL_CHAIN(3);
        __syncthreads();
    }
#undef PL_CHAIN
#undef PL_CAT2
#undef PL_PAD8
}

__device__ __forceinline__ void conv_items(const Params& P, const Frame& F, int l, int nrows, int ob, int nob) {
    const bf16* Z = WSP(bf16, WS_Z); bf16* YM = WSP(bf16, WS_H);
    const float* cw = P.in[I_CONVW] + l * 768;
    for (int idx = ob * NTHR + F.tid; idx < nrows * 32; idx += nob * NTHR) {
        const int row = idx >> 5, ch = (idx & 31) * 8;
        bool hp, hn;
        if (row < NT) { const int col = row & 63; hp = col != 0; hn = col != 63; } else { const int t = (row - NT) & 255; hp = t != 0; hn = t != 255; }
        const bf16* zr = Z + (size_t)row * NZ;
        const v4u u1 = *(const v4u*)(zr + C_U + ch), g1 = *(const v4u*)(zr + C_GC + ch), gb = *(const v4u*)(zr + C_GB + ch);
        v4u u0 = {0u, 0u, 0u, 0u}, g0 = u0, u2 = u0, g2 = u0;
        if (hp) { u0 = *(const v4u*)(zr - NZ + C_U + ch); g0 = *(const v4u*)(zr - NZ + C_GC + ch); }
        if (hn) { u2 = *(const v4u*)(zr + NZ + C_U + ch); g2 = *(const v4u*)(zr + NZ + C_GC + ch); }
        v4u o;
#pragma unroll
        for (int q = 0; q < 4; ++q) {
            const float wa0 = cw[ch + 2 * q], wa1 = cw[256 + ch + 2 * q], wa2 = cw[512 + ch + 2 * q], wb0 = cw[ch + 2 * q + 1], wb1 = cw[256 + ch + 2 * q + 1], wb2 = cw[512 + ch + 2 * q + 1];
            const float lo = bflo(gb[q]) * (wa0 * bflo(g0[q]) * bflo(u0[q]) + wa1 * bflo(g1[q]) * bflo(u1[q]) + wa2 * bflo(g2[q]) * bflo(u2[q]));
            const float hi = bfhi(gb[q]) * (wb0 * bfhi(g0[q]) * bfhi(u0[q]) + wb1 * bfhi(g1[q]) * bfhi(u1[q]) + wb2 * bfhi(g2[q]) * bfhi(u2[q]));
            o[q] = pk2(lo, hi);
        }
        *(v4u*)(YM + (size_t)row * D + 512 + ch) = o;
    }
}

__device__ __forceinline__ void load_tab64(LAS bf16* dst, const bf16* src, int tid) {
    for (int i = tid; i < 512; i += NTHR) { const int r = i >> 3, c = (i & 7) * 8; *(LAS v4u*)(dst + r * TP + c) = *(const v4u*)(src + r * 64 + c); }
}
__device__ __forceinline__ bf16x8 ldsfrag(const LAS bf16* base, int row, int col) { return *(const LAS bf16x8*)(base + row * TP + col); }
__device__ __forceinline__ void fourier_a_iter(const Params& P, const Frame& F, int it) {
    const int bg = it >> 3, j = it & 7, b = bg >> 2, g = bg & 3, w = F.wave, lane = F.lane, fr = lane & 15, fq = lane >> 4, p2 = 8 * j + w;
    LAS bf16* TC64 = (LAS bf16*)F.lds; LAS bf16* TS64 = TC64 + 64 * TP; LAS bf16* TN64 = TS64 + 64 * TP;
    LAS bf16* PT = TN64 + 64 * TP + w * (64 * TP);
    load_tab64(TC64, WSP(bf16, TAB_C64), F.tid); load_tab64(TS64, WSP(bf16, TAB_S64), F.tid); load_tab64(TN64, WSP(bf16, TAB_SN64), F.tid);
    const bf16* Z = WSP(bf16, WS_Z);
    __syncthreads();
    f32x4 Yr[4][4], Yi[4][4];
#pragma unroll
    for (int a = 0; a < 4; ++a)
#pragma unroll
        for (int c = 0; c < 4; ++c) { Yr[a][c] = (f32x4){0.f, 0.f, 0.f, 0.f}; Yi[a][c] = (f32x4){0.f, 0.f, 0.f, 0.f}; }
#pragma unroll
    for (int pass = 0; pass < 2; ++pass) {
        const LAS bf16* T1 = pass == 0 ? TC64 : TS64;
        asm volatile("" ::: "memory");
#pragma unroll
        for (int xt = 0; xt < 4; ++xt) {
            bf16x8 Ff[2];
#pragma unroll
            for (int ks = 0; ks < 2; ++ks) Ff[ks] = *(const bf16x8*)(Z + (size_t)(b * SEQ + 64 * (16 * xt + fr) + p2) * NZ + C_F + 64 * g + 32 * ks + 8 * fq);
#pragma unroll
            for (int yt = 0; yt < 4; ++yt) {
                f32x4 acc = {0.f, 0.f, 0.f, 0.f};
#pragma unroll
                for (int ks = 0; ks < 2; ++ks) acc = MFMA16(Ff[ks], ldsfrag(T1, 16 * yt + fr, 32 * ks + 8 * fq), acc);
                v2u wv; wv.x = pk2(acc.x, acc.y); wv.y = pk2(acc.z, acc.w);
                *(LAS v2u*)(PT + (16 * yt + fr) * TP + 16 * xt + 4 * fq) = wv;
            }
            __builtin_amdgcn_sched_barrier(0);
        }
        LDS_WAIT(); asm volatile("" ::: "memory");
        const LAS bf16* TA = pass == 0 ? TC64 : TN64;
        const LAS bf16* TB = pass == 0 ? TS64 : TC64;
#pragma unroll
        for (int ks = 0; ks < 2; ++ks) {
            bf16x8 pf[4];
#pragma unroll
            for (int yt = 0; yt < 4; ++yt) pf[yt] = ldsfrag(PT, 16 * yt + fr, 32 * ks + 8 * fq);
#pragma unroll
            for (int xt = 0; xt < 4; ++xt) { const bf16x8 ta = ldsfrag(TA, 16 * xt + fr, 32 * ks + 8 * fq), tb = ldsfrag(TB, 16 * xt + fr, 32 * ks + 8 * fq);
#pragma unroll
                for (int yt = 0; yt < 4; ++yt) { Yr[xt][yt] = MFMA16(ta, pf[yt], Yr[xt][yt]); Yi[xt][yt] = MFMA16(tb, pf[yt], Yi[xt][yt]); }
                __builtin_amdgcn_sched_barrier(0); }
        }
        LDS_WAIT(); asm volatile("" ::: "memory");
    }
    __syncthreads();
    LAS bf16* EX = (LAS bf16*)F.lds;
    const float* twc = WSP(float, TAB_TWC); const float* tws = WSP(float, TAB_TWS);
#pragma unroll
    for (int xt = 0; xt < 4; ++xt)
#pragma unroll
        for (int i = 0; i < 4; ++i) { const int q1 = 16 * xt + 4 * fq + i, m = (p2 * q1) & 4095; const float tc = twc[m], ts = tws[m];
#pragma unroll
            for (int yt = 0; yt < 4; ++yt) { const float yr = Yr[xt][yt][i], yi = Yi[xt][yt][i]; const int cp = 16 * yt + fr;
                EX[((q1 * 2 + 0) * 64 + cp) * 8 + w] = (bf16)f2bf(yr * tc - yi * ts);
                EX[((q1 * 2 + 1) * 64 + cp) * 8 + w] = (bf16)f2bf(-yi * tc - yr * ts); }
            __builtin_amdgcn_sched_barrier(0); }
    __syncthreads();
    bf16* YB = WSP(bf16, WS_YBUF) + (size_t)bg * (64 * 2 * 64 * 64);
#pragma unroll 4
    for (int n = 0; n < 16; ++n) { const int q = F.tid + NTHR * n; *(v4u*)(YB + (size_t)q * 64 + 8 * j) = *(const LAS v4u*)(EX + q * 8); }
    __syncthreads();
}
__device__ __forceinline__ void fourier_b_unit(const Params& P, const Frame& F, int u, const LAS bf16* TC64, const LAS bf16* TS64) {
    const int bg = u >> 6, s2 = u & 63, b = bg >> 2, g = bg & 3, lane = F.lane, fr = lane & 15, fq = lane >> 4;
    const bf16* YB = WSP(bf16, WS_YBUF) + (size_t)bg * (64 * 2 * 64 * 64) + (size_t)s2 * (2 * 64 * 64);
    f32x4 acc[4][4];
#pragma unroll
    for (int a = 0; a < 4; ++a)
#pragma unroll
        for (int c = 0; c < 4; ++c) acc[a][c] = (f32x4){0.f, 0.f, 0.f, 0.f};
#pragma unroll
    for (int ks = 0; ks < 4; ++ks) { const int ri = ks >> 1, pb = (ks & 1) * 32;
        bf16x8 xf[4];
#pragma unroll
        for (int xt = 0; xt < 4; ++xt) xf[xt] = *(const bf16x8*)(YB + (size_t)(ri * 64 + 16 * xt + fr) * 64 + pb + 8 * fq);
        const LAS bf16* T = ri ? TS64 : TC64;
#pragma unroll
        for (int yt = 0; yt < 4; ++yt) { const bf16x8 tf = ldsfrag(T, 16 * yt + fr, pb + 8 * fq);
#pragma unroll
            for (int xt = 0; xt < 4; ++xt) acc[xt][yt] = MFMA16(xf[xt], tf, acc[xt][yt]); }
    }
    bf16* YM = WSP(bf16, WS_H);
#pragma unroll
    for (int yt = 0; yt < 4; ++yt) { const int s1 = 16 * yt + fr; bf16* rowp = YM + (size_t)(b * SEQ + 64 * s1 + s2) * D + 768 + 64 * g;
#pragma unroll
        for (int xt = 0; xt < 4; ++xt) { const f32x4 a = acc[xt][yt] * (1.0f / 512.0f); v2u wv; wv.x = pk2(a.x, a.y); wv.y = pk2(a.z, a.w); *(v2u*)(rowp + 16 * xt + 4 * fq) = wv; } }
}
constexpr int TP2 = 264;
__device__ __forceinline__ void fourier_ctx_unit(const Params& P, const Frame& F, int bg) {
    const int b = bg >> 2, g = bg & 3, w = F.wave, lane = F.lane, fr = lane & 15, fq = lane >> 4;
    LAS bf16* TC64 = (LAS bf16*)F.lds; LAS bf16* TS64 = TC64 + 64 * TP;
    LAS bf16* PT = TS64 + 64 * TP; LAS bf16* QT = PT + 64 * TP2;
    load_tab64(TC64, WSP(bf16, TAB_C64), F.tid); load_tab64(TS64, WSP(bf16, TAB_S64), F.tid);
    const bf16* Z = WSP(bf16, WS_Z);
    bf16x8 Ff[2][2];
#pragma unroll
    for (int xt = 0; xt < 2; ++xt)
#pragma unroll
        for (int ks = 0; ks < 2; ++ks) Ff[xt][ks] = *(const bf16x8*)(Z + (size_t)(NT + b * LC + 32 * w + 16 * xt + fr) * NZ + C_F + 64 * g + 32 * ks + 8 * fq);
    __syncthreads();
#pragma unroll
    for (int xt = 0; xt < 2; ++xt)
#pragma unroll
        for (int yt = 0; yt < 4; ++yt) {
            f32x4 ap = {0.f, 0.f, 0.f, 0.f}, aq = {0.f, 0.f, 0.f, 0.f};
#pragma unroll
            for (int ks = 0; ks < 2; ++ks) { ap = MFMA16(Ff[xt][ks], ldsfrag(TC64, 16 * yt + fr, 32 * ks + 8 * fq), ap); aq = MFMA16(Ff[xt][ks], ldsfrag(TS64, 16 * yt + fr, 32 * ks + 8 * fq), aq); }
            v2u wp, wq; wp.x = pk2(ap.x, ap.y); wp.y = pk2(ap.z, ap.w); wq.x = pk2(aq.x, aq.y); wq.y = pk2(aq.z, aq.w);
            *(LAS v2u*)(PT + (16 * yt + fr) * TP2 + 32 * w + 16 * xt + 4 * fq) = wp; *(LAS v2u*)(QT + (16 * yt + fr) * TP2 + 32 * w + 16 * xt + 4 * fq) = wq;
        }
    __syncthreads();
    const bf16* C256 = WSP(bf16, WS_C256); const bf16* SN256 = WSP(bf16, WS_SN256);
    f32x4 acc[4][2];
#pragma unroll
    for (int a = 0; a < 4; ++a)
#pragma unroll
        for (int c = 0; c < 2; ++c) acc[a][c] = (f32x4){0.f, 0.f, 0.f, 0.f};
#pragma unroll 2
    for (int ks = 0; ks < 8; ++ks) {
        bf16x8 cf[2], sf[2];
#pragma unroll
        for (int yt = 0; yt < 2; ++yt) { cf[yt] = *(const bf16x8*)(C256 + (size_t)(32 * w + 16 * yt + fr) * 256 + 32 * ks + 8 * fq); sf[yt] = *(const bf16x8*)(SN256 + (size_t)(32 * w + 16 * yt + fr) * 256 + 32 * ks + 8 * fq); }
#pragma unroll
        for (int xt = 0; xt < 4; ++xt) { const bf16x8 pf = *(const LAS bf16x8*)(PT + (16 * xt + fr) * TP2 + 32 * ks + 8 * fq), qf = *(const LAS bf16x8*)(QT + (16 * xt + fr) * TP2 + 32 * ks + 8 * fq);
#pragma unroll
            for (int yt = 0; yt < 2; ++yt) { acc[xt][yt] = MFMA16(pf, cf[yt], acc[xt][yt]); acc[xt][yt] = MFMA16(qf, sf[yt], acc[xt][yt]); } }
    }
    bf16* YM = WSP(bf16, WS_H);
#pragma unroll
    for (int yt = 0; yt < 2; ++yt) { bf16* rowp = YM + (size_t)(NT + b * LC + 32 * w + 16 * yt + fr) * D + 768 + 64 * g;
#pragma unroll
        for (int xt = 0; xt < 4; ++xt) { const f32x4 a = acc[xt][yt] * (1.0f / 128.0f); v2u wv; wv.x = pk2(a.x, a.y); wv.y = pk2(a.z, a.w); *(v2u*)(rowp + 16 * xt + 4 * fq) = wv; } }
    __syncthreads();
}

constexpr int GP = 136;
__device__ __forceinline__ void finalize_phase(const Params& P, const Frame& F, int l, int nrows) {
    LAS bf16* G2 = (LAS bf16*)F.lds;
    const bf16* g2t = WSP(bf16, WS_G2T) + (size_t)l * 512 * 128;
    for (int i = F.tid; i < 512 * 16; i += NTHR) { const int r = i >> 4, c = (i & 15) * 8; *(LAS v4u*)(G2 + r * GP + c) = *(const v4u*)(g2t + r * 128 + c); }
    __syncthreads();
    const int gw = F.bx * NWAVES + F.wave, NGW = F.G * NWAVES, lane = F.lane, fr = lane & 15, fq = lane >> 4;
    const bf16* Z = WSP(bf16, WS_Z); const bf16* YSb = WSP(bf16, WS_YS); const float* BONG = WSP(float, WS_BONG); bf16* YM = WSP(bf16, WS_H);
    const float* gnw = P.in[I_GNW] + l * 512; const float* gnb = P.in[I_GNB] + l * 512; const float* mu = P.in[I_MU];
    const int nu = (nrows / 16) * 2;
    for (int u = gw; u < nu; u += NGW) {
        const int row = (u >> 1) * 16 + fr, half = u & 1;
        bf16x8 sf[4];
#pragma unroll
        for (int ks = 0; ks < 4; ++ks) { const v4u zv = *(const v4u*)(Z + (size_t)row * NZ + C_GLO + 32 * ks + 8 * fq); v4u o;
#pragma unroll
            for (int q = 0; q < 4; ++q) o[q] = pk2(sigmoidf_(bflo(zv[q])), sigmoidf_(bfhi(zv[q])));
            sf[ks] = __builtin_bit_cast(bf16x8, o); }
        int t, len; if (row < NT) { t = row & (SEQ - 1); len = SEQ; } else { t = (row - NT) & (LC - 1); len = LC; }
#pragma unroll 1
        for (int hh = 0; hh < 4; ++hh) {
            const int head = 4 * half + hh;
            f32x4 acc[4];
#pragma unroll
            for (int j = 0; j < 4; ++j) acc[j] = (f32x4){0.f, 0.f, 0.f, 0.f};
#pragma unroll
            for (int ks = 0; ks < 4; ++ks)
#pragma unroll
                for (int j = 0; j < 4; ++j) acc[j] = MFMA16(*(const LAS bf16x8*)(G2 + (64 * head + 16 * j + fr) * GP + 32 * ks + 8 * fq), sf[ks], acc[j]);
            f32x4 osum[4];
#pragma unroll
            for (int j = 0; j < 4; ++j) osum[j] = (f32x4){0.f, 0.f, 0.f, 0.f};
#pragma unroll
            for (int dir = 0; dir < 2; ++dir) {
                const bool hp = dir ? (t + 1 < len) : (t > 0); const int prow = hp ? (dir ? row + 1 : row - 1) : row;
                const bf16* ys = YSb + ((size_t)dir * MT + row) * 512 + 64 * head + 4 * fq;
                f32x4 y[4]; float s = 0.f;
#pragma unroll
                for (int j = 0; j < 4; ++j) { y[j] = ld4bf(ys + 16 * j); s += (y[j].x + y[j].y) + (y[j].z + y[j].w); }
                s += __shfl_xor(s, 16); s += __shfl_xor(s, 32);
                const float mean = s * (1.0f / 64.0f); float q2 = 0.f;
#pragma unroll
                for (int j = 0; j < 4; ++j) { y[j] = y[j] - mean; q2 += (y[j].x * y[j].x + y[j].y * y[j].y) + (y[j].z * y[j].z + y[j].w * y[j].w); }
                q2 += __shfl_xor(q2, 16); q2 += __shfl_xor(q2, 32);
                const float rstd = rsqrtf(q2 * (1.0f / 64.0f) + GN_EPS);
                const float bon = BONG[((size_t)dir * MT + row) * 8 + head];
#pragma unroll
                for (int j = 0; j < 4; ++j) { const int ch = 64 * head + 16 * j + 4 * fq;
                    const f32x4 vc = ld4bf(Z + (size_t)row * NZ + C_V + ch), vp = hp ? ld4bf(Z + (size_t)prow * NZ + C_V + ch) : (f32x4){0.f, 0.f, 0.f, 0.f};
                    const f32x4 mv = *(const f32x4*)(mu + (size_t)((l * 2 + dir) * 3 + 1) * 512 + ch);
                    const f32x4 vx = vc + (vp - vc) * mv;
                    osum[j] += y[j] * rstd * *(const f32x4*)(gnw + ch) + *(const f32x4*)(gnb + ch) + bon * vx; }
            }
#pragma unroll
            for (int j = 0; j < 4; ++j) { const int n = 64 * head + 16 * j + 4 * fq; const f32x4 o = osum[j] * acc[j];
                v2u wv; wv.x = pk2(o.x, o.y); wv.y = pk2(o.z, o.w); *(v2u*)(YM + (size_t)row * D + n) = wv; }
        }
    }
    __syncthreads();
}

struct MoePlan { int pb[9]; };
__device__ __forceinline__ void moe_plan(const Params& P, MoePlan& M, int (&cnt)[NE]) {
    int acc = 0;
#pragma unroll
    for (int e = 0; e < NE; ++e) { cnt[e] = (int)__hip_atomic_load(WSP(unsigned, WS_CTL) + CW_CNT + 64 * e, __ATOMIC_RELAXED, __HIP_MEMORY_SCOPE_AGENT); M.pb[e] = acc; acc += (cnt[e] + 255) >> 8; }
    M.pb[8] = acc;
}
__device__ __forceinline__ void moe_assign_gather(const Params& P, const Frame& F) {
    MoePlan M; int cnt[NE]; moe_plan(P, M, cnt);
    const int gw = F.bx * NWAVES + F.wave, NGW = F.G * NWAVES, lane = F.lane;
    const bf16* H = WSP(bf16, WS_H); bf16* XG = WSP(bf16, WS_XG);
    unsigned* fill = WSP(unsigned, WS_CTL) + CW_FILL;
    for (int it = gw; it < NT / 64; it += NGW) {
        const int tok = it * 64 + lane;
        const int4 rt = *(const int4*)(P.ws + WS_ROUTE + (size_t)tok * 16);
        const int es[2] = {rt.x & 255, (rt.x >> 8) & 255};
        int pos[2];
#pragma unroll
        for (int s = 0; s < 2; ++s) {
            pos[s] = 0;
#pragma unroll
            for (int e = 0; e < NE; ++e) {
                const unsigned long long m = __ballot(es[s] == e);
                if (m) {
                    const int n = __popcll(m), first = __ffsll((long long)m) - 1;
                    unsigned base = 0;
                    if (lane == first) base = __hip_atomic_fetch_add(fill + 64 * e, (unsigned)n, __ATOMIC_RELAXED, __HIP_MEMORY_SCOPE_AGENT);
                    base = __shfl(base, first);
                    const int rank = __popcll(m & ((1ull << lane) - 1ull));
                    if (es[s] == e) pos[s] = M.pb[e] * 256 + (int)base + rank;
                }
            }
        }
        *(int2*)(P.ws + WS_TOKPOS + (size_t)tok * 8) = make_int2(pos[0], pos[1]);
        for (int i = 0; i < 64; ++i) {
            const int t = it * 64 + i, d0 = __shfl(pos[0], i), d1 = __shfl(pos[1], i);
            const v4u a = *(const v4u*)(H + (size_t)t * D + 8 * lane), b = *(const v4u*)(H + (size_t)t * D + 512 + 8 * lane);
            *(v4u*)(XG + (size_t)d0 * D + 8 * lane) = a; *(v4u*)(XG + (size_t)d0 * D + 512 + 8 * lane) = b;
            *(v4u*)(XG + (size_t)d1 * D + 8 * lane) = a; *(v4u*)(XG + (size_t)d1 * D + 512 + 8 * lane) = b;
        }
    }
#pragma unroll
    for (int e = 0; e < NE; ++e) {
        const int r0 = M.pb[e] * 256 + cnt[e], r1 = M.pb[e + 1] * 256;
        for (int r = r0 + gw; r < r1; r += NGW) { *(v4u*)(XG + (size_t)r * D + 8 * lane) = (v4u){0u, 0u, 0u, 0u}; *(v4u*)(XG + (size_t)r * D + 512 + 8 * lane) = (v4u){0u, 0u, 0u, 0u}; }
    }
}

__device__ __forceinline__ Frame make_frame(LAS unsigned char* lds, int wave0) {
    Frame F; int tid = wave0 * 64 + (int)__builtin_amdgcn_mbcnt_hi(~0u, __builtin_amdgcn_mbcnt_lo(~0u, 0u)), G = gridDim.x, bx = blockIdx.x;
    asm volatile("" : "+v"(tid)); asm volatile("" : "+s"(G)); asm volatile("" : "+s"(bx));
    F.lds = lds; F.tid = tid; F.lane = tid & 63; F.wave = __builtin_amdgcn_readfirstlane(tid >> 6); F.G = G; F.bx = bx; return F;
}
#define CAS __attribute__((address_space(4)))
#define WSQ(T, off) ((T*)(Q.ws + (off)))
#if defined(__HIP_DEVICE_COMPILE__)
__device__ __forceinline__ Params load_params() { const CAS void* p = (const CAS void*)__builtin_amdgcn_kernarg_segment_ptr(); asm volatile("" : "+s"(p)); return *(const CAS Params*)p; }
#else
__device__ __forceinline__ Params load_params() { return Params{}; }
#endif
#ifndef PG8_SP2
#define PG8_SP2 true
#endif
#ifndef PG8_ALIGN
#define PG8_ALIGN true
#endif
#ifndef REP_MASK
#define REP_MASK 0
#endif
#define NREP(k) (1 + (((REP_MASK) >> (k)) & 1))
#ifdef PHMASK
#define IN(k) (((PHMASK) >> (k)) & 1)
#else
#define IN(k) (lo <= (k) && (k) < hi)
#endif
#define GRID_BARRIER() do { XcdBarrier b_ = bar; asm volatile("" : "+s"(b_.bar)); xcd_barrier(b_); } while (0)
#define SEAM(k) do { if (IN(k) && IN((k) + 1)) GRID_BARRIER(); } while (0)

__device__ __forceinline__ int tail_busy(int nwg, int G) {
#ifdef KEEP_SEAMS
    return 0;
#endif
    const int R = nwg / G, T = nwg - R * G; return (R >= 1 && 2 * T <= G) ? T : 0; }
#define PCNT(base) (WSQ(unsigned, WS_CTL) + CW_PCNT + (base))
#ifndef DOWN_SPLIT
#define DOWN_SPLIT 4
#endif
#ifndef MOE_SPLIT
#define MOE_SPLIT 4
#endif
#ifndef EXCL_WOUT0
#define EXCL_WOUT0 144
#endif
#ifndef EXCL_DOWN
#define EXCL_DOWN 68
#endif
#ifndef EXCL_MOE
#define EXCL_MOE 110
#endif
struct MoeTail { int p0, np, S, nfull, tp; size_t part_off; };
__device__ __forceinline__ MoeTail moe_tail(int ptot, int cap, int gq, int G) {
    int p0 = 0, np = 0;
    while (p0 < ptot) { np = ptot - p0; if (np > cap) np = gq; if (np <= 0 || p0 + np >= ptot) break; p0 += np; }
    pg8::SplitOrder T; T.np = np; T.nct = D / 256; T.G = G; T.init_split(MOE_SPLIT);
    MoeTail r; r.p0 = p0; r.np = np; r.S = T.S; r.nfull = T.nfull; r.tp = T.tail_panels(); r.part_off = WS_ACTM + (size_t)np * 256 * DFE * 2;
    if (r.S > 1 && r.part_off + (size_t)r.S * r.tp * 256 * D * 4 > WS_NEED) { r.S = 1; r.nfull = np * (D / 256); r.tp = 0; }
    return r;
}
#ifdef PROD_OLD
#define PNEED 0u
#else
#define PNEED 32u
#endif
#ifdef TPROBE
#ifndef TPROBE_BLK
#define TPROBE_BLK 0
#endif
#ifndef TPROBE_SCALE
#define TPROBE_SCALE 10
#endif
#define TP_BEGIN(k) do { if ((k) == TPROBE && (int)blockIdx.x == (TPROBE_BLK) && wave0 == 0) { __syncthreads_dummy(); MISC[41] = (unsigned)__builtin_amdgcn_s_memrealtime(); } } while (0)
#define TP_END(k) do { if ((k) == TPROBE && (int)blockIdx.x == (TPROBE_BLK) && wave0 == 0) { MISC[40] += (unsigned)__builtin_amdgcn_s_memrealtime() - MISC[41]; } } while (0)
__device__ __forceinline__ void __syncthreads_dummy() {}
#else
#define TP_BEGIN(k) do {} while (0)
#define TP_END(k) do {} while (0)
#endif
template <int l>
__device__ __forceinline__ void layer_phases(const XcdBarrier& bar, LAS unsigned char* const lds0, volatile LAS unsigned* MISC, const int lo, const int hi, const int wave0) {
        const int pb = 1 + 8 * l;
        for (int rep_ = 0; rep_ < NREP(pb + 1); ++rep_) { if (rep_) GRID_BARRIER();
        if (IN(pb + 1)) {
            const Params Q = load_params(); const Frame F = make_frame(lds0, wave0);
            pg8::Gemm g{WSQ(bf16, WS_H), WSQ(bf16, WS_WIN) + (size_t)l * NZ * D, MT, NZ, D}; pg8::StaticOrder S; S.init(MT, NZ, F.G, F.bx);
            pg8::EpiBf16<0> E{WSQ(bf16, WS_Z), NZ, nullptr, 0, 0, 1.f};
            pg8::gemm_phase<pg8::EpiBf16<0>, pg8::StaticOrder, PG8_ALIGN, PG8_SP2>(F.lds, g, S, E, F.wave);
        } }
        SEAM(pb + 1);
        for (int rep_ = 0; rep_ < NREP(pb + 2); ++rep_) { if (rep_) GRID_BARRIER();
        if (IN(pb + 2)) {
            const Params Q = load_params(); const Frame F = make_frame(lds0, wave0);
#ifdef FORCE_SOLO
            const bool paired = false;
#else
            const bool paired = F.G >= 256;
#endif
            const int nsb = F.G > 128 ? 128 : 0;
#ifndef NO_SCAN
#ifdef SCAN_PIPE
            (void)paired;
            if (F.bx < nsb || nsb == 0) { const int st = nsb ? nsb : F.G; for (int u = F.bx; u < 128; u += st) scan_unit_pipe(Q, F, l, u >> 4, (u >> 1) & 7, u & 1); }
#else
            if (paired) { if (F.bx < 128) scan_unit(Q, F, l, F.bx >> 4, (F.bx >> 1) & 7, F.bx & 1, 0); else if (F.bx < 256) { const int u = F.bx - 128; scan_unit(Q, F, l, u >> 4, (u >> 1) & 7, u & 1, 1); } }
            else if (F.bx < nsb || nsb == 0) { const int st = nsb ? nsb : F.G; for (int u = F.bx; u < 128; u += st) scan_unit(Q, F, l, u >> 4, (u >> 1) & 7, u & 1, 2); }
#endif
#endif
#ifdef PROBE_CF2
            for (int prb_ = 0; prb_ < 2; ++prb_)
#endif
            if (F.bx >= nsb) {
                const int ob = F.bx - nsb, nob = F.G - nsb;
#ifndef NO_CONV
                conv_items(Q, F, l, l == 0 ? MT : NT, ob, nob);
#endif
#ifndef NO_FA
#ifdef PROBE_FA2
                for (int prb_ = 0; prb_ < 2; ++prb_)
#endif
                for (int it = ob; it < 256; it += nob) fourier_a_iter(Q, F, it);
#endif
#ifndef NO_FC
                if (l == 0) for (int u = ob; u < 32; u += nob) fourier_ctx_unit(Q, F, u);
#endif
            }
        } }
        SEAM(pb + 2);
        for (int rep_ = 0; rep_ < NREP(pb + 3); ++rep_) { if (rep_) GRID_BARRIER();
        if (IN(pb + 3)) {
            const Params Q = load_params(); const Frame F = make_frame(lds0, wave0);
            LAS bf16* TC64 = (LAS bf16*)F.lds; LAS bf16* TS64 = TC64 + 64 * TP;
            load_tab64(TC64, WSQ(bf16, TAB_C64), F.tid); load_tab64(TS64, WSQ(bf16, TAB_S64), F.tid);
            __syncthreads();
#ifndef NO_FB
#ifdef PROBE_FB2
            for (int prb_ = 0; prb_ < 2; ++prb_)
#endif
            for (int u = F.bx * NWAVES + F.wave; u < 2048; u += F.G * NWAVES) fourier_b_unit(Q, F, u, TC64, TS64);
#endif
            __syncthreads();
#ifndef NO_FIN
            finalize_phase(Q, F, l, l == 0 ? MT : NT);
#endif
        } }
        SEAM(pb + 3);
        for (int rep_ = 0; rep_ < NREP(pb + 4); ++rep_) { if (rep_) GRID_BARRIER();
        if (IN(pb + 4)) {
            const Params Q = load_params(); const Frame F = make_frame(lds0, wave0);
            const int M = l == 0 ? MT : NT;
#ifdef PROD_OLD
            pg8::Gemm g{WSQ(bf16, WS_H), WSQ(bf16, WS_WOUT) + (size_t)l * D * D, M, D, D}; pg8::StaticOrder S; S.init(M, D, F.G, F.bx);
            pg8::EpiBf16<0> E{WSQ(bf16, WS_O32), D, nullptr, 0, 0, 1.f};
            pg8::gemm_phase<pg8::EpiBf16<0>, pg8::StaticOrder, PG8_ALIGN, PG8_SP2>(F.lds, g, S, E, F.wave);
#else
            pg8::Gemm g{WSQ(bf16, WS_H), WSQ(bf16, WS_WOUT) + (size_t)l * D * D, M, D, D}; pg8::PubOrder<pg8::StaticOrder> S; S.init(M, D, F.G, F.bx); S.cntr = PCNT(l == 0 ? PC_WOUT0 : PC_WOUT1); S.pend = -1;
            pg8::EpiBf16WT E{WSQ(bf16, WS_O32), D, 1 << 20};
            TP_BEGIN(l == 0 ? 3 : 7);
            pg8::gemm_phase<pg8::EpiBf16WT, pg8::PubOrder<pg8::StaticOrder>, PG8_ALIGN, PG8_SP2>(F.lds, g, S, E, F.wave);
            TP_END(l == 0 ? 3 : 7);
#endif
        } }
#ifdef KEEP_SEAMS
        SEAM(pb + 4);
#endif
        if (l == 0) {
            if (IN(pb + 5)) { const Params Q = load_params(); const Frame F = make_frame(lds0, wave0); TP_BEGIN(4); phase_post<0, true, false, true>(Q, F, MT, 0, 2048, 1, Q.in[I_CTX], 0, 2, 4096, 3072, PCNT(PC_WOUT0), PNEED, tail_busy((MT / 256) * (D / 256), F.G), (int)((long)MT * EXCL_WOUT0 / 256)); TP_END(4); }
            SEAM(pb + 5);
            for (int rep_ = 0; rep_ < NREP(pb + 6); ++rep_) { if (rep_) GRID_BARRIER();
            if (IN(pb + 6)) {
            const Params Q = load_params(); const Frame F = make_frame(lds0, wave0);
                pg8::Gemm g{WSQ(bf16, WS_H), WSQ(bf16, WS_WGU), MT, 2 * DFF, D}; pg8::StaticOrder S; S.init(MT, 2 * DFF, F.G, F.bx);
                pg8::EpiSwiglu E{WSQ(bf16, WS_Z), DFF, 0, 1 << 20};
                pg8::gemm_phase<pg8::EpiSwiglu, pg8::StaticOrder, PG8_ALIGN, PG8_SP2>(F.lds, g, S, E, F.wave);
            } }
            SEAM(pb + 6);
            for (int rep_ = 0; rep_ < NREP(pb + 7); ++rep_) { if (rep_) GRID_BARRIER();
            if (IN(pb + 7)) {
            const Params Q = load_params(); const Frame F = make_frame(lds0, wave0);
#ifdef PROD_OLD
                pg8::Gemm g{WSQ(bf16, WS_Z), WSQ(bf16, WS_WDN), MT, D, DFF}; pg8::StaticOrder S; S.init(MT, D, F.G, F.bx);
                pg8::EpiBf16<0> E{WSQ(bf16, WS_O32), D, nullptr, 0, 0, 1.f};
                pg8::gemm_phase<pg8::EpiBf16<0>, pg8::StaticOrder, PG8_ALIGN, PG8_SP2>(F.lds, g, S, E, F.wave);
#else
                pg8::Gemm g{WSQ(bf16, WS_Z), WSQ(bf16, WS_WDN), MT, D, DFF};
                pg8::PubOrder<pg8::SplitOrder> S; S.p0 = 0; S.np = MT / 256; S.nct = D / 256; S.G = F.G; S.c = F.bx; S.pb[0] = 0;
#pragma unroll
                for (int j = 1; j < 9; ++j) S.pb[j] = 1 << 20;
                S.init_split(DOWN_SPLIT); S.cntr = PCNT(PC_DOWN0); S.pend = -1;
                pg8::EpiSplitWT E{WSQ(bf16, WS_O32), D, D / 256, WSQ(float, WS_PARTD), S.nfull / (D / 256), S.tail_panels() * 256};
                TP_BEGIN(1);
                pg8::gemm_phase<pg8::EpiSplitWT, pg8::PubOrder<pg8::SplitOrder>, PG8_ALIGN, PG8_SP2>(F.lds, g, S, E, F.wave);
                TP_END(1);
#endif
            } }
#ifdef KEEP_SEAMS
            SEAM(pb + 7);
#endif
            if (IN(pb + 8)) { const Params Q = load_params(); const Frame F = make_frame(lds0, wave0); pg8::SplitOrder T; T.np = MT / 256; T.nct = D / 256; T.G = F.G; T.init_split(DOWN_SPLIT); const bool sp = T.S > 1;
                TP_BEGIN(2); phase_post<0, true, false>(Q, F, MT, 0, 5120, 3, (const float*)(Q.ws + WS_XC), 1, 0, 1024, 0, PCNT(PC_DOWN0), PNEED, sp ? T.tail_panels() * T.nct * T.S : tail_busy(T.np * T.nct, F.G),
                    (int)((long)MT * (sp ? EXCL_DOWN : EXCL_WOUT0) / 256), WSQ(float, WS_PARTD), sp ? (T.nfull / T.nct) * 256 : 0x7fffffff, T.S, T.tail_panels() * 256); TP_END(2); }
            SEAM(pb + 8);
        } else {
            if (IN(pb + 5)) { const Params Q = load_params(); const Frame F = make_frame(lds0, wave0); phase_post<0, true, true>(Q, F, NT, 1, 2048, 1, nullptr, 1, 2, 4096, 3072, PCNT(PC_WOUT1), PNEED, tail_busy((NT / 256) * (D / 256), F.G), 0); }
            SEAM(pb + 5);
            if (IN(pb + 6)) { const Params Q = load_params(); const Frame F = make_frame(lds0, wave0); for (int rep_ = 0; rep_ < NREP(15); ++rep_) convert_moe_weights(Q, F); moe_assign_gather(Q, F); }
            SEAM(pb + 6);
            if (IN(pb + 7)) {
            const Params Q = load_params(); const Frame F = make_frame(lds0, wave0);
                if (F.tid == 0) { MoePlan M; int cnt[NE]; moe_plan(Q, M, cnt);
#pragma unroll
                    for (int j = 0; j < 9; ++j) MISC[16 + j] = (unsigned)M.pb[j]; }
                __syncthreads();
                const int ptot = (int)MISC[16 + 8], gq = (F.G >= 256 && Q.act_cap_panels >= 128) ? 128 : (Q.act_cap_panels < 64 ? Q.act_cap_panels : 64);
                const MoeTail mt = moe_tail(ptot, Q.act_cap_panels, gq, F.G);
                int p0 = 0;
                while (p0 < ptot) {
                    int np = ptot - p0; if (np > Q.act_cap_panels) np = gq;
                    if (np > 0) {
                        for (int rep_ = 0; rep_ < NREP(16); ++rep_) { if (rep_) GRID_BARRIER();
                            pg8::Gemm g{WSQ(bf16, WS_XG), WSQ(bf16, WS_WMGU), 0, 0, D};
                            pg8::MoeOrder S; S.p0 = p0; S.np = np; S.nct = 2 * DFE / 256; S.G = F.G; S.c = F.bx;
#pragma unroll
                            for (int j = 0; j < 9; ++j) S.pb[j] = (int)MISC[16 + j];
                            pg8::EpiSwiglu E{WSQ(bf16, WS_ACTM), DFE, p0, 2 * DFE / 256};
                            pg8::gemm_phase<pg8::EpiSwiglu, pg8::MoeOrder, PG8_ALIGN, PG8_SP2>(F.lds, g, S, E, F.wave);
                        }
                        GRID_BARRIER();
                        for (int rep_ = 0; rep_ < NREP(17); ++rep_) { if (rep_) GRID_BARRIER();
                            pg8::Gemm g{WSQ(bf16, WS_ACTM) - (size_t)p0 * 256 * DFE, WSQ(bf16, WS_WMDN), 0, 0, DFE};
#ifdef PROD_OLD
                            pg8::MoeOrder S; S.p0 = p0; S.np = np; S.nct = D / 256; S.G = F.G; S.c = F.bx;
#pragma unroll
                            for (int j = 0; j < 9; ++j) S.pb[j] = (int)MISC[16 + j];
                            pg8::EpiBf16Mod E{WSQ(bf16, WS_XG), D, D / 256};
                            pg8::gemm_phase<pg8::EpiBf16Mod, pg8::MoeOrder, PG8_ALIGN, PG8_SP2>(F.lds, g, S, E, F.wave);
#else
                            pg8::PubOrder<pg8::SplitOrder> S; S.p0 = p0; S.np = np; S.nct = D / 256; S.G = F.G; S.c = F.bx; S.cntr = PCNT(PC_MOE); S.pend = -1;
#pragma unroll
                            for (int j = 0; j < 9; ++j) S.pb[j] = (int)MISC[16 + j];
                            S.init_split(p0 == mt.p0 ? mt.S : 1);
                            pg8::EpiSplitWT E{WSQ(bf16, WS_XG), D, D / 256, (float*)(Q.ws + mt.part_off), p0 + S.nfull / (D / 256), S.tail_panels() * 256};
                            TP_BEGIN(5);
                            pg8::gemm_phase<pg8::EpiSplitWT, pg8::PubOrder<pg8::SplitOrder>, PG8_ALIGN, PG8_SP2>(F.lds, g, S, E, F.wave);
                            TP_END(5);
#endif
                        }
#ifdef KEEP_SEAMS
                        GRID_BARRIER();
#else
                        if (p0 + np < ptot) GRID_BARRIER();
#endif
                    }
                    p0 += np;
                }
            }
            if (IN(pb + 8)) { const Params Q = load_params(); const Frame F = make_frame(lds0, wave0);
                MoePlan M; int cnt[NE]; moe_plan(Q, M, cnt);
                const int ptot = M.pb[8], gq = (F.G >= 256 && Q.act_cap_panels >= 128) ? 128 : (Q.act_cap_panels < 64 ? Q.act_cap_panels : 64);
                const MoeTail mt = moe_tail(ptot, Q.act_cap_panels, gq, F.G); const bool sp = mt.S > 1;
                TP_BEGIN(6); phase_post<1, false, false>(Q, F, NT, 1, 5120, 3, nullptr, 1, 0, 0, 0, PCNT(PC_MOE), PNEED, sp ? mt.tp * (D / 256) * mt.S : tail_busy(mt.np * (D / 256), F.G),
                    (int)((long)NT * (sp ? EXCL_MOE : 200) / 256), (const float*)(Q.ws + mt.part_off), sp ? (mt.p0 + mt.nfull / (D / 256)) * 256 : 0x7fffffff, mt.S, mt.tp * 256); TP_END(6); }
        }
    }
constexpr int N_PHASES = 18;
__global__ void __launch_bounds__(NTHR, 2) fwd_kernel(Params P) {
    extern __shared__ __attribute__((aligned(16))) unsigned char lds_raw[];
    LAS unsigned char* const lds0 = (LAS unsigned char*)lds_raw;
    volatile LAS unsigned* MISC = (volatile LAS unsigned*)(lds0 + MISC_OFF);
    const int wave0 = __builtin_amdgcn_readfirstlane((int)threadIdx.x >> 6);
    if (wave0 == 0) MISC[__builtin_amdgcn_mbcnt_hi(~0u, __builtin_amdgcn_mbcnt_lo(~0u, 0u))] = 0u;
    __syncthreads();
    unsigned* ctl = (unsigned*)(P.ws + WS_CTL);
    XcdBarrier bar = xcd_barrier_post(ctl + CW_BAR + P.li * XCD_BAR_WORDS, MISC + 8, wave0 == 0 ? 1u : 0u);
    const int lo = P.ph_lo, hi = P.ph_hi;
    for (int rep_ = 0; rep_ < NREP(0); ++rep_) { if (rep_) GRID_BARRIER(); if (IN(0)) { const Params Q = load_params(); const Frame F = make_frame(lds0, wave0); p0_adaln(Q, F); p0_small_weights(Q, F); p0_tables(Q, F); } }
    SEAM(0);
#ifdef PROBE_FN_NOSTORE
    for (int rep_ = 0; rep_ < 2; ++rep_) { if (rep_) GRID_BARRIER(); if (IN(1)) { const Params Q = load_params(); const Frame F = make_frame(lds0, wave0); phase_first_norm(Q, F); } }
#else
    for (int rep_ = 0; rep_ < NREP(1); ++rep_) { if (rep_) GRID_BARRIER(); if (IN(1)) { const Params Q = load_params(); const Frame F = make_frame(lds0, wave0); phase_first_norm(Q, F); } }
#endif
    SEAM(1);
#ifdef PROBE_BAR
    for (int prb_ = 0; prb_ < 20; ++prb_) GRID_BARRIER();
#endif
    layer_phases<0>(bar, lds0, MISC, lo, hi, wave0);
    layer_phases<1>(bar, lds0, MISC, lo, hi, wave0);
#ifdef TPROBE
    if ((int)blockIdx.x == (TPROBE_BLK) && wave0 == 0) { const unsigned long long t0 = __builtin_amdgcn_s_memrealtime(), dt = (unsigned long long)MISC[40] * (TPROBE_SCALE);
        while (__builtin_amdgcn_s_memrealtime() - t0 < dt) __builtin_amdgcn_s_sleep(8); }
#endif
#undef IN
#undef SEAM
}

#ifndef MK_PER_PHASE
#define MK_PER_PHASE 0
#endif
extern "C" void kernel_launch(void* const* d_in, const int* in_sizes, int n_in, void* d_out, int out_size, void* d_ws, size_t ws_size, hipStream_t stream) {
    static int grid = 0;
    if (grid == 0) {
        if (n_in != N_IN || in_sizes[0] != NT * D || out_size != NT * D || ws_size < WS_NEED) {
            fprintf(stderr, "kernel_launch: unexpected shapes (n_in %d, in0 %d, out %d, ws %zu); nothing launched\n", n_in, n_in > 0 ? in_sizes[0] : -1, out_size, ws_size); grid = -1; return; }
        int dev = 0, cus = 0, per_cu = 0;
        if (hipGetDevice(&dev) != hipSuccess || hipDeviceGetAttribute(&cus, hipDeviceAttributeMultiprocessorCount, dev) != hipSuccess) { grid = -1; return; }
        if (hipFuncSetAttribute((const void*)fwd_kernel, hipFuncAttributeMaxDynamicSharedMemorySize, LDS_BYTES) != hipSuccess) { fprintf(stderr, "kernel_launch: hipFuncSetAttribute failed\n"); grid = -1; return; }
        if (hipOccupancyMaxActiveBlocksPerMultiprocessor(&per_cu, (const void*)fwd_kernel, NTHR, LDS_BYTES) != hipSuccess || per_cu < 1)
            fprintf(stderr, "kernel_launch: occupancy query reports %d workgroups per CU\n", per_cu);
        (void)hipGetLastError();
        grid = cus;
    }
    if (grid < 0) return;
    if (hipMemsetAsync((char*)d_ws + WS_CTL, 0, CTL_ZERO_BYTES, stream) != hipSuccess) return;
    Params p{};
    for (int i = 0; i < N_IN; ++i) p.in[i] = (const float*)d_in[i];
    p.out = (float*)d_out; p.ws = (unsigned char*)d_ws;
    { size_t avail = ws_size - WS_ACTM; size_t cap = avail / ((size_t)256 * DFE * 2); if (cap > 264) cap = 264; p.act_cap_panels = (int)cap; }
#if MK_PER_PHASE
    int li = 0;
    for (int ph = 0; ph < N_PHASES; ++ph) {
        p.ph_lo = ph; p.ph_hi = ph + 1; p.li = li++;
        hipLaunchKernelGGL(fwd_kernel, dim3(grid), dim3(NTHR), LDS_BYTES, stream, p);
    }
#else
    p.ph_lo = 0; p.ph_hi = N_PHASES; p.li = 0;
    hipLaunchKernelGGL(fwd_kernel, dim3(grid), dim3(NTHR), LDS_BYTES, stream, p);
#endif
}
```

```cpp
#define POST_PLAINLD 1
#include <hip/hip_runtime.h>
#include <cstdio>
#include <cstdint>
namespace pg8 {
#define PG8_LAS __attribute__((address_space(3)))
typedef unsigned short bf16_t;
typedef short bf16x8 __attribute__((ext_vector_type(8)));
typedef float f32x4 __attribute__((ext_vector_type(4)));
typedef unsigned u32x4 __attribute__((ext_vector_type(4)));
constexpr int BM = 256, BK = 64, HALF = 128, HTB = HALF * BK * 2  , STAGE_BYTES = 8 * HTB, NXCD = 8, WGM = 8;

__host__ __device__ __forceinline__ int lds_byte(int r, int c) { const int st = (r >> 4) * 2 + (c >> 5), rr = r & 15, cc = c & 31, ob = rr * 64 + cc * 2; return st * 1024 + (ob ^ (((ob >> 9) & 1) << 5)); }
__host__ __device__ __forceinline__ void stage_rc(int b, int& R, int& C) { const int st = b / 1024, sb = b % 1024, swz = sb ^ (((sb >> 9) & 1) << 5); R = (st >> 1) * 16 + swz / 64; C = (st & 1) * 32 + (swz % 64) / 2; }
__host__ __device__ __forceinline__ int perm32(int rho) { const int n = rho >> 4, i = rho & 15; return 8 * (i >> 2) + 4 * n + (i & 3); }

struct Unit { int pm, pn; };
struct Gemm { const bf16_t* A; const bf16_t* Bt; int M, N, K; };

struct StaticOrder {
    static constexpr bool SPLITK = false;
    int nM, nN, nwg, G, c;
    __host__ __device__ void init(int M, int N, int G_, int c_) { nM = M / BM; nN = N / BM; nwg = nM * nN; G = G_; c = c_; }
    __host__ __device__ bool next(int i, Unit& u) const {
        const long L = (long)i * G + c; if (L >= nwg) return false;
        int wgid = (int)L; { const int q = nwg / NXCD, r = nwg % NXCD, xcd = wgid % NXCD, off = wgid / NXCD; wgid = (xcd < r ? xcd * (q + 1) : r * (q + 1) + (xcd - r) * q) + off; }
        const int nig = WGM * nN, gid = wgid / nig, fm = gid * WGM, gsz = (nM - fm) < WGM ? (nM - fm) : WGM;
        u.pm = fm + ((wgid % nig) % gsz); u.pn = (wgid % nig) / gsz; return true;
    }
    __device__ __forceinline__ void a_ready(const Unit&) const {}
    __device__ __forceinline__ void done(const Unit&) const {}
    __device__ __forceinline__ void flush() const {}
};

__device__ __forceinline__ unsigned cvt_pk_bf16(float lo, float hi) { unsigned r; asm volatile("v_cvt_pk_bf16_f32 %0, %1, %2" : "=v"(r) : "v"(lo), "v"(hi)); return r; }
typedef float f32x2 __attribute__((ext_vector_type(2)));
__device__ __forceinline__ f32x2 gelu_pk(f32x2 v) {
    const f32x2 av = __builtin_elementwise_abs(v), d = av * 0.2316418882f + 1.0f;
    f32x2 t; t.x = __builtin_amdgcn_rcpf(d.x); t.y = __builtin_amdgcn_rcpf(d.y);
    f32x2 q = t * 0.5307027145f + (-0.7265760135f); q = q * t + 0.7107068705f; q = q * t + (-0.142248368f); q = q * t + 0.127414796f; q = q * t;
    const f32x2 s = (v * v) * (-0.72134752044f);
    f32x2 e; e.x = __builtin_amdgcn_exp2f(s.x); e.y = __builtin_amdgcn_exp2f(s.y);
    const f32x2 m = v * (q * e), r = v - m;
    f32x2 o; o.x = v.x < 0.f ? m.x : r.x; o.y = v.y < 0.f ? m.y : r.y; return o;
}

template <int ACT  > struct EpiBf16 {
    static constexpr bool PERM = true, AFTER_DRAIN = false; static_assert(ACT == 0 || ACT == 1, "EpiBf16: ACT is 0 (none) or 1 (gelu_pk)");
    bf16_t* O; int ldc; const float* bias; int split_cols; size_t split_stride; float scale0;
    __device__ __forceinline__ void operator()(const f32x4 (&acc)[2][2][4][2], const Unit& u, int wr, int wc, int fr, int fq) const {
        const int row0 = u.pm * BM + wr * 64 + fr; int colt = u.pn * BM; bf16_t* base = O;
        float sc = 1.f; if (split_cols) { const int t = colt / split_cols; base += (size_t)t * split_stride; colt -= t * split_cols; if (t == 0) sc = scale0; }
        const int col0 = colt + wc * 32 + 8 * fq, bcol0 = u.pn * BM + wc * 32 + 8 * fq;
        f32x4 bv[2][2];
#pragma unroll
        for (int bj = 0; bj < 2; ++bj)
#pragma unroll
            for (int n = 0; n < 2; ++n) bv[bj][n] = bias ? *(const f32x4*)(bias + bcol0 + bj * HALF + 4 * n) : (f32x4){0.f, 0.f, 0.f, 0.f};
#pragma unroll
        for (int ai = 0; ai < 2; ++ai)
#pragma unroll
            for (int m = 0; m < 4; ++m) { bf16_t* rowp = base + (size_t)(row0 + ai * HALF + m * 16) * ldc + col0;
#pragma unroll
                for (int bj = 0; bj < 2; ++bj) { f32x4 v0 = acc[ai][bj][m][0] + bv[bj][0], v1 = acc[ai][bj][m][1] + bv[bj][1];
                    if (ACT == 1) { f32x2 a = gelu_pk((f32x2){v0[0], v0[1]}), b = gelu_pk((f32x2){v0[2], v0[3]}), c = gelu_pk((f32x2){v1[0], v1[1]}), d = gelu_pk((f32x2){v1[2], v1[3]});
                        v0 = (f32x4){a.x, a.y, b.x, b.y}; v1 = (f32x4){c.x, c.y, d.x, d.y}; }
                    v0 = v0 * sc; v1 = v1 * sc; u32x4 w; w.x = cvt_pk_bf16(v0[0], v0[1]); w.y = cvt_pk_bf16(v0[2], v0[3]); w.z = cvt_pk_bf16(v1[0], v1[1]); w.w = cvt_pk_bf16(v1[2], v1[3]);
                    *(u32x4*)(rowp + bj * HALF) = w; } }
    }
};

struct EpiF32 {
    static constexpr bool PERM = false, AFTER_DRAIN = false;
    float* C; int ldc; const float* bias;
    __device__ __forceinline__ void operator()(const f32x4 (&acc)[2][2][4][2], const Unit& u, int wr, int wc, int fr, int fq) const {
        const int row0 = u.pm * BM + wr * 64 + fr, col0 = u.pn * BM + wc * 32 + 4 * fq;
        f32x4 bv[2][2];
#pragma unroll
        for (int bj = 0; bj < 2; ++bj)
#pragma unroll
            for (int n = 0; n < 2; ++n) bv[bj][n] = bias ? *(const f32x4*)(bias + col0 + bj * HALF + n * 16) : (f32x4){0.f, 0.f, 0.f, 0.f};
#pragma unroll
        for (int ai = 0; ai < 2; ++ai)
#pragma unroll
            for (int m = 0; m < 4; ++m) { float* rowp = C + (size_t)(row0 + ai * HALF + m * 16) * ldc + col0;
#pragma unroll
                for (int bj = 0; bj < 2; ++bj)
#pragma unroll
                    for (int n = 0; n < 2; ++n) *(f32x4*)(rowp + bj * HALF + n * 16) = acc[ai][bj][m][n] + bv[bj][n]; }
    }
};
template <class Epi, class Sched, bool ALIGN_EPI = false, bool SP2 = false>
__device__ __forceinline__ void gemm_phase(PG8_LAS unsigned char* lds, const Gemm g, const Sched& S, const Epi& E, const int wave_in) {
    int tid_ = wave_in * 64 + (int)__builtin_amdgcn_mbcnt_hi(~0u, __builtin_amdgcn_mbcnt_lo(~0u, 0u)); asm volatile("" : "+v"(tid_));
    const int tid = tid_, wid = __builtin_amdgcn_readfirstlane(tid >> 6), lane = tid & 63, wr = wid >> 2, wc = wid & 3, fr = lane & 15, fq = lane >> 4;
    const int K = g.K, nt = K / BK;
    unsigned voffA[2], voffB[2];
#pragma unroll
    for (int i = 0; i < 2; ++i) { int R, C; stage_rc(tid * 16 + i * 8192, R, C); const int Rb = Epi::PERM ? ((R & ~31) + perm32(R & 31)) : R;
        voffA[i] = (unsigned)(R * K + C) * 2u; voffB[i] = (unsigned)(Rb * K + C) * 2u; }
    const size_t kstep = (size_t)(BK * 2);
    const size_t hstep = (size_t)HALF * K * 2;
    const size_t tstep = 2 * hstep;
    const unsigned ldsw = (unsigned)wid * 1024u;
    const int aoff = lds_byte(wr * 64 + fr, fq * 8), boff = lds_byte(wc * 32 + fr, fq * 8);
#define PG8_SA(b, h) (((b) * 2 + (h)) * HTB)
#define PG8_SB(b, h) ((4 + (b) * 2 + (h)) * HTB)
#define PG8_STAGE(bufoff, gbase, voff) do { _Pragma("unroll") for (int _i = 0; _i < 2; ++_i) \
        __builtin_amdgcn_global_load_lds((const unsigned*)((const char*)(gbase) + (voff)[_i]), (PG8_LAS unsigned*)(lds + (bufoff) + ldsw + _i * 8192), 16, 0, 0); } while (0)
#define PG8_LDA(dst, b, h) do { _Pragma("unroll") for (int m = 0; m < 4; ++m) _Pragma("unroll") for (int k = 0; k < 2; ++k) dst[m][k] = *(const PG8_LAS bf16x8*)(lds + PG8_SA(b, h) + aoff + m * 2048 + k * 1024); } while (0)
#define PG8_LDB(dst, b, h) do { _Pragma("unroll") for (int n = 0; n < 2; ++n) _Pragma("unroll") for (int k = 0; k < 2; ++k) dst[n][k] = *(const PG8_LAS bf16x8*)(lds + PG8_SB(b, h) + boff + n * 2048 + k * 1024); } while (0)
#define PG8_MMA(ai, bj, At, Bt) do { __builtin_amdgcn_s_setprio(1); _Pragma("unroll") for (int m = 0; m < 4; ++m) _Pragma("unroll") for (int n = 0; n < 2; ++n) _Pragma("unroll") for (int k = 0; k < 2; ++k) \
        acc[ai][bj][m][n] = __builtin_amdgcn_mfma_f32_16x16x32_bf16(Bt[n][k], At[m][k], acc[ai][bj][m][n], 0, 0, 0); __builtin_amdgcn_s_setprio(0); } while (0)
#define PG8_WAIT_V(n) asm volatile("s_waitcnt vmcnt(" #n ")" ::: "memory")
#define PG8_WAIT_L(n) asm volatile("s_waitcnt lgkmcnt(" #n ")" ::: "memory")
#define PG8_BAR __builtin_amdgcn_s_barrier()
#define PG8_SCHED __builtin_amdgcn_sched_barrier(0)
    Unit cur, nxt; int ui = 0;
    if (!S.next(0, cur)) return;
    f32x4 acc[2][2][4][2];
#pragma unroll
    for (int a = 0; a < 2; ++a)
#pragma unroll
        for (int b = 0; b < 2; ++b)
#pragma unroll
            for (int m = 0; m < 4; ++m)
#pragma unroll
                for (int n = 0; n < 2; ++n) acc[a][b][m][n] = (f32x4){0.f, 0.f, 0.f, 0.f};
    bf16x8 At[4][2], B0[2][2], B1[2][2];
    const char* cA = (const char*)g.A + (size_t)cur.pm * tstep; const char* cB = (const char*)g.Bt + (size_t)cur.pn * tstep;
    int cnt = nt;
    if constexpr (Sched::SPLITK) { cnt = S.ktiles(cur, nt); cA += S.kbyte(cur, nt); cB = (const char*)g.Bt + (size_t)S.btile(cur) * tstep + S.kbyte(cur, nt); }
    S.a_ready(cur);
    if constexpr (SP2) {
        PG8_STAGE(PG8_SB(0, 0), cB, voffB); PG8_STAGE(PG8_SB(0, 1), cB + hstep, voffB); PG8_STAGE(PG8_SA(0, 0), cA, voffA); PG8_STAGE(PG8_SA(0, 1), cA + hstep, voffA);
        if (wr == 1) PG8_BAR;
        PG8_WAIT_V(2); PG8_BAR;
        PG8_STAGE(PG8_SB(1, 0), cB + kstep, voffB); PG8_STAGE(PG8_SA(1, 0), cA + kstep, voffA); PG8_STAGE(PG8_SB(1, 1), cB + hstep + kstep, voffB);
        PG8_WAIT_V(6); PG8_BAR;
    } else {
        PG8_STAGE(PG8_SB(0, 0), cB, voffB); PG8_STAGE(PG8_SA(0, 0), cA, voffA); PG8_STAGE(PG8_SB(0, 1), cB + hstep, voffB); PG8_STAGE(PG8_SA(0, 1), cA + hstep, voffA);
        if (wr == 1) PG8_BAR;
        PG8_WAIT_V(4); PG8_BAR;
        PG8_STAGE(PG8_SB(1, 0), cB + kstep, voffB); PG8_STAGE(PG8_SA(1, 0), cA + kstep, voffA); PG8_STAGE(PG8_SB(1, 1), cB + hstep + kstep, voffB);
        PG8_WAIT_V(6); PG8_BAR;
    }
    for (;;) {
        const bool has_next = S.next(ui + 1, nxt);
        const char* nA = has_next ? (const char*)g.A + (size_t)nxt.pm * tstep : cA; const char* nB = has_next ? (const char*)g.Bt + (size_t)nxt.pn * tstep : cB;
        if constexpr (Sched::SPLITK) { if (has_next) { nA += S.kbyte(nxt, nt); nB = (const char*)g.Bt + (size_t)S.btile(nxt) * tstep + S.kbyte(nxt, nt); } }
        for (int t = 0; t < cnt; t += 2) {
            const bool last = (t == cnt - 2);
            const char* a1 = cA + (size_t)(t + 1) * kstep;
            const char* a2 = last ? nA : cA + (size_t)(t + 2) * kstep; const char* b2 = last ? nB : cB + (size_t)(t + 2) * kstep;
            const char* a3 = a2 + kstep; const char* b3 = b2 + kstep;
            if (last && has_next) S.a_ready(nxt);
            if constexpr (SP2) {
            PG8_LDB(B0, 0, 0); PG8_LDB(B1, 0, 1); PG8_SCHED; PG8_LDA(At, 0, 0); PG8_STAGE(PG8_SA(1, 1), a1 + hstep, voffA);
            PG8_WAIT_V(8); PG8_WAIT_L(0); PG8_BAR; PG8_MMA(0, 0, At, B0); PG8_MMA(0, 1, At, B1); PG8_BAR; PG8_SCHED;
            PG8_LDA(At, 0, 1); PG8_STAGE(PG8_SB(0, 0), b2, voffB); PG8_STAGE(PG8_SB(0, 1), b2 + hstep, voffB); PG8_STAGE(PG8_SA(0, 0), a2, voffA);
            PG8_WAIT_V(8); PG8_WAIT_L(0); PG8_BAR; PG8_MMA(1, 0, At, B0); PG8_MMA(1, 1, At, B1); PG8_BAR; PG8_SCHED;
            PG8_LDB(B0, 1, 0); PG8_LDB(B1, 1, 1); PG8_SCHED; PG8_LDA(At, 1, 0); PG8_STAGE(PG8_SA(0, 1), a2 + hstep, voffA);
            PG8_WAIT_V(8); PG8_WAIT_L(0); PG8_BAR; PG8_MMA(0, 0, At, B0); PG8_MMA(0, 1, At, B1); PG8_BAR; PG8_SCHED;
            PG8_LDA(At, 1, 1); PG8_STAGE(PG8_SB(1, 0), b3, voffB); PG8_STAGE(PG8_SB(1, 1), b3 + hstep, voffB); PG8_STAGE(PG8_SA(1, 0), a3, voffA);
            PG8_WAIT_V(8); PG8_WAIT_L(0); PG8_BAR; PG8_MMA(1, 0, At, B0); PG8_MMA(1, 1, At, B1); PG8_BAR; PG8_SCHED;
            } else {
            PG8_LDB(B0, 0, 0); PG8_SCHED; PG8_LDA(At, 0, 0); PG8_STAGE(PG8_SA(1, 1), a1 + hstep, voffA);
            PG8_WAIT_L(8); PG8_BAR; PG8_WAIT_L(0); PG8_MMA(0, 0, At, B0); PG8_BAR; PG8_SCHED;
            PG8_LDB(B1, 0, 1); PG8_STAGE(PG8_SB(0, 0), b2, voffB);
            PG8_BAR; PG8_WAIT_L(0); PG8_MMA(0, 1, At, B1); PG8_BAR;
            PG8_LDA(At, 0, 1); PG8_STAGE(PG8_SA(0, 0), a2, voffA);
            PG8_BAR; PG8_WAIT_L(0); PG8_MMA(1, 0, At, B0); PG8_BAR; PG8_SCHED;
            PG8_STAGE(PG8_SB(0, 1), b2 + hstep, voffB);
            PG8_WAIT_V(6); PG8_BAR; PG8_MMA(1, 1, At, B1); PG8_BAR;
            PG8_LDB(B0, 1, 0); PG8_SCHED; PG8_LDA(At, 1, 0); PG8_STAGE(PG8_SA(0, 1), a2 + hstep, voffA);
            PG8_WAIT_L(8); PG8_BAR; PG8_WAIT_L(0); PG8_MMA(0, 0, At, B0); PG8_BAR; PG8_SCHED;
            PG8_LDB(B1, 1, 1); PG8_STAGE(PG8_SB(1, 0), b3, voffB);
            PG8_BAR; PG8_WAIT_L(0); PG8_MMA(0, 1, At, B1); PG8_BAR;
            PG8_LDA(At, 1, 1); PG8_STAGE(PG8_SA(1, 0), a3, voffA);
            PG8_BAR; PG8_WAIT_L(0); PG8_MMA(1, 0, At, B0); PG8_BAR; PG8_SCHED;
            PG8_STAGE(PG8_SB(1, 1), b3 + hstep, voffB);
            PG8_WAIT_V(6); PG8_BAR; PG8_MMA(1, 1, At, B1); PG8_BAR;
            }
        }
        if constexpr (ALIGN_EPI) { if (wr == 0) PG8_BAR; }
        if constexpr (!Epi::AFTER_DRAIN) { E(acc, cur, wr, wc, fr, fq); S.done(cur); }
        if (!has_next) break;
#pragma unroll
        for (int a = 0; a < 2; ++a)
#pragma unroll
            for (int b = 0; b < 2; ++b)
#pragma unroll
                for (int m = 0; m < 4; ++m)
#pragma unroll
                    for (int n = 0; n < 2; ++n) acc[a][b][m][n] = (f32x4){0.f, 0.f, 0.f, 0.f};
        cur = nxt; cA = nA; cB = nB; ++ui;
        if constexpr (Sched::SPLITK) cnt = S.ktiles(cur, nt);
        if constexpr (ALIGN_EPI) { if (wr == 1) PG8_BAR; }
    }
    PG8_WAIT_V(0);
    S.flush();
    if constexpr (!ALIGN_EPI) { if (wr == 0) PG8_BAR; }
    PG8_BAR;
    if constexpr (Epi::AFTER_DRAIN) { E.fused(acc, cur, wr, wc, fr, fq, lds, wid, lane); S.done(cur); }
#undef PG8_SA
#undef PG8_SB
#undef PG8_STAGE
#undef PG8_LDA
#undef PG8_LDB
#undef PG8_MMA
#undef PG8_WAIT_V
#undef PG8_WAIT_L
#undef PG8_BAR
#undef PG8_SCHED
}
}

namespace pg8 {
struct EpiSwiglu {
    static constexpr bool PERM = true, AFTER_DRAIN = false;
    bf16_t* O; int ldo; int p0; int nct;
    __device__ __forceinline__ void operator()(const f32x4 (&acc)[2][2][4][2], const Unit& u, int wr, int wc, int fr, int fq) const {
        const int row0 = (u.pm - p0) * BM + wr * 64 + fr, col0 = (u.pn % nct) * HALF + wc * 32 + 8 * fq;
#pragma unroll
        for (int ai = 0; ai < 2; ++ai)
#pragma unroll
            for (int m = 0; m < 4; ++m) { bf16_t* rowp = O + (size_t)(row0 + ai * HALF + m * 16) * ldo + col0;
                float a[8];
#pragma unroll
                for (int n = 0; n < 2; ++n)
#pragma unroll
                    for (int j = 0; j < 4; ++j) { const float g = acc[ai][0][m][n][j], up = acc[ai][1][m][n][j]; a[n * 4 + j] = g * __builtin_amdgcn_rcpf(1.0f + __expf(-g)) * up; }
                u32x4 w; w.x = cvt_pk_bf16(a[0], a[1]); w.y = cvt_pk_bf16(a[2], a[3]); w.z = cvt_pk_bf16(a[4], a[5]); w.w = cvt_pk_bf16(a[6], a[7]);
                *(u32x4*)rowp = w; }
    }
};
struct EpiBf16Mod {
    static constexpr bool PERM = true, AFTER_DRAIN = false;
    bf16_t* O; int ldc; int nct;
    __device__ __forceinline__ void operator()(const f32x4 (&acc)[2][2][4][2], const Unit& u, int wr, int wc, int fr, int fq) const {
        const int row0 = u.pm * BM + wr * 64 + fr, col0 = (u.pn % nct) * BM + wc * 32 + 8 * fq;
#pragma unroll
        for (int ai = 0; ai < 2; ++ai)
#pragma unroll
            for (int m = 0; m < 4; ++m) { bf16_t* rowp = O + (size_t)(row0 + ai * HALF + m * 16) * ldc + col0;
#pragma unroll
                for (int bj = 0; bj < 2; ++bj) { const f32x4 v0 = acc[ai][bj][m][0], v1 = acc[ai][bj][m][1];
                    u32x4 w; w.x = cvt_pk_bf16(v0[0], v0[1]); w.y = cvt_pk_bf16(v0[2], v0[3]); w.z = cvt_pk_bf16(v1[0], v1[1]); w.w = cvt_pk_bf16(v1[2], v1[3]);
                    *(u32x4*)(rowp + bj * HALF) = w; } }
    }
};
struct MoeOrder {
    static constexpr bool SPLITK = false;
    int p0, np, nct, G, c; int pb[9];
    __device__ __forceinline__ bool next(int i, Unit& u) const {
        const int L = i * G + c; if (L >= np * nct) return false;
        const int nig = WGM * nct, gid = L / nig, fm = gid * WGM, gsz = (np - fm) < WGM ? (np - fm) : WGM, r = L % nig;
        const int pm = p0 + fm + (r % gsz), ct = r / gsz;
        int e = 0;
#pragma unroll
        for (int j = 1; j < 8; ++j) e += (pm >= pb[j]) ? 1 : 0;
        u.pm = pm; u.pn = e * nct + ct; return true;
    }
    __device__ __forceinline__ void a_ready(const Unit&) const {}
    __device__ __forceinline__ void done(const Unit&) const {}
    __device__ __forceinline__ void flush() const {}
};
#ifndef WT_AUX
#define WT_AUX 16
#endif
struct EpiBf16WT {
    static constexpr bool PERM = true, AFTER_DRAIN = false;
    bf16_t* O; int ldc; int nct;
    __device__ __forceinline__ void operator()(const f32x4 (&acc)[2][2][4][2], const Unit& u, int wr, int wc, int fr, int fq) const {
        const __amdgpu_buffer_rsrc_t rs = __builtin_amdgcn_make_buffer_rsrc(O, 0, 0x7ffffff0, 0x00020000);
        const unsigned row0 = (unsigned)(u.pm * BM + wr * 64 + fr), col0 = (unsigned)((u.pn % nct) * BM + wc * 32 + 8 * fq);
#pragma unroll
        for (int ai = 0; ai < 2; ++ai)
#pragma unroll
            for (int m = 0; m < 4; ++m) { const unsigned off = ((row0 + (unsigned)(ai * HALF + m * 16)) * (unsigned)ldc + col0) * 2u;
#pragma unroll
                for (int bj = 0; bj < 2; ++bj) { const f32x4 v0 = acc[ai][bj][m][0], v1 = acc[ai][bj][m][1];
                    u32x4 w; w.x = cvt_pk_bf16(v0[0], v0[1]); w.y = cvt_pk_bf16(v0[2], v0[3]); w.z = cvt_pk_bf16(v1[0], v1[1]); w.w = cvt_pk_bf16(v1[2], v1[3]);
                    __builtin_amdgcn_raw_buffer_store_b128(w, rs, off + (unsigned)(bj * HALF * 2), 0, WT_AUX); } }
    }
};
constexpr int SPLIT_FLAG = 1 << 14;
struct SplitOrder {
    static constexpr bool SPLITK = true;
    int p0, np, nct, G, c; int pb[9];
    int nfull, S;
    __device__ __forceinline__ void init_split(int S_) { const int nu = np * nct, R = nu / G, T = nu - R * G; if (S_ > 1 && R >= 1 && T > 0 && T * S_ <= G && (T % nct) == 0) { nfull = R * G; S = S_; } else { nfull = nu; S = 1; } }
    __device__ __forceinline__ int tail_panels() const { return (np * nct - nfull) / nct; }
    __device__ __forceinline__ bool next(int i, Unit& u) const {
        const int L = i * G + c; int pm, ct, ks = -1;
        if (L < nfull) { const int nig = WGM * nct, gid = L / nig, fm = gid * WGM, gsz = (np - fm) < WGM ? (np - fm) : WGM, r = L % nig; pm = p0 + fm + (r % gsz); ct = r / gsz; }
        else { if (S == 1) return false; const int j = L - nfull, tp = tail_panels(); if (j >= tp * nct * S) return false; const int rest = j / tp; pm = p0 + nfull / nct + (j % tp); ct = rest % nct; ks = rest / nct; }
        int e = 0;
#pragma unroll
        for (int j = 1; j < 8; ++j) e += (pm >= pb[j]) ? 1 : 0;
        u.pm = pm; u.pn = ks < 0 ? (e * nct + ct) : (SPLIT_FLAG | (ks << 6) | (e * nct + ct)); return true;
    }
    __device__ __forceinline__ int ktiles(const Unit& u, int nt) const { if (!(u.pn & SPLIT_FLAG)) return nt; const int ks = (u.pn >> 6) & 15, pairs = nt >> 1, q = pairs / S, r = pairs - q * S; return 2 * (q + (ks < r ? 1 : 0)); }
    __device__ __forceinline__ size_t kbyte(const Unit& u, int nt) const { if (!(u.pn & SPLIT_FLAG)) return 0; const int ks = (u.pn >> 6) & 15, pairs = nt >> 1, q = pairs / S, r = pairs - q * S; return (size_t)(ks * q + (ks < r ? ks : r)) * (2 * BK * 2); }
    __device__ __forceinline__ int btile(const Unit& u) const { return u.pn & 63; }
    __device__ __forceinline__ void a_ready(const Unit&) const {}
    __device__ __forceinline__ void done(const Unit&) const {}
    __device__ __forceinline__ void flush() const {}
};
struct EpiSplitWT {
    static constexpr bool PERM = true, AFTER_DRAIN = false;
    bf16_t* O; int ldc; int nct; float* part; int ptail0; int tail_rows;
    __device__ __forceinline__ void operator()(const f32x4 (&acc)[2][2][4][2], const Unit& u, int wr, int wc, int fr, int fq) const {
        const unsigned col0 = (unsigned)(((u.pn & 63) % nct) * BM + wc * 32 + 8 * fq);
        if (!(u.pn & SPLIT_FLAG)) {
            const __amdgpu_buffer_rsrc_t rs = __builtin_amdgcn_make_buffer_rsrc(O, 0, 0x7ffffff0, 0x00020000);
            const unsigned row0 = (unsigned)(u.pm * BM + wr * 64 + fr);
#pragma unroll
            for (int ai = 0; ai < 2; ++ai)
#pragma unroll
                for (int m = 0; m < 4; ++m) { const unsigned off = ((row0 + (unsigned)(ai * HALF + m * 16)) * (unsigned)ldc + col0) * 2u;
#pragma unroll
                    for (int bj = 0; bj < 2; ++bj) { const f32x4 v0 = acc[ai][bj][m][0], v1 = acc[ai][bj][m][1];
                        u32x4 w; w.x = cvt_pk_bf16(v0[0], v0[1]); w.y = cvt_pk_bf16(v0[2], v0[3]); w.z = cvt_pk_bf16(v1[0], v1[1]); w.w = cvt_pk_bf16(v1[2], v1[3]);
                        __builtin_amdgcn_raw_buffer_store_b128(w, rs, off + (unsigned)(bj * HALF * 2), 0, WT_AUX); } }
        } else {
            const __amdgpu_buffer_rsrc_t rs = __builtin_amdgcn_make_buffer_rsrc(part, 0, 0x7ffffff0, 0x00020000);
            const unsigned row0 = (unsigned)(((u.pn >> 6) & 15) * tail_rows + (u.pm - ptail0) * BM + wr * 64 + fr);
#pragma unroll
            for (int ai = 0; ai < 2; ++ai)
#pragma unroll
                for (int m = 0; m < 4; ++m) { const unsigned off = ((row0 + (unsigned)(ai * HALF + m * 16)) * (unsigned)ldc + col0) * 4u;
#pragma unroll
                    for (int bj = 0; bj < 2; ++bj) {
                        __builtin_amdgcn_raw_buffer_store_b128(__builtin_bit_cast(u32x4, acc[ai][bj][m][0]), rs, off + (unsigned)(bj * HALF * 4), 0, WT_AUX);
                        __builtin_amdgcn_raw_buffer_store_b128(__builtin_bit_cast(u32x4, acc[ai][bj][m][1]), rs, off + (unsigned)(bj * HALF * 4 + 16), 0, WT_AUX); } }
        }
    }
};
template <class Base> struct PubOrder : Base {
    unsigned* cntr; mutable int pend;
    __device__ __forceinline__ void pub() const {
        if (pend >= 0) { if (__builtin_amdgcn_mbcnt_hi(~0u, __builtin_amdgcn_mbcnt_lo(~0u, 0u)) == 0u) __hip_atomic_fetch_add(cntr + 16 * pend, 1u, __ATOMIC_RELAXED, __HIP_MEMORY_SCOPE_AGENT); pend = -1; }
    }
    __device__ __forceinline__ void a_ready(const Unit& u) const { Base::a_ready(u); pub(); }
    __device__ __forceinline__ void done(const Unit& u) const {
#ifdef PUB_EAGER
        asm volatile("s_waitcnt vmcnt(0)" ::: "memory"); pend = u.pm; pub();
#else
        pub(); pend = u.pm;
#endif
    }
    __device__ __forceinline__ void flush() const { pub(); }
};
}

constexpr int NWAVES = 8, NTHR = 512;
constexpr int D = 1024, NB = 8, SEQ = 4096, LC = 256, NT = NB * SEQ, NC = NB * LC, MT = NT + NC;
constexpr int DIN = 2944, NZ = 3072;
constexpr int C_K = 0, C_V = 512, C_WLO = 1024, C_ALO = 1152, C_R = 1280, C_GLO = 1792, C_U = 1920, C_GB = 2176, C_GC = 2432, C_F = 2688;
constexpr int DFF = 2816, NE = 8, DFE = 3584;
constexpr float NORM_EPS = 1e-6f, GN_EPS = 64e-5f;
constexpr int TP = 72;
enum { I_X = 0, I_C, I_CTX, I_CCTX, I_ADAW, I_ADAB, I_NORMG, I_WIN, I_WOUT, I_MU, I_MUW, I_MUA, I_W0, I_W2, I_A0, I_A2, I_G2, I_KK, I_KA, I_RK, I_GNW, I_GNB, I_CONVW,
       I_FG, I_FU, I_FD, I_RW, I_RB, I_MG, I_MUP, I_MD, N_IN };

constexpr size_t KiB = 1024, MiB = 1u << 20;
constexpr size_t WS_CTL = 0, CTL_ZERO_BYTES = 512 * KiB;
constexpr size_t WS_MOD = 512 * KiB;
constexpr size_t WS_TAB = 960 * KiB;
constexpr size_t TAB_E = WS_TAB;
constexpr size_t TAB_TWC = TAB_E + 64 * 512 * 4;
constexpr size_t TAB_TWS = TAB_TWC + 4096 * 4;
constexpr size_t TAB_C64 = TAB_TWS + 4096 * 4;
constexpr size_t TAB_S64 = TAB_C64 + 64 * 64 * 2;
constexpr size_t TAB_SN64 = TAB_S64 + 64 * 64 * 2;
constexpr size_t WS_ROUTE = 1152 * KiB;
constexpr size_t WS_TOKPOS = WS_ROUTE + (size_t)NT * 16;
static_assert(TAB_SN64 + 64 * 64 * 2 <= WS_ROUTE && WS_TOKPOS + (size_t)NT * 8 <= 2 * MiB, "low ws map");
constexpr size_t WS_Z = 2 * MiB;
constexpr size_t WS_SW = 206 * MiB;
constexpr size_t WS_WIN = WS_SW;
constexpr size_t WS_WOUT = WS_WIN + 2ull * NZ * D * 2;
constexpr size_t WS_WGU = WS_WOUT + 2ull * D * D * 2;
constexpr size_t WS_WDN = WS_WGU + 2ull * DFF * D * 2;
constexpr size_t WS_G2T = WS_WDN + (size_t)D * DFF * 2;
constexpr size_t WS_C256 = WS_G2T + 2ull * 512 * 128 * 2;
constexpr size_t WS_SN256 = WS_C256 + 256 * 256 * 2;
constexpr size_t WS_W2TG = WS_SN256 + 256 * 256 * 2;
constexpr size_t WS_A2TG = WS_W2TG + 4ull * 512 * 64 * 2;
constexpr size_t WS_XC = 244 * MiB;
static_assert(WS_A2TG + 4ull * 512 * 64 * 2 <= WS_XC, "small weights");
constexpr size_t WS_RING = 252 * MiB;
constexpr size_t WS_O32 = 381 * MiB;
constexpr size_t WS_YS = WS_O32;
constexpr size_t WS_YBUF = WS_YS + 2ull * MT * 512 * 2;
constexpr size_t WS_PARTD = WS_YBUF;
constexpr size_t WS_BONG = WS_YBUF + 32 * MiB;
constexpr size_t WS_H = 517 * MiB;
static_assert(WS_BONG + 2ull * MT * 8 * 4 <= WS_H && WS_Z + (size_t)MT * NZ * 2 <= WS_SW && WS_O32 + (size_t)MT * D * 4 <= WS_H, "ws map");
constexpr size_t WS_NEED = 585 * MiB;
static_assert(WS_H + (size_t)MT * D * 2 <= WS_NEED, "ws map end");
constexpr size_t WS_WMGU = 2 * MiB;
constexpr size_t WS_WMDN = WS_WMGU + 8ull * 2 * DFE * D * 2;
constexpr size_t WS_XG = 170 * MiB;
constexpr int XG_ROWS_CAP = 69632;
constexpr size_t WS_ACTM = 306 * MiB;
static_assert(WS_WMDN + 8ull * D * DFE * 2 <= WS_XG && WS_XG + (size_t)XG_ROWS_CAP * D * 2 <= WS_ACTM, "moe ws map");
constexpr int CW_TMO = 0;
constexpr int CW_CNT = 2048, CW_FILL = 3072;
constexpr int CW_BAR = 8192;
constexpr int MAX_LAUNCHES = 20;
constexpr int CW_PROD = 81920, CW_CONS = 81920 + 8192;
constexpr int CW_PCNT = 114688;
constexpr int PC_WOUT0 = 0, PC_DOWN0 = 2176, PC_WOUT1 = 4352, PC_MOE = 6528;
static_assert(CW_CONS + 16384 + 64 * 128 <= CW_PCNT && (CW_PCNT + PC_MOE + 16 * 272) * 4 <= (int)CTL_ZERO_BYTES, "control words");

constexpr int LDS_BYTES = 163840;
constexpr int MISC_OFF = LDS_BYTES - 256;

#define GAS __attribute__((address_space(1)))
#define LAS __attribute__((address_space(3)))
typedef unsigned short bf16;
typedef unsigned v4u __attribute__((ext_vector_type(4)));
typedef unsigned v2u __attribute__((ext_vector_type(2)));
typedef float f32x4 __attribute__((ext_vector_type(4)));
typedef float f32x2 __attribute__((ext_vector_type(2)));
typedef short bf16x8 __attribute__((ext_vector_type(8)));
typedef short bf16x4 __attribute__((ext_vector_type(4)));
#define LDS_WAIT() asm volatile("s_waitcnt lgkmcnt(0)" ::: "memory")
typedef __bf16 bf16x2n __attribute__((ext_vector_type(2)));
__device__ __forceinline__ unsigned pk2(float lo, float hi) { const f32x2 v = {lo, hi}; return __builtin_bit_cast(unsigned, __builtin_convertvector(v, bf16x2n)); }
__device__ __forceinline__ unsigned f2bf(float f) { return pk2(f, f) & 0xffffu; }
__device__ __forceinline__ float bflo(unsigned w) { return __builtin_bit_cast(float, w << 16); }
__device__ __forceinline__ float bfhi(unsigned w) { return __builtin_bit_cast(float, w & 0xffff0000u); }
__device__ __forceinline__ float bf1(bf16 b) { return __builtin_bit_cast(float, (unsigned)b << 16); }
template <int CTRL> __device__ __forceinline__ float dpp_mov(float v) { return __builtin_bit_cast(float, __builtin_amdgcn_update_dpp(0, __builtin_bit_cast(int, v), CTRL, 0xf, 0xf, true)); }
__device__ __forceinline__ float wave_sum(float v) {
    v += dpp_mov<0xB1>(v); v += dpp_mov<0x4E>(v); v += dpp_mov<0x141>(v); v += dpp_mov<0x140>(v);
    const int b = __builtin_bit_cast(int, v);
    const float s0 = __builtin_bit_cast(float, __builtin_amdgcn_readlane(b, 0)), s1 = __builtin_bit_cast(float, __builtin_amdgcn_readlane(b, 16));
    const float s2 = __builtin_bit_cast(float, __builtin_amdgcn_readlane(b, 32)), s3 = __builtin_bit_cast(float, __builtin_amdgcn_readlane(b, 48));
    return (s0 + s1) + (s2 + s3);
}
__device__ __forceinline__ float sigmoidf_(float x) { return __builtin_amdgcn_rcpf(1.0f + __expf(-x)); }
#define MFMA16(a, b, c) __builtin_amdgcn_mfma_f32_16x16x32_bf16((a), (b), (c), 0, 0, 0)
#define XB_TMO      128
#define XB_XCNT(j)  (256  + 64 * (j))
#define XB_XSUB(j)  (1280 + 64 * (j))
#define XB_XGEN(j)  (2304 + 64 * (j))
#define XB_TOP      3328
#define XB_TOPGEN   3392
#define XCD_BAR_WORDS 3456
#define XB_SPIN_CAP (1u << 18)
#define LAS __attribute__((address_space(3)))

__device__ __forceinline__ unsigned xb_ld(unsigned* p)              { return __hip_atomic_load(p, __ATOMIC_RELAXED, __HIP_MEMORY_SCOPE_AGENT); }
__device__ __forceinline__ unsigned xb_add(unsigned* p, unsigned v) { return __hip_atomic_fetch_add(p, v, __ATOMIC_RELAXED, __HIP_MEMORY_SCOPE_AGENT); }
__device__ __forceinline__ unsigned xb_xcc_id() { return (unsigned)__builtin_amdgcn_s_getreg((3 << 11) | 20) & 0xFu; }
#define XB_SPIN(cond, bar) do { unsigned _sp = 0; while (cond) { __builtin_amdgcn_s_sleep(1); \
    if ((++_sp & 255u) == 0u) { if (xb_ld(&(bar)[XB_TMO])) break; if (_sp > XB_SPIN_CAP) { atomicAdd(&(bar)[XB_TMO], 1u); break; } } } } while (0)

struct XcdBarrier {
    unsigned w0;
    unsigned* bar; unsigned x;
    volatile LAS unsigned* st;
};

__device__ __forceinline__ bool xb_lane0() { return __builtin_amdgcn_mbcnt_hi(~0u, __builtin_amdgcn_mbcnt_lo(~0u, 0u)) == 0u; }
__device__ __forceinline__ XcdBarrier xcd_barrier_post(unsigned* bar, volatile LAS unsigned* st, unsigned w0) {
    XcdBarrier b; b.w0 = w0; b.bar = bar; b.x = xb_xcc_id(); b.st = st;
    if (w0 && xb_lane0()) (void)xb_add(&bar[XB_XCNT(b.x)], 1u);
    return b;
}
__device__ __forceinline__ void xcd_barrier_complete(unsigned* bar, unsigned x, unsigned& nloc, unsigned& nx) {
    const unsigned G = gridDim.x * gridDim.y * gridDim.z;
    unsigned sum, cnt, mine, sp = 0u;
    for (;;) {
        sum = 0u; cnt = 0u; mine = 0u;
#pragma unroll
        for (unsigned j = 0; j < 16; ++j) { const unsigned c = xb_ld(&bar[XB_XCNT(j)]); sum += c; cnt += (c > 0u) ? 1u : 0u; mine = (j == x) ? c : mine; }
        if (sum == G) break;
        __builtin_amdgcn_s_sleep(1);
        if ((++sp & 255u) == 0u) { if (xb_ld(&bar[XB_TMO])) break; if (sp > XB_SPIN_CAP) { atomicAdd(&bar[XB_TMO], 1u); break; } }
    }
    nloc = mine > 0u ? mine : 1u; nx = cnt > 0u ? cnt : 1u;
}

__device__ __forceinline__ void xcd_barrier(const XcdBarrier& b) {
    asm volatile("s_waitcnt vmcnt(0)" ::: "memory");
    __syncthreads();
    if (b.w0 && xb_lane0()) {
        unsigned* bar = b.bar;
        __builtin_amdgcn_s_waitcnt(0);
        unsigned nloc = b.st[0], nx = b.st[1];
        if (nloc == 0u) { xcd_barrier_complete(bar, b.x, nloc, nx); b.st[0] = nloc; b.st[1] = nx; }
        const unsigned old = xb_add(&bar[XB_XSUB(b.x)], 1u);
        const unsigned gen = old / nloc;
        if (old + 1u == (gen + 1u) * nloc) {
            __builtin_amdgcn_fence(__ATOMIC_RELEASE, "agent");
            asm volatile("s_waitcnt vmcnt(0)" ::: "memory");
            const unsigned og = xb_add(&bar[XB_TOP], 1u);
            const unsigned tg = og / nx;
            if (og + 1u == (tg + 1u) * nx) xb_add(&bar[XB_TOPGEN], 1u);
            else XB_SPIN(xb_ld(&bar[XB_TOPGEN]) == tg, bar);
            __builtin_amdgcn_fence(__ATOMIC_ACQUIRE, "agent");
            xb_add(&bar[XB_XGEN(b.x)], 1u);
            asm volatile("s_waitcnt vmcnt(0)" ::: "memory");
        } else {
            XB_SPIN(xb_ld(&bar[XB_XGEN(b.x)]) == gen, bar);
            __builtin_amdgcn_fence(__ATOMIC_ACQUIRE, "agent");
            asm volatile("s_waitcnt vmcnt(0)" ::: "memory");
        }
    }
    __syncthreads();
}


struct Params {
    const float* in[N_IN];
    float* out;
    unsigned char* ws;
    int act_cap_panels;
    int ph_lo, ph_hi, li;
};
static_assert(sizeof(Params) == N_IN * 8 + 8 + 8 + 16, "Params has no padding");

struct Frame {
    LAS unsigned char* lds;
    int tid, lane, wave, G, bx;
};
#define WSP(T, off) ((T*)(P.ws + (off)))

__device__ __forceinline__ void transpose_item(const float* W, int N, bf16* WT, int ldk, int k0, int n0, int out_row0, LAS float* scr, int lane) {
#pragma unroll 8
    for (int i = 0; i < 32; ++i) { const int kk = 2 * i + (lane >> 5); scr[kk * 33 + (lane & 31)] = W[(size_t)(k0 + kk) * N + n0 + (lane & 31)]; }
    LDS_WAIT(); asm volatile("" ::: "memory");
    const int c = lane & 7;
#pragma unroll
    for (int j = 0; j < 4; ++j) { const int n = (lane >> 3) + 8 * j; const LAS float* s = scr + (8 * c) * 33 + n;
        v4u o; o.x = pk2(s[0 * 33], s[1 * 33]); o.y = pk2(s[2 * 33], s[3 * 33]); o.z = pk2(s[4 * 33], s[5 * 33]); o.w = pk2(s[6 * 33], s[7 * 33]);
        *(v4u*)(WT + (size_t)(out_row0 + n) * ldk + k0 + 8 * c) = o; }
    LDS_WAIT(); asm volatile("" ::: "memory");
}
__device__ __forceinline__ int gu_row(int n, int up) { return (n >> 7) * 256 + up * 128 + (n & 127); }

__device__ __forceinline__ void p0_small_weights(const Params& P, const Frame& F) {
    LAS float* scr = (LAS float*)(F.lds + F.wave * 16384);
    const int gw = F.bx * NWAVES + F.wave, NGW = F.G * NWAVES;
    constexpr int I_IN = 16 * 92, I_OUT = 16 * 32, I_GU = 16 * 88, I_DN = 44 * 32, I_GT = 2 * 16, I_LR = 16;
    constexpr int NITEMS = 2 * I_IN + 2 * I_OUT + 2 * I_GU + I_DN + 2 * I_GT + 8 * I_LR;
    for (int it = gw; it < NITEMS; it += NGW) {
        int r = it;
        if (r < 2 * I_IN) { const int l = r / I_IN; r %= I_IN; const int kb = r / 92, nb = r % 92;
            transpose_item(P.in[I_WIN] + (size_t)l * D * DIN, DIN, WSP(bf16, WS_WIN) + (size_t)l * NZ * D, D, 64 * kb, 32 * nb, 32 * nb, scr, F.lane); continue; } r -= 2 * I_IN;
        if (r < 2 * I_OUT) { const int l = r / I_OUT; r %= I_OUT; const int kb = r / 32, nb = r % 32;
            transpose_item(P.in[I_WOUT] + (size_t)l * D * D, D, WSP(bf16, WS_WOUT) + (size_t)l * D * D, D, 64 * kb, 32 * nb, 32 * nb, scr, F.lane); continue; } r -= 2 * I_OUT;
        if (r < 2 * I_GU) { const int up = r / I_GU; r %= I_GU; const int kb = r / 88, nb = r % 88;
            transpose_item(P.in[up ? I_FU : I_FG], DFF, WSP(bf16, WS_WGU), D, 64 * kb, 32 * nb, gu_row(32 * nb, up), scr, F.lane); continue; } r -= 2 * I_GU;
        if (r < I_DN) { const int kb = r / 32, nb = r % 32;
            transpose_item(P.in[I_FD], D, WSP(bf16, WS_WDN), DFF, 64 * kb, 32 * nb, 32 * nb, scr, F.lane); continue; } r -= I_DN;
        if (r < 2 * I_GT) { const int l = r / I_GT; r %= I_GT; const int kb = r / 16, nb = r % 16;
            transpose_item(P.in[I_G2] + (size_t)l * 128 * 512, 512, WSP(bf16, WS_G2T) + (size_t)l * 512 * 128, 128, 64 * kb, 32 * nb, 32 * nb, scr, F.lane); continue; } r -= 2 * I_GT;
        { const int which = r / (4 * I_LR); r %= 4 * I_LR; const int ldi = r / I_LR, nb = r % I_LR;
            transpose_item(P.in[which ? I_A2 : I_W2] + (size_t)ldi * 64 * 512, 512, WSP(bf16, which ? WS_A2TG : WS_W2TG) + (size_t)ldi * 512 * 64, 64, 0, 32 * nb, 32 * nb, scr, F.lane); }
    }
    { const int gt = F.bx * NTHR + F.tid, NGT = F.G * NTHR; constexpr int NV = 2 * (NZ - DIN) * D / 8;
        for (int i = gt; i < NV; i += NGT) { const int l = i / ((NZ - DIN) * D / 8), r = i % ((NZ - DIN) * D / 8);
            *(v4u*)(WSP(bf16, WS_WIN) + (size_t)l * NZ * D + (size_t)DIN * D + (size_t)r * 8) = (v4u){0u, 0u, 0u, 0u}; } }
}
__device__ __forceinline__ void p0_tables(const Params& P, const Frame& F) {
    const int gt = F.bx * NTHR + F.tid, NGT = F.G * NTHR;
    float* E = WSP(float, TAB_E);
    for (int i = gt; i < 64 * 256; i += NGT) { const int n = i >> 8, q = i & 255;
        const float omega = 1.0f / powf(10000.0f, (float)q / 256.0f), ang = (float)n * omega;
        E[n * 512 + q] = sinf(ang); E[n * 512 + 256 + q] = cosf(ang); }
    float* twc = WSP(float, TAB_TWC); float* tws = WSP(float, TAB_TWS);
    for (int i = gt; i < 4096; i += NGT) { const float a = (float)i / 2048.0f; twc[i] = cospif(a); tws[i] = sinpif(a); }
    bf16* c64 = WSP(bf16, TAB_C64); bf16* s64 = WSP(bf16, TAB_S64); bf16* sn64 = WSP(bf16, TAB_SN64);
    for (int i = gt; i < 64 * 64; i += NGT) { const int m = ((i >> 6) * (i & 63)) & 63; const float a = (float)m / 32.0f; const float c = cospif(a), s = sinpif(a);
        c64[i] = (bf16)f2bf(c); s64[i] = (bf16)f2bf(s); sn64[i] = (bf16)f2bf(-s); }
    bf16* c256 = WSP(bf16, WS_C256); bf16* sn256 = WSP(bf16, WS_SN256);
    for (int i = gt; i < 256 * 256; i += NGT) { const int m = ((i >> 8) * (i & 255)) & 255; const float a = (float)m / 128.0f;
        c256[i] = (bf16)f2bf(cospif(a)); sn256[i] = (bf16)f2bf(-sinpif(a)); }
}
__device__ __forceinline__ void p0_adaln(const Params& P, const Frame& F) {
    LAS float* sc = (LAS float*)F.lds;
    LAS float* red = sc + 9 * 1024;
    for (int u = F.bx; u < 192; u += F.G) {
        const int l = u / 96, cb = u % 96;
        for (int i = F.tid; i < 9 * 1024; i += NTHR) { const int r = i >> 10, d = i & 1023; const float v = r < 8 ? P.in[I_C][r * 1024 + d] : P.in[I_CCTX][d]; sc[i] = v / (1.0f + expf(-v)); }
        __syncthreads();
        const int col = F.tid & 63, ks = F.tid >> 6;
        float acc[9];
#pragma unroll
        for (int r = 0; r < 9; ++r) acc[r] = 0.f;
        const float* w = P.in[I_ADAW] + ((size_t)l * 1024 + ks * 128) * 6144 + cb * 64 + col;
#pragma unroll 2
        for (int k = 0; k < 128; k += 8) {
            float wv[8];
#pragma unroll
            for (int q = 0; q < 8; ++q) wv[q] = w[(size_t)(k + q) * 6144];
#pragma unroll
            for (int r = 0; r < 9; ++r) { const f32x4 s4 = *(const LAS f32x4*)(sc + r * 1024 + ks * 128 + k), s5 = *(const LAS f32x4*)(sc + r * 1024 + ks * 128 + k + 4);
                acc[r] += (s4.x * wv[0] + s4.y * wv[1] + s4.z * wv[2] + s4.w * wv[3]) + (s5.x * wv[4] + s5.y * wv[5] + s5.z * wv[6] + s5.w * wv[7]); }
        }
#pragma unroll
        for (int r = 0; r < 9; ++r) red[(ks * 9 + r) * 64 + col] = acc[r];
        __syncthreads();
        for (int i = F.tid; i < 9 * 64; i += NTHR) { const int r = i >> 6, c = i & 63; float s = 0.f;
#pragma unroll
            for (int k = 0; k < 8; ++k) s += red[(k * 9 + r) * 64 + c];
            WSP(float, WS_MOD)[(size_t)(l * 9 + r) * 6144 + cb * 64 + c] = s + P.in[I_ADAB][l * 6144 + cb * 64 + c]; }
        __syncthreads();
    }
}
__device__ __forceinline__ void convert_moe_weights(const Params& P, const Frame& F) {
    LAS float* scr = (LAS float*)(F.lds + F.wave * 16384);
    const int gw = F.bx * NWAVES + F.wave, NGW = F.G * NWAVES;
    constexpr int I_GU = 16 * 112, I_DN = 56 * 32, NITEMS = NE * (2 * I_GU + I_DN);
    for (int it = gw; it < NITEMS; it += NGW) {
        const int e = it / (2 * I_GU + I_DN); int r = it % (2 * I_GU + I_DN);
        if (r < 2 * I_GU) { const int up = r / I_GU; r %= I_GU; const int kb = r / 112, nb = r % 112;
            transpose_item(P.in[up ? I_MUP : I_MG] + (size_t)e * D * DFE, DFE, WSP(bf16, WS_WMGU) + (size_t)e * 2 * DFE * D, D, 64 * kb, 32 * nb, gu_row(32 * nb, up), scr, F.lane); }
        else { r -= 2 * I_GU; const int kb = r / 32, nb = r % 32;
            transpose_item(P.in[I_MD] + (size_t)e * DFE * D, D, WSP(bf16, WS_WMDN) + (size_t)e * D * DFE, DFE, 64 * kb, 32 * nb, 32 * nb, scr, F.lane); }
    }
}

__device__ __forceinline__ void store_h_row(bf16* hrow, int lane, const f32x4 (&h)[4]) {
#pragma unroll
    for (int j = 0; j < 4; ++j) { v2u w; w.x = pk2(h[j].x, h[j].y); w.y = pk2(h[j].z, h[j].w); *(v2u*)(hrow + 4 * lane + 256 * j) = w; }
}
__device__ __forceinline__ void norm_mod(const f32x4 (&x)[4], int lane, const float* ng, const float* sc, const float* sh, f32x4 (&h)[4]) {
    float ss = 0.f;
#pragma unroll
    for (int j = 0; j < 4; ++j) ss += (x[j].x * x[j].x + x[j].y * x[j].y) + (x[j].z * x[j].z + x[j].w * x[j].w);
    const float rs = rsqrtf(wave_sum(ss) * (1.0f / D) + NORM_EPS);
#pragma unroll
    for (int j = 0; j < 4; ++j) { const int c = 4 * lane + 256 * j; const f32x4 g = *(const f32x4*)(ng + c), s1 = *(const f32x4*)(sc + c), s0 = *(const f32x4*)(sh + c);
        h[j] = (x[j] * rs * g) * (1.0f + s1) + s0; }
}
__device__ __forceinline__ void norm_mod_lds(const f32x4 (&x)[4], int lane, const LAS float* ng, const LAS float* sc, const LAS float* sh, f32x4 (&h)[4]) {
    float ss = 0.f;
#pragma unroll
    for (int j = 0; j < 4; ++j) ss += (x[j].x * x[j].x + x[j].y * x[j].y) + (x[j].z * x[j].z + x[j].w * x[j].w);
    const float rs = rsqrtf(wave_sum(ss) * (1.0f / D) + NORM_EPS);
#pragma unroll
    for (int j = 0; j < 4; ++j) { const int c = 4 * lane + 256 * j; const f32x4 g = *(const LAS f32x4*)(ng + c), s1 = *(const LAS f32x4*)(sc + c), s0 = *(const LAS f32x4*)(sh + c);
        h[j] = (x[j] * rs * g) * (1.0f + s1) + s0; }
}
__device__ __forceinline__ void phase_first_norm(const Params& P, const Frame& F) {
    const int gw = F.bx * NWAVES + F.wave, NGW = F.G * NWAVES, lane = F.lane;
    const float* E = WSP(float, TAB_E); const float* mod = WSP(float, WS_MOD); bf16* H = WSP(bf16, WS_H);
    LAS float* WL = (LAS float*)F.lds; LAS float* WN = WL + 9 * 2 * 1024;
    for (int i = F.tid; i < 9 * 2 * 256; i += NTHR) { const int mr = i >> 9, wh = (i >> 8) & 1, c = (i & 255) * 4; *(LAS f32x4*)(WL + (mr * 2 + wh) * 1024 + c) = *(const f32x4*)(mod + (size_t)mr * 6144 + wh * 1024 + c); }
    for (int i = F.tid; i < 256; i += NTHR) *(LAS f32x4*)(WN + i * 4) = *(const f32x4*)(P.in[I_NORMG] + i * 4);
    __syncthreads();
    f32x4 xn[4], en[4];
    auto fetch = [&](int row) {
        const float* xr = row < NT ? P.in[I_X] + (size_t)row * D : P.in[I_CTX] + (size_t)(row - NT) * D;
#pragma unroll
        for (int j = 0; j < 4; ++j) xn[j] = *(const f32x4*)(xr + 4 * lane + 256 * j);
        if (row < NT) { const int p = row & (SEQ - 1);
#pragma unroll
            for (int j = 0; j < 4; ++j) { const int c = 4 * lane + 256 * j; en[j] = *(const f32x4*)((j < 2) ? (E + (p >> 6) * 512 + c) : (E + (p & 63) * 512 + (c - 512))); } }
    };
    if (gw < MT) fetch(gw);
    for (int row = gw; row < MT; row += NGW) {
        f32x4 x[4];
        const int mr = row < NT ? (row >> 12) : 8;
#pragma unroll
        for (int j = 0; j < 4; ++j) x[j] = row < NT ? xn[j] + en[j] : xn[j];
        if (row + NGW < MT) fetch(row + NGW);
        f32x4 h[4]; norm_mod_lds(x, lane, WN, WL + (mr * 2 + 1) * 1024, WL + (mr * 2) * 1024, h);
        store_h_row(H + (size_t)row * D, lane, h);
    }
    __syncthreads();
}
#ifndef POST_SLEEP
#define POST_SLEEP 4
#endif
#ifdef POST_PLAINLD
__device__ __forceinline__ v2u ld8_agent(const void* p) { return *(const v2u*)p; }
#else
__device__ __forceinline__ v2u ld8_agent(const void* p) { return __builtin_bit_cast(v2u, __hip_atomic_load((const unsigned long long*)p, __ATOMIC_RELAXED, __HIP_MEMORY_SCOPE_AGENT)); }
#endif
template <int MODE, bool NEXT, bool ROUTE, bool FIRST = false>
__device__ __forceinline__ void phase_post(const Params& P, const Frame& F, int nrows, int l, int goff, int ngp_idx, const float* xc_src, int ln, int ngn_idx, int scoff, int shoff,
                                           const unsigned* pcnt, unsigned need, int nbusy, int nexcl, const float* part = nullptr, int srow0 = 0x7fffffff, int S = 1, int tail_rows = 0) {
    const bool busy = F.bx < nbusy; const int lane = F.lane;
    const int gwa = F.bx * NWAVES + F.wave, NGWA = F.G * NWAVES, gwf = (F.bx - nbusy) * NWAVES + F.wave, NGWF = (F.G - nbusy) * NWAVES;
    const int KE = busy ? 0 : (nexcl + NGWF - 1) / NGWF, KS = (nrows - nexcl + NGWA - 1) / NGWA;
    auto rowq = [&](int q) -> int { return q < KE ? (gwf + q * NGWF) : (nexcl + gwa + (q - KE) * NGWA); };
    bf16* H = WSP(bf16, WS_H); const bf16* O32 = WSP(bf16, WS_O32);
    LAS float* WL = (LAS float*)F.lds; LAS float* WN = WL + 9 * 3 * 1024; LAS float* WR = WN + 2 * 1024;
    {
        const float* mod = WSP(float, WS_MOD);
        const float* ngp = P.in[I_NORMG] + (size_t)(l * 4 + ngp_idx) * D;
        const float* ngn = P.in[I_NORMG] + (size_t)(ln * 4 + ngn_idx) * D;
        for (int i = F.tid; i < 9 * 3 * 256; i += NTHR) { const int mr = i / 768, r = i - mr * 768, wh = r >> 8, c = (r & 255) * 4;
            if (wh == 0 || NEXT) { const float* src = wh == 0 ? mod + (size_t)(l * 9 + mr) * 6144 + goff + c : mod + (size_t)(ln * 9 + mr) * 6144 + (wh == 1 ? scoff : shoff) + c;
                *(LAS f32x4*)(WL + (mr * 3 + wh) * 1024 + c) = *(const f32x4*)src; } }
        for (int i = F.tid; i < 2 * 256; i += NTHR) { const int wh = i >> 8, c = (i & 255) * 4; if (wh == 0 || NEXT) *(LAS f32x4*)(WN + wh * 1024 + c) = *(const f32x4*)((wh ? ngn : ngp) + c); }
        if (ROUTE) for (int i = F.tid; i < 8 * 1024; i += NTHR) WR[(i & 7) * 1024 + (i >> 3)] = P.in[I_RW][i];
        __syncthreads();
    }
    int cnt[NE]; float rbias[NE];
#pragma unroll
    for (int e = 0; e < NE; ++e) { cnt[e] = 0; rbias[e] = ROUTE ? P.in[I_RB][e] : 0.f; }
    v2u on0[4], on1[4]; f32x4 xnx[4], enx[4]; float pn0 = 0.f, pn1 = 0.f;
    auto xsrc = [&](int row) -> const float* { return row < NT ? ((FIRST ? P.in[I_X] : (const float*)P.out) + (size_t)row * D) : (xc_src + (size_t)(row - NT) * D); };
    auto ldrow = [&](v2u (&dst)[4], const bf16* orow, int srow) {
        if (srow < 0) {
#pragma unroll
            for (int j = 0; j < 4; ++j) dst[j] = ld8_agent(orow + 4 * lane + 256 * j);
        } else {
            f32x4 a[4];
#pragma unroll
            for (int j = 0; j < 4; ++j) a[j] = (f32x4){0.f, 0.f, 0.f, 0.f};
            for (int ks = 0; ks < S; ++ks) { const float* pr = part + ((size_t)ks * tail_rows + srow) * D;
#pragma unroll
                for (int j = 0; j < 4; ++j) a[j] = a[j] + *(const f32x4*)(pr + 4 * lane + 256 * j); }
#pragma unroll
            for (int j = 0; j < 4; ++j) { dst[j].x = pk2(a[j].x, a[j].y); dst[j].y = pk2(a[j].z, a[j].w); }
        }
    };
    auto fetch = [&](int row) {
        if (MODE == 0) {
            ldrow(on0, O32 + (size_t)row * D, row >= srow0 ? row - srow0 : -1);
        } else {
            const int4 rt = *(const int4*)(P.ws + WS_ROUTE + (size_t)row * 16); const int2 tp = *(const int2*)(P.ws + WS_TOKPOS + (size_t)row * 8);
            pn0 = __builtin_bit_cast(float, rt.y); pn1 = __builtin_bit_cast(float, rt.z);
            ldrow(on0, WSP(bf16, WS_XG) + (size_t)tp.x * D, tp.x >= srow0 ? tp.x - srow0 : -1); ldrow(on1, WSP(bf16, WS_XG) + (size_t)tp.y * D, tp.y >= srow0 ? tp.y - srow0 : -1);
        }
        const float* xs = xsrc(row);
#pragma unroll
        for (int j = 0; j < 4; ++j) xnx[j] = *(const f32x4*)(xs + 4 * lane + 256 * j);
        if (FIRST && row < NT) { const int p = row & (SEQ - 1);
#pragma unroll
            for (int j = 0; j < 4; ++j) { const int c = 4 * lane + 256 * j; enx[j] = *(const f32x4*)((j < 2) ? (WSP(float, TAB_E) + (p >> 6) * 512 + c) : (WSP(float, TAB_E) + (p & 63) * 512 + (c - 512))); } }
    };
    for (int qb = 0; qb < KE + KS; qb += 64) {
    const int myq = qb + lane, myrow = rowq(myq); const bool valid = myq < KE ? (myrow < nexcl) : (myq < KE + KS && myrow < nrows);
    const unsigned* w0 = pcnt; const unsigned* w1 = pcnt; unsigned nd0 = need, nd1 = need;
    if (valid) { if (MODE == 0) { w0 = w1 = pcnt + 16 * (myrow >> 8); if (myrow >= srow0) nd0 = need * (unsigned)S; }
                 else { const int2 tp = *(const int2*)(P.ws + WS_TOKPOS + (size_t)myrow * 8); w0 = pcnt + 16 * (tp.x >> 8); w1 = pcnt + 16 * (tp.y >> 8); if (tp.x >= srow0) nd0 = need * (unsigned)S; if (tp.y >= srow0) nd1 = need * (unsigned)S; } }
    unsigned long long rem = __ballot(valid); unsigned spins = 0;
    while (rem) {
        bool rdy = false;
        if ((rem >> lane) & 1ull) { rdy = __hip_atomic_load(w0, __ATOMIC_RELAXED, __HIP_MEMORY_SCOPE_AGENT) >= nd0; if (MODE != 0) rdy = rdy && __hip_atomic_load(w1, __ATOMIC_RELAXED, __HIP_MEMORY_SCOPE_AGENT) >= nd1; }
        unsigned long long now = __ballot(rdy);
        if (!now) {
            __builtin_amdgcn_s_sleep(POST_SLEEP);
            if (++spins <= (1u << 15)) continue;
            if (lane == 0) { unsigned* tmo = WSP(unsigned, WS_CTL) + CW_TMO; __hip_atomic_store(tmo, 1u, __ATOMIC_RELAXED, __HIP_MEMORY_SCOPE_AGENT); __hip_atomic_fetch_max(tmo + 1, 0xB00u, __ATOMIC_RELAXED, __HIP_MEMORY_SCOPE_AGENT); }
            now = rem;
        }
        asm volatile("" ::: "memory");
        rem &= ~now;
        int kcur = __ffsll((long long)now) - 1; now &= now - 1ull;
        fetch(rowq(qb + kcur));
    for (;;) {
        const int row = rowq(qb + kcur);
        const int knext = now ? (__ffsll((long long)now) - 1) : -1; now &= now - 1ull;
        const int mr = row < NT ? (row >> 12) : 8;
        f32x4 o[4], xin[4];
#pragma unroll
        for (int j = 0; j < 4; ++j) { xin[j] = xnx[j];
            if (FIRST && row < NT) xin[j] = xin[j] + enx[j];
            if (MODE == 0) o[j] = (f32x4){bflo(on0[j].x), bfhi(on0[j].x), bflo(on0[j].y), bfhi(on0[j].y)};
            else o[j] = (f32x4){pn0 * bflo(on0[j].x) + pn1 * bflo(on1[j].x), pn0 * bfhi(on0[j].x) + pn1 * bfhi(on1[j].x), pn0 * bflo(on0[j].y) + pn1 * bflo(on1[j].y), pn0 * bfhi(on0[j].y) + pn1 * bfhi(on1[j].y)}; }
        if (knext >= 0) fetch(rowq(qb + knext));
        float ss = 0.f;
#pragma unroll
        for (int j = 0; j < 4; ++j) ss += (o[j].x * o[j].x + o[j].y * o[j].y) + (o[j].z * o[j].z + o[j].w * o[j].w);
        const float rs = rsqrtf(wave_sum(ss) * (1.0f / D) + NORM_EPS);
        float* xd = row < NT ? (P.out + (size_t)row * D) : (WSP(float, WS_XC) + (size_t)(row - NT) * D);
        const LAS float* wl = WL + mr * 3 * 1024;
        f32x4 x[4];
#pragma unroll
        for (int j = 0; j < 4; ++j) { const int c = 4 * lane + 256 * j; const f32x4 g = *(const LAS f32x4*)(wl + c), n = *(const LAS f32x4*)(WN + c);
            x[j] = xin[j] + g * (o[j] * rs * n); *(f32x4*)(xd + c) = x[j]; }
        if (NEXT) {
            f32x4 h[4]; norm_mod_lds(x, lane, WN + 1024, wl + 1024, wl + 2048, h);
            store_h_row(H + (size_t)row * D, lane, h);
            if (ROUTE) {
                float lg[NE];
#pragma unroll
                for (int e = 0; e < NE; ++e) lg[e] = 0.f;
#pragma unroll
                for (int e = 0; e < NE; ++e) {
#pragma unroll
                    for (int j = 0; j < 4; ++j) { const f32x4 w = *(const LAS f32x4*)(WR + e * 1024 + 4 * lane + 256 * j); lg[e] += (h[j].x * w.x + h[j].y * w.y) + (h[j].z * w.z + h[j].w * w.w); }
                    if (e & 1) __builtin_amdgcn_sched_barrier(0);
                }
#pragma unroll
                for (int e = 0; e < NE; ++e) lg[e] = wave_sum(lg[e]) + rbias[e];
                int i0 = 0; float v0 = lg[0];
#pragma unroll
                for (int e = 1; e < NE; ++e) if (lg[e] > v0) { v0 = lg[e]; i0 = e; }
                int i1 = -1; float v1 = -3.0e38f;
#pragma unroll
                for (int e = 0; e < NE; ++e) if (e != i0 && lg[e] > v1) { v1 = lg[e]; i1 = e; }
                const float e1 = expf(v1 - v0), p0 = 1.0f / (1.0f + e1), p1 = e1 / (1.0f + e1);
                if (lane == 0) *(int4*)(P.ws + WS_ROUTE + (size_t)row * 16) = make_int4(i0 | (i1 << 8), __builtin_bit_cast(int, p0), __builtin_bit_cast(int, p1), 0);
#pragma unroll
                for (int e = 0; e < NE; ++e) cnt[e] += (e == i0 || e == i1) ? 1 : 0;
            }
        }
        if (knext < 0) break;
        kcur = knext;
    }
    }
    }
    if (ROUTE) {
        if (lane == 0) {
#pragma unroll
            for (int e = 0; e < NE; ++e) if (cnt[e]) __hip_atomic_fetch_add(WSP(unsigned, WS_CTL) + CW_CNT + 64 * e, (unsigned)cnt[e], __ATOMIC_RELAXED, __HIP_MEMORY_SCOPE_AGENT);
        }
    }
}

constexpr int TB = 64;
typedef short bf16x4s __attribute__((ext_vector_type(4)));
#define MFMA16K(a, b, c) __builtin_amdgcn_mfma_f32_16x16x16bf16_1k((a), (b), (c), 0, 0, 0)
__device__ __forceinline__ float fexp(float x) { return __builtin_amdgcn_exp2f(x * 1.44269504089f); }
__device__ __forceinline__ float flog(float x) { return __builtin_amdgcn_logf(x) * 0.69314718056f; }
__device__ __forceinline__ float frcp(float x) { return __builtin_amdgcn_rcpf(x); }
__device__ __forceinline__ float softplusf_(float x) { return fmaxf(x, 0.f) + flog(1.0f + fexp(-fabsf(x))); }
__device__ __forceinline__ float ftanh(float x) { return 1.0f - 2.0f * frcp(1.0f + fexp(2.0f * x)); }
__device__ __forceinline__ f32x4 ld4bf(const bf16* p) { const v2u w = *(const v2u*)p; return (f32x4){bflo(w.x), bfhi(w.x), bflo(w.y), bfhi(w.y)}; }
template <int CTRL> __device__ __forceinline__ float dppf(float v) { return __builtin_bit_cast(float, __builtin_amdgcn_update_dpp(0, __builtin_bit_cast(int, v), CTRL, 0xf, 0xf, true)); }
__device__ __forceinline__ float sum8(float v) { v += dppf<0xB1>(v); v += dppf<0x4E>(v); v += dppf<0x141>(v); return v; }
__device__ __forceinline__ bf16x4s pack4(f32x4 v) { v2u w; w.x = pk2(v.x, v.y); w.y = pk2(v.z, v.w); return __builtin_bit_cast(bf16x4s, w); }
__device__ __forceinline__ void unpack8(v4u w, float (&o)[8]) {
#pragma unroll
    for (int q = 0; q < 4; ++q) { o[2 * q] = bflo(w[q]); o[2 * q + 1] = bfhi(w[q]); } }
__device__ __forceinline__ v4u pack8(const float (&o)[8]) { v4u w;
#pragma unroll
    for (int q = 0; q < 4; ++q) w[q] = pk2(o[2 * q], o[2 * q + 1]);
    return w; }
struct ScanPre { v4u kc, kp, vc, vp, rc, rp, wc, wp, ac, ap; };
__device__ __forceinline__ int scan_row(int bi, int tk, int b, int dir, bool& hp, int& prow) {
    const int seq = bi >= LC / TB, c = seq ? bi - LC / TB : bi, len = seq ? SEQ : LC, rowbase = seq ? b * SEQ : NT + b * LC;
    const int ts = c * TB + tk, t = dir ? (len - 1 - ts) : ts;
    hp = dir ? (t + 1 < len) : (t > 0);
    prow = rowbase + (hp ? (dir ? t + 1 : t - 1) : t);
    return rowbase + t;
}
__device__ __forceinline__ void scan_prefetch(const bf16* Z, int bi, int tk, int b, int dir, int gc, int c8, ScanPre& R) {
    bool hp; int prow; const int row = scan_row(bi, tk, b, dir, hp, prow);
    const bf16* zrk = Z + (size_t)row * NZ + gc; const bf16* zpk = Z + (size_t)prow * NZ + gc;
    const bf16* zrw = Z + (size_t)row * NZ + C_WLO + 64 * dir + c8; const bf16* zpw = Z + (size_t)prow * NZ + C_WLO + 64 * dir + c8;
    R.kc = *(const v4u*)(zrk + C_K); R.vc = *(const v4u*)(zrk + C_V); R.rc = *(const v4u*)(zrk + C_R); R.wc = *(const v4u*)(zrw); R.ac = *(const v4u*)(zrw + (C_ALO - C_WLO));
    R.kp = *(const v4u*)(zpk + C_K); R.vp = *(const v4u*)(zpk + C_V); R.rp = *(const v4u*)(zpk + C_R); R.wp = *(const v4u*)(zpw); R.ap = *(const v4u*)(zpw + (C_ALO - C_WLO));
}
__device__ __forceinline__ void lerp8(v4u cur, v4u prv, bool hp, const LAS float* mu, float (&o)[8]) {
    if (!hp) prv = (v4u){0u, 0u, 0u, 0u};
    const f32x4 m0 = *(const LAS f32x4*)mu, m1 = *(const LAS f32x4*)(mu + 4);
#pragma unroll
    for (int q = 0; q < 4; ++q) {
        const f32x2 c2 = {bflo(cur[q]), bfhi(cur[q])}, p2 = {bflo(prv[q]), bfhi(prv[q])};
        const f32x2 m2 = q < 2 ? (f32x2){m0[2 * q], m0[2 * q + 1]} : (f32x2){m1[2 * q - 4], m1[2 * q - 3]};
        const f32x2 r2 = c2 + (p2 - c2) * m2;
        o[2 * q] = r2.x; o[2 * q + 1] = r2.y; }
}
#define RLX_AGENT __ATOMIC_RELAXED, __HIP_MEMORY_SCOPE_AGENT
typedef GAS unsigned gu32;
constexpr unsigned kSpinCap = 1u << 17;
__device__ __forceinline__ bool wait_ge(gu32* word, unsigned want, gu32* tmo, unsigned code, int lane) {
    for (unsigned spins = 0;;) {
        if ((unsigned)__builtin_amdgcn_readfirstlane(__hip_atomic_load(word, RLX_AGENT)) >= want) return true;
        __builtin_amdgcn_s_sleep(1);
        if (++spins > kSpinCap) { if (lane == 0) { __hip_atomic_store(tmo, 1u, RLX_AGENT); __hip_atomic_fetch_max(tmo + 1, code, RLX_AGENT); } return false; }
        if ((spins & 255u) == 0u && __builtin_amdgcn_readfirstlane(__hip_atomic_load(tmo, RLX_AGENT))) return false;
    }
}
constexpr int XFER_PIECES = 3264, XFER_SLOT_BYTES = 52480, XFER_SLOTS = 6;
static_assert(WS_RING + 128ull * XFER_SLOTS * XFER_SLOT_BYTES <= WS_O32, "hand-off rings fit below the O buffer");
__device__ __forceinline__ int xfer_lds_off(int i) { return i < 1536 ? 20992 + 16 * i : (i < 2688 ? 45568 + 16 * (i - 1536) : 102912 + 16 * (i - 2688)); }
__device__ __forceinline__ void scan_unit(const Params& P, const Frame& F, int l, int b, int h, int dir, int role) {
    LAS unsigned char* L0 = F.lds;
    LAS bf16* W2T = (LAS bf16*)L0;
    LAS bf16* A2T = (LAS bf16*)(L0 + 9216);
    LAS float* CST = (LAS float*)(L0 + 18432);
    LAS bf16* TWb = (LAS bf16*)(L0 + 20992);
    LAS bf16* ALb = TWb + TB * TP;
    LAS bf16* BH = (LAS bf16*)(L0 + 20992);
    LAS bf16* KH = BH + 4 * 64 * 16;
    LAS bf16* Vt = KH + 4 * 64 * 16;
    LAS float* LW = (LAS float*)(L0 + 45568);
    constexpr int LWP = 68;
    LAS float* LA = LW + TB * LWP;
    LAS bf16* AT = (LAS bf16*)(L0 + 45568);
    LAS bf16* RT = AT + TB * TP; LAS bf16* BT = RT + TB * TP; LAS bf16* KT = BT + TB * TP;
    LAS float* CUM = (LAS float*)(L0 + 82432);
    LAS float* LabF = (LAS float*)(L0 + 98816);
    LAS bf16* LakB = (LAS bf16*)(L0 + 102912);
    LAS bf16* TtB = LakB + 1024; LAS bf16* MrbB = TtB + 1024; LAS bf16* MrkB = MrbB + 1024;
    LAS float* PCb = (LAS float*)(L0 + 111104);
    LAS float* YB = (LAS float*)(L0 + 112128);
    LAS float* BONl = (LAS float*)(L0 + 128512);
    const int tid = F.tid, lane = F.lane, w = F.wave, fr = lane & 15, fq = lane >> 4;
    const int tk = tid >> 3, c8 = (tid & 7) * 8, gc = 64 * h + c8;
    const int ld = l * 2 + dir;
    for (int i = tid; i < 4096; i += NTHR) { const int j = i >> 6, c = i & 63;
        W2T[c * TP + j] = (bf16)f2bf(P.in[I_W2][((size_t)ld * 64 + j) * 512 + 64 * h + c]); A2T[c * TP + j] = (bf16)f2bf(P.in[I_A2][((size_t)ld * 64 + j) * 512 + 64 * h + c]); }
    if (tid < 64) { const int c = 64 * h + tid;
        CST[0 * 64 + tid] = P.in[I_MU][(size_t)(ld * 3 + 0) * 512 + c]; CST[1 * 64 + tid] = P.in[I_MU][(size_t)(ld * 3 + 1) * 512 + c]; CST[2 * 64 + tid] = P.in[I_MU][(size_t)(ld * 3 + 2) * 512 + c];
        CST[3 * 64 + tid] = P.in[I_MUW][ld * 64 + tid]; CST[4 * 64 + tid] = P.in[I_MUA][ld * 64 + tid];
        CST[5 * 64 + tid] = P.in[I_W0][ld * 512 + c]; CST[6 * 64 + tid] = P.in[I_A0][ld * 512 + c];
        CST[7 * 64 + tid] = P.in[I_KK][l * 512 + c]; CST[8 * 64 + tid] = P.in[I_KA][l * 512 + c]; CST[9 * 64 + tid] = P.in[I_RK][l * 512 + c]; }
    const bf16* Z = WSP(bf16, WS_Z);
    bf16* YS = WSP(bf16, WS_YS) + (size_t)dir * MT * 512;
    float* BONG = WSP(float, WS_BONG) + (size_t)dir * MT * 8;
    f32x4 St[4];
#pragma unroll
    for (int kt = 0; kt < 4; ++kt) St[kt] = (f32x4){0.f, 0.f, 0.f, 0.f};
    constexpr int NBT = LC / TB + SEQ / TB;
    const int sid = (b * 8 + h) * 2 + dir;
    gu32* ctlw = (gu32*)WSP(unsigned, WS_CTL);
    gu32* prodw = ctlw + CW_PROD + l * 16384 + 64 * sid; gu32* consw = ctlw + CW_CONS + l * 16384 + 64 * sid;
    unsigned char* ring = P.ws + WS_RING + (size_t)sid * (XFER_SLOTS * XFER_SLOT_BYTES);
    v4u XR[7];
    ScanPre R; scan_prefetch(Z, role == 1 ? 1 : 0, tk, b, dir, gc, c8, R);
    __syncthreads();
    for (int bi = (role == 1 ? 1 : 0); bi < NBT; ++bi) {
        const bool mine = (role == 2) || ((bi % 2 == 0) == (role == 0));
        if (role == 1 && !mine) continue;
        const int hj = bi >> 1;
        const int bstep = role == 2 ? 1 : 2;
        const bool need_out = (bi >= LC / TB) || (l == 0);
        bool hp; int prow; const int row = scan_row(bi, tk, b, dir, hp, prow); (void)prow;
#ifdef PROBE_PREP2
        for (int prb_ = 0; prb_ < 2; ++prb_)
#endif
        if (mine) {
        if (role == 1 && hj >= XFER_SLOTS) { if (w == 0) wait_ge(consw, (unsigned)(hj - XFER_SLOTS + 1), ctlw + CW_TMO, 0x900u, lane); __syncthreads(); }
        float kx[8], vx[8], rx[8];
        { float wl[8], al[8];
          lerp8(R.kc, R.kp, hp, CST + 0 * 64 + c8, kx); lerp8(R.vc, R.vp, hp, CST + 1 * 64 + c8, vx); lerp8(R.rc, R.rp, hp, CST + 2 * 64 + c8, rx);
          lerp8(R.wc, R.wp, hp, CST + 3 * 64 + c8, wl); lerp8(R.ac, R.ap, hp, CST + 4 * 64 + c8, al);
#pragma unroll
          for (int j = 0; j < 8; ++j) wl[j] = ftanh(wl[j]);
          *(LAS v4u*)(TWb + tk * TP + c8) = pack8(wl); *(LAS v4u*)(ALb + tk * TP + c8) = pack8(al); }
        if (bi + bstep < NBT) scan_prefetch(Z, bi + bstep, tk, b, dir, gc, c8, R);
        __syncthreads();
        { const int mt = w & 3;
          bf16x8 yt[2], ya[2];
#pragma unroll
          for (int k2 = 0; k2 < 2; ++k2) { yt[k2] = *(const LAS bf16x8*)(TWb + (16 * mt + fr) * TP + 32 * k2 + 8 * fq); ya[k2] = *(const LAS bf16x8*)(ALb + (16 * mt + fr) * TP + 32 * k2 + 8 * fq); }
#pragma unroll
          for (int n2 = 0; n2 < 2; ++n2) { const int nt = 2 * (w >> 2) + n2;
              f32x4 cw = {0.f, 0.f, 0.f, 0.f}, ca = {0.f, 0.f, 0.f, 0.f};
#pragma unroll
              for (int k2 = 0; k2 < 2; ++k2) {
                  cw = MFMA16(*(const LAS bf16x8*)(W2T + (16 * nt + fr) * TP + 32 * k2 + 8 * fq), yt[k2], cw);
                  ca = MFMA16(*(const LAS bf16x8*)(A2T + (16 * nt + fr) * TP + 32 * k2 + 8 * fq), ya[k2], ca); }
              *(LAS f32x4*)(LW + (16 * mt + fr) * LWP + 16 * nt + 4 * fq) = cw; *(LAS f32x4*)(LA + (16 * mt + fr) * LWP + 16 * nt + 4 * fq) = ca; } }
        __syncthreads();
        float na[8], pb[8], km[8];
        {
            float n2 = 0.f, bon = 0.f, ew[8];
#pragma unroll
            for (int hf = 0; hf < 2; ++hf) {
#pragma unroll
                for (int j = 4 * hf; j < 4 * hf + 4; ++j) {
                    const float aw = LW[tk * LWP + c8 + j], aa = LA[tk * LWP + c8 + j];
                    ew[j] = 0.6065306597f * frcp(1.0f + fexp(-(CST[5 * 64 + c8 + j] + aw)));
                    const float ag = frcp(1.0f + fexp(-(CST[6 * 64 + c8 + j] + aa)));
                    const float kk = kx[j] * CST[7 * 64 + c8 + j]; n2 += kk * kk;
                    km[j] = kx[j] * (1.0f + (ag - 1.0f) * CST[8 * 64 + c8 + j]);
                    bon += rx[j] * km[j] * CST[9 * 64 + c8 + j];
                    na[j] = kk; pb[j] = ag;
                }
                __builtin_amdgcn_sched_barrier(0);
            }
            n2 = sum8(n2); bon = sum8(bon);
            const float inv = frcp(fmaxf(__builtin_amdgcn_sqrtf(n2), 1e-12f));
#pragma unroll
            for (int j = 0; j < 8; ++j) { const float kkn = na[j] * inv; na[j] = -kkn; pb[j] = kkn * pb[j]; }
            *(LAS f32x4*)(CUM + tk * 64 + c8) = (f32x4){ew[0], ew[1], ew[2], ew[3]} * 1.44269504089f; *(LAS f32x4*)(CUM + tk * 64 + c8 + 4) = (f32x4){ew[4], ew[5], ew[6], ew[7]} * 1.44269504089f;
            if ((tid & 7) == 0 && need_out) BONG[(size_t)row * 8 + h] = bon;
        }
        __syncthreads();
        if (tid < 256) { const int q = tid >> 6, ch = tid & 63; float c = 0.f;
#pragma unroll
            for (int i = 0; i < 16; ++i) { c -= CUM[(16 * q + i) * 64 + ch]; const float p = __builtin_amdgcn_exp2f(c); CUM[(16 * q + i) * 64 + ch] = p; if (i == 15) PCb[q * 64 + ch] = p; } }
        __syncthreads();
        {
            const int q = tk >> 4, tt = tk & 15;
            const f32x4 one4 = {1.f, 1.f, 1.f, 1.f};
            const f32x4 et0 = *(const LAS f32x4*)(CUM + tk * 64 + c8), et1 = *(const LAS f32x4*)(CUM + tk * 64 + c8 + 4);
            const f32x4 ep0 = tt ? *(const LAS f32x4*)(CUM + (tk - 1) * 64 + c8) : one4, ep1 = tt ? *(const LAS f32x4*)(CUM + (tk - 1) * 64 + c8 + 4) : one4;
            const f32x4 pc0 = *(const LAS f32x4*)(PCb + q * 64 + c8), pc1 = *(const LAS f32x4*)(PCb + q * 64 + c8 + 4);
            float ei8[8];
            { float t8[8];
#pragma unroll
              for (int j = 0; j < 8; ++j) t8[j] = na[j] * (j < 4 ? ep0[j & 3] : ep1[j & 3]);
              *(LAS v4u*)(AT + tk * TP + c8) = pack8(t8); }
            { float t8[8];
#pragma unroll
              for (int j = 0; j < 8; ++j) { const float et = j < 4 ? et0[j & 3] : et1[j & 3]; t8[j] = rx[j] * et; ei8[j] = frcp(et); }
              *(LAS v4u*)(RT + tk * TP + c8) = pack8(t8); }
            { float t8[8];
#pragma unroll
              for (int j = 0; j < 8; ++j) t8[j] = pb[j] * ei8[j];
              *(LAS v4u*)(BT + tk * TP + c8) = pack8(t8); }
            { float t8[8];
#pragma unroll
              for (int j = 0; j < 8; ++j) t8[j] = km[j] * ei8[j];
              *(LAS v4u*)(KT + tk * TP + c8) = pack8(t8); }
#pragma unroll
            for (int j = 0; j < 8; j += 2) { const float eh0 = (j < 4 ? pc0[j & 3] : pc1[j & 3]) * ei8[j], eh1 = (j + 1 < 4 ? pc0[(j + 1) & 3] : pc1[(j + 1) & 3]) * ei8[j + 1];
                const unsigned wb = pk2(pb[j] * eh0, pb[j + 1] * eh1), wk = pk2(km[j] * eh0, km[j + 1] * eh1), wv = pk2(vx[j], vx[j + 1]); const int o = (q * 64 + c8 + j) * 16 + (tt ^ (4 * ((tid & 7) & 3)));
                BH[o] = (bf16)(wb & 0xffffu); BH[o + 16] = (bf16)(wb >> 16); KH[o] = (bf16)(wk & 0xffffu); KH[o + 16] = (bf16)(wk >> 16); Vt[o] = (bf16)(wv & 0xffffu); Vt[o + 16] = (bf16)(wv >> 16); }
        }
        __syncthreads();
        { const int q = w >> 1, rsel = w & 1;
          const LAS bf16* YR = rsel ? RT : AT;
          f32x4 cb = {0.f, 0.f, 0.f, 0.f}, ck = {0.f, 0.f, 0.f, 0.f};
#pragma unroll
          for (int k2 = 0; k2 < 2; ++k2) { const bf16x8 yf = *(const LAS bf16x8*)(YR + (16 * q + fr) * TP + 32 * k2 + 8 * fq);
              cb = MFMA16(*(const LAS bf16x8*)(BT + (16 * q + fr) * TP + 32 * k2 + 8 * fq), yf, cb);
              ck = MFMA16(*(const LAS bf16x8*)(KT + (16 * q + fr) * TP + 32 * k2 + 8 * fq), yf, ck); }
#pragma unroll
          for (int i2 = 0; i2 < 4; ++i2) { const int i = 4 * fq + i2; const bool keep = rsel ? (i <= fr) : (i < fr); if (!keep) { cb[i2] = 0.f; ck[i2] = 0.f; } }
          if (rsel == 0) { *(LAS f32x4*)(LabF + (q * 16 + fr) * 16 + 4 * fq) = cb; *(LAS bf16x4s*)(LakB + (q * 16 + fr) * 16 + 4 * fq) = pack4(ck); }
          else { *(LAS bf16x4s*)(MrbB + (q * 16 + fr) * 16 + 4 * fq) = pack4(cb); *(LAS bf16x4s*)(MrkB + (q * 16 + fr) * 16 + 4 * fq) = pack4(ck); } }
        __syncthreads();
        if (tid < 64) { const int q = tid >> 4, c = tid & 15; float T[16];
#pragma unroll
            for (int t = 0; t < 16; ++t) { float sacc = (t == c) ? 1.f : 0.f;
#pragma unroll
                for (int i = 0; i < t; ++i) sacc += LabF[(q * 16 + t) * 16 + i] * T[i];
                T[t] = sacc; TtB[(q * 16 + t) * 16 + c] = (bf16)f2bf(sacc); } }
        __syncthreads();
        }
        if (role == 1) {
            const __amdgpu_buffer_rsrc_t rs = __builtin_amdgcn_make_buffer_rsrc(ring, 0, XFER_SLOTS * XFER_SLOT_BYTES, 0x00020000);
            const unsigned sb0 = (unsigned)((hj % XFER_SLOTS) * XFER_SLOT_BYTES);
            for (int i = tid; i < XFER_PIECES; i += NTHR) { const v4u v = *(const LAS v4u*)(L0 + xfer_lds_off(i)); __builtin_amdgcn_raw_buffer_store_b128(v, rs, sb0 + 16u * (unsigned)i, 0, 16); }
            asm volatile("s_waitcnt vmcnt(0)" ::: "memory");
            __syncthreads();
            if (tid == 0) __hip_atomic_store(prodw, (unsigned)(hj + 1), RLX_AGENT);
            continue;
        }
        if (!mine) {
#pragma unroll
            for (int k = 0; k < 7; ++k) { const int i = tid + NTHR * k; if (i < XFER_PIECES) *(LAS v4u*)(L0 + xfer_lds_off(i)) = XR[k]; }
            __syncthreads();
            if (tid == 0) __hip_atomic_store(consw, (unsigned)(hj + 1), RLX_AGENT);
        }
        if (role == 0 && bi + 1 < NBT && (bi + 1) % 2 != 0) {
            const int hn = (bi + 1) >> 1;
            if (w == 0) { wait_ge(prodw, (unsigned)(hn + 1), ctlw + CW_TMO, 0xA00u, lane); __builtin_amdgcn_fence(__ATOMIC_ACQUIRE, "agent"); asm volatile("s_waitcnt vmcnt(0)" ::: "memory"); }
            __syncthreads();
            const unsigned char* src = ring + (size_t)(hn % XFER_SLOTS) * XFER_SLOT_BYTES;
#pragma unroll
            for (int k = 0; k < 7; ++k) { int i = tid + NTHR * k; i = i < XFER_PIECES ? i : XFER_PIECES - 1; XR[k] = *(const v4u*)(src + 16 * i); }
        }
#ifdef PROBE_S2
        f32x4 Ssv[4];
#pragma unroll
        for (int kt = 0; kt < 4; ++kt) Ssv[kt] = St[kt];
        for (int prb_ = 0; prb_ < 2; ++prb_) {
        if (prb_) {
#pragma unroll
            for (int kt = 0; kt < 4; ++kt) St[kt] = Ssv[kt]; }
#endif
        if (w < 4) {
#pragma unroll 1
            for (int q = 0; q < 4; ++q) {
                const bf16x4s z4s = {0, 0, 0, 0};
#define CAT2(p0, p1) __builtin_shufflevector(*(const LAS bf16x4s*)(p0), *(const LAS bf16x4s*)(p1), 0, 1, 2, 3, 4, 5, 6, 7)
#define PAD8(p0) __builtin_shufflevector(*(const LAS bf16x4s*)(p0), z4s, 0, 1, 2, 3, 4, 5, 6, 7)
                const bf16x4s vt4 = *(const LAS bf16x4s*)(Vt + (q * 64 + 16 * w + fr) * 16 + 4 * (fq ^ ((2 * w + (fr >> 3)) & 3)));
                const LAS bf16* atp = AT + (16 * q + fr) * TP + 4 * fq; const LAS bf16* rtp = RT + (16 * q + fr) * TP + 4 * fq;
                f32x4 x1 = {0.f, 0.f, 0.f, 0.f}, yv = {0.f, 0.f, 0.f, 0.f};
                { const bf16x8 s01 = __builtin_shufflevector(pack4(St[0]), pack4(St[1]), 0, 1, 2, 3, 4, 5, 6, 7), s23 = __builtin_shufflevector(pack4(St[2]), pack4(St[3]), 0, 1, 2, 3, 4, 5, 6, 7);
                  x1 = MFMA16(CAT2(atp, atp + 16), s01, x1); x1 = MFMA16(CAT2(atp + 32, atp + 48), s23, x1);
                  yv = MFMA16(CAT2(rtp, rtp + 16), s01, yv); yv = MFMA16(CAT2(rtp + 32, rtp + 48), s23, yv); }
                x1 = MFMA16(PAD8(LakB + (q * 16 + fr) * 16 + 4 * fq), __builtin_shufflevector(vt4, z4s, 0, 1, 2, 3, 4, 5, 6, 7), x1);
                const f32x4 u = MFMA16(PAD8(TtB + (q * 16 + fr) * 16 + 4 * fq), __builtin_shufflevector(pack4(x1), z4s, 0, 1, 2, 3, 4, 5, 6, 7), ((f32x4){0.f, 0.f, 0.f, 0.f}));
                const bf16x8 vu = __builtin_shufflevector(vt4, pack4(u), 0, 1, 2, 3, 4, 5, 6, 7);
                yv = MFMA16(CAT2(MrkB + (q * 16 + fr) * 16 + 4 * fq, MrbB + (q * 16 + fr) * 16 + 4 * fq), vu, yv);
#pragma unroll
                for (int i2 = 0; i2 < 4; ++i2) YB[(16 * q + 4 * fq + i2) * 64 + 16 * w + fr] = yv[i2];
#pragma unroll
                for (int kt = 0; kt < 4; ++kt)
                    St[kt] = MFMA16(CAT2(KH + (q * 64 + 16 * kt + fr) * 16 + 4 * (fq ^ ((2 * kt + (fr >> 3)) & 3)), BH + (q * 64 + 16 * kt + fr) * 16 + 4 * (fq ^ ((2 * kt + (fr >> 3)) & 3))), vu, St[kt] * *(const LAS f32x4*)(PCb + q * 64 + 16 * kt + 4 * fq));
#undef CAT2
#undef PAD8
            }
        }
#ifdef PROBE_S2
        __syncthreads(); }
#endif
        __syncthreads();
        if (need_out) {
            float y8[8];
#pragma unroll
            for (int j = 0; j < 8; ++j) y8[j] = YB[tk * 64 + c8 + j];
            *(v4u*)(YS + (size_t)row * 512 + gc) = pack8(y8);
        }
    }
    __syncthreads();
}

constexpr int PL_CST = 0, PL_TW = 2560, PL_AL = PL_TW + 9216, PL_LW = PL_AL + 9216, PL_LA = PL_LW + 16384, PL_SET = PL_LA + 16384, PL_SETB = 52224, PL_END = PL_SET + 2 * PL_SETB;
static_assert(PL_END <= MISC_OFF, "pipelined scan LDS map");
__device__ __forceinline__ void scan_unit_pipe(const Params& P, const Frame& F, int l, int b, int h, int dir) {
    LAS unsigned char* L0 = F.lds;
    LAS float* CST = (LAS float*)(L0 + PL_CST);
    LAS bf16* TWb = (LAS bf16*)(L0 + PL_TW);
    LAS bf16* ALb = (LAS bf16*)(L0 + PL_AL);
    LAS bf16* BT = TWb; LAS bf16* KT = ALb;
    LAS float* LW = (LAS float*)(L0 + PL_LW);
    LAS float* LA = (LAS float*)(L0 + PL_LA);
    LAS float* CUM = LW; LAS float* LabF = LA;
    const int tid = F.tid, lane = F.lane, w = F.wave, fr = lane & 15, fq = lane >> 4;
    const int tk = tid >> 3, c8 = (tid & 7) * 8, gc = 64 * h + c8;
    const int ld = l * 2 + dir;
    if (tid < 64) { const int c = 64 * h + tid;
        CST[0 * 64 + tid] = P.in[I_MU][(size_t)(ld * 3 + 0) * 512 + c]; CST[1 * 64 + tid] = P.in[I_MU][(size_t)(ld * 3 + 1) * 512 + c]; CST[2 * 64 + tid] = P.in[I_MU][(size_t)(ld * 3 + 2) * 512 + c];
        CST[3 * 64 + tid] = P.in[I_MUW][ld * 64 + tid]; CST[4 * 64 + tid] = P.in[I_MUA][ld * 64 + tid];
        CST[5 * 64 + tid] = P.in[I_W0][ld * 512 + c]; CST[6 * 64 + tid] = P.in[I_A0][ld * 512 + c];
        CST[7 * 64 + tid] = P.in[I_KK][l * 512 + c]; CST[8 * 64 + tid] = P.in[I_KA][l * 512 + c]; CST[9 * 64 + tid] = P.in[I_RK][l * 512 + c]; }
    const bf16* Z = WSP(bf16, WS_Z);
    bf16* YS = WSP(bf16, WS_YS) + (size_t)dir * MT * 512;
    float* BONG = WSP(float, WS_BONG) + (size_t)dir * MT * 8;
    f32x4 St[4];
#pragma unroll
    for (int kt = 0; kt < 4; ++kt) St[kt] = (f32x4){0.f, 0.f, 0.f, 0.f};
    constexpr int NBT = LC / TB + SEQ / TB;
    ScanPre R; scan_prefetch(Z, 0, tk, b, dir, gc, c8, R);
    __syncthreads();
#define PL_CHAIN(q) do { if (w < 4 && it >= 1) { \
        const bf16x4s z4s = {0, 0, 0, 0}; \
        const LAS bf16* cBH = (const LAS bf16*)(cset); const LAS bf16* cKH = cBH + 4096; const LAS bf16* cVt = cKH + 4096; const LAS bf16* cAT = (const LAS bf16*)(cset + 24576); const LAS bf16* cRT = (const LAS bf16*)(cset + 33792); \
        const LAS bf16* cLak = (const LAS bf16*)(cset + 43008); const LAS bf16* cTt = cLak + 1024; const LAS bf16* cMrb = cTt + 1024; const LAS bf16* cMrk = cMrb + 1024; const LAS float* cPC = (const LAS float*)(cset + 51200); \
        const bf16x4s vt4 = *(const LAS bf16x4s*)(cVt + ((q) * 64 + 16 * w + fr) * 16 + 4 * fq); \
        const LAS bf16* atp = cAT + (16 * (q) + fr) * TP + 4 * fq; const LAS bf16* rtp = cRT + (16 * (q) + fr) * TP + 4 * fq; \
        f32x4 x1 = {0.f, 0.f, 0.f, 0.f}, yv = {0.f, 0.f, 0.f, 0.f}; \
        { const bf16x8 s01 = __builtin_shufflevector(pack4(St[0]), pack4(St[1]), 0, 1, 2, 3, 4, 5, 6, 7), s23 = __builtin_shufflevector(pack4(St[2]), pack4(St[3]), 0, 1, 2, 3, 4, 5, 6, 7); \
          x1 = MFMA16(PL_CAT2(atp, atp + 16), s01, x1); x1 = MFMA16(PL_CAT2(atp + 32, atp + 48), s23, x1); \
          yv = MFMA16(PL_CAT2(rtp, rtp + 16), s01, yv); yv = MFMA16(PL_CAT2(rtp + 32, rtp + 48), s23, yv); } \
        x1 = MFMA16(PL_PAD8(cLak + ((q) * 16 + fr) * 16 + 4 * fq), __builtin_shufflevector(vt4, z4s, 0, 1, 2, 3, 4, 5, 6, 7), x1); \
        const f32x4 u = MFMA16(PL_PAD8(cTt + ((q) * 16 + fr) * 16 + 4 * fq), __builtin_shufflevector(pack4(x1), z4s, 0, 1, 2, 3, 4, 5, 6, 7), ((f32x4){0.f, 0.f, 0.f, 0.f})); \
        const bf16x8 vu = __builtin_shufflevector(vt4, pack4(u), 0, 1, 2, 3, 4, 5, 6, 7); \
        yv = MFMA16(PL_CAT2(cMrk + ((q) * 16 + fr) * 16 + 4 * fq, cMrb + ((q) * 16 + fr) * 16 + 4 * fq), vu, yv); \
        _Pragma("unroll") for (int kt = 0; kt < 4; ++kt) { \
            St[kt] = MFMA16(PL_CAT2(cKH + ((q) * 64 + 16 * kt + fr) * 16 + 4 * fq, cBH + ((q) * 64 + 16 * kt + fr) * 16 + 4 * fq), vu, St[kt] * *(const LAS f32x4*)(cPC + (q) * 64 + 16 * kt + 4 * fq)); \
            if (kt & 1) __builtin_amdgcn_sched_barrier(0); } \
        if (cout_) { _Pragma("unroll") for (int i2 = 0; i2 < 4; ++i2) { bool hp2; int pr2; const int row2 = scan_row(it - 1, 16 * (q) + 4 * fq + i2, b, dir, hp2, pr2); \
            YS[(size_t)row2 * 512 + 64 * h + 16 * w + fr] = (bf16)f2bf(yv[i2]); } } \
    } } while (0)
#define PL_CAT2(p0, p1) __builtin_shufflevector(*(const LAS bf16x4s*)(p0), *(const LAS bf16x4s*)(p1), 0, 1, 2, 3, 4, 5, 6, 7)
#define PL_PAD8(p0) __builtin_shufflevector(*(const LAS bf16x4s*)(p0), z4s, 0, 1, 2, 3, 4, 5, 6, 7)
    for (int it = 0; it <= NBT; ++it) {
        const bool prep = it < NBT;
        const LAS unsigned char* cset = L0 + PL_SET + ((it - 1) & 1) * PL_SETB;
        LAS unsigned char* pset = L0 + PL_SET + (it & 1) * PL_SETB;
        const bool need_out = (it >= LC / TB) || (l == 0), cout_ = (it - 1 >= LC / TB) || (l == 0);
        LAS bf16* BH = (LAS bf16*)pset; LAS bf16* KH = BH + 4096; LAS bf16* Vt = KH + 4096; LAS bf16* AT = (LAS bf16*)(pset + 24576); LAS bf16* RT = (LAS bf16*)(pset + 33792);
        LAS bf16* LakB = (LAS bf16*)(pset + 43008); LAS bf16* TtB = LakB + 1024; LAS bf16* MrbB = TtB + 1024; LAS bf16* MrkB = MrbB + 1024; LAS float* PCb = (LAS float*)(pset + 51200);
        bool hp = false; int prow = 0; const int row = prep ? scan_row(it, tk, b, dir, hp, prow) : 0; (void)prow;
        float kx[8], vx[8], rx[8], na[8], pb[8], km[8];
#ifdef PROBE_ST1
        for (int prb_ = 0; prb_ < 2; ++prb_)
#endif
        if (prep) { float wl[8], al[8];
            lerp8(R.kc, R.kp, hp, CST + 0 * 64 + c8, kx); lerp8(R.vc, R.vp, hp, CST + 1 * 64 + c8, vx); lerp8(R.rc, R.rp, hp, CST + 2 * 64 + c8, rx);
            lerp8(R.wc, R.wp, hp, CST + 3 * 64 + c8, wl); lerp8(R.ac, R.ap, hp, CST + 4 * 64 + c8, al);
#pragma unroll
            for (int j = 0; j < 8; ++j) wl[j] = ftanh(wl[j]);
            *(LAS v4u*)(TWb + tk * TP + c8) = pack8(wl); *(LAS v4u*)(ALb + tk * TP + c8) = pack8(al);
        }
        __syncthreads();
        if (w >= 4) { if (prep) { const int nt = w - 4;
            int ll = lane; asm volatile("" : "+v"(ll));
            const size_t lo = ((size_t)ld * 512 + 64 * h + 16 * nt + (ll & 15)) * 64 + 8 * (ll >> 4);
            const bf16* w2g = WSP(bf16, WS_W2TG) + lo; const bf16* a2g = WSP(bf16, WS_A2TG) + lo;
            bf16x8 w2x[2], a2x[2];
#pragma unroll
            for (int k2 = 0; k2 < 2; ++k2) { w2x[k2] = *(const bf16x8*)(w2g + 32 * k2); a2x[k2] = *(const bf16x8*)(a2g + 32 * k2); }
#pragma unroll
            for (int mt = 0; mt < 4; ++mt) { f32x4 cw = {0.f, 0.f, 0.f, 0.f}, ca = {0.f, 0.f, 0.f, 0.f};
#pragma unroll
                for (int k2 = 0; k2 < 2; ++k2) { cw = MFMA16(w2x[k2], *(const LAS bf16x8*)(TWb + (16 * mt + fr) * TP + 32 * k2 + 8 * fq), cw); ca = MFMA16(a2x[k2], *(const LAS bf16x8*)(ALb + (16 * mt + fr) * TP + 32 * k2 + 8 * fq), ca); }
                *(LAS f32x4*)(LW + (16 * mt + fr) * 64 + 16 * nt + 4 * fq) = cw; *(LAS f32x4*)(LA + (16 * mt + fr) * 64 + 16 * nt + 4 * fq) = ca; } } }
        else PL_CHAIN(0);
        __syncthreads();
#ifdef PROBE_ST3
        float lwsv[8], lasv[8];
        if (prep) {
#pragma unroll
            for (int j = 0; j < 8; ++j) { lwsv[j] = LW[tk * 64 + c8 + j]; lasv[j] = LA[tk * 64 + c8 + j]; } }
        for (int prb_ = 0; prb_ < 2; ++prb_) {
        if (prb_ && prep) {
#pragma unroll
            for (int j = 0; j < 8; ++j) { LW[tk * 64 + c8 + j] = lwsv[j]; LA[tk * 64 + c8 + j] = lasv[j]; } }
#endif
        if (prep) {
            float n2 = 0.f, bon = 0.f, ew[8];
#pragma unroll
            for (int hf = 0; hf < 2; ++hf) {
#pragma unroll
                for (int j = 4 * hf; j < 4 * hf + 4; ++j) {
                    const float aw = LW[tk * 64 + c8 + j], aa = LA[tk * 64 + c8 + j];
                    ew[j] = 0.6065306597f * frcp(1.0f + fexp(-(CST[5 * 64 + c8 + j] + aw)));
                    const float ag = frcp(1.0f + fexp(-(CST[6 * 64 + c8 + j] + aa)));
                    const float kk = kx[j] * CST[7 * 64 + c8 + j]; n2 += kk * kk;
                    km[j] = kx[j] * (1.0f + (ag - 1.0f) * CST[8 * 64 + c8 + j]);
                    bon += rx[j] * km[j] * CST[9 * 64 + c8 + j];
                    na[j] = kk; pb[j] = ag;
                }
                __builtin_amdgcn_sched_barrier(0);
            }
            n2 = sum8(n2); bon = sum8(bon);
            const float inv = frcp(fmaxf(__builtin_amdgcn_sqrtf(n2), 1e-12f));
#pragma unroll
            for (int j = 0; j < 8; ++j) { const float kkn = na[j] * inv; na[j] = -kkn; pb[j] = kkn * pb[j]; }
            *(LAS f32x4*)(CUM + tk * 64 + c8) = (f32x4){ew[0], ew[1], ew[2], ew[3]} * 1.44269504089f; *(LAS f32x4*)(CUM + tk * 64 + c8 + 4) = (f32x4){ew[4], ew[5], ew[6], ew[7]} * 1.44269504089f;
            if ((tid & 7) == 0 && need_out) BONG[(size_t)row * 8 + h] = bon;
#pragma unroll
            for (int j = 0; j < 8; j += 2) { const unsigned wv = pk2(vx[j], vx[j + 1]); const int o = ((tk >> 4) * 64 + c8 + j) * 16 + (tk & 15); Vt[o] = (bf16)(wv & 0xffffu); Vt[o + 16] = (bf16)(wv >> 16); }
        }
#ifdef PROBE_ST3
        }
#endif
        __syncthreads();
        if (w >= 4) { if (prep) { const int t2 = tid - 256, q = t2 >> 6, ch = t2 & 63; float c = 0.f;
#pragma unroll
            for (int i = 0; i < 16; ++i) { c -= CUM[(16 * q + i) * 64 + ch]; const float p = __builtin_amdgcn_exp2f(c); CUM[(16 * q + i) * 64 + ch] = p; if (i == 15) PCb[q * 64 + ch] = p; } } }
        else PL_CHAIN(1);
        __syncthreads();
#ifdef PROBE_ST5
        for (int prb_ = 0; prb_ < 2; ++prb_)
#endif
        if (prep) {
            const int q = tk >> 4, tt = tk & 15;
            const f32x4 one4 = {1.f, 1.f, 1.f, 1.f};
            const f32x4 et0 = *(const LAS f32x4*)(CUM + tk * 64 + c8), et1 = *(const LAS f32x4*)(CUM + tk * 64 + c8 + 4);
            const f32x4 ep0 = tt ? *(const LAS f32x4*)(CUM + (tk - 1) * 64 + c8) : one4, ep1 = tt ? *(const LAS f32x4*)(CUM + (tk - 1) * 64 + c8 + 4) : one4;
            const f32x4 pc0 = *(const LAS f32x4*)(PCb + q * 64 + c8), pc1 = *(const LAS f32x4*)(PCb + q * 64 + c8 + 4);
            float ei8[8];
            { float t8[8];
#pragma unroll
              for (int j = 0; j < 8; ++j) t8[j] = na[j] * (j < 4 ? ep0[j & 3] : ep1[j & 3]);
              *(LAS v4u*)(AT + tk * TP + c8) = pack8(t8); }
            __builtin_amdgcn_sched_barrier(0);
            { float t8[8];
#pragma unroll
              for (int j = 0; j < 8; ++j) { const float et = j < 4 ? et0[j & 3] : et1[j & 3]; t8[j] = rx[j] * et; ei8[j] = frcp(et); }
              *(LAS v4u*)(RT + tk * TP + c8) = pack8(t8); }
            __builtin_amdgcn_sched_barrier(0);
            { float t8[8];
#pragma unroll
              for (int j = 0; j < 8; ++j) t8[j] = pb[j] * ei8[j];
              *(LAS v4u*)(BT + tk * TP + c8) = pack8(t8); }
            __builtin_amdgcn_sched_barrier(0);
            { float t8[8];
#pragma unroll
              for (int j = 0; j < 8; ++j) t8[j] = km[j] * ei8[j];
              *(LAS v4u*)(KT + tk * TP + c8) = pack8(t8); }
            __builtin_amdgcn_sched_barrier(0);
#pragma unroll
            for (int j = 0; j < 8; j += 2) { const float eh0 = (j < 4 ? pc0[j & 3] : pc1[j & 3]) * ei8[j], eh1 = (j + 1 < 4 ? pc0[(j + 1) & 3] : pc1[(j + 1) & 3]) * ei8[j + 1];
                const unsigned wb = pk2(pb[j] * eh0, pb[j + 1] * eh1), wk = pk2(km[j] * eh0, km[j + 1] * eh1); const int o = (q * 64 + c8 + j) * 16 + tt;
                BH[o] = (bf16)(wb & 0xffffu); BH[o + 16] = (bf16)(wb >> 16); KH[o] = (bf16)(wk & 0xffffu); KH[o + 16] = (bf16)(wk >> 16); }
        }
        __syncthreads();
        if (it + 1 < NBT) scan_prefetch(Z, it + 1, tk, b, dir, gc, c8, R);
        if (w >= 4) { if (prep) { const int q = w - 4;
#pragma unroll
            for (int rsel = 0; rsel < 2; ++rsel) {
                const LAS bf16* YR = rsel ? RT : AT;
                f32x4 cb = {0.f, 0.f, 0.f, 0.f}, ck = {0.f, 0.f, 0.f, 0.f};
#pragma unroll
                for (int k2 = 0; k2 < 2; ++k2) { const bf16x8 yf = *(const LAS bf16x8*)(YR + (16 * q + fr) * TP + 32 * k2 + 8 * fq);
                    cb = MFMA16(*(const LAS bf16x8*)(BT + (16 * q + fr) * TP + 32 * k2 + 8 * fq), yf, cb);
                    ck = MFMA16(*(const LAS bf16x8*)(KT + (16 * q + fr) * TP + 32 * k2 + 8 * fq), yf, ck); }
#pragma unroll
                for (int i2 = 0; i2 < 4; ++i2) { const int i = 4 * fq + i2; const bool keep = rsel ? (i <= fr) : (i < fr); if (!keep) { cb[i2] = 0.f; ck[i2] = 0.f; } }
                if (rsel == 0) { *(LAS f32x4*)(LabF + (q * 16 + fr) * 16 + 4 * fq) = cb; *(LAS bf16x4s*)(LakB + (q * 16 + fr) * 16 + 4 * fq) = pack4(ck); }
                else { *(LAS bf16x4s*)(MrbB + (q * 16 + fr) * 16 + 4 * fq) = pack4(cb); *(LAS bf16x4s*)(MrkB + (q * 16 + fr) * 16 + 4 * fq) = pack4(ck); } } } }
        else PL_CHAIN(2);
        __syncthreads();
        if (w == 4) { if (prep) { const int q = lane >> 4, c = lane & 15; float T[16];
#pragma unroll
            for (int t = 0; t < 16; ++t) { float sacc = (t == c) ? 1.f : 0.f;
#pragma unroll
                for (int i = 0; i < t; ++i) sacc += LabF[(q * 16 + t) * 16 + i] * T[i];
                T[t] = sacc; TtB[(q * 16 + t) * 16 + c] = (bf16)f2bf(sacc); } } }
        else if (w < 4) PL_CHAIN(3);
        __syncthreads();
    }
#undef PL_CHAIN
#undef PL_CAT2
#undef PL_PAD8
}

__device__ __forceinline__ void conv_items(const Params& P, const Frame& F, int l, int nrows, int ob, int nob) {
    const bf16* Z = WSP(bf16, WS_Z); bf16* YM = WSP(bf16, WS_H);
    const float* cw = P.in[I_CONVW] + l * 768;
    for (int idx = ob * NTHR + F.tid; idx < nrows * 32; idx += nob * NTHR) {
        const int row = idx >> 5, ch = (idx & 31) * 8;
        bool hp, hn;
        if (row < NT) { const int col = row & 63; hp = col != 0; hn = col != 63; } else { const int t = (row - NT) & 255; hp = t != 0; hn = t != 255; }
        const bf16* zr = Z + (size_t)row * NZ;
        const v4u u1 = *(const v4u*)(zr + C_U + ch), g1 = *(const v4u*)(zr + C_GC + ch), gb = *(const v4u*)(zr + C_GB + ch);
        v4u u0 = {0u, 0u, 0u, 0u}, g0 = u0, u2 = u0, g2 = u0;
        if (hp) { u0 = *(const v4u*)(zr - NZ + C_U + ch); g0 = *(const v4u*)(zr - NZ + C_GC + ch); }
        if (hn) { u2 = *(const v4u*)(zr + NZ + C_U + ch); g2 = *(const v4u*)(zr + NZ + C_GC + ch); }
        v4u o;
#pragma unroll
        for (int q = 0; q < 4; ++q) {
            const float wa0 = cw[ch + 2 * q], wa1 = cw[256 + ch + 2 * q], wa2 = cw[512 + ch + 2 * q], wb0 = cw[ch + 2 * q + 1], wb1 = cw[256 + ch + 2 * q + 1], wb2 = cw[512 + ch + 2 * q + 1];
            const float lo = bflo(gb[q]) * (wa0 * bflo(g0[q]) * bflo(u0[q]) + wa1 * bflo(g1[q]) * bflo(u1[q]) + wa2 * bflo(g2[q]) * bflo(u2[q]));
            const float hi = bfhi(gb[q]) * (wb0 * bfhi(g0[q]) * bfhi(u0[q]) + wb1 * bfhi(g1[q]) * bfhi(u1[q]) + wb2 * bfhi(g2[q]) * bfhi(u2[q]));
            o[q] = pk2(lo, hi);
        }
        *(v4u*)(YM + (size_t)row * D + 512 + ch) = o;
    }
}

__device__ __forceinline__ void load_tab64(LAS bf16* dst, const bf16* src, int tid) {
    for (int i = tid; i < 512; i += NTHR) { const int r = i >> 3, c = (i & 7) * 8; *(LAS v4u*)(dst + r * TP + c) = *(const v4u*)(src + r * 64 + c); }
}
__device__ __forceinline__ bf16x8 ldsfrag(const LAS bf16* base, int row, int col) { return *(const LAS bf16x8*)(base + row * TP + col); }
__device__ __forceinline__ void fourier_a_iter(const Params& P, const Frame& F, int it) {
    const int bg = it >> 3, j = it & 7, b = bg >> 2, g = bg & 3, w = F.wave, lane = F.lane, fr = lane & 15, fq = lane >> 4, p2 = 8 * j + w;
    LAS bf16* TC64 = (LAS bf16*)F.lds; LAS bf16* TS64 = TC64 + 64 * TP; LAS bf16* TN64 = TS64 + 64 * TP;
    LAS bf16* PT = TN64 + 64 * TP + w * (64 * TP);
    load_tab64(TC64, WSP(bf16, TAB_C64), F.tid); load_tab64(TS64, WSP(bf16, TAB_S64), F.tid); load_tab64(TN64, WSP(bf16, TAB_SN64), F.tid);
    const bf16* Z = WSP(bf16, WS_Z);
    __syncthreads();
    f32x4 Yr[4][4], Yi[4][4];
#pragma unroll
    for (int a = 0; a < 4; ++a)
#pragma unroll
        for (int c = 0; c < 4; ++c) { Yr[a][c] = (f32x4){0.f, 0.f, 0.f, 0.f}; Yi[a][c] = (f32x4){0.f, 0.f, 0.f, 0.f}; }
#pragma unroll
    for (int pass = 0; pass < 2; ++pass) {
        const LAS bf16* T1 = pass == 0 ? TC64 : TS64;
        asm volatile("" ::: "memory");
#pragma unroll
        for (int xt = 0; xt < 4; ++xt) {
            bf16x8 Ff[2];
#pragma unroll
            for (int ks = 0; ks < 2; ++ks) Ff[ks] = *(const bf16x8*)(Z + (size_t)(b * SEQ + 64 * (16 * xt + fr) + p2) * NZ + C_F + 64 * g + 32 * ks + 8 * fq);
#pragma unroll
            for (int yt = 0; yt < 4; ++yt) {
                f32x4 acc = {0.f, 0.f, 0.f, 0.f};
#pragma unroll
                for (int ks = 0; ks < 2; ++ks) acc = MFMA16(Ff[ks], ldsfrag(T1, 16 * yt + fr, 32 * ks + 8 * fq), acc);
                v2u wv; wv.x = pk2(acc.x, acc.y); wv.y = pk2(acc.z, acc.w);
                *(LAS v2u*)(PT + (16 * yt + fr) * TP + 16 * xt + 4 * fq) = wv;
            }
            __builtin_amdgcn_sched_barrier(0);
        }
        LDS_WAIT(); asm volatile("" ::: "memory");
        const LAS bf16* TA = pass == 0 ? TC64 : TN64;
        const LAS bf16* TB = pass == 0 ? TS64 : TC64;
#pragma unroll
        for (int ks = 0; ks < 2; ++ks) {
            bf16x8 pf[4];
#pragma unroll
            for (int yt = 0; yt < 4; ++yt) pf[yt] = ldsfrag(PT, 16 * yt + fr, 32 * ks + 8 * fq);
#pragma unroll
            for (int xt = 0; xt < 4; ++xt) { const bf16x8 ta = ldsfrag(TA, 16 * xt + fr, 32 * ks + 8 * fq), tb = ldsfrag(TB, 16 * xt + fr, 32 * ks + 8 * fq);
#pragma unroll
                for (int yt = 0; yt < 4; ++yt) { Yr[xt][yt] = MFMA16(ta, pf[yt], Yr[xt][yt]); Yi[xt][yt] = MFMA16(tb, pf[yt], Yi[xt][yt]); }
                __builtin_amdgcn_sched_barrier(0); }
        }
        LDS_WAIT(); asm volatile("" ::: "memory");
    }
    __syncthreads();
    LAS bf16* EX = (LAS bf16*)F.lds;
    const float* twc = WSP(float, TAB_TWC); const float* tws = WSP(float, TAB_TWS);
#pragma unroll
    for (int xt = 0; xt < 4; ++xt)
#pragma unroll
        for (int i = 0; i < 4; ++i) { const int q1 = 16 * xt + 4 * fq + i, m = (p2 * q1) & 4095; const float tc = twc[m], ts = tws[m];
#pragma unroll
            for (int yt = 0; yt < 4; ++yt) { const float yr = Yr[xt][yt][i], yi = Yi[xt][yt][i]; const int cp = 16 * yt + fr;
                EX[((q1 * 2 + 0) * 64 + cp) * 8 + w] = (bf16)f2bf(yr * tc - yi * ts);
                EX[((q1 * 2 + 1) * 64 + cp) * 8 + w] = (bf16)f2bf(-yi * tc - yr * ts); }
            __builtin_amdgcn_sched_barrier(0); }
    __syncthreads();
    bf16* YB = WSP(bf16, WS_YBUF) + (size_t)bg * (64 * 2 * 64 * 64);
#pragma unroll 4
    for (int n = 0; n < 16; ++n) { const int q = F.tid + NTHR * n; *(v4u*)(YB + (size_t)q * 64 + 8 * j) = *(const LAS v4u*)(EX + q * 8); }
    __syncthreads();
}
__device__ __forceinline__ void fourier_b_unit(const Params& P, const Frame& F, int u, const LAS bf16* TC64, const LAS bf16* TS64) {
    const int bg = u >> 6, s2 = u & 63, b = bg >> 2, g = bg & 3, lane = F.lane, fr = lane & 15, fq = lane >> 4;
    const bf16* YB = WSP(bf16, WS_YBUF) + (size_t)bg * (64 * 2 * 64 * 64) + (size_t)s2 * (2 * 64 * 64);
    f32x4 acc[4][4];
#pragma unroll
    for (int a = 0; a < 4; ++a)
#pragma unroll
        for (int c = 0; c < 4; ++c) acc[a][c] = (f32x4){0.f, 0.f, 0.f, 0.f};
#pragma unroll
    for (int ks = 0; ks < 4; ++ks) { const int ri = ks >> 1, pb = (ks & 1) * 32;
        bf16x8 xf[4];
#pragma unroll
        for (int xt = 0; xt < 4; ++xt) xf[xt] = *(const bf16x8*)(YB + (size_t)(ri * 64 + 16 * xt + fr) * 64 + pb + 8 * fq);
        const LAS bf16* T = ri ? TS64 : TC64;
#pragma unroll
        for (int yt = 0; yt < 4; ++yt) { const bf16x8 tf = ldsfrag(T, 16 * yt + fr, pb + 8 * fq);
#pragma unroll
            for (int xt = 0; xt < 4; ++xt) acc[xt][yt] = MFMA16(xf[xt], tf, acc[xt][yt]); }
    }
    bf16* YM = WSP(bf16, WS_H);
#pragma unroll
    for (int yt = 0; yt < 4; ++yt) { const int s1 = 16 * yt + fr; bf16* rowp = YM + (size_t)(b * SEQ + 64 * s1 + s2) * D + 768 + 64 * g;
#pragma unroll
        for (int xt = 0; xt < 4; ++xt) { const f32x4 a = acc[xt][yt] * (1.0f / 512.0f); v2u wv; wv.x = pk2(a.x, a.y); wv.y = pk2(a.z, a.w); *(v2u*)(rowp + 16 * xt + 4 * fq) = wv; } }
}
constexpr int TP2 = 264;
__device__ __forceinline__ void fourier_ctx_unit(const Params& P, const Frame& F, int bg) {
    const int b = bg >> 2, g = bg & 3, w = F.wave, lane = F.lane, fr = lane & 15, fq = lane >> 4;
    LAS bf16* TC64 = (LAS bf16*)F.lds; LAS bf16* TS64 = TC64 + 64 * TP;
    LAS bf16* PT = TS64 + 64 * TP; LAS bf16* QT = PT + 64 * TP2;
    load_tab64(TC64, WSP(bf16, TAB_C64), F.tid); load_tab64(TS64, WSP(bf16, TAB_S64), F.tid);
    const bf16* Z = WSP(bf16, WS_Z);
    bf16x8 Ff[2][2];
#pragma unroll
    for (int xt = 0; xt < 2; ++xt)
#pragma unroll
        for (int ks = 0; ks < 2; ++ks) Ff[xt][ks] = *(const bf16x8*)(Z + (size_t)(NT + b * LC + 32 * w + 16 * xt + fr) * NZ + C_F + 64 * g + 32 * ks + 8 * fq);
    __syncthreads();
#pragma unroll
    for (int xt = 0; xt < 2; ++xt)
#pragma unroll
        for (int yt = 0; yt < 4; ++yt) {
            f32x4 ap = {0.f, 0.f, 0.f, 0.f}, aq = {0.f, 0.f, 0.f, 0.f};
#pragma unroll
            for (int ks = 0; ks < 2; ++ks) { ap = MFMA16(Ff[xt][ks], ldsfrag(TC64, 16 * yt + fr, 32 * ks + 8 * fq), ap); aq = MFMA16(Ff[xt][ks], ldsfrag(TS64, 16 * yt + fr, 32 * ks + 8 * fq), aq); }
            v2u wp, wq; wp.x = pk2(ap.x, ap.y); wp.y = pk2(ap.z, ap.w); wq.x = pk2(aq.x, aq.y); wq.y = pk2(aq.z, aq.w);
            *(LAS v2u*)(PT + (16 * yt + fr) * TP2 + 32 * w + 16 * xt + 4 * fq) = wp; *(LAS v2u*)(QT + (16 * yt + fr) * TP2 + 32 * w + 16 * xt + 4 * fq) = wq;
        }
    __syncthreads();
    const bf16* C256 = WSP(bf16, WS_C256); const bf16* SN256 = WSP(bf16, WS_SN256);
    f32x4 acc[4][2];
#pragma unroll
    for (int a = 0; a < 4; ++a)
#pragma unroll
        for (int c = 0; c < 2; ++c) acc[a][c] = (f32x4){0.f, 0.f, 0.f, 0.f};
#pragma unroll 2
    for (int ks = 0; ks < 8; ++ks) {
        bf16x8 cf[2], sf[2];
#pragma unroll
        for (int yt = 0; yt < 2; ++yt) { cf[yt] = *(const bf16x8*)(C256 + (size_t)(32 * w + 16 * yt + fr) * 256 + 32 * ks + 8 * fq); sf[yt] = *(const bf16x8*)(SN256 + (size_t)(32 * w + 16 * yt + fr) * 256 + 32 * ks + 8 * fq); }
#pragma unroll
        for (int xt = 0; xt < 4; ++xt) { const bf16x8 pf = *(const LAS bf16x8*)(PT + (16 * xt + fr) * TP2 + 32 * ks + 8 * fq), qf = *(const LAS bf16x8*)(QT + (16 * xt + fr) * TP2 + 32 * ks + 8 * fq);
#pragma unroll
            for (int yt = 0; yt < 2; ++yt) { acc[xt][yt] = MFMA16(pf, cf[yt], acc[xt][yt]); acc[xt][yt] = MFMA16(qf, sf[yt], acc[xt][yt]); } }
    }
    bf16* YM = WSP(bf16, WS_H);
#pragma unroll
    for (int yt = 0; yt < 2; ++yt) { bf16* rowp = YM + (size_t)(NT + b * LC + 32 * w + 16 * yt + fr) * D + 768 + 64 * g;
#pragma unroll
        for (int xt = 0; xt < 4; ++xt) { const f32x4 a = acc[xt][yt] * (1.0f / 128.0f); v2u wv; wv.x = pk2(a.x, a.y); wv.y = pk2(a.z, a.w); *(v2u*)(rowp + 16 * xt + 4 * fq) = wv; } }
    __syncthreads();
}

constexpr int GP = 136;
__device__ __forceinline__ void finalize_phase(const Params& P, const Frame& F, int l, int nrows) {
    LAS bf16* G2 = (LAS bf16*)F.lds;
    const bf16* g2t = WSP(bf16, WS_G2T) + (size_t)l * 512 * 128;
    for (int i = F.tid; i < 512 * 16; i += NTHR) { const int r = i >> 4, c = (i & 15) * 8; *(LAS v4u*)(G2 + r * GP + c) = *(const v4u*)(g2t + r * 128 + c); }
    __syncthreads();
    const int gw = F.bx * NWAVES + F.wave, NGW = F.G * NWAVES, lane = F.lane, fr = lane & 15, fq = lane >> 4;
    const bf16* Z = WSP(bf16, WS_Z); const bf16* YSb = WSP(bf16, WS_YS); const float* BONG = WSP(float, WS_BONG); bf16* YM = WSP(bf16, WS_H);
    const float* gnw = P.in[I_GNW] + l * 512; const float* gnb = P.in[I_GNB] + l * 512; const float* mu = P.in[I_MU];
    const int nu = (nrows / 16) * 2;
    for (int u = gw; u < nu; u += NGW) {
        const int row = (u >> 1) * 16 + fr, half = u & 1;
        bf16x8 sf[4];
#pragma unroll
        for (int ks = 0; ks < 4; ++ks) { const v4u zv = *(const v4u*)(Z + (size_t)row * NZ + C_GLO + 32 * ks + 8 * fq); v4u o;
#pragma unroll
            for (int q = 0; q < 4; ++q) o[q] = pk2(sigmoidf_(bflo(zv[q])), sigmoidf_(bfhi(zv[q])));
            sf[ks] = __builtin_bit_cast(bf16x8, o); }
        int t, len; if (row < NT) { t = row & (SEQ - 1); len = SEQ; } else { t = (row - NT) & (LC - 1); len = LC; }
#pragma unroll 1
        for (int hh = 0; hh < 4; ++hh) {
            const int head = 4 * half + hh;
            f32x4 acc[4];
#pragma unroll
            for (int j = 0; j < 4; ++j) acc[j] = (f32x4){0.f, 0.f, 0.f, 0.f};
#pragma unroll
            for (int ks = 0; ks < 4; ++ks)
#pragma unroll
                for (int j = 0; j < 4; ++j) acc[j] = MFMA16(*(const LAS bf16x8*)(G2 + (64 * head + 16 * j + fr) * GP + 32 * ks + 8 * fq), sf[ks], acc[j]);
            f32x4 osum[4];
#pragma unroll
            for (int j = 0; j < 4; ++j) osum[j] = (f32x4){0.f, 0.f, 0.f, 0.f};
#pragma unroll
            for (int dir = 0; dir < 2; ++dir) {
                const bool hp = dir ? (t + 1 < len) : (t > 0); const int prow = hp ? (dir ? row + 1 : row - 1) : row;
                const bf16* ys = YSb + ((size_t)dir * MT + row) * 512 + 64 * head + 4 * fq;
                f32x4 y[4]; float s = 0.f;
#pragma unroll
                for (int j = 0; j < 4; ++j) { y[j] = ld4bf(ys + 16 * j); s += (y[j].x + y[j].y) + (y[j].z + y[j].w); }
                s += __shfl_xor(s, 16); s += __shfl_xor(s, 32);
                const float mean = s * (1.0f / 64.0f); float q2 = 0.f;
#pragma unroll
                for (int j = 0; j < 4; ++j) { y[j] = y[j] - mean; q2 += (y[j].x * y[j].x + y[j].y * y[j].y) + (y[j].z * y[j].z + y[j].w * y[j].w); }
                q2 += __shfl_xor(q2, 16); q2 += __shfl_xor(q2, 32);
                const float rstd = rsqrtf(q2 * (1.0f / 64.0f) + GN_EPS);
                const float bon = BONG[((size_t)dir * MT + row) * 8 + head];
#pragma unroll
                for (int j = 0; j < 4; ++j) { const int ch = 64 * head + 16 * j + 4 * fq;
                    const f32x4 vc = ld4bf(Z + (size_t)row * NZ + C_V + ch), vp = hp ? ld4bf(Z + (size_t)prow * NZ + C_V + ch) : (f32x4){0.f, 0.f, 0.f, 0.f};
                    const f32x4 mv = *(const f32x4*)(mu + (size_t)((l * 2 + dir) * 3 + 1) * 512 + ch);
                    const f32x4 vx = vc + (vp - vc) * mv;
                    osum[j] += y[j] * rstd * *(const f32x4*)(gnw + ch) + *(const f32x4*)(gnb + ch) + bon * vx; }
            }
#pragma unroll
            for (int j = 0; j < 4; ++j) { const int n = 64 * head + 16 * j + 4 * fq; const f32x4 o = osum[j] * acc[j];
                v2u wv; wv.x = pk2(o.x, o.y); wv.y = pk2(o.z, o.w); *(v2u*)(YM + (size_t)row * D + n) = wv; }
        }
    }
    __syncthreads();
}

struct MoePlan { int pb[9]; };
__device__ __forceinline__ void moe_plan(const Params& P, MoePlan& M, int (&cnt)[NE]) {
    int acc = 0;
#pragma unroll
    for (int e = 0; e < NE; ++e) { cnt[e] = (int)__hip_atomic_load(WSP(unsigned, WS_CTL) + CW_CNT + 64 * e, __ATOMIC_RELAXED, __HIP_MEMORY_SCOPE_AGENT); M.pb[e] = acc; acc += (cnt[e] + 255) >> 8; }
    M.pb[8] = acc;
}
__device__ __forceinline__ void moe_assign_gather(const Params& P, const Frame& F) {
    MoePlan M; int cnt[NE]; moe_plan(P, M, cnt);
    const int gw = F.bx * NWAVES + F.wave, NGW = F.G * NWAVES, lane = F.lane;
    const bf16* H = WSP(bf16, WS_H); bf16* XG = WSP(bf16, WS_XG);
    unsigned* fill = WSP(unsigned, WS_CTL) + CW_FILL;
    for (int it = gw; it < NT / 64; it += NGW) {
        const int tok = it * 64 + lane;
        const int4 rt = *(const int4*)(P.ws + WS_ROUTE + (size_t)tok * 16);
        const int es[2] = {rt.x & 255, (rt.x >> 8) & 255};
        int pos[2];
#pragma unroll
        for (int s = 0; s < 2; ++s) {
            pos[s] = 0;
#pragma unroll
            for (int e = 0; e < NE; ++e) {
                const unsigned long long m = __ballot(es[s] == e);
                if (m) {
                    const int n = __popcll(m), first = __ffsll((long long)m) - 1;
                    unsigned base = 0;
                    if (lane == first) base = __hip_atomic_fetch_add(fill + 64 * e, (unsigned)n, __ATOMIC_RELAXED, __HIP_MEMORY_SCOPE_AGENT);
                    base = __shfl(base, first);
                    const int rank = __popcll(m & ((1ull << lane) - 1ull));
                    if (es[s] == e) pos[s] = M.pb[e] * 256 + (int)base + rank;
                }
            }
        }
        *(int2*)(P.ws + WS_TOKPOS + (size_t)tok * 8) = make_int2(pos[0], pos[1]);
        for (int i = 0; i < 64; ++i) {
            const int t = it * 64 + i, d0 = __shfl(pos[0], i), d1 = __shfl(pos[1], i);
            const v4u a = *(const v4u*)(H + (size_t)t * D + 8 * lane), b = *(const v4u*)(H + (size_t)t * D + 512 + 8 * lane);
            *(v4u*)(XG + (size_t)d0 * D + 8 * lane) = a; *(v4u*)(XG + (size_t)d0 * D + 512 + 8 * lane) = b;
            *(v4u*)(XG + (size_t)d1 * D + 8 * lane) = a; *(v4u*)(XG + (size_t)d1 * D + 512 + 8 * lane) = b;
        }
    }
#pragma unroll
    for (int e = 0; e < NE; ++e) {
        const int r0 = M.pb[e] * 256 + cnt[e], r1 = M.pb[e + 1] * 256;
        for (int r = r0 + gw; r < r1; r += NGW) { *(v4u*)(XG + (size_t)r * D + 8 * lane) = (v4u){0u, 0u, 0u, 0u}; *(v4u*)(XG + (size_t)r * D + 512 + 8 * lane) = (v4u){0u, 0u, 0u, 0u}; }
    }
}

__device__ __forceinline__ Frame make_frame(LAS unsigned char* lds, int wave0) {
    Frame F; int tid = wave0 * 64 + (int)__builtin_amdgcn_mbcnt_hi(~0u, __builtin_amdgcn_mbcnt_lo(~0u, 0u)), G = gridDim.x, bx = blockIdx.x;
    asm volatile("" : "+v"(tid)); asm volatile("" : "+s"(G)); asm volatile("" : "+s"(bx));
    F.lds = lds; F.tid = tid; F.lane = tid & 63; F.wave = __builtin_amdgcn_readfirstlane(tid >> 6); F.G = G; F.bx = bx; return F;
}
#define CAS __attribute__((address_space(4)))
#define WSQ(T, off) ((T*)(Q.ws + (off)))
#if defined(__HIP_DEVICE_COMPILE__)
__device__ __forceinline__ Params load_params() { const CAS void* p = (const CAS void*)__builtin_amdgcn_kernarg_segment_ptr(); asm volatile("" : "+s"(p)); return *(const CAS Params*)p; }
#else
__device__ __forceinline__ Params load_params() { return Params{}; }
#endif
#ifndef PG8_SP2
#define PG8_SP2 true
#endif
#ifndef PG8_ALIGN
#define PG8_ALIGN true
#endif
#ifndef REP_MASK
#define REP_MASK 0
#endif
#define NREP(k) (1 + (((REP_MASK) >> (k)) & 1))
#ifdef PHMASK
#define IN(k) (((PHMASK) >> (k)) & 1)
#else
#define IN(k) (lo <= (k) && (k) < hi)
#endif
#define GRID_BARRIER() do { XcdBarrier b_ = bar; asm volatile("" : "+s"(b_.bar)); xcd_barrier(b_); } while (0)
#define SEAM(k) do { if (IN(k) && IN((k) + 1)) GRID_BARRIER(); } while (0)

__device__ __forceinline__ int tail_busy(int nwg, int G) {
#ifdef KEEP_SEAMS
    return 0;
#endif
    const int R = nwg / G, T = nwg - R * G; return (R >= 1 && 2 * T <= G) ? T : 0; }
#define PCNT(base) (WSQ(unsigned, WS_CTL) + CW_PCNT + (base))
#ifndef DOWN_SPLIT
#define DOWN_SPLIT 4
#endif
#ifndef MOE_SPLIT
#define MOE_SPLIT 4
#endif
#ifndef EXCL_WOUT0
#define EXCL_WOUT0 144
#endif
#ifndef EXCL_DOWN
#define EXCL_DOWN 68
#endif
#ifndef EXCL_MOE
#define EXCL_MOE 110
#endif
struct MoeTail { int p0, np, S, nfull, tp; size_t part_off; };
__device__ __forceinline__ MoeTail moe_tail(int ptot, int cap, int gq, int G) {
    int p0 = 0, np = 0;
    while (p0 < ptot) { np = ptot - p0; if (np > cap) np = gq; if (np <= 0 || p0 + np >= ptot) break; p0 += np; }
    pg8::SplitOrder T; T.np = np; T.nct = D / 256; T.G = G; T.init_split(MOE_SPLIT);
    MoeTail r; r.p0 = p0; r.np = np; r.S = T.S; r.nfull = T.nfull; r.tp = T.tail_panels(); r.part_off = WS_ACTM + (size_t)np * 256 * DFE * 2;
    if (r.S > 1 && r.part_off + (size_t)r.S * r.tp * 256 * D * 4 > WS_NEED) { r.S = 1; r.nfull = np * (D / 256); r.tp = 0; }
    return r;
}
#ifdef PROD_OLD
#define PNEED 0u
#else
#define PNEED 32u
#endif
#ifdef TPROBE
#ifndef TPROBE_BLK
#define TPROBE_BLK 0
#endif
#ifndef TPROBE_SCALE
#define TPROBE_SCALE 10
#endif
#define TP_BEGIN(k) do { if ((k) == TPROBE && (int)blockIdx.x == (TPROBE_BLK) && wave0 == 0) { __syncthreads_dummy(); MISC[41] = (unsigned)__builtin_amdgcn_s_memrealtime(); } } while (0)
#define TP_END(k) do { if ((k) == TPROBE && (int)blockIdx.x == (TPROBE_BLK) && wave0 == 0) { MISC[40] += (unsigned)__builtin_amdgcn_s_memrealtime() - MISC[41]; } } while (0)
__device__ __forceinline__ void __syncthreads_dummy() {}
#else
#define TP_BEGIN(k) do {} while (0)
#define TP_END(k) do {} while (0)
#endif
template <int l>
__device__ __forceinline__ void layer_phases(const XcdBarrier& bar, LAS unsigned char* const lds0, volatile LAS unsigned* MISC, const int lo, const int hi, const int wave0) {
        const int pb = 1 + 8 * l;
        for (int rep_ = 0; rep_ < NREP(pb + 1); ++rep_) { if (rep_) GRID_BARRIER();
        if (IN(pb + 1)) {
            const Params Q = load_params(); const Frame F = make_frame(lds0, wave0);
            pg8::Gemm g{WSQ(bf16, WS_H), WSQ(bf16, WS_WIN) + (size_t)l * NZ * D, MT, NZ, D}; pg8::StaticOrder S; S.init(MT, NZ, F.G, F.bx);
            pg8::EpiBf16<0> E{WSQ(bf16, WS_Z), NZ, nullptr, 0, 0, 1.f};
            pg8::gemm_phase<pg8::EpiBf16<0>, pg8::StaticOrder, PG8_ALIGN, PG8_SP2>(F.lds, g, S, E, F.wave);
        } }
        SEAM(pb + 1);
        for (int rep_ = 0; rep_ < NREP(pb + 2); ++rep_) { if (rep_) GRID_BARRIER();
        if (IN(pb + 2)) {
            const Params Q = load_params(); const Frame F = make_frame(lds0, wave0);
#ifdef FORCE_SOLO
            const bool paired = false;
#else
            const bool paired = F.G >= 256;
#endif
            const int nsb = F.G > 128 ? 128 : 0;
#ifndef NO_SCAN
#ifdef SCAN_PIPE
            (void)paired;
            if (F.bx < nsb || nsb == 0) { const int st = nsb ? nsb : F.G; for (int u = F.bx; u < 128; u += st) scan_unit_pipe(Q, F, l, u >> 4, (u >> 1) & 7, u & 1); }
#else
            if (paired) { if (F.bx < 128) scan_unit(Q, F, l, F.bx >> 4, (F.bx >> 1) & 7, F.bx & 1, 0); else if (F.bx < 256) { const int u = F.bx - 128; scan_unit(Q, F, l, u >> 4, (u >> 1) & 7, u & 1, 1); } }
            else if (F.bx < nsb || nsb == 0) { const int st = nsb ? nsb : F.G; for (int u = F.bx; u < 128; u += st) scan_unit(Q, F, l, u >> 4, (u >> 1) & 7, u & 1, 2); }
#endif
#endif
#ifdef PROBE_CF2
            for (int prb_ = 0; prb_ < 2; ++prb_)
#endif
            if (F.bx >= nsb) {
                const int ob = F.bx - nsb, nob = F.G - nsb;
#ifndef NO_CONV
                conv_items(Q, F, l, l == 0 ? MT : NT, ob, nob);
#endif
#ifndef NO_FA
#ifdef PROBE_FA2
                for (int prb_ = 0; prb_ < 2; ++prb_)
#endif
                for (int it = ob; it < 256; it += nob) fourier_a_iter(Q, F, it);
#endif
#ifndef NO_FC
                if (l == 0) for (int u = ob; u < 32; u += nob) fourier_ctx_unit(Q, F, u);
#endif
            }
        } }
        SEAM(pb + 2);
        for (int rep_ = 0; rep_ < NREP(pb + 3); ++rep_) { if (rep_) GRID_BARRIER();
        if (IN(pb + 3)) {
            const Params Q = load_params(); const Frame F = make_frame(lds0, wave0);
            LAS bf16* TC64 = (LAS bf16*)F.lds; LAS bf16* TS64 = TC64 + 64 * TP;
            load_tab64(TC64, WSQ(bf16, TAB_C64), F.tid); load_tab64(TS64, WSQ(bf16, TAB_S64), F.tid);
            __syncthreads();
#ifndef NO_FB
#ifdef PROBE_FB2
            for (int prb_ = 0; prb_ < 2; ++prb_)
#endif
            for (int u = F.bx * NWAVES + F.wave; u < 2048; u += F.G * NWAVES) fourier_b_unit(Q, F, u, TC64, TS64);
#endif
            __syncthreads();
#ifndef NO_FIN
            finalize_phase(Q, F, l, l == 0 ? MT : NT);
#endif
        } }
        SEAM(pb + 3);
        for (int rep_ = 0; rep_ < NREP(pb + 4); ++rep_) { if (rep_) GRID_BARRIER();
        if (IN(pb + 4)) {
            const Params Q = load_params(); const Frame F = make_frame(lds0, wave0);
            const int M = l == 0 ? MT : NT;
#ifdef PROD_OLD
            pg8::Gemm g{WSQ(bf16, WS_H), WSQ(bf16, WS_WOUT) + (size_t)l * D * D, M, D, D}; pg8::StaticOrder S; S.init(M, D, F.G, F.bx);
            pg8::EpiBf16<0> E{WSQ(bf16, WS_O32), D, nullptr, 0, 0, 1.f};
            pg8::gemm_phase<pg8::EpiBf16<0>, pg8::StaticOrder, PG8_ALIGN, PG8_SP2>(F.lds, g, S, E, F.wave);
#else
            pg8::Gemm g{WSQ(bf16, WS_H), WSQ(bf16, WS_WOUT) + (size_t)l * D * D, M, D, D}; pg8::PubOrder<pg8::StaticOrder> S; S.init(M, D, F.G, F.bx); S.cntr = PCNT(l == 0 ? PC_WOUT0 : PC_WOUT1); S.pend = -1;
            pg8::EpiBf16WT E{WSQ(bf16, WS_O32), D, 1 << 20};
            TP_BEGIN(l == 0 ? 3 : 7);
            pg8::gemm_phase<pg8::EpiBf16WT, pg8::PubOrder<pg8::StaticOrder>, PG8_ALIGN, PG8_SP2>(F.lds, g, S, E, F.wave);
            TP_END(l == 0 ? 3 : 7);
#endif
        } }
#ifdef KEEP_SEAMS
        SEAM(pb + 4);
#endif
        if (l == 0) {
            if (IN(pb + 5)) { const Params Q = load_params(); const Frame F = make_frame(lds0, wave0); TP_BEGIN(4); phase_post<0, true, false, true>(Q, F, MT, 0, 2048, 1, Q.in[I_CTX], 0, 2, 4096, 3072, PCNT(PC_WOUT0), PNEED, tail_busy((MT / 256) * (D / 256), F.G), (int)((long)MT * EXCL_WOUT0 / 256)); TP_END(4); }
            SEAM(pb + 5);
            for (int rep_ = 0; rep_ < NREP(pb + 6); ++rep_) { if (rep_) GRID_BARRIER();
            if (IN(pb + 6)) {
            const Params Q = load_params(); const Frame F = make_frame(lds0, wave0);
                pg8::Gemm g{WSQ(bf16, WS_H), WSQ(bf16, WS_WGU), MT, 2 * DFF, D}; pg8::StaticOrder S; S.init(MT, 2 * DFF, F.G, F.bx);
                pg8::EpiSwiglu E{WSQ(bf16, WS_Z), DFF, 0, 1 << 20};
                pg8::gemm_phase<pg8::EpiSwiglu, pg8::StaticOrder, PG8_ALIGN, PG8_SP2>(F.lds, g, S, E, F.wave);
            } }
            SEAM(pb + 6);
            for (int rep_ = 0; rep_ < NREP(pb + 7); ++rep_) { if (rep_) GRID_BARRIER();
            if (IN(pb + 7)) {
            const Params Q = load_params(); const Frame F = make_frame(lds0, wave0);
#ifdef PROD_OLD
                pg8::Gemm g{WSQ(bf16, WS_Z), WSQ(bf16, WS_WDN), MT, D, DFF}; pg8::StaticOrder S; S.init(MT, D, F.G, F.bx);
                pg8::EpiBf16<0> E{WSQ(bf16, WS_O32), D, nullptr, 0, 0, 1.f};
                pg8::gemm_phase<pg8::EpiBf16<0>, pg8::StaticOrder, PG8_ALIGN, PG8_SP2>(F.lds, g, S, E, F.wave);
#else
                pg8::Gemm g{WSQ(bf16, WS_Z), WSQ(bf16, WS_WDN), MT, D, DFF};
                pg8::PubOrder<pg8::SplitOrder> S; S.p0 = 0; S.np = MT / 256; S.nct = D / 256; S.G = F.G; S.c = F.bx; S.pb[0] = 0;
#pragma unroll
                for (int j = 1; j < 9; ++j) S.pb[j] = 1 << 20;
                S.init_split(DOWN_SPLIT); S.cntr = PCNT(PC_DOWN0); S.pend = -1;
                pg8::EpiSplitWT E{WSQ(bf16, WS_O32), D, D / 256, WSQ(float, WS_PARTD), S.nfull / (D / 256), S.tail_panels() * 256};
                TP_BEGIN(1);
                pg8::gemm_phase<pg8::EpiSplitWT, pg8::PubOrder<pg8::SplitOrder>, PG8_ALIGN, PG8_SP2>(F.lds, g, S, E, F.wave);
                TP_END(1);
#endif
            } }
#ifdef KEEP_SEAMS
            SEAM(pb + 7);
#endif
            if (IN(pb + 8)) { const Params Q = load_params(); const Frame F = make_frame(lds0, wave0); pg8::SplitOrder T; T.np = MT / 256; T.nct = D / 256; T.G = F.G; T.init_split(DOWN_SPLIT); const bool sp = T.S > 1;
                TP_BEGIN(2); phase_post<0, true, false>(Q, F, MT, 0, 5120, 3, (const float*)(Q.ws + WS_XC), 1, 0, 1024, 0, PCNT(PC_DOWN0), PNEED, sp ? T.tail_panels() * T.nct * T.S : tail_busy(T.np * T.nct, F.G),
                    (int)((long)MT * (sp ? EXCL_DOWN : EXCL_WOUT0) / 256), WSQ(float, WS_PARTD), sp ? (T.nfull / T.nct) * 256 : 0x7fffffff, T.S, T.tail_panels() * 256); TP_END(2); }
            SEAM(pb + 8);
        } else {
            if (IN(pb + 5)) { const Params Q = load_params(); const Frame F = make_frame(lds0, wave0); phase_post<0, true, true>(Q, F, NT, 1, 2048, 1, nullptr, 1, 2, 4096, 3072, PCNT(PC_WOUT1), PNEED, tail_busy((NT / 256) * (D / 256), F.G), 0); }
            SEAM(pb + 5);
            if (IN(pb + 6)) { const Params Q = load_params(); const Frame F = make_frame(lds0, wave0); for (int rep_ = 0; rep_ < NREP(15); ++rep_) convert_moe_weights(Q, F); moe_assign_gather(Q, F); }
            SEAM(pb + 6);
            if (IN(pb + 7)) {
            const Params Q = load_params(); const Frame F = make_frame(lds0, wave0);
                if (F.tid == 0) { MoePlan M; int cnt[NE]; moe_plan(Q, M, cnt);
#pragma unroll
                    for (int j = 0; j < 9; ++j) MISC[16 + j] = (unsigned)M.pb[j]; }
                __syncthreads();
                const int ptot = (int)MISC[16 + 8], gq = (F.G >= 256 && Q.act_cap_panels >= 128) ? 128 : (Q.act_cap_panels < 64 ? Q.act_cap_panels : 64);
                const MoeTail mt = moe_tail(ptot, Q.act_cap_panels, gq, F.G);
                int p0 = 0;
                while (p0 < ptot) {
                    int np = ptot - p0; if (np > Q.act_cap_panels) np = gq;
                    if (np > 0) {
                        for (int rep_ = 0; rep_ < NREP(16); ++rep_) { if (rep_) GRID_BARRIER();
                            pg8::Gemm g{WSQ(bf16, WS_XG), WSQ(bf16, WS_WMGU), 0, 0, D};
                            pg8::MoeOrder S; S.p0 = p0; S.np = np; S.nct = 2 * DFE / 256; S.G = F.G; S.c = F.bx;
#pragma unroll
                            for (int j = 0; j < 9; ++j) S.pb[j] = (int)MISC[16 + j];
                            pg8::EpiSwiglu E{WSQ(bf16, WS_ACTM), DFE, p0, 2 * DFE / 256};
                            pg8::gemm_phase<pg8::EpiSwiglu, pg8::MoeOrder, PG8_ALIGN, PG8_SP2>(F.lds, g, S, E, F.wave);
                        }
                        GRID_BARRIER();
                        for (int rep_ = 0; rep_ < NREP(17); ++rep_) { if (rep_) GRID_BARRIER();
                            pg8::Gemm g{WSQ(bf16, WS_ACTM) - (size_t)p0 * 256 * DFE, WSQ(bf16, WS_WMDN), 0, 0, DFE};
#ifdef PROD_OLD
                            pg8::MoeOrder S; S.p0 = p0; S.np = np; S.nct = D / 256; S.G = F.G; S.c = F.bx;
#pragma unroll
                            for (int j = 0; j < 9; ++j) S.pb[j] = (int)MISC[16 + j];
                            pg8::EpiBf16Mod E{WSQ(bf16, WS_XG), D, D / 256};
                            pg8::gemm_phase<pg8::EpiBf16Mod, pg8::MoeOrder, PG8_ALIGN, PG8_SP2>(F.lds, g, S, E, F.wave);
#else
                            pg8::PubOrder<pg8::SplitOrder> S; S.p0 = p0; S.np = np; S.nct = D / 256; S.G = F.G; S.c = F.bx; S.cntr = PCNT(PC_MOE); S.pend = -1;
#pragma unroll
                            for (int j = 0; j < 9; ++j) S.pb[j] = (int)MISC[16 + j];
                            S.init_split(p0 == mt.p0 ? mt.S : 1);
                            pg8::EpiSplitWT E{WSQ(bf16, WS_XG), D, D / 256, (float*)(Q.ws + mt.part_off), p0 + S.nfull / (D / 256), S.tail_panels() * 256};
                            TP_BEGIN(5);
                            pg8::gemm_phase<pg8::EpiSplitWT, pg8::PubOrder<pg8::SplitOrder>, PG8_ALIGN, PG8_SP2>(F.lds, g, S, E, F.wave);
                            TP_END(5);
#endif
                        }
#ifdef KEEP_SEAMS
                        GRID_BARRIER();
#else
                        if (p0 + np < ptot) GRID_BARRIER();
#endif
                    }
                    p0 += np;
                }
            }
            if (IN(pb + 8)) { const Params Q = load_params(); const Frame F = make_frame(lds0, wave0);
                MoePlan M; int cnt[NE]; moe_plan(Q, M, cnt);
                const int ptot = M.pb[8], gq = (F.G >= 256 && Q.act_cap_panels >= 128) ? 128 : (Q.act_cap_panels < 64 ? Q.act_cap_panels : 64);
                const MoeTail mt = moe_tail(ptot, Q.act_cap_panels, gq, F.G); const bool sp = mt.S > 1;
                TP_BEGIN(6); phase_post<1, false, false>(Q, F, NT, 1, 5120, 3, nullptr, 1, 0, 0, 0, PCNT(PC_MOE), PNEED, sp ? mt.tp * (D / 256) * mt.S : tail_busy(mt.np * (D / 256), F.G),
                    (int)((long)NT * (sp ? EXCL_MOE : 200) / 256), (const float*)(Q.ws + mt.part_off), sp ? (mt.p0 + mt.nfull / (D / 256)) * 256 : 0x7fffffff, mt.S, mt.tp * 256); TP_END(6); }
        }
    }
constexpr int N_PHASES = 18;
__global__ void __launch_bounds__(NTHR, 2) fwd_kernel(Params P) {
    extern __shared__ __attribute__((aligned(16))) unsigned char lds_raw[];
    LAS unsigned char* const lds0 = (LAS unsigned char*)lds_raw;
    volatile LAS unsigned* MISC = (volatile LAS unsigned*)(lds0 + MISC_OFF);
    const int wave0 = __builtin_amdgcn_readfirstlane((int)threadIdx.x >> 6);
    if (wave0 == 0) MISC[__builtin_amdgcn_mbcnt_hi(~0u, __builtin_amdgcn_mbcnt_lo(~0u, 0u))] = 0u;
    __syncthreads();
    unsigned* ctl = (unsigned*)(P.ws + WS_CTL);
    XcdBarrier bar = xcd_barrier_post(ctl + CW_BAR + P.li * XCD_BAR_WORDS, MISC + 8, wave0 == 0 ? 1u : 0u);
    const int lo = P.ph_lo, hi = P.ph_hi;
    for (int rep_ = 0; rep_ < NREP(0); ++rep_) { if (rep_) GRID_BARRIER(); if (IN(0)) { const Params Q = load_params(); const Frame F = make_frame(lds0, wave0); p0_adaln(Q, F); p0_small_weights(Q, F); p0_tables(Q, F); } }
    SEAM(0);
#ifdef PROBE_FN_NOSTORE
    for (int rep_ = 0; rep_ < 2; ++rep_) { if (rep_) GRID_BARRIER(); if (IN(1)) { const Params Q = load_params(); const Frame F = make_frame(lds0, wave0); phase_first_norm(Q, F); } }
#else
    for (int rep_ = 0; rep_ < NREP(1); ++rep_) { if (rep_) GRID_BARRIER(); if (IN(1)) { const Params Q = load_params(); const Frame F = make_frame(lds0, wave0); phase_first_norm(Q, F); } }
#endif
    SEAM(1);
#ifdef PROBE_BAR
    for (int prb_ = 0; prb_ < 20; ++prb_) GRID_BARRIER();
#endif
    layer_phases<0>(bar, lds0, MISC, lo, hi, wave0);
    layer_phases<1>(bar, lds0, MISC, lo, hi, wave0);
#ifdef TPROBE
    if ((int)blockIdx.x == (TPROBE_BLK) && wave0 == 0) { const unsigned long long t0 = __builtin_amdgcn_s_memrealtime(), dt = (unsigned long long)MISC[40] * (TPROBE_SCALE);
        while (__builtin_amdgcn_s_memrealtime() - t0 < dt) __builtin_amdgcn_s_sleep(8); }
#endif
#undef IN
#undef SEAM
}

#ifndef MK_PER_PHASE
#define MK_PER_PHASE 0
#endif
extern "C" void kernel_launch(void* const* d_in, const int* in_sizes, int n_in, void* d_out, int out_size, void* d_ws, size_t ws_size, hipStream_t stream) {
    static int grid = 0;
    if (grid == 0) {
        if (n_in != N_IN || in_sizes[0] != NT * D || out_size != NT * D || ws_size < WS_NEED) {
            fprintf(stderr, "kernel_launch: unexpected shapes (n_in %d, in0 %d, out %d, ws %zu); nothing launched\n", n_in, n_in > 0 ? in_sizes[0] : -1, out_size, ws_size); grid = -1; return; }
        int dev = 0, cus = 0, per_cu = 0;
        if (hipGetDevice(&dev) != hipSuccess || hipDeviceGetAttribute(&cus, hipDeviceAttributeMultiprocessorCount, dev) != hipSuccess) { grid = -1; return; }
        if (hipFuncSetAttribute((const void*)fwd_kernel, hipFuncAttributeMaxDynamicSharedMemorySize, LDS_BYTES) != hipSuccess) { fprintf(stderr, "kernel_launch: hipFuncSetAttribute failed\n"); grid = -1; return; }
        if (hipOccupancyMaxActiveBlocksPerMultiprocessor(&per_cu, (const void*)fwd_kernel, NTHR, LDS_BYTES) != hipSuccess || per_cu < 1)
            fprintf(stderr, "kernel_launch: occupancy query reports %d workgroups per CU\n", per_cu);
        (void)hipGetLastError();
        grid = cus;
    }
    if (grid < 0) return;
    if (hipMemsetAsync((char*)d_ws + WS_CTL, 0, CTL_ZERO_BYTES, stream) != hipSuccess) return;
    Params p{};
    for (int i = 0; i < N_IN; ++i) p.in[i] = (const float*)d_in[i];
    p.out = (float*)d_out; p.ws = (unsigned char*)d_ws;
    { size_t avail = ws_size - WS_ACTM; size_t cap = avail / ((size_t)256 * DFE * 2); if (cap > 264) cap = 264; p.act_cap_panels = (int)cap; }
#if MK_PER_PHASE
    int li = 0;
    for (int ph = 0; ph < N_PHASES; ++ph) {
        p.ph_lo = ph; p.ph_hi = ph + 1; p.li = li++;
        hipLaunchKernelGGL(fwd_kernel, dim3(grid), dim3(NTHR), LDS_BYTES, stream, p);
    }
#else
    p.ph_lo = 0; p.ph_hi = N_PHASES; p.li = 0;
    hipLaunchKernelGGL(fwd_kernel, dim3(grid), dim3(NTHR), LDS_BYTES, stream, p);
#endif
}
```

```cpp
#define POST_PLAINLD 1
#include <hip/hip_runtime.h>
#include <cstdio>
#include <cstdint>
namespace pg8 {
#define PG8_LAS __attribute__((address_space(3)))
typedef unsigned short bf16_t;
typedef short bf16x8 __attribute__((ext_vector_type(8)));
typedef float f32x4 __attribute__((ext_vector_type(4)));
typedef unsigned u32x4 __attribute__((ext_vector_type(4)));
constexpr int BM = 256, BK = 64, HALF = 128, HTB = HALF * BK * 2  , STAGE_BYTES = 8 * HTB, NXCD = 8, WGM = 8;

__host__ __device__ __forceinline__ int lds_byte(int r, int c) { const int st = (r >> 4) * 2 + (c >> 5), rr = r & 15, cc = c & 31, ob = rr * 64 + cc * 2; return st * 1024 + (ob ^ (((ob >> 9) & 1) << 5)); }
__host__ __device__ __forceinline__ void stage_rc(int b, int& R, int& C) { const int st = b / 1024, sb = b % 1024, swz = sb ^ (((sb >> 9) & 1) << 5); R = (st >> 1) * 16 + swz / 64; C = (st & 1) * 32 + (swz % 64) / 2; }
__host__ __device__ __forceinline__ int perm32(int rho) { const int n = rho >> 4, i = rho & 15; return 8 * (i >> 2) + 4 * n + (i & 3); }

struct Unit { int pm, pn; };
struct Gemm { const bf16_t* A; const bf16_t* Bt; int M, N, K; };

struct StaticOrder {
    static constexpr bool SPLITK = false;
    int nM, nN, nwg, G, c;
    __host__ __device__ void init(int M, int N, int G_, int c_) { nM = M / BM; nN = N / BM; nwg = nM * nN; G = G_; c = c_; }
    __host__ __device__ bool next(int i, Unit& u) const {
        const long L = (long)i * G + c; if (L >= nwg) return false;
        int wgid = (int)L; { const int q = nwg / NXCD, r = nwg % NXCD, xcd = wgid % NXCD, off = wgid / NXCD; wgid = (xcd < r ? xcd * (q + 1) : r * (q + 1) + (xcd - r) * q) + off; }
        const int nig = WGM * nN, gid = wgid / nig, fm = gid * WGM, gsz = (nM - fm) < WGM ? (nM - fm) : WGM;
        u.pm = fm + ((wgid % nig) % gsz); u.pn = (wgid % nig) / gsz; return true;
    }
    __device__ __forceinline__ void a_ready(const Unit&) const {}
    __device__ __forceinline__ void done(const Unit&) const {}
    __device__ __forceinline__ void flush() const {}
};

__device__ __forceinline__ unsigned cvt_pk_bf16(float lo, float hi) { unsigned r; asm volatile("v_cvt_pk_bf16_f32 %0, %1, %2" : "=v"(r) : "v"(lo), "v"(hi)); return r; }
typedef float f32x2 __attribute__((ext_vector_type(2)));
__device__ __forceinline__ f32x2 gelu_pk(f32x2 v) {
    const f32x2 av = __builtin_elementwise_abs(v), d = av * 0.2316418882f + 1.0f;
    f32x2 t; t.x = __builtin_amdgcn_rcpf(d.x); t.y = __builtin_amdgcn_rcpf(d.y);
    f32x2 q = t * 0.5307027145f + (-0.7265760135f); q = q * t + 0.7107068705f; q = q * t + (-0.142248368f); q = q * t + 0.127414796f; q = q * t;
    const f32x2 s = (v * v) * (-0.72134752044f);
    f32x2 e; e.x = __builtin_amdgcn_exp2f(s.x); e.y = __builtin_amdgcn_exp2f(s.y);
    const f32x2 m = v * (q * e), r = v - m;
    f32x2 o; o.x = v.x < 0.f ? m.x : r.x; o.y = v.y < 0.f ? m.y : r.y; return o;
}

template <int ACT  > struct EpiBf16 {
    static constexpr bool PERM = true, AFTER_DRAIN = false; static_assert(ACT == 0 || ACT == 1, "EpiBf16: ACT is 0 (none) or 1 (gelu_pk)");
    bf16_t* O; int ldc; const float* bias; int split_cols; size_t split_stride; float scale0;
    __device__ __forceinline__ void operator()(const f32x4 (&acc)[2][2][4][2], const Unit& u, int wr, int wc, int fr, int fq) const {
        const int row0 = u.pm * BM + wr * 64 + fr; int colt = u.pn * BM; bf16_t* base = O;
        float sc = 1.f; if (split_cols) { const int t = colt / split_cols; base += (size_t)t * split_stride; colt -= t * split_cols; if (t == 0) sc = scale0; }
        const int col0 = colt + wc * 32 + 8 * fq, bcol0 = u.pn * BM + wc * 32 + 8 * fq;
        f32x4 bv[2][2];
#pragma unroll
        for (int bj = 0; bj < 2; ++bj)
#pragma unroll
            for (int n = 0; n < 2; ++n) bv[bj][n] = bias ? *(const f32x4*)(bias + bcol0 + bj * HALF + 4 * n) : (f32x4){0.f, 0.f, 0.f, 0.f};
#pragma unroll
        for (int ai = 0; ai < 2; ++ai)
#pragma unroll
            for (int m = 0; m < 4; ++m) { bf16_t* rowp = base + (size_t)(row0 + ai * HALF + m * 16) * ldc + col0;
#pragma unroll
                for (int bj = 0; bj < 2; ++bj) { f32x4 v0 = acc[ai][bj][m][0] + bv[bj][0], v1 = acc[ai][bj][m][1] + bv[bj][1];
                    if (ACT == 1) { f32x2 a = gelu_pk((f32x2){v0[0], v0[1]}), b = gelu_pk((f32x2){v0[2], v0[3]}), c = gelu_pk((f32x2){v1[0], v1[1]}), d = gelu_pk((f32x2){v1[2], v1[3]});
                        v0 = (f32x4){a.x, a.y, b.x, b.y}; v1 = (f32x4){c.x, c.y, d.x, d.y}; }
                    v0 = v0 * sc; v1 = v1 * sc; u32x4 w; w.x = cvt_pk_bf16(v0[0], v0[1]); w.y = cvt_pk_bf16(v0[2], v0[3]); w.z = cvt_pk_bf16(v1[0], v1[1]); w.w = cvt_pk_bf16(v1[2], v1[3]);
                    *(u32x4*)(rowp + bj * HALF) = w; } }
    }
};

struct EpiF32 {
    static constexpr bool PERM = false, AFTER_DRAIN = false;
    float* C; int ldc; const float* bias;
    __device__ __forceinline__ void operator()(const f32x4 (&acc)[2][2][4][2], const Unit& u, int wr, int wc, int fr, int fq) const {
        const int row0 = u.pm * BM + wr * 64 + fr, col0 = u.pn * BM + wc * 32 + 4 * fq;
        f32x4 bv[2][2];
#pragma unroll
        for (int bj = 0; bj < 2; ++bj)
#pragma unroll
            for (int n = 0; n < 2; ++n) bv[bj][n] = bias ? *(const f32x4*)(bias + col0 + bj * HALF + n * 16) : (f32x4){0.f, 0.f, 0.f, 0.f};
#pragma unroll
        for (int ai = 0; ai < 2; ++ai)
#pragma unroll
            for (int m = 0; m < 4; ++m) { float* rowp = C + (size_t)(row0 + ai * HALF + m * 16) * ldc + col0;
#pragma unroll
                for (int bj = 0; bj < 2; ++bj)
#pragma unroll
                    for (int n = 0; n < 2; ++n) *(f32x4*)(rowp + bj * HALF + n * 16) = acc[ai][bj][m][n] + bv[bj][n]; }
    }
};
template <class Epi, class Sched, bool ALIGN_EPI = false, bool SP2 = false>
__device__ __forceinline__ void gemm_phase(PG8_LAS unsigned char* lds, const Gemm g, const Sched& S, const Epi& E, const int wave_in) {
    int tid_ = wave_in * 64 + (int)__builtin_amdgcn_mbcnt_hi(~0u, __builtin_amdgcn_mbcnt_lo(~0u, 0u)); asm volatile("" : "+v"(tid_));
    const int tid = tid_, wid = __builtin_amdgcn_readfirstlane(tid >> 6), lane = tid & 63, wr = wid >> 2, wc = wid & 3, fr = lane & 15, fq = lane >> 4;
    const int K = g.K, nt = K / BK;
    unsigned voffA[2], voffB[2];
#pragma unroll
    for (int i = 0; i < 2; ++i) { int R, C; stage_rc(tid * 16 + i * 8192, R, C); const int Rb = Epi::PERM ? ((R & ~31) + perm32(R & 31)) : R;
        voffA[i] = (unsigned)(R * K + C) * 2u; voffB[i] = (unsigned)(Rb * K + C) * 2u; }
    const size_t kstep = (size_t)(BK * 2);
    const size_t hstep = (size_t)HALF * K * 2;
    const size_t tstep = 2 * hstep;
    const unsigned ldsw = (unsigned)wid * 1024u;
    const int aoff = lds_byte(wr * 64 + fr, fq * 8), boff = lds_byte(wc * 32 + fr, fq * 8);
#define PG8_SA(b, h) (((b) * 2 + (h)) * HTB)
#define PG8_SB(b, h) ((4 + (b) * 2 + (h)) * HTB)
#define PG8_STAGE(bufoff, gbase, voff) do { _Pragma("unroll") for (int _i = 0; _i < 2; ++_i) \
        __builtin_amdgcn_global_load_lds((const unsigned*)((const char*)(gbase) + (voff)[_i]), (PG8_LAS unsigned*)(lds + (bufoff) + ldsw + _i * 8192), 16, 0, 0); } while (0)
#define PG8_LDA(dst, b, h) do { _Pragma("unroll") for (int m = 0; m < 4; ++m) _Pragma("unroll") for (int k = 0; k < 2; ++k) dst[m][k] = *(const PG8_LAS bf16x8*)(lds + PG8_SA(b, h) + aoff + m * 2048 + k * 1024); } while (0)
#define PG8_LDB(dst, b, h) do { _Pragma("unroll") for (int n = 0; n < 2; ++n) _Pragma("unroll") for (int k = 0; k < 2; ++k) dst[n][k] = *(const PG8_LAS bf16x8*)(lds + PG8_SB(b, h) + boff + n * 2048 + k * 1024); } while (0)
#define PG8_MMA(ai, bj, At, Bt) do { __builtin_amdgcn_s_setprio(1); _Pragma("unroll") for (int m = 0; m < 4; ++m) _Pragma("unroll") for (int n = 0; n < 2; ++n) _Pragma("unroll") for (int k = 0; k < 2; ++k) \
        acc[ai][bj][m][n] = __builtin_amdgcn_mfma_f32_16x16x32_bf16(Bt[n][k], At[m][k], acc[ai][bj][m][n], 0, 0, 0); __builtin_amdgcn_s_setprio(0); } while (0)
#define PG8_WAIT_V(n) asm volatile("s_waitcnt vmcnt(" #n ")" ::: "memory")
#define PG8_WAIT_L(n) asm volatile("s_waitcnt lgkmcnt(" #n ")" ::: "memory")
#define PG8_BAR __builtin_amdgcn_s_barrier()
#define PG8_SCHED __builtin_amdgcn_sched_barrier(0)
    Unit cur, nxt; int ui = 0;
    if (!S.next(0, cur)) return;
    f32x4 acc[2][2][4][2];
#pragma unroll
    for (int a = 0; a < 2; ++a)
#pragma unroll
        for (int b = 0; b < 2; ++b)
#pragma unroll
            for (int m = 0; m < 4; ++m)
#pragma unroll
                for (int n = 0; n < 2; ++n) acc[a][b][m][n] = (f32x4){0.f, 0.f, 0.f, 0.f};
    bf16x8 At[4][2], B0[2][2], B1[2][2];
    const char* cA = (const char*)g.A + (size_t)cur.pm * tstep; const char* cB = (const char*)g.Bt + (size_t)cur.pn * tstep;
    int cnt = nt;
    if constexpr (Sched::SPLITK) { cnt = S.ktiles(cur, nt); cA += S.kbyte(cur, nt); cB = (const char*)g.Bt + (size_t)S.btile(cur) * tstep + S.kbyte(cur, nt); }
    S.a_ready(cur);
    if constexpr (SP2) {
        PG8_STAGE(PG8_SB(0, 0), cB, voffB); PG8_STAGE(PG8_SB(0, 1), cB + hstep, voffB); PG8_STAGE(PG8_SA(0, 0), cA, voffA); PG8_STAGE(PG8_SA(0, 1), cA + hstep, voffA);
        if (wr == 1) PG8_BAR;
        PG8_WAIT_V(2); PG8_BAR;
        PG8_STAGE(PG8_SB(1, 0), cB + kstep, voffB); PG8_STAGE(PG8_SA(1, 0), cA + kstep, voffA); PG8_STAGE(PG8_SB(1, 1), cB + hstep + kstep, voffB);
        PG8_WAIT_V(6); PG8_BAR;
    } else {
        PG8_STAGE(PG8_SB(0, 0), cB, voffB); PG8_STAGE(PG8_SA(0, 0), cA, voffA); PG8_STAGE(PG8_SB(0, 1), cB + hstep, voffB); PG8_STAGE(PG8_SA(0, 1), cA + hstep, voffA);
        if (wr == 1) PG8_BAR;
        PG8_WAIT_V(4); PG8_BAR;
        PG8_STAGE(PG8_SB(1, 0), cB + kstep, voffB); PG8_STAGE(PG8_SA(1, 0), cA + kstep, voffA); PG8_STAGE(PG8_SB(1, 1), cB + hstep + kstep, voffB);
        PG8_WAIT_V(6); PG8_BAR;
    }
    for (;;) {
        const bool has_next = S.next(ui + 1, nxt);
        const char* nA = has_next ? (const char*)g.A + (size_t)nxt.pm * tstep : cA; const char* nB = has_next ? (const char*)g.Bt + (size_t)nxt.pn * tstep : cB;
        if constexpr (Sched::SPLITK) { if (has_next) { nA += S.kbyte(nxt, nt); nB = (const char*)g.Bt + (size_t)S.btile(nxt) * tstep + S.kbyte(nxt, nt); } }
        for (int t = 0; t < cnt; t += 2) {
            const bool last = (t == cnt - 2);
            const char* a1 = cA + (size_t)(t + 1) * kstep;
            const char* a2 = last ? nA : cA + (size_t)(t + 2) * kstep; const char* b2 = last ? nB : cB + (size_t)(t + 2) * kstep;
            const char* a3 = a2 + kstep; const char* b3 = b2 + kstep;
            if (last && has_next) S.a_ready(nxt);
            if constexpr (SP2) {
            PG8_LDB(B0, 0, 0); PG8_LDB(B1, 0, 1); PG8_SCHED; PG8_LDA(At, 0, 0); PG8_STAGE(PG8_SA(1, 1), a1 + hstep, voffA);
            PG8_WAIT_V(8); PG8_WAIT_L(0); PG8_BAR; PG8_MMA(0, 0, At, B0); PG8_MMA(0, 1, At, B1); PG8_BAR; PG8_SCHED;
            PG8_LDA(At, 0, 1); PG8_STAGE(PG8_SB(0, 0), b2, voffB); PG8_STAGE(PG8_SB(0, 1), b2 + hstep, voffB); PG8_STAGE(PG8_SA(0, 0), a2, voffA);
            PG8_WAIT_V(8); PG8_WAIT_L(0); PG8_BAR; PG8_MMA(1, 0, At, B0); PG8_MMA(1, 1, At, B1); PG8_BAR; PG8_SCHED;
            PG8_LDB(B0, 1, 0); PG8_LDB(B1, 1, 1); PG8_SCHED; PG8_LDA(At, 1, 0); PG8_STAGE(PG8_SA(0, 1), a2 + hstep, voffA);
            PG8_WAIT_V(8); PG8_WAIT_L(0); PG8_BAR; PG8_MMA(0, 0, At, B0); PG8_MMA(0, 1, At, B1); PG8_BAR; PG8_SCHED;
            PG8_LDA(At, 1, 1); PG8_STAGE(PG8_SB(1, 0), b3, voffB); PG8_STAGE(PG8_SB(1, 1), b3 + hstep, voffB); PG8_STAGE(PG8_SA(1, 0), a3, voffA);
            PG8_WAIT_V(8); PG8_WAIT_L(0); PG8_BAR; PG8_MMA(1, 0, At, B0); PG8_MMA(1, 1, At, B1); PG8_BAR; PG8_SCHED;
            } else {
            PG8_LDB(B0, 0, 0); PG8_SCHED; PG8_LDA(At, 0, 0); PG8_STAGE(PG8_SA(1, 1), a1 + hstep, voffA);
            PG8_WAIT_L(8); PG8_BAR; PG8_WAIT_L(0); PG8_MMA(0, 0, At, B0); PG8_BAR; PG8_SCHED;
            PG8_LDB(B1, 0, 1); PG8_STAGE(PG8_SB(0, 0), b2, voffB);
            PG8_BAR; PG8_WAIT_L(0); PG8_MMA(0, 1, At, B1); PG8_BAR;
            PG8_LDA(At, 0, 1); PG8_STAGE(PG8_SA(0, 0), a2, voffA);
            PG8_BAR; PG8_WAIT_L(0); PG8_MMA(1, 0, At, B0); PG8_BAR; PG8_SCHED;
            PG8_STAGE(PG8_SB(0, 1), b2 + hstep, voffB);
            PG8_WAIT_V(6); PG8_BAR; PG8_MMA(1, 1, At, B1); PG8_BAR;
            PG8_LDB(B0, 1, 0); PG8_SCHED; PG8_LDA(At, 1, 0); PG8_STAGE(PG8_SA(0, 1), a2 + hstep, voffA);
            PG8_WAIT_L(8); PG8_BAR; PG8_WAIT_L(0); PG8_MMA(0, 0, At, B0); PG8_BAR; PG8_SCHED;
            PG8_LDB(B1, 1, 1); PG8_STAGE(PG8_SB(1, 0), b3, voffB);
            PG8_BAR; PG8_WAIT_L(0); PG8_MMA(0, 1, At, B1); PG8_BAR;
            PG8_LDA(At, 1, 1); PG8_STAGE(PG8_SA(1, 0), a3, voffA);
            PG8_BAR; PG8_WAIT_L(0); PG8_MMA(1, 0, At, B0); PG8_BAR; PG8_SCHED;
            PG8_STAGE(PG8_SB(1, 1), b3 + hstep, voffB);
            PG8_WAIT_V(6); PG8_BAR; PG8_MMA(1, 1, At, B1); PG8_BAR;
            }
        }
        if constexpr (ALIGN_EPI) { if (wr == 0) PG8_BAR; }
        if constexpr (!Epi::AFTER_DRAIN) { E(acc, cur, wr, wc, fr, fq); S.done(cur); }
        if (!has_next) break;
#pragma unroll
        for (int a = 0; a < 2; ++a)
#pragma unroll
            for (int b = 0; b < 2; ++b)
#pragma unroll
                for (int m = 0; m < 4; ++m)
#pragma unroll
                    for (int n = 0; n < 2; ++n) acc[a][b][m][n] = (f32x4){0.f, 0.f, 0.f, 0.f};
        cur = nxt; cA = nA; cB = nB; ++ui;
        if constexpr (Sched::SPLITK) cnt = S.ktiles(cur, nt);
        if constexpr (ALIGN_EPI) { if (wr == 1) PG8_BAR; }
    }
    PG8_WAIT_V(0);
    S.flush();
    if constexpr (!ALIGN_EPI) { if (wr == 0) PG8_BAR; }
    PG8_BAR;
    if constexpr (Epi::AFTER_DRAIN) { E.fused(acc, cur, wr, wc, fr, fq, lds, wid, lane); S.done(cur); }
#undef PG8_SA
#undef PG8_SB
#undef PG8_STAGE
#undef PG8_LDA
#undef PG8_LDB
#undef PG8_MMA
#undef PG8_WAIT_V
#undef PG8_WAIT_L
#undef PG8_BAR
#undef PG8_SCHED
}
}

namespace pg8 {
struct EpiSwiglu {
    static constexpr bool PERM = true, AFTER_DRAIN = false;
    bf16_t* O; int ldo; int p0; int nct;
    __device__ __forceinline__ void operator()(const f32x4 (&acc)[2][2][4][2], const Unit& u, int wr, int wc, int fr, int fq) const {
        const int row0 = (u.pm - p0) * BM + wr * 64 + fr, col0 = (u.pn % nct) * HALF + wc * 32 + 8 * fq;
#pragma unroll
        for (int ai = 0; ai < 2; ++ai)
#pragma unroll
            for (int m = 0; m < 4; ++m) { bf16_t* rowp = O + (size_t)(row0 + ai * HALF + m * 16) * ldo + col0;
                float a[8];
#pragma unroll
                for (int n = 0; n < 2; ++n)
#pragma unroll
                    for (int j = 0; j < 4; ++j) { const float g = acc[ai][0][m][n][j], up = acc[ai][1][m][n][j]; a[n * 4 + j] = g * __builtin_amdgcn_rcpf(1.0f + __expf(-g)) * up; }
                u32x4 w; w.x = cvt_pk_bf16(a[0], a[1]); w.y = cvt_pk_bf16(a[2], a[3]); w.z = cvt_pk_bf16(a[4], a[5]); w.w = cvt_pk_bf16(a[6], a[7]);
                *(u32x4*)rowp = w; }
    }
};
struct EpiBf16Mod {
    static constexpr bool PERM = true, AFTER_DRAIN = false;
    bf16_t* O; int ldc; int nct;
    __device__ __forceinline__ void operator()(const f32x4 (&acc)[2][2][4][2], const Unit& u, int wr, int wc, int fr, int fq) const {
        const int row0 = u.pm * BM + wr * 64 + fr, col0 = (u.pn % nct) * BM + wc * 32 + 8 * fq;
#pragma unroll
        for (int ai = 0; ai < 2; ++ai)
#pragma unroll
            for (int m = 0; m < 4; ++m) { bf16_t* rowp = O + (size_t)(row0 + ai * HALF + m * 16) * ldc + col0;
#pragma unroll
                for (int bj = 0; bj < 2; ++bj) { const f32x4 v0 = acc[ai][bj][m][0], v1 = acc[ai][bj][m][1];
                    u32x4 w; w.x = cvt_pk_bf16(v0[0], v0[1]); w.y = cvt_pk_bf16(v0[2], v0[3]); w.z = cvt_pk_bf16(v1[0], v1[1]); w.w = cvt_pk_bf16(v1[2], v1[3]);
                    *(u32x4*)(rowp + bj * HALF) = w; } }
    }
};
struct MoeOrder {
    static constexpr bool SPLITK = false;
    int p0, np, nct, G, c; int pb[9];
    __device__ __forceinline__ bool next(int i, Unit& u) const {
        const int L = i * G + c; if (L >= np * nct) return false;
        const int nig = WGM * nct, gid = L / nig, fm = gid * WGM, gsz = (np - fm) < WGM ? (np - fm) : WGM, r = L % nig;
        const int pm = p0 + fm + (r % gsz), ct = r / gsz;
        int e = 0;
#pragma unroll
        for (int j = 1; j < 8; ++j) e += (pm >= pb[j]) ? 1 : 0;
        u.pm = pm; u.pn = e * nct + ct; return true;
    }
    __device__ __forceinline__ void a_ready(const Unit&) const {}
    __device__ __forceinline__ void done(const Unit&) const {}
    __device__ __forceinline__ void flush() const {}
};
#ifndef WT_AUX
#define WT_AUX 16
#endif
struct EpiBf16WT {
    static constexpr bool PERM = true, AFTER_DRAIN = false;
    bf16_t* O; int ldc; int nct;
    __device__ __forceinline__ void operator()(const f32x4 (&acc)[2][2][4][2], const Unit& u, int wr, int wc, int fr, int fq) const {
        const __amdgpu_buffer_rsrc_t rs = __builtin_amdgcn_make_buffer_rsrc(O, 0, 0x7ffffff0, 0x00020000);
        const unsigned row0 = (unsigned)(u.pm * BM + wr * 64 + fr), col0 = (unsigned)((u.pn % nct) * BM + wc * 32 + 8 * fq);
#pragma unroll
        for (int ai = 0; ai < 2; ++ai)
#pragma unroll
            for (int m = 0; m < 4; ++m) { const unsigned off = ((row0 + (unsigned)(ai * HALF + m * 16)) * (unsigned)ldc + col0) * 2u;
#pragma unroll
                for (int bj = 0; bj < 2; ++bj) { const f32x4 v0 = acc[ai][bj][m][0], v1 = acc[ai][bj][m][1];
                    u32x4 w; w.x = cvt_pk_bf16(v0[0], v0[1]); w.y = cvt_pk_bf16(v0[2], v0[3]); w.z = cvt_pk_bf16(v1[0], v1[1]); w.w = cvt_pk_bf16(v1[2], v1[3]);
                    __builtin_amdgcn_raw_buffer_store_b128(w, rs, off + (unsigned)(bj * HALF * 2), 0, WT_AUX); } }
    }
};
constexpr int SPLIT_FLAG = 1 << 14;
struct SplitOrder {
    static constexpr bool SPLITK = true;
    int p0, np, nct, G, c; int pb[9];
    int nfull, S;
    __device__ __forceinline__ void init_split(int S_) { const int nu = np * nct, R = nu / G, T = nu - R * G; if (S_ > 1 && R >= 1 && T > 0 && T * S_ <= G && (T % nct) == 0) { nfull = R * G; S = S_; } else { nfull = nu; S = 1; } }
    __device__ __forceinline__ int tail_panels() const { return (np * nct - nfull) / nct; }
    __device__ __forceinline__ bool next(int i, Unit& u) const {
        const int L = i * G + c; int pm, ct, ks = -1;
        if (L < nfull) { const int nig = WGM * nct, gid = L / nig, fm = gid * WGM, gsz = (np - fm) < WGM ? (np - fm) : WGM, r = L % nig; pm = p0 + fm + (r % gsz); ct = r / gsz; }
        else { if (S == 1) return false; const int j = L - nfull, tp = tail_panels(); if (j >= tp * nct * S) return false; const int rest = j / tp; pm = p0 + nfull / nct + (j % tp); ct = rest % nct; ks = rest / nct; }
        int e = 0;
#pragma unroll
        for (int j = 1; j < 8; ++j) e += (pm >= pb[j]) ? 1 : 0;
        u.pm = pm; u.pn = ks < 0 ? (e * nct + ct) : (SPLIT_FLAG | (ks << 6) | (e * nct + ct)); return true;
    }
    __device__ __forceinline__ int ktiles(const Unit& u, int nt) const { if (!(u.pn & SPLIT_FLAG)) return nt; const int ks = (u.pn >> 6) & 15, pairs = nt >> 1, q = pairs / S, r = pairs - q * S; return 2 * (q + (ks < r ? 1 : 0)); }
    __device__ __forceinline__ size_t kbyte(const Unit& u, int nt) const { if (!(u.pn & SPLIT_FLAG)) return 0; const int ks = (u.pn >> 6) & 15, pairs = nt >> 1, q = pairs / S, r = pairs - q * S; return (size_t)(ks * q + (ks < r ? ks : r)) * (2 * BK * 2); }
    __device__ __forceinline__ int btile(const Unit& u) const { return u.pn & 63; }
    __device__ __forceinline__ void a_ready(const Unit&) const {}
    __device__ __forceinline__ void done(const Unit&) const {}
    __device__ __forceinline__ void flush() const {}
};
struct EpiSplitWT {
    static constexpr bool PERM = true, AFTER_DRAIN = false;
    bf16_t* O; int ldc; int nct; float* part; int ptail0; int tail_rows;
    __device__ __forceinline__ void operator()(const f32x4 (&acc)[2][2][4][2], const Unit& u, int wr, int wc, int fr, int fq) const {
        const unsigned col0 = (unsigned)(((u.pn & 63) % nct) * BM + wc * 32 + 8 * fq);
        if (!(u.pn & SPLIT_FLAG)) {
            const __amdgpu_buffer_rsrc_t rs = __builtin_amdgcn_make_buffer_rsrc(O, 0, 0x7ffffff0, 0x00020000);
            const unsigned row0 = (unsigned)(u.pm * BM + wr * 64 + fr);
#pragma unroll
            for (int ai = 0; ai < 2; ++ai)
#pragma unroll
                for (int m = 0; m < 4; ++m) { const unsigned off = ((row0 + (unsigned)(ai * HALF + m * 16)) * (unsigned)ldc + col0) * 2u;
#pragma unroll
                    for (int bj = 0; bj < 2; ++bj) { const f32x4 v0 = acc[ai][bj][m][0], v1 = acc[ai][bj][m][1];
                        u32x4 w; w.x = cvt_pk_bf16(v0[0], v0[1]); w.y = cvt_pk_bf16(v0[2], v0[3]); w.z = cvt_pk_bf16(v1[0], v1[1]); w.w = cvt_pk_bf16(v1[2], v1[3]);
                        __builtin_amdgcn_raw_buffer_store_b128(w, rs, off + (unsigned)(bj * HALF * 2), 0, WT_AUX); } }
        } else {
            const __amdgpu_buffer_rsrc_t rs = __builtin_amdgcn_make_buffer_rsrc(part, 0, 0x7ffffff0, 0x00020000);
            const unsigned row0 = (unsigned)(((u.pn >> 6) & 15) * tail_rows + (u.pm - ptail0) * BM + wr * 64 + fr);
#pragma unroll
            for (int ai = 0; ai < 2; ++ai)
#pragma unroll
                for (int m = 0; m < 4; ++m) { const unsigned off = ((row0 + (unsigned)(ai * HALF + m * 16)) * (unsigned)ldc + col0) * 4u;
#pragma unroll
                    for (int bj = 0; bj < 2; ++bj) {
                        __builtin_amdgcn_raw_buffer_store_b128(__builtin_bit_cast(u32x4, acc[ai][bj][m][0]), rs, off + (unsigned)(bj * HALF * 4), 0, WT_AUX);
                        __builtin_amdgcn_raw_buffer_store_b128(__builtin_bit_cast(u32x4, acc[ai][bj][m][1]), rs, off + (unsigned)(bj * HALF * 4 + 16), 0, WT_AUX); } }
        }
    }
};
template <class Base> struct PubOrder : Base {
    unsigned* cntr; mutable int pend;
    __device__ __forceinline__ void pub() const {
        if (pend >= 0) { if (__builtin_amdgcn_mbcnt_hi(~0u, __builtin_amdgcn_mbcnt_lo(~0u, 0u)) == 0u) __hip_atomic_fetch_add(cntr + 16 * pend, 1u, __ATOMIC_RELAXED, __HIP_MEMORY_SCOPE_AGENT); pend = -1; }
    }
    __device__ __forceinline__ void a_ready(const Unit& u) const { Base::a_ready(u); pub(); }
    __device__ __forceinline__ void done(const Unit& u) const {
#ifdef PUB_EAGER
        asm volatile("s_waitcnt vmcnt(0)" ::: "memory"); pend = u.pm; pub();
#else
        pub(); pend = u.pm;
#endif
    }
    __device__ __forceinline__ void flush() const { pub(); }
};
}

constexpr int NWAVES = 8, NTHR = 512;
constexpr int D = 1024, NB = 8, SEQ = 4096, LC = 256, NT = NB * SEQ, NC = NB * LC, MT = NT + NC;
constexpr int DIN = 2944, NZ = 3072;
constexpr int C_K = 0, C_V = 512, C_WLO = 1024, C_ALO = 1152, C_R = 1280, C_GLO = 1792, C_U = 1920, C_GB = 2176, C_GC = 2432, C_F = 2688;
constexpr int DFF = 2816, NE = 8, DFE = 3584;
constexpr float NORM_EPS = 1e-6f, GN_EPS = 64e-5f;
constexpr int TP = 72;
enum { I_X = 0, I_C, I_CTX, I_CCTX, I_ADAW, I_ADAB, I_NORMG, I_WIN, I_WOUT, I_MU, I_MUW, I_MUA, I_W0, I_W2, I_A0, I_A2, I_G2, I_KK, I_KA, I_RK, I_GNW, I_GNB, I_CONVW,
       I_FG, I_FU, I_FD, I_RW, I_RB, I_MG, I_MUP, I_MD, N_IN };

constexpr size_t KiB = 1024, MiB = 1u << 20;
constexpr size_t WS_CTL = 0, CTL_ZERO_BYTES = 512 * KiB;
constexpr size_t WS_MOD = 512 * KiB;
constexpr size_t WS_TAB = 960 * KiB;
constexpr size_t TAB_E = WS_TAB;
constexpr size_t TAB_TWC = TAB_E + 64 * 512 * 4;
constexpr size_t TAB_TWS = TAB_TWC + 4096 * 4;
constexpr size_t TAB_C64 = TAB_TWS + 4096 * 4;
constexpr size_t TAB_S64 = TAB_C64 + 64 * 64 * 2;
constexpr size_t TAB_SN64 = TAB_S64 + 64 * 64 * 2;
constexpr size_t WS_ROUTE = 1152 * KiB;
constexpr size_t WS_TOKPOS = WS_ROUTE + (size_t)NT * 16;
static_assert(TAB_SN64 + 64 * 64 * 2 <= WS_ROUTE && WS_TOKPOS + (size_t)NT * 8 <= 2 * MiB, "low ws map");
constexpr size_t WS_Z = 2 * MiB;
constexpr size_t WS_SW = 206 * MiB;
constexpr size_t WS_WIN = WS_SW;
constexpr size_t WS_WOUT = WS_WIN + 2ull * NZ * D * 2;
constexpr size_t WS_WGU = WS_WOUT + 2ull * D * D * 2;
constexpr size_t WS_WDN = WS_WGU + 2ull * DFF * D * 2;
constexpr size_t WS_G2T = WS_WDN + (size_t)D * DFF * 2;
constexpr size_t WS_C256 = WS_G2T + 2ull * 512 * 128 * 2;
constexpr size_t WS_SN256 = WS_C256 + 256 * 256 * 2;
constexpr size_t WS_W2TG = WS_SN256 + 256 * 256 * 2;
constexpr size_t WS_A2TG = WS_W2TG + 4ull * 512 * 64 * 2;
constexpr size_t WS_XC = 244 * MiB;
static_assert(WS_A2TG + 4ull * 512 * 64 * 2 <= WS_XC, "small weights");
constexpr size_t WS_RING = 252 * MiB;
constexpr size_t WS_O32 = 381 * MiB;
constexpr size_t WS_YS = WS_O32;
constexpr size_t WS_YBUF = WS_YS + 2ull * MT * 512 * 2;
constexpr size_t WS_PARTD = WS_YBUF;
constexpr size_t WS_BONG = WS_YBUF + 32 * MiB;
constexpr size_t WS_H = 517 * MiB;
static_assert(WS_BONG + 2ull * MT * 8 * 4 <= WS_H && WS_Z + (size_t)MT * NZ * 2 <= WS_SW && WS_O32 + (size_t)MT * D * 4 <= WS_H, "ws map");
constexpr size_t WS_NEED = 585 * MiB;
static_assert(WS_H + (size_t)MT * D * 2 <= WS_NEED, "ws map end");
constexpr size_t WS_WMGU = 2 * MiB;
constexpr size_t WS_WMDN = WS_WMGU + 8ull * 2 * DFE * D * 2;
constexpr size_t WS_XG = 170 * MiB;
constexpr int XG_ROWS_CAP = 69632;
constexpr size_t WS_ACTM = 306 * MiB;
static_assert(WS_WMDN + 8ull * D * DFE * 2 <= WS_XG && WS_XG + (size_t)XG_ROWS_CAP * D * 2 <= WS_ACTM, "moe ws map");
constexpr int CW_TMO = 0;
constexpr int CW_CNT = 2048, CW_FILL = 3072;
constexpr int CW_BAR = 8192;
constexpr int MAX_LAUNCHES = 20;
constexpr int CW_PROD = 81920, CW_CONS = 81920 + 8192;
constexpr int CW_PCNT = 114688;
constexpr int PC_WOUT0 = 0, PC_DOWN0 = 2176, PC_WOUT1 = 4352, PC_MOE = 6528;
static_assert(CW_CONS + 16384 + 64 * 128 <= CW_PCNT && (CW_PCNT + PC_MOE + 16 * 272) * 4 <= (int)CTL_ZERO_BYTES, "control words");

constexpr int LDS_BYTES = 163840;
constexpr int MISC_OFF = LDS_BYTES - 256;

#define GAS __attribute__((address_space(1)))
#define LAS __attribute__((address_space(3)))
typedef unsigned short bf16;
typedef unsigned v4u __attribute__((ext_vector_type(4)));
typedef unsigned v2u __attribute__((ext_vector_type(2)));
typedef float f32x4 __attribute__((ext_vector_type(4)));
typedef float f32x2 __attribute__((ext_vector_type(2)));
typedef short bf16x8 __attribute__((ext_vector_type(8)));
typedef short bf16x4 __attribute__((ext_vector_type(4)));
#define LDS_WAIT() asm volatile("s_waitcnt lgkmcnt(0)" ::: "memory")
typedef __bf16 bf16x2n __attribute__((ext_vector_type(2)));
__device__ __forceinline__ unsigned pk2(float lo, float hi) { const f32x2 v = {lo, hi}; return __builtin_bit_cast(unsigned, __builtin_convertvector(v, bf16x2n)); }
__device__ __forceinline__ unsigned f2bf(float f) { return pk2(f, f) & 0xffffu; }
__device__ __forceinline__ float bflo(unsigned w) { return __builtin_bit_cast(float, w << 16); }
__device__ __forceinline__ float bfhi(unsigned w) { return __builtin_bit_cast(float, w & 0xffff0000u); }
__device__ __forceinline__ float bf1(bf16 b) { return __builtin_bit_cast(float, (unsigned)b << 16); }
template <int CTRL> __device__ __forceinline__ float dpp_mov(float v) { return __builtin_bit_cast(float, __builtin_amdgcn_update_dpp(0, __builtin_bit_cast(int, v), CTRL, 0xf, 0xf, true)); }
__device__ __forceinline__ float wave_sum(float v) {
    v += dpp_mov<0xB1>(v); v += dpp_mov<0x4E>(v); v += dpp_mov<0x141>(v); v += dpp_mov<0x140>(v);
    const int b = __builtin_bit_cast(int, v);
    const float s0 = __builtin_bit_cast(float, __builtin_amdgcn_readlane(b, 0)), s1 = __builtin_bit_cast(float, __builtin_amdgcn_readlane(b, 16));
    const float s2 = __builtin_bit_cast(float, __builtin_amdgcn_readlane(b, 32)), s3 = __builtin_bit_cast(float, __builtin_amdgcn_readlane(b, 48));
    return (s0 + s1) + (s2 + s3);
}
__device__ __forceinline__ float sigmoidf_(float x) { return __builtin_amdgcn_rcpf(1.0f + __expf(-x)); }
#define MFMA16(a, b, c) __builtin_amdgcn_mfma_f32_16x16x32_bf16((a), (b), (c), 0, 0, 0)
#define XB_TMO      128
#define XB_XCNT(j)  (256  + 64 * (j))
#define XB_XSUB(j)  (1280 + 64 * (j))
#define XB_XGEN(j)  (2304 + 64 * (j))
#define XB_TOP      3328
#define XB_TOPGEN   3392
#define XCD_BAR_WORDS 3456
#define XB_SPIN_CAP (1u << 18)
#define LAS __attribute__((address_space(3)))

__device__ __forceinline__ unsigned xb_ld(unsigned* p)              { return __hip_atomic_load(p, __ATOMIC_RELAXED, __HIP_MEMORY_SCOPE_AGENT); }
__device__ __forceinline__ unsigned xb_add(unsigned* p, unsigned v) { return __hip_atomic_fetch_add(p, v, __ATOMIC_RELAXED, __HIP_MEMORY_SCOPE_AGENT); }
__device__ __forceinline__ unsigned xb_xcc_id() { return (unsigned)__builtin_amdgcn_s_getreg((3 << 11) | 20) & 0xFu; }
#define XB_SPIN(cond, bar) do { unsigned _sp = 0; while (cond) { __builtin_amdgcn_s_sleep(1); \
    if ((++_sp & 255u) == 0u) { if (xb_ld(&(bar)[XB_TMO])) break; if (_sp > XB_SPIN_CAP) { atomicAdd(&(bar)[XB_TMO], 1u); break; } } } } while (0)

struct XcdBarrier {
    unsigned w0;
    unsigned* bar; unsigned x;
    volatile LAS unsigned* st;
};

__device__ __forceinline__ bool xb_lane0() { return __builtin_amdgcn_mbcnt_hi(~0u, __builtin_amdgcn_mbcnt_lo(~0u, 0u)) == 0u; }
__device__ __forceinline__ XcdBarrier xcd_barrier_post(unsigned* bar, volatile LAS unsigned* st, unsigned w0) {
    XcdBarrier b; b.w0 = w0; b.bar = bar; b.x = xb_xcc_id(); b.st = st;
    if (w0 && xb_lane0()) (void)xb_add(&bar[XB_XCNT(b.x)], 1u);
    return b;
}
__device__ __forceinline__ void xcd_barrier_complete(unsigned* bar, unsigned x, unsigned& nloc, unsigned& nx) {
    const unsigned G = gridDim.x * gridDim.y * gridDim.z;
    unsigned sum, cnt, mine, sp = 0u;
    for (;;) {
        sum = 0u; cnt = 0u; mine = 0u;
#pragma unroll
        for (unsigned j = 0; j < 16; ++j) { const unsigned c = xb_ld(&bar[XB_XCNT(j)]); sum += c; cnt += (c > 0u) ? 1u : 0u; mine = (j == x) ? c : mine; }
        if (sum == G) break;
        __builtin_amdgcn_s_sleep(1);
        if ((++sp & 255u) == 0u) { if (xb_ld(&bar[XB_TMO])) break; if (sp > XB_SPIN_CAP) { atomicAdd(&bar[XB_TMO], 1u); break; } }
    }
    nloc = mine > 0u ? mine : 1u; nx = cnt > 0u ? cnt : 1u;
}

__device__ __forceinline__ void xcd_barrier(const XcdBarrier& b) {
    asm volatile("s_waitcnt vmcnt(0)" ::: "memory");
    __syncthreads();
    if (b.w0 && xb_lane0()) {
        unsigned* bar = b.bar;
        __builtin_amdgcn_s_waitcnt(0);
        unsigned nloc = b.st[0], nx = b.st[1];
        if (nloc == 0u) { xcd_barrier_complete(bar, b.x, nloc, nx); b.st[0] = nloc; b.st[1] = nx; }
        const unsigned old = xb_add(&bar[XB_XSUB(b.x)], 1u);
        const unsigned gen = old / nloc;
        if (old + 1u == (gen + 1u) * nloc) {
            __builtin_amdgcn_fence(__ATOMIC_RELEASE, "agent");
            asm volatile("s_waitcnt vmcnt(0)" ::: "memory");
            const unsigned og = xb_add(&bar[XB_TOP], 1u);
            const unsigned tg = og / nx;
            if (og + 1u == (tg + 1u) * nx) xb_add(&bar[XB_TOPGEN], 1u);
            else XB_SPIN(xb_ld(&bar[XB_TOPGEN]) == tg, bar);
            __builtin_amdgcn_fence(__ATOMIC_ACQUIRE, "agent");
            xb_add(&bar[XB_XGEN(b.x)], 1u);
            asm volatile("s_waitcnt vmcnt(0)" ::: "memory");
        } else {
            XB_SPIN(xb_ld(&bar[XB_XGEN(b.x)]) == gen, bar);
            __builtin_amdgcn_fence(__ATOMIC_ACQUIRE, "agent");
            asm volatile("s_waitcnt vmcnt(0)" ::: "memory");
        }
    }
    __syncthreads();
}


struct Params {
    const float* in[N_IN];
    float* out;
    unsigned char* ws;
    int act_cap_panels;
    int ph_lo, ph_hi, li;
};
static_assert(sizeof(Params) == N_IN * 8 + 8 + 8 + 16, "Params has no padding");

struct Frame {
    LAS unsigned char* lds;
    int tid, lane, wave, G, bx;
};
#define WSP(T, off) ((T*)(P.ws + (off)))

__device__ __forceinline__ void transpose_item(const float* W, int N, bf16* WT, int ldk, int k0, int n0, int out_row0, LAS float* scr, int lane) {
#pragma unroll 8
    for (int i = 0; i < 32; ++i) { const int kk = 2 * i + (lane >> 5); scr[kk * 33 + (lane & 31)] = W[(size_t)(k0 + kk) * N + n0 + (lane & 31)]; }
    LDS_WAIT(); asm volatile("" ::: "memory");
    const int c = lane & 7;
#pragma unroll
    for (int j = 0; j < 4; ++j) { const int n = (lane >> 3) + 8 * j; const LAS float* s = scr + (8 * c) * 33 + n;
        v4u o; o.x = pk2(s[0 * 33], s[1 * 33]); o.y = pk2(s[2 * 33], s[3 * 33]); o.z = pk2(s[4 * 33], s[5 * 33]); o.w = pk2(s[6 * 33], s[7 * 33]);
        *(v4u*)(WT + (size_t)(out_row0 + n) * ldk + k0 + 8 * c) = o; }
    LDS_WAIT(); asm volatile("" ::: "memory");
}
__device__ __forceinline__ int gu_row(int n, int up) { return (n >> 7) * 256 + up * 128 + (n & 127); }

__device__ __forceinline__ void p0_small_weights(const Params& P, const Frame& F) {
    LAS float* scr = (LAS float*)(F.lds + F.wave * 16384);
    const int gw = F.bx * NWAVES + F.wave, NGW = F.G * NWAVES;
    constexpr int I_IN = 16 * 92, I_OUT = 16 * 32, I_GU = 16 * 88, I_DN = 44 * 32, I_GT = 2 * 16, I_LR = 16;
    constexpr int NITEMS = 2 * I_IN + 2 * I_OUT + 2 * I_GU + I_DN + 2 * I_GT + 8 * I_LR;
    for (int it = gw; it < NITEMS; it += NGW) {
        int r = it;
        if (r < 2 * I_IN) { const int l = r / I_IN; r %= I_IN; const int kb = r / 92, nb = r % 92;
            transpose_item(P.in[I_WIN] + (size_t)l * D * DIN, DIN, WSP(bf16, WS_WIN) + (size_t)l * NZ * D, D, 64 * kb, 32 * nb, 32 * nb, scr, F.lane); continue; } r -= 2 * I_IN;
        if (r < 2 * I_OUT) { const int l = r / I_OUT; r %= I_OUT; const int kb = r / 32, nb = r % 32;
            transpose_item(P.in[I_WOUT] + (size_t)l * D * D, D, WSP(bf16, WS_WOUT) + (size_t)l * D * D, D, 64 * kb, 32 * nb, 32 * nb, scr, F.lane); continue; } r -= 2 * I_OUT;
        if (r < 2 * I_GU) { const int up = r / I_GU; r %= I_GU; const int kb = r / 88, nb = r % 88;
            transpose_item(P.in[up ? I_FU : I_FG], DFF, WSP(bf16, WS_WGU), D, 64 * kb, 32 * nb, gu_row(32 * nb, up), scr, F.lane); continue; } r -= 2 * I_GU;
        if (r < I_DN) { const int kb = r / 32, nb = r % 32;
            transpose_item(P.in[I_FD], D, WSP(bf16, WS_WDN), DFF, 64 * kb, 32 * nb, 32 * nb, scr, F.lane); continue; } r -= I_DN;
        if (r < 2 * I_GT) { const int l = r / I_GT; r %= I_GT; const int kb = r / 16, nb = r % 16;
            transpose_item(P.in[I_G2] + (size_t)l * 128 * 512, 512, WSP(bf16, WS_G2T) + (size_t)l * 512 * 128, 128, 64 * kb, 32 * nb, 32 * nb, scr, F.lane); continue; } r -= 2 * I_GT;
        { const int which = r / (4 * I_LR); r %= 4 * I_LR; const int ldi = r / I_LR, nb = r % I_LR;
            transpose_item(P.in[which ? I_A2 : I_W2] + (size_t)ldi * 64 * 512, 512, WSP(bf16, which ? WS_A2TG : WS_W2TG) + (size_t)ldi * 512 * 64, 64, 0, 32 * nb, 32 * nb, scr, F.lane); }
    }
    { const int gt = F.bx * NTHR + F.tid, NGT = F.G * NTHR; constexpr int NV = 2 * (NZ - DIN) * D / 8;
        for (int i = gt; i < NV; i += NGT) { const int l = i / ((NZ - DIN) * D / 8), r = i % ((NZ - DIN) * D / 8);
            *(v4u*)(WSP(bf16, WS_WIN) + (size_t)l * NZ * D + (size_t)DIN * D + (size_t)r * 8) = (v4u){0u, 0u, 0u, 0u}; } }
}
__device__ __forceinline__ void p0_tables(const Params& P, const Frame& F) {
    const int gt = F.bx * NTHR + F.tid, NGT = F.G * NTHR;
    float* E = WSP(float, TAB_E);
    for (int i = gt; i < 64 * 256; i += NGT) { const int n = i >> 8, q = i & 255;
        const float omega = 1.0f / powf(10000.0f, (float)q / 256.0f), ang = (float)n * omega;
        E[n * 512 + q] = sinf(ang); E[n * 512 + 256 + q] = cosf(ang); }
    float* twc = WSP(float, TAB_TWC); float* tws = WSP(float, TAB_TWS);
    for (int i = gt; i < 4096; i += NGT) { const float a = (float)i / 2048.0f; twc[i] = cospif(a); tws[i] = sinpif(a); }
    bf16* c64 = WSP(bf16, TAB_C64); bf16* s64 = WSP(bf16, TAB_S64); bf16* sn64 = WSP(bf16, TAB_SN64);
    for (int i = gt; i < 64 * 64; i += NGT) { const int m = ((i >> 6) * (i & 63)) & 63; const float a = (float)m / 32.0f; const float c = cospif(a), s = sinpif(a);
        c64[i] = (bf16)f2bf(c); s64[i] = (bf16)f2bf(s); sn64[i] = (bf16)f2bf(-s); }
    bf16* c256 = WSP(bf16, WS_C256); bf16* sn256 = WSP(bf16, WS_SN256);
    for (int i = gt; i < 256 * 256; i += NGT) { const int m = ((i >> 8) * (i & 255)) & 255; const float a = (float)m / 128.0f;
        c256[i] = (bf16)f2bf(cospif(a)); sn256[i] = (bf16)f2bf(-sinpif(a)); }
}
__device__ __forceinline__ void p0_adaln(const Params& P, const Frame& F) {
    LAS float* sc = (LAS float*)F.lds;
    LAS float* red = sc + 9 * 1024;
    for (int u = F.bx; u < 192; u += F.G) {
        const int l = u / 96, cb = u % 96;
        for (int i = F.tid; i < 9 * 1024; i += NTHR) { const int r = i >> 10, d = i & 1023; const float v = r < 8 ? P.in[I_C][r * 1024 + d] : P.in[I_CCTX][d]; sc[i] = v / (1.0f + expf(-v)); }
        __syncthreads();
        const int col = F.tid & 63, ks = F.tid >> 6;
        float acc[9];
#pragma unroll
        for (int r = 0; r < 9; ++r) acc[r] = 0.f;
        const float* w = P.in[I_ADAW] + ((size_t)l * 1024 + ks * 128) * 6144 + cb * 64 + col;
#pragma unroll 2
        for (int k = 0; k < 128; k += 8) {
            float wv[8];
#pragma unroll
            for (int q = 0; q < 8; ++q) wv[q] = w[(size_t)(k + q) * 6144];
#pragma unroll
            for (int r = 0; r < 9; ++r) { const f32x4 s4 = *(const LAS f32x4*)(sc + r * 1024 + ks * 128 + k), s5 = *(const LAS f32x4*)(sc + r * 1024 + ks * 128 + k + 4);
                acc[r] += (s4.x * wv[0] + s4.y * wv[1] + s4.z * wv[2] + s4.w * wv[3]) + (s5.x * wv[4] + s5.y * wv[5] + s5.z * wv[6] + s5.w * wv[7]); }
        }
#pragma unroll
        for (int r = 0; r < 9; ++r) red[(ks * 9 + r) * 64 + col] = acc[r];
        __syncthreads();
        for (int i = F.tid; i < 9 * 64; i += NTHR) { const int r = i >> 6, c = i & 63; float s = 0.f;
#pragma unroll
            for (int k = 0; k < 8; ++k) s += red[(k * 9 + r) * 64 + c];
            WSP(float, WS_MOD)[(size_t)(l * 9 + r) * 6144 + cb * 64 + c] = s + P.in[I_ADAB][l * 6144 + cb * 64 + c]; }
        __syncthreads();
    }
}
__device__ __forceinline__ void convert_moe_weights(const Params& P, const Frame& F) {
    LAS float* scr = (LAS float*)(F.lds + F.wave * 16384);
    const int gw = F.bx * NWAVES + F.wave, NGW = F.G * NWAVES;
    constexpr int I_GU = 16 * 112, I_DN = 56 * 32, NITEMS = NE * (2 * I_GU + I_DN);
    for (int it = gw; it < NITEMS; it += NGW) {
        const int e = it / (2 * I_GU + I_DN); int r = it % (2 * I_GU + I_DN);
        if (r < 2 * I_GU) { const int up = r / I_GU; r %= I_GU; const int kb = r / 112, nb = r % 112;
            transpose_item(P.in[up ? I_MUP : I_MG] + (size_t)e * D * DFE, DFE, WSP(bf16, WS_WMGU) + (size_t)e * 2 * DFE * D, D, 64 * kb, 32 * nb, gu_row(32 * nb, up), scr, F.lane); }
        else { r -= 2 * I_GU; const int kb = r / 32, nb = r % 32;
            transpose_item(P.in[I_MD] + (size_t)e * DFE * D, D, WSP(bf16, WS_WMDN) + (size_t)e * D * DFE, DFE, 64 * kb, 32 * nb, 32 * nb, scr, F.lane); }
    }
}

__device__ __forceinline__ void store_h_row(bf16* hrow, int lane, const f32x4 (&h)[4]) {
#pragma unroll
    for (int j = 0; j < 4; ++j) { v2u w; w.x = pk2(h[j].x, h[j].y); w.y = pk2(h[j].z, h[j].w); *(v2u*)(hrow + 4 * lane + 256 * j) = w; }
}
__device__ __forceinline__ void norm_mod(const f32x4 (&x)[4], int lane, const float* ng, const float* sc, const float* sh, f32x4 (&h)[4]) {
    float ss = 0.f;
#pragma unroll
    for (int j = 0; j < 4; ++j) ss += (x[j].x * x[j].x + x[j].y * x[j].y) + (x[j].z * x[j].z + x[j].w * x[j].w);
    const float rs = rsqrtf(wave_sum(ss) * (1.0f / D) + NORM_EPS);
#pragma unroll
    for (int j = 0; j < 4; ++j) { const int c = 4 * lane + 256 * j; const f32x4 g = *(const f32x4*)(ng + c), s1 = *(const f32x4*)(sc + c), s0 = *(const f32x4*)(sh + c);
        h[j] = (x[j] * rs * g) * (1.0f + s1) + s0; }
}
__device__ __forceinline__ void norm_mod_lds(const f32x4 (&x)[4], int lane, const LAS float* ng, const LAS float* sc, const LAS float* sh, f32x4 (&h)[4]) {
    float ss = 0.f;
#pragma unroll
    for (int j = 0; j < 4; ++j) ss += (x[j].x * x[j].x + x[j].y * x[j].y) + (x[j].z * x[j].z + x[j].w * x[j].w);
    const float rs = rsqrtf(wave_sum(ss) * (1.0f / D) + NORM_EPS);
#pragma unroll
    for (int j = 0; j < 4; ++j) { const int c = 4 * lane + 256 * j; const f32x4 g = *(const LAS f32x4*)(ng + c), s1 = *(const LAS f32x4*)(sc + c), s0 = *(const LAS f32x4*)(sh + c);
        h[j] = (x[j] * rs * g) * (1.0f + s1) + s0; }
}
__device__ __forceinline__ void phase_first_norm(const Params& P, const Frame& F) {
    const int gw = F.bx * NWAVES + F.wave, NGW = F.G * NWAVES, lane = F.lane;
    const float* E = WSP(float, TAB_E); const float* mod = WSP(float, WS_MOD); bf16* H = WSP(bf16, WS_H);
    LAS float* WL = (LAS float*)F.lds; LAS float* WN = WL + 9 * 2 * 1024;
    for (int i = F.tid; i < 9 * 2 * 256; i += NTHR) { const int mr = i >> 9, wh = (i >> 8) & 1, c = (i & 255) * 4; *(LAS f32x4*)(WL + (mr * 2 + wh) * 1024 + c) = *(const f32x4*)(mod + (size_t)mr * 6144 + wh * 1024 + c); }
    for (int i = F.tid; i < 256; i += NTHR) *(LAS f32x4*)(WN + i * 4) = *(const f32x4*)(P.in[I_NORMG] + i * 4);
    __syncthreads();
    f32x4 xn[4], en[4];
    auto fetch = [&](int row) {
        const float* xr = row < NT ? P.in[I_X] + (size_t)row * D : P.in[I_CTX] + (size_t)(row - NT) * D;
#pragma unroll
        for (int j = 0; j < 4; ++j) xn[j] = *(const f32x4*)(xr + 4 * lane + 256 * j);
        if (row < NT) { const int p = row & (SEQ - 1);
#pragma unroll
            for (int j = 0; j < 4; ++j) { const int c = 4 * lane + 256 * j; en[j] = *(const f32x4*)((j < 2) ? (E + (p >> 6) * 512 + c) : (E + (p & 63) * 512 + (c - 512))); } }
    };
    if (gw < MT) fetch(gw);
    for (int row = gw; row < MT; row += NGW) {
        f32x4 x[4];
        const int mr = row < NT ? (row >> 12) : 8;
#pragma unroll
        for (int j = 0; j < 4; ++j) x[j] = row < NT ? xn[j] + en[j] : xn[j];
        if (row + NGW < MT) fetch(row + NGW);
        f32x4 h[4]; norm_mod_lds(x, lane, WN, WL + (mr * 2 + 1) * 1024, WL + (mr * 2) * 1024, h);
        store_h_row(H + (size_t)row * D, lane, h);
    }
    __syncthreads();
}
#ifndef POST_SLEEP
#define POST_SLEEP 4
#endif
#ifdef POST_PLAINLD
__device__ __forceinline__ v2u ld8_agent(const void* p) { return *(const v2u*)p; }
#else
__device__ __forceinline__ v2u ld8_agent(const void* p) { return __builtin_bit_cast(v2u, __hip_atomic_load((const unsigned long long*)p, __ATOMIC_RELAXED, __HIP_MEMORY_SCOPE_AGENT)); }
#endif
template <int MODE, bool NEXT, bool ROUTE, bool FIRST = false>
__device__ __forceinline__ void phase_post(const Params& P, const Frame& F, int nrows, int l, int goff, int ngp_idx, const float* xc_src, int ln, int ngn_idx, int scoff, int shoff,
                                           const unsigned* pcnt, unsigned need, int nbusy, int nexcl, const float* part = nullptr, int srow0 = 0x7fffffff, int S = 1, int tail_rows = 0) {
    const bool busy = F.bx < nbusy; const int lane = F.lane;
    const int gwa = F.bx * NWAVES + F.wave, NGWA = F.G * NWAVES, gwf = (F.bx - nbusy) * NWAVES + F.wave, NGWF = (F.G - nbusy) * NWAVES;
    const int KE = busy ? 0 : (nexcl + NGWF - 1) / NGWF, KS = (nrows - nexcl + NGWA - 1) / NGWA;
    auto rowq = [&](int q) -> int { return q < KE ? (gwf + q * NGWF) : (nexcl + gwa + (q - KE) * NGWA); };
    bf16* H = WSP(bf16, WS_H); const bf16* O32 = WSP(bf16, WS_O32);
    LAS float* WL = (LAS float*)F.lds; LAS float* WN = WL + 9 * 3 * 1024; LAS float* WR = WN + 2 * 1024;
    {
        const float* mod = WSP(float, WS_MOD);
        const float* ngp = P.in[I_NORMG] + (size_t)(l * 4 + ngp_idx) * D;
        const float* ngn = P.in[I_NORMG] + (size_t)(ln * 4 + ngn_idx) * D;
        for (int i = F.tid; i < 9 * 3 * 256; i += NTHR) { const int mr = i / 768, r = i - mr * 768, wh = r >> 8, c = (r & 255) * 4;
            if (wh == 0 || NEXT) { const float* src = wh == 0 ? mod + (size_t)(l * 9 + mr) * 6144 + goff + c : mod + (size_t)(ln * 9 + mr) * 6144 + (wh == 1 ? scoff : shoff) + c;
                *(LAS f32x4*)(WL + (mr * 3 + wh) * 1024 + c) = *(const f32x4*)src; } }
        for (int i = F.tid; i < 2 * 256; i += NTHR) { const int wh = i >> 8, c = (i & 255) * 4; if (wh == 0 || NEXT) *(LAS f32x4*)(WN + wh * 1024 + c) = *(const f32x4*)((wh ? ngn : ngp) + c); }
        if (ROUTE) for (int i = F.tid; i < 8 * 1024; i += NTHR) WR[(i & 7) * 1024 + (i >> 3)] = P.in[I_RW][i];
        __syncthreads();
    }
    int cnt[NE]; float rbias[NE];
#pragma unroll
    for (int e = 0; e < NE; ++e) { cnt[e] = 0; rbias[e] = ROUTE ? P.in[I_RB][e] : 0.f; }
    v2u on0[4], on1[4]; f32x4 xnx[4], enx[4]; float pn0 = 0.f, pn1 = 0.f;
    auto xsrc = [&](int row) -> const float* { return row < NT ? ((FIRST ? P.in[I_X] : (const float*)P.out) + (size_t)row * D) : (xc_src + (size_t)(row - NT) * D); };
    auto ldrow = [&](v2u (&dst)[4], const bf16* orow, int srow) {
        if (srow < 0) {
#pragma unroll
            for (int j = 0; j < 4; ++j) dst[j] = ld8_agent(orow + 4 * lane + 256 * j);
        } else {
            f32x4 a[4];
#pragma unroll
            for (int j = 0; j < 4; ++j) a[j] = (f32x4){0.f, 0.f, 0.f, 0.f};
            for (int ks = 0; ks < S; ++ks) { const float* pr = part + ((size_t)ks * tail_rows + srow) * D;
#pragma unroll
                for (int j = 0; j < 4; ++j) a[j] = a[j] + *(const f32x4*)(pr + 4 * lane + 256 * j); }
#pragma unroll
            for (int j = 0; j < 4; ++j) { dst[j].x = pk2(a[j].x, a[j].y); dst[j].y = pk2(a[j].z, a[j].w); }
        }
    };
    auto fetch = [&](int row) {
        if (MODE == 0) {
            ldrow(on0, O32 + (size_t)row * D, row >= srow0 ? row - srow0 : -1);
        } else {
            const int4 rt = *(const int4*)(P.ws + WS_ROUTE + (size_t)row * 16); const int2 tp = *(const int2*)(P.ws + WS_TOKPOS + (size_t)row * 8);
            pn0 = __builtin_bit_cast(float, rt.y); pn1 = __builtin_bit_cast(float, rt.z);
            ldrow(on0, WSP(bf16, WS_XG) + (size_t)tp.x * D, tp.x >= srow0 ? tp.x - srow0 : -1); ldrow(on1, WSP(bf16, WS_XG) + (size_t)tp.y * D, tp.y >= srow0 ? tp.y - srow0 : -1);
        }
        const float* xs = xsrc(row);
#pragma unroll
        for (int j = 0; j < 4; ++j) xnx[j] = *(const f32x4*)(xs + 4 * lane + 256 * j);
        if (FIRST && row < NT) { const int p = row & (SEQ - 1);
#pragma unroll
            for (int j = 0; j < 4; ++j) { const int c = 4 * lane + 256 * j; enx[j] = *(const f32x4*)((j < 2) ? (WSP(float, TAB_E) + (p >> 6) * 512 + c) : (WSP(float, TAB_E) + (p & 63) * 512 + (c - 512))); } }
    };
    for (int qb = 0; qb < KE + KS; qb += 64) {
    const int myq = qb + lane, myrow = rowq(myq); const bool valid = myq < KE ? (myrow < nexcl) : (myq < KE + KS && myrow < nrows);
    const unsigned* w0 = pcnt; const unsigned* w1 = pcnt; unsigned nd0 = need, nd1 = need;
    if (valid) { if (MODE == 0) { w0 = w1 = pcnt + 16 * (myrow >> 8); if (myrow >= srow0) nd0 = need * (unsigned)S; }
                 else { const int2 tp = *(const int2*)(P.ws + WS_TOKPOS + (size_t)myrow * 8); w0 = pcnt + 16 * (tp.x >> 8); w1 = pcnt + 16 * (tp.y >> 8); if (tp.x >= srow0) nd0 = need * (unsigned)S; if (tp.y >= srow0) nd1 = need * (unsigned)S; } }
    unsigned long long rem = __ballot(valid); unsigned spins = 0;
    while (rem) {
        bool rdy = false;
        if ((rem >> lane) & 1ull) { rdy = __hip_atomic_load(w0, __ATOMIC_RELAXED, __HIP_MEMORY_SCOPE_AGENT) >= nd0; if (MODE != 0) rdy = rdy && __hip_atomic_load(w1, __ATOMIC_RELAXED, __HIP_MEMORY_SCOPE_AGENT) >= nd1; }
        unsigned long long now = __ballot(rdy);
        if (!now) {
            __builtin_amdgcn_s_sleep(POST_SLEEP);
            if (++spins <= (1u << 15)) continue;
            if (lane == 0) { unsigned* tmo = WSP(unsigned, WS_CTL) + CW_TMO; __hip_atomic_store(tmo, 1u, __ATOMIC_RELAXED, __HIP_MEMORY_SCOPE_AGENT); __hip_atomic_fetch_max(tmo + 1, 0xB00u, __ATOMIC_RELAXED, __HIP_MEMORY_SCOPE_AGENT); }
            now = rem;
        }
        asm volatile("" ::: "memory");
        rem &= ~now;
        int kcur = __ffsll((long long)now) - 1; now &= now - 1ull;
        fetch(rowq(qb + kcur));
    for (;;) {
        const int row = rowq(qb + kcur);
        const int knext = now ? (__ffsll((long long)now) - 1) : -1; now &= now - 1ull;
        const int mr = row < NT ? (row >> 12) : 8;
        f32x4 o[4], xin[4];
#pragma unroll
        for (int j = 0; j < 4; ++j) { xin[j] = xnx[j];
            if (FIRST && row < NT) xin[j] = xin[j] + enx[j];
            if (MODE == 0) o[j] = (f32x4){bflo(on0[j].x), bfhi(on0[j].x), bflo(on0[j].y), bfhi(on0[j].y)};
            else o[j] = (f32x4){pn0 * bflo(on0[j].x) + pn1 * bflo(on1[j].x), pn0 * bfhi(on0[j].x) + pn1 * bfhi(on1[j].x), pn0 * bflo(on0[j].y) + pn1 * bflo(on1[j].y), pn0 * bfhi(on0[j].y) + pn1 * bfhi(on1[j].y)}; }
        if (knext >= 0) fetch(rowq(qb + knext));
        float ss = 0.f;
#pragma unroll
        for (int j = 0; j < 4; ++j) ss += (o[j].x * o[j].x + o[j].y * o[j].y) + (o[j].z * o[j].z + o[j].w * o[j].w);
        const float rs = rsqrtf(wave_sum(ss) * (1.0f / D) + NORM_EPS);
        float* xd = row < NT ? (P.out + (size_t)row * D) : (WSP(float, WS_XC) + (size_t)(row - NT) * D);
        const LAS float* wl = WL + mr * 3 * 1024;
        f32x4 x[4];
#pragma unroll
        for (int j = 0; j < 4; ++j) { const int c = 4 * lane + 256 * j; const f32x4 g = *(const LAS f32x4*)(wl + c), n = *(const LAS f32x4*)(WN + c);
            x[j] = xin[j] + g * (o[j] * rs * n); *(f32x4*)(xd + c) = x[j]; }
        if (NEXT) {
            f32x4 h[4]; norm_mod_lds(x, lane, WN + 1024, wl + 1024, wl + 2048, h);
            store_h_row(H + (size_t)row * D, lane, h);
            if (ROUTE) {
                float lg[NE];
#pragma unroll
                for (int e = 0; e < NE; ++e) lg[e] = 0.f;
#pragma unroll
                for (int e = 0; e < NE; ++e) {
#pragma unroll
                    for (int j = 0; j < 4; ++j) { const f32x4 w = *(const LAS f32x4*)(WR + e * 1024 + 4 * lane + 256 * j); lg[e] += (h[j].x * w.x + h[j].y * w.y) + (h[j].z * w.z + h[j].w * w.w); }
                    if (e & 1) __builtin_amdgcn_sched_barrier(0);
                }
#pragma unroll
                for (int e = 0; e < NE; ++e) lg[e] = wave_sum(lg[e]) + rbias[e];
                int i0 = 0; float v0 = lg[0];
#pragma unroll
                for (int e = 1; e < NE; ++e) if (lg[e] > v0) { v0 = lg[e]; i0 = e; }
                int i1 = -1; float v1 = -3.0e38f;
#pragma unroll
                for (int e = 0; e < NE; ++e) if (e != i0 && lg[e] > v1) { v1 = lg[e]; i1 = e; }
                const float e1 = expf(v1 - v0), p0 = 1.0f / (1.0f + e1), p1 = e1 / (1.0f + e1);
                if (lane == 0) *(int4*)(P.ws + WS_ROUTE + (size_t)row * 16) = make_int4(i0 | (i1 << 8), __builtin_bit_cast(int, p0), __builtin_bit_cast(int, p1), 0);
#pragma unroll
                for (int e = 0; e < NE; ++e) cnt[e] += (e == i0 || e == i1) ? 1 : 0;
            }
        }
        if (knext < 0) break;
        kcur = knext;
    }
    }
    }
    if (ROUTE) {
        if (lane == 0) {
#pragma unroll
            for (int e = 0; e < NE; ++e) if (cnt[e]) __hip_atomic_fetch_add(WSP(unsigned, WS_CTL) + CW_CNT + 64 * e, (unsigned)cnt[e], __ATOMIC_RELAXED, __HIP_MEMORY_SCOPE_AGENT);
        }
    }
}

constexpr int TB = 64;
typedef short bf16x4s __attribute__((ext_vector_type(4)));
#define MFMA16K(a, b, c) __builtin_amdgcn_mfma_f32_16x16x16bf16_1k((a), (b), (c), 0, 0, 0)
__device__ __forceinline__ float fexp(float x) { return __builtin_amdgcn_exp2f(x * 1.44269504089f); }
__device__ __forceinline__ float flog(float x) { return __builtin_amdgcn_logf(x) * 0.69314718056f; }
__device__ __forceinline__ float frcp(float x) { return __builtin_amdgcn_rcpf(x); }
__device__ __forceinline__ float softplusf_(float x) { return fmaxf(x, 0.f) + flog(1.0f + fexp(-fabsf(x))); }
__device__ __forceinline__ float ftanh(float x) { return 1.0f - 2.0f * frcp(1.0f + fexp(2.0f * x)); }
__device__ __forceinline__ f32x4 ld4bf(const bf16* p) { const v2u w = *(const v2u*)p; return (f32x4){bflo(w.x), bfhi(w.x), bflo(w.y), bfhi(w.y)}; }
template <int CTRL> __device__ __forceinline__ float dppf(float v) { return __builtin_bit_cast(float, __builtin_amdgcn_update_dpp(0, __builtin_bit_cast(int, v), CTRL, 0xf, 0xf, true)); }
__device__ __forceinline__ float sum8(float v) { v += dppf<0xB1>(v); v += dppf<0x4E>(v); v += dppf<0x141>(v); return v; }
__device__ __forceinline__ bf16x4s pack4(f32x4 v) { v2u w; w.x = pk2(v.x, v.y); w.y = pk2(v.z, v.w); return __builtin_bit_cast(bf16x4s, w); }
__device__ __forceinline__ void unpack8(v4u w, float (&o)[8]) {
#pragma unroll
    for (int q = 0; q < 4; ++q) { o[2 * q] = bflo(w[q]); o[2 * q + 1] = bfhi(w[q]); } }
__device__ __forceinline__ v4u pack8(const float (&o)[8]) { v4u w;
#pragma unroll
    for (int q = 0; q < 4; ++q) w[q] = pk2(o[2 * q], o[2 * q + 1]);
    return w; }
struct ScanPre { v4u kc, kp, vc, vp, rc, rp, wc, wp, ac, ap; };
__device__ __forceinline__ int scan_row(int bi, int tk, int b, int dir, bool& hp, int& prow) {
    const int seq = bi >= LC / TB, c = seq ? bi - LC / TB : bi, len = seq ? SEQ : LC, rowbase = seq ? b * SEQ : NT + b * LC;
    const int ts = c * TB + tk, t = dir ? (len - 1 - ts) : ts;
    hp = dir ? (t + 1 < len) : (t > 0);
    prow = rowbase + (hp ? (dir ? t + 1 : t - 1) : t);
    return rowbase + t;
}
__device__ __forceinline__ void scan_prefetch(const bf16* Z, int bi, int tk, int b, int dir, int gc, int c8, ScanPre& R) {
    bool hp; int prow; const int row = scan_row(bi, tk, b, dir, hp, prow);
    const bf16* zrk = Z + (size_t)row * NZ + gc; const bf16* zpk = Z + (size_t)prow * NZ + gc;
    const bf16* zrw = Z + (size_t)row * NZ + C_WLO + 64 * dir + c8; const bf16* zpw = Z + (size_t)prow * NZ + C_WLO + 64 * dir + c8;
    R.kc = *(const v4u*)(zrk + C_K); R.vc = *(const v4u*)(zrk + C_V); R.rc = *(const v4u*)(zrk + C_R); R.wc = *(const v4u*)(zrw); R.ac = *(const v4u*)(zrw + (C_ALO - C_WLO));
    R.kp = *(const v4u*)(zpk + C_K); R.vp = *(const v4u*)(zpk + C_V); R.rp = *(const v4u*)(zpk + C_R); R.wp = *(const v4u*)(zpw); R.ap = *(const v4u*)(zpw + (C_ALO - C_WLO));
}
__device__ __forceinline__ void lerp8(v4u cur, v4u prv, bool hp, const LAS float* mu, float (&o)[8]) {
    if (!hp) prv = (v4u){0u, 0u, 0u, 0u};
    const f32x4 m0 = *(const LAS f32x4*)mu, m1 = *(const LAS f32x4*)(mu + 4);
#pragma unroll
    for (int q = 0; q < 4; ++q) {
        const f32x2 c2 = {bflo(cur[q]), bfhi(cur[q])}, p2 = {bflo(prv[q]), bfhi(prv[q])};
        const f32x2 m2 = q < 2 ? (f32x2){m0[2 * q], m0[2 * q + 1]} : (f32x2){m1[2 * q - 4], m1[2 * q - 3]};
        const f32x2 r2 = c2 + (p2 - c2) * m2;
        o[2 * q] = r2.x; o[2 * q + 1] = r2.y; }
}
#define RLX_AGENT __ATOMIC_RELAXED, __HIP_MEMORY_SCOPE_AGENT
typedef GAS unsigned gu32;
constexpr unsigned kSpinCap = 1u << 17;
__device__ __forceinline__ bool wait_ge(gu32* word, unsigned want, gu32* tmo, unsigned code, int lane) {
    for (unsigned spins = 0;;) {
        if ((unsigned)__builtin_amdgcn_readfirstlane(__hip_atomic_load(word, RLX_AGENT)) >= want) return true;
        __builtin_amdgcn_s_sleep(1);
        if (++spins > kSpinCap) { if (lane == 0) { __hip_atomic_store(tmo, 1u, RLX_AGENT); __hip_atomic_fetch_max(tmo + 1, code, RLX_AGENT); } return false; }
        if ((spins & 255u) == 0u && __builtin_amdgcn_readfirstlane(__hip_atomic_load(tmo, RLX_AGENT))) return false;
    }
}
constexpr int XFER_PIECES = 3264, XFER_SLOT_BYTES = 52480, XFER_SLOTS = 6;
static_assert(WS_RING + 128ull * XFER_SLOTS * XFER_SLOT_BYTES <= WS_O32, "hand-off rings fit below the O buffer");
__device__ __forceinline__ int xfer_lds_off(int i) { return i < 1536 ? 20992 + 16 * i : (i < 2688 ? 45568 + 16 * (i - 1536) : 102912 + 16 * (i - 2688)); }
__device__ __forceinline__ void scan_unit(const Params& P, const Frame& F, int l, int b, int h, int dir, int role) {
    LAS unsigned char* L0 = F.lds;
    LAS bf16* W2T = (LAS bf16*)L0;
    LAS bf16* A2T = (LAS bf16*)(L0 + 9216);
    LAS float* CST = (LAS float*)(L0 + 18432);
    LAS bf16* TWb = (LAS bf16*)(L0 + 20992);
    LAS bf16* ALb = TWb + TB * TP;
    LAS bf16* BH = (LAS bf16*)(L0 + 20992);
    LAS bf16* KH = BH + 4 * 64 * 16;
    LAS bf16* Vt = KH + 4 * 64 * 16;
    LAS float* LW = (LAS float*)(L0 + 45568);
    constexpr int LWP = 68;
    LAS float* LA = LW + TB * LWP;
    LAS bf16* AT = (LAS bf16*)(L0 + 45568);
    LAS bf16* RT = AT + TB * TP; LAS bf16* BT = RT + TB * TP; LAS bf16* KT = BT + TB * TP;
    LAS float* CUM = (LAS float*)(L0 + 82432);
    LAS float* LabF = (LAS float*)(L0 + 98816);
    LAS bf16* LakB = (LAS bf16*)(L0 + 102912);
    LAS bf16* TtB = LakB + 1024; LAS bf16* MrbB = TtB + 1024; LAS bf16* MrkB = MrbB + 1024;
    LAS float* PCb = (LAS float*)(L0 + 111104);
    LAS float* YB = (LAS float*)(L0 + 112128);
    LAS float* BONl = (LAS float*)(L0 + 128512);
    const int tid = F.tid, lane = F.lane, w = F.wave, fr = lane & 15, fq = lane >> 4;
    const int tk = tid >> 3, c8 = (tid & 7) * 8, gc = 64 * h + c8;
    const int ld = l * 2 + dir;
    for (int i = tid; i < 4096; i += NTHR) { const int j = i >> 6, c = i & 63;
        W2T[c * TP + j] = (bf16)f2bf(P.in[I_W2][((size_t)ld * 64 + j) * 512 + 64 * h + c]); A2T[c * TP + j] = (bf16)f2bf(P.in[I_A2][((size_t)ld * 64 + j) * 512 + 64 * h + c]); }
    if (tid < 64) { const int c = 64 * h + tid;
        CST[0 * 64 + tid] = P.in[I_MU][(size_t)(ld * 3 + 0) * 512 + c]; CST[1 * 64 + tid] = P.in[I_MU][(size_t)(ld * 3 + 1) * 512 + c]; CST[2 * 64 + tid] = P.in[I_MU][(size_t)(ld * 3 + 2) * 512 + c];
        CST[3 * 64 + tid] = P.in[I_MUW][ld * 64 + tid]; CST[4 * 64 + tid] = P.in[I_MUA][ld * 64 + tid];
        CST[5 * 64 + tid] = P.in[I_W0][ld * 512 + c]; CST[6 * 64 + tid] = P.in[I_A0][ld * 512 + c];
        CST[7 * 64 + tid] = P.in[I_KK][l * 512 + c]; CST[8 * 64 + tid] = P.in[I_KA][l * 512 + c]; CST[9 * 64 + tid] = P.in[I_RK][l * 512 + c]; }
    const bf16* Z = WSP(bf16, WS_Z);
    bf16* YS = WSP(bf16, WS_YS) + (size_t)dir * MT * 512;
    float* BONG = WSP(float, WS_BONG) + (size_t)dir * MT * 8;
    f32x4 St[4];
#pragma unroll
    for (int kt = 0; kt < 4; ++kt) St[kt] = (f32x4){0.f, 0.f, 0.f, 0.f};
    constexpr int NBT = LC / TB + SEQ / TB;
    const int sid = (b * 8 + h) * 2 + dir;
    gu32* ctlw = (gu32*)WSP(unsigned, WS_CTL);
    gu32* prodw = ctlw + CW_PROD + l * 16384 + 64 * sid; gu32* consw = ctlw + CW_CONS + l * 16384 + 64 * sid;
    unsigned char* ring = P.ws + WS_RING + (size_t)sid * (XFER_SLOTS * XFER_SLOT_BYTES);
    v4u XR[7];
    ScanPre R; scan_prefetch(Z, role == 1 ? 1 : 0, tk, b, dir, gc, c8, R);
    __syncthreads();
    for (int bi = (role == 1 ? 1 : 0); bi < NBT; ++bi) {
        const bool mine = (role == 2) || ((bi % 2 == 0) == (role == 0));
        if (role == 1 && !mine) continue;
        const int hj = bi >> 1;
        const int bstep = role == 2 ? 1 : 2;
        const bool need_out = (bi >= LC / TB) || (l == 0);
        bool hp; int prow; const int row = scan_row(bi, tk, b, dir, hp, prow); (void)prow;
#ifdef PROBE_PREP2
        for (int prb_ = 0; prb_ < 2; ++prb_)
#endif
        if (mine) {
        if (role == 1 && hj >= XFER_SLOTS) { if (w == 0) wait_ge(consw, (unsigned)(hj - XFER_SLOTS + 1), ctlw + CW_TMO, 0x900u, lane); __syncthreads(); }
        float kx[8], vx[8], rx[8];
        { float wl[8], al[8];
          lerp8(R.kc, R.kp, hp, CST + 0 * 64 + c8, kx); lerp8(R.vc, R.vp, hp, CST + 1 * 64 + c8, vx); lerp8(R.rc, R.rp, hp, CST + 2 * 64 + c8, rx);
          lerp8(R.wc, R.wp, hp, CST + 3 * 64 + c8, wl); lerp8(R.ac, R.ap, hp, CST + 4 * 64 + c8, al);
#pragma unroll
          for (int j = 0; j < 8; ++j) wl[j] = ftanh(wl[j]);
          *(LAS v4u*)(TWb + tk * TP + c8) = pack8(wl); *(LAS v4u*)(ALb + tk * TP + c8) = pack8(al); }
        if (bi + bstep < NBT) scan_prefetch(Z, bi + bstep, tk, b, dir, gc, c8, R);
        __syncthreads();
        { const int mt = w & 3;
          bf16x8 yt[2], ya[2];
#pragma unroll
          for (int k2 = 0; k2 < 2; ++k2) { yt[k2] = *(const LAS bf16x8*)(TWb + (16 * mt + fr) * TP + 32 * k2 + 8 * fq); ya[k2] = *(const LAS bf16x8*)(ALb + (16 * mt + fr) * TP + 32 * k2 + 8 * fq); }
#pragma unroll
          for (int n2 = 0; n2 < 2; ++n2) { const int nt = 2 * (w >> 2) + n2;
              f32x4 cw = {0.f, 0.f, 0.f, 0.f}, ca = {0.f, 0.f, 0.f, 0.f};
#pragma unroll
              for (int k2 = 0; k2 < 2; ++k2) {
                  cw = MFMA16(*(const LAS bf16x8*)(W2T + (16 * nt + fr) * TP + 32 * k2 + 8 * fq), yt[k2], cw);
                  ca = MFMA16(*(const LAS bf16x8*)(A2T + (16 * nt + fr) * TP + 32 * k2 + 8 * fq), ya[k2], ca); }
              *(LAS f32x4*)(LW + (16 * mt + fr) * LWP + 16 * nt + 4 * fq) = cw; *(LAS f32x4*)(LA + (16 * mt + fr) * LWP + 16 * nt + 4 * fq) = ca; } }
        __syncthreads();
        float na[8], pb[8], km[8];
        {
            float n2 = 0.f, bon = 0.f, ew[8];
#pragma unroll
            for (int hf = 0; hf < 2; ++hf) {
#pragma unroll
                for (int j = 4 * hf; j < 4 * hf + 4; ++j) {
                    const float aw = LW[tk * LWP + c8 + j], aa = LA[tk * LWP + c8 + j];
                    ew[j] = 0.6065306597f * frcp(1.0f + fexp(-(CST[5 * 64 + c8 + j] + aw)));
                    const float ag = frcp(1.0f + fexp(-(CST[6 * 64 + c8 + j] + aa)));
                    const float kk = kx[j] * CST[7 * 64 + c8 + j]; n2 += kk * kk;
                    km[j] = kx[j] * (1.0f + (ag - 1.0f) * CST[8 * 64 + c8 + j]);
                    bon += rx[j] * km[j] * CST[9 * 64 + c8 + j];
                    na[j] = kk; pb[j] = ag;
                }
                __builtin_amdgcn_sched_barrier(0);
            }
            n2 = sum8(n2); bon = sum8(bon);
            const float inv = frcp(fmaxf(__builtin_amdgcn_sqrtf(n2), 1e-12f));
#pragma unroll
            for (int j = 0; j < 8; ++j) { const float kkn = na[j] * inv; na[j] = -kkn; pb[j] = kkn * pb[j]; }
            *(LAS f32x4*)(CUM + tk * 64 + c8) = (f32x4){ew[0], ew[1], ew[2], ew[3]} * 1.44269504089f; *(LAS f32x4*)(CUM + tk * 64 + c8 + 4) = (f32x4){ew[4], ew[5], ew[6], ew[7]} * 1.44269504089f;
            if ((tid & 7) == 0 && need_out) BONG[(size_t)row * 8 + h] = bon;
        }
        __syncthreads();
        if (tid < 256) { const int q = tid >> 6, ch = tid & 63; float c = 0.f;
#pragma unroll
            for (int i = 0; i < 16; ++i) { c -= CUM[(16 * q + i) * 64 + ch]; const float p = __builtin_amdgcn_exp2f(c); CUM[(16 * q + i) * 64 + ch] = p; if (i == 15) PCb[q * 64 + ch] = p; } }
        __syncthreads();
        {
            const int q = tk >> 4, tt = tk & 15;
            const f32x4 one4 = {1.f, 1.f, 1.f, 1.f};
            const f32x4 et0 = *(const LAS f32x4*)(CUM + tk * 64 + c8), et1 = *(const LAS f32x4*)(CUM + tk * 64 + c8 + 4);
            const f32x4 ep0 = tt ? *(const LAS f32x4*)(CUM + (tk - 1) * 64 + c8) : one4, ep1 = tt ? *(const LAS f32x4*)(CUM + (tk - 1) * 64 + c8 + 4) : one4;
            const f32x4 pc0 = *(const LAS f32x4*)(PCb + q * 64 + c8), pc1 = *(const LAS f32x4*)(PCb + q * 64 + c8 + 4);
            float ei8[8];
            { float t8[8];
#pragma unroll
              for (int j = 0; j < 8; ++j) t8[j] = na[j] * (j < 4 ? ep0[j & 3] : ep1[j & 3]);
              *(LAS v4u*)(AT + tk * TP + c8) = pack8(t8); }
            { float t8[8];
#pragma unroll
              for (int j = 0; j < 8; ++j) { const float et = j < 4 ? et0[j & 3] : et1[j & 3]; t8[j] = rx[j] * et; ei8[j] = frcp(et); }
              *(LAS v4u*)(RT + tk * TP + c8) = pack8(t8); }
            { float t8[8];
#pragma unroll
              for (int j = 0; j < 8; ++j) t8[j] = pb[j] * ei8[j];
              *(LAS v4u*)(BT + tk * TP + c8) = pack8(t8); }
            { float t8[8];
#pragma unroll
              for (int j = 0; j < 8; ++j) t8[j] = km[j] * ei8[j];
              *(LAS v4u*)(KT + tk * TP + c8) = pack8(t8); }
#pragma unroll
            for (int j = 0; j < 8; j += 2) { const float eh0 = (j < 4 ? pc0[j & 3] : pc1[j & 3]) * ei8[j], eh1 = (j + 1 < 4 ? pc0[(j + 1) & 3] : pc1[(j + 1) & 3]) * ei8[j + 1];
                const unsigned wb = pk2(pb[j] * eh0, pb[j + 1] * eh1), wk = pk2(km[j] * eh0, km[j + 1] * eh1), wv = pk2(vx[j], vx[j + 1]); const int o = (q * 64 + c8 + j) * 16 + (tt ^ (4 * ((tid & 7) & 3)));
                BH[o] = (bf16)(wb & 0xffffu); BH[o + 16] = (bf16)(wb >> 16); KH[o] = (bf16)(wk & 0xffffu); KH[o + 16] = (bf16)(wk >> 16); Vt[o] = (bf16)(wv & 0xffffu); Vt[o + 16] = (bf16)(wv >> 16); }
        }
        __syncthreads();
        { const int q = w >> 1, rsel = w & 1;
          const LAS bf16* YR = rsel ? RT : AT;
          f32x4 cb = {0.f, 0.f, 0.f, 0.f}, ck = {0.f, 0.f, 0.f, 0.f};
#pragma unroll
          for (int k2 = 0; k2 < 2; ++k2) { const bf16x8 yf = *(const LAS bf16x8*)(YR + (16 * q + fr) * TP + 32 * k2 + 8 * fq);
              cb = MFMA16(*(const LAS bf16x8*)(BT + (16 * q + fr) * TP + 32 * k2 + 8 * fq), yf, cb);
              ck = MFMA16(*(const LAS bf16x8*)(KT + (16 * q + fr) * TP + 32 * k2 + 8 * fq), yf, ck); }
#pragma unroll
          for (int i2 = 0; i2 < 4; ++i2) { const int i = 4 * fq + i2; const bool keep = rsel ? (i <= fr) : (i < fr); if (!keep) { cb[i2] = 0.f; ck[i2] = 0.f; } }
          if (rsel == 0) { *(LAS f32x4*)(LabF + (q * 16 + fr) * 16 + 4 * fq) = cb; *(LAS bf16x4s*)(LakB + (q * 16 + fr) * 16 + 4 * fq) = pack4(ck); }
          else { *(LAS bf16x4s*)(MrbB + (q * 16 + fr) * 16 + 4 * fq) = pack4(cb); *(LAS bf16x4s*)(MrkB + (q * 16 + fr) * 16 + 4 * fq) = pack4(ck); } }
        __syncthreads();
        if (tid < 64) { const int q = tid >> 4, c = tid & 15; float T[16];
#pragma unroll
            for (int t = 0; t < 16; ++t) { float sacc = (t == c) ? 1.f : 0.f;
#pragma unroll
                for (int i = 0; i < t; ++i) sacc += LabF[(q * 16 + t) * 16 + i] * T[i];
                T[t] = sacc; TtB[(q * 16 + t) * 16 + c] = (bf16)f2bf(sacc); } }
        __syncthreads();
        }
        if (role == 1) {
            const __amdgpu_buffer_rsrc_t rs = __builtin_amdgcn_make_buffer_rsrc(ring, 0, XFER_SLOTS * XFER_SLOT_BYTES, 0x00020000);
            const unsigned sb0 = (unsigned)((hj % XFER_SLOTS) * XFER_SLOT_BYTES);
            for (int i = tid; i < XFER_PIECES; i += NTHR) { const v4u v = *(const LAS v4u*)(L0 + xfer_lds_off(i)); __builtin_amdgcn_raw_buffer_store_b128(v, rs, sb0 + 16u * (unsigned)i, 0, 16); }
            asm volatile("s_waitcnt vmcnt(0)" ::: "memory");
            __syncthreads();
            if (tid == 0) __hip_atomic_store(prodw, (unsigned)(hj + 1), RLX_AGENT);
            continue;
        }
        if (!mine) {
#pragma unroll
            for (int k = 0; k < 7; ++k) { const int i = tid + NTHR * k; if (i < XFER_PIECES) *(LAS v4u*)(L0 + xfer_lds_off(i)) = XR[k]; }
            __syncthreads();
            if (tid == 0) __hip_atomic_store(consw, (unsigned)(hj + 1), RLX_AGENT);
        }
        if (role == 0 && bi + 1 < NBT && (bi + 1) % 2 != 0) {
            const int hn = (bi + 1) >> 1;
            if (w == 0) { wait_ge(prodw, (unsigned)(hn + 1), ctlw + CW_TMO, 0xA00u, lane); __builtin_amdgcn_fence(__ATOMIC_ACQUIRE, "agent"); asm volatile("s_waitcnt vmcnt(0)" ::: "memory"); }
            __syncthreads();
            const unsigned char* src = ring + (size_t)(hn % XFER_SLOTS) * XFER_SLOT_BYTES;
#pragma unroll
            for (int k = 0; k < 7; ++k) { int i = tid + NTHR * k; i = i < XFER_PIECES ? i : XFER_PIECES - 1; XR[k] = *(const v4u*)(src + 16 * i); }
        }
#ifdef PROBE_S2
        f32x4 Ssv[4];
#pragma unroll
        for (int kt = 0; kt < 4; ++kt) Ssv[kt] = St[kt];
        for (int prb_ = 0; prb_ < 2; ++prb_) {
        if (prb_) {
#pragma unroll
            for (int kt = 0; kt < 4; ++kt) St[kt] = Ssv[kt]; }
#endif
        if (w < 4) {
#pragma unroll 1
            for (int q = 0; q < 4; ++q) {
                const bf16x4s z4s = {0, 0, 0, 0};
#define CAT2(p0, p1) __builtin_shufflevector(*(const LAS bf16x4s*)(p0), *(const LAS bf16x4s*)(p1), 0, 1, 2, 3, 4, 5, 6, 7)
#define PAD8(p0) __builtin_shufflevector(*(const LAS bf16x4s*)(p0), z4s, 0, 1, 2, 3, 4, 5, 6, 7)
                const bf16x4s vt4 = *(const LAS bf16x4s*)(Vt + (q * 64 + 16 * w + fr) * 16 + 4 * (fq ^ ((2 * w + (fr >> 3)) & 3)));
                const LAS bf16* atp = AT + (16 * q + fr) * TP + 4 * fq; const LAS bf16* rtp = RT + (16 * q + fr) * TP + 4 * fq;
                f32x4 x1 = {0.f, 0.f, 0.f, 0.f}, yv = {0.f, 0.f, 0.f, 0.f};
                { const bf16x8 s01 = __builtin_shufflevector(pack4(St[0]), pack4(St[1]), 0, 1, 2, 3, 4, 5, 6, 7), s23 = __builtin_shufflevector(pack4(St[2]), pack4(St[3]), 0, 1, 2, 3, 4, 5, 6, 7);
                  x1 = MFMA16(CAT2(atp, atp + 16), s01, x1); x1 = MFMA16(CAT2(atp + 32, atp + 48), s23, x1);
                  yv = MFMA16(CAT2(rtp, rtp + 16), s01, yv); yv = MFMA16(CAT2(rtp + 32, rtp + 48), s23, yv); }
                x1 = MFMA16(PAD8(LakB + (q * 16 + fr) * 16 + 4 * fq), __builtin_shufflevector(vt4, z4s, 0, 1, 2, 3, 4, 5, 6, 7), x1);
                const f32x4 u = MFMA16(PAD8(TtB + (q * 16 + fr) * 16 + 4 * fq), __builtin_shufflevector(pack4(x1), z4s, 0, 1, 2, 3, 4, 5, 6, 7), ((f32x4){0.f, 0.f, 0.f, 0.f}));
                const bf16x8 vu = __builtin_shufflevector(vt4, pack4(u), 0, 1, 2, 3, 4, 5, 6, 7);
                yv = MFMA16(CAT2(MrkB + (q * 16 + fr) * 16 + 4 * fq, MrbB + (q * 16 + fr) * 16 + 4 * fq), vu, yv);
#pragma unroll
                for (int i2 = 0; i2 < 4; ++i2) YB[(16 * q + 4 * fq + i2) * 64 + 16 * w + fr] = yv[i2];
#pragma unroll
                for (int kt = 0; kt < 4; ++kt)
                    St[kt] = MFMA16(CAT2(KH + (q * 64 + 16 * kt + fr) * 16 + 4 * (fq ^ ((2 * kt + (fr >> 3)) & 3)), BH + (q * 64 + 16 * kt + fr) * 16 + 4 * (fq ^ ((2 * kt + (fr >> 3)) & 3))), vu, St[kt] * *(const LAS f32x4*)(PCb + q * 64 + 16 * kt + 4 * fq));
#undef CAT2
#undef PAD8
            }
        }
#ifdef PROBE_S2
        __syncthreads(); }
#endif
        __syncthreads();
        if (need_out) {
            float y8[8];
#pragma unroll
            for (int j = 0; j < 8; ++j) y8[j] = YB[tk * 64 + c8 + j];
            *(v4u*)(YS + (size_t)row * 512 + gc) = pack8(y8);
        }
    }
    __syncthreads();
}

constexpr int PL_CST = 0, PL_TW = 2560, PL_AL = PL_TW + 9216, PL_LW = PL_AL + 9216, PL_LA = PL_LW + 16384, PL_SET = PL_LA + 16384, PL_SETB = 52224, PL_END = PL_SET + 2 * PL_SETB;
static_assert(PL_END <= MISC_OFF, "pipelined scan LDS map");
__device__ __forceinline__ void scan_unit_pipe(const Params& P, const Frame& F, int l, int b, int h, int dir) {
    LAS unsigned char* L0 = F.lds;
    LAS float* CST = (LAS float*)(L0 + PL_CST);
    LAS bf16* TWb = (LAS bf16*)(L0 + PL_TW);
    LAS bf16* ALb = (LAS bf16*)(L0 + PL_AL);
    LAS bf16* BT = TWb; LAS bf16* KT = ALb;
    LAS float* LW = (LAS float*)(L0 + PL_LW);
    LAS float* LA = (LAS float*)(L0 + PL_LA);
    LAS float* CUM = LW; LAS float* LabF = LA;
    const int tid = F.tid, lane = F.lane, w = F.wave, fr = lane & 15, fq = lane >> 4;
    const int tk = tid >> 3, c8 = (tid & 7) * 8, gc = 64 * h + c8;
    const int ld = l * 2 + dir;
    if (tid < 64) { const int c = 64 * h + tid;
        CST[0 * 64 + tid] = P.in[I_MU][(size_t)(ld * 3 + 0) * 512 + c]; CST[1 * 64 + tid] = P.in[I_MU][(size_t)(ld * 3 + 1) * 512 + c]; CST[2 * 64 + tid] = P.in[I_MU][(size_t)(ld * 3 + 2) * 512 + c];
        CST[3 * 64 + tid] = P.in[I_MUW][ld * 64 + tid]; CST[4 * 64 + tid] = P.in[I_MUA][ld * 64 + tid];
        CST[5 * 64 + tid] = P.in[I_W0][ld * 512 + c]; CST[6 * 64 + tid] = P.in[I_A0][ld * 512 + c];
        CST[7 * 64 + tid] = P.in[I_KK][l * 512 + c]; CST[8 * 64 + tid] = P.in[I_KA][l * 512 + c]; CST[9 * 64 + tid] = P.in[I_RK][l * 512 + c]; }
    const bf16* Z = WSP(bf16, WS_Z);
    bf16* YS = WSP(bf16, WS_YS) + (size_t)dir * MT * 512;
    float* BONG = WSP(float, WS_BONG) + (size_t)dir * MT * 8;
    f32x4 St[4];
#pragma unroll
    for (int kt = 0; kt < 4; ++kt) St[kt] = (f32x4){0.f, 0.f, 0.f, 0.f};
    constexpr int NBT = LC / TB + SEQ / TB;
    ScanPre R; scan_prefetch(Z, 0, tk, b, dir, gc, c8, R);
    __syncthreads();
#define PL_CHAIN(q) do { if (w < 4 && it >= 1) { \
        const bf16x4s z4s = {0, 0, 0, 0}; \
        const LAS bf16* cBH = (const LAS bf16*)(cset); const LAS bf16* cKH = cBH + 4096; const LAS bf16* cVt = cKH + 4096; const LAS bf16* cAT = (const LAS bf16*)(cset + 24576); const LAS bf16* cRT = (const LAS bf16*)(cset + 33792); \
        const LAS bf16* cLak = (const LAS bf16*)(cset + 43008); const LAS bf16* cTt = cLak + 1024; const LAS bf16* cMrb = cTt + 1024; const LAS bf16* cMrk = cMrb + 1024; const LAS float* cPC = (const LAS float*)(cset + 51200); \
        const bf16x4s vt4 = *(const LAS bf16x4s*)(cVt + ((q) * 64 + 16 * w + fr) * 16 + 4 * fq); \
        const LAS bf16* atp = cAT + (16 * (q) + fr) * TP + 4 * fq; const LAS bf16* rtp = cRT + (16 * (q) + fr) * TP + 4 * fq; \
        f32x4 x1 = {0.f, 0.f, 0.f, 0.f}, yv = {0.f, 0.f, 0.f, 0.f}; \
        { const bf16x8 s01 = __builtin_shufflevector(pack4(St[0]), pack4(St[1]), 0, 1, 2, 3, 4, 5, 6, 7), s23 = __builtin_shufflevector(pack4(St[2]), pack4(St[3]), 0, 1, 2, 3, 4, 5, 6, 7); \
          x1 = MFMA16(PL_CAT2(atp, atp + 16), s01, x1); x1 = MFMA16(PL_CAT2(atp + 32, atp + 48), s23, x1); \
          yv = MFMA16(PL_CAT2(rtp, rtp + 16), s01, yv); yv = MFMA16(PL_CAT2(rtp + 32, rtp + 48), s23, yv); } \
        x1 = MFMA16(PL_PAD8(cLak + ((q) * 16 + fr) * 16 + 4 * fq), __builtin_shufflevector(vt4, z4s, 0, 1, 2, 3, 4, 5, 6, 7), x1); \
        const f32x4 u = MFMA16(PL_PAD8(cTt + ((q) * 16 + fr) * 16 + 4 * fq), __builtin_shufflevector(pack4(x1), z4s, 0, 1, 2, 3, 4, 5, 6, 7), ((f32x4){0.f, 0.f, 0.f, 0.f})); \
        const bf16x8 vu = __builtin_shufflevector(vt4, pack4(u), 0, 1, 2, 3, 4, 5, 6, 7); \
        yv = MFMA16(PL_CAT2(cMrk + ((q) * 16 + fr) * 16 + 4 * fq, cMrb + ((q) * 16 + fr) * 16 + 4 * fq), vu, yv); \
        _Pragma("unroll") for (int kt = 0; kt < 4; ++kt) { \
            St[kt] = MFMA16(PL_CAT2(cKH + ((q) * 64 + 16 * kt + fr) * 16 + 4 * fq, cBH + ((q) * 64 + 16 * kt + fr) * 16 + 4 * fq), vu, St[kt] * *(const LAS f32x4*)(cPC + (q) * 64 + 16 * kt + 4 * fq)); \
            if (kt & 1) __builtin_amdgcn_sched_barrier(0); } \
        if (cout_) { _Pragma("unroll") for (int i2 = 0; i2 < 4; ++i2) { bool hp2; int pr2; const int row2 = scan_row(it - 1, 16 * (q) + 4 * fq + i2, b, dir, hp2, pr2); \
            YS[(size_t)row2 * 512 + 64 * h + 16 * w + fr] = (bf16)f2bf(yv[i2]); } } \
    } } while (0)
#define PL_CAT2(p0, p1) __builtin_shufflevector(*(const LAS bf16x4s*)(p0), *(const LAS bf16x4s*)(p1), 0, 1, 2, 3, 4, 5, 6, 7)
#define PL_PAD8(p0) __builtin_shufflevector(*(const LAS bf16x4s*)(p0), z4s, 0, 1, 2, 3, 4, 5, 6, 7)
    for (int it = 0; it <= NBT; ++it) {
        const bool prep = it < NBT;
        const LAS unsigned char* cset = L0 + PL_SET + ((it - 1) & 1) * PL_SETB;
        LAS unsigned char* pset = L0 + PL_SET + (it & 1) * PL_SETB;
        const bool need_out = (it >= LC / TB) || (l == 0), cout_ = (it - 1 >= LC / TB) || (l == 0);
        LAS bf16* BH = (LAS bf16*)pset; LAS bf16* KH = BH + 4096; LAS bf16* Vt = KH + 4096; LAS bf16* AT = (LAS bf16*)(pset + 24576); LAS bf16* RT = (LAS bf16*)(pset + 33792);
        LAS bf16* LakB = (LAS bf16*)(pset + 43008); LAS bf16* TtB = LakB + 1024; LAS bf16* MrbB = TtB + 1024; LAS bf16* MrkB = MrbB + 1024; LAS float* PCb = (LAS float*)(pset + 51200);
        bool hp = false; int prow = 0; const int row = prep ? scan_row(it, tk, b, dir, hp, prow) : 0; (void)prow;
        float kx[8], vx[8], rx[8], na[8], pb[8], km[8];
#ifdef PROBE_ST1
        for (int prb_ = 0; prb_ < 2; ++prb_)
#endif
        if (prep) { float wl[8], al[8];
            lerp8(R.kc, R.kp, hp, CST + 0 * 64 + c8, kx); lerp8(R.vc, R.vp, hp, CST + 1 * 64 + c8, vx); lerp8(R.rc, R.rp, hp, CST + 2 * 64 + c8, rx);
            lerp8(R.wc, R.wp, hp, CST + 3 * 64 + c8, wl); lerp8(R.ac, R.ap, hp, CST + 4 * 64 + c8, al);
#pragma unroll
            for (int j = 0; j < 8; ++j) wl[j] = ftanh(wl[j]);
            *(LAS v4u*)(TWb + tk * TP + c8) = pack8(wl); *(LAS v4u*)(ALb + tk * TP + c8) = pack8(al);
        }
        __syncthreads();
        if (w >= 4) { if (prep) { const int nt = w - 4;
            int ll = lane; asm volatile("" : "+v"(ll));
            const size_t lo = ((size_t)ld * 512 + 64 * h + 16 * nt + (ll & 15)) * 64 + 8 * (ll >> 4);
            const bf16* w2g = WSP(bf16, WS_W2TG) + lo; const bf16* a2g = WSP(bf16, WS_A2TG) + lo;
            bf16x8 w2x[2], a2x[2];
#pragma unroll
            for (int k2 = 0; k2 < 2; ++k2) { w2x[k2] = *(const bf16x8*)(w2g + 32 * k2); a2x[k2] = *(const bf16x8*)(a2g + 32 * k2); }
#pragma unroll
            for (int mt = 0; mt < 4; ++mt) { f32x4 cw = {0.f, 0.f, 0.f, 0.f}, ca = {0.f, 0.f, 0.f, 0.f};
#pragma unroll
                for (int k2 = 0; k2 < 2; ++k2) { cw = MFMA16(w2x[k2], *(const LAS bf16x8*)(TWb + (16 * mt + fr) * TP + 32 * k2 + 8 * fq), cw); ca = MFMA16(a2x[k2], *(const LAS bf16x8*)(ALb + (16 * mt + fr) * TP + 32 * k2 + 8 * fq), ca); }
                *(LAS f32x4*)(LW + (16 * mt + fr) * 64 + 16 * nt + 4 * fq) = cw; *(LAS f32x4*)(LA + (16 * mt + fr) * 64 + 16 * nt + 4 * fq) = ca; } } }
        else PL_CHAIN(0);
        __syncthreads();
#ifdef PROBE_ST3
        float lwsv[8], lasv[8];
        if (prep) {
#pragma unroll
            for (int j = 0; j < 8; ++j) { lwsv[j] = LW[tk * 64 + c8 + j]; lasv[j] = LA[tk * 64 + c8 + j]; } }
        for (int prb_ = 0; prb_ < 2; ++prb_) {
        if (prb_ && prep) {
#pragma unroll
            for (int j = 0; j < 8; ++j) { LW[tk * 64 + c8 + j] = lwsv[j]; LA[tk * 64 + c8 + j] = lasv[j]; } }
#endif
        if (prep) {
            float n2 = 0.f, bon = 0.f, ew[8];
#pragma unroll
            for (int hf = 0; hf < 2; ++hf) {
#pragma unroll
                for (int j = 4 * hf; j < 4 * hf + 4; ++j) {
                    const float aw = LW[tk * 64 + c8 + j], aa = LA[tk * 64 + c8 + j];
                    ew[j] = 0.6065306597f * frcp(1.0f + fexp(-(CST[5 * 64 + c8 + j] + aw)));
                    const float ag = frcp(1.0f + fexp(-(CST[6 * 64 + c8 + j] + aa)));
                    const float kk = kx[j] * CST[7 * 64 + c8 + j]; n2 += kk * kk;
                    km[j] = kx[j] * (1.0f + (ag - 1.0f) * CST[8 * 64 + c8 + j]);
                    bon += rx[j] * km[j] * CST[9 * 64 + c8 + j];
                    na[j] = kk; pb[j] = ag;
                }
                __builtin_amdgcn_sched_barrier(0);
            }
            n2 = sum8(n2); bon = sum8(bon);
            const float inv = frcp(fmaxf(__builtin_amdgcn_sqrtf(n2), 1e-12f));
#pragma unroll
            for (int j = 0; j < 8; ++j) { const float kkn = na[j] * inv; na[j] = -kkn; pb[j] = kkn * pb[j]; }
            *(LAS f32x4*)(CUM + tk * 64 + c8) = (f32x4){ew[0], ew[1], ew[2], ew[3]} * 1.44269504089f; *(LAS f32x4*)(CUM + tk * 64 + c8 + 4) = (f32x4){ew[4], ew[5], ew[6], ew[7]} * 1.44269504089f;
            if ((tid & 7) == 0 && need_out) BONG[(size_t)row * 8 + h] = bon;
#pragma unroll
            for (int j = 0; j < 8; j += 2) { const unsigned wv = pk2(vx[j], vx[j + 1]); const int o = ((tk >> 4) * 64 + c8 + j) * 16 + (tk & 15); Vt[o] = (bf16)(wv & 0xffffu); Vt[o + 16] = (bf16)(wv >> 16); }
        }
#ifdef PROBE_ST3
        }
#endif
        __syncthreads();
        if (w >= 4) { if (prep) { const int t2 = tid - 256, q = t2 >> 6, ch = t2 & 63; float c = 0.f;
#pragma unroll
            for (int i = 0; i < 16; ++i) { c -= CUM[(16 * q + i) * 64 + ch]; const float p = __builtin_amdgcn_exp2f(c); CUM[(16 * q + i) * 64 + ch] = p; if (i == 15) PCb[q * 64 + ch] = p; } } }
        else PL_CHAIN(1);
        __syncthreads();
#ifdef PROBE_ST5
        for (int prb_ = 0; prb_ < 2; ++prb_)
#endif
        if (prep) {
            const int q = tk >> 4, tt = tk & 15;
            const f32x4 one4 = {1.f, 1.f, 1.f, 1.f};
            const f32x4 et0 = *(const LAS f32x4*)(CUM + tk * 64 + c8), et1 = *(const LAS f32x4*)(CUM + tk * 64 + c8 + 4);
            const f32x4 ep0 = tt ? *(const LAS f32x4*)(CUM + (tk - 1) * 64 + c8) : one4, ep1 = tt ? *(const LAS f32x4*)(CUM + (tk - 1) * 64 + c8 + 4) : one4;
            const f32x4 pc0 = *(const LAS f32x4*)(PCb + q * 64 + c8), pc1 = *(const LAS f32x4*)(PCb + q * 64 + c8 + 4);
            float ei8[8];
            { float t8[8];
#pragma unroll
              for (int j = 0; j < 8; ++j) t8[j] = na[j] * (j < 4 ? ep0[j & 3] : ep1[j & 3]);
              *(LAS v4u*)(AT + tk * TP + c8) = pack8(t8); }
            __builtin_amdgcn_sched_barrier(0);
            { float t8[8];
#pragma unroll
              for (int j = 0; j < 8; ++j) { const float et = j < 4 ? et0[j & 3] : et1[j & 3]; t8[j] = rx[j] * et; ei8[j] = frcp(et); }
              *(LAS v4u*)(RT + tk * TP + c8) = pack8(t8); }
            __builtin_amdgcn_sched_barrier(0);
            { float t8[8];
#pragma unroll
              for (int j = 0; j < 8; ++j) t8[j] = pb[j] * ei8[j];
              *(LAS v4u*)(BT + tk * TP + c8) = pack8(t8); }
            __builtin_amdgcn_sched_barrier(0);
            { float t8[8];
#pragma unroll
              for (int j = 0; j < 8; ++j) t8[j] = km[j] * ei8[j];
              *(LAS v4u*)(KT + tk * TP + c8) = pack8(t8); }
            __builtin_amdgcn_sched_barrier(0);
#pragma unroll
            for (int j = 0; j < 8; j += 2) { const float eh0 = (j < 4 ? pc0[j & 3] : pc1[j & 3]) * ei8[j], eh1 = (j + 1 < 4 ? pc0[(j + 1) & 3] : pc1[(j + 1) & 3]) * ei8[j + 1];
                const unsigned wb = pk2(pb[j] * eh0, pb[j + 1] * eh1), wk = pk2(km[j] * eh0, km[j + 1] * eh1); const int o = (q * 64 + c8 + j) * 16 + tt;
                BH[o] = (bf16)(wb & 0xffffu); BH[o + 16] = (bf16)(wb >> 16); KH[o] = (bf16)(wk & 0xffffu); KH[o + 16] = (bf16)(wk >> 16); }
        }
        __syncthreads();
        if (it + 1 < NBT) scan_prefetch(Z, it + 1, tk, b, dir, gc, c8, R);
        if (w >= 4) { if (prep) { const int q = w - 4;
#pragma unroll
            for (int rsel = 0; rsel < 2; ++rsel) {
                const LAS bf16* YR = rsel ? RT : AT;
                f32x4 cb = {0.f, 0.f, 0.f, 0.f}, ck = {0.f, 0.f, 0.f, 0.f};
#pragma unroll
                for (int k2 = 0; k2 < 2; ++k2) { const bf16x8 yf = *(const LAS bf16x8*)(YR + (16 * q + fr) * TP + 32 * k2 + 8 * fq);
                    cb = MFMA16(*(const LAS bf16x8*)(BT + (16 * q + fr) * TP + 32 * k2 + 8 * fq), yf, cb);
                    ck = MFMA16(*(const LAS bf16x8*)(KT + (16 * q + fr) * TP + 32 * k2 + 8 * fq), yf, ck); }
#pragma unroll
                for (int i2 = 0; i2 < 4; ++i2) { const int i = 4 * fq + i2; const bool keep = rsel ? (i <= fr) : (i < fr); if (!keep) { cb[i2] = 0.f; ck[i2] = 0.f; } }
                if (rsel == 0) { *(LAS f32x4*)(LabF + (q * 16 + fr) * 16 + 4 * fq) = cb; *(LAS bf16x4s*)(LakB + (q * 16 + fr) * 16 + 4 * fq) = pack4(ck); }
                else { *(LAS bf16x4s*)(MrbB + (q * 16 + fr) * 16 + 4 * fq) = pack4(cb); *(LAS bf16x4s*)(MrkB + (q * 16 + fr) * 16 + 4 * fq) = pack4(ck); } } } }
        else PL_CHAIN(2);
        __syncthreads();
        if (w == 4) { if (prep) { const int q = lane >> 4, c = lane & 15; float T[16];
#pragma unroll
            for (int t = 0; t < 16; ++t) { float sacc = (t == c) ? 1.f : 0.f;
#pragma unroll
                for (int i = 0; i < t; ++i) sacc += LabF[(q * 16 + t) * 16 + i] * T[i];
                T[t] = sacc; TtB[(q * 16 + t) * 16 + c] = (bf16)f2bf(sacc); } } }
        else if (w < 4) PL_CHAIN(3);
        __syncthreads();
    }
#undef PL_CHAIN
#undef PL_CAT2
#undef PL_PAD8
}

__device__ __forceinline__ void conv_items(const Params& P, const Frame& F, int l, int nrows, int ob, int nob) {
    const bf16* Z = WSP(bf16, WS_Z); bf16* YM = WSP(bf16, WS_H);
    const float* cw = P.in[I_CONVW] + l * 768;
    for (int idx = ob * NTHR + F.tid; idx < nrows * 32; idx += nob * NTHR) {
        const int row = idx >> 5, ch = (idx & 31) * 8;
        bool hp, hn;
        if (row < NT) { const int col = row & 63; hp = col != 0; hn = col != 63; } else { const int t = (row - NT) & 255; hp = t != 0; hn = t != 255; }
        const bf16* zr = Z + (size_t)row * NZ;
        const v4u u1 = *(const v4u*)(zr + C_U + ch), g1 = *(const v4u*)(zr + C_GC + ch), gb = *(const v4u*)(zr + C_GB + ch);
        v4u u0 = {0u, 0u, 0u, 0u}, g0 = u0, u2 = u0, g2 = u0;
        if (hp) { u0 = *(const v4u*)(zr - NZ + C_U + ch); g0 = *(const v4u*)(zr - NZ + C_GC + ch); }
        if (hn) { u2 = *(const v4u*)(zr + NZ + C_U + ch); g2 = *(const v4u*)(zr + NZ + C_GC + ch); }
        v4u o;
#pragma unroll
        for (int q = 0; q < 4; ++q) {
            const float wa0 = cw[ch + 2 * q], wa1 = cw[256 + ch + 2 * q], wa2 = cw[512 + ch + 2 * q], wb0 = cw[ch + 2 * q + 1], wb1 = cw[256 + ch + 2 * q + 1], wb2 = cw[512 + ch + 2 * q + 1];
            const float lo = bflo(gb[q]) * (wa0 * bflo(g0[q]) * bflo(u0[q]) + wa1 * bflo(g1[q]) * bflo(u1[q]) + wa2 * bflo(g2[q]) * bflo(u2[q]));
            const float hi = bfhi(gb[q]) * (wb0 * bfhi(g0[q]) * bfhi(u0[q]) + wb1 * bfhi(g1[q]) * bfhi(u1[q]) + wb2 * bfhi(g2[q]) * bfhi(u2[q]));
            o[q] = pk2(lo, hi);
        }
        *(v4u*)(YM + (size_t)row * D + 512 + ch) = o;
    }
}

__device__ __forceinline__ void load_tab64(LAS bf16* dst, const bf16* src, int tid) {
    for (int i = tid; i < 512; i += NTHR) { const int r = i >> 3, c = (i & 7) * 8; *(LAS v4u*)(dst + r * TP + c) = *(const v4u*)(src + r * 64 + c); }
}
__device__ __forceinline__ bf16x8 ldsfrag(const LAS bf16* base, int row, int col) { return *(const LAS bf16x8*)(base + row * TP + col); }
__device__ __forceinline__ void fourier_a_iter(const Params& P, const Frame& F, int it) {
    const int bg = it >> 3, j = it & 7, b = bg >> 2, g = bg & 3, w = F.wave, lane = F.lane, fr = lane & 15, fq = lane >> 4, p2 = 8 * j + w;
    LAS bf16* TC64 = (LAS bf16*)F.lds; LAS bf16* TS64 = TC64 + 64 * TP; LAS bf16* TN64 = TS64 + 64 * TP;
    LAS bf16* PT = TN64 + 64 * TP + w * (64 * TP);
    load_tab64(TC64, WSP(bf16, TAB_C64), F.tid); load_tab64(TS64, WSP(bf16, TAB_S64), F.tid); load_tab64(TN64, WSP(bf16, TAB_SN64), F.tid);
    const bf16* Z = WSP(bf16, WS_Z);
    __syncthreads();
    f32x4 Yr[4][4], Yi[4][4];
#pragma unroll
    for (int a = 0; a < 4; ++a)
#pragma unroll
        for (int c = 0; c < 4; ++c) { Yr[a][c] = (f32x4){0.f, 0.f, 0.f, 0.f}; Yi[a][c] = (f32x4){0.f, 0.f, 0.f, 0.f}; }
#pragma unroll
    for (int pass = 0; pass < 2; ++pass) {
        const LAS bf16* T1 = pass == 0 ? TC64 : TS64;
        asm volatile("" ::: "memory");
#pragma unroll
        for (int xt = 0; xt < 4; ++xt) {
            bf16x8 Ff[2];
#pragma unroll
            for (int ks = 0; ks < 2; ++ks) Ff[ks] = *(const bf16x8*)(Z + (size_t)(b * SEQ + 64 * (16 * xt + fr) + p2) * NZ + C_F + 64 * g + 32 * ks + 8 * fq);
#pragma unroll
            for (int yt = 0; yt < 4; ++yt) {
                f32x4 acc = {0.f, 0.f, 0.f, 0.f};
#pragma unroll
                for (int ks = 0; ks < 2; ++ks) acc = MFMA16(Ff[ks], ldsfrag(T1, 16 * yt + fr, 32 * ks + 8 * fq), acc);
                v2u wv; wv.x = pk2(acc.x, acc.y); wv.y = pk2(acc.z, acc.w);
                *(LAS v2u*)(PT + (16 * yt + fr) * TP + 16 * xt + 4 * fq) = wv;
            }
            __builtin_amdgcn_sched_barrier(0);
        }
        LDS_WAIT(); asm volatile("" ::: "memory");
        const LAS bf16* TA = pass == 0 ? TC64 : TN64;
        const LAS bf16* TB = pass == 0 ? TS64 : TC64;
#pragma unroll
        for (int ks = 0; ks < 2; ++ks) {
            bf16x8 pf[4];
#pragma unroll
            for (int yt = 0; yt < 4; ++yt) pf[yt] = ldsfrag(PT, 16 * yt + fr, 32 * ks + 8 * fq);
#pragma unroll
            for (int xt = 0; xt < 4; ++xt) { const bf16x8 ta = ldsfrag(TA, 16 * xt + fr, 32 * ks + 8 * fq), tb = ldsfrag(TB, 16 * xt + fr, 32 * ks + 8 * fq);
#pragma unroll
                for (int yt = 0; yt < 4; ++yt) { Yr[xt][yt] = MFMA16(ta, pf[yt], Yr[xt][yt]); Yi[xt][yt] = MFMA16(tb, pf[yt], Yi[xt][yt]); }
                __builtin_amdgcn_sched_barrier(0); }
        }
        LDS_WAIT(); asm volatile("" ::: "memory");
    }
    __syncthreads();
    LAS bf16* EX = (LAS bf16*)F.lds;
    const float* twc = WSP(float, TAB_TWC); const float* tws = WSP(float, TAB_TWS);
#pragma unroll
    for (int xt = 0; xt < 4; ++xt)
#pragma unroll
        for (int i = 0; i < 4; ++i) { const int q1 = 16 * xt + 4 * fq + i, m = (p2 * q1) & 4095; const float tc = twc[m], ts = tws[m];
#pragma unroll
            for (int yt = 0; yt < 4; ++yt) { const float yr = Yr[xt][yt][i], yi = Yi[xt][yt][i]; const int cp = 16 * yt + fr;
                EX[((q1 * 2 + 0) * 64 + cp) * 8 + w] = (bf16)f2bf(yr * tc - yi * ts);
                EX[((q1 * 2 + 1) * 64 + cp) * 8 + w] = (bf16)f2bf(-yi * tc - yr * ts); }
            __builtin_amdgcn_sched_barrier(0); }
    __syncthreads();
    bf16* YB = WSP(bf16, WS_YBUF) + (size_t)bg * (64 * 2 * 64 * 64);
#pragma unroll 4
    for (int n = 0; n < 16; ++n) { const int q = F.tid + NTHR * n; *(v4u*)(YB + (size_t)q * 64 + 8 * j) = *(const LAS v4u*)(EX + q * 8); }
    __syncthreads();
}
__device__ __forceinline__ void fourier_b_unit(const Params& P, const Frame& F, int u, const LAS bf16* TC64, const LAS bf16* TS64) {
    const int bg = u >> 6, s2 = u & 63, b = bg >> 2, g = bg & 3, lane = F.lane, fr = lane & 15, fq = lane >> 4;
    const bf16* YB = WSP(bf16, WS_YBUF) + (size_t)bg * (64 * 2 * 64 * 64) + (size_t)s2 * (2 * 64 * 64);
    f32x4 acc[4][4];
#pragma unroll
    for (int a = 0; a < 4; ++a)
#pragma unroll
        for (int c = 0; c < 4; ++c) acc[a][c] = (f32x4){0.f, 0.f, 0.f, 0.f};
#pragma unroll
    for (int ks = 0; ks < 4; ++ks) { const int ri = ks >> 1, pb = (ks & 1) * 32;
        bf16x8 xf[4];
#pragma unroll
        for (int xt = 0; xt < 4; ++xt) xf[xt] = *(const bf16x8*)(YB + (size_t)(ri * 64 + 16 * xt + fr) * 64 + pb + 8 * fq);
        const LAS bf16* T = ri ? TS64 : TC64;
#pragma unroll
        for (int yt = 0; yt < 4; ++yt) { const bf16x8 tf = ldsfrag(T, 16 * yt + fr, pb + 8 * fq);
#pragma unroll
            for (int xt = 0; xt < 4; ++xt) acc[xt][yt] = MFMA16(xf[xt], tf, acc[xt][yt]); }
    }
    bf16* YM = WSP(bf16, WS_H);
#pragma unroll
    for (int yt = 0; yt < 4; ++yt) { const int s1 = 16 * yt + fr; bf16* rowp = YM + (size_t)(b * SEQ + 64 * s1 + s2) * D + 768 + 64 * g;
#pragma unroll
        for (int xt = 0; xt < 4; ++xt) { const f32x4 a = acc[xt][yt] * (1.0f / 512.0f); v2u wv; wv.x = pk2(a.x, a.y); wv.y = pk2(a.z, a.w); *(v2u*)(rowp + 16 * xt + 4 * fq) = wv; } }
}
constexpr int TP2 = 264;
__device__ __forceinline__ void fourier_ctx_unit(const Params& P, const Frame& F, int bg) {
    const int b = bg >> 2, g = bg & 3, w = F.wave, lane = F.lane, fr = lane & 15, fq = lane >> 4;
    LAS bf16* TC64 = (LAS bf16*)F.lds; LAS bf16* TS64 = TC64 + 64 * TP;
    LAS bf16* PT = TS64 + 64 * TP; LAS bf16* QT = PT + 64 * TP2;
    load_tab64(TC64, WSP(bf16, TAB_C64), F.tid); load_tab64(TS64, WSP(bf16, TAB_S64), F.tid);
    const bf16* Z = WSP(bf16, WS_Z);
    bf16x8 Ff[2][2];
#pragma unroll
    for (int xt = 0; xt < 2; ++xt)
#pragma unroll
        for (int ks = 0; ks < 2; ++ks) Ff[xt][ks] = *(const bf16x8*)(Z + (size_t)(NT + b * LC + 32 * w + 16 * xt + fr) * NZ + C_F + 64 * g + 32 * ks + 8 * fq);
    __syncthreads();
#pragma unroll
    for (int xt = 0; xt < 2; ++xt)
#pragma unroll
        for (int yt = 0; yt < 4; ++yt) {
            f32x4 ap = {0.f, 0.f, 0.f, 0.f}, aq = {0.f, 0.f, 0.f, 0.f};
#pragma unroll
            for (int ks = 0; ks < 2; ++ks) { ap = MFMA16(Ff[xt][ks], ldsfrag(TC64, 16 * yt + fr, 32 * ks + 8 * fq), ap); aq = MFMA16(Ff[xt][ks], ldsfrag(TS64, 16 * yt + fr, 32 * ks + 8 * fq), aq); }
            v2u wp, wq; wp.x = pk2(ap.x, ap.y); wp.y = pk2(ap.z, ap.w); wq.x = pk2(aq.x, aq.y); wq.y = pk2(aq.z, aq.w);
            *(LAS v2u*)(PT + (16 * yt + fr) * TP2 + 32 * w + 16 * xt + 4 * fq) = wp; *(LAS v2u*)(QT + (16 * yt + fr) * TP2 + 32 * w + 16 * xt + 4 * fq) = wq;
        }
    __syncthreads();
    const bf16* C256 = WSP(bf16, WS_C256); const bf16* SN256 = WSP(bf16, WS_SN256);
    f32x4 acc[4][2];
#pragma unroll
    for (int a = 0; a < 4; ++a)
#pragma unroll
        for (int c = 0; c < 2; ++c) acc[a][c] = (f32x4){0.f, 0.f, 0.f, 0.f};
#pragma unroll 2
    for (int ks = 0; ks < 8; ++ks) {
        bf16x8 cf[2], sf[2];
#pragma unroll
        for (int yt = 0; yt < 2; ++yt) { cf[yt] = *(const bf16x8*)(C256 + (size_t)(32 * w + 16 * yt + fr) * 256 + 32 * ks + 8 * fq); sf[yt] = *(const bf16x8*)(SN256 + (size_t)(32 * w + 16 * yt + fr) * 256 + 32 * ks + 8 * fq); }
#pragma unroll
        for (int xt = 0; xt < 4; ++xt) { const bf16x8 pf = *(const LAS bf16x8*)(PT + (16 * xt + fr) * TP2 + 32 * ks + 8 * fq), qf = *(const LAS bf16x8*)(QT + (16 * xt + fr) * TP2 + 32 * ks + 8 * fq);
#pragma unroll
            for (int yt = 0; yt < 2; ++yt) { acc[xt][yt] = MFMA16(pf, cf[yt], acc[xt][yt]); acc[xt][yt] = MFMA16(qf, sf[yt], acc[xt][yt]); } }
    }
    bf16* YM = WSP(bf16, WS_H);
#pragma unroll
    for (int yt = 0; yt < 2; ++yt) { bf16* rowp = YM + (size_t)(NT + b * LC + 32 * w + 16 * yt + fr) * D + 768 + 64 * g;
#pragma unroll
        for (int xt = 0; xt < 4; ++xt) { const f32x4 a = acc[xt][yt] * (1.0f / 128.0f); v2u wv; wv.x = pk2(a.x, a.y); wv.y = pk2(a.z, a.w); *(v2u*)(rowp + 16 * xt + 4 * fq) = wv; } }
    __syncthreads();
}

constexpr int GP = 136;
__device__ __forceinline__ void finalize_phase(const Params& P, const Frame& F, int l, int nrows) {
    LAS bf16* G2 = (LAS bf16*)F.lds;
    const bf16* g2t = WSP(bf16, WS_G2T) + (size_t)l * 512 * 128;
    for (int i = F.tid; i < 512 * 16; i += NTHR) { const int r = i >> 4, c = (i & 15) * 8; *(LAS v4u*)(G2 + r * GP + c) = *(const v4u*)(g2t + r * 128 + c); }
    __syncthreads();
    const int gw = F.bx * NWAVES + F.wave, NGW = F.G * NWAVES, lane = F.lane, fr = lane & 15, fq = lane >> 4;
    const bf16* Z = WSP(bf16, WS_Z); const bf16* YSb = WSP(bf16, WS_YS); const float* BONG = WSP(float, WS_BONG); bf16* YM = WSP(bf16, WS_H);
    const float* gnw = P.in[I_GNW] + l * 512; const float* gnb = P.in[I_GNB] + l * 512; const float* mu = P.in[I_MU];
    const int nu = (nrows / 16) * 2;
    for (int u = gw; u < nu; u += NGW) {
        const int row = (u >> 1) * 16 + fr, half = u & 1;
        bf16x8 sf[4];
#pragma unroll
        for (int ks = 0; ks < 4; ++ks) { const v4u zv = *(const v4u*)(Z + (size_t)row * NZ + C_GLO + 32 * ks + 8 * fq); v4u o;
#pragma unroll
            for (int q = 0; q < 4; ++q) o[q] = pk2(sigmoidf_(bflo(zv[q])), sigmoidf_(bfhi(zv[q])));
            sf[ks] = __builtin_bit_cast(bf16x8, o); }
        int t, len; if (row < NT) { t = row & (SEQ - 1); len = SEQ; } else { t = (row - NT) & (LC - 1); len = LC; }
#pragma unroll 1
        for (int hh = 0; hh < 4; ++hh) {
            const int head = 4 * half + hh;
            f32x4 acc[4];
#pragma unroll
            for (int j = 0; j < 4; ++j) acc[j] = (f32x4){0.f, 0.f, 0.f, 0.f};
#pragma unroll
            for (int ks = 0; ks < 4; ++ks)
#pragma unroll
                for (int j = 0; j < 4; ++j) acc[j] = MFMA16(*(const LAS bf16x8*)(G2 + (64 * head + 16 * j + fr) * GP + 32 * ks + 8 * fq), sf[ks], acc[j]);
            f32x4 osum[4];
#pragma unroll
            for (int j = 0; j < 4; ++j) osum[j] = (f32x4){0.f, 0.f, 0.f, 0.f};
#pragma unroll
            for (int dir = 0; dir < 2; ++dir) {
                const bool hp = dir ? (t + 1 < len) : (t > 0); const int prow = hp ? (dir ? row + 1 : row - 1) : row;
                const bf16* ys = YSb + ((size_t)dir * MT + row) * 512 + 64 * head + 4 * fq;
                f32x4 y[4]; float s = 0.f;
#pragma unroll
                for (int j = 0; j < 4; ++j) { y[j] = ld4bf(ys + 16 * j); s += (y[j].x + y[j].y) + (y[j].z + y[j].w); }
                s += __shfl_xor(s, 16); s += __shfl_xor(s, 32);
                const float mean = s * (1.0f / 64.0f); float q2 = 0.f;
#pragma unroll
                for (int j = 0; j < 4; ++j) { y[j] = y[j] - mean; q2 += (y[j].x * y[j].x + y[j].y * y[j].y) + (y[j].z * y[j].z + y[j].w * y[j].w); }
                q2 += __shfl_xor(q2, 16); q2 += __shfl_xor(q2, 32);
                const float rstd = rsqrtf(q2 * (1.0f / 64.0f) + GN_EPS);
                const float bon = BONG[((size_t)dir * MT + row) * 8 + head];
#pragma unroll
                for (int j = 0; j < 4; ++j) { const int ch = 64 * head + 16 * j + 4 * fq;
                    const f32x4 vc = ld4bf(Z + (size_t)row * NZ + C_V + ch), vp = hp ? ld4bf(Z + (size_t)prow * NZ + C_V + ch) : (f32x4){0.f, 0.f, 0.f, 0.f};
                    const f32x4 mv = *(const f32x4*)(mu + (size_t)((l * 2 + dir) * 3 + 1) * 512 + ch);
                    const f32x4 vx = vc + (vp - vc) * mv;
                    osum[j] += y[j] * rstd * *(const f32x4*)(gnw + ch) + *(const f32x4*)(gnb + ch) + bon * vx; }
            }
#pragma unroll
            for (int j = 0; j < 4; ++j) { const int n = 64 * head + 16 * j + 4 * fq; const f32x4 o = osum[j] * acc[j];
                v2u wv; wv.x = pk2(o.x, o.y); wv.y = pk2(o.z, o.w); *(v2u*)(YM + (size_t)row * D + n) = wv; }
        }
    }
    __syncthreads();
}

struct MoePlan { int pb[9]; };
__device__ __forceinline__ void moe_plan(const Params& P, MoePlan& M, int (&cnt)[NE]) {
    int acc = 0;
#pragma unroll
    for (int e = 0; e < NE; ++e) { cnt[e] = (int)__hip_atomic_load(WSP(unsigned, WS_CTL) + CW_CNT + 64 * e, __ATOMIC_RELAXED, __HIP_MEMORY_SCOPE_AGENT); M.pb[e] = acc; acc += (cnt[e] + 255) >> 8; }
    M.pb[8] = acc;
}
__device__ __forceinline__ void moe_assign_gather(const Params& P, const Frame& F) {
    MoePlan M; int cnt[NE]; moe_plan(P, M, cnt);
    const int gw = F.bx * NWAVES + F.wave, NGW = F.G * NWAVES, lane = F.lane;
    const bf16* H = WSP(bf16, WS_H); bf16* XG = WSP(bf16, WS_XG);
    unsigned* fill = WSP(unsigned, WS_CTL) + CW_FILL;
    for (int it = gw; it < NT / 16; it += NGW) {
        const int tok = it * 16 + (lane & 15); const bool act = lane < 16;
        const int4 rt = *(const int4*)(P.ws + WS_ROUTE + (size_t)tok * 16);
        const int es[2] = {act ? (rt.x & 255) : 255, act ? ((rt.x >> 8) & 255) : 255};
        int pos[2];
#pragma unroll
        for (int s = 0; s < 2; ++s) {
            pos[s] = 0;
#pragma unroll
            for (int e = 0; e < NE; ++e) {
                const unsigned long long m = __ballot(es[s] == e);
                if (m) {
                    const int n = __popcll(m), first = __ffsll((long long)m) - 1;
                    unsigned base = 0;
                    if (lane == first) base = __hip_atomic_fetch_add(fill + 64 * e, (unsigned)n, __ATOMIC_RELAXED, __HIP_MEMORY_SCOPE_AGENT);
                    base = __shfl(base, first);
                    const int rank = __popcll(m & ((1ull << lane) - 1ull));
                    if (es[s] == e) pos[s] = M.pb[e] * 256 + (int)base + rank;
                }
            }
        }
        if (act) *(int2*)(P.ws + WS_TOKPOS + (size_t)tok * 8) = make_int2(pos[0], pos[1]);
#pragma unroll 1
        for (int i0 = 0; i0 < 16; i0 += 4) {
            v4u a[4], b[4]; int d0[4], d1[4];
#pragma unroll
            for (int i = 0; i < 4; ++i) { const int t = it * 16 + i0 + i; d0[i] = __shfl(pos[0], i0 + i); d1[i] = __shfl(pos[1], i0 + i);
                a[i] = *(const v4u*)(H + (size_t)t * D + 8 * lane); b[i] = *(const v4u*)(H + (size_t)t * D + 512 + 8 * lane); }
#pragma unroll
            for (int i = 0; i < 4; ++i) {
                *(v4u*)(XG + (size_t)d0[i] * D + 8 * lane) = a[i]; *(v4u*)(XG + (size_t)d0[i] * D + 512 + 8 * lane) = b[i];
                *(v4u*)(XG + (size_t)d1[i] * D + 8 * lane) = a[i]; *(v4u*)(XG + (size_t)d1[i] * D + 512 + 8 * lane) = b[i]; }
        }
    }
#pragma unroll
    for (int e = 0; e < NE; ++e) {
        const int r0 = M.pb[e] * 256 + cnt[e], r1 = M.pb[e + 1] * 256;
        for (int r = r0 + gw; r < r1; r += NGW) { *(v4u*)(XG + (size_t)r * D + 8 * lane) = (v4u){0u, 0u, 0u, 0u}; *(v4u*)(XG + (size_t)r * D + 512 + 8 * lane) = (v4u){0u, 0u, 0u, 0u}; }
    }
}

__device__ __forceinline__ Frame make_frame(LAS unsigned char* lds, int wave0) {
    Frame F; int tid = wave0 * 64 + (int)__builtin_amdgcn_mbcnt_hi(~0u, __builtin_amdgcn_mbcnt_lo(~0u, 0u)), G = gridDim.x, bx = blockIdx.x;
    asm volatile("" : "+v"(tid)); asm volatile("" : "+s"(G)); asm volatile("" : "+s"(bx));
    F.lds = lds; F.tid = tid; F.lane = tid & 63; F.wave = __builtin_amdgcn_readfirstlane(tid >> 6); F.G = G; F.bx = bx; return F;
}
#define CAS __attribute__((address_space(4)))
#define WSQ(T, off) ((T*)(Q.ws + (off)))
#if defined(__HIP_DEVICE_COMPILE__)
__device__ __forceinline__ Params load_params() { const CAS void* p = (const CAS void*)__builtin_amdgcn_kernarg_segment_ptr(); asm volatile("" : "+s"(p)); return *(const CAS Params*)p; }
#else
__device__ __forceinline__ Params load_params() { return Params{}; }
#endif
#ifndef PG8_SP2
#define PG8_SP2 true
#endif
#ifndef PG8_ALIGN
#define PG8_ALIGN true
#endif
#ifndef REP_MASK
#define REP_MASK 0
#endif
#define NREP(k) (1 + (((REP_MASK) >> (k)) & 1))
#ifdef PHMASK
#define IN(k) (((PHMASK) >> (k)) & 1)
#else
#define IN(k) (lo <= (k) && (k) < hi)
#endif
#define GRID_BARRIER() do { XcdBarrier b_ = bar; asm volatile("" : "+s"(b_.bar)); xcd_barrier(b_); } while (0)
#define SEAM(k) do { if (IN(k) && IN((k) + 1)) GRID_BARRIER(); } while (0)

__device__ __forceinline__ int tail_busy(int nwg, int G) {
#ifdef KEEP_SEAMS
    return 0;
#endif
    const int R = nwg / G, T = nwg - R * G; return (R >= 1 && 2 * T <= G) ? T : 0; }
#define PCNT(base) (WSQ(unsigned, WS_CTL) + CW_PCNT + (base))
#ifndef DOWN_SPLIT
#define DOWN_SPLIT 4
#endif
#ifndef MOE_SPLIT
#define MOE_SPLIT 4
#endif
#ifndef EXCL_WOUT0
#define EXCL_WOUT0 144
#endif
#ifndef EXCL_DOWN
#define EXCL_DOWN 68
#endif
#ifndef EXCL_MOE
#define EXCL_MOE 110
#endif
struct MoeTail { int p0, np, S, nfull, tp; size_t part_off; };
__device__ __forceinline__ MoeTail moe_tail(int ptot, int cap, int gq, int G) {
    int p0 = 0, np = 0;
    while (p0 < ptot) { np = ptot - p0; if (np > cap) np = gq; if (np <= 0 || p0 + np >= ptot) break; p0 += np; }
    pg8::SplitOrder T; T.np = np; T.nct = D / 256; T.G = G; T.init_split(MOE_SPLIT);
    MoeTail r; r.p0 = p0; r.np = np; r.S = T.S; r.nfull = T.nfull; r.tp = T.tail_panels(); r.part_off = WS_ACTM + (size_t)np * 256 * DFE * 2;
    if (r.S > 1 && r.part_off + (size_t)r.S * r.tp * 256 * D * 4 > WS_NEED) { r.S = 1; r.nfull = np * (D / 256); r.tp = 0; }
    return r;
}
#ifdef PROD_OLD
#define PNEED 0u
#else
#define PNEED 32u
#endif
#ifdef TPROBE
#ifndef TPROBE_BLK
#define TPROBE_BLK 0
#endif
#ifndef TPROBE_SCALE
#define TPROBE_SCALE 10
#endif
#define TP_BEGIN(k) do { if ((k) == TPROBE && (int)blockIdx.x == (TPROBE_BLK) && wave0 == 0) { __syncthreads_dummy(); MISC[41] = (unsigned)__builtin_amdgcn_s_memrealtime(); } } while (0)
#define TP_END(k) do { if ((k) == TPROBE && (int)blockIdx.x == (TPROBE_BLK) && wave0 == 0) { MISC[40] += (unsigned)__builtin_amdgcn_s_memrealtime() - MISC[41]; } } while (0)
__device__ __forceinline__ void __syncthreads_dummy() {}
#else
#define TP_BEGIN(k) do {} while (0)
#define TP_END(k) do {} while (0)
#endif
template <int l>
__device__ __forceinline__ void layer_phases(const XcdBarrier& bar, LAS unsigned char* const lds0, volatile LAS unsigned* MISC, const int lo, const int hi, const int wave0) {
        const int pb = 1 + 8 * l;
        for (int rep_ = 0; rep_ < NREP(pb + 1); ++rep_) { if (rep_) GRID_BARRIER();
        if (IN(pb + 1)) {
            const Params Q = load_params(); const Frame F = make_frame(lds0, wave0);
            pg8::Gemm g{WSQ(bf16, WS_H), WSQ(bf16, WS_WIN) + (size_t)l * NZ * D, MT, NZ, D}; pg8::StaticOrder S; S.init(MT, NZ, F.G, F.bx);
            pg8::EpiBf16<0> E{WSQ(bf16, WS_Z), NZ, nullptr, 0, 0, 1.f};
            TP_BEGIN(100 + pb + 1);
            pg8::gemm_phase<pg8::EpiBf16<0>, pg8::StaticOrder, PG8_ALIGN, PG8_SP2>(F.lds, g, S, E, F.wave);
            TP_END(100 + pb + 1);
        } }
        SEAM(pb + 1);
        for (int rep_ = 0; rep_ < NREP(pb + 2); ++rep_) { if (rep_) GRID_BARRIER();
        if (IN(pb + 2)) {
            const Params Q = load_params(); const Frame F = make_frame(lds0, wave0); TP_BEGIN(100 + pb + 2);
#ifdef FORCE_SOLO
            const bool paired = false;
#else
            const bool paired = F.G >= 256;
#endif
            const int nsb = F.G > 128 ? 128 : 0;
#ifndef NO_SCAN
#ifdef SCAN_PIPE
            (void)paired;
            if (F.bx < nsb || nsb == 0) { const int st = nsb ? nsb : F.G; for (int u = F.bx; u < 128; u += st) scan_unit_pipe(Q, F, l, u >> 4, (u >> 1) & 7, u & 1); }
#else
            if (paired) { if (F.bx < 128) scan_unit(Q, F, l, F.bx >> 4, (F.bx >> 1) & 7, F.bx & 1, 0); else if (F.bx < 256) { const int u = F.bx - 128; scan_unit(Q, F, l, u >> 4, (u >> 1) & 7, u & 1, 1); } }
            else if (F.bx < nsb || nsb == 0) { const int st = nsb ? nsb : F.G; for (int u = F.bx; u < 128; u += st) scan_unit(Q, F, l, u >> 4, (u >> 1) & 7, u & 1, 2); }
#endif
#endif
#ifdef PROBE_CF2
            for (int prb_ = 0; prb_ < 2; ++prb_)
#endif
            if (F.bx >= nsb) {
                const int ob = F.bx - nsb, nob = F.G - nsb;
#ifndef NO_CONV
                conv_items(Q, F, l, l == 0 ? MT : NT, ob, nob);
#endif
#ifndef NO_FA
#ifdef PROBE_FA2
                for (int prb_ = 0; prb_ < 2; ++prb_)
#endif
                for (int it = ob; it < 256; it += nob) fourier_a_iter(Q, F, it);
#endif
#ifndef NO_FC
                if (l == 0) for (int u = ob; u < 32; u += nob) fourier_ctx_unit(Q, F, u);
#endif
            }
            TP_END(100 + pb + 2);
        } }
        SEAM(pb + 2);
        for (int rep_ = 0; rep_ < NREP(pb + 3); ++rep_) { if (rep_) GRID_BARRIER();
        if (IN(pb + 3)) {
            const Params Q = load_params(); const Frame F = make_frame(lds0, wave0);
            TP_BEGIN(100 + pb + 3); TP_BEGIN(200 + l);
            LAS bf16* TC64 = (LAS bf16*)F.lds; LAS bf16* TS64 = TC64 + 64 * TP;
            load_tab64(TC64, WSQ(bf16, TAB_C64), F.tid); load_tab64(TS64, WSQ(bf16, TAB_S64), F.tid);
            __syncthreads();
#ifndef NO_FB
#ifdef PROBE_FB2
            for (int prb_ = 0; prb_ < 2; ++prb_)
#endif
            for (int u = F.bx * NWAVES + F.wave; u < 2048; u += F.G * NWAVES) fourier_b_unit(Q, F, u, TC64, TS64);
#endif
            __syncthreads(); TP_END(200 + l);
#ifndef NO_FIN
            finalize_phase(Q, F, l, l == 0 ? MT : NT);
#endif
            TP_END(100 + pb + 3);
        } }
        SEAM(pb + 3);
        for (int rep_ = 0; rep_ < NREP(pb + 4); ++rep_) { if (rep_) GRID_BARRIER();
        if (IN(pb + 4)) {
            const Params Q = load_params(); const Frame F = make_frame(lds0, wave0);
            const int M = l == 0 ? MT : NT;
#ifdef PROD_OLD
            pg8::Gemm g{WSQ(bf16, WS_H), WSQ(bf16, WS_WOUT) + (size_t)l * D * D, M, D, D}; pg8::StaticOrder S; S.init(M, D, F.G, F.bx);
            pg8::EpiBf16<0> E{WSQ(bf16, WS_O32), D, nullptr, 0, 0, 1.f};
            pg8::gemm_phase<pg8::EpiBf16<0>, pg8::StaticOrder, PG8_ALIGN, PG8_SP2>(F.lds, g, S, E, F.wave);
#else
            pg8::Gemm g{WSQ(bf16, WS_H), WSQ(bf16, WS_WOUT) + (size_t)l * D * D, M, D, D}; pg8::PubOrder<pg8::StaticOrder> S; S.init(M, D, F.G, F.bx); S.cntr = PCNT(l == 0 ? PC_WOUT0 : PC_WOUT1); S.pend = -1;
            pg8::EpiBf16WT E{WSQ(bf16, WS_O32), D, 1 << 20};
            TP_BEGIN(l == 0 ? 3 : 7);
            pg8::gemm_phase<pg8::EpiBf16WT, pg8::PubOrder<pg8::StaticOrder>, PG8_ALIGN, PG8_SP2>(F.lds, g, S, E, F.wave);
            TP_END(l == 0 ? 3 : 7);
#endif
        } }
#ifdef KEEP_SEAMS
        SEAM(pb + 4);
#endif
        if (l == 0) {
            if (IN(pb + 5)) { const Params Q = load_params(); const Frame F = make_frame(lds0, wave0); TP_BEGIN(4); phase_post<0, true, false, true>(Q, F, MT, 0, 2048, 1, Q.in[I_CTX], 0, 2, 4096, 3072, PCNT(PC_WOUT0), PNEED, tail_busy((MT / 256) * (D / 256), F.G), (int)((long)MT * EXCL_WOUT0 / 256)); TP_END(4); }
            SEAM(pb + 5);
            for (int rep_ = 0; rep_ < NREP(pb + 6); ++rep_) { if (rep_) GRID_BARRIER();
            if (IN(pb + 6)) {
            const Params Q = load_params(); const Frame F = make_frame(lds0, wave0);
                pg8::Gemm g{WSQ(bf16, WS_H), WSQ(bf16, WS_WGU), MT, 2 * DFF, D}; pg8::StaticOrder S; S.init(MT, 2 * DFF, F.G, F.bx);
                pg8::EpiSwiglu E{WSQ(bf16, WS_Z), DFF, 0, 1 << 20};
                TP_BEGIN(100 + pb + 6);
                pg8::gemm_phase<pg8::EpiSwiglu, pg8::StaticOrder, PG8_ALIGN, PG8_SP2>(F.lds, g, S, E, F.wave);
                TP_END(100 + pb + 6);
            } }
            SEAM(pb + 6);
            for (int rep_ = 0; rep_ < NREP(pb + 7); ++rep_) { if (rep_) GRID_BARRIER();
            if (IN(pb + 7)) {
            const Params Q = load_params(); const Frame F = make_frame(lds0, wave0);
#ifdef PROD_OLD
                pg8::Gemm g{WSQ(bf16, WS_Z), WSQ(bf16, WS_WDN), MT, D, DFF}; pg8::StaticOrder S; S.init(MT, D, F.G, F.bx);
                pg8::EpiBf16<0> E{WSQ(bf16, WS_O32), D, nullptr, 0, 0, 1.f};
                pg8::gemm_phase<pg8::EpiBf16<0>, pg8::StaticOrder, PG8_ALIGN, PG8_SP2>(F.lds, g, S, E, F.wave);
#else
                pg8::Gemm g{WSQ(bf16, WS_Z), WSQ(bf16, WS_WDN), MT, D, DFF};
                pg8::PubOrder<pg8::SplitOrder> S; S.p0 = 0; S.np = MT / 256; S.nct = D / 256; S.G = F.G; S.c = F.bx; S.pb[0] = 0;
#pragma unroll
                for (int j = 1; j < 9; ++j) S.pb[j] = 1 << 20;
                S.init_split(DOWN_SPLIT); S.cntr = PCNT(PC_DOWN0); S.pend = -1;
                pg8::EpiSplitWT E{WSQ(bf16, WS_O32), D, D / 256, WSQ(float, WS_PARTD), S.nfull / (D / 256), S.tail_panels() * 256};
                TP_BEGIN(1);
                pg8::gemm_phase<pg8::EpiSplitWT, pg8::PubOrder<pg8::SplitOrder>, PG8_ALIGN, PG8_SP2>(F.lds, g, S, E, F.wave);
                TP_END(1);
#endif
            } }
#ifdef KEEP_SEAMS
            SEAM(pb + 7);
#endif
            if (IN(pb + 8)) { const Params Q = load_params(); const Frame F = make_frame(lds0, wave0); pg8::SplitOrder T; T.np = MT / 256; T.nct = D / 256; T.G = F.G; T.init_split(DOWN_SPLIT); const bool sp = T.S > 1;
                TP_BEGIN(2); phase_post<0, true, false>(Q, F, MT, 0, 5120, 3, (const float*)(Q.ws + WS_XC), 1, 0, 1024, 0, PCNT(PC_DOWN0), PNEED, sp ? T.tail_panels() * T.nct * T.S : tail_busy(T.np * T.nct, F.G),
                    (int)((long)MT * (sp ? EXCL_DOWN : EXCL_WOUT0) / 256), WSQ(float, WS_PARTD), sp ? (T.nfull / T.nct) * 256 : 0x7fffffff, T.S, T.tail_panels() * 256); TP_END(2); }
            SEAM(pb + 8);
        } else {
            if (IN(pb + 5)) { const Params Q = load_params(); const Frame F = make_frame(lds0, wave0); TP_BEGIN(8); phase_post<0, true, true>(Q, F, NT, 1, 2048, 1, nullptr, 1, 2, 4096, 3072, PCNT(PC_WOUT1), PNEED, tail_busy((NT / 256) * (D / 256), F.G), 0); TP_END(8); }
            SEAM(pb + 5);
            if (IN(pb + 6)) { const Params Q = load_params(); const Frame F = make_frame(lds0, wave0); TP_BEGIN(220); for (int rep_ = 0; rep_ < NREP(15); ++rep_) convert_moe_weights(Q, F); TP_END(220); TP_BEGIN(221); moe_assign_gather(Q, F); TP_END(221); }
            SEAM(pb + 6);
            if (IN(pb + 7)) {
            const Params Q = load_params(); const Frame F = make_frame(lds0, wave0);
                if (F.tid == 0) { MoePlan M; int cnt[NE]; moe_plan(Q, M, cnt);
#pragma unroll
                    for (int j = 0; j < 9; ++j) MISC[16 + j] = (unsigned)M.pb[j]; }
                __syncthreads();
                const int ptot = (int)MISC[16 + 8], gq = (F.G >= 256 && Q.act_cap_panels >= 128) ? 128 : (Q.act_cap_panels < 64 ? Q.act_cap_panels : 64);
                const MoeTail mt = moe_tail(ptot, Q.act_cap_panels, gq, F.G);
                int p0 = 0;
                while (p0 < ptot) {
                    int np = ptot - p0; if (np > Q.act_cap_panels) np = gq;
                    if (np > 0) {
                        for (int rep_ = 0; rep_ < NREP(16); ++rep_) { if (rep_) GRID_BARRIER();
                            pg8::Gemm g{WSQ(bf16, WS_XG), WSQ(bf16, WS_WMGU), 0, 0, D};
                            pg8::MoeOrder S; S.p0 = p0; S.np = np; S.nct = 2 * DFE / 256; S.G = F.G; S.c = F.bx;
#pragma unroll
                            for (int j = 0; j < 9; ++j) S.pb[j] = (int)MISC[16 + j];
                            pg8::EpiSwiglu E{WSQ(bf16, WS_ACTM), DFE, p0, 2 * DFE / 256};
                            TP_BEGIN(222);
                            pg8::gemm_phase<pg8::EpiSwiglu, pg8::MoeOrder, PG8_ALIGN, PG8_SP2>(F.lds, g, S, E, F.wave);
                            TP_END(222);
                        }
                        GRID_BARRIER();
                        for (int rep_ = 0; rep_ < NREP(17); ++rep_) { if (rep_) GRID_BARRIER();
                            pg8::Gemm g{WSQ(bf16, WS_ACTM) - (size_t)p0 * 256 * DFE, WSQ(bf16, WS_WMDN), 0, 0, DFE};
#ifdef PROD_OLD
                            pg8::MoeOrder S; S.p0 = p0; S.np = np; S.nct = D / 256; S.G = F.G; S.c = F.bx;
#pragma unroll
                            for (int j = 0; j < 9; ++j) S.pb[j] = (int)MISC[16 + j];
                            pg8::EpiBf16Mod E{WSQ(bf16, WS_XG), D, D / 256};
                            pg8::gemm_phase<pg8::EpiBf16Mod, pg8::MoeOrder, PG8_ALIGN, PG8_SP2>(F.lds, g, S, E, F.wave);
#else
                            pg8::PubOrder<pg8::SplitOrder> S; S.p0 = p0; S.np = np; S.nct = D / 256; S.G = F.G; S.c = F.bx; S.cntr = PCNT(PC_MOE); S.pend = -1;
#pragma unroll
                            for (int j = 0; j < 9; ++j) S.pb[j] = (int)MISC[16 + j];
                            S.init_split(p0 == mt.p0 ? mt.S : 1);
                            pg8::EpiSplitWT E{WSQ(bf16, WS_XG), D, D / 256, (float*)(Q.ws + mt.part_off), p0 + S.nfull / (D / 256), S.tail_panels() * 256};
                            TP_BEGIN(5);
                            pg8::gemm_phase<pg8::EpiSplitWT, pg8::PubOrder<pg8::SplitOrder>, PG8_ALIGN, PG8_SP2>(F.lds, g, S, E, F.wave);
                            TP_END(5);
#endif
                        }
#ifdef KEEP_SEAMS
                        GRID_BARRIER();
#else
                        if (p0 + np < ptot) GRID_BARRIER();
#endif
                    }
                    p0 += np;
                }
            }
            if (IN(pb + 8)) { const Params Q = load_params(); const Frame F = make_frame(lds0, wave0);
                MoePlan M; int cnt[NE]; moe_plan(Q, M, cnt);
                const int ptot = M.pb[8], gq = (F.G >= 256 && Q.act_cap_panels >= 128) ? 128 : (Q.act_cap_panels < 64 ? Q.act_cap_panels : 64);
                const MoeTail mt = moe_tail(ptot, Q.act_cap_panels, gq, F.G); const bool sp = mt.S > 1;
                TP_BEGIN(6); phase_post<1, false, false>(Q, F, NT, 1, 5120, 3, nullptr, 1, 0, 0, 0, PCNT(PC_MOE), PNEED, sp ? mt.tp * (D / 256) * mt.S : tail_busy(mt.np * (D / 256), F.G),
                    (int)((long)NT * (sp ? EXCL_MOE : 200) / 256), (const float*)(Q.ws + mt.part_off), sp ? (mt.p0 + mt.nfull / (D / 256)) * 256 : 0x7fffffff, mt.S, mt.tp * 256); TP_END(6); }
        }
    }
constexpr int N_PHASES = 18;
__global__ void __launch_bounds__(NTHR, 2) fwd_kernel(Params P) {
    extern __shared__ __attribute__((aligned(16))) unsigned char lds_raw[];
    LAS unsigned char* const lds0 = (LAS unsigned char*)lds_raw;
    volatile LAS unsigned* MISC = (volatile LAS unsigned*)(lds0 + MISC_OFF);
    const int wave0 = __builtin_amdgcn_readfirstlane((int)threadIdx.x >> 6);
    if (wave0 == 0) MISC[__builtin_amdgcn_mbcnt_hi(~0u, __builtin_amdgcn_mbcnt_lo(~0u, 0u))] = 0u;
    __syncthreads();
    unsigned* ctl = (unsigned*)(P.ws + WS_CTL);
    XcdBarrier bar = xcd_barrier_post(ctl + CW_BAR + P.li * XCD_BAR_WORDS, MISC + 8, wave0 == 0 ? 1u : 0u);
    const int lo = P.ph_lo, hi = P.ph_hi;
    for (int rep_ = 0; rep_ < NREP(0); ++rep_) { if (rep_) GRID_BARRIER(); if (IN(0)) { const Params Q = load_params(); const Frame F = make_frame(lds0, wave0); TP_BEGIN(210); p0_adaln(Q, F); TP_END(210); TP_BEGIN(211); p0_small_weights(Q, F); TP_END(211); TP_BEGIN(212); p0_tables(Q, F); TP_END(212); } }
    SEAM(0);
#ifdef PROBE_FN_NOSTORE
    for (int rep_ = 0; rep_ < 2; ++rep_) { if (rep_) GRID_BARRIER(); if (IN(1)) { const Params Q = load_params(); const Frame F = make_frame(lds0, wave0); phase_first_norm(Q, F); } }
#else
    for (int rep_ = 0; rep_ < NREP(1); ++rep_) { if (rep_) GRID_BARRIER(); if (IN(1)) { const Params Q = load_params(); const Frame F = make_frame(lds0, wave0); TP_BEGIN(101); phase_first_norm(Q, F); TP_END(101); } }
#endif
    SEAM(1);
#ifdef PROBE_BAR
    for (int prb_ = 0; prb_ < 20; ++prb_) GRID_BARRIER();
#endif
    layer_phases<0>(bar, lds0, MISC, lo, hi, wave0);
    layer_phases<1>(bar, lds0, MISC, lo, hi, wave0);
#ifdef TPROBE
    if ((int)blockIdx.x == (TPROBE_BLK) && wave0 == 0) { const unsigned long long t0 = __builtin_amdgcn_s_memrealtime(), dt = (unsigned long long)MISC[40] * (TPROBE_SCALE);
        while (__builtin_amdgcn_s_memrealtime() - t0 < dt) __builtin_amdgcn_s_sleep(8); }
#endif
#undef IN
#undef SEAM
}

#ifndef MK_PER_PHASE
#define MK_PER_PHASE 0
#endif
extern "C" void kernel_launch(void* const* d_in, const int* in_sizes, int n_in, void* d_out, int out_size, void* d_ws, size_t ws_size, hipStream_t stream) {
    static int grid = 0;
    if (grid == 0) {
        if (n_in != N_IN || in_sizes[0] != NT * D || out_size != NT * D || ws_size < WS_NEED) {
            fprintf(stderr, "kernel_launch: unexpected shapes (n_in %d, in0 %d, out %d, ws %zu); nothing launched\n", n_in, n_in > 0 ? in_sizes[0] : -1, out_size, ws_size); grid = -1; return; }
        int dev = 0, cus = 0, per_cu = 0;
        if (hipGetDevice(&dev) != hipSuccess || hipDeviceGetAttribute(&cus, hipDeviceAttributeMultiprocessorCount, dev) != hipSuccess) { grid = -1; return; }
        if (hipFuncSetAttribute((const void*)fwd_kernel, hipFuncAttributeMaxDynamicSharedMemorySize, LDS_BYTES) != hipSuccess) { fprintf(stderr, "kernel_launch: hipFuncSetAttribute failed\n"); grid = -1; return; }
        if (hipOccupancyMaxActiveBlocksPerMultiprocessor(&per_cu, (const void*)fwd_kernel, NTHR, LDS_BYTES) != hipSuccess || per_cu < 1)
            fprintf(stderr, "kernel_launch: occupancy query reports %d workgroups per CU\n", per_cu);
        (void)hipGetLastError();
        grid = cus;
    }
    if (grid < 0) return;
    if (hipMemsetAsync((char*)d_ws + WS_CTL, 0, CTL_ZERO_BYTES, stream) != hipSuccess) return;
    Params p{};
    for (int i = 0; i < N_IN; ++i) p.in[i] = (const float*)d_in[i];
    p.out = (float*)d_out; p.ws = (unsigned char*)d_ws;
    { size_t avail = ws_size - WS_ACTM; size_t cap = avail / ((size_t)256 * DFE * 2); if (cap > 264) cap = 264; p.act_cap_panels = (int)cap; }
#if MK_PER_PHASE
    int li = 0;
    for (int ph = 0; ph < N_PHASES; ++ph) {
        p.ph_lo = ph; p.ph_hi = ph + 1; p.li = li++;
        hipLaunchKernelGGL(fwd_kernel, dim3(grid), dim3(NTHR), LDS_BYTES, stream, p);
    }
#else
    p.ph_lo = 0; p.ph_hi = N_PHASES; p.li = 0;
    hipLaunchKernelGGL(fwd_kernel, dim3(grid), dim3(NTHR), LDS_BYTES, stream, p);
#endif
}
```

```cpp
#define POST_PLAINLD 1
#include <hip/hip_runtime.h>
#include <cstdio>
#include <cstdint>
namespace pg8 {
#define PG8_LAS __attribute__((address_space(3)))
typedef unsigned short bf16_t;
typedef short bf16x8 __attribute__((ext_vector_type(8)));
typedef float f32x4 __attribute__((ext_vector_type(4)));
typedef unsigned u32x4 __attribute__((ext_vector_type(4)));
constexpr int BM = 256, BK = 64, HALF = 128, HTB = HALF * BK * 2  , STAGE_BYTES = 8 * HTB, NXCD = 8, WGM = 8;

__host__ __device__ __forceinline__ int lds_byte(int r, int c) { const int st = (r >> 4) * 2 + (c >> 5), rr = r & 15, cc = c & 31, ob = rr * 64 + cc * 2; return st * 1024 + (ob ^ (((ob >> 9) & 1) << 5)); }
__host__ __device__ __forceinline__ void stage_rc(int b, int& R, int& C) { const int st = b / 1024, sb = b % 1024, swz = sb ^ (((sb >> 9) & 1) << 5); R = (st >> 1) * 16 + swz / 64; C = (st & 1) * 32 + (swz % 64) / 2; }
__host__ __device__ __forceinline__ int perm32(int rho) { const int n = rho >> 4, i = rho & 15; return 8 * (i >> 2) + 4 * n + (i & 3); }

struct Unit { int pm, pn; };
struct Gemm { const bf16_t* A; const bf16_t* Bt; int M, N, K; };

struct StaticOrder {
    static constexpr bool SPLITK = false;
    int nM, nN, nwg, G, c;
    __host__ __device__ void init(int M, int N, int G_, int c_) { nM = M / BM; nN = N / BM; nwg = nM * nN; G = G_; c = c_; }
    __host__ __device__ bool next(int i, Unit& u) const {
        const long L = (long)i * G + c; if (L >= nwg) return false;
        int wgid = (int)L; { const int q = nwg / NXCD, r = nwg % NXCD, xcd = wgid % NXCD, off = wgid / NXCD; wgid = (xcd < r ? xcd * (q + 1) : r * (q + 1) + (xcd - r) * q) + off; }
        const int nig = WGM * nN, gid = wgid / nig, fm = gid * WGM, gsz = (nM - fm) < WGM ? (nM - fm) : WGM;
        u.pm = fm + ((wgid % nig) % gsz); u.pn = (wgid % nig) / gsz; return true;
    }
    __device__ __forceinline__ void a_ready(const Unit&) const {}
    __device__ __forceinline__ void done(const Unit&) const {}
    __device__ __forceinline__ void flush() const {}
};

__device__ __forceinline__ unsigned cvt_pk_bf16(float lo, float hi) { unsigned r; asm volatile("v_cvt_pk_bf16_f32 %0, %1, %2" : "=v"(r) : "v"(lo), "v"(hi)); return r; }
typedef float f32x2 __attribute__((ext_vector_type(2)));
__device__ __forceinline__ f32x2 gelu_pk(f32x2 v) {
    const f32x2 av = __builtin_elementwise_abs(v), d = av * 0.2316418882f + 1.0f;
    f32x2 t; t.x = __builtin_amdgcn_rcpf(d.x); t.y = __builtin_amdgcn_rcpf(d.y);
    f32x2 q = t * 0.5307027145f + (-0.7265760135f); q = q * t + 0.7107068705f; q = q * t + (-0.142248368f); q = q * t + 0.127414796f; q = q * t;
    const f32x2 s = (v * v) * (-0.72134752044f);
    f32x2 e; e.x = __builtin_amdgcn_exp2f(s.x); e.y = __builtin_amdgcn_exp2f(s.y);
    const f32x2 m = v * (q * e), r = v - m;
    f32x2 o; o.x = v.x < 0.f ? m.x : r.x; o.y = v.y < 0.f ? m.y : r.y; return o;
}

template <int ACT  > struct EpiBf16 {
    static constexpr bool PERM = true, AFTER_DRAIN = false; static_assert(ACT == 0 || ACT == 1, "EpiBf16: ACT is 0 (none) or 1 (gelu_pk)");
    bf16_t* O; int ldc; const float* bias; int split_cols; size_t split_stride; float scale0;
    __device__ __forceinline__ void operator()(const f32x4 (&acc)[2][2][4][2], const Unit& u, int wr, int wc, int fr, int fq) const {
        const int row0 = u.pm * BM + wr * 64 + fr; int colt = u.pn * BM; bf16_t* base = O;
        float sc = 1.f; if (split_cols) { const int t = colt / split_cols; base += (size_t)t * split_stride; colt -= t * split_cols; if (t == 0) sc = scale0; }
        const int col0 = colt + wc * 32 + 8 * fq, bcol0 = u.pn * BM + wc * 32 + 8 * fq;
        f32x4 bv[2][2];
#pragma unroll
        for (int bj = 0; bj < 2; ++bj)
#pragma unroll
            for (int n = 0; n < 2; ++n) bv[bj][n] = bias ? *(const f32x4*)(bias + bcol0 + bj * HALF + 4 * n) : (f32x4){0.f, 0.f, 0.f, 0.f};
#pragma unroll
        for (int ai = 0; ai < 2; ++ai)
#pragma unroll
            for (int m = 0; m < 4; ++m) { bf16_t* rowp = base + (size_t)(row0 + ai * HALF + m * 16) * ldc + col0;
#pragma unroll
                for (int bj = 0; bj < 2; ++bj) { f32x4 v0 = acc[ai][bj][m][0] + bv[bj][0], v1 = acc[ai][bj][m][1] + bv[bj][1];
                    if (ACT == 1) { f32x2 a = gelu_pk((f32x2){v0[0], v0[1]}), b = gelu_pk((f32x2){v0[2], v0[3]}), c = gelu_pk((f32x2){v1[0], v1[1]}), d = gelu_pk((f32x2){v1[2], v1[3]});
                        v0 = (f32x4){a.x, a.y, b.x, b.y}; v1 = (f32x4){c.x, c.y, d.x, d.y}; }
                    v0 = v0 * sc; v1 = v1 * sc; u32x4 w; w.x = cvt_pk_bf16(v0[0], v0[1]); w.y = cvt_pk_bf16(v0[2], v0[3]); w.z = cvt_pk_bf16(v1[0], v1[1]); w.w = cvt_pk_bf16(v1[2], v1[3]);
                    *(u32x4*)(rowp + bj * HALF) = w; } }
    }
};

struct EpiF32 {
    static constexpr bool PERM = false, AFTER_DRAIN = false;
    float* C; int ldc; const float* bias;
    __device__ __forceinline__ void operator()(const f32x4 (&acc)[2][2][4][2], const Unit& u, int wr, int wc, int fr, int fq) const {
        const int row0 = u.pm * BM + wr * 64 + fr, col0 = u.pn * BM + wc * 32 + 4 * fq;
        f32x4 bv[2][2];
#pragma unroll
        for (int bj = 0; bj < 2; ++bj)
#pragma unroll
            for (int n = 0; n < 2; ++n) bv[bj][n] = bias ? *(const f32x4*)(bias + col0 + bj * HALF + n * 16) : (f32x4){0.f, 0.f, 0.f, 0.f};
#pragma unroll
        for (int ai = 0; ai < 2; ++ai)
#pragma unroll
            for (int m = 0; m < 4; ++m) { float* rowp = C + (size_t)(row0 + ai * HALF + m * 16) * ldc + col0;
#pragma unroll
                for (int bj = 0; bj < 2; ++bj)
#pragma unroll
                    for (int n = 0; n < 2; ++n) *(f32x4*)(rowp + bj * HALF + n * 16) = acc[ai][bj][m][n] + bv[bj][n]; }
    }
};
template <class Epi, class Sched, bool ALIGN_EPI = false, bool SP2 = false>
__device__ __forceinline__ void gemm_phase(PG8_LAS unsigned char* lds, const Gemm g, const Sched& S, const Epi& E, const int wave_in) {
    int tid_ = wave_in * 64 + (int)__builtin_amdgcn_mbcnt_hi(~0u, __builtin_amdgcn_mbcnt_lo(~0u, 0u)); asm volatile("" : "+v"(tid_));
    const int tid = tid_, wid = __builtin_amdgcn_readfirstlane(tid >> 6), lane = tid & 63, wr = wid >> 2, wc = wid & 3, fr = lane & 15, fq = lane >> 4;
    const int K = g.K, nt = K / BK;
    unsigned voffA[2], voffB[2];
#pragma unroll
    for (int i = 0; i < 2; ++i) { int R, C; stage_rc(tid * 16 + i * 8192, R, C); const int Rb = Epi::PERM ? ((R & ~31) + perm32(R & 31)) : R;
        voffA[i] = (unsigned)(R * K + C) * 2u; voffB[i] = (unsigned)(Rb * K + C) * 2u; }
    const size_t kstep = (size_t)(BK * 2);
    const size_t hstep = (size_t)HALF * K * 2;
    const size_t tstep = 2 * hstep;
    const unsigned ldsw = (unsigned)wid * 1024u;
    const int aoff = lds_byte(wr * 64 + fr, fq * 8), boff = lds_byte(wc * 32 + fr, fq * 8);
#define PG8_SA(b, h) (((b) * 2 + (h)) * HTB)
#define PG8_SB(b, h) ((4 + (b) * 2 + (h)) * HTB)
#define PG8_STAGE(bufoff, gbase, voff) do { _Pragma("unroll") for (int _i = 0; _i < 2; ++_i) \
        __builtin_amdgcn_global_load_lds((const unsigned*)((const char*)(gbase) + (voff)[_i]), (PG8_LAS unsigned*)(lds + (bufoff) + ldsw + _i * 8192), 16, 0, 0); } while (0)
#define PG8_LDA(dst, b, h) do { _Pragma("unroll") for (int m = 0; m < 4; ++m) _Pragma("unroll") for (int k = 0; k < 2; ++k) dst[m][k] = *(const PG8_LAS bf16x8*)(lds + PG8_SA(b, h) + aoff + m * 2048 + k * 1024); } while (0)
#define PG8_LDB(dst, b, h) do { _Pragma("unroll") for (int n = 0; n < 2; ++n) _Pragma("unroll") for (int k = 0; k < 2; ++k) dst[n][k] = *(const PG8_LAS bf16x8*)(lds + PG8_SB(b, h) + boff + n * 2048 + k * 1024); } while (0)
#define PG8_MMA(ai, bj, At, Bt) do { __builtin_amdgcn_s_setprio(1); _Pragma("unroll") for (int m = 0; m < 4; ++m) _Pragma("unroll") for (int n = 0; n < 2; ++n) _Pragma("unroll") for (int k = 0; k < 2; ++k) \
        acc[ai][bj][m][n] = __builtin_amdgcn_mfma_f32_16x16x32_bf16(Bt[n][k], At[m][k], acc[ai][bj][m][n], 0, 0, 0); __builtin_amdgcn_s_setprio(0); } while (0)
#define PG8_WAIT_V(n) asm volatile("s_waitcnt vmcnt(" #n ")" ::: "memory")
#define PG8_WAIT_L(n) asm volatile("s_waitcnt lgkmcnt(" #n ")" ::: "memory")
#define PG8_BAR __builtin_amdgcn_s_barrier()
#define PG8_SCHED __builtin_amdgcn_sched_barrier(0)
    Unit cur, nxt; int ui = 0;
    if (!S.next(0, cur)) return;
    f32x4 acc[2][2][4][2];
#pragma unroll
    for (int a = 0; a < 2; ++a)
#pragma unroll
        for (int b = 0; b < 2; ++b)
#pragma unroll
            for (int m = 0; m < 4; ++m)
#pragma unroll
                for (int n = 0; n < 2; ++n) acc[a][b][m][n] = (f32x4){0.f, 0.f, 0.f, 0.f};
    bf16x8 At[4][2], B0[2][2], B1[2][2];
    const char* cA = (const char*)g.A + (size_t)cur.pm * tstep; const char* cB = (const char*)g.Bt + (size_t)cur.pn * tstep;
    int cnt = nt;
    if constexpr (Sched::SPLITK) { cnt = S.ktiles(cur, nt); cA += S.kbyte(cur, nt); cB = (const char*)g.Bt + (size_t)S.btile(cur) * tstep + S.kbyte(cur, nt); }
    S.a_ready(cur);
    if constexpr (SP2) {
        PG8_STAGE(PG8_SB(0, 0), cB, voffB); PG8_STAGE(PG8_SB(0, 1), cB + hstep, voffB); PG8_STAGE(PG8_SA(0, 0), cA, voffA); PG8_STAGE(PG8_SA(0, 1), cA + hstep, voffA);
        if (wr == 1) PG8_BAR;
        PG8_WAIT_V(2); PG8_BAR;
        PG8_STAGE(PG8_SB(1, 0), cB + kstep, voffB); PG8_STAGE(PG8_SA(1, 0), cA + kstep, voffA); PG8_STAGE(PG8_SB(1, 1), cB + hstep + kstep, voffB);
        PG8_WAIT_V(6); PG8_BAR;
    } else {
        PG8_STAGE(PG8_SB(0, 0), cB, voffB); PG8_STAGE(PG8_SA(0, 0), cA, voffA); PG8_STAGE(PG8_SB(0, 1), cB + hstep, voffB); PG8_STAGE(PG8_SA(0, 1), cA + hstep, voffA);
        if (wr == 1) PG8_BAR;
        PG8_WAIT_V(4); PG8_BAR;
        PG8_STAGE(PG8_SB(1, 0), cB + kstep, voffB); PG8_STAGE(PG8_SA(1, 0), cA + kstep, voffA); PG8_STAGE(PG8_SB(1, 1), cB + hstep + kstep, voffB);
        PG8_WAIT_V(6); PG8_BAR;
    }
    for (;;) {
        const bool has_next = S.next(ui + 1, nxt);
        const char* nA = has_next ? (const char*)g.A + (size_t)nxt.pm * tstep : cA; const char* nB = has_next ? (const char*)g.Bt + (size_t)nxt.pn * tstep : cB;
        if constexpr (Sched::SPLITK) { if (has_next) { nA += S.kbyte(nxt, nt); nB = (const char*)g.Bt + (size_t)S.btile(nxt) * tstep + S.kbyte(nxt, nt); } }
        for (int t = 0; t < cnt; t += 2) {
            const bool last = (t == cnt - 2);
            const char* a1 = cA + (size_t)(t + 1) * kstep;
            const char* a2 = last ? nA : cA + (size_t)(t + 2) * kstep; const char* b2 = last ? nB : cB + (size_t)(t + 2) * kstep;
            const char* a3 = a2 + kstep; const char* b3 = b2 + kstep;
            if (last && has_next) S.a_ready(nxt);
            if constexpr (SP2) {
            PG8_LDB(B0, 0, 0); PG8_LDB(B1, 0, 1); PG8_SCHED; PG8_LDA(At, 0, 0); PG8_STAGE(PG8_SA(1, 1), a1 + hstep, voffA);
            PG8_WAIT_V(8); PG8_WAIT_L(0); PG8_BAR; PG8_MMA(0, 0, At, B0); PG8_MMA(0, 1, At, B1); PG8_BAR; PG8_SCHED;
            PG8_LDA(At, 0, 1); PG8_STAGE(PG8_SB(0, 0), b2, voffB); PG8_STAGE(PG8_SB(0, 1), b2 + hstep, voffB); PG8_STAGE(PG8_SA(0, 0), a2, voffA);
            PG8_WAIT_V(8); PG8_WAIT_L(0); PG8_BAR; PG8_MMA(1, 0, At, B0); PG8_MMA(1, 1, At, B1); PG8_BAR; PG8_SCHED;
            PG8_LDB(B0, 1, 0); PG8_LDB(B1, 1, 1); PG8_SCHED; PG8_LDA(At, 1, 0); PG8_STAGE(PG8_SA(0, 1), a2 + hstep, voffA);
            PG8_WAIT_V(8); PG8_WAIT_L(0); PG8_BAR; PG8_MMA(0, 0, At, B0); PG8_MMA(0, 1, At, B1); PG8_BAR; PG8_SCHED;
            PG8_LDA(At, 1, 1); PG8_STAGE(PG8_SB(1, 0), b3, voffB); PG8_STAGE(PG8_SB(1, 1), b3 + hstep, voffB); PG8_STAGE(PG8_SA(1, 0), a3, voffA);
            PG8_WAIT_V(8); PG8_WAIT_L(0); PG8_BAR; PG8_MMA(1, 0, At, B0); PG8_MMA(1, 1, At, B1); PG8_BAR; PG8_SCHED;
            } else {
            PG8_LDB(B0, 0, 0); PG8_SCHED; PG8_LDA(At, 0, 0); PG8_STAGE(PG8_SA(1, 1), a1 + hstep, voffA);
            PG8_WAIT_L(8); PG8_BAR; PG8_WAIT_L(0); PG8_MMA(0, 0, At, B0); PG8_BAR; PG8_SCHED;
            PG8_LDB(B1, 0, 1); PG8_STAGE(PG8_SB(0, 0), b2, voffB);
            PG8_BAR; PG8_WAIT_L(0); PG8_MMA(0, 1, At, B1); PG8_BAR;
            PG8_LDA(At, 0, 1); PG8_STAGE(PG8_SA(0, 0), a2, voffA);
            PG8_BAR; PG8_WAIT_L(0); PG8_MMA(1, 0, At, B0); PG8_BAR; PG8_SCHED;
            PG8_STAGE(PG8_SB(0, 1), b2 + hstep, voffB);
            PG8_WAIT_V(6); PG8_BAR; PG8_MMA(1, 1, At, B1); PG8_BAR;
            PG8_LDB(B0, 1, 0); PG8_SCHED; PG8_LDA(At, 1, 0); PG8_STAGE(PG8_SA(0, 1), a2 + hstep, voffA);
            PG8_WAIT_L(8); PG8_BAR; PG8_WAIT_L(0); PG8_MMA(0, 0, At, B0); PG8_BAR; PG8_SCHED;
            PG8_LDB(B1, 1, 1); PG8_STAGE(PG8_SB(1, 0), b3, voffB);
            PG8_BAR; PG8_WAIT_L(0); PG8_MMA(0, 1, At, B1); PG8_BAR;
            PG8_LDA(At, 1, 1); PG8_STAGE(PG8_SA(1, 0), a3, voffA);
            PG8_BAR; PG8_WAIT_L(0); PG8_MMA(1, 0, At, B0); PG8_BAR; PG8_SCHED;
            PG8_STAGE(PG8_SB(1, 1), b3 + hstep, voffB);
            PG8_WAIT_V(6); PG8_BAR; PG8_MMA(1, 1, At, B1); PG8_BAR;
            }
        }
        if constexpr (ALIGN_EPI) { if (wr == 0) PG8_BAR; }
        if constexpr (!Epi::AFTER_DRAIN) { E(acc, cur, wr, wc, fr, fq); S.done(cur); }
        if (!has_next) break;
#pragma unroll
        for (int a = 0; a < 2; ++a)
#pragma unroll
            for (int b = 0; b < 2; ++b)
#pragma unroll
                for (int m = 0; m < 4; ++m)
#pragma unroll
                    for (int n = 0; n < 2; ++n) acc[a][b][m][n] = (f32x4){0.f, 0.f, 0.f, 0.f};
        cur = nxt; cA = nA; cB = nB; ++ui;
        if constexpr (Sched::SPLITK) cnt = S.ktiles(cur, nt);
        if constexpr (ALIGN_EPI) { if (wr == 1) PG8_BAR; }
    }
    PG8_WAIT_V(0);
    S.flush();
    if constexpr (!ALIGN_EPI) { if (wr == 0) PG8_BAR; }
    PG8_BAR;
    if constexpr (Epi::AFTER_DRAIN) { E.fused(acc, cur, wr, wc, fr, fq, lds, wid, lane); S.done(cur); }
#undef PG8_SA
#undef PG8_SB
#undef PG8_STAGE
#undef PG8_LDA
#undef PG8_LDB
#undef PG8_MMA
#undef PG8_WAIT_V
#undef PG8_WAIT_L
#undef PG8_BAR
#undef PG8_SCHED
}
}

namespace pg8 {
struct EpiSwiglu {
    static constexpr bool PERM = true, AFTER_DRAIN = false;
    bf16_t* O; int ldo; int p0; int nct;
    __device__ __forceinline__ void operator()(const f32x4 (&acc)[2][2][4][2], const Unit& u, int wr, int wc, int fr, int fq) const {
        const int row0 = (u.pm - p0) * BM + wr * 64 + fr, col0 = (u.pn % nct) * HALF + wc * 32 + 8 * fq;
#pragma unroll
        for (int ai = 0; ai < 2; ++ai)
#pragma unroll
            for (int m = 0; m < 4; ++m) { bf16_t* rowp = O + (size_t)(row0 + ai * HALF + m * 16) * ldo + col0;
                float a[8];
#pragma unroll
                for (int n = 0; n < 2; ++n)
#pragma unroll
                    for (int j = 0; j < 4; ++j) { const float g = acc[ai][0][m][n][j], up = acc[ai][1][m][n][j]; a[n * 4 + j] = g * __builtin_amdgcn_rcpf(1.0f + __expf(-g)) * up; }
                u32x4 w; w.x = cvt_pk_bf16(a[0], a[1]); w.y = cvt_pk_bf16(a[2], a[3]); w.z = cvt_pk_bf16(a[4], a[5]); w.w = cvt_pk_bf16(a[6], a[7]);
                *(u32x4*)rowp = w; }
    }
};
struct EpiBf16Mod {
    static constexpr bool PERM = true, AFTER_DRAIN = false;
    bf16_t* O; int ldc; int nct;
    __device__ __forceinline__ void operator()(const f32x4 (&acc)[2][2][4][2], const Unit& u, int wr, int wc, int fr, int fq) const {
        const int row0 = u.pm * BM + wr * 64 + fr, col0 = (u.pn % nct) * BM + wc * 32 + 8 * fq;
#pragma unroll
        for (int ai = 0; ai < 2; ++ai)
#pragma unroll
            for (int m = 0; m < 4; ++m) { bf16_t* rowp = O + (size_t)(row0 + ai * HALF + m * 16) * ldc + col0;
#pragma unroll
                for (int bj = 0; bj < 2; ++bj) { const f32x4 v0 = acc[ai][bj][m][0], v1 = acc[ai][bj][m][1];
                    u32x4 w; w.x = cvt_pk_bf16(v0[0], v0[1]); w.y = cvt_pk_bf16(v0[2], v0[3]); w.z = cvt_pk_bf16(v1[0], v1[1]); w.w = cvt_pk_bf16(v1[2], v1[3]);
                    *(u32x4*)(rowp + bj * HALF) = w; } }
    }
};
struct MoeOrder {
    static constexpr bool SPLITK = false;
    int p0, np, nct, G, c; int pb[9];
    __device__ __forceinline__ bool next(int i, Unit& u) const {
        const int L = i * G + c; if (L >= np * nct) return false;
        const int nig = WGM * nct, gid = L / nig, fm = gid * WGM, gsz = (np - fm) < WGM ? (np - fm) : WGM, r = L % nig;
        const int pm = p0 + fm + (r % gsz), ct = r / gsz;
        int e = 0;
#pragma unroll
        for (int j = 1; j < 8; ++j) e += (pm >= pb[j]) ? 1 : 0;
        u.pm = pm; u.pn = e * nct + ct; return true;
    }
    __device__ __forceinline__ void a_ready(const Unit&) const {}
    __device__ __forceinline__ void done(const Unit&) const {}
    __device__ __forceinline__ void flush() const {}
};
#ifndef WT_AUX
#define WT_AUX 16
#endif
struct EpiBf16WT {
    static constexpr bool PERM = true, AFTER_DRAIN = false;
    bf16_t* O; int ldc; int nct;
    __device__ __forceinline__ void operator()(const f32x4 (&acc)[2][2][4][2], const Unit& u, int wr, int wc, int fr, int fq) const {
        const __amdgpu_buffer_rsrc_t rs = __builtin_amdgcn_make_buffer_rsrc(O, 0, 0x7ffffff0, 0x00020000);
        const unsigned row0 = (unsigned)(u.pm * BM + wr * 64 + fr), col0 = (unsigned)((u.pn % nct) * BM + wc * 32 + 8 * fq);
#pragma unroll
        for (int ai = 0; ai < 2; ++ai)
#pragma unroll
            for (int m = 0; m < 4; ++m) { const unsigned off = ((row0 + (unsigned)(ai * HALF + m * 16)) * (unsigned)ldc + col0) * 2u;
#pragma unroll
                for (int bj = 0; bj < 2; ++bj) { const f32x4 v0 = acc[ai][bj][m][0], v1 = acc[ai][bj][m][1];
                    u32x4 w; w.x = cvt_pk_bf16(v0[0], v0[1]); w.y = cvt_pk_bf16(v0[2], v0[3]); w.z = cvt_pk_bf16(v1[0], v1[1]); w.w = cvt_pk_bf16(v1[2], v1[3]);
                    __builtin_amdgcn_raw_buffer_store_b128(w, rs, off + (unsigned)(bj * HALF * 2), 0, WT_AUX); } }
    }
};
constexpr int SPLIT_FLAG = 1 << 14;
struct SplitOrder {
    static constexpr bool SPLITK = true;
    int p0, np, nct, G, c; int pb[9];
    int nfull, S;
    __device__ __forceinline__ void init_split(int S_) { const int nu = np * nct, R = nu / G, T = nu - R * G; if (S_ > 1 && R >= 1 && T > 0 && T * S_ <= G && (T % nct) == 0) { nfull = R * G; S = S_; } else { nfull = nu; S = 1; } }
    __device__ __forceinline__ int tail_panels() const { return (np * nct - nfull) / nct; }
    __device__ __forceinline__ bool next(int i, Unit& u) const {
        const int L = i * G + c; int pm, ct, ks = -1;
        if (L < nfull) { const int nig = WGM * nct, gid = L / nig, fm = gid * WGM, gsz = (np - fm) < WGM ? (np - fm) : WGM, r = L % nig; pm = p0 + fm + (r % gsz); ct = r / gsz; }
        else { if (S == 1) return false; const int j = L - nfull, tp = tail_panels(); if (j >= tp * nct * S) return false; const int rest = j / tp; pm = p0 + nfull / nct + (j % tp); ct = rest % nct; ks = rest / nct; }
        int e = 0;
#pragma unroll
        for (int j = 1; j < 8; ++j) e += (pm >= pb[j]) ? 1 : 0;
        u.pm = pm; u.pn = ks < 0 ? (e * nct + ct) : (SPLIT_FLAG | (ks << 6) | (e * nct + ct)); return true;
    }
    __device__ __forceinline__ int ktiles(const Unit& u, int nt) const { if (!(u.pn & SPLIT_FLAG)) return nt; const int ks = (u.pn >> 6) & 15, pairs = nt >> 1, q = pairs / S, r = pairs - q * S; return 2 * (q + (ks < r ? 1 : 0)); }
    __device__ __forceinline__ size_t kbyte(const Unit& u, int nt) const { if (!(u.pn & SPLIT_FLAG)) return 0; const int ks = (u.pn >> 6) & 15, pairs = nt >> 1, q = pairs / S, r = pairs - q * S; return (size_t)(ks * q + (ks < r ? ks : r)) * (2 * BK * 2); }
    __device__ __forceinline__ int btile(const Unit& u) const { return u.pn & 63; }
    __device__ __forceinline__ void a_ready(const Unit&) const {}
    __device__ __forceinline__ void done(const Unit&) const {}
    __device__ __forceinline__ void flush() const {}
};
struct EpiSplitWT {
    static constexpr bool PERM = true, AFTER_DRAIN = false;
    bf16_t* O; int ldc; int nct; float* part; int ptail0; int tail_rows;
    __device__ __forceinline__ void operator()(const f32x4 (&acc)[2][2][4][2], const Unit& u, int wr, int wc, int fr, int fq) const {
        const unsigned col0 = (unsigned)(((u.pn & 63) % nct) * BM + wc * 32 + 8 * fq);
        if (!(u.pn & SPLIT_FLAG)) {
            const __amdgpu_buffer_rsrc_t rs = __builtin_amdgcn_make_buffer_rsrc(O, 0, 0x7ffffff0, 0x00020000);
            const unsigned row0 = (unsigned)(u.pm * BM + wr * 64 + fr);
#pragma unroll
            for (int ai = 0; ai < 2; ++ai)
#pragma unroll
                for (int m = 0; m < 4; ++m) { const unsigned off = ((row0 + (unsigned)(ai * HALF + m * 16)) * (unsigned)ldc + col0) * 2u;
#pragma unroll
                    for (int bj = 0; bj < 2; ++bj) { const f32x4 v0 = acc[ai][bj][m][0], v1 = acc[ai][bj][m][1];
                        u32x4 w; w.x = cvt_pk_bf16(v0[0], v0[1]); w.y = cvt_pk_bf16(v0[2], v0[3]); w.z = cvt_pk_bf16(v1[0], v1[1]); w.w = cvt_pk_bf16(v1[2], v1[3]);
                        __builtin_amdgcn_raw_buffer_store_b128(w, rs, off + (unsigned)(bj * HALF * 2), 0, WT_AUX); } }
        } else {
            const __amdgpu_buffer_rsrc_t rs = __builtin_amdgcn_make_buffer_rsrc(part, 0, 0x7ffffff0, 0x00020000);
            const unsigned row0 = (unsigned)(((u.pn >> 6) & 15) * tail_rows + (u.pm - ptail0) * BM + wr * 64 + fr);
#pragma unroll
            for (int ai = 0; ai < 2; ++ai)
#pragma unroll
                for (int m = 0; m < 4; ++m) { const unsigned off = ((row0 + (unsigned)(ai * HALF + m * 16)) * (unsigned)ldc + col0) * 4u;
#pragma unroll
                    for (int bj = 0; bj < 2; ++bj) {
                        __builtin_amdgcn_raw_buffer_store_b128(__builtin_bit_cast(u32x4, acc[ai][bj][m][0]), rs, off + (unsigned)(bj * HALF * 4), 0, WT_AUX);
                        __builtin_amdgcn_raw_buffer_store_b128(__builtin_bit_cast(u32x4, acc[ai][bj][m][1]), rs, off + (unsigned)(bj * HALF * 4 + 16), 0, WT_AUX); } }
        }
    }
};
template <class Base> struct PubOrder : Base {
    unsigned* cntr; mutable int pend;
    __device__ __forceinline__ void pub() const {
        if (pend >= 0) { if (__builtin_amdgcn_mbcnt_hi(~0u, __builtin_amdgcn_mbcnt_lo(~0u, 0u)) == 0u) __hip_atomic_fetch_add(cntr + 16 * pend, 1u, __ATOMIC_RELAXED, __HIP_MEMORY_SCOPE_AGENT); pend = -1; }
    }
    __device__ __forceinline__ void a_ready(const Unit& u) const { Base::a_ready(u); pub(); }
    __device__ __forceinline__ void done(const Unit& u) const {
#ifdef PUB_EAGER
        asm volatile("s_waitcnt vmcnt(0)" ::: "memory"); pend = u.pm; pub();
#else
        pub(); pend = u.pm;
#endif
    }
    __device__ __forceinline__ void flush() const { pub(); }
};
}

constexpr int NWAVES = 8, NTHR = 512;
constexpr int D = 1024, NB = 8, SEQ = 4096, LC = 256, NT = NB * SEQ, NC = NB * LC, MT = NT + NC;
constexpr int DIN = 2944, NZ = 3072;
constexpr int C_K = 0, C_V = 512, C_WLO = 1024, C_ALO = 1152, C_R = 1280, C_GLO = 1792, C_U = 1920, C_GB = 2176, C_GC = 2432, C_F = 2688;
constexpr int DFF = 2816, NE = 8, DFE = 3584;
constexpr float NORM_EPS = 1e-6f, GN_EPS = 64e-5f;
constexpr int TP = 72;
enum { I_X = 0, I_C, I_CTX, I_CCTX, I_ADAW, I_ADAB, I_NORMG, I_WIN, I_WOUT, I_MU, I_MUW, I_MUA, I_W0, I_W2, I_A0, I_A2, I_G2, I_KK, I_KA, I_RK, I_GNW, I_GNB, I_CONVW,
       I_FG, I_FU, I_FD, I_RW, I_RB, I_MG, I_MUP, I_MD, N_IN };

constexpr size_t KiB = 1024, MiB = 1u << 20;
constexpr size_t WS_CTL = 0, CTL_ZERO_BYTES = 512 * KiB;
constexpr size_t WS_MOD = 512 * KiB;
constexpr size_t WS_TAB = 960 * KiB;
constexpr size_t TAB_E = WS_TAB;
constexpr size_t TAB_TWC = TAB_E + 64 * 512 * 4;
constexpr size_t TAB_TWS = TAB_TWC + 4096 * 4;
constexpr size_t TAB_C64 = TAB_TWS + 4096 * 4;
constexpr size_t TAB_S64 = TAB_C64 + 64 * 64 * 2;
constexpr size_t TAB_SN64 = TAB_S64 + 64 * 64 * 2;
constexpr size_t WS_ROUTE = 1152 * KiB;
constexpr size_t WS_TOKPOS = WS_ROUTE + (size_t)NT * 16;
static_assert(TAB_SN64 + 64 * 64 * 2 <= WS_ROUTE && WS_TOKPOS + (size_t)NT * 8 <= 2 * MiB, "low ws map");
constexpr size_t WS_Z = 2 * MiB;
constexpr size_t WS_SW = 206 * MiB;
constexpr size_t WS_WIN = WS_SW;
constexpr size_t WS_WOUT = WS_WIN + 2ull * NZ * D * 2;
constexpr size_t WS_WGU = WS_WOUT + 2ull * D * D * 2;
constexpr size_t WS_WDN = WS_WGU + 2ull * DFF * D * 2;
constexpr size_t WS_G2T = WS_WDN + (size_t)D * DFF * 2;
constexpr size_t WS_C256 = WS_G2T + 2ull * 512 * 128 * 2;
constexpr size_t WS_SN256 = WS_C256 + 256 * 256 * 2;
constexpr size_t WS_W2TG = WS_SN256 + 256 * 256 * 2;
constexpr size_t WS_A2TG = WS_W2TG + 4ull * 512 * 64 * 2;
constexpr size_t WS_XC = 244 * MiB;
static_assert(WS_A2TG + 4ull * 512 * 64 * 2 <= WS_XC, "small weights");
constexpr size_t WS_RING = 252 * MiB;
constexpr size_t WS_O32 = 381 * MiB;
constexpr size_t WS_YS = WS_O32;
constexpr size_t WS_YBUF = WS_YS + 2ull * MT * 512 * 2;
constexpr size_t WS_PARTD = WS_YBUF;
constexpr size_t WS_BONG = WS_YBUF + 32 * MiB;
constexpr size_t WS_H = 517 * MiB;
static_assert(WS_BONG + 2ull * MT * 8 * 4 <= WS_H && WS_Z + (size_t)MT * NZ * 2 <= WS_SW && WS_O32 + (size_t)MT * D * 4 <= WS_H, "ws map");
constexpr size_t WS_NEED = 585 * MiB;
static_assert(WS_H + (size_t)MT * D * 2 <= WS_NEED, "ws map end");
constexpr size_t WS_WMGU = 2 * MiB;
constexpr size_t WS_WMDN = WS_WMGU + 8ull * 2 * DFE * D * 2;
constexpr size_t WS_XG = 170 * MiB;
constexpr int XG_ROWS_CAP = 69632;
constexpr size_t WS_ACTM = 306 * MiB;
static_assert(WS_WMDN + 8ull * D * DFE * 2 <= WS_XG && WS_XG + (size_t)XG_ROWS_CAP * D * 2 <= WS_ACTM, "moe ws map");
constexpr int CW_TMO = 0;
constexpr int CW_CNT = 2048, CW_FILL = 3072;
constexpr int CW_BAR = 8192;
constexpr int MAX_LAUNCHES = 20;
constexpr int CW_PROD = 81920, CW_CONS = 81920 + 8192;
constexpr int CW_PCNT = 114688;
constexpr int PC_WOUT0 = 0, PC_DOWN0 = 2176, PC_WOUT1 = 4352, PC_MOE = 6528;
static_assert(CW_CONS + 16384 + 64 * 128 <= CW_PCNT && (CW_PCNT + PC_MOE + 16 * 272) * 4 <= (int)CTL_ZERO_BYTES, "control words");

constexpr int LDS_BYTES = 163840;
constexpr int MISC_OFF = LDS_BYTES - 256;

#define GAS __attribute__((address_space(1)))
#define LAS __attribute__((address_space(3)))
typedef unsigned short bf16;
typedef unsigned v4u __attribute__((ext_vector_type(4)));
typedef unsigned v2u __attribute__((ext_vector_type(2)));
typedef float f32x4 __attribute__((ext_vector_type(4)));
typedef float f32x2 __attribute__((ext_vector_type(2)));
typedef short bf16x8 __attribute__((ext_vector_type(8)));
typedef short bf16x4 __attribute__((ext_vector_type(4)));
#define LDS_WAIT() asm volatile("s_waitcnt lgkmcnt(0)" ::: "memory")
typedef __bf16 bf16x2n __attribute__((ext_vector_type(2)));
__device__ __forceinline__ unsigned pk2(float lo, float hi) { const f32x2 v = {lo, hi}; return __builtin_bit_cast(unsigned, __builtin_convertvector(v, bf16x2n)); }
__device__ __forceinline__ unsigned f2bf(float f) { return pk2(f, f) & 0xffffu; }
__device__ __forceinline__ float bflo(unsigned w) { return __builtin_bit_cast(float, w << 16); }
__device__ __forceinline__ float bfhi(unsigned w) { return __builtin_bit_cast(float, w & 0xffff0000u); }
__device__ __forceinline__ float bf1(bf16 b) { return __builtin_bit_cast(float, (unsigned)b << 16); }
template <int CTRL> __device__ __forceinline__ float dpp_mov(float v) { return __builtin_bit_cast(float, __builtin_amdgcn_update_dpp(0, __builtin_bit_cast(int, v), CTRL, 0xf, 0xf, true)); }
__device__ __forceinline__ float wave_sum(float v) {
    v += dpp_mov<0xB1>(v); v += dpp_mov<0x4E>(v); v += dpp_mov<0x141>(v); v += dpp_mov<0x140>(v);
    const int b = __builtin_bit_cast(int, v);
    const float s0 = __builtin_bit_cast(float, __builtin_amdgcn_readlane(b, 0)), s1 = __builtin_bit_cast(float, __builtin_amdgcn_readlane(b, 16));
    const float s2 = __builtin_bit_cast(float, __builtin_amdgcn_readlane(b, 32)), s3 = __builtin_bit_cast(float, __builtin_amdgcn_readlane(b, 48));
    return (s0 + s1) + (s2 + s3);
}
__device__ __forceinline__ float sigmoidf_(float x) { return __builtin_amdgcn_rcpf(1.0f + __expf(-x)); }
#define MFMA16(a, b, c) __builtin_amdgcn_mfma_f32_16x16x32_bf16((a), (b), (c), 0, 0, 0)
#define XB_TMO      128
#define XB_XCNT(j)  (256  + 64 * (j))
#define XB_XSUB(j)  (1280 + 64 * (j))
#define XB_XGEN(j)  (2304 + 64 * (j))
#define XB_TOP      3328
#define XB_TOPGEN   3392
#define XCD_BAR_WORDS 3456
#define XB_SPIN_CAP (1u << 18)
#define LAS __attribute__((address_space(3)))

__device__ __forceinline__ unsigned xb_ld(unsigned* p)              { return __hip_atomic_load(p, __ATOMIC_RELAXED, __HIP_MEMORY_SCOPE_AGENT); }
__device__ __forceinline__ unsigned xb_add(unsigned* p, unsigned v) { return __hip_atomic_fetch_add(p, v, __ATOMIC_RELAXED, __HIP_MEMORY_SCOPE_AGENT); }
__device__ __forceinline__ unsigned xb_xcc_id() { return (unsigned)__builtin_amdgcn_s_getreg((3 << 11) | 20) & 0xFu; }
#define XB_SPIN(cond, bar) do { unsigned _sp = 0; while (cond) { __builtin_amdgcn_s_sleep(1); \
    if ((++_sp & 255u) == 0u) { if (xb_ld(&(bar)[XB_TMO])) break; if (_sp > XB_SPIN_CAP) { atomicAdd(&(bar)[XB_TMO], 1u); break; } } } } while (0)

struct XcdBarrier {
    unsigned w0;
    unsigned* bar; unsigned x;
    volatile LAS unsigned* st;
};

__device__ __forceinline__ bool xb_lane0() { return __builtin_amdgcn_mbcnt_hi(~0u, __builtin_amdgcn_mbcnt_lo(~0u, 0u)) == 0u; }
__device__ __forceinline__ XcdBarrier xcd_barrier_post(unsigned* bar, volatile LAS unsigned* st, unsigned w0) {
    XcdBarrier b; b.w0 = w0; b.bar = bar; b.x = xb_xcc_id(); b.st = st;
    if (w0 && xb_lane0()) (void)xb_add(&bar[XB_XCNT(b.x)], 1u);
    return b;
}
__device__ __forceinline__ void xcd_barrier_complete(unsigned* bar, unsigned x, unsigned& nloc, unsigned& nx) {
    const unsigned G = gridDim.x * gridDim.y * gridDim.z;
    unsigned sum, cnt, mine, sp = 0u;
    for (;;) {
        sum = 0u; cnt = 0u; mine = 0u;
#pragma unroll
        for (unsigned j = 0; j < 16; ++j) { const unsigned c = xb_ld(&bar[XB_XCNT(j)]); sum += c; cnt += (c > 0u) ? 1u : 0u; mine = (j == x) ? c : mine; }
        if (sum == G) break;
        __builtin_amdgcn_s_sleep(1);
        if ((++sp & 255u) == 0u) { if (xb_ld(&bar[XB_TMO])) break; if (sp > XB_SPIN_CAP) { atomicAdd(&bar[XB_TMO], 1u); break; } }
    }
    nloc = mine > 0u ? mine : 1u; nx = cnt > 0u ? cnt : 1u;
}

__device__ __forceinline__ void xcd_barrier(const XcdBarrier& b) {
    asm volatile("s_waitcnt vmcnt(0)" ::: "memory");
    __syncthreads();
    if (b.w0 && xb_lane0()) {
        unsigned* bar = b.bar;
        __builtin_amdgcn_s_waitcnt(0);
        unsigned nloc = b.st[0], nx = b.st[1];
        if (nloc == 0u) { xcd_barrier_complete(bar, b.x, nloc, nx); b.st[0] = nloc; b.st[1] = nx; }
        const unsigned old = xb_add(&bar[XB_XSUB(b.x)], 1u);
        const unsigned gen = old / nloc;
        if (old + 1u == (gen + 1u) * nloc) {
            __builtin_amdgcn_fence(__ATOMIC_RELEASE, "agent");
            asm volatile("s_waitcnt vmcnt(0)" ::: "memory");
            const unsigned og = xb_add(&bar[XB_TOP], 1u);
            const unsigned tg = og / nx;
            if (og + 1u == (tg + 1u) * nx) xb_add(&bar[XB_TOPGEN], 1u);
            else XB_SPIN(xb_ld(&bar[XB_TOPGEN]) == tg, bar);
            __builtin_amdgcn_fence(__ATOMIC_ACQUIRE, "agent");
            xb_add(&bar[XB_XGEN(b.x)], 1u);
            asm volatile("s_waitcnt vmcnt(0)" ::: "memory");
        } else {
            XB_SPIN(xb_ld(&bar[XB_XGEN(b.x)]) == gen, bar);
            __builtin_amdgcn_fence(__ATOMIC_ACQUIRE, "agent");
            asm volatile("s_waitcnt vmcnt(0)" ::: "memory");
        }
    }
    __syncthreads();
}


struct Params {
    const float* in[N_IN];
    float* out;
    unsigned char* ws;
    int act_cap_panels;
    int ph_lo, ph_hi, li;
};
static_assert(sizeof(Params) == N_IN * 8 + 8 + 8 + 16, "Params has no padding");

struct Frame {
    LAS unsigned char* lds;
    int tid, lane, wave, G, bx;
};
#define WSP(T, off) ((T*)(P.ws + (off)))

__device__ __forceinline__ void transpose_item(const float* W, int N, bf16* WT, int ldk, int k0, int n0, int out_row0, LAS float* scr, int lane) {
#pragma unroll 8
    for (int i = 0; i < 32; ++i) { const int kk = 2 * i + (lane >> 5); scr[kk * 33 + (lane & 31)] = W[(size_t)(k0 + kk) * N + n0 + (lane & 31)]; }
    LDS_WAIT(); asm volatile("" ::: "memory");
    const int c = lane & 7;
#pragma unroll
    for (int j = 0; j < 4; ++j) { const int n = (lane >> 3) + 8 * j; const LAS float* s = scr + (8 * c) * 33 + n;
        v4u o; o.x = pk2(s[0 * 33], s[1 * 33]); o.y = pk2(s[2 * 33], s[3 * 33]); o.z = pk2(s[4 * 33], s[5 * 33]); o.w = pk2(s[6 * 33], s[7 * 33]);
        *(v4u*)(WT + (size_t)(out_row0 + n) * ldk + k0 + 8 * c) = o; }
    LDS_WAIT(); asm volatile("" ::: "memory");
}
__device__ __forceinline__ int gu_row(int n, int up) { return (n >> 7) * 256 + up * 128 + (n & 127); }

__device__ __forceinline__ void p0_small_weights(const Params& P, const Frame& F) {
    LAS float* scr = (LAS float*)(F.lds + F.wave * 16384);
    const int gw = F.bx * NWAVES + F.wave, NGW = F.G * NWAVES;
    constexpr int I_IN = 16 * 92, I_OUT = 16 * 32, I_GU = 16 * 88, I_DN = 44 * 32, I_GT = 2 * 16, I_LR = 16;
    constexpr int NITEMS = 2 * I_IN + 2 * I_OUT + 2 * I_GU + I_DN + 2 * I_GT + 8 * I_LR;
    for (int it = gw; it < NITEMS; it += NGW) {
        int r = it;
        if (r < 2 * I_IN) { const int l = r / I_IN; r %= I_IN; const int kb = r / 92, nb = r % 92;
            transpose_item(P.in[I_WIN] + (size_t)l * D * DIN, DIN, WSP(bf16, WS_WIN) + (size_t)l * NZ * D, D, 64 * kb, 32 * nb, 32 * nb, scr, F.lane); continue; } r -= 2 * I_IN;
        if (r < 2 * I_OUT) { const int l = r / I_OUT; r %= I_OUT; const int kb = r / 32, nb = r % 32;
            transpose_item(P.in[I_WOUT] + (size_t)l * D * D, D, WSP(bf16, WS_WOUT) + (size_t)l * D * D, D, 64 * kb, 32 * nb, 32 * nb, scr, F.lane); continue; } r -= 2 * I_OUT;
        if (r < 2 * I_GU) { const int up = r / I_GU; r %= I_GU; const int kb = r / 88, nb = r % 88;
            transpose_item(P.in[up ? I_FU : I_FG], DFF, WSP(bf16, WS_WGU), D, 64 * kb, 32 * nb, gu_row(32 * nb, up), scr, F.lane); continue; } r -= 2 * I_GU;
        if (r < I_DN) { const int kb = r / 32, nb = r % 32;
            transpose_item(P.in[I_FD], D, WSP(bf16, WS_WDN), DFF, 64 * kb, 32 * nb, 32 * nb, scr, F.lane); continue; } r -= I_DN;
        if (r < 2 * I_GT) { const int l = r / I_GT; r %= I_GT; const int kb = r / 16, nb = r % 16;
            transpose_item(P.in[I_G2] + (size_t)l * 128 * 512, 512, WSP(bf16, WS_G2T) + (size_t)l * 512 * 128, 128, 64 * kb, 32 * nb, 32 * nb, scr, F.lane); continue; } r -= 2 * I_GT;
        { const int which = r / (4 * I_LR); r %= 4 * I_LR; const int ldi = r / I_LR, nb = r % I_LR;
            transpose_item(P.in[which ? I_A2 : I_W2] + (size_t)ldi * 64 * 512, 512, WSP(bf16, which ? WS_A2TG : WS_W2TG) + (size_t)ldi * 512 * 64, 64, 0, 32 * nb, 32 * nb, scr, F.lane); }
    }
    { const int gt = F.bx * NTHR + F.tid, NGT = F.G * NTHR; constexpr int NV = 2 * (NZ - DIN) * D / 8;
        for (int i = gt; i < NV; i += NGT) { const int l = i / ((NZ - DIN) * D / 8), r = i % ((NZ - DIN) * D / 8);
            *(v4u*)(WSP(bf16, WS_WIN) + (size_t)l * NZ * D + (size_t)DIN * D + (size_t)r * 8) = (v4u){0u, 0u, 0u, 0u}; } }
}
__device__ __forceinline__ void p0_tables(const Params& P, const Frame& F) {
    const int gt = F.bx * NTHR + F.tid, NGT = F.G * NTHR;
    float* E = WSP(float, TAB_E);
    for (int i = gt; i < 64 * 256; i += NGT) { const int n = i >> 8, q = i & 255;
        const float omega = 1.0f / powf(10000.0f, (float)q / 256.0f), ang = (float)n * omega;
        E[n * 512 + q] = sinf(ang); E[n * 512 + 256 + q] = cosf(ang); }
    float* twc = WSP(float, TAB_TWC); float* tws = WSP(float, TAB_TWS);
    for (int i = gt; i < 4096; i += NGT) { const float a = (float)i / 2048.0f; twc[i] = cospif(a); tws[i] = sinpif(a); }
    bf16* c64 = WSP(bf16, TAB_C64); bf16* s64 = WSP(bf16, TAB_S64); bf16* sn64 = WSP(bf16, TAB_SN64);
    for (int i = gt; i < 64 * 64; i += NGT) { const int m = ((i >> 6) * (i & 63)) & 63; const float a = (float)m / 32.0f; const float c = cospif(a), s = sinpif(a);
        c64[i] = (bf16)f2bf(c); s64[i] = (bf16)f2bf(s); sn64[i] = (bf16)f2bf(-s); }
    bf16* c256 = WSP(bf16, WS_C256); bf16* sn256 = WSP(bf16, WS_SN256);
    for (int i = gt; i < 256 * 256; i += NGT) { const int m = ((i >> 8) * (i & 255)) & 255; const float a = (float)m / 128.0f;
        c256[i] = (bf16)f2bf(cospif(a)); sn256[i] = (bf16)f2bf(-sinpif(a)); }
}
__device__ __forceinline__ void p0_adaln(const Params& P, const Frame& F) {
    LAS float* sc = (LAS float*)F.lds;
    LAS float* red = sc + 9 * 1024;
    for (int u = F.bx; u < 192; u += F.G) {
        const int l = u / 96, cb = u % 96;
        for (int i = F.tid; i < 9 * 1024; i += NTHR) { const int r = i >> 10, d = i & 1023; const float v = r < 8 ? P.in[I_C][r * 1024 + d] : P.in[I_CCTX][d]; sc[i] = v / (1.0f + expf(-v)); }
        __syncthreads();
        const int col = F.tid & 63, ks = F.tid >> 6;
        float acc[9];
#pragma unroll
        for (int r = 0; r < 9; ++r) acc[r] = 0.f;
        const float* w = P.in[I_ADAW] + ((size_t)l * 1024 + ks * 128) * 6144 + cb * 64 + col;
#pragma unroll 2
        for (int k = 0; k < 128; k += 8) {
            float wv[8];
#pragma unroll
            for (int q = 0; q < 8; ++q) wv[q] = w[(size_t)(k + q) * 6144];
#pragma unroll
            for (int r = 0; r < 9; ++r) { const f32x4 s4 = *(const LAS f32x4*)(sc + r * 1024 + ks * 128 + k), s5 = *(const LAS f32x4*)(sc + r * 1024 + ks * 128 + k + 4);
                acc[r] += (s4.x * wv[0] + s4.y * wv[1] + s4.z * wv[2] + s4.w * wv[3]) + (s5.x * wv[4] + s5.y * wv[5] + s5.z * wv[6] + s5.w * wv[7]); }
        }
#pragma unroll
        for (int r = 0; r < 9; ++r) red[(ks * 9 + r) * 64 + col] = acc[r];
        __syncthreads();
        for (int i = F.tid; i < 9 * 64; i += NTHR) { const int r = i >> 6, c = i & 63; float s = 0.f;
#pragma unroll
            for (int k = 0; k < 8; ++k) s += red[(k * 9 + r) * 64 + c];
            WSP(float, WS_MOD)[(size_t)(l * 9 + r) * 6144 + cb * 64 + c] = s + P.in[I_ADAB][l * 6144 + cb * 64 + c]; }
        __syncthreads();
    }
}
__device__ __forceinline__ void convert_moe_weights(const Params& P, const Frame& F) {
    LAS float* scr = (LAS float*)(F.lds + F.wave * 16384);
    const int gw = F.bx * NWAVES + F.wave, NGW = F.G * NWAVES;
    constexpr int I_GU = 16 * 112, I_DN = 56 * 32, NITEMS = NE * (2 * I_GU + I_DN);
    for (int it = gw; it < NITEMS; it += NGW) {
        const int e = it / (2 * I_GU + I_DN); int r = it % (2 * I_GU + I_DN);
        if (r < 2 * I_GU) { const int up = r / I_GU; r %= I_GU; const int kb = r / 112, nb = r % 112;
            transpose_item(P.in[up ? I_MUP : I_MG] + (size_t)e * D * DFE, DFE, WSP(bf16, WS_WMGU) + (size_t)e * 2 * DFE * D, D, 64 * kb, 32 * nb, gu_row(32 * nb, up), scr, F.lane); }
        else { r -= 2 * I_GU; const int kb = r / 32, nb = r % 32;
            transpose_item(P.in[I_MD] + (size_t)e * DFE * D, D, WSP(bf16, WS_WMDN) + (size_t)e * D * DFE, DFE, 64 * kb, 32 * nb, 32 * nb, scr, F.lane); }
    }
}

__device__ __forceinline__ void store_h_row(bf16* hrow, int lane, const f32x4 (&h)[4]) {
#pragma unroll
    for (int j = 0; j < 4; ++j) { v2u w; w.x = pk2(h[j].x, h[j].y); w.y = pk2(h[j].z, h[j].w); *(v2u*)(hrow + 4 * lane + 256 * j) = w; }
}
__device__ __forceinline__ void norm_mod(const f32x4 (&x)[4], int lane, const float* ng, const float* sc, const float* sh, f32x4 (&h)[4]) {
    float ss = 0.f;
#pragma unroll
    for (int j = 0; j < 4; ++j) ss += (x[j].x * x[j].x + x[j].y * x[j].y) + (x[j].z * x[j].z + x[j].w * x[j].w);
    const float rs = rsqrtf(wave_sum(ss) * (1.0f / D) + NORM_EPS);
#pragma unroll
    for (int j = 0; j < 4; ++j) { const int c = 4 * lane + 256 * j; const f32x4 g = *(const f32x4*)(ng + c), s1 = *(const f32x4*)(sc + c), s0 = *(const f32x4*)(sh + c);
        h[j] = (x[j] * rs * g) * (1.0f + s1) + s0; }
}
__device__ __forceinline__ void norm_mod_lds(const f32x4 (&x)[4], int lane, const LAS float* ng, const LAS float* sc, const LAS float* sh, f32x4 (&h)[4]) {
    float ss = 0.f;
#pragma unroll
    for (int j = 0; j < 4; ++j) ss += (x[j].x * x[j].x + x[j].y * x[j].y) + (x[j].z * x[j].z + x[j].w * x[j].w);
    const float rs = rsqrtf(wave_sum(ss) * (1.0f / D) + NORM_EPS);
#pragma unroll
    for (int j = 0; j < 4; ++j) { const int c = 4 * lane + 256 * j; const f32x4 g = *(const LAS f32x4*)(ng + c), s1 = *(const LAS f32x4*)(sc + c), s0 = *(const LAS f32x4*)(sh + c);
        h[j] = (x[j] * rs * g) * (1.0f + s1) + s0; }
}
__device__ __forceinline__ void phase_first_norm(const Params& P, const Frame& F) {
    const int gw = F.bx * NWAVES + F.wave, NGW = F.G * NWAVES, lane = F.lane;
    const float* E = WSP(float, TAB_E); const float* mod = WSP(float, WS_MOD); bf16* H = WSP(bf16, WS_H);
    LAS float* WL = (LAS float*)F.lds; LAS float* WN = WL + 9 * 2 * 1024;
    for (int i = F.tid; i < 9 * 2 * 256; i += NTHR) { const int mr = i >> 9, wh = (i >> 8) & 1, c = (i & 255) * 4; *(LAS f32x4*)(WL + (mr * 2 + wh) * 1024 + c) = *(const f32x4*)(mod + (size_t)mr * 6144 + wh * 1024 + c); }
    for (int i = F.tid; i < 256; i += NTHR) *(LAS f32x4*)(WN + i * 4) = *(const f32x4*)(P.in[I_NORMG] + i * 4);
    __syncthreads();
    f32x4 xn[4], en[4];
    auto fetch = [&](int row) {
        const float* xr = row < NT ? P.in[I_X] + (size_t)row * D : P.in[I_CTX] + (size_t)(row - NT) * D;
#pragma unroll
        for (int j = 0; j < 4; ++j) xn[j] = *(const f32x4*)(xr + 4 * lane + 256 * j);
        if (row < NT) { const int p = row & (SEQ - 1);
#pragma unroll
            for (int j = 0; j < 4; ++j) { const int c = 4 * lane + 256 * j; en[j] = *(const f32x4*)((j < 2) ? (E + (p >> 6) * 512 + c) : (E + (p & 63) * 512 + (c - 512))); } }
    };
    if (gw < MT) fetch(gw);
    for (int row = gw; row < MT; row += NGW) {
        f32x4 x[4];
        const int mr = row < NT ? (row >> 12) : 8;
#pragma unroll
        for (int j = 0; j < 4; ++j) x[j] = row < NT ? xn[j] + en[j] : xn[j];
        if (row + NGW < MT) fetch(row + NGW);
        f32x4 h[4]; norm_mod_lds(x, lane, WN, WL + (mr * 2 + 1) * 1024, WL + (mr * 2) * 1024, h);
        store_h_row(H + (size_t)row * D, lane, h);
    }
    __syncthreads();
}
#ifndef POST_SLEEP
#define POST_SLEEP 4
#endif
#ifdef POST_PLAINLD
__device__ __forceinline__ v2u ld8_agent(const void* p) { return *(const v2u*)p; }
#else
__device__ __forceinline__ v2u ld8_agent(const void* p) { return __builtin_bit_cast(v2u, __hip_atomic_load((const unsigned long long*)p, __ATOMIC_RELAXED, __HIP_MEMORY_SCOPE_AGENT)); }
#endif
template <int MODE, bool NEXT, bool ROUTE, bool FIRST = false>
__device__ __forceinline__ void phase_post(const Params& P, const Frame& F, int nrows, int l, int goff, int ngp_idx, const float* xc_src, int ln, int ngn_idx, int scoff, int shoff,
                                           const unsigned* pcnt, unsigned need, int nbusy, int nexcl, const float* part = nullptr, int srow0 = 0x7fffffff, int S = 1, int tail_rows = 0) {
    const bool busy = F.bx < nbusy; const int lane = F.lane;
    const int gwa = F.bx * NWAVES + F.wave, NGWA = F.G * NWAVES, gwf = (F.bx - nbusy) * NWAVES + F.wave, NGWF = (F.G - nbusy) * NWAVES;
    const int KE = busy ? 0 : (nexcl + NGWF - 1) / NGWF, KS = (nrows - nexcl + NGWA - 1) / NGWA;
    auto rowq = [&](int q) -> int { return q < KE ? (gwf + q * NGWF) : (nexcl + gwa + (q - KE) * NGWA); };
    bf16* H = WSP(bf16, WS_H); const bf16* O32 = WSP(bf16, WS_O32);
    LAS float* WL = (LAS float*)F.lds; LAS float* WN = WL + 9 * 3 * 1024; LAS float* WR = WN + 2 * 1024;
    {
        const float* mod = WSP(float, WS_MOD);
        const float* ngp = P.in[I_NORMG] + (size_t)(l * 4 + ngp_idx) * D;
        const float* ngn = P.in[I_NORMG] + (size_t)(ln * 4 + ngn_idx) * D;
        for (int i = F.tid; i < 9 * 3 * 256; i += NTHR) { const int mr = i / 768, r = i - mr * 768, wh = r >> 8, c = (r & 255) * 4;
            if (wh == 0 || NEXT) { const float* src = wh == 0 ? mod + (size_t)(l * 9 + mr) * 6144 + goff + c : mod + (size_t)(ln * 9 + mr) * 6144 + (wh == 1 ? scoff : shoff) + c;
                *(LAS f32x4*)(WL + (mr * 3 + wh) * 1024 + c) = *(const f32x4*)src; } }
        for (int i = F.tid; i < 2 * 256; i += NTHR) { const int wh = i >> 8, c = (i & 255) * 4; if (wh == 0 || NEXT) *(LAS f32x4*)(WN + wh * 1024 + c) = *(const f32x4*)((wh ? ngn : ngp) + c); }
        if (ROUTE) for (int i = F.tid; i < 8 * 1024; i += NTHR) WR[(i & 7) * 1024 + (i >> 3)] = P.in[I_RW][i];
        __syncthreads();
    }
    int cnt[NE]; float rbias[NE];
#pragma unroll
    for (int e = 0; e < NE; ++e) { cnt[e] = 0; rbias[e] = ROUTE ? P.in[I_RB][e] : 0.f; }
    v2u on0[4], on1[4]; f32x4 xnx[4], enx[4]; float pn0 = 0.f, pn1 = 0.f;
    auto xsrc = [&](int row) -> const float* { return row < NT ? ((FIRST ? P.in[I_X] : (const float*)P.out) + (size_t)row * D) : (xc_src + (size_t)(row - NT) * D); };
    auto ldrow = [&](v2u (&dst)[4], const bf16* orow, int srow) {
        if (srow < 0) {
#pragma unroll
            for (int j = 0; j < 4; ++j) dst[j] = ld8_agent(orow + 4 * lane + 256 * j);
        } else {
            f32x4 a[4];
#pragma unroll
            for (int j = 0; j < 4; ++j) a[j] = (f32x4){0.f, 0.f, 0.f, 0.f};
            for (int ks = 0; ks < S; ++ks) { const float* pr = part + ((size_t)ks * tail_rows + srow) * D;
#pragma unroll
                for (int j = 0; j < 4; ++j) a[j] = a[j] + *(const f32x4*)(pr + 4 * lane + 256 * j); }
#pragma unroll
            for (int j = 0; j < 4; ++j) { dst[j].x = pk2(a[j].x, a[j].y); dst[j].y = pk2(a[j].z, a[j].w); }
        }
    };
    auto fetch = [&](int row) {
        if (MODE == 0) {
            ldrow(on0, O32 + (size_t)row * D, row >= srow0 ? row - srow0 : -1);
        } else {
            const int4 rt = *(const int4*)(P.ws + WS_ROUTE + (size_t)row * 16); const int2 tp = *(const int2*)(P.ws + WS_TOKPOS + (size_t)row * 8);
            pn0 = __builtin_bit_cast(float, rt.y); pn1 = __builtin_bit_cast(float, rt.z);
            ldrow(on0, WSP(bf16, WS_XG) + (size_t)tp.x * D, tp.x >= srow0 ? tp.x - srow0 : -1); ldrow(on1, WSP(bf16, WS_XG) + (size_t)tp.y * D, tp.y >= srow0 ? tp.y - srow0 : -1);
        }
        const float* xs = xsrc(row);
#pragma unroll
        for (int j = 0; j < 4; ++j) xnx[j] = *(const f32x4*)(xs + 4 * lane + 256 * j);
        if (FIRST && row < NT) { const int p = row & (SEQ - 1);
#pragma unroll
            for (int j = 0; j < 4; ++j) { const int c = 4 * lane + 256 * j; enx[j] = *(const f32x4*)((j < 2) ? (WSP(float, TAB_E) + (p >> 6) * 512 + c) : (WSP(float, TAB_E) + (p & 63) * 512 + (c - 512))); } }
    };
    for (int qb = 0; qb < KE + KS; qb += 64) {
    const int myq = qb + lane, myrow = rowq(myq); const bool valid = myq < KE ? (myrow < nexcl) : (myq < KE + KS && myrow < nrows);
    const unsigned* w0 = pcnt; const unsigned* w1 = pcnt; unsigned nd0 = need, nd1 = need;
    if (valid) { if (MODE == 0) { w0 = w1 = pcnt + 16 * (myrow >> 8); if (myrow >= srow0) nd0 = need * (unsigned)S; }
                 else { const int2 tp = *(const int2*)(P.ws + WS_TOKPOS + (size_t)myrow * 8); w0 = pcnt + 16 * (tp.x >> 8); w1 = pcnt + 16 * (tp.y >> 8); if (tp.x >= srow0) nd0 = need * (unsigned)S; if (tp.y >= srow0) nd1 = need * (unsigned)S; } }
    unsigned long long rem = __ballot(valid); unsigned spins = 0;
    while (rem) {
        bool rdy = false;
        if ((rem >> lane) & 1ull) { rdy = __hip_atomic_load(w0, __ATOMIC_RELAXED, __HIP_MEMORY_SCOPE_AGENT) >= nd0; if (MODE != 0) rdy = rdy && __hip_atomic_load(w1, __ATOMIC_RELAXED, __HIP_MEMORY_SCOPE_AGENT) >= nd1; }
        unsigned long long now = __ballot(rdy);
        if (!now) {
            __builtin_amdgcn_s_sleep(POST_SLEEP);
            if (++spins <= (1u << 15)) continue;
            if (lane == 0) { unsigned* tmo = WSP(unsigned, WS_CTL) + CW_TMO; __hip_atomic_store(tmo, 1u, __ATOMIC_RELAXED, __HIP_MEMORY_SCOPE_AGENT); __hip_atomic_fetch_max(tmo + 1, 0xB00u, __ATOMIC_RELAXED, __HIP_MEMORY_SCOPE_AGENT); }
            now = rem;
        }
        asm volatile("" ::: "memory");
        rem &= ~now;
        int kcur = __ffsll((long long)now) - 1; now &= now - 1ull;
        fetch(rowq(qb + kcur));
    for (;;) {
        const int row = rowq(qb + kcur);
        const int knext = now ? (__ffsll((long long)now) - 1) : -1; now &= now - 1ull;
        const int mr = row < NT ? (row >> 12) : 8;
        f32x4 o[4], xin[4];
#pragma unroll
        for (int j = 0; j < 4; ++j) { xin[j] = xnx[j];
            if (FIRST && row < NT) xin[j] = xin[j] + enx[j];
            if (MODE == 0) o[j] = (f32x4){bflo(on0[j].x), bfhi(on0[j].x), bflo(on0[j].y), bfhi(on0[j].y)};
            else o[j] = (f32x4){pn0 * bflo(on0[j].x) + pn1 * bflo(on1[j].x), pn0 * bfhi(on0[j].x) + pn1 * bfhi(on1[j].x), pn0 * bflo(on0[j].y) + pn1 * bflo(on1[j].y), pn0 * bfhi(on0[j].y) + pn1 * bfhi(on1[j].y)}; }
        if (knext >= 0) fetch(rowq(qb + knext));
        float ss = 0.f;
#pragma unroll
        for (int j = 0; j < 4; ++j) ss += (o[j].x * o[j].x + o[j].y * o[j].y) + (o[j].z * o[j].z + o[j].w * o[j].w);
        const float rs = rsqrtf(wave_sum(ss) * (1.0f / D) + NORM_EPS);
        float* xd = row < NT ? (P.out + (size_t)row * D) : (WSP(float, WS_XC) + (size_t)(row - NT) * D);
        const LAS float* wl = WL + mr * 3 * 1024;
        f32x4 x[4];
#pragma unroll
        for (int j = 0; j < 4; ++j) { const int c = 4 * lane + 256 * j; const f32x4 g = *(const LAS f32x4*)(wl + c), n = *(const LAS f32x4*)(WN + c);
            x[j] = xin[j] + g * (o[j] * rs * n); *(f32x4*)(xd + c) = x[j]; }
        if (NEXT) {
            f32x4 h[4]; norm_mod_lds(x, lane, WN + 1024, wl + 1024, wl + 2048, h);
            store_h_row(H + (size_t)row * D, lane, h);
            if (ROUTE) {
                float lg[NE];
#pragma unroll
                for (int e = 0; e < NE; ++e) lg[e] = 0.f;
#pragma unroll
                for (int e = 0; e < NE; ++e) {
#pragma unroll
                    for (int j = 0; j < 4; ++j) { const f32x4 w = *(const LAS f32x4*)(WR + e * 1024 + 4 * lane + 256 * j); lg[e] += (h[j].x * w.x + h[j].y * w.y) + (h[j].z * w.z + h[j].w * w.w); }
                    if (e & 1) __builtin_amdgcn_sched_barrier(0);
                }
#pragma unroll
                for (int e = 0; e < NE; ++e) lg[e] = wave_sum(lg[e]) + rbias[e];
                int i0 = 0; float v0 = lg[0];
#pragma unroll
                for (int e = 1; e < NE; ++e) if (lg[e] > v0) { v0 = lg[e]; i0 = e; }
                int i1 = -1; float v1 = -3.0e38f;
#pragma unroll
                for (int e = 0; e < NE; ++e) if (e != i0 && lg[e] > v1) { v1 = lg[e]; i1 = e; }
                const float e1 = expf(v1 - v0), p0 = 1.0f / (1.0f + e1), p1 = e1 / (1.0f + e1);
                if (lane == 0) *(int4*)(P.ws + WS_ROUTE + (size_t)row * 16) = make_int4(i0 | (i1 << 8), __builtin_bit_cast(int, p0), __builtin_bit_cast(int, p1), 0);
#pragma unroll
                for (int e = 0; e < NE; ++e) cnt[e] += (e == i0 || e == i1) ? 1 : 0;
            }
        }
        if (knext < 0) break;
        kcur = knext;
    }
    }
    }
    if (ROUTE) {
        if (lane == 0) {
#pragma unroll
            for (int e = 0; e < NE; ++e) if (cnt[e]) __hip_atomic_fetch_add(WSP(unsigned, WS_CTL) + CW_CNT + 64 * e, (unsigned)cnt[e], __ATOMIC_RELAXED, __HIP_MEMORY_SCOPE_AGENT);
        }
    }
}

constexpr int TB = 64;
typedef short bf16x4s __attribute__((ext_vector_type(4)));
#define MFMA16K(a, b, c) __builtin_amdgcn_mfma_f32_16x16x16bf16_1k((a), (b), (c), 0, 0, 0)
__device__ __forceinline__ float fexp(float x) { return __builtin_amdgcn_exp2f(x * 1.44269504089f); }
__device__ __forceinline__ float flog(float x) { return __builtin_amdgcn_logf(x) * 0.69314718056f; }
__device__ __forceinline__ float frcp(float x) { return __builtin_amdgcn_rcpf(x); }
__device__ __forceinline__ float softplusf_(float x) { return fmaxf(x, 0.f) + flog(1.0f + fexp(-fabsf(x))); }
__device__ __forceinline__ float ftanh(float x) { return 1.0f - 2.0f * frcp(1.0f + fexp(2.0f * x)); }
__device__ __forceinline__ f32x4 ld4bf(const bf16* p) { const v2u w = *(const v2u*)p; return (f32x4){bflo(w.x), bfhi(w.x), bflo(w.y), bfhi(w.y)}; }
template <int CTRL> __device__ __forceinline__ float dppf(float v) { return __builtin_bit_cast(float, __builtin_amdgcn_update_dpp(0, __builtin_bit_cast(int, v), CTRL, 0xf, 0xf, true)); }
__device__ __forceinline__ float sum8(float v) { v += dppf<0xB1>(v); v += dppf<0x4E>(v); v += dppf<0x141>(v); return v; }
__device__ __forceinline__ bf16x4s pack4(f32x4 v) { v2u w; w.x = pk2(v.x, v.y); w.y = pk2(v.z, v.w); return __builtin_bit_cast(bf16x4s, w); }
__device__ __forceinline__ void unpack8(v4u w, float (&o)[8]) {
#pragma unroll
    for (int q = 0; q < 4; ++q) { o[2 * q] = bflo(w[q]); o[2 * q + 1] = bfhi(w[q]); } }
__device__ __forceinline__ v4u pack8(const float (&o)[8]) { v4u w;
#pragma unroll
    for (int q = 0; q < 4; ++q) w[q] = pk2(o[2 * q], o[2 * q + 1]);
    return w; }
struct ScanPre { v4u kc, kp, vc, vp, rc, rp, wc, wp, ac, ap; };
__device__ __forceinline__ int scan_row(int bi, int tk, int b, int dir, bool& hp, int& prow) {
    const int seq = bi >= LC / TB, c = seq ? bi - LC / TB : bi, len = seq ? SEQ : LC, rowbase = seq ? b * SEQ : NT + b * LC;
    const int ts = c * TB + tk, t = dir ? (len - 1 - ts) : ts;
    hp = dir ? (t + 1 < len) : (t > 0);
    prow = rowbase + (hp ? (dir ? t + 1 : t - 1) : t);
    return rowbase + t;
}
__device__ __forceinline__ void scan_prefetch(const bf16* Z, int bi, int tk, int b, int dir, int gc, int c8, ScanPre& R) {
    bool hp; int prow; const int row = scan_row(bi, tk, b, dir, hp, prow);
    const bf16* zrk = Z + (size_t)row * NZ + gc; const bf16* zpk = Z + (size_t)prow * NZ + gc;
    const bf16* zrw = Z + (size_t)row * NZ + C_WLO + 64 * dir + c8; const bf16* zpw = Z + (size_t)prow * NZ + C_WLO + 64 * dir + c8;
    R.kc = *(const v4u*)(zrk + C_K); R.vc = *(const v4u*)(zrk + C_V); R.rc = *(const v4u*)(zrk + C_R); R.wc = *(const v4u*)(zrw); R.ac = *(const v4u*)(zrw + (C_ALO - C_WLO));
    R.kp = *(const v4u*)(zpk + C_K); R.vp = *(const v4u*)(zpk + C_V); R.rp = *(const v4u*)(zpk + C_R); R.wp = *(const v4u*)(zpw); R.ap = *(const v4u*)(zpw + (C_ALO - C_WLO));
}
__device__ __forceinline__ void lerp8(v4u cur, v4u prv, bool hp, const LAS float* mu, float (&o)[8]) {
    if (!hp) prv = (v4u){0u, 0u, 0u, 0u};
    const f32x4 m0 = *(const LAS f32x4*)mu, m1 = *(const LAS f32x4*)(mu + 4);
#pragma unroll
    for (int q = 0; q < 4; ++q) {
        const f32x2 c2 = {bflo(cur[q]), bfhi(cur[q])}, p2 = {bflo(prv[q]), bfhi(prv[q])};
        const f32x2 m2 = q < 2 ? (f32x2){m0[2 * q], m0[2 * q + 1]} : (f32x2){m1[2 * q - 4], m1[2 * q - 3]};
        const f32x2 r2 = c2 + (p2 - c2) * m2;
        o[2 * q] = r2.x; o[2 * q + 1] = r2.y; }
}
#define RLX_AGENT __ATOMIC_RELAXED, __HIP_MEMORY_SCOPE_AGENT
typedef GAS unsigned gu32;
constexpr unsigned kSpinCap = 1u << 17;
__device__ __forceinline__ bool wait_ge(gu32* word, unsigned want, gu32* tmo, unsigned code, int lane) {
    for (unsigned spins = 0;;) {
        if ((unsigned)__builtin_amdgcn_readfirstlane(__hip_atomic_load(word, RLX_AGENT)) >= want) return true;
        __builtin_amdgcn_s_sleep(1);
        if (++spins > kSpinCap) { if (lane == 0) { __hip_atomic_store(tmo, 1u, RLX_AGENT); __hip_atomic_fetch_max(tmo + 1, code, RLX_AGENT); } return false; }
        if ((spins & 255u) == 0u && __builtin_amdgcn_readfirstlane(__hip_atomic_load(tmo, RLX_AGENT))) return false;
    }
}
constexpr int XFER_PIECES = 3264, XFER_SLOT_BYTES = 52480, XFER_SLOTS = 6;
static_assert(WS_RING + 128ull * XFER_SLOTS * XFER_SLOT_BYTES <= WS_O32, "hand-off rings fit below the O buffer");
__device__ __forceinline__ int xfer_lds_off(int i) { return i < 1536 ? 20992 + 16 * i : (i < 2688 ? 45568 + 16 * (i - 1536) : 102912 + 16 * (i - 2688)); }
__device__ __forceinline__ void scan_unit(const Params& P, const Frame& F, int l, int b, int h, int dir, int role) {
    LAS unsigned char* L0 = F.lds;
    LAS bf16* W2T = (LAS bf16*)L0;
    LAS bf16* A2T = (LAS bf16*)(L0 + 9216);
    LAS float* CST = (LAS float*)(L0 + 18432);
    LAS bf16* TWb = (LAS bf16*)(L0 + 20992);
    LAS bf16* ALb = TWb + TB * TP;
    LAS bf16* BH = (LAS bf16*)(L0 + 20992);
    LAS bf16* KH = BH + 4 * 64 * 16;
    LAS bf16* Vt = KH + 4 * 64 * 16;
    LAS float* LW = (LAS float*)(L0 + 45568);
    constexpr int LWP = 68;
    LAS float* LA = LW + TB * LWP;
    LAS bf16* AT = (LAS bf16*)(L0 + 45568);
    LAS bf16* RT = AT + TB * TP; LAS bf16* BT = RT + TB * TP; LAS bf16* KT = BT + TB * TP;
    LAS float* CUM = (LAS float*)(L0 + 82432);
    LAS float* LabF = (LAS float*)(L0 + 98816);
    LAS bf16* LakB = (LAS bf16*)(L0 + 102912);
    LAS bf16* TtB = LakB + 1024; LAS bf16* MrbB = TtB + 1024; LAS bf16* MrkB = MrbB + 1024;
    LAS float* PCb = (LAS float*)(L0 + 111104);
    LAS float* YB = (LAS float*)(L0 + 112128);
    LAS float* BONl = (LAS float*)(L0 + 128512);
    const int tid = F.tid, lane = F.lane, w = F.wave, fr = lane & 15, fq = lane >> 4;
    const int tk = tid >> 3, c8 = (tid & 7) * 8, gc = 64 * h + c8;
    const int ld = l * 2 + dir;
    for (int i = tid; i < 4096; i += NTHR) { const int j = i >> 6, c = i & 63;
        W2T[c * TP + j] = (bf16)f2bf(P.in[I_W2][((size_t)ld * 64 + j) * 512 + 64 * h + c]); A2T[c * TP + j] = (bf16)f2bf(P.in[I_A2][((size_t)ld * 64 + j) * 512 + 64 * h + c]); }
    if (tid < 64) { const int c = 64 * h + tid;
        CST[0 * 64 + tid] = P.in[I_MU][(size_t)(ld * 3 + 0) * 512 + c]; CST[1 * 64 + tid] = P.in[I_MU][(size_t)(ld * 3 + 1) * 512 + c]; CST[2 * 64 + tid] = P.in[I_MU][(size_t)(ld * 3 + 2) * 512 + c];
        CST[3 * 64 + tid] = P.in[I_MUW][ld * 64 + tid]; CST[4 * 64 + tid] = P.in[I_MUA][ld * 64 + tid];
        CST[5 * 64 + tid] = P.in[I_W0][ld * 512 + c]; CST[6 * 64 + tid] = P.in[I_A0][ld * 512 + c];
        CST[7 * 64 + tid] = P.in[I_KK][l * 512 + c]; CST[8 * 64 + tid] = P.in[I_KA][l * 512 + c]; CST[9 * 64 + tid] = P.in[I_RK][l * 512 + c]; }
    const bf16* Z = WSP(bf16, WS_Z);
    bf16* YS = WSP(bf16, WS_YS) + (size_t)dir * MT * 512;
    float* BONG = WSP(float, WS_BONG) + (size_t)dir * MT * 8;
    f32x4 St[4];
#pragma unroll
    for (int kt = 0; kt < 4; ++kt) St[kt] = (f32x4){0.f, 0.f, 0.f, 0.f};
    constexpr int NBT = LC / TB + SEQ / TB;
    const int sid = (b * 8 + h) * 2 + dir;
    gu32* ctlw = (gu32*)WSP(unsigned, WS_CTL);
    gu32* prodw = ctlw + CW_PROD + l * 16384 + 64 * sid; gu32* consw = ctlw + CW_CONS + l * 16384 + 64 * sid;
    unsigned char* ring = P.ws + WS_RING + (size_t)sid * (XFER_SLOTS * XFER_SLOT_BYTES);
    v4u XR[7];
    ScanPre R; scan_prefetch(Z, role == 1 ? 1 : 0, tk, b, dir, gc, c8, R);
    __syncthreads();
    for (int bi = (role == 1 ? 1 : 0); bi < NBT; ++bi) {
        const bool mine = (role == 2) || ((bi % 2 == 0) == (role == 0));
        if (role == 1 && !mine) continue;
        const int hj = bi >> 1;
        const int bstep = role == 2 ? 1 : 2;
        const bool need_out = (bi >= LC / TB) || (l == 0);
        bool hp; int prow; const int row = scan_row(bi, tk, b, dir, hp, prow); (void)prow;
#ifdef PROBE_PREP2
        for (int prb_ = 0; prb_ < 2; ++prb_)
#endif
        if (mine) {
        if (role == 1 && hj >= XFER_SLOTS) { if (w == 0) wait_ge(consw, (unsigned)(hj - XFER_SLOTS + 1), ctlw + CW_TMO, 0x900u, lane); __syncthreads(); }
        float kx[8], vx[8], rx[8];
        { float wl[8], al[8];
          lerp8(R.kc, R.kp, hp, CST + 0 * 64 + c8, kx); lerp8(R.vc, R.vp, hp, CST + 1 * 64 + c8, vx); lerp8(R.rc, R.rp, hp, CST + 2 * 64 + c8, rx);
          lerp8(R.wc, R.wp, hp, CST + 3 * 64 + c8, wl); lerp8(R.ac, R.ap, hp, CST + 4 * 64 + c8, al);
#pragma unroll
          for (int j = 0; j < 8; ++j) wl[j] = ftanh(wl[j]);
          *(LAS v4u*)(TWb + tk * TP + c8) = pack8(wl); *(LAS v4u*)(ALb + tk * TP + c8) = pack8(al); }
        if (bi + bstep < NBT) scan_prefetch(Z, bi + bstep, tk, b, dir, gc, c8, R);
        __syncthreads();
        { const int mt = w & 3;
          bf16x8 yt[2], ya[2];
#pragma unroll
          for (int k2 = 0; k2 < 2; ++k2) { yt[k2] = *(const LAS bf16x8*)(TWb + (16 * mt + fr) * TP + 32 * k2 + 8 * fq); ya[k2] = *(const LAS bf16x8*)(ALb + (16 * mt + fr) * TP + 32 * k2 + 8 * fq); }
#pragma unroll
          for (int n2 = 0; n2 < 2; ++n2) { const int nt = 2 * (w >> 2) + n2;
              f32x4 cw = {0.f, 0.f, 0.f, 0.f}, ca = {0.f, 0.f, 0.f, 0.f};
#pragma unroll
              for (int k2 = 0; k2 < 2; ++k2) {
                  cw = MFMA16(*(const LAS bf16x8*)(W2T + (16 * nt + fr) * TP + 32 * k2 + 8 * fq), yt[k2], cw);
                  ca = MFMA16(*(const LAS bf16x8*)(A2T + (16 * nt + fr) * TP + 32 * k2 + 8 * fq), ya[k2], ca); }
              *(LAS f32x4*)(LW + (16 * mt + fr) * LWP + 16 * nt + 4 * fq) = cw; *(LAS f32x4*)(LA + (16 * mt + fr) * LWP + 16 * nt + 4 * fq) = ca; } }
        __syncthreads();
        float na[8], pb[8], km[8];
        {
            float n2 = 0.f, bon = 0.f, ew[8];
#pragma unroll
            for (int hf = 0; hf < 2; ++hf) {
#pragma unroll
                for (int j = 4 * hf; j < 4 * hf + 4; ++j) {
                    const float aw = LW[tk * LWP + c8 + j], aa = LA[tk * LWP + c8 + j];
                    ew[j] = 0.6065306597f * frcp(1.0f + fexp(-(CST[5 * 64 + c8 + j] + aw)));
                    const float ag = frcp(1.0f + fexp(-(CST[6 * 64 + c8 + j] + aa)));
                    const float kk = kx[j] * CST[7 * 64 + c8 + j]; n2 += kk * kk;
                    km[j] = kx[j] * (1.0f + (ag - 1.0f) * CST[8 * 64 + c8 + j]);
                    bon += rx[j] * km[j] * CST[9 * 64 + c8 + j];
                    na[j] = kk; pb[j] = ag;
                }
                __builtin_amdgcn_sched_barrier(0);
            }
            n2 = sum8(n2); bon = sum8(bon);
            const float inv = frcp(fmaxf(__builtin_amdgcn_sqrtf(n2), 1e-12f));
#pragma unroll
            for (int j = 0; j < 8; ++j) { const float kkn = na[j] * inv; na[j] = -kkn; pb[j] = kkn * pb[j]; }
            *(LAS f32x4*)(CUM + tk * 64 + c8) = (f32x4){ew[0], ew[1], ew[2], ew[3]} * 1.44269504089f; *(LAS f32x4*)(CUM + tk * 64 + c8 + 4) = (f32x4){ew[4], ew[5], ew[6], ew[7]} * 1.44269504089f;
            if ((tid & 7) == 0 && need_out) BONG[(size_t)row * 8 + h] = bon;
        }
        __syncthreads();
        if (tid < 256) { const int q = tid >> 6, ch = tid & 63; float c = 0.f;
#pragma unroll
            for (int i = 0; i < 16; ++i) { c -= CUM[(16 * q + i) * 64 + ch]; const float p = __builtin_amdgcn_exp2f(c); CUM[(16 * q + i) * 64 + ch] = p; if (i == 15) PCb[q * 64 + ch] = p; } }
        __syncthreads();
        {
            const int q = tk >> 4, tt = tk & 15;
            const f32x4 one4 = {1.f, 1.f, 1.f, 1.f};
            const f32x4 et0 = *(const LAS f32x4*)(CUM + tk * 64 + c8), et1 = *(const LAS f32x4*)(CUM + tk * 64 + c8 + 4);
            const f32x4 ep0 = tt ? *(const LAS f32x4*)(CUM + (tk - 1) * 64 + c8) : one4, ep1 = tt ? *(const LAS f32x4*)(CUM + (tk - 1) * 64 + c8 + 4) : one4;
            const f32x4 pc0 = *(const LAS f32x4*)(PCb + q * 64 + c8), pc1 = *(const LAS f32x4*)(PCb + q * 64 + c8 + 4);
            float ei8[8];
            { float t8[8];
#pragma unroll
              for (int j = 0; j < 8; ++j) t8[j] = na[j] * (j < 4 ? ep0[j & 3] : ep1[j & 3]);
              *(LAS v4u*)(AT + tk * TP + c8) = pack8(t8); }
            { float t8[8];
#pragma unroll
              for (int j = 0; j < 8; ++j) { const float et = j < 4 ? et0[j & 3] : et1[j & 3]; t8[j] = rx[j] * et; ei8[j] = frcp(et); }
              *(LAS v4u*)(RT + tk * TP + c8) = pack8(t8); }
            { float t8[8];
#pragma unroll
              for (int j = 0; j < 8; ++j) t8[j] = pb[j] * ei8[j];
              *(LAS v4u*)(BT + tk * TP + c8) = pack8(t8); }
            { float t8[8];
#pragma unroll
              for (int j = 0; j < 8; ++j) t8[j] = km[j] * ei8[j];
              *(LAS v4u*)(KT + tk * TP + c8) = pack8(t8); }
#pragma unroll
            for (int j = 0; j < 8; j += 2) { const float eh0 = (j < 4 ? pc0[j & 3] : pc1[j & 3]) * ei8[j], eh1 = (j + 1 < 4 ? pc0[(j + 1) & 3] : pc1[(j + 1) & 3]) * ei8[j + 1];
                const unsigned wb = pk2(pb[j] * eh0, pb[j + 1] * eh1), wk = pk2(km[j] * eh0, km[j + 1] * eh1), wv = pk2(vx[j], vx[j + 1]); const int o = (q * 64 + c8 + j) * 16 + (tt ^ (4 * ((tid & 7) & 3)));
                BH[o] = (bf16)(wb & 0xffffu); BH[o + 16] = (bf16)(wb >> 16); KH[o] = (bf16)(wk & 0xffffu); KH[o + 16] = (bf16)(wk >> 16); Vt[o] = (bf16)(wv & 0xffffu); Vt[o + 16] = (bf16)(wv >> 16); }
        }
        __syncthreads();
        { const int q = w >> 1, rsel = w & 1;
          const LAS bf16* YR = rsel ? RT : AT;
          f32x4 cb = {0.f, 0.f, 0.f, 0.f}, ck = {0.f, 0.f, 0.f, 0.f};
#pragma unroll
          for (int k2 = 0; k2 < 2; ++k2) { const bf16x8 yf = *(const LAS bf16x8*)(YR + (16 * q + fr) * TP + 32 * k2 + 8 * fq);
              cb = MFMA16(*(const LAS bf16x8*)(BT + (16 * q + fr) * TP + 32 * k2 + 8 * fq), yf, cb);
              ck = MFMA16(*(const LAS bf16x8*)(KT + (16 * q + fr) * TP + 32 * k2 + 8 * fq), yf, ck); }
#pragma unroll
          for (int i2 = 0; i2 < 4; ++i2) { const int i = 4 * fq + i2; const bool keep = rsel ? (i <= fr) : (i < fr); if (!keep) { cb[i2] = 0.f; ck[i2] = 0.f; } }
          if (rsel == 0) { *(LAS f32x4*)(LabF + (q * 16 + fr) * 16 + 4 * fq) = cb; *(LAS bf16x4s*)(LakB + (q * 16 + fr) * 16 + 4 * fq) = pack4(ck); }
          else { *(LAS bf16x4s*)(MrbB + (q * 16 + fr) * 16 + 4 * fq) = pack4(cb); *(LAS bf16x4s*)(MrkB + (q * 16 + fr) * 16 + 4 * fq) = pack4(ck); } }
        __syncthreads();
        if (tid < 64) { const int q = tid >> 4, c = tid & 15; float T[16];
#pragma unroll
            for (int t = 0; t < 16; ++t) { float sacc = (t == c) ? 1.f : 0.f;
#pragma unroll
                for (int i = 0; i < t; ++i) sacc += LabF[(q * 16 + t) * 16 + i] * T[i];
                T[t] = sacc; TtB[(q * 16 + t) * 16 + c] = (bf16)f2bf(sacc); } }
        __syncthreads();
        }
        if (role == 1) {
            const __amdgpu_buffer_rsrc_t rs = __builtin_amdgcn_make_buffer_rsrc(ring, 0, XFER_SLOTS * XFER_SLOT_BYTES, 0x00020000);
            const unsigned sb0 = (unsigned)((hj % XFER_SLOTS) * XFER_SLOT_BYTES);
            for (int i = tid; i < XFER_PIECES; i += NTHR) { const v4u v = *(const LAS v4u*)(L0 + xfer_lds_off(i)); __builtin_amdgcn_raw_buffer_store_b128(v, rs, sb0 + 16u * (unsigned)i, 0, 16); }
            asm volatile("s_waitcnt vmcnt(0)" ::: "memory");
            __syncthreads();
            if (tid == 0) __hip_atomic_store(prodw, (unsigned)(hj + 1), RLX_AGENT);
            continue;
        }
        if (!mine) {
#pragma unroll
            for (int k = 0; k < 7; ++k) { const int i = tid + NTHR * k; if (i < XFER_PIECES) *(LAS v4u*)(L0 + xfer_lds_off(i)) = XR[k]; }
            __syncthreads();
            if (tid == 0) __hip_atomic_store(consw, (unsigned)(hj + 1), RLX_AGENT);
        }
        if (role == 0 && bi + 1 < NBT && (bi + 1) % 2 != 0) {
            const int hn = (bi + 1) >> 1;
            if (w == 0) { wait_ge(prodw, (unsigned)(hn + 1), ctlw + CW_TMO, 0xA00u, lane); __builtin_amdgcn_fence(__ATOMIC_ACQUIRE, "agent"); asm volatile("s_waitcnt vmcnt(0)" ::: "memory"); }
            __syncthreads();
            const unsigned char* src = ring + (size_t)(hn % XFER_SLOTS) * XFER_SLOT_BYTES;
#pragma unroll
            for (int k = 0; k < 7; ++k) { int i = tid + NTHR * k; i = i < XFER_PIECES ? i : XFER_PIECES - 1; XR[k] = *(const v4u*)(src + 16 * i); }
        }
#ifdef PROBE_S2
        f32x4 Ssv[4];
#pragma unroll
        for (int kt = 0; kt < 4; ++kt) Ssv[kt] = St[kt];
        for (int prb_ = 0; prb_ < 2; ++prb_) {
        if (prb_) {
#pragma unroll
            for (int kt = 0; kt < 4; ++kt) St[kt] = Ssv[kt]; }
#endif
        if (w < 4) {
#pragma unroll 1
            for (int q = 0; q < 4; ++q) {
                const bf16x4s z4s = {0, 0, 0, 0};
#define CAT2(p0, p1) __builtin_shufflevector(*(const LAS bf16x4s*)(p0), *(const LAS bf16x4s*)(p1), 0, 1, 2, 3, 4, 5, 6, 7)
#define PAD8(p0) __builtin_shufflevector(*(const LAS bf16x4s*)(p0), z4s, 0, 1, 2, 3, 4, 5, 6, 7)
                const bf16x4s vt4 = *(const LAS bf16x4s*)(Vt + (q * 64 + 16 * w + fr) * 16 + 4 * (fq ^ ((2 * w + (fr >> 3)) & 3)));
                const LAS bf16* atp = AT + (16 * q + fr) * TP + 4 * fq; const LAS bf16* rtp = RT + (16 * q + fr) * TP + 4 * fq;
                f32x4 x1 = {0.f, 0.f, 0.f, 0.f}, yv = {0.f, 0.f, 0.f, 0.f};
                { const bf16x8 s01 = __builtin_shufflevector(pack4(St[0]), pack4(St[1]), 0, 1, 2, 3, 4, 5, 6, 7), s23 = __builtin_shufflevector(pack4(St[2]), pack4(St[3]), 0, 1, 2, 3, 4, 5, 6, 7);
                  x1 = MFMA16(CAT2(atp, atp + 16), s01, x1); x1 = MFMA16(CAT2(atp + 32, atp + 48), s23, x1);
                  yv = MFMA16(CAT2(rtp, rtp + 16), s01, yv); yv = MFMA16(CAT2(rtp + 32, rtp + 48), s23, yv); }
                x1 = MFMA16(PAD8(LakB + (q * 16 + fr) * 16 + 4 * fq), __builtin_shufflevector(vt4, z4s, 0, 1, 2, 3, 4, 5, 6, 7), x1);
                const f32x4 u = MFMA16(PAD8(TtB + (q * 16 + fr) * 16 + 4 * fq), __builtin_shufflevector(pack4(x1), z4s, 0, 1, 2, 3, 4, 5, 6, 7), ((f32x4){0.f, 0.f, 0.f, 0.f}));
                const bf16x8 vu = __builtin_shufflevector(vt4, pack4(u), 0, 1, 2, 3, 4, 5, 6, 7);
                yv = MFMA16(CAT2(MrkB + (q * 16 + fr) * 16 + 4 * fq, MrbB + (q * 16 + fr) * 16 + 4 * fq), vu, yv);
#pragma unroll
                for (int i2 = 0; i2 < 4; ++i2) YB[(16 * q + 4 * fq + i2) * 64 + 16 * w + fr] = yv[i2];
#pragma unroll
                for (int kt = 0; kt < 4; ++kt)
                    St[kt] = MFMA16(CAT2(KH + (q * 64 + 16 * kt + fr) * 16 + 4 * (fq ^ ((2 * kt + (fr >> 3)) & 3)), BH + (q * 64 + 16 * kt + fr) * 16 + 4 * (fq ^ ((2 * kt + (fr >> 3)) & 3))), vu, St[kt] * *(const LAS f32x4*)(PCb + q * 64 + 16 * kt + 4 * fq));
#undef CAT2
#undef PAD8
            }
        }
#ifdef PROBE_S2
        __syncthreads(); }
#endif
        __syncthreads();
        if (need_out) {
            float y8[8];
#pragma unroll
            for (int j = 0; j < 8; ++j) y8[j] = YB[tk * 64 + c8 + j];
            *(v4u*)(YS + (size_t)row * 512 + gc) = pack8(y8);
        }
    }
    __syncthreads();
}

constexpr int PL_CST = 0, PL_TW = 2560, PL_AL = PL_TW + 9216, PL_LW = PL_AL + 9216, PL_LA = PL_LW + 16384, PL_SET = PL_LA + 16384, PL_SETB = 52224, PL_END = PL_SET + 2 * PL_SETB;
static_assert(PL_END <= MISC_OFF, "pipelined scan LDS map");
__device__ __forceinline__ void scan_unit_pipe(const Params& P, const Frame& F, int l, int b, int h, int dir) {
    LAS unsigned char* L0 = F.lds;
    LAS float* CST = (LAS float*)(L0 + PL_CST);
    LAS bf16* TWb = (LAS bf16*)(L0 + PL_TW);
    LAS bf16* ALb = (LAS bf16*)(L0 + PL_AL);
    LAS bf16* BT = TWb; LAS bf16* KT = ALb;
    LAS float* LW = (LAS float*)(L0 + PL_LW);
    LAS float* LA = (LAS float*)(L0 + PL_LA);
    LAS float* CUM = LW; LAS float* LabF = LA;
    const int tid = F.tid, lane = F.lane, w = F.wave, fr = lane & 15, fq = lane >> 4;
    const int tk = tid >> 3, c8 = (tid & 7) * 8, gc = 64 * h + c8;
    const int ld = l * 2 + dir;
    if (tid < 64) { const int c = 64 * h + tid;
        CST[0 * 64 + tid] = P.in[I_MU][(size_t)(ld * 3 + 0) * 512 + c]; CST[1 * 64 + tid] = P.in[I_MU][(size_t)(ld * 3 + 1) * 512 + c]; CST[2 * 64 + tid] = P.in[I_MU][(size_t)(ld * 3 + 2) * 512 + c];
        CST[3 * 64 + tid] = P.in[I_MUW][ld * 64 + tid]; CST[4 * 64 + tid] = P.in[I_MUA][ld * 64 + tid];
        CST[5 * 64 + tid] = P.in[I_W0][ld * 512 + c]; CST[6 * 64 + tid] = P.in[I_A0][ld * 512 + c];
        CST[7 * 64 + tid] = P.in[I_KK][l * 512 + c]; CST[8 * 64 + tid] = P.in[I_KA][l * 512 + c]; CST[9 * 64 + tid] = P.in[I_RK][l * 512 + c]; }
    const bf16* Z = WSP(bf16, WS_Z);
    bf16* YS = WSP(bf16, WS_YS) + (size_t)dir * MT * 512;
    float* BONG = WSP(float, WS_BONG) + (size_t)dir * MT * 8;
    f32x4 St[4];
#pragma unroll
    for (int kt = 0; kt < 4; ++kt) St[kt] = (f32x4){0.f, 0.f, 0.f, 0.f};
    constexpr int NBT = LC / TB + SEQ / TB;
    ScanPre R; scan_prefetch(Z, 0, tk, b, dir, gc, c8, R);
    __syncthreads();
#define PL_CHAIN(q) do { if (w < 4 && it >= 1) { \
        const bf16x4s z4s = {0, 0, 0, 0}; \
        const LAS bf16* cBH = (const LAS bf16*)(cset); const LAS bf16* cKH = cBH + 4096; const LAS bf16* cVt = cKH + 4096; const LAS bf16* cAT = (const LAS bf16*)(cset + 24576); const LAS bf16* cRT = (const LAS bf16*)(cset + 33792); \
        const LAS bf16* cLak = (const LAS bf16*)(cset + 43008); const LAS bf16* cTt = cLak + 1024; const LAS bf16* cMrb = cTt + 1024; const LAS bf16* cMrk = cMrb + 1024; const LAS float* cPC = (const LAS float*)(cset + 51200); \
        const bf16x4s vt4 = *(const LAS bf16x4s*)(cVt + ((q) * 64 + 16 * w + fr) * 16 + 4 * fq); \
        const LAS bf16* atp = cAT + (16 * (q) + fr) * TP + 4 * fq; const LAS bf16* rtp = cRT + (16 * (q) + fr) * TP + 4 * fq; \
        f32x4 x1 = {0.f, 0.f, 0.f, 0.f}, yv = {0.f, 0.f, 0.f, 0.f}; \
        { const bf16x8 s01 = __builtin_shufflevector(pack4(St[0]), pack4(St[1]), 0, 1, 2, 3, 4, 5, 6, 7), s23 = __builtin_shufflevector(pack4(St[2]), pack4(St[3]), 0, 1, 2, 3, 4, 5, 6, 7); \
          x1 = MFMA16(PL_CAT2(atp, atp + 16), s01, x1); x1 = MFMA16(PL_CAT2(atp + 32, atp + 48), s23, x1); \
          yv = MFMA16(PL_CAT2(rtp, rtp + 16), s01, yv); yv = MFMA16(PL_CAT2(rtp + 32, rtp + 48), s23, yv); } \
        x1 = MFMA16(PL_PAD8(cLak + ((q) * 16 + fr) * 16 + 4 * fq), __builtin_shufflevector(vt4, z4s, 0, 1, 2, 3, 4, 5, 6, 7), x1); \
        const f32x4 u = MFMA16(PL_PAD8(cTt + ((q) * 16 + fr) * 16 + 4 * fq), __builtin_shufflevector(pack4(x1), z4s, 0, 1, 2, 3, 4, 5, 6, 7), ((f32x4){0.f, 0.f, 0.f, 0.f})); \
        const bf16x8 vu = __builtin_shufflevector(vt4, pack4(u), 0, 1, 2, 3, 4, 5, 6, 7); \
        yv = MFMA16(PL_CAT2(cMrk + ((q) * 16 + fr) * 16 + 4 * fq, cMrb + ((q) * 16 + fr) * 16 + 4 * fq), vu, yv); \
        _Pragma("unroll") for (int kt = 0; kt < 4; ++kt) { \
            St[kt] = MFMA16(PL_CAT2(cKH + ((q) * 64 + 16 * kt + fr) * 16 + 4 * fq, cBH + ((q) * 64 + 16 * kt + fr) * 16 + 4 * fq), vu, St[kt] * *(const LAS f32x4*)(cPC + (q) * 64 + 16 * kt + 4 * fq)); \
            if (kt & 1) __builtin_amdgcn_sched_barrier(0); } \
        if (cout_) { _Pragma("unroll") for (int i2 = 0; i2 < 4; ++i2) { bool hp2; int pr2; const int row2 = scan_row(it - 1, 16 * (q) + 4 * fq + i2, b, dir, hp2, pr2); \
            YS[(size_t)row2 * 512 + 64 * h + 16 * w + fr] = (bf16)f2bf(yv[i2]); } } \
    } } while (0)
#define PL_CAT2(p0, p1) __builtin_shufflevector(*(const LAS bf16x4s*)(p0), *(const LAS bf16x4s*)(p1), 0, 1, 2, 3, 4, 5, 6, 7)
#define PL_PAD8(p0) __builtin_shufflevector(*(const LAS bf16x4s*)(p0), z4s, 0, 1, 2, 3, 4, 5, 6, 7)
    for (int it = 0; it <= NBT; ++it) {
        const bool prep = it < NBT;
        const LAS unsigned char* cset = L0 + PL_SET + ((it - 1) & 1) * PL_SETB;
        LAS unsigned char* pset = L0 + PL_SET + (it & 1) * PL_SETB;
        const bool need_out = (it >= LC / TB) || (l == 0), cout_ = (it - 1 >= LC / TB) || (l == 0);
        LAS bf16* BH = (LAS bf16*)pset; LAS bf16* KH = BH + 4096; LAS bf16* Vt = KH + 4096; LAS bf16* AT = (LAS bf16*)(pset + 24576); LAS bf16* RT = (LAS bf16*)(pset + 33792);
        LAS bf16* LakB = (LAS bf16*)(pset + 43008); LAS bf16* TtB = LakB + 1024; LAS bf16* MrbB = TtB + 1024; LAS bf16* MrkB = MrbB + 1024; LAS float* PCb = (LAS float*)(pset + 51200);
        bool hp = false; int prow = 0; const int row = prep ? scan_row(it, tk, b, dir, hp, prow) : 0; (void)prow;
        float kx[8], vx[8], rx[8], na[8], pb[8], km[8];
#ifdef PROBE_ST1
        for (int prb_ = 0; prb_ < 2; ++prb_)
#endif
        if (prep) { float wl[8], al[8];
            lerp8(R.kc, R.kp, hp, CST + 0 * 64 + c8, kx); lerp8(R.vc, R.vp, hp, CST + 1 * 64 + c8, vx); lerp8(R.rc, R.rp, hp, CST + 2 * 64 + c8, rx);
            lerp8(R.wc, R.wp, hp, CST + 3 * 64 + c8, wl); lerp8(R.ac, R.ap, hp, CST + 4 * 64 + c8, al);
#pragma unroll
            for (int j = 0; j < 8; ++j) wl[j] = ftanh(wl[j]);
            *(LAS v4u*)(TWb + tk * TP + c8) = pack8(wl); *(LAS v4u*)(ALb + tk * TP + c8) = pack8(al);
        }
        __syncthreads();
        if (w >= 4) { if (prep) { const int nt = w - 4;
            int ll = lane; asm volatile("" : "+v"(ll));
            const size_t lo = ((size_t)ld * 512 + 64 * h + 16 * nt + (ll & 15)) * 64 + 8 * (ll >> 4);
            const bf16* w2g = WSP(bf16, WS_W2TG) + lo; const bf16* a2g = WSP(bf16, WS_A2TG) + lo;
            bf16x8 w2x[2], a2x[2];
#pragma unroll
            for (int k2 = 0; k2 < 2; ++k2) { w2x[k2] = *(const bf16x8*)(w2g + 32 * k2); a2x[k2] = *(const bf16x8*)(a2g + 32 * k2); }
#pragma unroll
            for (int mt = 0; mt < 4; ++mt) { f32x4 cw = {0.f, 0.f, 0.f, 0.f}, ca = {0.f, 0.f, 0.f, 0.f};
#pragma unroll
                for (int k2 = 0; k2 < 2; ++k2) { cw = MFMA16(w2x[k2], *(const LAS bf16x8*)(TWb + (16 * mt + fr) * TP + 32 * k2 + 8 * fq), cw); ca = MFMA16(a2x[k2], *(const LAS bf16x8*)(ALb + (16 * mt + fr) * TP + 32 * k2 + 8 * fq), ca); }
                *(LAS f32x4*)(LW + (16 * mt + fr) * 64 + 16 * nt + 4 * fq) = cw; *(LAS f32x4*)(LA + (16 * mt + fr) * 64 + 16 * nt + 4 * fq) = ca; } } }
        else PL_CHAIN(0);
        __syncthreads();
#ifdef PROBE_ST3
        float lwsv[8], lasv[8];
        if (prep) {
#pragma unroll
            for (int j = 0; j < 8; ++j) { lwsv[j] = LW[tk * 64 + c8 + j]; lasv[j] = LA[tk * 64 + c8 + j]; } }
        for (int prb_ = 0; prb_ < 2; ++prb_) {
        if (prb_ && prep) {
#pragma unroll
            for (int j = 0; j < 8; ++j) { LW[tk * 64 + c8 + j] = lwsv[j]; LA[tk * 64 + c8 + j] = lasv[j]; } }
#endif
        if (prep) {
            float n2 = 0.f, bon = 0.f, ew[8];
#pragma unroll
            for (int hf = 0; hf < 2; ++hf) {
#pragma unroll
                for (int j = 4 * hf; j < 4 * hf + 4; ++j) {
                    const float aw = LW[tk * 64 + c8 + j], aa = LA[tk * 64 + c8 + j];
                    ew[j] = 0.6065306597f * frcp(1.0f + fexp(-(CST[5 * 64 + c8 + j] + aw)));
                    const float ag = frcp(1.0f + fexp(-(CST[6 * 64 + c8 + j] + aa)));
                    const float kk = kx[j] * CST[7 * 64 + c8 + j]; n2 += kk * kk;
                    km[j] = kx[j] * (1.0f + (ag - 1.0f) * CST[8 * 64 + c8 + j]);
                    bon += rx[j] * km[j] * CST[9 * 64 + c8 + j];
                    na[j] = kk; pb[j] = ag;
                }
                __builtin_amdgcn_sched_barrier(0);
            }
            n2 = sum8(n2); bon = sum8(bon);
            const float inv = frcp(fmaxf(__builtin_amdgcn_sqrtf(n2), 1e-12f));
#pragma unroll
            for (int j = 0; j < 8; ++j) { const float kkn = na[j] * inv; na[j] = -kkn; pb[j] = kkn * pb[j]; }
            *(LAS f32x4*)(CUM + tk * 64 + c8) = (f32x4){ew[0], ew[1], ew[2], ew[3]} * 1.44269504089f; *(LAS f32x4*)(CUM + tk * 64 + c8 + 4) = (f32x4){ew[4], ew[5], ew[6], ew[7]} * 1.44269504089f;
            if ((tid & 7) == 0 && need_out) BONG[(size_t)row * 8 + h] = bon;
#pragma unroll
            for (int j = 0; j < 8; j += 2) { const unsigned wv = pk2(vx[j], vx[j + 1]); const int o = ((tk >> 4) * 64 + c8 + j) * 16 + (tk & 15); Vt[o] = (bf16)(wv & 0xffffu); Vt[o + 16] = (bf16)(wv >> 16); }
        }
#ifdef PROBE_ST3
        }
#endif
        __syncthreads();
        if (w >= 4) { if (prep) { const int t2 = tid - 256, q = t2 >> 6, ch = t2 & 63; float c = 0.f;
#pragma unroll
            for (int i = 0; i < 16; ++i) { c -= CUM[(16 * q + i) * 64 + ch]; const float p = __builtin_amdgcn_exp2f(c); CUM[(16 * q + i) * 64 + ch] = p; if (i == 15) PCb[q * 64 + ch] = p; } } }
        else PL_CHAIN(1);
        __syncthreads();
#ifdef PROBE_ST5
        for (int prb_ = 0; prb_ < 2; ++prb_)
#endif
        if (prep) {
            const int q = tk >> 4, tt = tk & 15;
            const f32x4 one4 = {1.f, 1.f, 1.f, 1.f};
            const f32x4 et0 = *(const LAS f32x4*)(CUM + tk * 64 + c8), et1 = *(const LAS f32x4*)(CUM + tk * 64 + c8 + 4);
            const f32x4 ep0 = tt ? *(const LAS f32x4*)(CUM + (tk - 1) * 64 + c8) : one4, ep1 = tt ? *(const LAS f32x4*)(CUM + (tk - 1) * 64 + c8 + 4) : one4;
            const f32x4 pc0 = *(const LAS f32x4*)(PCb + q * 64 + c8), pc1 = *(const LAS f32x4*)(PCb + q * 64 + c8 + 4);
            float ei8[8];
            { float t8[8];
#pragma unroll
              for (int j = 0; j < 8; ++j) t8[j] = na[j] * (j < 4 ? ep0[j & 3] : ep1[j & 3]);
              *(LAS v4u*)(AT + tk * TP + c8) = pack8(t8); }
            __builtin_amdgcn_sched_barrier(0);
            { float t8[8];
#pragma unroll
              for (int j = 0; j < 8; ++j) { const float et = j < 4 ? et0[j & 3] : et1[j & 3]; t8[j] = rx[j] * et; ei8[j] = frcp(et); }
              *(LAS v4u*)(RT + tk * TP + c8) = pack8(t8); }
            __builtin_amdgcn_sched_barrier(0);
            { float t8[8];
#pragma unroll
              for (int j = 0; j < 8; ++j) t8[j] = pb[j] * ei8[j];
              *(LAS v4u*)(BT + tk * TP + c8) = pack8(t8); }
            __builtin_amdgcn_sched_barrier(0);
            { float t8[8];
#pragma unroll
              for (int j = 0; j < 8; ++j) t8[j] = km[j] * ei8[j];
              *(LAS v4u*)(KT + tk * TP + c8) = pack8(t8); }
            __builtin_amdgcn_sched_barrier(0);
#pragma unroll
            for (int j = 0; j < 8; j += 2) { const float eh0 = (j < 4 ? pc0[j & 3] : pc1[j & 3]) * ei8[j], eh1 = (j + 1 < 4 ? pc0[(j + 1) & 3] : pc1[(j + 1) & 3]) * ei8[j + 1];
                const unsigned wb = pk2(pb[j] * eh0, pb[j + 1] * eh1), wk = pk2(km[j] * eh0, km[j + 1] * eh1); const int o = (q * 64 + c8 + j) * 16 + tt;
                BH[o] = (bf16)(wb & 0xffffu); BH[o + 16] = (bf16)(wb >> 16); KH[o] = (bf16)(wk & 0xffffu); KH[o + 16] = (bf16)(wk >> 16); }
        }
        __syncthreads();
        if (it + 1 < NBT) scan_prefetch(Z, it + 1, tk, b, dir, gc, c8, R);
        if (w >= 4) { if (prep) { const int q = w - 4;
#pragma unroll
            for (int rsel = 0; rsel < 2; ++rsel) {
                const LAS bf16* YR = rsel ? RT : AT;
                f32x4 cb = {0.f, 0.f, 0.f, 0.f}, ck = {0.f, 0.f, 0.f, 0.f};
#pragma unroll
                for (int k2 = 0; k2 < 2; ++k2) { const bf16x8 yf = *(const LAS bf16x8*)(YR + (16 * q + fr) * TP + 32 * k2 + 8 * fq);
                    cb = MFMA16(*(const LAS bf16x8*)(BT + (16 * q + fr) * TP + 32 * k2 + 8 * fq), yf, cb);
                    ck = MFMA16(*(const LAS bf16x8*)(KT + (16 * q + fr) * TP + 32 * k2 + 8 * fq), yf, ck); }
#pragma unroll
                for (int i2 = 0; i2 < 4; ++i2) { const int i = 4 * fq + i2; const bool keep = rsel ? (i <= fr) : (i < fr); if (!keep) { cb[i2] = 0.f; ck[i2] = 0.f; } }
                if (rsel == 0) { *(LAS f32x4*)(LabF + (q * 16 + fr) * 16 + 4 * fq) = cb; *(LAS bf16x4s*)(LakB + (q * 16 + fr) * 16 + 4 * fq) = pack4(ck); }
                else { *(LAS bf16x4s*)(MrbB + (q * 16 + fr) * 16 + 4 * fq) = pack4(cb); *(LAS bf16x4s*)(MrkB + (q * 16 + fr) * 16 + 4 * fq) = pack4(ck); } } } }
        else PL_CHAIN(2);
        __syncthreads();
        if (w == 4) { if (prep) { const int q = lane >> 4, c = lane & 15; float T[16];
#pragma unroll
            for (int t = 0; t < 16; ++t) { float sacc = (t == c) ? 1.f : 0.f;
#pragma unroll
                for (int i = 0; i < t; ++i) sacc += LabF[(q * 16 + t) * 16 + i] * T[i];
                T[t] = sacc; TtB[(q * 16 + t) * 16 + c] = (bf16)f2bf(sacc); } } }
        else if (w < 4) PL_CHAIN(3);
        __syncthreads();
    }
#undef PL_CHAIN
#undef PL_CAT2
#undef PL_PAD8
}

__device__ __forceinline__ void conv_items(const Params& P, const Frame& F, int l, int nrows, int ob, int nob) {
    const bf16* Z = WSP(bf16, WS_Z); bf16* YM = WSP(bf16, WS_H);
    const float* cw = P.in[I_CONVW] + l * 768;
    for (int idx = ob * NTHR + F.tid; idx < nrows * 32; idx += nob * NTHR) {
        const int row = idx >> 5, ch = (idx & 31) * 8;
        bool hp, hn;
        if (row < NT) { const int col = row & 63; hp = col != 0; hn = col != 63; } else { const int t = (row - NT) & 255; hp = t != 0; hn = t != 255; }
        const bf16* zr = Z + (size_t)row * NZ;
        const v4u u1 = *(const v4u*)(zr + C_U + ch), g1 = *(const v4u*)(zr + C_GC + ch), gb = *(const v4u*)(zr + C_GB + ch);
        v4u u0 = {0u, 0u, 0u, 0u}, g0 = u0, u2 = u0, g2 = u0;
        if (hp) { u0 = *(const v4u*)(zr - NZ + C_U + ch); g0 = *(const v4u*)(zr - NZ + C_GC + ch); }
        if (hn) { u2 = *(const v4u*)(zr + NZ + C_U + ch); g2 = *(const v4u*)(zr + NZ + C_GC + ch); }
        v4u o;
#pragma unroll
        for (int q = 0; q < 4; ++q) {
            const float wa0 = cw[ch + 2 * q], wa1 = cw[256 + ch + 2 * q], wa2 = cw[512 + ch + 2 * q], wb0 = cw[ch + 2 * q + 1], wb1 = cw[256 + ch + 2 * q + 1], wb2 = cw[512 + ch + 2 * q + 1];
            const float lo = bflo(gb[q]) * (wa0 * bflo(g0[q]) * bflo(u0[q]) + wa1 * bflo(g1[q]) * bflo(u1[q]) + wa2 * bflo(g2[q]) * bflo(u2[q]));
            const float hi = bfhi(gb[q]) * (wb0 * bfhi(g0[q]) * bfhi(u0[q]) + wb1 * bfhi(g1[q]) * bfhi(u1[q]) + wb2 * bfhi(g2[q]) * bfhi(u2[q]));
            o[q] = pk2(lo, hi);
        }
        *(v4u*)(YM + (size_t)row * D + 512 + ch) = o;
    }
}

__device__ __forceinline__ void load_tab64(LAS bf16* dst, const bf16* src, int tid) {
    for (int i = tid; i < 512; i += NTHR) { const int r = i >> 3, c = (i & 7) * 8; *(LAS v4u*)(dst + r * TP + c) = *(const v4u*)(src + r * 64 + c); }
}
__device__ __forceinline__ bf16x8 ldsfrag(const LAS bf16* base, int row, int col) { return *(const LAS bf16x8*)(base + row * TP + col); }
__device__ __forceinline__ void fourier_a_iter(const Params& P, const Frame& F, int it) {
    const int bg = it >> 3, j = it & 7, b = bg >> 2, g = bg & 3, w = F.wave, lane = F.lane, fr = lane & 15, fq = lane >> 4, p2 = 8 * j + w;
    LAS bf16* TC64 = (LAS bf16*)F.lds; LAS bf16* TS64 = TC64 + 64 * TP; LAS bf16* TN64 = TS64 + 64 * TP;
    LAS bf16* PT = TN64 + 64 * TP + w * (64 * TP);
    load_tab64(TC64, WSP(bf16, TAB_C64), F.tid); load_tab64(TS64, WSP(bf16, TAB_S64), F.tid); load_tab64(TN64, WSP(bf16, TAB_SN64), F.tid);
    const bf16* Z = WSP(bf16, WS_Z);
    __syncthreads();
    f32x4 Yr[4][4], Yi[4][4];
#pragma unroll
    for (int a = 0; a < 4; ++a)
#pragma unroll
        for (int c = 0; c < 4; ++c) { Yr[a][c] = (f32x4){0.f, 0.f, 0.f, 0.f}; Yi[a][c] = (f32x4){0.f, 0.f, 0.f, 0.f}; }
#pragma unroll
    for (int pass = 0; pass < 2; ++pass) {
        const LAS bf16* T1 = pass == 0 ? TC64 : TS64;
        asm volatile("" ::: "memory");
#pragma unroll
        for (int xt = 0; xt < 4; ++xt) {
            bf16x8 Ff[2];
#pragma unroll
            for (int ks = 0; ks < 2; ++ks) Ff[ks] = *(const bf16x8*)(Z + (size_t)(b * SEQ + 64 * (16 * xt + fr) + p2) * NZ + C_F + 64 * g + 32 * ks + 8 * fq);
#pragma unroll
            for (int yt = 0; yt < 4; ++yt) {
                f32x4 acc = {0.f, 0.f, 0.f, 0.f};
#pragma unroll
                for (int ks = 0; ks < 2; ++ks) acc = MFMA16(Ff[ks], ldsfrag(T1, 16 * yt + fr, 32 * ks + 8 * fq), acc);
                v2u wv; wv.x = pk2(acc.x, acc.y); wv.y = pk2(acc.z, acc.w);
                *(LAS v2u*)(PT + (16 * yt + fr) * TP + 16 * xt + 4 * fq) = wv;
            }
            __builtin_amdgcn_sched_barrier(0);
        }
        LDS_WAIT(); asm volatile("" ::: "memory");
        const LAS bf16* TA = pass == 0 ? TC64 : TN64;
        const LAS bf16* TB = pass == 0 ? TS64 : TC64;
#pragma unroll
        for (int ks = 0; ks < 2; ++ks) {
            bf16x8 pf[4];
#pragma unroll
            for (int yt = 0; yt < 4; ++yt) pf[yt] = ldsfrag(PT, 16 * yt + fr, 32 * ks + 8 * fq);
#pragma unroll
            for (int xt = 0; xt < 4; ++xt) { const bf16x8 ta = ldsfrag(TA, 16 * xt + fr, 32 * ks + 8 * fq), tb = ldsfrag(TB, 16 * xt + fr, 32 * ks + 8 * fq);
#pragma unroll
                for (int yt = 0; yt < 4; ++yt) { Yr[xt][yt] = MFMA16(ta, pf[yt], Yr[xt][yt]); Yi[xt][yt] = MFMA16(tb, pf[yt], Yi[xt][yt]); }
                __builtin_amdgcn_sched_barrier(0); }
        }
        LDS_WAIT(); asm volatile("" ::: "memory");
    }
    __syncthreads();
    LAS bf16* EX = (LAS bf16*)F.lds;
    const float* twc = WSP(float, TAB_TWC); const float* tws = WSP(float, TAB_TWS);
#pragma unroll
    for (int xt = 0; xt < 4; ++xt)
#pragma unroll
        for (int i = 0; i < 4; ++i) { const int q1 = 16 * xt + 4 * fq + i, m = (p2 * q1) & 4095; const float tc = twc[m], ts = tws[m];
#pragma unroll
            for (int yt = 0; yt < 4; ++yt) { const float yr = Yr[xt][yt][i], yi = Yi[xt][yt][i]; const int cp = 16 * yt + fr;
                EX[((q1 * 2 + 0) * 64 + cp) * 8 + w] = (bf16)f2bf(yr * tc - yi * ts);
                EX[((q1 * 2 + 1) * 64 + cp) * 8 + w] = (bf16)f2bf(-yi * tc - yr * ts); }
            __builtin_amdgcn_sched_barrier(0); }
    __syncthreads();
    bf16* YB = WSP(bf16, WS_YBUF) + (size_t)bg * (64 * 2 * 64 * 64);
#pragma unroll 4
    for (int n = 0; n < 16; ++n) { const int q = F.tid + NTHR * n; *(v4u*)(YB + (size_t)q * 64 + 8 * j) = *(const LAS v4u*)(EX + q * 8); }
    __syncthreads();
}
__device__ __forceinline__ void fourier_b_unit(const Params& P, const Frame& F, int u, const LAS bf16* TC64, const LAS bf16* TS64) {
    const int bg = u >> 6, s2 = u & 63, b = bg >> 2, g = bg & 3, lane = F.lane, fr = lane & 15, fq = lane >> 4;
    const bf16* YB = WSP(bf16, WS_YBUF) + (size_t)bg * (64 * 2 * 64 * 64) + (size_t)s2 * (2 * 64 * 64);
    f32x4 acc[4][4];
#pragma unroll
    for (int a = 0; a < 4; ++a)
#pragma unroll
        for (int c = 0; c < 4; ++c) acc[a][c] = (f32x4){0.f, 0.f, 0.f, 0.f};
#pragma unroll
    for (int ks = 0; ks < 4; ++ks) { const int ri = ks >> 1, pb = (ks & 1) * 32;
        bf16x8 xf[4];
#pragma unroll
        for (int xt = 0; xt < 4; ++xt) xf[xt] = *(const bf16x8*)(YB + (size_t)(ri * 64 + 16 * xt + fr) * 64 + pb + 8 * fq);
        const LAS bf16* T = ri ? TS64 : TC64;
#pragma unroll
        for (int yt = 0; yt < 4; ++yt) { const bf16x8 tf = ldsfrag(T, 16 * yt + fr, pb + 8 * fq);
#pragma unroll
            for (int xt = 0; xt < 4; ++xt) acc[xt][yt] = MFMA16(xf[xt], tf, acc[xt][yt]); }
    }
    bf16* YM = WSP(bf16, WS_H);
#pragma unroll
    for (int yt = 0; yt < 4; ++yt) { const int s1 = 16 * yt + fr; bf16* rowp = YM + (size_t)(b * SEQ + 64 * s1 + s2) * D + 768 + 64 * g;
#pragma unroll
        for (int xt = 0; xt < 4; ++xt) { const f32x4 a = acc[xt][yt] * (1.0f / 512.0f); v2u wv; wv.x = pk2(a.x, a.y); wv.y = pk2(a.z, a.w); *(v2u*)(rowp + 16 * xt + 4 * fq) = wv; } }
}
constexpr int TP2 = 264;
__device__ __forceinline__ void fourier_ctx_unit(const Params& P, const Frame& F, int bg) {
    const int b = bg >> 2, g = bg & 3, w = F.wave, lane = F.lane, fr = lane & 15, fq = lane >> 4;
    LAS bf16* TC64 = (LAS bf16*)F.lds; LAS bf16* TS64 = TC64 + 64 * TP;
    LAS bf16* PT = TS64 + 64 * TP; LAS bf16* QT = PT + 64 * TP2;
    load_tab64(TC64, WSP(bf16, TAB_C64), F.tid); load_tab64(TS64, WSP(bf16, TAB_S64), F.tid);
    const bf16* Z = WSP(bf16, WS_Z);
    bf16x8 Ff[2][2];
#pragma unroll
    for (int xt = 0; xt < 2; ++xt)
#pragma unroll
        for (int ks = 0; ks < 2; ++ks) Ff[xt][ks] = *(const bf16x8*)(Z + (size_t)(NT + b * LC + 32 * w + 16 * xt + fr) * NZ + C_F + 64 * g + 32 * ks + 8 * fq);
    __syncthreads();
#pragma unroll
    for (int xt = 0; xt < 2; ++xt)
#pragma unroll
        for (int yt = 0; yt < 4; ++yt) {
            f32x4 ap = {0.f, 0.f, 0.f, 0.f}, aq = {0.f, 0.f, 0.f, 0.f};
#pragma unroll
            for (int ks = 0; ks < 2; ++ks) { ap = MFMA16(Ff[xt][ks], ldsfrag(TC64, 16 * yt + fr, 32 * ks + 8 * fq), ap); aq = MFMA16(Ff[xt][ks], ldsfrag(TS64, 16 * yt + fr, 32 * ks + 8 * fq), aq); }
            v2u wp, wq; wp.x = pk2(ap.x, ap.y); wp.y = pk2(ap.z, ap.w); wq.x = pk2(aq.x, aq.y); wq.y = pk2(aq.z, aq.w);
            *(LAS v2u*)(PT + (16 * yt + fr) * TP2 + 32 * w + 16 * xt + 4 * fq) = wp; *(LAS v2u*)(QT + (16 * yt + fr) * TP2 + 32 * w + 16 * xt + 4 * fq) = wq;
        }
    __syncthreads();
    const bf16* C256 = WSP(bf16, WS_C256); const bf16* SN256 = WSP(bf16, WS_SN256);
    f32x4 acc[4][2];
#pragma unroll
    for (int a = 0; a < 4; ++a)
#pragma unroll
        for (int c = 0; c < 2; ++c) acc[a][c] = (f32x4){0.f, 0.f, 0.f, 0.f};
#pragma unroll 2
    for (int ks = 0; ks < 8; ++ks) {
        bf16x8 cf[2], sf[2];
#pragma unroll
        for (int yt = 0; yt < 2; ++yt) { cf[yt] = *(const bf16x8*)(C256 + (size_t)(32 * w + 16 * yt + fr) * 256 + 32 * ks + 8 * fq); sf[yt] = *(const bf16x8*)(SN256 + (size_t)(32 * w + 16 * yt + fr) * 256 + 32 * ks + 8 * fq); }
#pragma unroll
        for (int xt = 0; xt < 4; ++xt) { const bf16x8 pf = *(const LAS bf16x8*)(PT + (16 * xt + fr) * TP2 + 32 * ks + 8 * fq), qf = *(const LAS bf16x8*)(QT + (16 * xt + fr) * TP2 + 32 * ks + 8 * fq);
#pragma unroll
            for (int yt = 0; yt < 2; ++yt) { acc[xt][yt] = MFMA16(pf, cf[yt], acc[xt][yt]); acc[xt][yt] = MFMA16(qf, sf[yt], acc[xt][yt]); } }
    }
    bf16* YM = WSP(bf16, WS_H);
#pragma unroll
    for (int yt = 0; yt < 2; ++yt) { bf16* rowp = YM + (size_t)(NT + b * LC + 32 * w + 16 * yt + fr) * D + 768 + 64 * g;
#pragma unroll
        for (int xt = 0; xt < 4; ++xt) { const f32x4 a = acc[xt][yt] * (1.0f / 128.0f); v2u wv; wv.x = pk2(a.x, a.y); wv.y = pk2(a.z, a.w); *(v2u*)(rowp + 16 * xt + 4 * fq) = wv; } }
    __syncthreads();
}

constexpr int GP = 136;
__device__ __forceinline__ void finalize_phase(const Params& P, const Frame& F, int l, int nrows) {
    LAS bf16* G2 = (LAS bf16*)F.lds;
    LAS float* WF = (LAS float*)(F.lds + 512 * GP * 2);
    const bf16* g2t = WSP(bf16, WS_G2T) + (size_t)l * 512 * 128;
    for (int i = F.tid; i < 512 * 16; i += NTHR) { const int r = i >> 4, c = (i & 15) * 8, rl = (r & ~63) + 16 * ((r >> 2) & 3) + 4 * ((r >> 4) & 3) + (r & 3); *(LAS v4u*)(G2 + rl * GP + c) = *(const v4u*)(g2t + r * 128 + c); }
    for (int i = F.tid; i < 4 * 128; i += NTHR) { const int wh = i >> 7, c = (i & 127) * 4;
        const float* src = wh < 2 ? P.in[I_MU] + (size_t)((l * 2 + wh) * 3 + 1) * 512 + c : (wh == 2 ? P.in[I_GNW] + l * 512 + c : P.in[I_GNB] + l * 512 + c);
        *(LAS f32x4*)(WF + wh * 512 + c) = *(const f32x4*)src; }
    __syncthreads();
    const int gw = F.bx * NWAVES + F.wave, NGW = F.G * NWAVES, lane = F.lane, fr = lane & 15, fq = lane >> 4;
    const bf16* Z = WSP(bf16, WS_Z); const bf16* YSb = WSP(bf16, WS_YS); const float* BONG = WSP(float, WS_BONG); bf16* YM = WSP(bf16, WS_H);
    const int nu = (nrows / 16) * 2;
    const int nq = gw < nu ? ((nu - 1 - gw) / NGW + 1) * 4 : 0;
    v4u yn[2][2], vcn[2], vpn[2], vnn[2]; float bonn[2]; v4u zvn[4];
    auto fetch = [&](int q) {
        const int u = gw + (q >> 2) * NGW, row = (u >> 1) * 16 + fr, head = 4 * (u & 1) + (q & 3);
        int t, len; if (row < NT) { t = row & (SEQ - 1); len = SEQ; } else { t = (row - NT) & (LC - 1); len = LC; }
        const int rp = t > 0 ? row - 1 : row, rn = t + 1 < len ? row + 1 : row;
        if ((q & 3) == 0) {
#pragma unroll
            for (int ks = 0; ks < 4; ++ks) zvn[ks] = *(const v4u*)(Z + (size_t)row * NZ + C_GLO + 32 * ks + 8 * fq); }
#pragma unroll
        for (int dir = 0; dir < 2; ++dir) { const bf16* ys = YSb + ((size_t)dir * MT + row) * 512 + 64 * head + 16 * fq;
#pragma unroll
            for (int h = 0; h < 2; ++h) yn[dir][h] = *(const v4u*)(ys + 8 * h);
            bonn[dir] = BONG[((size_t)dir * MT + row) * 8 + head]; }
#pragma unroll
        for (int h = 0; h < 2; ++h) { const int ch = C_V + 64 * head + 16 * fq + 8 * h;
            vcn[h] = *(const v4u*)(Z + (size_t)row * NZ + ch); vpn[h] = *(const v4u*)(Z + (size_t)rp * NZ + ch); vnn[h] = *(const v4u*)(Z + (size_t)rn * NZ + ch); }
    };
    auto up4 = [](const v4u (&w)[2], int j) -> f32x4 { const v4u q = w[j >> 1]; const unsigned lo = (j & 1) ? q.z : q.x, hi = (j & 1) ? q.w : q.y; return (f32x4){bflo(lo), bfhi(lo), bflo(hi), bfhi(hi)}; };
    bf16x8 sf[4];
    if (nq > 0) fetch(0);
    for (int q = 0; q < nq; ++q) {
        const int u = gw + (q >> 2) * NGW, row = (u >> 1) * 16 + fr, head = 4 * (u & 1) + (q & 3);
        int t, len; if (row < NT) { t = row & (SEQ - 1); len = SEQ; } else { t = (row - NT) & (LC - 1); len = LC; }
        const bool hprev = t > 0, hnext = t + 1 < len;
        if ((q & 3) == 0) {
#pragma unroll
            for (int ks = 0; ks < 4; ++ks) { v4u o;
#pragma unroll
                for (int k = 0; k < 4; ++k) o[k] = pk2(sigmoidf_(bflo(zvn[ks][k])), sigmoidf_(bfhi(zvn[ks][k])));
                sf[ks] = __builtin_bit_cast(bf16x8, o); } }
        f32x4 y[2][4], vc[4], vnb[2][4]; float bon[2];
#pragma unroll
        for (int j = 0; j < 4; ++j) { y[0][j] = up4(yn[0], j); y[1][j] = up4(yn[1], j); vc[j] = up4(vcn, j);
            vnb[0][j] = hprev ? up4(vpn, j) : (f32x4){0.f, 0.f, 0.f, 0.f}; vnb[1][j] = hnext ? up4(vnn, j) : (f32x4){0.f, 0.f, 0.f, 0.f}; }
        bon[0] = bonn[0]; bon[1] = bonn[1];
        if (q + 1 < nq) fetch(q + 1);
        f32x4 acc[4];
#pragma unroll
        for (int j = 0; j < 4; ++j) acc[j] = (f32x4){0.f, 0.f, 0.f, 0.f};
#pragma unroll
        for (int ks = 0; ks < 4; ++ks)
#pragma unroll
            for (int j = 0; j < 4; ++j) acc[j] = MFMA16(*(const LAS bf16x8*)(G2 + (64 * head + 16 * j + fr) * GP + 32 * ks + 8 * fq), sf[ks], acc[j]);
        f32x4 osum[4];
#pragma unroll
        for (int j = 0; j < 4; ++j) osum[j] = (f32x4){0.f, 0.f, 0.f, 0.f};
#pragma unroll
        for (int dir = 0; dir < 2; ++dir) {
            float s = 0.f;
#pragma unroll
            for (int j = 0; j < 4; ++j) s += (y[dir][j].x + y[dir][j].y) + (y[dir][j].z + y[dir][j].w);
            s += __shfl_xor(s, 16); s += __shfl_xor(s, 32);
            const float mean = s * (1.0f / 64.0f); float q2 = 0.f;
#pragma unroll
            for (int j = 0; j < 4; ++j) { y[dir][j] = y[dir][j] - mean; q2 += (y[dir][j].x * y[dir][j].x + y[dir][j].y * y[dir][j].y) + (y[dir][j].z * y[dir][j].z + y[dir][j].w * y[dir][j].w); }
            q2 += __shfl_xor(q2, 16); q2 += __shfl_xor(q2, 32);
            const float rstd = rsqrtf(q2 * (1.0f / 64.0f) + GN_EPS);
#pragma unroll
            for (int j = 0; j < 4; ++j) { const int ch = 64 * head + 16 * fq + 4 * j;
                const f32x4 mv = *(const LAS f32x4*)(WF + dir * 512 + ch), gw4 = *(const LAS f32x4*)(WF + 1024 + ch), gb4 = *(const LAS f32x4*)(WF + 1536 + ch);
                const f32x4 vx = vc[j] + (vnb[dir][j] - vc[j]) * mv;
                osum[j] += y[dir][j] * rstd * gw4 + gb4 + bon[dir] * vx; }
        }
#pragma unroll
        for (int h = 0; h < 2; ++h) { const f32x4 o0 = osum[2 * h] * acc[2 * h], o1 = osum[2 * h + 1] * acc[2 * h + 1];
            v4u wv; wv.x = pk2(o0.x, o0.y); wv.y = pk2(o0.z, o0.w); wv.z = pk2(o1.x, o1.y); wv.w = pk2(o1.z, o1.w); *(v4u*)(YM + (size_t)row * D + 64 * head + 16 * fq + 8 * h) = wv; }
    }
    __syncthreads();
}

struct MoePlan { int pb[9]; };
__device__ __forceinline__ void moe_plan(const Params& P, MoePlan& M, int (&cnt)[NE]) {
    int acc = 0;
#pragma unroll
    for (int e = 0; e < NE; ++e) { cnt[e] = (int)__hip_atomic_load(WSP(unsigned, WS_CTL) + CW_CNT + 64 * e, __ATOMIC_RELAXED, __HIP_MEMORY_SCOPE_AGENT); M.pb[e] = acc; acc += (cnt[e] + 255) >> 8; }
    M.pb[8] = acc;
}
__device__ __forceinline__ void moe_assign_gather(const Params& P, const Frame& F) {
    MoePlan M; int cnt[NE]; moe_plan(P, M, cnt);
    const int gw = F.bx * NWAVES + F.wave, NGW = F.G * NWAVES, lane = F.lane;
    const bf16* H = WSP(bf16, WS_H); bf16* XG = WSP(bf16, WS_XG);
    unsigned* fill = WSP(unsigned, WS_CTL) + CW_FILL;
    for (int it = gw; it < NT / 16; it += NGW) {
        const int tok = it * 16 + (lane & 15); const bool act = lane < 16;
        const int4 rt = *(const int4*)(P.ws + WS_ROUTE + (size_t)tok * 16);
        const int es[2] = {act ? (rt.x & 255) : 255, act ? ((rt.x >> 8) & 255) : 255};
        int pos[2];
#pragma unroll
        for (int s = 0; s < 2; ++s) {
            pos[s] = 0;
#pragma unroll
            for (int e = 0; e < NE; ++e) {
                const unsigned long long m = __ballot(es[s] == e);
                if (m) {
                    const int n = __popcll(m), first = __ffsll((long long)m) - 1;
                    unsigned base = 0;
                    if (lane == first) base = __hip_atomic_fetch_add(fill + 64 * e, (unsigned)n, __ATOMIC_RELAXED, __HIP_MEMORY_SCOPE_AGENT);
                    base = __shfl(base, first);
                    const int rank = __popcll(m & ((1ull << lane) - 1ull));
                    if (es[s] == e) pos[s] = M.pb[e] * 256 + (int)base + rank;
                }
            }
        }
        if (act) *(int2*)(P.ws + WS_TOKPOS + (size_t)tok * 8) = make_int2(pos[0], pos[1]);
#pragma unroll 1
        for (int i0 = 0; i0 < 16; i0 += 4) {
            v4u a[4], b[4]; int d0[4], d1[4];
#pragma unroll
            for (int i = 0; i < 4; ++i) { const int t = it * 16 + i0 + i; d0[i] = __shfl(pos[0], i0 + i); d1[i] = __shfl(pos[1], i0 + i);
                a[i] = *(const v4u*)(H + (size_t)t * D + 8 * lane); b[i] = *(const v4u*)(H + (size_t)t * D + 512 + 8 * lane); }
#pragma unroll
            for (int i = 0; i < 4; ++i) {
                *(v4u*)(XG + (size_t)d0[i] * D + 8 * lane) = a[i]; *(v4u*)(XG + (size_t)d0[i] * D + 512 + 8 * lane) = b[i];
                *(v4u*)(XG + (size_t)d1[i] * D + 8 * lane) = a[i]; *(v4u*)(XG + (size_t)d1[i] * D + 512 + 8 * lane) = b[i]; }
        }
    }
#pragma unroll
    for (int e = 0; e < NE; ++e) {
        const int r0 = M.pb[e] * 256 + cnt[e], r1 = M.pb[e + 1] * 256;
        for (int r = r0 + gw; r < r1; r += NGW) { *(v4u*)(XG + (size_t)r * D + 8 * lane) = (v4u){0u, 0u, 0u, 0u}; *(v4u*)(XG + (size_t)r * D + 512 + 8 * lane) = (v4u){0u, 0u, 0u, 0u}; }
    }
}

__device__ __forceinline__ Frame make_frame(LAS unsigned char* lds, int wave0) {
    Frame F; int tid = wave0 * 64 + (int)__builtin_amdgcn_mbcnt_hi(~0u, __builtin_amdgcn_mbcnt_lo(~0u, 0u)), G = gridDim.x, bx = blockIdx.x;
    asm volatile("" : "+v"(tid)); asm volatile("" : "+s"(G)); asm volatile("" : "+s"(bx));
    F.lds = lds; F.tid = tid; F.lane = tid & 63; F.wave = __builtin_amdgcn_readfirstlane(tid >> 6); F.G = G; F.bx = bx; return F;
}
#define CAS __attribute__((address_space(4)))
#define WSQ(T, off) ((T*)(Q.ws + (off)))
#if defined(__HIP_DEVICE_COMPILE__)
__device__ __forceinline__ Params load_params() { const CAS void* p = (const CAS void*)__builtin_amdgcn_kernarg_segment_ptr(); asm volatile("" : "+s"(p)); return *(const CAS Params*)p; }
#else
__device__ __forceinline__ Params load_params() { return Params{}; }
#endif
#ifndef PG8_SP2
#define PG8_SP2 true
#endif
#ifndef PG8_ALIGN
#define PG8_ALIGN true
#endif
#ifndef REP_MASK
#define REP_MASK 0
#endif
#define NREP(k) (1 + (((REP_MASK) >> (k)) & 1))
#ifdef PHMASK
#define IN(k) (((PHMASK) >> (k)) & 1)
#else
#define IN(k) (lo <= (k) && (k) < hi)
#endif
#define GRID_BARRIER() do { XcdBarrier b_ = bar; asm volatile("" : "+s"(b_.bar)); xcd_barrier(b_); } while (0)
#define SEAM(k) do { if (IN(k) && IN((k) + 1)) GRID_BARRIER(); } while (0)

__device__ __forceinline__ int tail_busy(int nwg, int G) {
#ifdef KEEP_SEAMS
    return 0;
#endif
    const int R = nwg / G, T = nwg - R * G; return (R >= 1 && 2 * T <= G) ? T : 0; }
#define PCNT(base) (WSQ(unsigned, WS_CTL) + CW_PCNT + (base))
#ifndef DOWN_SPLIT
#define DOWN_SPLIT 4
#endif
#ifndef MOE_SPLIT
#define MOE_SPLIT 4
#endif
#ifndef EXCL_WOUT0
#define EXCL_WOUT0 144
#endif
#ifndef EXCL_DOWN
#define EXCL_DOWN 68
#endif
#ifndef EXCL_MOE
#define EXCL_MOE 110
#endif
struct MoeTail { int p0, np, S, nfull, tp; size_t part_off; };
__device__ __forceinline__ MoeTail moe_tail(int ptot, int cap, int gq, int G) {
    int p0 = 0, np = 0;
    while (p0 < ptot) { np = ptot - p0; if (np > cap) np = gq; if (np <= 0 || p0 + np >= ptot) break; p0 += np; }
    pg8::SplitOrder T; T.np = np; T.nct = D / 256; T.G = G; T.init_split(MOE_SPLIT);
    MoeTail r; r.p0 = p0; r.np = np; r.S = T.S; r.nfull = T.nfull; r.tp = T.tail_panels(); r.part_off = WS_ACTM + (size_t)np * 256 * DFE * 2;
    if (r.S > 1 && r.part_off + (size_t)r.S * r.tp * 256 * D * 4 > WS_NEED) { r.S = 1; r.nfull = np * (D / 256); r.tp = 0; }
    return r;
}
#ifdef PROD_OLD
#define PNEED 0u
#else
#define PNEED 32u
#endif
#ifdef TPROBE
#ifndef TPROBE_BLK
#define TPROBE_BLK 0
#endif
#ifndef TPROBE_SCALE
#define TPROBE_SCALE 10
#endif
#define TP_BEGIN(k) do { if ((k) == TPROBE && (int)blockIdx.x == (TPROBE_BLK) && wave0 == 0) { __syncthreads_dummy(); MISC[41] = (unsigned)__builtin_amdgcn_s_memrealtime(); } } while (0)
#define TP_END(k) do { if ((k) == TPROBE && (int)blockIdx.x == (TPROBE_BLK) && wave0 == 0) { MISC[40] += (unsigned)__builtin_amdgcn_s_memrealtime() - MISC[41]; } } while (0)
__device__ __forceinline__ void __syncthreads_dummy() {}
#else
#define TP_BEGIN(k) do {} while (0)
#define TP_END(k) do {} while (0)
#endif
template <int l>
__device__ __forceinline__ void layer_phases(const XcdBarrier& bar, LAS unsigned char* const lds0, volatile LAS unsigned* MISC, const int lo, const int hi, const int wave0) {
        const int pb = 1 + 8 * l;
        for (int rep_ = 0; rep_ < NREP(pb + 1); ++rep_) { if (rep_) GRID_BARRIER();
        if (IN(pb + 1)) {
            const Params Q = load_params(); const Frame F = make_frame(lds0, wave0);
            pg8::Gemm g{WSQ(bf16, WS_H), WSQ(bf16, WS_WIN) + (size_t)l * NZ * D, MT, NZ, D}; pg8::StaticOrder S; S.init(MT, NZ, F.G, F.bx);
            pg8::EpiBf16<0> E{WSQ(bf16, WS_Z), NZ, nullptr, 0, 0, 1.f};
            TP_BEGIN(100 + pb + 1);
            pg8::gemm_phase<pg8::EpiBf16<0>, pg8::StaticOrder, PG8_ALIGN, PG8_SP2>(F.lds, g, S, E, F.wave);
            TP_END(100 + pb + 1);
        } }
        SEAM(pb + 1);
        for (int rep_ = 0; rep_ < NREP(pb + 2); ++rep_) { if (rep_) GRID_BARRIER();
        if (IN(pb + 2)) {
            const Params Q = load_params(); const Frame F = make_frame(lds0, wave0); TP_BEGIN(100 + pb + 2);
#ifdef FORCE_SOLO
            const bool paired = false;
#else
            const bool paired = F.G >= 256;
#endif
            const int nsb = F.G > 128 ? 128 : 0;
#ifndef NO_SCAN
#ifdef SCAN_PIPE
            (void)paired;
            if (F.bx < nsb || nsb == 0) { const int st = nsb ? nsb : F.G; for (int u = F.bx; u < 128; u += st) scan_unit_pipe(Q, F, l, u >> 4, (u >> 1) & 7, u & 1); }
#else
            if (paired) { if (F.bx < 128) scan_unit(Q, F, l, F.bx >> 4, (F.bx >> 1) & 7, F.bx & 1, 0); else if (F.bx < 256) { const int u = F.bx - 128; scan_unit(Q, F, l, u >> 4, (u >> 1) & 7, u & 1, 1); } }
            else if (F.bx < nsb || nsb == 0) { const int st = nsb ? nsb : F.G; for (int u = F.bx; u < 128; u += st) scan_unit(Q, F, l, u >> 4, (u >> 1) & 7, u & 1, 2); }
#endif
#endif
#ifdef PROBE_CF2
            for (int prb_ = 0; prb_ < 2; ++prb_)
#endif
            if (F.bx >= nsb) {
                const int ob = F.bx - nsb, nob = F.G - nsb;
#ifndef NO_CONV
                conv_items(Q, F, l, l == 0 ? MT : NT, ob, nob);
#endif
#ifndef NO_FA
#ifdef PROBE_FA2
                for (int prb_ = 0; prb_ < 2; ++prb_)
#endif
                for (int it = ob; it < 256; it += nob) fourier_a_iter(Q, F, it);
#endif
#ifndef NO_FC
                if (l == 0) for (int u = ob; u < 32; u += nob) fourier_ctx_unit(Q, F, u);
#endif
            }
            TP_END(100 + pb + 2);
        } }
        SEAM(pb + 2);
        for (int rep_ = 0; rep_ < NREP(pb + 3); ++rep_) { if (rep_) GRID_BARRIER();
        if (IN(pb + 3)) {
            const Params Q = load_params(); const Frame F = make_frame(lds0, wave0);
            TP_BEGIN(100 + pb + 3); TP_BEGIN(200 + l);
            LAS bf16* TC64 = (LAS bf16*)F.lds; LAS bf16* TS64 = TC64 + 64 * TP;
            load_tab64(TC64, WSQ(bf16, TAB_C64), F.tid); load_tab64(TS64, WSQ(bf16, TAB_S64), F.tid);
            __syncthreads();
#ifndef NO_FB
#ifdef PROBE_FB2
            for (int prb_ = 0; prb_ < 2; ++prb_)
#endif
            for (int u = F.bx * NWAVES + F.wave; u < 2048; u += F.G * NWAVES) fourier_b_unit(Q, F, u, TC64, TS64);
#endif
            __syncthreads(); TP_END(200 + l);
#ifndef NO_FIN
            finalize_phase(Q, F, l, l == 0 ? MT : NT);
#endif
            TP_END(100 + pb + 3);
        } }
        SEAM(pb + 3);
        for (int rep_ = 0; rep_ < NREP(pb + 4); ++rep_) { if (rep_) GRID_BARRIER();
        if (IN(pb + 4)) {
            const Params Q = load_params(); const Frame F = make_frame(lds0, wave0);
            const int M = l == 0 ? MT : NT;
#ifdef PROD_OLD
            pg8::Gemm g{WSQ(bf16, WS_H), WSQ(bf16, WS_WOUT) + (size_t)l * D * D, M, D, D}; pg8::StaticOrder S; S.init(M, D, F.G, F.bx);
            pg8::EpiBf16<0> E{WSQ(bf16, WS_O32), D, nullptr, 0, 0, 1.f};
            pg8::gemm_phase<pg8::EpiBf16<0>, pg8::StaticOrder, PG8_ALIGN, PG8_SP2>(F.lds, g, S, E, F.wave);
#else
            pg8::Gemm g{WSQ(bf16, WS_H), WSQ(bf16, WS_WOUT) + (size_t)l * D * D, M, D, D}; pg8::PubOrder<pg8::StaticOrder> S; S.init(M, D, F.G, F.bx); S.cntr = PCNT(l == 0 ? PC_WOUT0 : PC_WOUT1); S.pend = -1;
            pg8::EpiBf16WT E{WSQ(bf16, WS_O32), D, 1 << 20};
            TP_BEGIN(l == 0 ? 3 : 7);
            pg8::gemm_phase<pg8::EpiBf16WT, pg8::PubOrder<pg8::StaticOrder>, PG8_ALIGN, PG8_SP2>(F.lds, g, S, E, F.wave);
            TP_END(l == 0 ? 3 : 7);
#endif
        } }
#ifdef KEEP_SEAMS
        SEAM(pb + 4);
#endif
        if (l == 0) {
            if (IN(pb + 5)) { const Params Q = load_params(); const Frame F = make_frame(lds0, wave0); TP_BEGIN(4); phase_post<0, true, false, true>(Q, F, MT, 0, 2048, 1, Q.in[I_CTX], 0, 2, 4096, 3072, PCNT(PC_WOUT0), PNEED, tail_busy((MT / 256) * (D / 256), F.G), (int)((long)MT * EXCL_WOUT0 / 256)); TP_END(4); }
            SEAM(pb + 5);
            for (int rep_ = 0; rep_ < NREP(pb + 6); ++rep_) { if (rep_) GRID_BARRIER();
            if (IN(pb + 6)) {
            const Params Q = load_params(); const Frame F = make_frame(lds0, wave0);
                pg8::Gemm g{WSQ(bf16, WS_H), WSQ(bf16, WS_WGU), MT, 2 * DFF, D}; pg8::StaticOrder S; S.init(MT, 2 * DFF, F.G, F.bx);
                pg8::EpiSwiglu E{WSQ(bf16, WS_Z), DFF, 0, 1 << 20};
                TP_BEGIN(100 + pb + 6);
                pg8::gemm_phase<pg8::EpiSwiglu, pg8::StaticOrder, PG8_ALIGN, PG8_SP2>(F.lds, g, S, E, F.wave);
                TP_END(100 + pb + 6);
            } }
            SEAM(pb + 6);
            for (int rep_ = 0; rep_ < NREP(pb + 7); ++rep_) { if (rep_) GRID_BARRIER();
            if (IN(pb + 7)) {
            const Params Q = load_params(); const Frame F = make_frame(lds0, wave0);
#ifdef PROD_OLD
                pg8::Gemm g{WSQ(bf16, WS_Z), WSQ(bf16, WS_WDN), MT, D, DFF}; pg8::StaticOrder S; S.init(MT, D, F.G, F.bx);
                pg8::EpiBf16<0> E{WSQ(bf16, WS_O32), D, nullptr, 0, 0, 1.f};
                pg8::gemm_phase<pg8::EpiBf16<0>, pg8::StaticOrder, PG8_ALIGN, PG8_SP2>(F.lds, g, S, E, F.wave);
#else
                pg8::Gemm g{WSQ(bf16, WS_Z), WSQ(bf16, WS_WDN), MT, D, DFF};
                pg8::PubOrder<pg8::SplitOrder> S; S.p0 = 0; S.np = MT / 256; S.nct = D / 256; S.G = F.G; S.c = F.bx; S.pb[0] = 0;
#pragma unroll
                for (int j = 1; j < 9; ++j) S.pb[j] = 1 << 20;
                S.init_split(DOWN_SPLIT); S.cntr = PCNT(PC_DOWN0); S.pend = -1;
                pg8::EpiSplitWT E{WSQ(bf16, WS_O32), D, D / 256, WSQ(float, WS_PARTD), S.nfull / (D / 256), S.tail_panels() * 256};
                TP_BEGIN(1);
                pg8::gemm_phase<pg8::EpiSplitWT, pg8::PubOrder<pg8::SplitOrder>, PG8_ALIGN, PG8_SP2>(F.lds, g, S, E, F.wave);
                TP_END(1);
#endif
            } }
#ifdef KEEP_SEAMS
            SEAM(pb + 7);
#endif
            if (IN(pb + 8)) { const Params Q = load_params(); const Frame F = make_frame(lds0, wave0); pg8::SplitOrder T; T.np = MT / 256; T.nct = D / 256; T.G = F.G; T.init_split(DOWN_SPLIT); const bool sp = T.S > 1;
                TP_BEGIN(2); phase_post<0, true, false>(Q, F, MT, 0, 5120, 3, (const float*)(Q.ws + WS_XC), 1, 0, 1024, 0, PCNT(PC_DOWN0), PNEED, sp ? T.tail_panels() * T.nct * T.S : tail_busy(T.np * T.nct, F.G),
                    (int)((long)MT * (sp ? EXCL_DOWN : EXCL_WOUT0) / 256), WSQ(float, WS_PARTD), sp ? (T.nfull / T.nct) * 256 : 0x7fffffff, T.S, T.tail_panels() * 256); TP_END(2); }
            SEAM(pb + 8);
        } else {
            if (IN(pb + 5)) { const Params Q = load_params(); const Frame F = make_frame(lds0, wave0); TP_BEGIN(8); phase_post<0, true, true>(Q, F, NT, 1, 2048, 1, nullptr, 1, 2, 4096, 3072, PCNT(PC_WOUT1), PNEED, tail_busy((NT / 256) * (D / 256), F.G), 0); TP_END(8); }
            SEAM(pb + 5);
            if (IN(pb + 6)) { const Params Q = load_params(); const Frame F = make_frame(lds0, wave0); TP_BEGIN(220); for (int rep_ = 0; rep_ < NREP(15); ++rep_) convert_moe_weights(Q, F); TP_END(220); TP_BEGIN(221); moe_assign_gather(Q, F); TP_END(221); }
            SEAM(pb + 6);
            if (IN(pb + 7)) {
            const Params Q = load_params(); const Frame F = make_frame(lds0, wave0);
                if (F.tid == 0) { MoePlan M; int cnt[NE]; moe_plan(Q, M, cnt);
#pragma unroll
                    for (int j = 0; j < 9; ++j) MISC[16 + j] = (unsigned)M.pb[j]; }
                __syncthreads();
                const int ptot = (int)MISC[16 + 8], gq = (F.G >= 256 && Q.act_cap_panels >= 128) ? 128 : (Q.act_cap_panels < 64 ? Q.act_cap_panels : 64);
                const MoeTail mt = moe_tail(ptot, Q.act_cap_panels, gq, F.G);
                int p0 = 0;
                while (p0 < ptot) {
                    int np = ptot - p0; if (np > Q.act_cap_panels) np = gq;
                    if (np > 0) {
                        for (int rep_ = 0; rep_ < NREP(16); ++rep_) { if (rep_) GRID_BARRIER();
                            pg8::Gemm g{WSQ(bf16, WS_XG), WSQ(bf16, WS_WMGU), 0, 0, D};
                            pg8::MoeOrder S; S.p0 = p0; S.np = np; S.nct = 2 * DFE / 256; S.G = F.G; S.c = F.bx;
#pragma unroll
                            for (int j = 0; j < 9; ++j) S.pb[j] = (int)MISC[16 + j];
                            pg8::EpiSwiglu E{WSQ(bf16, WS_ACTM), DFE, p0, 2 * DFE / 256};
                            TP_BEGIN(222);
                            pg8::gemm_phase<pg8::EpiSwiglu, pg8::MoeOrder, PG8_ALIGN, PG8_SP2>(F.lds, g, S, E, F.wave);
                            TP_END(222);
                        }
                        GRID_BARRIER();
                        for (int rep_ = 0; rep_ < NREP(17); ++rep_) { if (rep_) GRID_BARRIER();
                            pg8::Gemm g{WSQ(bf16, WS_ACTM) - (size_t)p0 * 256 * DFE, WSQ(bf16, WS_WMDN), 0, 0, DFE};
#ifdef PROD_OLD
                            pg8::MoeOrder S; S.p0 = p0; S.np = np; S.nct = D / 256; S.G = F.G; S.c = F.bx;
#pragma unroll
                            for (int j = 0; j < 9; ++j) S.pb[j] = (int)MISC[16 + j];
                            pg8::EpiBf16Mod E{WSQ(bf16, WS_XG), D, D / 256};
                            pg8::gemm_phase<pg8::EpiBf16Mod, pg8::MoeOrder, PG8_ALIGN, PG8_SP2>(F.lds, g, S, E, F.wave);
#else
                            pg8::PubOrder<pg8::SplitOrder> S; S.p0 = p0; S.np = np; S.nct = D / 256; S.G = F.G; S.c = F.bx; S.cntr = PCNT(PC_MOE); S.pend = -1;
#pragma unroll
                            for (int j = 0; j < 9; ++j) S.pb[j] = (int)MISC[16 + j];
                            S.init_split(p0 == mt.p0 ? mt.S : 1);
                            pg8::EpiSplitWT E{WSQ(bf16, WS_XG), D, D / 256, (float*)(Q.ws + mt.part_off), p0 + S.nfull / (D / 256), S.tail_panels() * 256};
                            TP_BEGIN(5);
                            pg8::gemm_phase<pg8::EpiSplitWT, pg8::PubOrder<pg8::SplitOrder>, PG8_ALIGN, PG8_SP2>(F.lds, g, S, E, F.wave);
                            TP_END(5);
#endif
                        }
#ifdef KEEP_SEAMS
                        GRID_BARRIER();
#else
                        if (p0 + np < ptot) GRID_BARRIER();
#endif
                    }
                    p0 += np;
                }
            }
            if (IN(pb + 8)) { const Params Q = load_params(); const Frame F = make_frame(lds0, wave0);
                MoePlan M; int cnt[NE]; moe_plan(Q, M, cnt);
                const int ptot = M.pb[8], gq = (F.G >= 256 && Q.act_cap_panels >= 128) ? 128 : (Q.act_cap_panels < 64 ? Q.act_cap_panels : 64);
                const MoeTail mt = moe_tail(ptot, Q.act_cap_panels, gq, F.G); const bool sp = mt.S > 1;
                TP_BEGIN(6); phase_post<1, false, false>(Q, F, NT, 1, 5120, 3, nullptr, 1, 0, 0, 0, PCNT(PC_MOE), PNEED, sp ? mt.tp * (D / 256) * mt.S : tail_busy(mt.np * (D / 256), F.G),
                    (int)((long)NT * (sp ? EXCL_MOE : 200) / 256), (const float*)(Q.ws + mt.part_off), sp ? (mt.p0 + mt.nfull / (D / 256)) * 256 : 0x7fffffff, mt.S, mt.tp * 256); TP_END(6); }
        }
    }
constexpr int N_PHASES = 18;
__global__ void __launch_bounds__(NTHR, 2) fwd_kernel(Params P) {
    extern __shared__ __attribute__((aligned(16))) unsigned char lds_raw[];
    LAS unsigned char* const lds0 = (LAS unsigned char*)lds_raw;
    volatile LAS unsigned* MISC = (volatile LAS unsigned*)(lds0 + MISC_OFF);
    const int wave0 = __builtin_amdgcn_readfirstlane((int)threadIdx.x >> 6);
    if (wave0 == 0) MISC[__builtin_amdgcn_mbcnt_hi(~0u, __builtin_amdgcn_mbcnt_lo(~0u, 0u))] = 0u;
    __syncthreads();
    unsigned* ctl = (unsigned*)(P.ws + WS_CTL);
    XcdBarrier bar = xcd_barrier_post(ctl + CW_BAR + P.li * XCD_BAR_WORDS, MISC + 8, wave0 == 0 ? 1u : 0u);
    const int lo = P.ph_lo, hi = P.ph_hi;
    for (int rep_ = 0; rep_ < NREP(0); ++rep_) { if (rep_) GRID_BARRIER(); if (IN(0)) { const Params Q = load_params(); const Frame F = make_frame(lds0, wave0); TP_BEGIN(210); p0_adaln(Q, F); TP_END(210); TP_BEGIN(211); p0_small_weights(Q, F); TP_END(211); TP_BEGIN(212); p0_tables(Q, F); TP_END(212); } }
    SEAM(0);
#ifdef PROBE_FN_NOSTORE
    for (int rep_ = 0; rep_ < 2; ++rep_) { if (rep_) GRID_BARRIER(); if (IN(1)) { const Params Q = load_params(); const Frame F = make_frame(lds0, wave0); phase_first_norm(Q, F); } }
#else
    for (int rep_ = 0; rep_ < NREP(1); ++rep_) { if (rep_) GRID_BARRIER(); if (IN(1)) { const Params Q = load_params(); const Frame F = make_frame(lds0, wave0); TP_BEGIN(101); phase_first_norm(Q, F); TP_END(101); } }
#endif
    SEAM(1);
#ifdef PROBE_BAR
    for (int prb_ = 0; prb_ < 20; ++prb_) GRID_BARRIER();
#endif
    layer_phases<0>(bar, lds0, MISC, lo, hi, wave0);
    layer_phases<1>(bar, lds0, MISC, lo, hi, wave0);
#ifdef TPROBE
    if ((int)blockIdx.x == (TPROBE_BLK) && wave0 == 0) { const unsigned long long t0 = __builtin_amdgcn_s_memrealtime(), dt = (unsigned long long)MISC[40] * (TPROBE_SCALE);
        while (__builtin_amdgcn_s_memrealtime() - t0 < dt) __builtin_amdgcn_s_sleep(8); }
#endif
#undef IN
#undef SEAM
}

#ifndef MK_PER_PHASE
#define MK_PER_PHASE 0
#endif
extern "C" void kernel_launch(void* const* d_in, const int* in_sizes, int n_in, void* d_out, int out_size, void* d_ws, size_t ws_size, hipStream_t stream) {
    static int grid = 0;
    if (grid == 0) {
        if (n_in != N_IN || in_sizes[0] != NT * D || out_size != NT * D || ws_size < WS_NEED) {
            fprintf(stderr, "kernel_launch: unexpected shapes (n_in %d, in0 %d, out %d, ws %zu); nothing launched\n", n_in, n_in > 0 ? in_sizes[0] : -1, out_size, ws_size); grid = -1; return; }
        int dev = 0, cus = 0, per_cu = 0;
        if (hipGetDevice(&dev) != hipSuccess || hipDeviceGetAttribute(&cus, hipDeviceAttributeMultiprocessorCount, dev) != hipSuccess) { grid = -1; return; }
        if (hipFuncSetAttribute((const void*)fwd_kernel, hipFuncAttributeMaxDynamicSharedMemorySize, LDS_BYTES) != hipSuccess) { fprintf(stderr, "kernel_launch: hipFuncSetAttribute failed\n"); grid = -1; return; }
        if (hipOccupancyMaxActiveBlocksPerMultiprocessor(&per_cu, (const void*)fwd_kernel, NTHR, LDS_BYTES) != hipSuccess || per_cu < 1)
            fprintf(stderr, "kernel_launch: occupancy query reports %d workgroups per CU\n", per_cu);
        (void)hipGetLastError();
        grid = cus;
    }
    if (grid < 0) return;
    if (hipMemsetAsync((char*)d_ws + WS_CTL, 0, CTL_ZERO_BYTES, stream) != hipSuccess) return;
    Params p{};
    for (int i = 0; i < N_IN; ++i) p.in[i] = (const float*)d_in[i];
    p.out = (float*)d_out; p.ws = (unsigned char*)d_ws;
    { size_t avail = ws_size - WS_ACTM; size_t cap = avail / ((size_t)256 * DFE * 2); if (cap > 264) cap = 264; p.act_cap_panels = (int)cap; }
#if MK_PER_PHASE
    int li = 0;
    for (int ph = 0; ph < N_PHASES; ++ph) {
        p.ph_lo = ph; p.ph_hi = ph + 1; p.li = li++;
        hipLaunchKernelGGL(fwd_kernel, dim3(grid), dim3(NTHR), LDS_BYTES, stream, p);
    }
#else
    p.ph_lo = 0; p.ph_hi = N_PHASES; p.li = 0;
    hipLaunchKernelGGL(fwd_kernel, dim3(grid), dim3(NTHR), LDS_BYTES, stream, p);
#endif
}
```

```cpp
#include <hip/hip_runtime.h>
#include <cstdio>
#include <cstdint>
namespace pg8 {
#define PG8_LAS __attribute__((address_space(3)))
typedef unsigned short bf16_t;
typedef short bf16x8 __attribute__((ext_vector_type(8)));
typedef float f32x4 __attribute__((ext_vector_type(4)));
typedef unsigned u32x4 __attribute__((ext_vector_type(4)));
constexpr int BM = 256, BK = 64, HALF = 128, HTB = HALF * BK * 2  , STAGE_BYTES = 8 * HTB, NXCD = 8, WGM = 8;

__host__ __device__ __forceinline__ int lds_byte(int r, int c) { const int st = (r >> 4) * 2 + (c >> 5), rr = r & 15, cc = c & 31, ob = rr * 64 + cc * 2; return st * 1024 + (ob ^ (((ob >> 9) & 1) << 5)); }
__host__ __device__ __forceinline__ void stage_rc(int b, int& R, int& C) { const int st = b / 1024, sb = b % 1024, swz = sb ^ (((sb >> 9) & 1) << 5); R = (st >> 1) * 16 + swz / 64; C = (st & 1) * 32 + (swz % 64) / 2; }
__host__ __device__ __forceinline__ int perm32(int rho) { const int n = rho >> 4, i = rho & 15; return 8 * (i >> 2) + 4 * n + (i & 3); }

struct Unit { int pm, pn; };
struct Gemm { const bf16_t* A; const bf16_t* Bt; int M, N, K; };

struct StaticOrder {
    static constexpr bool SPLITK = false;
    int nM, nN, nwg, G, c;
    __host__ __device__ void init(int M, int N, int G_, int c_) { nM = M / BM; nN = N / BM; nwg = nM * nN; G = G_; c = c_; }
    __host__ __device__ bool next(int i, Unit& u) const {
        const long L = (long)i * G + c; if (L >= nwg) return false;
        int wgid = (int)L; { const int q = nwg / NXCD, r = nwg % NXCD, xcd = wgid % NXCD, off = wgid / NXCD; wgid = (xcd < r ? xcd * (q + 1) : r * (q + 1) + (xcd - r) * q) + off; }
        const int nig = WGM * nN, gid = wgid / nig, fm = gid * WGM, gsz = (nM - fm) < WGM ? (nM - fm) : WGM;
        u.pm = fm + ((wgid % nig) % gsz); u.pn = (wgid % nig) / gsz; return true;
    }
    __device__ __forceinline__ void a_ready(const Unit&) const {}
    __device__ __forceinline__ void done(const Unit&) const {}
    __device__ __forceinline__ void flush() const {}
};

__device__ __forceinline__ unsigned cvt_pk_bf16(float lo, float hi) { unsigned r; asm volatile("v_cvt_pk_bf16_f32 %0, %1, %2" : "=v"(r) : "v"(lo), "v"(hi)); return r; }
typedef float f32x2 __attribute__((ext_vector_type(2)));
__device__ __forceinline__ f32x2 gelu_pk(f32x2 v) {
    const f32x2 av = __builtin_elementwise_abs(v), d = av * 0.2316418882f + 1.0f;
    f32x2 t; t.x = __builtin_amdgcn_rcpf(d.x); t.y = __builtin_amdgcn_rcpf(d.y);
    f32x2 q = t * 0.5307027145f + (-0.7265760135f); q = q * t + 0.7107068705f; q = q * t + (-0.142248368f); q = q * t + 0.127414796f; q = q * t;
    const f32x2 s = (v * v) * (-0.72134752044f);
    f32x2 e; e.x = __builtin_amdgcn_exp2f(s.x); e.y = __builtin_amdgcn_exp2f(s.y);
    const f32x2 m = v * (q * e), r = v - m;
    f32x2 o; o.x = v.x < 0.f ? m.x : r.x; o.y = v.y < 0.f ? m.y : r.y; return o;
}

template <int ACT  > struct EpiBf16 {
    static constexpr bool PERM = true, AFTER_DRAIN = false; static_assert(ACT == 0 || ACT == 1, "EpiBf16: ACT is 0 (none) or 1 (gelu_pk)");
    bf16_t* O; int ldc; const float* bias; int split_cols; size_t split_stride; float scale0;
    __device__ __forceinline__ void operator()(const f32x4 (&acc)[2][2][4][2], const Unit& u, int wr, int wc, int fr, int fq) const {
        const int row0 = u.pm * BM + wr * 64 + fr; int colt = u.pn * BM; bf16_t* base = O;
        float sc = 1.f; if (split_cols) { const int t = colt / split_cols; base += (size_t)t * split_stride; colt -= t * split_cols; if (t == 0) sc = scale0; }
        const int col0 = colt + wc * 32 + 8 * fq, bcol0 = u.pn * BM + wc * 32 + 8 * fq;
        f32x4 bv[2][2];
#pragma unroll
        for (int bj = 0; bj < 2; ++bj)
#pragma unroll
            for (int n = 0; n < 2; ++n) bv[bj][n] = bias ? *(const f32x4*)(bias + bcol0 + bj * HALF + 4 * n) : (f32x4){0.f, 0.f, 0.f, 0.f};
#pragma unroll
        for (int ai = 0; ai < 2; ++ai)
#pragma unroll
            for (int m = 0; m < 4; ++m) { bf16_t* rowp = base + (size_t)(row0 + ai * HALF + m * 16) * ldc + col0;
#pragma unroll
                for (int bj = 0; bj < 2; ++bj) { f32x4 v0 = acc[ai][bj][m][0] + bv[bj][0], v1 = acc[ai][bj][m][1] + bv[bj][1];
                    if (ACT == 1) { f32x2 a = gelu_pk((f32x2){v0[0], v0[1]}), b = gelu_pk((f32x2){v0[2], v0[3]}), c = gelu_pk((f32x2){v1[0], v1[1]}), d = gelu_pk((f32x2){v1[2], v1[3]});
                        v0 = (f32x4){a.x, a.y, b.x, b.y}; v1 = (f32x4){c.x, c.y, d.x, d.y}; }
                    v0 = v0 * sc; v1 = v1 * sc; u32x4 w; w.x = cvt_pk_bf16(v0[0], v0[1]); w.y = cvt_pk_bf16(v0[2], v0[3]); w.z = cvt_pk_bf16(v1[0], v1[1]); w.w = cvt_pk_bf16(v1[2], v1[3]);
                    *(u32x4*)(rowp + bj * HALF) = w; } }
    }
};

struct EpiF32 {
    static constexpr bool PERM = false, AFTER_DRAIN = false;
    float* C; int ldc; const float* bias;
    __device__ __forceinline__ void operator()(const f32x4 (&acc)[2][2][4][2], const Unit& u, int wr, int wc, int fr, int fq) const {
        const int row0 = u.pm * BM + wr * 64 + fr, col0 = u.pn * BM + wc * 32 + 4 * fq;
        f32x4 bv[2][2];
#pragma unroll
        for (int bj = 0; bj < 2; ++bj)
#pragma unroll
            for (int n = 0; n < 2; ++n) bv[bj][n] = bias ? *(const f32x4*)(bias + col0 + bj * HALF + n * 16) : (f32x4){0.f, 0.f, 0.f, 0.f};
#pragma unroll
        for (int ai = 0; ai < 2; ++ai)
#pragma unroll
            for (int m = 0; m < 4; ++m) { float* rowp = C + (size_t)(row0 + ai * HALF + m * 16) * ldc + col0;
#pragma unroll
                for (int bj = 0; bj < 2; ++bj)
#pragma unroll
                    for (int n = 0; n < 2; ++n) *(f32x4*)(rowp + bj * HALF + n * 16) = acc[ai][bj][m][n] + bv[bj][n]; }
    }
};
template <class Epi, class Sched, bool ALIGN_EPI = false, bool SP2 = false>
__device__ __forceinline__ void gemm_phase(PG8_LAS unsigned char* lds, const Gemm g, const Sched& S, const Epi& E, const int wave_in) {
    int tid_ = wave_in * 64 + (int)__builtin_amdgcn_mbcnt_hi(~0u, __builtin_amdgcn_mbcnt_lo(~0u, 0u)); asm volatile("" : "+v"(tid_));
    const int tid = tid_, wid = __builtin_amdgcn_readfirstlane(tid >> 6), lane = tid & 63, wr = wid >> 2, wc = wid & 3, fr = lane & 15, fq = lane >> 4;
    const int K = g.K, nt = K / BK;
    unsigned voffA[2], voffB[2];
#pragma unroll
    for (int i = 0; i < 2; ++i) { int R, C; stage_rc(tid * 16 + i * 8192, R, C); const int Rb = Epi::PERM ? ((R & ~31) + perm32(R & 31)) : R;
        voffA[i] = (unsigned)(R * K + C) * 2u; voffB[i] = (unsigned)(Rb * K + C) * 2u; }
    const size_t kstep = (size_t)(BK * 2);
    const size_t hstep = (size_t)HALF * K * 2;
    const size_t tstep = 2 * hstep;
    const unsigned ldsw = (unsigned)wid * 1024u;
    const int aoff = lds_byte(wr * 64 + fr, fq * 8), boff = lds_byte(wc * 32 + fr, fq * 8);
#define PG8_SA(b, h) (((b) * 2 + (h)) * HTB)
#define PG8_SB(b, h) ((4 + (b) * 2 + (h)) * HTB)
#define PG8_STAGE(bufoff, gbase, voff) do { _Pragma("unroll") for (int _i = 0; _i < 2; ++_i) \
        __builtin_amdgcn_global_load_lds((const unsigned*)((const char*)(gbase) + (voff)[_i]), (PG8_LAS unsigned*)(lds + (bufoff) + ldsw + _i * 8192), 16, 0, 0); } while (0)
#define PG8_LDA(dst, b, h) do { _Pragma("unroll") for (int m = 0; m < 4; ++m) _Pragma("unroll") for (int k = 0; k < 2; ++k) dst[m][k] = *(const PG8_LAS bf16x8*)(lds + PG8_SA(b, h) + aoff + m * 2048 + k * 1024); } while (0)
#define PG8_LDB(dst, b, h) do { _Pragma("unroll") for (int n = 0; n < 2; ++n) _Pragma("unroll") for (int k = 0; k < 2; ++k) dst[n][k] = *(const PG8_LAS bf16x8*)(lds + PG8_SB(b, h) + boff + n * 2048 + k * 1024); } while (0)
#define PG8_MMA(ai, bj, At, Bt) do { __builtin_amdgcn_s_setprio(1); _Pragma("unroll") for (int m = 0; m < 4; ++m) _Pragma("unroll") for (int n = 0; n < 2; ++n) _Pragma("unroll") for (int k = 0; k < 2; ++k) \
        acc[ai][bj][m][n] = __builtin_amdgcn_mfma_f32_16x16x32_bf16(Bt[n][k], At[m][k], acc[ai][bj][m][n], 0, 0, 0); __builtin_amdgcn_s_setprio(0); } while (0)
#define PG8_WAIT_V(n) asm volatile("s_waitcnt vmcnt(" #n ")" ::: "memory")
#define PG8_WAIT_L(n) asm volatile("s_waitcnt lgkmcnt(" #n ")" ::: "memory")
#define PG8_BAR __builtin_amdgcn_s_barrier()
#define PG8_SCHED __builtin_amdgcn_sched_barrier(0)
    Unit cur, nxt; int ui = 0;
    if (!S.next(0, cur)) return;
    f32x4 acc[2][2][4][2];
#pragma unroll
    for (int a = 0; a < 2; ++a)
#pragma unroll
        for (int b = 0; b < 2; ++b)
#pragma unroll
            for (int m = 0; m < 4; ++m)
#pragma unroll
                for (int n = 0; n < 2; ++n) acc[a][b][m][n] = (f32x4){0.f, 0.f, 0.f, 0.f};
    bf16x8 At[4][2], B0[2][2], B1[2][2];
    const char* cA = (const char*)g.A + (size_t)cur.pm * tstep; const char* cB = (const char*)g.Bt + (size_t)cur.pn * tstep;
    int cnt = nt;
    if constexpr (Sched::SPLITK) { cnt = S.ktiles(cur, nt); cA += S.kbyte(cur, nt); cB = (const char*)g.Bt + (size_t)S.btile(cur) * tstep + S.kbyte(cur, nt); }
    S.a_ready(cur);
    if constexpr (SP2) {
        PG8_STAGE(PG8_SB(0, 0), cB, voffB); PG8_STAGE(PG8_SB(0, 1), cB + hstep, voffB); PG8_STAGE(PG8_SA(0, 0), cA, voffA); PG8_STAGE(PG8_SA(0, 1), cA + hstep, voffA);
        if (wr == 1) PG8_BAR;
        PG8_WAIT_V(2); PG8_BAR;
        PG8_STAGE(PG8_SB(1, 0), cB + kstep, voffB); PG8_STAGE(PG8_SA(1, 0), cA + kstep, voffA); PG8_STAGE(PG8_SB(1, 1), cB + hstep + kstep, voffB);
        PG8_WAIT_V(6); PG8_BAR;
    } else {
        PG8_STAGE(PG8_SB(0, 0), cB, voffB); PG8_STAGE(PG8_SA(0, 0), cA, voffA); PG8_STAGE(PG8_SB(0, 1), cB + hstep, voffB); PG8_STAGE(PG8_SA(0, 1), cA + hstep, voffA);
        if (wr == 1) PG8_BAR;
        PG8_WAIT_V(4); PG8_BAR;
        PG8_STAGE(PG8_SB(1, 0), cB + kstep, voffB); PG8_STAGE(PG8_SA(1, 0), cA + kstep, voffA); PG8_STAGE(PG8_SB(1, 1), cB + hstep + kstep, voffB);
        PG8_WAIT_V(6); PG8_BAR;
    }
    for (;;) {
        const bool has_next = S.next(ui + 1, nxt);
        const char* nA = has_next ? (const char*)g.A + (size_t)nxt.pm * tstep : cA; const char* nB = has_next ? (const char*)g.Bt + (size_t)nxt.pn * tstep : cB;
        if constexpr (Sched::SPLITK) { if (has_next) { nA += S.kbyte(nxt, nt); nB = (const char*)g.Bt + (size_t)S.btile(nxt) * tstep + S.kbyte(nxt, nt); } }
        for (int t = 0; t < cnt; t += 2) {
            const bool last = (t == cnt - 2);
            const char* a1 = cA + (size_t)(t + 1) * kstep;
            const char* a2 = last ? nA : cA + (size_t)(t + 2) * kstep; const char* b2 = last ? nB : cB + (size_t)(t + 2) * kstep;
            const char* a3 = a2 + kstep; const char* b3 = b2 + kstep;
            if (last && has_next) S.a_ready(nxt);
            if constexpr (SP2) {
            PG8_LDB(B0, 0, 0); PG8_LDB(B1, 0, 1); PG8_SCHED; PG8_LDA(At, 0, 0); PG8_STAGE(PG8_SA(1, 1), a1 + hstep, voffA);
            PG8_WAIT_V(8); PG8_WAIT_L(0); PG8_BAR; PG8_MMA(0, 0, At, B0); PG8_MMA(0, 1, At, B1); PG8_BAR; PG8_SCHED;
            PG8_LDA(At, 0, 1); PG8_STAGE(PG8_SB(0, 0), b2, voffB); PG8_STAGE(PG8_SB(0, 1), b2 + hstep, voffB); PG8_STAGE(PG8_SA(0, 0), a2, voffA);
            PG8_WAIT_V(8); PG8_WAIT_L(0); PG8_BAR; PG8_MMA(1, 0, At, B0); PG8_MMA(1, 1, At, B1); PG8_BAR; PG8_SCHED;
            PG8_LDB(B0, 1, 0); PG8_LDB(B1, 1, 1); PG8_SCHED; PG8_LDA(At, 1, 0); PG8_STAGE(PG8_SA(0, 1), a2 + hstep, voffA);
            PG8_WAIT_V(8); PG8_WAIT_L(0); PG8_BAR; PG8_MMA(0, 0, At, B0); PG8_MMA(0, 1, At, B1); PG8_BAR; PG8_SCHED;
            PG8_LDA(At, 1, 1); PG8_STAGE(PG8_SB(1, 0), b3, voffB); PG8_STAGE(PG8_SB(1, 1), b3 + hstep, voffB); PG8_STAGE(PG8_SA(1, 0), a3, voffA);
            PG8_WAIT_V(8); PG8_WAIT_L(0); PG8_BAR; PG8_MMA(1, 0, At, B0); PG8_MMA(1, 1, At, B1); PG8_BAR; PG8_SCHED;
            } else {
            PG8_LDB(B0, 0, 0); PG8_SCHED; PG8_LDA(At, 0, 0); PG8_STAGE(PG8_SA(1, 1), a1 + hstep, voffA);
            PG8_WAIT_L(8); PG8_BAR; PG8_WAIT_L(0); PG8_MMA(0, 0, At, B0); PG8_BAR; PG8_SCHED;
            PG8_LDB(B1, 0, 1); PG8_STAGE(PG8_SB(0, 0), b2, voffB);
            PG8_BAR; PG8_WAIT_L(0); PG8_MMA(0, 1, At, B1); PG8_BAR;
            PG8_LDA(At, 0, 1); PG8_STAGE(PG8_SA(0, 0), a2, voffA);
            PG8_BAR; PG8_WAIT_L(0); PG8_MMA(1, 0, At, B0); PG8_BAR; PG8_SCHED;
            PG8_STAGE(PG8_SB(0, 1), b2 + hstep, voffB);
            PG8_WAIT_V(6); PG8_BAR; PG8_MMA(1, 1, At, B1); PG8_BAR;
            PG8_LDB(B0, 1, 0); PG8_SCHED; PG8_LDA(At, 1, 0); PG8_STAGE(PG8_SA(0, 1), a2 + hstep, voffA);
            PG8_WAIT_L(8); PG8_BAR; PG8_WAIT_L(0); PG8_MMA(0, 0, At, B0); PG8_BAR; PG8_SCHED;
            PG8_LDB(B1, 1, 1); PG8_STAGE(PG8_SB(1, 0), b3, voffB);
            PG8_BAR; PG8_WAIT_L(0); PG8_MMA(0, 1, At, B1); PG8_BAR;
            PG8_LDA(At, 1, 1); PG8_STAGE(PG8_SA(1, 0), a3, voffA);
            PG8_BAR; PG8_WAIT_L(0); PG8_MMA(1, 0, At, B0); PG8_BAR; PG8_SCHED;
            PG8_STAGE(PG8_SB(1, 1), b3 + hstep, voffB);
            PG8_WAIT_V(6); PG8_BAR; PG8_MMA(1, 1, At, B1); PG8_BAR;
            }
        }
        if constexpr (ALIGN_EPI) { if (wr == 0) PG8_BAR; }
        if constexpr (!Epi::AFTER_DRAIN) { E(acc, cur, wr, wc, fr, fq); S.done(cur); }
        if (!has_next) break;
#pragma unroll
        for (int a = 0; a < 2; ++a)
#pragma unroll
            for (int b = 0; b < 2; ++b)
#pragma unroll
                for (int m = 0; m < 4; ++m)
#pragma unroll
                    for (int n = 0; n < 2; ++n) acc[a][b][m][n] = (f32x4){0.f, 0.f, 0.f, 0.f};
        cur = nxt; cA = nA; cB = nB; ++ui;
        if constexpr (Sched::SPLITK) cnt = S.ktiles(cur, nt);
        if constexpr (ALIGN_EPI) { if (wr == 1) PG8_BAR; }
    }
    PG8_WAIT_V(0);
    S.flush();
    if constexpr (!ALIGN_EPI) { if (wr == 0) PG8_BAR; }
    PG8_BAR;
    if constexpr (Epi::AFTER_DRAIN) { E.fused(acc, cur, wr, wc, fr, fq, lds, wid, lane); S.done(cur); }
#undef PG8_SA
#undef PG8_SB
#undef PG8_STAGE
#undef PG8_LDA
#undef PG8_LDB
#undef PG8_MMA
#undef PG8_WAIT_V
#undef PG8_WAIT_L
#undef PG8_BAR
#undef PG8_SCHED
}
}

namespace pg8 {
struct EpiSwiglu {
    static constexpr bool PERM = true, AFTER_DRAIN = false;
    bf16_t* O; int ldo; int p0; int nct;
    __device__ __forceinline__ void operator()(const f32x4 (&acc)[2][2][4][2], const Unit& u, int wr, int wc, int fr, int fq) const {
        const int row0 = (u.pm - p0) * BM + wr * 64 + fr, col0 = (u.pn % nct) * HALF + wc * 32 + 8 * fq;
#pragma unroll
        for (int ai = 0; ai < 2; ++ai)
#pragma unroll
            for (int m = 0; m < 4; ++m) { bf16_t* rowp = O + (size_t)(row0 + ai * HALF + m * 16) * ldo + col0;
                float a[8];
#pragma unroll
                for (int n = 0; n < 2; ++n)
#pragma unroll
                    for (int j = 0; j < 4; ++j) { const float g = acc[ai][0][m][n][j], up = acc[ai][1][m][n][j]; a[n * 4 + j] = g * __builtin_amdgcn_rcpf(1.0f + __expf(-g)) * up; }
                u32x4 w; w.x = cvt_pk_bf16(a[0], a[1]); w.y = cvt_pk_bf16(a[2], a[3]); w.z = cvt_pk_bf16(a[4], a[5]); w.w = cvt_pk_bf16(a[6], a[7]);
                *(u32x4*)rowp = w; }
    }
};
struct EpiBf16Mod {
    static constexpr bool PERM = true, AFTER_DRAIN = false;
    bf16_t* O; int ldc; int nct;
    __device__ __forceinline__ void operator()(const f32x4 (&acc)[2][2][4][2], const Unit& u, int wr, int wc, int fr, int fq) const {
        const int row0 = u.pm * BM + wr * 64 + fr, col0 = (u.pn % nct) * BM + wc * 32 + 8 * fq;
#pragma unroll
        for (int ai = 0; ai < 2; ++ai)
#pragma unroll
            for (int m = 0; m < 4; ++m) { bf16_t* rowp = O + (size_t)(row0 + ai * HALF + m * 16) * ldc + col0;
#pragma unroll
                for (int bj = 0; bj < 2; ++bj) { const f32x4 v0 = acc[ai][bj][m][0], v1 = acc[ai][bj][m][1];
                    u32x4 w; w.x = cvt_pk_bf16(v0[0], v0[1]); w.y = cvt_pk_bf16(v0[2], v0[3]); w.z = cvt_pk_bf16(v1[0], v1[1]); w.w = cvt_pk_bf16(v1[2], v1[3]);
                    *(u32x4*)(rowp + bj * HALF) = w; } }
    }
};
struct MoeOrder {
    static constexpr bool SPLITK = false;
    int p0, np, nct, G, c; int pb[9];
    __device__ __forceinline__ bool next(int i, Unit& u) const {
        const int L = i * G + c; if (L >= np * nct) return false;
        const int nig = WGM * nct, gid = L / nig, fm = gid * WGM, gsz = (np - fm) < WGM ? (np - fm) : WGM, r = L % nig;
        const int pm = p0 + fm + (r % gsz), ct = r / gsz;
        int e = 0;
#pragma unroll
        for (int j = 1; j < 8; ++j) e += (pm >= pb[j]) ? 1 : 0;
        u.pm = pm; u.pn = e * nct + ct; return true;
    }
    __device__ __forceinline__ void a_ready(const Unit&) const {}
    __device__ __forceinline__ void done(const Unit&) const {}
    __device__ __forceinline__ void flush() const {}
};
#ifndef WT_AUX
#define WT_AUX 16
#endif
struct EpiBf16WT {
    static constexpr bool PERM = true, AFTER_DRAIN = false;
    bf16_t* O; int ldc; int nct;
    __device__ __forceinline__ void operator()(const f32x4 (&acc)[2][2][4][2], const Unit& u, int wr, int wc, int fr, int fq) const {
        const __amdgpu_buffer_rsrc_t rs = __builtin_amdgcn_make_buffer_rsrc(O, 0, 0x7ffffff0, 0x00020000);
        const unsigned row0 = (unsigned)(u.pm * BM + wr * 64 + fr), col0 = (unsigned)((u.pn % nct) * BM + wc * 32 + 8 * fq);
#pragma unroll
        for (int ai = 0; ai < 2; ++ai)
#pragma unroll
            for (int m = 0; m < 4; ++m) { const unsigned off = ((row0 + (unsigned)(ai * HALF + m * 16)) * (unsigned)ldc + col0) * 2u;
#pragma unroll
                for (int bj = 0; bj < 2; ++bj) { const f32x4 v0 = acc[ai][bj][m][0], v1 = acc[ai][bj][m][1];
                    u32x4 w; w.x = cvt_pk_bf16(v0[0], v0[1]); w.y = cvt_pk_bf16(v0[2], v0[3]); w.z = cvt_pk_bf16(v1[0], v1[1]); w.w = cvt_pk_bf16(v1[2], v1[3]);
                    __builtin_amdgcn_raw_buffer_store_b128(w, rs, off + (unsigned)(bj * HALF * 2), 0, WT_AUX); } }
    }
};
constexpr int SPLIT_FLAG = 1 << 14;
struct SplitOrder {
    static constexpr bool SPLITK = true;
    int p0, np, nct, G, c; int pb[9];
    int nfull, S;
    __device__ __forceinline__ void init_split(int S_) { const int nu = np * nct, R = nu / G, T = nu - R * G; if (S_ > 1 && R >= 1 && T > 0 && T * S_ <= G && (T % nct) == 0) { nfull = R * G; S = S_; } else { nfull = nu; S = 1; } }
    __device__ __forceinline__ int tail_panels() const { return (np * nct - nfull) / nct; }
    __device__ __forceinline__ bool next(int i, Unit& u) const {
        const int L = i * G + c; int pm, ct, ks = -1;
        if (L < nfull) { const int nig = WGM * nct, gid = L / nig, fm = gid * WGM, gsz = (np - fm) < WGM ? (np - fm) : WGM, r = L % nig; pm = p0 + fm + (r % gsz); ct = r / gsz; }
        else { if (S == 1) return false; const int j = L - nfull, tp = tail_panels(); if (j >= tp * nct * S) return false; const int rest = j / tp; pm = p0 + nfull / nct + (j % tp); ct = rest % nct; ks = rest / nct; }
        int e = 0;
#pragma unroll
        for (int j = 1; j < 8; ++j) e += (pm >= pb[j]) ? 1 : 0;
        u.pm = pm; u.pn = ks < 0 ? (e * nct + ct) : (SPLIT_FLAG | (ks << 6) | (e * nct + ct)); return true;
    }
    __device__ __forceinline__ int ktiles(const Unit& u, int nt) const { if (!(u.pn & SPLIT_FLAG)) return nt; const int ks = (u.pn >> 6) & 15, pairs = nt >> 1, q = pairs / S, r = pairs - q * S; return 2 * (q + (ks < r ? 1 : 0)); }
    __device__ __forceinline__ size_t kbyte(const Unit& u, int nt) const { if (!(u.pn & SPLIT_FLAG)) return 0; const int ks = (u.pn >> 6) & 15, pairs = nt >> 1, q = pairs / S, r = pairs - q * S; return (size_t)(ks * q + (ks < r ? ks : r)) * (2 * BK * 2); }
    __device__ __forceinline__ int btile(const Unit& u) const { return u.pn & 63; }
    __device__ __forceinline__ void a_ready(const Unit&) const {}
    __device__ __forceinline__ void done(const Unit&) const {}
    __device__ __forceinline__ void flush() const {}
};
struct EpiSplitWT {
    static constexpr bool PERM = true, AFTER_DRAIN = false;
    bf16_t* O; int ldc; int nct; float* part; int ptail0; int tail_rows;
    __device__ __forceinline__ void operator()(const f32x4 (&acc)[2][2][4][2], const Unit& u, int wr, int wc, int fr, int fq) const {
        const unsigned col0 = (unsigned)(((u.pn & 63) % nct) * BM + wc * 32 + 8 * fq);
        if (!(u.pn & SPLIT_FLAG)) {
            const __amdgpu_buffer_rsrc_t rs = __builtin_amdgcn_make_buffer_rsrc(O, 0, 0x7ffffff0, 0x00020000);
            const unsigned row0 = (unsigned)(u.pm * BM + wr * 64 + fr);
#pragma unroll
            for (int ai = 0; ai < 2; ++ai)
#pragma unroll
                for (int m = 0; m < 4; ++m) { const unsigned off = ((row0 + (unsigned)(ai * HALF + m * 16)) * (unsigned)ldc + col0) * 2u;
#pragma unroll
                    for (int bj = 0; bj < 2; ++bj) { const f32x4 v0 = acc[ai][bj][m][0], v1 = acc[ai][bj][m][1];
                        u32x4 w; w.x = cvt_pk_bf16(v0[0], v0[1]); w.y = cvt_pk_bf16(v0[2], v0[3]); w.z = cvt_pk_bf16(v1[0], v1[1]); w.w = cvt_pk_bf16(v1[2], v1[3]);
                        __builtin_amdgcn_raw_buffer_store_b128(w, rs, off + (unsigned)(bj * HALF * 2), 0, WT_AUX); } }
        } else {
            const __amdgpu_buffer_rsrc_t rs = __builtin_amdgcn_make_buffer_rsrc(part, 0, 0x7ffffff0, 0x00020000);
            const unsigned row0 = (unsigned)(((u.pn >> 6) & 15) * tail_rows + (u.pm - ptail0) * BM + wr * 64 + fr);
#pragma unroll
            for (int ai = 0; ai < 2; ++ai)
#pragma unroll
                for (int m = 0; m < 4; ++m) { const unsigned off = ((row0 + (unsigned)(ai * HALF + m * 16)) * (unsigned)ldc + col0) * 4u;
#pragma unroll
                    for (int bj = 0; bj < 2; ++bj) {
                        __builtin_amdgcn_raw_buffer_store_b128(__builtin_bit_cast(u32x4, acc[ai][bj][m][0]), rs, off + (unsigned)(bj * HALF * 4), 0, WT_AUX);
                        __builtin_amdgcn_raw_buffer_store_b128(__builtin_bit_cast(u32x4, acc[ai][bj][m][1]), rs, off + (unsigned)(bj * HALF * 4 + 16), 0, WT_AUX); } }
        }
    }
};
template <class Base> struct PubOrder : Base {
    unsigned* cntr; mutable int pend;
    __device__ __forceinline__ void pub() const {
        if (pend >= 0) { if (__builtin_amdgcn_mbcnt_hi(~0u, __builtin_amdgcn_mbcnt_lo(~0u, 0u)) == 0u) __hip_atomic_fetch_add(cntr + 16 * pend, 1u, __ATOMIC_RELAXED, __HIP_MEMORY_SCOPE_AGENT); pend = -1; }
    }
    __device__ __forceinline__ void a_ready(const Unit& u) const { Base::a_ready(u); pub(); }
    __device__ __forceinline__ void done(const Unit& u) const {
#ifdef PUB_EAGER
        asm volatile("s_waitcnt vmcnt(0)" ::: "memory"); pend = u.pm; pub();
#else
        pub(); pend = u.pm;
#endif
    }
    __device__ __forceinline__ void flush() const { pub(); }
};
}

constexpr int NWAVES = 8, NTHR = 512;
constexpr int D = 1024, NB = 8, SEQ = 4096, LC = 256, NT = NB * SEQ, NC = NB * LC, MT = NT + NC;
constexpr int DIN = 2944, NZ = 3072;
constexpr int C_K = 0, C_V = 512, C_WLO = 1024, C_ALO = 1152, C_R = 1280, C_GLO = 1792, C_U = 1920, C_GB = 2176, C_GC = 2432, C_F = 2688;
constexpr int DFF = 2816, NE = 8, DFE = 3584;
constexpr float NORM_EPS = 1e-6f, GN_EPS = 64e-5f;
constexpr int TP = 72;
enum { I_X = 0, I_C, I_CTX, I_CCTX, I_ADAW, I_ADAB, I_NORMG, I_WIN, I_WOUT, I_MU, I_MUW, I_MUA, I_W0, I_W2, I_A0, I_A2, I_G2, I_KK, I_KA, I_RK, I_GNW, I_GNB, I_CONVW,
       I_FG, I_FU, I_FD, I_RW, I_RB, I_MG, I_MUP, I_MD, N_IN };

constexpr size_t KiB = 1024, MiB = 1u << 20;
constexpr size_t WS_CTL = 0, CTL_ZERO_BYTES = 512 * KiB;
constexpr size_t WS_MOD = 512 * KiB;
constexpr size_t WS_TAB = 960 * KiB;
constexpr size_t TAB_E = WS_TAB;
constexpr size_t TAB_TWC = TAB_E + 64 * 512 * 4;
constexpr size_t TAB_TWS = TAB_TWC + 4096 * 4;
constexpr size_t TAB_C64 = TAB_TWS + 4096 * 4;
constexpr size_t TAB_S64 = TAB_C64 + 64 * 64 * 2;
constexpr size_t TAB_SN64 = TAB_S64 + 64 * 64 * 2;
constexpr size_t WS_ROUTE = 1152 * KiB;
constexpr size_t WS_TOKPOS = WS_ROUTE + (size_t)NT * 16;
static_assert(TAB_SN64 + 64 * 64 * 2 <= WS_ROUTE && WS_TOKPOS + (size_t)NT * 8 <= 2 * MiB, "low ws map");
constexpr size_t WS_Z = 2 * MiB;
constexpr size_t WS_SW = 206 * MiB;
constexpr size_t WS_WIN = WS_SW;
constexpr size_t WS_WOUT = WS_WIN + 2ull * NZ * D * 2;
constexpr size_t WS_WGU = WS_WOUT + 2ull * D * D * 2;
constexpr size_t WS_WDN = WS_WGU + 2ull * DFF * D * 2;
constexpr size_t WS_G2T = WS_WDN + (size_t)D * DFF * 2;
constexpr size_t WS_C256 = WS_G2T + 2ull * 512 * 128 * 2;
constexpr size_t WS_SN256 = WS_C256 + 256 * 256 * 2;
constexpr size_t WS_W2TG = WS_SN256 + 256 * 256 * 2;
constexpr size_t WS_A2TG = WS_W2TG + 4ull * 512 * 64 * 2;
constexpr size_t WS_XC = 244 * MiB;
static_assert(WS_A2TG + 4ull * 512 * 64 * 2 <= WS_XC, "small weights");
constexpr size_t WS_RING = 252 * MiB;
constexpr size_t WS_XB = 304 * MiB;
constexpr size_t WS_O32 = 381 * MiB;
constexpr size_t WS_YS = WS_O32;
constexpr size_t WS_YBUF = WS_YS + 2ull * MT * 512 * 2;
constexpr size_t WS_PARTD = WS_YBUF;
constexpr size_t WS_BONG = WS_YBUF + 32 * MiB;
constexpr size_t WS_H = 517 * MiB;
static_assert(WS_BONG + 2ull * MT * 8 * 4 <= WS_H && WS_Z + (size_t)MT * NZ * 2 <= WS_SW && WS_O32 + (size_t)MT * D * 4 <= WS_H, "ws map");
constexpr size_t WS_NEED = 585 * MiB;
static_assert(WS_XB + (size_t)MT * D * 2 <= WS_O32, "residual stream fits below the O buffer");
static_assert(WS_H + (size_t)MT * D * 2 <= WS_NEED, "ws map end");
constexpr size_t WS_WMGU = 2 * MiB;
constexpr size_t WS_WMDN = WS_WMGU + 8ull * 2 * DFE * D * 2;
constexpr size_t WS_XG = 170 * MiB;
constexpr int XG_ROWS_CAP = 69632;
constexpr size_t WS_ACTM = 306 * MiB;
static_assert(WS_WMDN + 8ull * D * DFE * 2 <= WS_XG && WS_XG + (size_t)XG_ROWS_CAP * D * 2 <= WS_ACTM, "moe ws map");
constexpr int CW_TMO = 0;
constexpr int CW_CNT = 2048, CW_FILL = 3072;
constexpr int CW_BAR = 8192;
constexpr int MAX_LAUNCHES = 20;
constexpr int CW_PROD = 81920, CW_CONS = 81920 + 8192;
constexpr int CW_PCNT = 114688;
constexpr int PC_WOUT0 = 0, PC_DOWN0 = 2176, PC_WOUT1 = 4352, PC_MOE = 6528;
static_assert(CW_CONS + 16384 + 64 * 128 <= CW_PCNT && (CW_PCNT + PC_MOE + 16 * 272) * 4 <= (int)CTL_ZERO_BYTES, "control words");

constexpr int LDS_BYTES = 163840;
constexpr int MISC_OFF = LDS_BYTES - 256;

#define GAS __attribute__((address_space(1)))
#define LAS __attribute__((address_space(3)))
typedef unsigned short bf16;
typedef unsigned v4u __attribute__((ext_vector_type(4)));
typedef unsigned v2u __attribute__((ext_vector_type(2)));
typedef float f32x4 __attribute__((ext_vector_type(4)));
typedef float f32x2 __attribute__((ext_vector_type(2)));
typedef short bf16x8 __attribute__((ext_vector_type(8)));
typedef short bf16x4 __attribute__((ext_vector_type(4)));
#define LDS_WAIT() asm volatile("s_waitcnt lgkmcnt(0)" ::: "memory")
typedef __bf16 bf16x2n __attribute__((ext_vector_type(2)));
__device__ __forceinline__ unsigned pk2(float lo, float hi) { const f32x2 v = {lo, hi}; return __builtin_bit_cast(unsigned, __builtin_convertvector(v, bf16x2n)); }
__device__ __forceinline__ unsigned f2bf(float f) { return pk2(f, f) & 0xffffu; }
__device__ __forceinline__ float bflo(unsigned w) { return __builtin_bit_cast(float, w << 16); }
__device__ __forceinline__ float bfhi(unsigned w) { return __builtin_bit_cast(float, w & 0xffff0000u); }
__device__ __forceinline__ float bf1(bf16 b) { return __builtin_bit_cast(float, (unsigned)b << 16); }
template <int CTRL> __device__ __forceinline__ float dpp_mov(float v) { return __builtin_bit_cast(float, __builtin_amdgcn_update_dpp(0, __builtin_bit_cast(int, v), CTRL, 0xf, 0xf, true)); }
__device__ __forceinline__ float wave_sum(float v) {
    v += dpp_mov<0xB1>(v); v += dpp_mov<0x4E>(v); v += dpp_mov<0x141>(v); v += dpp_mov<0x140>(v);
    const int b = __builtin_bit_cast(int, v);
    const float s0 = __builtin_bit_cast(float, __builtin_amdgcn_readlane(b, 0)), s1 = __builtin_bit_cast(float, __builtin_amdgcn_readlane(b, 16));
    const float s2 = __builtin_bit_cast(float, __builtin_amdgcn_readlane(b, 32)), s3 = __builtin_bit_cast(float, __builtin_amdgcn_readlane(b, 48));
    return (s0 + s1) + (s2 + s3);
}
__device__ __forceinline__ float sigmoidf_(float x) { return __builtin_amdgcn_rcpf(1.0f + __expf(-x)); }
#define MFMA16(a, b, c) __builtin_amdgcn_mfma_f32_16x16x32_bf16((a), (b), (c), 0, 0, 0)
#define XB_TMO      128
#define XB_XCNT(j)  (256  + 64 * (j))
#define XB_XSUB(j)  (1280 + 64 * (j))
#define XB_XGEN(j)  (2304 + 64 * (j))
#define XB_TOP      3328
#define XB_TOPGEN   3392
#define XCD_BAR_WORDS 3456
#define XB_SPIN_CAP (1u << 18)
#define LAS __attribute__((address_space(3)))

__device__ __forceinline__ unsigned xb_ld(unsigned* p)              { return __hip_atomic_load(p, __ATOMIC_RELAXED, __HIP_MEMORY_SCOPE_AGENT); }
__device__ __forceinline__ unsigned xb_add(unsigned* p, unsigned v) { return __hip_atomic_fetch_add(p, v, __ATOMIC_RELAXED, __HIP_MEMORY_SCOPE_AGENT); }
__device__ __forceinline__ unsigned xb_xcc_id() { return (unsigned)__builtin_amdgcn_s_getreg((3 << 11) | 20) & 0xFu; }
#define XB_SPIN(cond, bar) do { unsigned _sp = 0; while (cond) { __builtin_amdgcn_s_sleep(1); \
    if ((++_sp & 255u) == 0u) { if (xb_ld(&(bar)[XB_TMO])) break; if (_sp > XB_SPIN_CAP) { atomicAdd(&(bar)[XB_TMO], 1u); break; } } } } while (0)

struct XcdBarrier {
    unsigned w0;
    unsigned* bar; unsigned x;
    volatile LAS unsigned* st;
};

__device__ __forceinline__ bool xb_lane0() { return __builtin_amdgcn_mbcnt_hi(~0u, __builtin_amdgcn_mbcnt_lo(~0u, 0u)) == 0u; }
__device__ __forceinline__ XcdBarrier xcd_barrier_post(unsigned* bar, volatile LAS unsigned* st, unsigned w0) {
    XcdBarrier b; b.w0 = w0; b.bar = bar; b.x = xb_xcc_id(); b.st = st;
    if (w0 && xb_lane0()) (void)xb_add(&bar[XB_XCNT(b.x)], 1u);
    return b;
}
__device__ __forceinline__ void xcd_barrier_complete(unsigned* bar, unsigned x, unsigned& nloc, unsigned& nx) {
    const unsigned G = gridDim.x * gridDim.y * gridDim.z;
    unsigned sum, cnt, mine, sp = 0u;
    for (;;) {
        sum = 0u; cnt = 0u; mine = 0u;
#pragma unroll
        for (unsigned j = 0; j < 16; ++j) { const unsigned c = xb_ld(&bar[XB_XCNT(j)]); sum += c; cnt += (c > 0u) ? 1u : 0u; mine = (j == x) ? c : mine; }
        if (sum == G) break;
        __builtin_amdgcn_s_sleep(1);
        if ((++sp & 255u) == 0u) { if (xb_ld(&bar[XB_TMO])) break; if (sp > XB_SPIN_CAP) { atomicAdd(&bar[XB_TMO], 1u); break; } }
    }
    nloc = mine > 0u ? mine : 1u; nx = cnt > 0u ? cnt : 1u;
}

__device__ __forceinline__ void xcd_barrier(const XcdBarrier& b) {
    asm volatile("s_waitcnt vmcnt(0)" ::: "memory");
    __syncthreads();
    if (b.w0 && xb_lane0()) {
        unsigned* bar = b.bar;
        __builtin_amdgcn_s_waitcnt(0);
        unsigned nloc = b.st[0], nx = b.st[1];
        if (nloc == 0u) { xcd_barrier_complete(bar, b.x, nloc, nx); b.st[0] = nloc; b.st[1] = nx; }
        const unsigned old = xb_add(&bar[XB_XSUB(b.x)], 1u);
        const unsigned gen = old / nloc;
        if (old + 1u == (gen + 1u) * nloc) {
            __builtin_amdgcn_fence(__ATOMIC_RELEASE, "agent");
            asm volatile("s_waitcnt vmcnt(0)" ::: "memory");
            const unsigned og = xb_add(&bar[XB_TOP], 1u);
            const unsigned tg = og / nx;
            if (og + 1u == (tg + 1u) * nx) xb_add(&bar[XB_TOPGEN], 1u);
            else XB_SPIN(xb_ld(&bar[XB_TOPGEN]) == tg, bar);
            __builtin_amdgcn_fence(__ATOMIC_ACQUIRE, "agent");
            xb_add(&bar[XB_XGEN(b.x)], 1u);
            asm volatile("s_waitcnt vmcnt(0)" ::: "memory");
        } else {
            XB_SPIN(xb_ld(&bar[XB_XGEN(b.x)]) == gen, bar);
            __builtin_amdgcn_fence(__ATOMIC_ACQUIRE, "agent");
            asm volatile("s_waitcnt vmcnt(0)" ::: "memory");
        }
    }
    __syncthreads();
}


struct Params {
    const float* in[N_IN];
    float* out;
    unsigned char* ws;
    int act_cap_panels;
    int ph_lo, ph_hi, li;
};
static_assert(sizeof(Params) == N_IN * 8 + 8 + 8 + 16, "Params has no padding");

struct Frame {
    LAS unsigned char* lds;
    int tid, lane, wave, G, bx;
};
#define WSP(T, off) ((T*)(P.ws + (off)))

__device__ __forceinline__ void transpose_item(const float* W, int N, bf16* WT, int ldk, int k0, int n0, int out_row0, LAS float* scr, int lane) {
#pragma unroll 8
    for (int i = 0; i < 32; ++i) { const int kk = 2 * i + (lane >> 5); scr[kk * 33 + (lane & 31)] = W[(size_t)(k0 + kk) * N + n0 + (lane & 31)]; }
    LDS_WAIT(); asm volatile("" ::: "memory");
    const int c = lane & 7;
#pragma unroll
    for (int j = 0; j < 4; ++j) { const int n = (lane >> 3) + 8 * j; const LAS float* s = scr + (8 * c) * 33 + n;
        v4u o; o.x = pk2(s[0 * 33], s[1 * 33]); o.y = pk2(s[2 * 33], s[3 * 33]); o.z = pk2(s[4 * 33], s[5 * 33]); o.w = pk2(s[6 * 33], s[7 * 33]);
        *(v4u*)(WT + (size_t)(out_row0 + n) * ldk + k0 + 8 * c) = o; }
    LDS_WAIT(); asm volatile("" ::: "memory");
}
__device__ __forceinline__ int gu_row(int n, int up) { return (n >> 7) * 256 + up * 128 + (n & 127); }

__device__ __forceinline__ void p0_small_weights(const Params& P, const Frame& F) {
    LAS float* scr = (LAS float*)(F.lds + F.wave * 16384);
    const int gw = F.bx * NWAVES + F.wave, NGW = F.G * NWAVES;
    constexpr int I_IN = 16 * 92, I_OUT = 16 * 32, I_GU = 16 * 88, I_DN = 44 * 32, I_GT = 2 * 16, I_LR = 16;
    constexpr int NITEMS = 2 * I_IN + 2 * I_OUT + 2 * I_GU + I_DN + 2 * I_GT + 8 * I_LR;
    for (int it = gw; it < NITEMS; it += NGW) {
        int r = it;
        if (r < 2 * I_IN) { const int l = r / I_IN; r %= I_IN; const int kb = r / 92, nb = r % 92;
            transpose_item(P.in[I_WIN] + (size_t)l * D * DIN, DIN, WSP(bf16, WS_WIN) + (size_t)l * NZ * D, D, 64 * kb, 32 * nb, 32 * nb, scr, F.lane); continue; } r -= 2 * I_IN;
        if (r < 2 * I_OUT) { const int l = r / I_OUT; r %= I_OUT; const int kb = r / 32, nb = r % 32;
            transpose_item(P.in[I_WOUT] + (size_t)l * D * D, D, WSP(bf16, WS_WOUT) + (size_t)l * D * D, D, 64 * kb, 32 * nb, 32 * nb, scr, F.lane); continue; } r -= 2 * I_OUT;
        if (r < 2 * I_GU) { const int up = r / I_GU; r %= I_GU; const int kb = r / 88, nb = r % 88;
            transpose_item(P.in[up ? I_FU : I_FG], DFF, WSP(bf16, WS_WGU), D, 64 * kb, 32 * nb, gu_row(32 * nb, up), scr, F.lane); continue; } r -= 2 * I_GU;
        if (r < I_DN) { const int kb = r / 32, nb = r % 32;
            transpose_item(P.in[I_FD], D, WSP(bf16, WS_WDN), DFF, 64 * kb, 32 * nb, 32 * nb, scr, F.lane); continue; } r -= I_DN;
        if (r < 2 * I_GT) { const int l = r / I_GT; r %= I_GT; const int kb = r / 16, nb = r % 16;
            transpose_item(P.in[I_G2] + (size_t)l * 128 * 512, 512, WSP(bf16, WS_G2T) + (size_t)l * 512 * 128, 128, 64 * kb, 32 * nb, 32 * nb, scr, F.lane); continue; } r -= 2 * I_GT;
        { const int which = r / (4 * I_LR); r %= 4 * I_LR; const int ldi = r / I_LR, nb = r % I_LR;
            transpose_item(P.in[which ? I_A2 : I_W2] + (size_t)ldi * 64 * 512, 512, WSP(bf16, which ? WS_A2TG : WS_W2TG) + (size_t)ldi * 512 * 64, 64, 0, 32 * nb, 32 * nb, scr, F.lane); }
    }
    { const int gt = F.bx * NTHR + F.tid, NGT = F.G * NTHR; constexpr int NV = 2 * (NZ - DIN) * D / 8;
        for (int i = gt; i < NV; i += NGT) { const int l = i / ((NZ - DIN) * D / 8), r = i % ((NZ - DIN) * D / 8);
            *(v4u*)(WSP(bf16, WS_WIN) + (size_t)l * NZ * D + (size_t)DIN * D + (size_t)r * 8) = (v4u){0u, 0u, 0u, 0u}; } }
}
__device__ __forceinline__ void p0_tables(const Params& P, const Frame& F) {
    const int gt = F.bx * NTHR + F.tid, NGT = F.G * NTHR;
    float* E = WSP(float, TAB_E);
    for (int i = gt; i < 64 * 256; i += NGT) { const int n = i >> 8, q = i & 255;
        const float omega = 1.0f / powf(10000.0f, (float)q / 256.0f), ang = (float)n * omega;
        E[n * 512 + q] = sinf(ang); E[n * 512 + 256 + q] = cosf(ang); }
    float* twc = WSP(float, TAB_TWC); float* tws = WSP(float, TAB_TWS);
    for (int i = gt; i < 4096; i += NGT) { const float a = (float)i / 2048.0f; twc[i] = cospif(a); tws[i] = sinpif(a); }
    bf16* c64 = WSP(bf16, TAB_C64); bf16* s64 = WSP(bf16, TAB_S64); bf16* sn64 = WSP(bf16, TAB_SN64);
    for (int i = gt; i < 64 * 64; i += NGT) { const int m = ((i >> 6) * (i & 63)) & 63; const float a = (float)m / 32.0f; const float c = cospif(a), s = sinpif(a);
        c64[i] = (bf16)f2bf(c); s64[i] = (bf16)f2bf(s); sn64[i] = (bf16)f2bf(-s); }
    bf16* c256 = WSP(bf16, WS_C256); bf16* sn256 = WSP(bf16, WS_SN256);
    for (int i = gt; i < 256 * 256; i += NGT) { const int m = ((i >> 8) * (i & 255)) & 255; const float a = (float)m / 128.0f;
        c256[i] = (bf16)f2bf(cospif(a)); sn256[i] = (bf16)f2bf(-sinpif(a)); }
}
__device__ __forceinline__ void p0_adaln(const Params& P, const Frame& F) {
    LAS float* sc = (LAS float*)F.lds;
    LAS float* red = sc + 9 * 1024;
    for (int u = F.bx; u < 192; u += F.G) {
        const int l = u / 96, cb = u % 96;
        for (int i = F.tid; i < 9 * 1024; i += NTHR) { const int r = i >> 10, d = i & 1023; const float v = r < 8 ? P.in[I_C][r * 1024 + d] : P.in[I_CCTX][d]; sc[i] = v / (1.0f + expf(-v)); }
        __syncthreads();
        const int c4 = (F.tid & 15) * 4, kg = F.tid >> 4;
        f32x4 acc[9];
#pragma unroll
        for (int r = 0; r < 9; ++r) acc[r] = (f32x4){0.f, 0.f, 0.f, 0.f};
        const float* w = P.in[I_ADAW] + ((size_t)l * 1024 + kg) * 6144 + cb * 64 + c4;
#pragma unroll 1
        for (int j0 = 0; j0 < 32; j0 += 16) {
            f32x4 wv[16];
#pragma unroll
            for (int q = 0; q < 16; ++q) wv[q] = *(const f32x4*)(w + (size_t)(j0 + q) * 32 * 6144);
#pragma unroll
            for (int q = 0; q < 16; ++q) { const int k = kg + 32 * (j0 + q);
#pragma unroll
                for (int r = 0; r < 9; ++r) acc[r] = acc[r] + wv[q] * sc[r * 1024 + k]; }
        }
#pragma unroll
        for (int r = 0; r < 9; ++r) *(LAS f32x4*)(red + (kg * 9 + r) * 64 + c4) = acc[r];
        __syncthreads();
        for (int i = F.tid; i < 9 * 64; i += NTHR) { const int r = i >> 6, c = i & 63; float s = 0.f;
#pragma unroll
            for (int k = 0; k < 32; ++k) s += red[(k * 9 + r) * 64 + c];
            WSP(float, WS_MOD)[(size_t)(l * 9 + r) * 6144 + cb * 64 + c] = s + P.in[I_ADAB][l * 6144 + cb * 64 + c]; }
        __syncthreads();
    }
}
__device__ __forceinline__ void convert_moe_weights(const Params& P, const Frame& F) {
    LAS float* scr = (LAS float*)(F.lds + F.wave * 16384);
    const int gw = F.bx * NWAVES + F.wave, NGW = F.G * NWAVES;
    constexpr int I_GU = 16 * 112, I_DN = 56 * 32, NITEMS = NE * (2 * I_GU + I_DN);
    for (int it = gw; it < NITEMS; it += NGW) {
        const int e = it / (2 * I_GU + I_DN); int r = it % (2 * I_GU + I_DN);
        if (r < 2 * I_GU) { const int up = r / I_GU; r %= I_GU; const int kb = r / 112, nb = r % 112;
            transpose_item(P.in[up ? I_MUP : I_MG] + (size_t)e * D * DFE, DFE, WSP(bf16, WS_WMGU) + (size_t)e * 2 * DFE * D, D, 64 * kb, 32 * nb, gu_row(32 * nb, up), scr, F.lane); }
        else { r -= 2 * I_GU; const int kb = r / 32, nb = r % 32;
            transpose_item(P.in[I_MD] + (size_t)e * DFE * D, D, WSP(bf16, WS_WMDN) + (size_t)e * D * DFE, DFE, 64 * kb, 32 * nb, 32 * nb, scr, F.lane); }
    }
}

__device__ __forceinline__ void store_h_row(bf16* hrow, int lane, const f32x4 (&h)[4]) {
#pragma unroll
    for (int j = 0; j < 4; ++j) { v2u w; w.x = pk2(h[j].x, h[j].y); w.y = pk2(h[j].z, h[j].w); *(v2u*)(hrow + 4 * lane + 256 * j) = w; }
}
__device__ __forceinline__ void norm_mod(const f32x4 (&x)[4], int lane, const float* ng, const float* sc, const float* sh, f32x4 (&h)[4]) {
    float ss = 0.f;
#pragma unroll
    for (int j = 0; j < 4; ++j) ss += (x[j].x * x[j].x + x[j].y * x[j].y) + (x[j].z * x[j].z + x[j].w * x[j].w);
    const float rs = rsqrtf(wave_sum(ss) * (1.0f / D) + NORM_EPS);
#pragma unroll
    for (int j = 0; j < 4; ++j) { const int c = 4 * lane + 256 * j; const f32x4 g = *(const f32x4*)(ng + c), s1 = *(const f32x4*)(sc + c), s0 = *(const f32x4*)(sh + c);
        h[j] = (x[j] * rs * g) * (1.0f + s1) + s0; }
}
__device__ __forceinline__ void norm_mod_lds(const f32x4 (&x)[4], int lane, const LAS float* ng, const LAS float* sc, const LAS float* sh, f32x4 (&h)[4]) {
    float ss = 0.f;
#pragma unroll
    for (int j = 0; j < 4; ++j) ss += (x[j].x * x[j].x + x[j].y * x[j].y) + (x[j].z * x[j].z + x[j].w * x[j].w);
    const float rs = rsqrtf(wave_sum(ss) * (1.0f / D) + NORM_EPS);
#pragma unroll
    for (int j = 0; j < 4; ++j) { const int c = 4 * lane + 256 * j; const f32x4 g = *(const LAS f32x4*)(ng + c), s1 = *(const LAS f32x4*)(sc + c), s0 = *(const LAS f32x4*)(sh + c);
        h[j] = (x[j] * rs * g) * (1.0f + s1) + s0; }
}
__device__ __forceinline__ void phase_first_norm(const Params& P, const Frame& F) {
    const int gw = F.bx * NWAVES + F.wave, NGW = F.G * NWAVES, lane = F.lane;
    const float* E = WSP(float, TAB_E); const float* mod = WSP(float, WS_MOD); bf16* H = WSP(bf16, WS_H);
    LAS float* WL = (LAS float*)F.lds; LAS float* WN = WL + 9 * 2 * 1024;
    for (int i = F.tid; i < 9 * 2 * 256; i += NTHR) { const int mr = i >> 9, wh = (i >> 8) & 1, c = (i & 255) * 4; *(LAS f32x4*)(WL + (mr * 2 + wh) * 1024 + c) = *(const f32x4*)(mod + (size_t)mr * 6144 + wh * 1024 + c); }
    for (int i = F.tid; i < 256; i += NTHR) *(LAS f32x4*)(WN + i * 4) = *(const f32x4*)(P.in[I_NORMG] + i * 4);
    __syncthreads();
    f32x4 xa[4], ea[4], xb[4], eb[4];
    auto fetch = [&](int row, f32x4 (&xn)[4], f32x4 (&en)[4]) {
        const float* xr = row < NT ? P.in[I_X] + (size_t)row * D : P.in[I_CTX] + (size_t)(row - NT) * D;
#pragma unroll
        for (int j = 0; j < 4; ++j) xn[j] = *(const f32x4*)(xr + 4 * lane + 256 * j);
        if (row < NT) { const int p = row & (SEQ - 1);
#pragma unroll
            for (int j = 0; j < 4; ++j) { const int c = 4 * lane + 256 * j; en[j] = *(const f32x4*)((j < 2) ? (E + (p >> 6) * 512 + c) : (E + (p & 63) * 512 + (c - 512))); } }
    };
    auto body = [&](int row, f32x4 (&xn)[4], f32x4 (&en)[4]) {
        f32x4 x[4];
        const int mr = row < NT ? (row >> 12) : 8;
#pragma unroll
        for (int j = 0; j < 4; ++j) x[j] = row < NT ? xn[j] + en[j] : xn[j];
        if (row + 2 * NGW < MT) fetch(row + 2 * NGW, xn, en);
        f32x4 h[4]; norm_mod_lds(x, lane, WN, WL + (mr * 2 + 1) * 1024, WL + (mr * 2) * 1024, h);
        store_h_row(H + (size_t)row * D, lane, h);
    };
    if (gw < MT) fetch(gw, xa, ea);
    if (gw + NGW < MT) fetch(gw + NGW, xb, eb);
    for (int row = gw; row < MT; row += 2 * NGW) {
        body(row, xa, ea);
        if (row + NGW < MT) body(row + NGW, xb, eb);
    }
    __syncthreads();
}
#ifndef POST_SLEEP
#define POST_SLEEP 4
#endif
#ifdef POST_PLAINLD
__device__ __forceinline__ v2u ld8_agent(const void* p) { return *(const v2u*)p; }
#else
__device__ __forceinline__ v2u ld8_agent(const void* p) { return __builtin_bit_cast(v2u, __hip_atomic_load((const unsigned long long*)p, __ATOMIC_RELAXED, __HIP_MEMORY_SCOPE_AGENT)); }
#endif
template <int MODE, bool NEXT, bool ROUTE, bool FIRST = false>
__device__ __forceinline__ void phase_post(const Params& P, const Frame& F, int nrows, int l, int goff, int ngp_idx, const float* xc_src, int ln, int ngn_idx, int scoff, int shoff,
                                           const unsigned* pcnt, unsigned need, int nbusy, int nexcl, const float* part = nullptr, int srow0 = 0x7fffffff, int S = 1, int tail_rows = 0) {
    const bool busy = F.bx < nbusy; const int lane = F.lane;
    const int gwa = F.bx * NWAVES + F.wave, NGWA = F.G * NWAVES, gwf = (F.bx - nbusy) * NWAVES + F.wave, NGWF = (F.G - nbusy) * NWAVES;
    const int KE = busy ? 0 : (nexcl + NGWF - 1) / NGWF, KS = (nrows - nexcl + NGWA - 1) / NGWA;
    auto rowq = [&](int q) -> int { return q < KE ? (gwf + q * NGWF) : (nexcl + gwa + (q - KE) * NGWA); };
    bf16* H = WSP(bf16, WS_H); const bf16* O32 = WSP(bf16, WS_O32);
    LAS float* WL = (LAS float*)F.lds; LAS float* WN = WL + 9 * 3 * 1024; LAS float* WR = WN + 2 * 1024;
    {
        const float* mod = WSP(float, WS_MOD);
        const float* ngp = P.in[I_NORMG] + (size_t)(l * 4 + ngp_idx) * D;
        const float* ngn = P.in[I_NORMG] + (size_t)(ln * 4 + ngn_idx) * D;
        for (int i = F.tid; i < 9 * 3 * 256; i += NTHR) { const int mr = i / 768, r = i - mr * 768, wh = r >> 8, c = (r & 255) * 4;
            if (wh == 0 || NEXT) { const float* src = wh == 0 ? mod + (size_t)(l * 9 + mr) * 6144 + goff + c : mod + (size_t)(ln * 9 + mr) * 6144 + (wh == 1 ? scoff : shoff) + c;
                *(LAS f32x4*)(WL + (mr * 3 + wh) * 1024 + c) = *(const f32x4*)src; } }
        for (int i = F.tid; i < 2 * 256; i += NTHR) { const int wh = i >> 8, c = (i & 255) * 4; if (wh == 0 || NEXT) *(LAS f32x4*)(WN + wh * 1024 + c) = *(const f32x4*)((wh ? ngn : ngp) + c); }
        if (ROUTE) for (int i = F.tid; i < 8 * 1024; i += NTHR) WR[(i & 7) * 1024 + (i >> 3)] = P.in[I_RW][i];
        if (ROUTE && F.tid < NE) ((LAS unsigned*)(F.lds + MISC_OFF))[48 + F.tid] = 0u;
        __syncthreads();
    }
    int cnt[NE]; float rbias[NE];
#pragma unroll
    for (int e = 0; e < NE; ++e) { cnt[e] = 0; rbias[e] = ROUTE ? P.in[I_RB][e] : 0.f; }
    constexpr bool XI16 = !FIRST && MODE == 0, XO16 = MODE == 0 && !ROUTE;
    v2u on0[4], on1[4], xbn[4]; f32x4 xnx[4], enx[4]; float pn0 = 0.f, pn1 = 0.f;
    bf16* XB = WSP(bf16, WS_XB);
    auto ldrow = [&](v2u (&dst)[4], const bf16* orow, int srow) {
        if (srow < 0) {
#pragma unroll
            for (int j = 0; j < 4; ++j) dst[j] = ld8_agent(orow + 4 * lane + 256 * j);
        } else {
            f32x4 a[4];
#pragma unroll
            for (int j = 0; j < 4; ++j) a[j] = (f32x4){0.f, 0.f, 0.f, 0.f};
            const __amdgpu_buffer_rsrc_t prs = __builtin_amdgcn_make_buffer_rsrc(const_cast<float*>(part), 0, 0x7ffffff0, 0x00020000);
            for (int ks = 0; ks < S; ++ks) { const unsigned po = (unsigned)(((size_t)ks * tail_rows + srow) * D + 4 * lane) * 4u;
#pragma unroll
                for (int j = 0; j < 4; ++j) a[j] = a[j] + __builtin_bit_cast(f32x4, __builtin_amdgcn_raw_buffer_load_b128(prs, po + 1024u * (unsigned)j, 0, 16)); }
#pragma unroll
            for (int j = 0; j < 4; ++j) { dst[j].x = pk2(a[j].x, a[j].y); dst[j].y = pk2(a[j].z, a[j].w); }
        }
    };
    auto fetch = [&](int row) {
        if (MODE == 0) {
            ldrow(on0, O32 + (size_t)row * D, row >= srow0 ? row - srow0 : -1);
        } else {
            const int4 rt = *(const int4*)(P.ws + WS_ROUTE + (size_t)row * 16); const int2 tp = *(const int2*)(P.ws + WS_TOKPOS + (size_t)row * 8);
            pn0 = __builtin_bit_cast(float, rt.y); pn1 = __builtin_bit_cast(float, rt.z);
            ldrow(on0, WSP(bf16, WS_XG) + (size_t)tp.x * D, tp.x >= srow0 ? tp.x - srow0 : -1); ldrow(on1, WSP(bf16, WS_XG) + (size_t)tp.y * D, tp.y >= srow0 ? tp.y - srow0 : -1);
        }
        if (!XI16) { const float* xs = FIRST ? (row < NT ? P.in[I_X] + (size_t)row * D : xc_src + (size_t)(row - NT) * D) : (const float*)P.out + (size_t)row * D;
#pragma unroll
            for (int j = 0; j < 4; ++j) xnx[j] = *(const f32x4*)(xs + 4 * lane + 256 * j);
        } else {
#pragma unroll
            for (int j = 0; j < 4; ++j) xbn[j] = *(const v2u*)(XB + (size_t)row * D + 4 * lane + 256 * j); }
        if (FIRST && row < NT) { const int p = row & (SEQ - 1);
#pragma unroll
            for (int j = 0; j < 4; ++j) { const int c = 4 * lane + 256 * j; enx[j] = *(const f32x4*)((j < 2) ? (WSP(float, TAB_E) + (p >> 6) * 512 + c) : (WSP(float, TAB_E) + (p & 63) * 512 + (c - 512))); } }
    };
    for (int qb = 0; qb < KE + KS; qb += 64) {
    const int myq = qb + lane, myrow = rowq(myq); const bool valid = myq < KE ? (myrow < nexcl) : (myq < KE + KS && myrow < nrows);
    const unsigned* w0 = pcnt; const unsigned* w1 = pcnt; unsigned nd0 = need, nd1 = need;
    if (valid) { if (MODE == 0) { w0 = w1 = pcnt + 16 * (myrow >> 8); if (myrow >= srow0) nd0 = need * (unsigned)S; }
                 else { const int2 tp = *(const int2*)(P.ws + WS_TOKPOS + (size_t)myrow * 8); w0 = pcnt + 16 * (tp.x >> 8); w1 = pcnt + 16 * (tp.y >> 8); if (tp.x >= srow0) nd0 = need * (unsigned)S; if (tp.y >= srow0) nd1 = need * (unsigned)S; } }
    unsigned long long rem = __ballot(valid); unsigned spins = 0;
    while (rem) {
        bool rdy = false;
        if ((rem >> lane) & 1ull) { rdy = __hip_atomic_load(w0, __ATOMIC_RELAXED, __HIP_MEMORY_SCOPE_AGENT) >= nd0; if (MODE != 0) rdy = rdy && __hip_atomic_load(w1, __ATOMIC_RELAXED, __HIP_MEMORY_SCOPE_AGENT) >= nd1; }
        unsigned long long now = __ballot(rdy);
        if (!now) {
            __builtin_amdgcn_s_sleep(POST_SLEEP);
            if (++spins <= (1u << 15)) continue;
            if (lane == 0) { unsigned* tmo = WSP(unsigned, WS_CTL) + CW_TMO; __hip_atomic_store(tmo, 1u, __ATOMIC_RELAXED, __HIP_MEMORY_SCOPE_AGENT); __hip_atomic_fetch_max(tmo + 1, 0xB00u, __ATOMIC_RELAXED, __HIP_MEMORY_SCOPE_AGENT); }
            now = rem;
        }
        asm volatile("" ::: "memory");
        rem &= ~now;
        int kcur = __ffsll((long long)now) - 1; now &= now - 1ull;
        fetch(rowq(qb + kcur));
    for (;;) {
        const int row = rowq(qb + kcur);
        const int knext = now ? (__ffsll((long long)now) - 1) : -1; now &= now - 1ull;
        const int mr = row < NT ? (row >> 12) : 8;
        f32x4 o[4], xin[4];
#pragma unroll
        for (int j = 0; j < 4; ++j) { xin[j] = !XI16 ? xnx[j] : (f32x4){bflo(xbn[j].x), bfhi(xbn[j].x), bflo(xbn[j].y), bfhi(xbn[j].y)};
            if (FIRST && row < NT) xin[j] = xin[j] + enx[j];
            if (MODE == 0) o[j] = (f32x4){bflo(on0[j].x), bfhi(on0[j].x), bflo(on0[j].y), bfhi(on0[j].y)};
            else o[j] = (f32x4){pn0 * bflo(on0[j].x) + pn1 * bflo(on1[j].x), pn0 * bfhi(on0[j].x) + pn1 * bfhi(on1[j].x), pn0 * bflo(on0[j].y) + pn1 * bflo(on1[j].y), pn0 * bfhi(on0[j].y) + pn1 * bfhi(on1[j].y)}; }
        if (knext >= 0) fetch(rowq(qb + knext));
        float ss = 0.f;
#pragma unroll
        for (int j = 0; j < 4; ++j) ss += (o[j].x * o[j].x + o[j].y * o[j].y) + (o[j].z * o[j].z + o[j].w * o[j].w);
        const float rs = rsqrtf(wave_sum(ss) * (1.0f / D) + NORM_EPS);
        float* xd = P.out + (size_t)row * D;
        const LAS float* wl = WL + mr * 3 * 1024;
        f32x4 x[4];
#pragma unroll
        for (int j = 0; j < 4; ++j) { const int c = 4 * lane + 256 * j; const f32x4 g = *(const LAS f32x4*)(wl + c), n = *(const LAS f32x4*)(WN + c);
            x[j] = xin[j] + g * (o[j] * rs * n);
            if (!XO16) *(f32x4*)(xd + c) = x[j];
            else { v2u w; w.x = pk2(x[j].x, x[j].y); w.y = pk2(x[j].z, x[j].w); *(v2u*)(XB + (size_t)row * D + c) = w; } }
        if (NEXT) {
            f32x4 h[4]; norm_mod_lds(x, lane, WN + 1024, wl + 1024, wl + 2048, h);
            store_h_row(H + (size_t)row * D, lane, h);
            if (ROUTE) {
                float lg[NE];
#pragma unroll
                for (int e = 0; e < NE; ++e) lg[e] = 0.f;
#pragma unroll
                for (int e = 0; e < NE; ++e) {
#pragma unroll
                    for (int j = 0; j < 4; ++j) { const f32x4 w = *(const LAS f32x4*)(WR + e * 1024 + 4 * lane + 256 * j); lg[e] += (h[j].x * w.x + h[j].y * w.y) + (h[j].z * w.z + h[j].w * w.w); }
                    if (e & 1) __builtin_amdgcn_sched_barrier(0);
                }
#pragma unroll
                for (int e = 0; e < NE; ++e) lg[e] = wave_sum(lg[e]) + rbias[e];
                int i0 = 0; float v0 = lg[0];
#pragma unroll
                for (int e = 1; e < NE; ++e) if (lg[e] > v0) { v0 = lg[e]; i0 = e; }
                int i1 = -1; float v1 = -3.0e38f;
#pragma unroll
                for (int e = 0; e < NE; ++e) if (e != i0 && lg[e] > v1) { v1 = lg[e]; i1 = e; }
                const float e1 = expf(v1 - v0), p0 = 1.0f / (1.0f + e1), p1 = e1 / (1.0f + e1);
                if (lane == 0) *(int4*)(P.ws + WS_ROUTE + (size_t)row * 16) = make_int4(i0 | (i1 << 8), __builtin_bit_cast(int, p0), __builtin_bit_cast(int, p1), 0);
#pragma unroll
                for (int e = 0; e < NE; ++e) cnt[e] += (e == i0 || e == i1) ? 1 : 0;
            }
        }
        if (knext < 0) break;
        kcur = knext;
    }
    }
    }
    if (ROUTE) {
        LAS unsigned* bc = (LAS unsigned*)(F.lds + MISC_OFF) + 48;
        if (lane == 0) {
#pragma unroll
            for (int e = 0; e < NE; ++e) if (cnt[e]) __hip_atomic_fetch_add(bc + e, (unsigned)cnt[e], __ATOMIC_RELAXED, __HIP_MEMORY_SCOPE_WORKGROUP);
        }
        __syncthreads();
        if (F.tid < NE) { const unsigned c = bc[F.tid]; if (c) __hip_atomic_fetch_add(WSP(unsigned, WS_CTL) + CW_CNT + 64 * F.tid, c, __ATOMIC_RELAXED, __HIP_MEMORY_SCOPE_AGENT); }
    }
}

constexpr int TB = 64;
typedef short bf16x4s __attribute__((ext_vector_type(4)));
#define MFMA16K(a, b, c) __builtin_amdgcn_mfma_f32_16x16x16bf16_1k((a), (b), (c), 0, 0, 0)
__device__ __forceinline__ float fexp(float x) { return __builtin_amdgcn_exp2f(x * 1.44269504089f); }
__device__ __forceinline__ float flog(float x) { return __builtin_amdgcn_logf(x) * 0.69314718056f; }
__device__ __forceinline__ float frcp(float x) { return __builtin_amdgcn_rcpf(x); }
__device__ __forceinline__ float softplusf_(float x) { return fmaxf(x, 0.f) + flog(1.0f + fexp(-fabsf(x))); }
__device__ __forceinline__ float ftanh(float x) { return 1.0f - 2.0f * frcp(1.0f + fexp(2.0f * x)); }
__device__ __forceinline__ f32x4 ld4bf(const bf16* p) { const v2u w = *(const v2u*)p; return (f32x4){bflo(w.x), bfhi(w.x), bflo(w.y), bfhi(w.y)}; }
template <int CTRL> __device__ __forceinline__ float dppf(float v) { return __builtin_bit_cast(float, __builtin_amdgcn_update_dpp(0, __builtin_bit_cast(int, v), CTRL, 0xf, 0xf, true)); }
__device__ __forceinline__ float sum8(float v) { v += dppf<0xB1>(v); v += dppf<0x4E>(v); v += dppf<0x141>(v); return v; }
__device__ __forceinline__ bf16x4s pack4(f32x4 v) { v2u w; w.x = pk2(v.x, v.y); w.y = pk2(v.z, v.w); return __builtin_bit_cast(bf16x4s, w); }
__device__ __forceinline__ void unpack8(v4u w, float (&o)[8]) {
#pragma unroll
    for (int q = 0; q < 4; ++q) { o[2 * q] = bflo(w[q]); o[2 * q + 1] = bfhi(w[q]); } }
__device__ __forceinline__ v4u pack8(const float (&o)[8]) { v4u w;
#pragma unroll
    for (int q = 0; q < 4; ++q) w[q] = pk2(o[2 * q], o[2 * q + 1]);
    return w; }
struct ScanPre { v4u kc, kp, vc, vp, rc, rp, wc, wp, ac, ap; };
__device__ __forceinline__ int scan_row(int bi, int tk, int b, int dir, bool& hp, int& prow) {
    const int seq = bi >= LC / TB, c = seq ? bi - LC / TB : bi, len = seq ? SEQ : LC, rowbase = seq ? b * SEQ : NT + b * LC;
    const int ts = c * TB + tk, t = dir ? (len - 1 - ts) : ts;
    hp = dir ? (t + 1 < len) : (t > 0);
    prow = rowbase + (hp ? (dir ? t + 1 : t - 1) : t);
    return rowbase + t;
}
__device__ __forceinline__ void scan_prefetch(const bf16* Z, int bi, int tk, int b, int dir, int gc, int c8, ScanPre& R) {
    bool hp; int prow; const int row = scan_row(bi, tk, b, dir, hp, prow);
    const bf16* zrk = Z + (size_t)row * NZ + gc; const bf16* zpk = Z + (size_t)prow * NZ + gc;
    const bf16* zrw = Z + (size_t)row * NZ + C_WLO + 64 * dir + c8; const bf16* zpw = Z + (size_t)prow * NZ + C_WLO + 64 * dir + c8;
    R.kc = *(const v4u*)(zrk + C_K); R.vc = *(const v4u*)(zrk + C_V); R.rc = *(const v4u*)(zrk + C_R); R.wc = *(const v4u*)(zrw); R.ac = *(const v4u*)(zrw + (C_ALO - C_WLO));
    R.kp = *(const v4u*)(zpk + C_K); R.vp = *(const v4u*)(zpk + C_V); R.rp = *(const v4u*)(zpk + C_R); R.wp = *(const v4u*)(zpw); R.ap = *(const v4u*)(zpw + (C_ALO - C_WLO));
}
__device__ __forceinline__ void lerp8(v4u cur, v4u prv, bool hp, const LAS float* mu, float (&o)[8]) {
    if (!hp) prv = (v4u){0u, 0u, 0u, 0u};
    const f32x4 m0 = *(const LAS f32x4*)mu, m1 = *(const LAS f32x4*)(mu + 4);
#pragma unroll
    for (int q = 0; q < 4; ++q) {
        const f32x2 c2 = {bflo(cur[q]), bfhi(cur[q])}, p2 = {bflo(prv[q]), bfhi(prv[q])};
        const f32x2 m2 = q < 2 ? (f32x2){m0[2 * q], m0[2 * q + 1]} : (f32x2){m1[2 * q - 4], m1[2 * q - 3]};
        const f32x2 r2 = c2 + (p2 - c2) * m2;
        o[2 * q] = r2.x; o[2 * q + 1] = r2.y; }
}
#define RLX_AGENT __ATOMIC_RELAXED, __HIP_MEMORY_SCOPE_AGENT
typedef GAS unsigned gu32;
constexpr unsigned kSpinCap = 1u << 17;
__device__ __forceinline__ bool wait_ge(gu32* word, unsigned want, gu32* tmo, unsigned code, int lane) {
    for (unsigned spins = 0;;) {
        if ((unsigned)__builtin_amdgcn_readfirstlane(__hip_atomic_load(word, RLX_AGENT)) >= want) return true;
        __builtin_amdgcn_s_sleep(1);
        if (++spins > kSpinCap) { if (lane == 0) { __hip_atomic_store(tmo, 1u, RLX_AGENT); __hip_atomic_fetch_max(tmo + 1, code, RLX_AGENT); } return false; }
        if ((spins & 255u) == 0u && __builtin_amdgcn_readfirstlane(__hip_atomic_load(tmo, RLX_AGENT))) return false;
    }
}
constexpr int XFER_PIECES = 3264, XFER_SLOT_BYTES = 52480, XFER_SLOTS = 8;
static_assert(WS_RING + 128ull * XFER_SLOTS * XFER_SLOT_BYTES <= WS_XB, "hand-off rings fit below the residual stream");
__device__ __forceinline__ int xfer_lds_off(int i) { return i < 1536 ? 20992 + 16 * i : (i < 2688 ? 45568 + 16 * (i - 1536) : 102912 + 16 * (i - 2688)); }
#ifdef TPROBE
#define STP_BEGIN(k) do { if ((k) == TPROBE && (int)blockIdx.x == (TPROBE_BLK) && F.wave == 0) { ((volatile LAS unsigned*)(F.lds + MISC_OFF))[41] = (unsigned)__builtin_amdgcn_s_memrealtime(); } } while (0)
#define STP_END(k) do { if ((k) == TPROBE && (int)blockIdx.x == (TPROBE_BLK) && F.wave == 0) { volatile LAS unsigned* m_ = (volatile LAS unsigned*)(F.lds + MISC_OFF); m_[40] += (unsigned)__builtin_amdgcn_s_memrealtime() - m_[41]; } } while (0)
#else
#define STP_BEGIN(k) do {} while (0)
#define STP_END(k) do {} while (0)
#endif
__device__ __forceinline__ void scan_unit(const Params& P, const Frame& F, int l, int b, int h, int dir, int role) {
    LAS unsigned char* L0 = F.lds;
    LAS bf16* W2T = (LAS bf16*)L0;
    LAS bf16* A2T = (LAS bf16*)(L0 + 9216);
    LAS float* CST = (LAS float*)(L0 + 18432);
    LAS bf16* TWb = (LAS bf16*)(L0 + 20992);
    LAS bf16* ALb = TWb + TB * TP;
    LAS bf16* BH = (LAS bf16*)(L0 + 20992);
    LAS bf16* KH = BH + 4 * 64 * 16;
    LAS bf16* Vt = KH + 4 * 64 * 16;
    LAS float* LW = (LAS float*)(L0 + 45568);
    constexpr int LWP = 68;
    LAS float* LA = LW + TB * LWP;
    LAS bf16* AT = (LAS bf16*)(L0 + 45568);
    LAS bf16* RT = AT + TB * TP; LAS bf16* BT = RT + TB * TP; LAS bf16* KT = BT + TB * TP;
    LAS float* CUM = (LAS float*)(L0 + 82432);
    LAS float* LabF = (LAS float*)(L0 + 98816);
    LAS bf16* LakB = (LAS bf16*)(L0 + 102912);
    LAS bf16* TtB = LakB + 1024; LAS bf16* MrbB = TtB + 1024; LAS bf16* MrkB = MrbB + 1024;
    LAS float* PCb = (LAS float*)(L0 + 111104);
    LAS float* YB = (LAS float*)(L0 + 112128);
    LAS float* BONl = (LAS float*)(L0 + 128512);
    const int tid = F.tid, lane = F.lane, w = F.wave, fr = lane & 15, fq = lane >> 4;
    const int tk = tid >> 3, c8 = (tid & 7) * 8, gc = 64 * h + c8;
    const int ld = l * 2 + dir;
    for (int i = tid; i < 4096; i += NTHR) { const int j = i >> 6, c = i & 63;
        W2T[c * TP + j] = (bf16)f2bf(P.in[I_W2][((size_t)ld * 64 + j) * 512 + 64 * h + c]); A2T[c * TP + j] = (bf16)f2bf(P.in[I_A2][((size_t)ld * 64 + j) * 512 + 64 * h + c]); }
    if (tid < 64) { const int c = 64 * h + tid;
        CST[0 * 64 + tid] = P.in[I_MU][(size_t)(ld * 3 + 0) * 512 + c]; CST[1 * 64 + tid] = P.in[I_MU][(size_t)(ld * 3 + 1) * 512 + c]; CST[2 * 64 + tid] = P.in[I_MU][(size_t)(ld * 3 + 2) * 512 + c];
        CST[3 * 64 + tid] = P.in[I_MUW][ld * 64 + tid]; CST[4 * 64 + tid] = P.in[I_MUA][ld * 64 + tid];
        CST[5 * 64 + tid] = P.in[I_W0][ld * 512 + c]; CST[6 * 64 + tid] = P.in[I_A0][ld * 512 + c];
        CST[7 * 64 + tid] = P.in[I_KK][l * 512 + c]; CST[8 * 64 + tid] = P.in[I_KA][l * 512 + c]; CST[9 * 64 + tid] = P.in[I_RK][l * 512 + c]; }
    const bf16* Z = WSP(bf16, WS_Z);
    bf16* YS = WSP(bf16, WS_YS) + (size_t)dir * MT * 512;
    float* BONG = WSP(float, WS_BONG) + (size_t)dir * MT * 8;
    f32x4 St[4];
#pragma unroll
    for (int kt = 0; kt < 4; ++kt) St[kt] = (f32x4){0.f, 0.f, 0.f, 0.f};
    constexpr int NBT = LC / TB + SEQ / TB;
    const int sid = (b * 8 + h) * 2 + dir;
    gu32* ctlw = (gu32*)WSP(unsigned, WS_CTL);
    gu32* prodw = ctlw + CW_PROD + l * 16384 + 64 * sid; gu32* consw = ctlw + CW_CONS + l * 16384 + 64 * sid;
    unsigned char* ring = P.ws + WS_RING + (size_t)sid * (XFER_SLOTS * XFER_SLOT_BYTES);
    v4u XR[7];
    ScanPre R; scan_prefetch(Z, role == 1 ? 1 : 0, tk, b, dir, gc, c8, R);
    __syncthreads();
    for (int bi = (role == 1 ? 1 : 0); bi < NBT; ++bi) {
        const bool mine = (role == 2) || ((bi % 2 == 0) == (role == 0));
        if (role == 1 && !mine) continue;
        const int hj = bi >> 1;
        const int bstep = role == 2 ? 1 : 2;
        const bool need_out = (bi >= LC / TB) || (l == 0);
        bool hp; int prow; const int row = scan_row(bi, tk, b, dir, hp, prow); (void)prow;
#ifdef PROBE_PREP2
        for (int prb_ = 0; prb_ < 2; ++prb_)
#endif
        STP_BEGIN(240);
        if (mine) {
        if (role == 1 && hj >= XFER_SLOTS) { if (w == 0) wait_ge(consw, (unsigned)(hj - XFER_SLOTS + 1), ctlw + CW_TMO, 0x900u, lane); __syncthreads(); }
        STP_BEGIN(250);
        float kx[8], vx[8], rx[8];
        { float wl[8], al[8];
          lerp8(R.kc, R.kp, hp, CST + 0 * 64 + c8, kx); lerp8(R.vc, R.vp, hp, CST + 1 * 64 + c8, vx); lerp8(R.rc, R.rp, hp, CST + 2 * 64 + c8, rx);
          lerp8(R.wc, R.wp, hp, CST + 3 * 64 + c8, wl); lerp8(R.ac, R.ap, hp, CST + 4 * 64 + c8, al);
#pragma unroll
          for (int j = 0; j < 8; ++j) wl[j] = ftanh(wl[j]);
          *(LAS v4u*)(TWb + tk * TP + c8) = pack8(wl); *(LAS v4u*)(ALb + tk * TP + c8) = pack8(al); }
        if (bi + bstep < NBT) scan_prefetch(Z, bi + bstep, tk, b, dir, gc, c8, R);
        __syncthreads();
        STP_END(250); STP_BEGIN(251);
        { const int mt = w & 3;
          bf16x8 yt[2], ya[2];
#pragma unroll
          for (int k2 = 0; k2 < 2; ++k2) { yt[k2] = *(const LAS bf16x8*)(TWb + (16 * mt + fr) * TP + 32 * k2 + 8 * fq); ya[k2] = *(const LAS bf16x8*)(ALb + (16 * mt + fr) * TP + 32 * k2 + 8 * fq); }
#pragma unroll
          for (int n2 = 0; n2 < 2; ++n2) { const int nt = 2 * (w >> 2) + n2;
              f32x4 cw = {0.f, 0.f, 0.f, 0.f}, ca = {0.f, 0.f, 0.f, 0.f};
#pragma unroll
              for (int k2 = 0; k2 < 2; ++k2) {
                  cw = MFMA16(*(const LAS bf16x8*)(W2T + (16 * nt + fr) * TP + 32 * k2 + 8 * fq), yt[k2], cw);
                  ca = MFMA16(*(const LAS bf16x8*)(A2T + (16 * nt + fr) * TP + 32 * k2 + 8 * fq), ya[k2], ca); }
              *(LAS f32x4*)(LW + (16 * mt + fr) * LWP + 16 * nt + 4 * fq) = cw; *(LAS f32x4*)(LA + (16 * mt + fr) * LWP + 16 * nt + 4 * fq) = ca; } }
        __syncthreads();
        STP_END(251); STP_BEGIN(252);
        float na[8], pb[8], km[8];
        {
            float n2 = 0.f, bon = 0.f, ew[8];
#pragma unroll
            for (int hf = 0; hf < 2; ++hf) {
#pragma unroll
                for (int j = 4 * hf; j < 4 * hf + 4; ++j) {
                    const float aw = LW[tk * LWP + c8 + j], aa = LA[tk * LWP + c8 + j];
                    ew[j] = 0.6065306597f * frcp(1.0f + fexp(-(CST[5 * 64 + c8 + j] + aw)));
                    const float ag = frcp(1.0f + fexp(-(CST[6 * 64 + c8 + j] + aa)));
                    const float kk = kx[j] * CST[7 * 64 + c8 + j]; n2 += kk * kk;
                    km[j] = kx[j] * (1.0f + (ag - 1.0f) * CST[8 * 64 + c8 + j]);
                    bon += rx[j] * km[j] * CST[9 * 64 + c8 + j];
                    na[j] = kk; pb[j] = ag;
                }
                __builtin_amdgcn_sched_barrier(0);
            }
            n2 = sum8(n2); bon = sum8(bon);
            const float inv = frcp(fmaxf(__builtin_amdgcn_sqrtf(n2), 1e-12f));
#pragma unroll
            for (int j = 0; j < 8; ++j) { const float kkn = na[j] * inv; na[j] = -kkn; pb[j] = kkn * pb[j]; }
            *(LAS f32x4*)(CUM + tk * 64 + c8) = (f32x4){ew[0], ew[1], ew[2], ew[3]} * 1.44269504089f; *(LAS f32x4*)(CUM + tk * 64 + c8 + 4) = (f32x4){ew[4], ew[5], ew[6], ew[7]} * 1.44269504089f;
            if ((tid & 7) == 0 && need_out) BONG[(size_t)row * 8 + h] = bon;
        }
        __syncthreads();
        STP_END(252); STP_BEGIN(253);
        if (tid < 256) { const int q = tid >> 6, ch = tid & 63; float c = 0.f;
#pragma unroll
            for (int i = 0; i < 16; ++i) { c -= CUM[(16 * q + i) * 64 + ch]; const float p = __builtin_amdgcn_exp2f(c); CUM[(16 * q + i) * 64 + ch] = p; if (i == 15) PCb[q * 64 + ch] = p; } }
        __syncthreads();
        STP_END(253); STP_BEGIN(254);
        {
            const int q = tk >> 4, tt = tk & 15;
            const f32x4 one4 = {1.f, 1.f, 1.f, 1.f};
            const f32x4 et0 = *(const LAS f32x4*)(CUM + tk * 64 + c8), et1 = *(const LAS f32x4*)(CUM + tk * 64 + c8 + 4);
            const f32x4 ep0 = tt ? *(const LAS f32x4*)(CUM + (tk - 1) * 64 + c8) : one4, ep1 = tt ? *(const LAS f32x4*)(CUM + (tk - 1) * 64 + c8 + 4) : one4;
            const f32x4 pc0 = *(const LAS f32x4*)(PCb + q * 64 + c8), pc1 = *(const LAS f32x4*)(PCb + q * 64 + c8 + 4);
            float ei8[8];
            { float t8[8];
#pragma unroll
              for (int j = 0; j < 8; ++j) t8[j] = na[j] * (j < 4 ? ep0[j & 3] : ep1[j & 3]);
              *(LAS v4u*)(AT + tk * TP + c8) = pack8(t8); }
            { float t8[8];
#pragma unroll
              for (int j = 0; j < 8; ++j) { const float et = j < 4 ? et0[j & 3] : et1[j & 3]; t8[j] = rx[j] * et; ei8[j] = frcp(et); }
              *(LAS v4u*)(RT + tk * TP + c8) = pack8(t8); }
            { float t8[8];
#pragma unroll
              for (int j = 0; j < 8; ++j) t8[j] = pb[j] * ei8[j];
              *(LAS v4u*)(BT + tk * TP + c8) = pack8(t8); }
            { float t8[8];
#pragma unroll
              for (int j = 0; j < 8; ++j) t8[j] = km[j] * ei8[j];
              *(LAS v4u*)(KT + tk * TP + c8) = pack8(t8); }
#pragma unroll
            for (int j = 0; j < 8; j += 2) { const float eh0 = (j < 4 ? pc0[j & 3] : pc1[j & 3]) * ei8[j], eh1 = (j + 1 < 4 ? pc0[(j + 1) & 3] : pc1[(j + 1) & 3]) * ei8[j + 1];
                const unsigned wb = pk2(pb[j] * eh0, pb[j + 1] * eh1), wk = pk2(km[j] * eh0, km[j + 1] * eh1), wv = pk2(vx[j], vx[j + 1]); const int o = (q * 64 + c8 + j) * 16 + (tt ^ (4 * ((tid & 7) & 3)));
                BH[o] = (bf16)(wb & 0xffffu); BH[o + 16] = (bf16)(wb >> 16); KH[o] = (bf16)(wk & 0xffffu); KH[o + 16] = (bf16)(wk >> 16); Vt[o] = (bf16)(wv & 0xffffu); Vt[o + 16] = (bf16)(wv >> 16); }
        }
        __syncthreads();
        STP_END(254); STP_BEGIN(255);
        { const int q = w >> 1, rsel = w & 1;
          const LAS bf16* YR = rsel ? RT : AT;
          f32x4 cb = {0.f, 0.f, 0.f, 0.f}, ck = {0.f, 0.f, 0.f, 0.f};
#pragma unroll
          for (int k2 = 0; k2 < 2; ++k2) { const bf16x8 yf = *(const LAS bf16x8*)(YR + (16 * q + fr) * TP + 32 * k2 + 8 * fq);
              cb = MFMA16(*(const LAS bf16x8*)(BT + (16 * q + fr) * TP + 32 * k2 + 8 * fq), yf, cb);
              ck = MFMA16(*(const LAS bf16x8*)(KT + (16 * q + fr) * TP + 32 * k2 + 8 * fq), yf, ck); }
#pragma unroll
          for (int i2 = 0; i2 < 4; ++i2) { const int i = 4 * fq + i2; const bool keep = rsel ? (i <= fr) : (i < fr); if (!keep) { cb[i2] = 0.f; ck[i2] = 0.f; } }
          if (rsel == 0) { *(LAS f32x4*)(LabF + (q * 16 + fr) * 16 + 4 * fq) = cb; *(LAS bf16x4s*)(LakB + (q * 16 + fr) * 16 + 4 * fq) = pack4(ck); }
          else { *(LAS bf16x4s*)(MrbB + (q * 16 + fr) * 16 + 4 * fq) = pack4(cb); *(LAS bf16x4s*)(MrkB + (q * 16 + fr) * 16 + 4 * fq) = pack4(ck); } }
        __syncthreads();
        STP_END(255); STP_BEGIN(256);
        if (tid < 256) { const int pair = tid >> 2, p = tid & 3, q = pair >> 4, c = pair & 15;
            f32x4 Lr[4][4];
#pragma unroll
            for (int r = 0; r < 4; ++r)
#pragma unroll
                for (int k = 0; k <= r; ++k) Lr[r][k] = *(const LAS f32x4*)(LabF + (q * 16 + p + 4 * r) * 16 + 4 * k);
            float T[4];
#pragma unroll
            for (int r = 0; r < 4; ++r) T[r] = (p + 4 * r == c) ? 1.f : 0.f;
#pragma unroll
            for (int i = 0; i < 16; ++i) { constexpr int bc[4] = {0x00, 0x55, 0xAA, 0xFF};
                const float own = T[i >> 2];
                const float ti = (i & 3) == 0 ? dpp_mov<0x00>(own) : ((i & 3) == 1 ? dpp_mov<0x55>(own) : ((i & 3) == 2 ? dpp_mov<0xAA>(own) : dpp_mov<0xFF>(own)));
                (void)bc;
                if (p == (i & 3)) TtB[(q * 16 + i) * 16 + c] = (bf16)f2bf(ti);
#pragma unroll
                for (int r = i >> 2; r < 4; ++r) T[r] += Lr[r][i >> 2][i & 3] * ti; } }
        __syncthreads();
        STP_END(256);
        }
        STP_END(240);
        if (role == 1) {
            const __amdgpu_buffer_rsrc_t rs = __builtin_amdgcn_make_buffer_rsrc(ring, 0, XFER_SLOTS * XFER_SLOT_BYTES, 0x00020000);
            const unsigned sb0 = (unsigned)((hj % XFER_SLOTS) * XFER_SLOT_BYTES);
            for (int i = tid; i < XFER_PIECES; i += NTHR) { const v4u v = *(const LAS v4u*)(L0 + xfer_lds_off(i)); __builtin_amdgcn_raw_buffer_store_b128(v, rs, sb0 + 16u * (unsigned)i, 0, 16); }
            asm volatile("s_waitcnt vmcnt(0)" ::: "memory");
            __syncthreads();
            if (tid == 0) __hip_atomic_store(prodw, (unsigned)(hj + 1), RLX_AGENT);
            continue;
        }
        STP_BEGIN(241);
        if (!mine) {
#pragma unroll
            for (int k = 0; k < 7; ++k) { const int i = tid + NTHR * k; if (i < XFER_PIECES) *(LAS v4u*)(L0 + xfer_lds_off(i)) = XR[k]; }
            __syncthreads();
            if (tid == 0) __hip_atomic_store(consw, (unsigned)(hj + 1), RLX_AGENT);
        }
        if (role == 0 && bi + 1 < NBT && (bi + 1) % 2 != 0) {
            const int hn = (bi + 1) >> 1;
            if (w == 0) wait_ge(prodw, (unsigned)(hn + 1), ctlw + CW_TMO, 0xA00u, lane);
            __syncthreads();
            const __amdgpu_buffer_rsrc_t rsl = __builtin_amdgcn_make_buffer_rsrc(ring, 0, XFER_SLOTS * XFER_SLOT_BYTES, 0x00020000);
            const unsigned sbl = (unsigned)((hn % XFER_SLOTS) * XFER_SLOT_BYTES);
#pragma unroll
            for (int k = 0; k < 7; ++k) { int i = tid + NTHR * k; i = i < XFER_PIECES ? i : XFER_PIECES - 1; XR[k] = __builtin_amdgcn_raw_buffer_load_b128(rsl, sbl + 16u * (unsigned)i, 0, 16); }
        }
        STP_END(241);
        STP_BEGIN(242);
#ifdef PROBE_S2
        f32x4 Ssv[4];
#pragma unroll
        for (int kt = 0; kt < 4; ++kt) Ssv[kt] = St[kt];
        for (int prb_ = 0; prb_ < 2; ++prb_) {
        if (prb_) {
#pragma unroll
            for (int kt = 0; kt < 4; ++kt) St[kt] = Ssv[kt]; }
#endif
        if (w < 4) {
#pragma unroll 1
            for (int q = 0; q < 4; ++q) {
                const bf16x4s z4s = {0, 0, 0, 0};
#define CAT2(p0, p1) __builtin_shufflevector(*(const LAS bf16x4s*)(p0), *(const LAS bf16x4s*)(p1), 0, 1, 2, 3, 4, 5, 6, 7)
#define PAD8(p0) __builtin_shufflevector(*(const LAS bf16x4s*)(p0), z4s, 0, 1, 2, 3, 4, 5, 6, 7)
                const bf16x4s vt4 = *(const LAS bf16x4s*)(Vt + (q * 64 + 16 * w + fr) * 16 + 4 * (fq ^ ((2 * w + (fr >> 3)) & 3)));
                const LAS bf16* atp = AT + (16 * q + fr) * TP + 4 * fq; const LAS bf16* rtp = RT + (16 * q + fr) * TP + 4 * fq;
                f32x4 x1 = {0.f, 0.f, 0.f, 0.f}, yv = {0.f, 0.f, 0.f, 0.f};
                { const bf16x8 s01 = __builtin_shufflevector(pack4(St[0]), pack4(St[1]), 0, 1, 2, 3, 4, 5, 6, 7), s23 = __builtin_shufflevector(pack4(St[2]), pack4(St[3]), 0, 1, 2, 3, 4, 5, 6, 7);
                  x1 = MFMA16(CAT2(atp, atp + 16), s01, x1); x1 = MFMA16(CAT2(atp + 32, atp + 48), s23, x1);
                  yv = MFMA16(CAT2(rtp, rtp + 16), s01, yv); yv = MFMA16(CAT2(rtp + 32, rtp + 48), s23, yv); }
                x1 = MFMA16(PAD8(LakB + (q * 16 + fr) * 16 + 4 * fq), __builtin_shufflevector(vt4, z4s, 0, 1, 2, 3, 4, 5, 6, 7), x1);
                const f32x4 u = MFMA16(PAD8(TtB + (q * 16 + fr) * 16 + 4 * fq), __builtin_shufflevector(pack4(x1), z4s, 0, 1, 2, 3, 4, 5, 6, 7), ((f32x4){0.f, 0.f, 0.f, 0.f}));
                const bf16x8 vu = __builtin_shufflevector(vt4, pack4(u), 0, 1, 2, 3, 4, 5, 6, 7);
                yv = MFMA16(CAT2(MrkB + (q * 16 + fr) * 16 + 4 * fq, MrbB + (q * 16 + fr) * 16 + 4 * fq), vu, yv);
#pragma unroll
                for (int i2 = 0; i2 < 4; ++i2) YB[(16 * q + 4 * fq + i2) * 64 + 16 * w + fr] = yv[i2];
#pragma unroll
                for (int kt = 0; kt < 4; ++kt)
                    St[kt] = MFMA16(CAT2(KH + (q * 64 + 16 * kt + fr) * 16 + 4 * (fq ^ ((2 * kt + (fr >> 3)) & 3)), BH + (q * 64 + 16 * kt + fr) * 16 + 4 * (fq ^ ((2 * kt + (fr >> 3)) & 3))), vu, St[kt] * *(const LAS f32x4*)(PCb + q * 64 + 16 * kt + 4 * fq));
#undef CAT2
#undef PAD8
            }
        }
#ifdef PROBE_S2
        __syncthreads(); }
#endif
        __syncthreads();
        STP_END(242);
        STP_BEGIN(243);
        if (need_out) {
            float y8[8];
#pragma unroll
            for (int j = 0; j < 8; ++j) y8[j] = YB[tk * 64 + c8 + j];
            *(v4u*)(YS + (size_t)row * 512 + gc) = pack8(y8);
        }
        STP_END(243);
    }
    __syncthreads();
}

constexpr int PL_CST = 0, PL_TW = 2560, PL_AL = PL_TW + 9216, PL_LW = PL_AL + 9216, PL_LA = PL_LW + 16384, PL_SET = PL_LA + 16384, PL_SETB = 52224, PL_END = PL_SET + 2 * PL_SETB;
static_assert(PL_END <= MISC_OFF, "pipelined scan LDS map");
__device__ __forceinline__ void scan_unit_pipe(const Params& P, const Frame& F, int l, int b, int h, int dir) {
    LAS unsigned char* L0 = F.lds;
    LAS float* CST = (LAS float*)(L0 + PL_CST);
    LAS bf16* TWb = (LAS bf16*)(L0 + PL_TW);
    LAS bf16* ALb = (LAS bf16*)(L0 + PL_AL);
    LAS bf16* BT = TWb; LAS bf16* KT = ALb;
    LAS float* LW = (LAS float*)(L0 + PL_LW);
    LAS float* LA = (LAS float*)(L0 + PL_LA);
    LAS float* CUM = LW; LAS float* LabF = LA;
    const int tid = F.tid, lane = F.lane, w = F.wave, fr = lane & 15, fq = lane >> 4;
    const int tk = tid >> 3, c8 = (tid & 7) * 8, gc = 64 * h + c8;
    const int ld = l * 2 + dir;
    if (tid < 64) { const int c = 64 * h + tid;
        CST[0 * 64 + tid] = P.in[I_MU][(size_t)(ld * 3 + 0) * 512 + c]; CST[1 * 64 + tid] = P.in[I_MU][(size_t)(ld * 3 + 1) * 512 + c]; CST[2 * 64 + tid] = P.in[I_MU][(size_t)(ld * 3 + 2) * 512 + c];
        CST[3 * 64 + tid] = P.in[I_MUW][ld * 64 + tid]; CST[4 * 64 + tid] = P.in[I_MUA][ld * 64 + tid];
        CST[5 * 64 + tid] = P.in[I_W0][ld * 512 + c]; CST[6 * 64 + tid] = P.in[I_A0][ld * 512 + c];
        CST[7 * 64 + tid] = P.in[I_KK][l * 512 + c]; CST[8 * 64 + tid] = P.in[I_KA][l * 512 + c]; CST[9 * 64 + tid] = P.in[I_RK][l * 512 + c]; }
    const bf16* Z = WSP(bf16, WS_Z);
    bf16* YS = WSP(bf16, WS_YS) + (size_t)dir * MT * 512;
    float* BONG = WSP(float, WS_BONG) + (size_t)dir * MT * 8;
    f32x4 St[4];
#pragma unroll
    for (int kt = 0; kt < 4; ++kt) St[kt] = (f32x4){0.f, 0.f, 0.f, 0.f};
    constexpr int NBT = LC / TB + SEQ / TB;
    ScanPre R; scan_prefetch(Z, 0, tk, b, dir, gc, c8, R);
    __syncthreads();
#define PL_CHAIN(q) do { if (w < 4 && it >= 1) { \
        const bf16x4s z4s = {0, 0, 0, 0}; \
        const LAS bf16* cBH = (const LAS bf16*)(cset); const LAS bf16* cKH = cBH + 4096; const LAS bf16* cVt = cKH + 4096; const LAS bf16* cAT = (const LAS bf16*)(cset + 24576); const LAS bf16* cRT = (const LAS bf16*)(cset + 33792); \
        const LAS bf16* cLak = (const LAS bf16*)(cset + 43008); const LAS bf16* cTt = cLak + 1024; const LAS bf16* cMrb = cTt + 1024; const LAS bf16* cMrk = cMrb + 1024; const LAS float* cPC = (const LAS float*)(cset + 51200); \
        const bf16x4s vt4 = *(const LAS bf16x4s*)(cVt + ((q) * 64 + 16 * w + fr) * 16 + 4 * fq); \
        const LAS bf16* atp = cAT + (16 * (q) + fr) * TP + 4 * fq; const LAS bf16* rtp = cRT + (16 * (q) + fr) * TP + 4 * fq; \
        f32x4 x1 = {0.f, 0.f, 0.f, 0.f}, yv = {0.f, 0.f, 0.f, 0.f}; \
        { const bf16x8 s01 = __builtin_shufflevector(pack4(St[0]), pack4(St[1]), 0, 1, 2, 3, 4, 5, 6, 7), s23 = __builtin_shufflevector(pack4(St[2]), pack4(St[3]), 0, 1, 2, 3, 4, 5, 6, 7); \
          x1 = MFMA16(PL_CAT2(atp, atp + 16), s01, x1); x1 = MFMA16(PL_CAT2(atp + 32, atp + 48), s23, x1); \
          yv = MFMA16(PL_CAT2(rtp, rtp + 16), s01, yv); yv = MFMA16(PL_CAT2(rtp + 32, rtp + 48), s23, yv); } \
        x1 = MFMA16(PL_PAD8(cLak + ((q) * 16 + fr) * 16 + 4 * fq), __builtin_shufflevector(vt4, z4s, 0, 1, 2, 3, 4, 5, 6, 7), x1); \
        const f32x4 u = MFMA16(PL_PAD8(cTt + ((q) * 16 + fr) * 16 + 4 * fq), __builtin_shufflevector(pack4(x1), z4s, 0, 1, 2, 3, 4, 5, 6, 7), ((f32x4){0.f, 0.f, 0.f, 0.f})); \
        const bf16x8 vu = __builtin_shufflevector(vt4, pack4(u), 0, 1, 2, 3, 4, 5, 6, 7); \
        yv = MFMA16(PL_CAT2(cMrk + ((q) * 16 + fr) * 16 + 4 * fq, cMrb + ((q) * 16 + fr) * 16 + 4 * fq), vu, yv); \
        _Pragma("unroll") for (int kt = 0; kt < 4; ++kt) { \
            St[kt] = MFMA16(PL_CAT2(cKH + ((q) * 64 + 16 * kt + fr) * 16 + 4 * fq, cBH + ((q) * 64 + 16 * kt + fr) * 16 + 4 * fq), vu, St[kt] * *(const LAS f32x4*)(cPC + (q) * 64 + 16 * kt + 4 * fq)); \
            if (kt & 1) __builtin_amdgcn_sched_barrier(0); } \
        if (cout_) { _Pragma("unroll") for (int i2 = 0; i2 < 4; ++i2) { bool hp2; int pr2; const int row2 = scan_row(it - 1, 16 * (q) + 4 * fq + i2, b, dir, hp2, pr2); \
            YS[(size_t)row2 * 512 + 64 * h + 16 * w + fr] = (bf16)f2bf(yv[i2]); } } \
    } } while (0)
#define PL_CAT2(p0, p1) __builtin_shufflevector(*(const LAS bf16x4s*)(p0), *(const LAS bf16x4s*)(p1), 0, 1, 2, 3, 4, 5, 6, 7)
#define PL_PAD8(p0) __builtin_shufflevector(*(const LAS bf16x4s*)(p0), z4s, 0, 1, 2, 3, 4, 5, 6, 7)
    for (int it = 0; it <= NBT; ++it) {
        const bool prep = it < NBT;
        const LAS unsigned char* cset = L0 + PL_SET + ((it - 1) & 1) * PL_SETB;
        LAS unsigned char* pset = L0 + PL_SET + (it & 1) * PL_SETB;
        const bool need_out = (it >= LC / TB) || (l == 0), cout_ = (it - 1 >= LC / TB) || (l == 0);
        LAS bf16* BH = (LAS bf16*)pset; LAS bf16* KH = BH + 4096; LAS bf16* Vt = KH + 4096; LAS bf16* AT = (LAS bf16*)(pset + 24576); LAS bf16* RT = (LAS bf16*)(pset + 33792);
        LAS bf16* LakB = (LAS bf16*)(pset + 43008); LAS bf16* TtB = LakB + 1024; LAS bf16* MrbB = TtB + 1024; LAS bf16* MrkB = MrbB + 1024; LAS float* PCb = (LAS float*)(pset + 51200);
        bool hp = false; int prow = 0; const int row = prep ? scan_row(it, tk, b, dir, hp, prow) : 0; (void)prow;
        float kx[8], vx[8], rx[8], na[8], pb[8], km[8];
#ifdef PROBE_ST1
        for (int prb_ = 0; prb_ < 2; ++prb_)
#endif
        if (prep) { float wl[8], al[8];
            lerp8(R.kc, R.kp, hp, CST + 0 * 64 + c8, kx); lerp8(R.vc, R.vp, hp, CST + 1 * 64 + c8, vx); lerp8(R.rc, R.rp, hp, CST + 2 * 64 + c8, rx);
            lerp8(R.wc, R.wp, hp, CST + 3 * 64 + c8, wl); lerp8(R.ac, R.ap, hp, CST + 4 * 64 + c8, al);
#pragma unroll
            for (int j = 0; j < 8; ++j) wl[j] = ftanh(wl[j]);
            *(LAS v4u*)(TWb + tk * TP + c8) = pack8(wl); *(LAS v4u*)(ALb + tk * TP + c8) = pack8(al);
        }
        __syncthreads();
        if (w >= 4) { if (prep) { const int nt = w - 4;
            int ll = lane; asm volatile("" : "+v"(ll));
            const size_t lo = ((size_t)ld * 512 + 64 * h + 16 * nt + (ll & 15)) * 64 + 8 * (ll >> 4);
            const bf16* w2g = WSP(bf16, WS_W2TG) + lo; const bf16* a2g = WSP(bf16, WS_A2TG) + lo;
            bf16x8 w2x[2], a2x[2];
#pragma unroll
            for (int k2 = 0; k2 < 2; ++k2) { w2x[k2] = *(const bf16x8*)(w2g + 32 * k2); a2x[k2] = *(const bf16x8*)(a2g + 32 * k2); }
#pragma unroll
            for (int mt = 0; mt < 4; ++mt) { f32x4 cw = {0.f, 0.f, 0.f, 0.f}, ca = {0.f, 0.f, 0.f, 0.f};
#pragma unroll
                for (int k2 = 0; k2 < 2; ++k2) { cw = MFMA16(w2x[k2], *(const LAS bf16x8*)(TWb + (16 * mt + fr) * TP + 32 * k2 + 8 * fq), cw); ca = MFMA16(a2x[k2], *(const LAS bf16x8*)(ALb + (16 * mt + fr) * TP + 32 * k2 + 8 * fq), ca); }
                *(LAS f32x4*)(LW + (16 * mt + fr) * 64 + 16 * nt + 4 * fq) = cw; *(LAS f32x4*)(LA + (16 * mt + fr) * 64 + 16 * nt + 4 * fq) = ca; } } }
        else PL_CHAIN(0);
        __syncthreads();
#ifdef PROBE_ST3
        float lwsv[8], lasv[8];
        if (prep) {
#pragma unroll
            for (int j = 0; j < 8; ++j) { lwsv[j] = LW[tk * 64 + c8 + j]; lasv[j] = LA[tk * 64 + c8 + j]; } }
        for (int prb_ = 0; prb_ < 2; ++prb_) {
        if (prb_ && prep) {
#pragma unroll
            for (int j = 0; j < 8; ++j) { LW[tk * 64 + c8 + j] = lwsv[j]; LA[tk * 64 + c8 + j] = lasv[j]; } }
#endif
        if (prep) {
            float n2 = 0.f, bon = 0.f, ew[8];
#pragma unroll
            for (int hf = 0; hf < 2; ++hf) {
#pragma unroll
                for (int j = 4 * hf; j < 4 * hf + 4; ++j) {
                    const float aw = LW[tk * 64 + c8 + j], aa = LA[tk * 64 + c8 + j];
                    ew[j] = 0.6065306597f * frcp(1.0f + fexp(-(CST[5 * 64 + c8 + j] + aw)));
                    const float ag = frcp(1.0f + fexp(-(CST[6 * 64 + c8 + j] + aa)));
                    const float kk = kx[j] * CST[7 * 64 + c8 + j]; n2 += kk * kk;
                    km[j] = kx[j] * (1.0f + (ag - 1.0f) * CST[8 * 64 + c8 + j]);
                    bon += rx[j] * km[j] * CST[9 * 64 + c8 + j];
                    na[j] = kk; pb[j] = ag;
                }
                __builtin_amdgcn_sched_barrier(0);
            }
            n2 = sum8(n2); bon = sum8(bon);
            const float inv = frcp(fmaxf(__builtin_amdgcn_sqrtf(n2), 1e-12f));
#pragma unroll
            for (int j = 0; j < 8; ++j) { const float kkn = na[j] * inv; na[j] = -kkn; pb[j] = kkn * pb[j]; }
            *(LAS f32x4*)(CUM + tk * 64 + c8) = (f32x4){ew[0], ew[1], ew[2], ew[3]} * 1.44269504089f; *(LAS f32x4*)(CUM + tk * 64 + c8 + 4) = (f32x4){ew[4], ew[5], ew[6], ew[7]} * 1.44269504089f;
            if ((tid & 7) == 0 && need_out) BONG[(size_t)row * 8 + h] = bon;
#pragma unroll
            for (int j = 0; j < 8; j += 2) { const unsigned wv = pk2(vx[j], vx[j + 1]); const int o = ((tk >> 4) * 64 + c8 + j) * 16 + (tk & 15); Vt[o] = (bf16)(wv & 0xffffu); Vt[o + 16] = (bf16)(wv >> 16); }
        }
#ifdef PROBE_ST3
        }
#endif
        __syncthreads();
        if (w >= 4) { if (prep) { const int t2 = tid - 256, q = t2 >> 6, ch = t2 & 63; float c = 0.f;
#pragma unroll
            for (int i = 0; i < 16; ++i) { c -= CUM[(16 * q + i) * 64 + ch]; const float p = __builtin_amdgcn_exp2f(c); CUM[(16 * q + i) * 64 + ch] = p; if (i == 15) PCb[q * 64 + ch] = p; } } }
        else PL_CHAIN(1);
        __syncthreads();
#ifdef PROBE_ST5
        for (int prb_ = 0; prb_ < 2; ++prb_)
#endif
        if (prep) {
            const int q = tk >> 4, tt = tk & 15;
            const f32x4 one4 = {1.f, 1.f, 1.f, 1.f};
            const f32x4 et0 = *(const LAS f32x4*)(CUM + tk * 64 + c8), et1 = *(const LAS f32x4*)(CUM + tk * 64 + c8 + 4);
            const f32x4 ep0 = tt ? *(const LAS f32x4*)(CUM + (tk - 1) * 64 + c8) : one4, ep1 = tt ? *(const LAS f32x4*)(CUM + (tk - 1) * 64 + c8 + 4) : one4;
            const f32x4 pc0 = *(const LAS f32x4*)(PCb + q * 64 + c8), pc1 = *(const LAS f32x4*)(PCb + q * 64 + c8 + 4);
            float ei8[8];
            { float t8[8];
#pragma unroll
              for (int j = 0; j < 8; ++j) t8[j] = na[j] * (j < 4 ? ep0[j & 3] : ep1[j & 3]);
              *(LAS v4u*)(AT + tk * TP + c8) = pack8(t8); }
            __builtin_amdgcn_sched_barrier(0);
            { float t8[8];
#pragma unroll
              for (int j = 0; j < 8; ++j) { const float et = j < 4 ? et0[j & 3] : et1[j & 3]; t8[j] = rx[j] * et; ei8[j] = frcp(et); }
              *(LAS v4u*)(RT + tk * TP + c8) = pack8(t8); }
            __builtin_amdgcn_sched_barrier(0);
            { float t8[8];
#pragma unroll
              for (int j = 0; j < 8; ++j) t8[j] = pb[j] * ei8[j];
              *(LAS v4u*)(BT + tk * TP + c8) = pack8(t8); }
            __builtin_amdgcn_sched_barrier(0);
            { float t8[8];
#pragma unroll
              for (int j = 0; j < 8; ++j) t8[j] = km[j] * ei8[j];
              *(LAS v4u*)(KT + tk * TP + c8) = pack8(t8); }
            __builtin_amdgcn_sched_barrier(0);
#pragma unroll
            for (int j = 0; j < 8; j += 2) { const float eh0 = (j < 4 ? pc0[j & 3] : pc1[j & 3]) * ei8[j], eh1 = (j + 1 < 4 ? pc0[(j + 1) & 3] : pc1[(j + 1) & 3]) * ei8[j + 1];
                const unsigned wb = pk2(pb[j] * eh0, pb[j + 1] * eh1), wk = pk2(km[j] * eh0, km[j + 1] * eh1); const int o = (q * 64 + c8 + j) * 16 + tt;
                BH[o] = (bf16)(wb & 0xffffu); BH[o + 16] = (bf16)(wb >> 16); KH[o] = (bf16)(wk & 0xffffu); KH[o + 16] = (bf16)(wk >> 16); }
        }
        __syncthreads();
        if (it + 1 < NBT) scan_prefetch(Z, it + 1, tk, b, dir, gc, c8, R);
        if (w >= 4) { if (prep) { const int q = w - 4;
#pragma unroll
            for (int rsel = 0; rsel < 2; ++rsel) {
                const LAS bf16* YR = rsel ? RT : AT;
                f32x4 cb = {0.f, 0.f, 0.f, 0.f}, ck = {0.f, 0.f, 0.f, 0.f};
#pragma unroll
                for (int k2 = 0; k2 < 2; ++k2) { const bf16x8 yf = *(const LAS bf16x8*)(YR + (16 * q + fr) * TP + 32 * k2 + 8 * fq);
                    cb = MFMA16(*(const LAS bf16x8*)(BT + (16 * q + fr) * TP + 32 * k2 + 8 * fq), yf, cb);
                    ck = MFMA16(*(const LAS bf16x8*)(KT + (16 * q + fr) * TP + 32 * k2 + 8 * fq), yf, ck); }
#pragma unroll
                for (int i2 = 0; i2 < 4; ++i2) { const int i = 4 * fq + i2; const bool keep = rsel ? (i <= fr) : (i < fr); if (!keep) { cb[i2] = 0.f; ck[i2] = 0.f; } }
                if (rsel == 0) { *(LAS f32x4*)(LabF + (q * 16 + fr) * 16 + 4 * fq) = cb; *(LAS bf16x4s*)(LakB + (q * 16 + fr) * 16 + 4 * fq) = pack4(ck); }
                else { *(LAS bf16x4s*)(MrbB + (q * 16 + fr) * 16 + 4 * fq) = pack4(cb); *(LAS bf16x4s*)(MrkB + (q * 16 + fr) * 16 + 4 * fq) = pack4(ck); } } } }
        else PL_CHAIN(2);
        __syncthreads();
        if (w == 4) { if (prep) { const int q = lane >> 4, c = lane & 15; float T[16];
#pragma unroll
            for (int t = 0; t < 16; ++t) { float sacc = (t == c) ? 1.f : 0.f;
#pragma unroll
                for (int i = 0; i < t; ++i) sacc += LabF[(q * 16 + t) * 16 + i] * T[i];
                T[t] = sacc; TtB[(q * 16 + t) * 16 + c] = (bf16)f2bf(sacc); } } }
        else if (w < 4) PL_CHAIN(3);
        __syncthreads();
    }
#undef PL_CHAIN
#undef PL_CAT2
#undef PL_PAD8
}

__device__ __forceinline__ void conv_items(const Params& P, const Frame& F, int l, int nrows, int ob, int nob) {
    const bf16* Z = WSP(bf16, WS_Z); bf16* YM = WSP(bf16, WS_H);
    const float* cw = P.in[I_CONVW] + l * 768;
    const int ch = (F.tid & 31) * 8, stride = nob * NTHR, n = nrows * 32;
    asm volatile("" ::: "memory"); __builtin_amdgcn_sched_barrier(0);
    float wt[3][8];
#pragma unroll
    for (int k = 0; k < 3; ++k) { const f32x4 a = *(const f32x4*)(cw + 256 * k + ch), b = *(const f32x4*)(cw + 256 * k + ch + 4);
        wt[k][0] = a.x; wt[k][1] = a.y; wt[k][2] = a.z; wt[k][3] = a.w; wt[k][4] = b.x; wt[k][5] = b.y; wt[k][6] = b.z; wt[k][7] = b.w; }
    v4u nu0, nu1, nu2, ng0, ng1, ng2, ngb;
    auto nbr = [&](int row, bool& hp, bool& hn) { if (row < NT) { const int col = row & 63; hp = col != 0; hn = col != 63; } else { const int t = (row - NT) & 255; hp = t != 0; hn = t != 255; } };
    auto fetch = [&](int idx) { const int row = idx >> 5; bool hp, hn; nbr(row, hp, hn);
        const bf16* zr = Z + (size_t)row * NZ + ch; const bf16* zp = hp ? zr - NZ : zr; const bf16* zn = hn ? zr + NZ : zr;
        nu1 = *(const v4u*)(zr + C_U); ng1 = *(const v4u*)(zr + C_GC); ngb = *(const v4u*)(zr + C_GB);
        nu0 = *(const v4u*)(zp + C_U); ng0 = *(const v4u*)(zp + C_GC); nu2 = *(const v4u*)(zn + C_U); ng2 = *(const v4u*)(zn + C_GC); };
    int idx = ob * NTHR + F.tid;
    if (idx < n) fetch(idx);
    for (; idx < n; idx += stride) {
        const int row = idx >> 5; bool hp, hn; nbr(row, hp, hn);
        const v4u u1 = nu1, g1 = ng1, gb = ngb, z4 = {0u, 0u, 0u, 0u};
        const v4u u0 = hp ? nu0 : z4, g0 = hp ? ng0 : z4, u2 = hn ? nu2 : z4, g2 = hn ? ng2 : z4;
        if (idx + stride < n) fetch(idx + stride);
        v4u o;
#pragma unroll
        for (int q = 0; q < 4; ++q) {
            const float lo = bflo(gb[q]) * (wt[0][2 * q] * bflo(g0[q]) * bflo(u0[q]) + wt[1][2 * q] * bflo(g1[q]) * bflo(u1[q]) + wt[2][2 * q] * bflo(g2[q]) * bflo(u2[q]));
            const float hi = bfhi(gb[q]) * (wt[0][2 * q + 1] * bfhi(g0[q]) * bfhi(u0[q]) + wt[1][2 * q + 1] * bfhi(g1[q]) * bfhi(u1[q]) + wt[2][2 * q + 1] * bfhi(g2[q]) * bfhi(u2[q]));
            o[q] = pk2(lo, hi);
        }
        *(v4u*)(YM + (size_t)row * D + 512 + ch) = o;
    }
    asm volatile("" ::: "memory"); __builtin_amdgcn_sched_barrier(0);
}

__device__ __forceinline__ void load_tab64(LAS bf16* dst, const bf16* src, int tid) {
    for (int i = tid; i < 512; i += NTHR) { const int r = i >> 3, c = (i & 7) * 8; *(LAS v4u*)(dst + r * TP + c) = *(const v4u*)(src + r * 64 + c); }
}
__device__ __forceinline__ bf16x8 ldsfrag(const LAS bf16* base, int row, int col) { return *(const LAS bf16x8*)(base + row * TP + col); }
__device__ __forceinline__ void fourier_a_iter(const Params& P, const Frame& F, int it) {
    const int bg = it >> 3, j = it & 7, b = bg >> 2, g = bg & 3, w = F.wave, lane = F.lane, fr = lane & 15, fq = lane >> 4, p2 = 8 * j + w;
    LAS bf16* TC64 = (LAS bf16*)F.lds; LAS bf16* TS64 = TC64 + 64 * TP; LAS bf16* TN64 = TS64 + 64 * TP;
    LAS bf16* PT = TN64 + 64 * TP + w * (64 * TP);
    load_tab64(TC64, WSP(bf16, TAB_C64), F.tid); load_tab64(TS64, WSP(bf16, TAB_S64), F.tid); load_tab64(TN64, WSP(bf16, TAB_SN64), F.tid);
    const bf16* Z = WSP(bf16, WS_Z);
    __syncthreads();
    f32x4 Yr[4][4], Yi[4][4];
#pragma unroll
    for (int a = 0; a < 4; ++a)
#pragma unroll
        for (int c = 0; c < 4; ++c) { Yr[a][c] = (f32x4){0.f, 0.f, 0.f, 0.f}; Yi[a][c] = (f32x4){0.f, 0.f, 0.f, 0.f}; }
    bf16x8 Fall[4][2];
#pragma unroll
    for (int xt = 0; xt < 4; ++xt)
#pragma unroll
        for (int ks = 0; ks < 2; ++ks) Fall[xt][ks] = *(const bf16x8*)(Z + (size_t)(b * SEQ + 64 * (16 * xt + fr) + p2) * NZ + C_F + 64 * g + 32 * ks + 8 * fq);
#pragma unroll
    for (int pass = 0; pass < 2; ++pass) {
        const LAS bf16* T1 = pass == 0 ? TC64 : TS64;
#pragma unroll
        for (int xt = 0; xt < 4; ++xt) {
            bf16x8 Ff[2]; Ff[0] = Fall[xt][0]; Ff[1] = Fall[xt][1];
#pragma unroll
            for (int yt = 0; yt < 4; ++yt) {
                f32x4 acc = {0.f, 0.f, 0.f, 0.f};
#pragma unroll
                for (int ks = 0; ks < 2; ++ks) acc = MFMA16(Ff[ks], ldsfrag(T1, 16 * yt + fr, 32 * ks + 8 * fq), acc);
                v2u wv; wv.x = pk2(acc.x, acc.y); wv.y = pk2(acc.z, acc.w);
                *(LAS v2u*)(PT + (16 * yt + fr) * TP + 16 * xt + 4 * fq) = wv;
            }
            __builtin_amdgcn_sched_barrier(0);
        }
        LDS_WAIT(); asm volatile("" ::: "memory");
        const LAS bf16* TA = pass == 0 ? TC64 : TN64;
        const LAS bf16* TB = pass == 0 ? TS64 : TC64;
#pragma unroll
        for (int ks = 0; ks < 2; ++ks) {
            bf16x8 pf[4];
#pragma unroll
            for (int yt = 0; yt < 4; ++yt) pf[yt] = ldsfrag(PT, 16 * yt + fr, 32 * ks + 8 * fq);
#pragma unroll
            for (int xt = 0; xt < 4; ++xt) { const bf16x8 ta = ldsfrag(TA, 16 * xt + fr, 32 * ks + 8 * fq), tb = ldsfrag(TB, 16 * xt + fr, 32 * ks + 8 * fq);
#pragma unroll
                for (int yt = 0; yt < 4; ++yt) { Yr[xt][yt] = MFMA16(ta, pf[yt], Yr[xt][yt]); Yi[xt][yt] = MFMA16(tb, pf[yt], Yi[xt][yt]); }
                __builtin_amdgcn_sched_barrier(0); }
        }
        LDS_WAIT(); asm volatile("" ::: "memory");
    }
    const float* twc = WSP(float, TAB_TWC); const float* tws = WSP(float, TAB_TWS);
    float tcv[4][4], tsv[4][4];
#pragma unroll
    for (int xt = 0; xt < 4; ++xt)
#pragma unroll
        for (int i = 0; i < 4; ++i) { const int m = (p2 * (16 * xt + 4 * fq + i)) & 4095; tcv[xt][i] = twc[m]; tsv[xt][i] = tws[m]; }
    __syncthreads();
    LAS bf16* EX = (LAS bf16*)F.lds;
    const int ws = w ^ (2 * fq);
#pragma unroll
    for (int xt = 0; xt < 4; ++xt)
#pragma unroll
        for (int i = 0; i < 4; ++i) { const int q1 = 16 * xt + 4 * fq + i; const float tc = tcv[xt][i], ts = tsv[xt][i];
#pragma unroll
            for (int yt = 0; yt < 4; ++yt) { const float yr = Yr[xt][yt][i], yi = Yi[xt][yt][i]; const int cp = 16 * yt + fr;
                EX[((q1 * 2 + 0) * 64 + cp) * 8 + ws] = (bf16)f2bf(yr * tc - yi * ts);
                EX[((q1 * 2 + 1) * 64 + cp) * 8 + ws] = (bf16)f2bf(-yi * tc - yr * ts); }
            __builtin_amdgcn_sched_barrier(0); }
    __syncthreads();
    bf16* YB = WSP(bf16, WS_YBUF) + (size_t)bg * (64 * 2 * 64 * 64);
#pragma unroll 4
    for (int n = 0; n < 16; ++n) { const int q = F.tid + NTHR * n, f = (q >> 9) & 3;
        const v4u e = *(const LAS v4u*)(EX + q * 8); v4u o;
        o.x = f == 0 ? e.x : (f == 1 ? e.y : (f == 2 ? e.z : e.w)); o.y = f == 0 ? e.y : (f == 1 ? e.x : (f == 2 ? e.w : e.z));
        o.z = f == 0 ? e.z : (f == 1 ? e.w : (f == 2 ? e.x : e.y)); o.w = f == 0 ? e.w : (f == 1 ? e.z : (f == 2 ? e.y : e.x));
        *(v4u*)(YB + (size_t)q * 64 + 8 * j) = o; }
    __syncthreads();
}
__device__ __forceinline__ void fourier_b_unit(const Params& P, const Frame& F, int u, const LAS bf16* TC64, const LAS bf16* TS64) {
    const int bg = u >> 6, s2 = u & 63, b = bg >> 2, g = bg & 3, lane = F.lane, fr = lane & 15, fq = lane >> 4;
    const bf16* YB = WSP(bf16, WS_YBUF) + (size_t)bg * (64 * 2 * 64 * 64) + (size_t)s2 * (2 * 64 * 64);
    f32x4 acc[4][4];
#pragma unroll
    for (int a = 0; a < 4; ++a)
#pragma unroll
        for (int c = 0; c < 4; ++c) acc[a][c] = (f32x4){0.f, 0.f, 0.f, 0.f};
#pragma unroll
    for (int ks = 0; ks < 4; ++ks) { const int ri = ks >> 1, pb = (ks & 1) * 32;
        bf16x8 xf[4];
#pragma unroll
        for (int xt = 0; xt < 4; ++xt) xf[xt] = *(const bf16x8*)(YB + (size_t)(ri * 64 + 16 * xt + fr) * 64 + pb + 8 * fq);
        const LAS bf16* T = ri ? TS64 : TC64;
#pragma unroll
        for (int yt = 0; yt < 4; ++yt) { const bf16x8 tf = ldsfrag(T, 16 * yt + fr, pb + 8 * fq);
#pragma unroll
            for (int xt = 0; xt < 4; ++xt) acc[xt][yt] = MFMA16(xf[xt], tf, acc[xt][yt]); }
    }
    bf16* YM = WSP(bf16, WS_H);
#pragma unroll
    for (int yt = 0; yt < 4; ++yt) { const int s1 = 16 * yt + fr; bf16* rowp = YM + (size_t)(b * SEQ + 64 * s1 + s2) * D + 768 + 64 * g;
#pragma unroll
        for (int xt = 0; xt < 4; ++xt) { const f32x4 a = acc[xt][yt] * (1.0f / 512.0f); v2u wv; wv.x = pk2(a.x, a.y); wv.y = pk2(a.z, a.w); *(v2u*)(rowp + 16 * xt + 4 * fq) = wv; } }
}
constexpr int TP2 = 264;
__device__ __forceinline__ void fourier_ctx_unit(const Params& P, const Frame& F, int bg) {
    const int b = bg >> 2, g = bg & 3, w = F.wave, lane = F.lane, fr = lane & 15, fq = lane >> 4;
    LAS bf16* TC64 = (LAS bf16*)F.lds; LAS bf16* TS64 = TC64 + 64 * TP;
    LAS bf16* PT = TS64 + 64 * TP; LAS bf16* QT = PT + 64 * TP2;
    load_tab64(TC64, WSP(bf16, TAB_C64), F.tid); load_tab64(TS64, WSP(bf16, TAB_S64), F.tid);
    const bf16* Z = WSP(bf16, WS_Z);
    bf16x8 Ff[2][2];
#pragma unroll
    for (int xt = 0; xt < 2; ++xt)
#pragma unroll
        for (int ks = 0; ks < 2; ++ks) Ff[xt][ks] = *(const bf16x8*)(Z + (size_t)(NT + b * LC + 32 * w + 16 * xt + fr) * NZ + C_F + 64 * g + 32 * ks + 8 * fq);
    __syncthreads();
#pragma unroll
    for (int xt = 0; xt < 2; ++xt)
#pragma unroll
        for (int yt = 0; yt < 4; ++yt) {
            f32x4 ap = {0.f, 0.f, 0.f, 0.f}, aq = {0.f, 0.f, 0.f, 0.f};
#pragma unroll
            for (int ks = 0; ks < 2; ++ks) { ap = MFMA16(Ff[xt][ks], ldsfrag(TC64, 16 * yt + fr, 32 * ks + 8 * fq), ap); aq = MFMA16(Ff[xt][ks], ldsfrag(TS64, 16 * yt + fr, 32 * ks + 8 * fq), aq); }
            v2u wp, wq; wp.x = pk2(ap.x, ap.y); wp.y = pk2(ap.z, ap.w); wq.x = pk2(aq.x, aq.y); wq.y = pk2(aq.z, aq.w);
            *(LAS v2u*)(PT + (16 * yt + fr) * TP2 + 32 * w + 16 * xt + 4 * fq) = wp; *(LAS v2u*)(QT + (16 * yt + fr) * TP2 + 32 * w + 16 * xt + 4 * fq) = wq;
        }
    __syncthreads();
    const bf16* C256 = WSP(bf16, WS_C256); const bf16* SN256 = WSP(bf16, WS_SN256);
    f32x4 acc[4][2];
#pragma unroll
    for (int a = 0; a < 4; ++a)
#pragma unroll
        for (int c = 0; c < 2; ++c) acc[a][c] = (f32x4){0.f, 0.f, 0.f, 0.f};
#pragma unroll 2
    for (int ks = 0; ks < 8; ++ks) {
        bf16x8 cf[2], sf[2];
#pragma unroll
        for (int yt = 0; yt < 2; ++yt) { cf[yt] = *(const bf16x8*)(C256 + (size_t)(32 * w + 16 * yt + fr) * 256 + 32 * ks + 8 * fq); sf[yt] = *(const bf16x8*)(SN256 + (size_t)(32 * w + 16 * yt + fr) * 256 + 32 * ks + 8 * fq); }
#pragma unroll
        for (int xt = 0; xt < 4; ++xt) { const bf16x8 pf = *(const LAS bf16x8*)(PT + (16 * xt + fr) * TP2 + 32 * ks + 8 * fq), qf = *(const LAS bf16x8*)(QT + (16 * xt + fr) * TP2 + 32 * ks + 8 * fq);
#pragma unroll
            for (int yt = 0; yt < 2; ++yt) { acc[xt][yt] = MFMA16(pf, cf[yt], acc[xt][yt]); acc[xt][yt] = MFMA16(qf, sf[yt], acc[xt][yt]); } }
    }
    bf16* YM = WSP(bf16, WS_H);
#pragma unroll
    for (int yt = 0; yt < 2; ++yt) { bf16* rowp = YM + (size_t)(NT + b * LC + 32 * w + 16 * yt + fr) * D + 768 + 64 * g;
#pragma unroll
        for (int xt = 0; xt < 4; ++xt) { const f32x4 a = acc[xt][yt] * (1.0f / 128.0f); v2u wv; wv.x = pk2(a.x, a.y); wv.y = pk2(a.z, a.w); *(v2u*)(rowp + 16 * xt + 4 * fq) = wv; } }
    __syncthreads();
}

constexpr int GP = 136;
__device__ __forceinline__ void finalize_phase(const Params& P, const Frame& F, int l, int nrows) {
    LAS bf16* G2 = (LAS bf16*)F.lds;
    LAS float* WF = (LAS float*)(F.lds + 512 * GP * 2);
    const bf16* g2t = WSP(bf16, WS_G2T) + (size_t)l * 512 * 128;
    for (int i = F.tid; i < 512 * 16; i += NTHR) { const int r = i >> 4, c = (i & 15) * 8, rl = (r & ~63) + 16 * ((r >> 2) & 3) + 4 * ((r >> 4) & 3) + (r & 3); *(LAS v4u*)(G2 + rl * GP + c) = *(const v4u*)(g2t + r * 128 + c); }
    for (int i = F.tid; i < 4 * 128; i += NTHR) { const int wh = i >> 7, c = (i & 127) * 4;
        const float* src = wh < 2 ? P.in[I_MU] + (size_t)((l * 2 + wh) * 3 + 1) * 512 + c : (wh == 2 ? P.in[I_GNW] + l * 512 + c : P.in[I_GNB] + l * 512 + c);
        *(LAS f32x4*)(WF + wh * 512 + c) = *(const f32x4*)src; }
    __syncthreads();
    const int gw = F.bx * NWAVES + F.wave, NGW = F.G * NWAVES, lane = F.lane, fr = lane & 15, fq = lane >> 4;
    const bf16* Z = WSP(bf16, WS_Z); const bf16* YSb = WSP(bf16, WS_YS); const float* BONG = WSP(float, WS_BONG); bf16* YM = WSP(bf16, WS_H);
    const int nu = (nrows / 16) * 4;
    const int nq = gw < nu ? ((nu - 1 - gw) / NGW + 1) * 2 : 0;
    v4u yn[2][2], vcn[2], vpn[2], vnn[2]; float bonn[2]; v4u zvn[4];
    auto fetch = [&](int q) {
        const int u = gw + (q >> 1) * NGW, row = (u >> 2) * 16 + fr, head = 2 * (u & 3) + (q & 1);
        int t, len; if (row < NT) { t = row & (SEQ - 1); len = SEQ; } else { t = (row - NT) & (LC - 1); len = LC; }
        const int rp = t > 0 ? row - 1 : row, rn = t + 1 < len ? row + 1 : row;
        if ((q & 1) == 0) {
#pragma unroll
            for (int ks = 0; ks < 4; ++ks) zvn[ks] = *(const v4u*)(Z + (size_t)row * NZ + C_GLO + 32 * ks + 8 * fq); }
#pragma unroll
        for (int dir = 0; dir < 2; ++dir) { const bf16* ys = YSb + ((size_t)dir * MT + row) * 512 + 64 * head + 16 * fq;
#pragma unroll
            for (int h = 0; h < 2; ++h) yn[dir][h] = *(const v4u*)(ys + 8 * h);
            bonn[dir] = BONG[((size_t)dir * MT + row) * 8 + head]; }
#pragma unroll
        for (int h = 0; h < 2; ++h) { const int ch = C_V + 64 * head + 16 * fq + 8 * h;
            vcn[h] = *(const v4u*)(Z + (size_t)row * NZ + ch); vpn[h] = *(const v4u*)(Z + (size_t)rp * NZ + ch); vnn[h] = *(const v4u*)(Z + (size_t)rn * NZ + ch); }
    };
    auto up4 = [](const v4u (&w)[2], int j) -> f32x4 { const v4u q = w[j >> 1]; const unsigned lo = (j & 1) ? q.z : q.x, hi = (j & 1) ? q.w : q.y; return (f32x4){bflo(lo), bfhi(lo), bflo(hi), bfhi(hi)}; };
    bf16x8 sf[4];
    if (nq > 0) fetch(0);
    for (int q = 0; q < nq; ++q) {
        const int u = gw + (q >> 1) * NGW, row = (u >> 2) * 16 + fr, head = 2 * (u & 3) + (q & 1);
        int t, len; if (row < NT) { t = row & (SEQ - 1); len = SEQ; } else { t = (row - NT) & (LC - 1); len = LC; }
        const bool hprev = t > 0, hnext = t + 1 < len;
        if ((q & 1) == 0) {
#pragma unroll
            for (int ks = 0; ks < 4; ++ks) { v4u o;
#pragma unroll
                for (int k = 0; k < 4; ++k) o[k] = pk2(sigmoidf_(bflo(zvn[ks][k])), sigmoidf_(bfhi(zvn[ks][k])));
                sf[ks] = __builtin_bit_cast(bf16x8, o); } }
        f32x4 y[2][4], vc[4], vnb[2][4]; float bon[2];
#pragma unroll
        for (int j = 0; j < 4; ++j) { y[0][j] = up4(yn[0], j); y[1][j] = up4(yn[1], j); vc[j] = up4(vcn, j);
            vnb[0][j] = hprev ? up4(vpn, j) : (f32x4){0.f, 0.f, 0.f, 0.f}; vnb[1][j] = hnext ? up4(vnn, j) : (f32x4){0.f, 0.f, 0.f, 0.f}; }
        bon[0] = bonn[0]; bon[1] = bonn[1];
        if (q + 1 < nq) fetch(q + 1);
        f32x4 acc[4];
#pragma unroll
        for (int j = 0; j < 4; ++j) acc[j] = (f32x4){0.f, 0.f, 0.f, 0.f};
#pragma unroll
        for (int ks = 0; ks < 4; ++ks)
#pragma unroll
            for (int j = 0; j < 4; ++j) acc[j] = MFMA16(*(const LAS bf16x8*)(G2 + (64 * head + 16 * j + fr) * GP + 32 * ks + 8 * fq), sf[ks], acc[j]);
        f32x4 osum[4];
#pragma unroll
        for (int j = 0; j < 4; ++j) osum[j] = (f32x4){0.f, 0.f, 0.f, 0.f};
#pragma unroll
        for (int dir = 0; dir < 2; ++dir) {
            float s = 0.f;
#pragma unroll
            for (int j = 0; j < 4; ++j) s += (y[dir][j].x + y[dir][j].y) + (y[dir][j].z + y[dir][j].w);
            s += __shfl_xor(s, 16); s += __shfl_xor(s, 32);
            const float mean = s * (1.0f / 64.0f); float q2 = 0.f;
#pragma unroll
            for (int j = 0; j < 4; ++j) { y[dir][j] = y[dir][j] - mean; q2 += (y[dir][j].x * y[dir][j].x + y[dir][j].y * y[dir][j].y) + (y[dir][j].z * y[dir][j].z + y[dir][j].w * y[dir][j].w); }
            q2 += __shfl_xor(q2, 16); q2 += __shfl_xor(q2, 32);
            const float rstd = rsqrtf(q2 * (1.0f / 64.0f) + GN_EPS);
#pragma unroll
            for (int j = 0; j < 4; ++j) { const int ch = 64 * head + 16 * fq + 4 * j;
                const f32x4 mv = *(const LAS f32x4*)(WF + dir * 512 + ch), gw4 = *(const LAS f32x4*)(WF + 1024 + ch), gb4 = *(const LAS f32x4*)(WF + 1536 + ch);
                const f32x4 vx = vc[j] + (vnb[dir][j] - vc[j]) * mv;
                osum[j] += y[dir][j] * rstd * gw4 + gb4 + bon[dir] * vx; }
        }
#pragma unroll
        for (int h = 0; h < 2; ++h) { const f32x4 o0 = osum[2 * h] * acc[2 * h], o1 = osum[2 * h + 1] * acc[2 * h + 1];
            v4u wv; wv.x = pk2(o0.x, o0.y); wv.y = pk2(o0.z, o0.w); wv.z = pk2(o1.x, o1.y); wv.w = pk2(o1.z, o1.w); *(v4u*)(YM + (size_t)row * D + 64 * head + 16 * fq + 8 * h) = wv; }
    }
    __syncthreads();
}

struct MoePlan { int pb[9]; };
__device__ __forceinline__ void moe_plan(const Params& P, MoePlan& M, int (&cnt)[NE]) {
    int acc = 0;
#pragma unroll
    for (int e = 0; e < NE; ++e) { cnt[e] = (int)__hip_atomic_load(WSP(unsigned, WS_CTL) + CW_CNT + 64 * e, __ATOMIC_RELAXED, __HIP_MEMORY_SCOPE_AGENT); M.pb[e] = acc; acc += (cnt[e] + 255) >> 8; }
    M.pb[8] = acc;
}
__device__ __forceinline__ void moe_plan_block(const Params& P, const Frame& F, MoePlan& M, int (&cnt)[NE]) {
    LAS int* PC = (LAS int*)F.lds + 192;
    __syncthreads();
    if (F.wave == 0 && F.lane < NE) PC[F.lane] = (int)__hip_atomic_load(WSP(unsigned, WS_CTL) + CW_CNT + 64 * F.lane, __ATOMIC_RELAXED, __HIP_MEMORY_SCOPE_AGENT);
    __syncthreads();
    int acc = 0;
#pragma unroll
    for (int e = 0; e < NE; ++e) { cnt[e] = PC[e]; M.pb[e] = acc; acc += (cnt[e] + 255) >> 8; }
    M.pb[8] = acc;
    __syncthreads();
}
__device__ __forceinline__ void moe_assign_gather(const Params& P, const Frame& F) {
    MoePlan M; int cnt[NE]; moe_plan_block(P, F, M, cnt);
    const int gw = F.bx * NWAVES + F.wave, NGW = F.G * NWAVES, lane = F.lane;
    const bf16* H = WSP(bf16, WS_H); bf16* XG = WSP(bf16, WS_XG);
    unsigned* fill = WSP(unsigned, WS_CTL) + CW_FILL;
    LAS int* WC = (LAS int*)F.lds;
    LAS int* WB = WC + 64;
    __syncthreads();
    for (int it0 = F.bx * NWAVES; it0 < NT / 16; it0 += NGW) {
        const int it = it0 + F.wave;
        const int tok = it * 16 + (lane & 15); const bool act = lane < 16;
        const int4 rt = *(const int4*)(P.ws + WS_ROUTE + (size_t)tok * 16);
        const int es[2] = {act ? (rt.x & 255) : 255, act ? ((rt.x >> 8) & 255) : 255};
        unsigned long long m0[NE], m1[NE];
#pragma unroll
        for (int e = 0; e < NE; ++e) { m0[e] = __ballot(es[0] == e); m1[e] = __ballot(es[1] == e); }
        if (lane < NE) { int c = 0;
#pragma unroll
            for (int e = 0; e < NE; ++e) if (lane == e) c = __popcll(m0[e]) + __popcll(m1[e]);
            WC[F.wave * 8 + lane] = c; }
        __syncthreads();
        if (F.wave == 0 && lane < NE) { int tot = 0, off[NWAVES];
#pragma unroll
            for (int w = 0; w < NWAVES; ++w) { off[w] = tot; tot += WC[w * 8 + lane]; }
            const unsigned base = tot ? __hip_atomic_fetch_add(fill + 64 * lane, (unsigned)tot, __ATOMIC_RELAXED, __HIP_MEMORY_SCOPE_AGENT) : 0u;
            WB[lane] = (int)base;
#pragma unroll
            for (int w = 0; w < NWAVES; ++w) WC[w * 8 + lane] = off[w]; }
        __syncthreads();
        int pos[2] = {0, 0};
#pragma unroll
        for (int e = 0; e < NE; ++e) { const int b0 = M.pb[e] * 256 + WB[e] + WC[F.wave * 8 + e];
            if (es[0] == e) pos[0] = b0 + __popcll(m0[e] & ((1ull << lane) - 1ull));
            if (es[1] == e) pos[1] = b0 + __popcll(m0[e]) + __popcll(m1[e] & ((1ull << lane) - 1ull)); }
        __syncthreads();
        if (act) *(int2*)(P.ws + WS_TOKPOS + (size_t)tok * 8) = make_int2(pos[0], pos[1]);
#pragma unroll 1
        for (int i0 = 0; i0 < 16; i0 += 8) {
            v4u a[8], b[8]; int d0[8], d1[8];
#pragma unroll
            for (int i = 0; i < 8; ++i) { const int t = it * 16 + i0 + i; d0[i] = __shfl(pos[0], i0 + i); d1[i] = __shfl(pos[1], i0 + i);
                a[i] = *(const v4u*)(H + (size_t)t * D + 8 * lane); b[i] = *(const v4u*)(H + (size_t)t * D + 512 + 8 * lane); }
#pragma unroll
            for (int i = 0; i < 8; ++i) {
                *(v4u*)(XG + (size_t)d0[i] * D + 8 * lane) = a[i]; *(v4u*)(XG + (size_t)d0[i] * D + 512 + 8 * lane) = b[i];
                *(v4u*)(XG + (size_t)d1[i] * D + 8 * lane) = a[i]; *(v4u*)(XG + (size_t)d1[i] * D + 512 + 8 * lane) = b[i]; }
        }
    }
#pragma unroll
    for (int e = 0; e < NE; ++e) {
        const int r0 = M.pb[e] * 256 + cnt[e], r1 = M.pb[e + 1] * 256;
        for (int r = r0 + gw; r < r1; r += NGW) { *(v4u*)(XG + (size_t)r * D + 8 * lane) = (v4u){0u, 0u, 0u, 0u}; *(v4u*)(XG + (size_t)r * D + 512 + 8 * lane) = (v4u){0u, 0u, 0u, 0u}; }
    }
}

__device__ __forceinline__ Frame make_frame(LAS unsigned char* lds, int wave0) {
    Frame F; int tid = wave0 * 64 + (int)__builtin_amdgcn_mbcnt_hi(~0u, __builtin_amdgcn_mbcnt_lo(~0u, 0u)), G = gridDim.x, bx = blockIdx.x;
    asm volatile("" : "+v"(tid)); asm volatile("" : "+s"(G)); asm volatile("" : "+s"(bx));
    F.lds = lds; F.tid = tid; F.lane = tid & 63; F.wave = __builtin_amdgcn_readfirstlane(tid >> 6); F.G = G; F.bx = bx; return F;
}
#define CAS __attribute__((address_space(4)))
#define WSQ(T, off) ((T*)(Q.ws + (off)))
#if defined(__HIP_DEVICE_COMPILE__)
__device__ __forceinline__ Params load_params() { const CAS void* p = (const CAS void*)__builtin_amdgcn_kernarg_segment_ptr(); asm volatile("" : "+s"(p)); return *(const CAS Params*)p; }
#else
__device__ __forceinline__ Params load_params() { return Params{}; }
#endif
#ifndef PG8_SP2
#define PG8_SP2 true
#endif
#ifndef PG8_ALIGN
#define PG8_ALIGN true
#endif
#ifndef REP_MASK
#define REP_MASK 0
#endif
#define NREP(k) (1 + (((REP_MASK) >> (k)) & 1))
#ifdef PHMASK
#define IN(k) (((PHMASK) >> (k)) & 1)
#else
#define IN(k) (lo <= (k) && (k) < hi)
#endif
#ifdef TPROBE
#define GRID_BARRIER() do { const bool blk_ = (int)blockIdx.x == (TPROBE_BLK) && wave0 == 0; bool tp_ = false; if (blk_) { const unsigned n_ = MISC[42]; MISC[42] = n_ + 1u; tp_ = (TPROBE == 300) || (TPROBE == 301 + (int)n_); } \
    unsigned t0_ = 0; if (tp_) t0_ = (unsigned)__builtin_amdgcn_s_memrealtime(); \
    XcdBarrier b_ = bar; asm volatile("" : "+s"(b_.bar)); xcd_barrier(b_); if (tp_) MISC[40] += (unsigned)__builtin_amdgcn_s_memrealtime() - t0_; } while (0)
#else
#define GRID_BARRIER() do { XcdBarrier b_ = bar; asm volatile("" : "+s"(b_.bar)); xcd_barrier(b_); } while (0)
#endif
#define SEAM(k) do { if (IN(k) && IN((k) + 1)) GRID_BARRIER(); } while (0)

__device__ __forceinline__ int tail_busy(int nwg, int G) {
#ifdef KEEP_SEAMS
    return 0;
#endif
    const int R = nwg / G, T = nwg - R * G; return (R >= 1 && 2 * T <= G) ? T : 0; }
#define PCNT(base) (WSQ(unsigned, WS_CTL) + CW_PCNT + (base))
#ifndef DOWN_SPLIT
#define DOWN_SPLIT 4
#endif
#ifndef MOE_SPLIT
#define MOE_SPLIT 4
#endif
#ifndef WOUT_SPLIT
#define WOUT_SPLIT 1
#endif
#ifndef EXCL_WOUT0
#define EXCL_WOUT0 170
#endif
#ifndef EXCL_DOWN
#define EXCL_DOWN 100
#endif
#ifndef EXCL_MOE
#define EXCL_MOE 190
#endif
struct MoeTail { int p0, np, S, nfull, tp; size_t part_off; };
__device__ __forceinline__ MoeTail moe_tail(int ptot, int cap, int gq, int G) {
    int p0 = 0, np = 0;
    while (p0 < ptot) { np = ptot - p0; if (np > cap) np = gq; if (np <= 0 || p0 + np >= ptot) break; p0 += np; }
    pg8::SplitOrder T; T.np = np; T.nct = D / 256; T.G = G; T.init_split(MOE_SPLIT);
    MoeTail r; r.p0 = p0; r.np = np; r.S = T.S; r.nfull = T.nfull; r.tp = T.tail_panels(); r.part_off = WS_ACTM + (size_t)np * 256 * DFE * 2;
    if (r.S > 1 && r.part_off + (size_t)r.S * r.tp * 256 * D * 4 > WS_NEED) { r.S = 1; r.nfull = np * (D / 256); r.tp = 0; }
    return r;
}
#ifdef PROD_OLD
#define PNEED 0u
#else
#define PNEED 32u
#endif
#ifdef TPROBE
#ifndef TPROBE_BLK
#define TPROBE_BLK 0
#endif
#ifndef TPROBE_WAVE
#define TPROBE_WAVE 0
#endif
#ifndef TPROBE_SCALE
#define TPROBE_SCALE 10
#endif
#define TP_BEGIN(k) do { if ((k) == TPROBE && (int)blockIdx.x == (TPROBE_BLK) && wave0 == (TPROBE_WAVE)) { __syncthreads_dummy(); MISC[41] = (unsigned)__builtin_amdgcn_s_memrealtime(); } } while (0)
#define TP_END(k) do { if ((k) == TPROBE && (int)blockIdx.x == (TPROBE_BLK) && wave0 == (TPROBE_WAVE)) { MISC[40] += (unsigned)__builtin_amdgcn_s_memrealtime() - MISC[41]; } } while (0)
__device__ __forceinline__ void __syncthreads_dummy() {}
#else
#define TP_BEGIN(k) do {} while (0)
#define TP_END(k) do {} while (0)
#endif
template <int l>
__device__ __forceinline__ void layer_phases(const XcdBarrier& bar, LAS unsigned char* const lds0, volatile LAS unsigned* MISC, const int lo, const int hi, const int wave0) {
        const int pb = 1 + 8 * l;
        for (int rep_ = 0; rep_ < NREP(pb + 1); ++rep_) { if (rep_) GRID_BARRIER();
        if (IN(pb + 1)) {
            const Params Q = load_params(); const Frame F = make_frame(lds0, wave0);
            pg8::Gemm g{WSQ(bf16, WS_H), WSQ(bf16, WS_WIN) + (size_t)l * NZ * D, MT, NZ, D}; pg8::StaticOrder S; S.init(MT, NZ, F.G, F.bx);
            pg8::EpiBf16<0> E{WSQ(bf16, WS_Z), NZ, nullptr, 0, 0, 1.f};
            TP_BEGIN(100 + pb + 1);
            pg8::gemm_phase<pg8::EpiBf16<0>, pg8::StaticOrder, PG8_ALIGN, PG8_SP2>(F.lds, g, S, E, F.wave);
            TP_END(100 + pb + 1);
        } }
        SEAM(pb + 1);
        for (int rep_ = 0; rep_ < NREP(pb + 2); ++rep_) { if (rep_) GRID_BARRIER();
        if (IN(pb + 2)) {
            const Params Q = load_params(); const Frame F = make_frame(lds0, wave0); TP_BEGIN(100 + pb + 2);
#ifdef FORCE_SOLO
            const bool paired = false;
#else
            const bool paired = F.G >= 256;
#endif
            const int nsb = F.G > 128 ? 128 : 0;
#ifndef NO_SCAN
#ifdef SCAN_PIPE
            (void)paired;
            if (F.bx < nsb || nsb == 0) { const int st = nsb ? nsb : F.G; for (int u = F.bx; u < 128; u += st) scan_unit_pipe(Q, F, l, u >> 4, (u >> 1) & 7, u & 1); }
#else
            if (paired) { if (F.bx < 128) scan_unit(Q, F, l, F.bx >> 4, (F.bx >> 1) & 7, F.bx & 1, 0); else if (F.bx < 256) { const int u = F.bx - 128; scan_unit(Q, F, l, u >> 4, (u >> 1) & 7, u & 1, 1); } }
            else if (F.bx < nsb || nsb == 0) { const int st = nsb ? nsb : F.G; for (int u = F.bx; u < 128; u += st) scan_unit(Q, F, l, u >> 4, (u >> 1) & 7, u & 1, 2); }
#endif
#endif
#ifdef PROBE_CF2
            for (int prb_ = 0; prb_ < 2; ++prb_)
#endif
            if (F.bx >= nsb) {
                const int ob = F.bx - nsb, nob = F.G - nsb;
#ifndef NO_CONV
                { const Frame Fc = make_frame(lds0, wave0); TP_BEGIN(230 + l); conv_items(Q, Fc, l, l == 0 ? MT : NT, ob, nob); TP_END(230 + l); }
#endif
#ifndef NO_FA
#ifdef PROBE_FA2
                for (int prb_ = 0; prb_ < 2; ++prb_)
#endif
                { const Frame Fa = make_frame(lds0, wave0); TP_BEGIN(232 + l); for (int it = ob; it < 256; it += nob) fourier_a_iter(Q, Fa, it); TP_END(232 + l); }
#endif
#ifndef NO_FC
                if (l == 0) { const Frame Fx = make_frame(lds0, wave0); for (int u = ob; u < 32; u += nob) fourier_ctx_unit(Q, Fx, u); }
#endif
            }
            TP_END(100 + pb + 2);
        } }
        SEAM(pb + 2);
        for (int rep_ = 0; rep_ < NREP(pb + 3); ++rep_) { if (rep_) GRID_BARRIER();
        if (IN(pb + 3)) {
            const Params Q = load_params(); const Frame F = make_frame(lds0, wave0);
            TP_BEGIN(100 + pb + 3); TP_BEGIN(200 + l);
            LAS bf16* TC64 = (LAS bf16*)F.lds; LAS bf16* TS64 = TC64 + 64 * TP;
            load_tab64(TC64, WSQ(bf16, TAB_C64), F.tid); load_tab64(TS64, WSQ(bf16, TAB_S64), F.tid);
            __syncthreads();
#ifndef NO_FB
#ifdef PROBE_FB2
            for (int prb_ = 0; prb_ < 2; ++prb_)
#endif
            for (int u = F.bx * NWAVES + F.wave; u < 2048; u += F.G * NWAVES) fourier_b_unit(Q, F, u, TC64, TS64);
#endif
            __syncthreads(); TP_END(200 + l);
#ifndef NO_FIN
            finalize_phase(Q, F, l, l == 0 ? MT : NT);
#endif
            TP_END(100 + pb + 3);
        } }
        SEAM(pb + 3);
        for (int rep_ = 0; rep_ < NREP(pb + 4); ++rep_) { if (rep_) GRID_BARRIER();
        if (IN(pb + 4)) {
            const Params Q = load_params(); const Frame F = make_frame(lds0, wave0);
            const int M = l == 0 ? MT : NT;
#ifdef PROD_OLD
            pg8::Gemm g{WSQ(bf16, WS_H), WSQ(bf16, WS_WOUT) + (size_t)l * D * D, M, D, D}; pg8::StaticOrder S; S.init(M, D, F.G, F.bx);
            pg8::EpiBf16<0> E{WSQ(bf16, WS_O32), D, nullptr, 0, 0, 1.f};
            pg8::gemm_phase<pg8::EpiBf16<0>, pg8::StaticOrder, PG8_ALIGN, PG8_SP2>(F.lds, g, S, E, F.wave);
#else
            pg8::Gemm g{WSQ(bf16, WS_H), WSQ(bf16, WS_WOUT) + (size_t)l * D * D, M, D, D};
            if (l == 0) {
                pg8::PubOrder<pg8::SplitOrder> S; S.p0 = 0; S.np = MT / 256; S.nct = D / 256; S.G = F.G; S.c = F.bx; S.pb[0] = 0;
#pragma unroll
                for (int j = 1; j < 9; ++j) S.pb[j] = 1 << 20;
                S.init_split(WOUT_SPLIT); S.cntr = PCNT(PC_WOUT0); S.pend = -1;
                pg8::EpiSplitWT E{WSQ(bf16, WS_O32), D, D / 256, WSQ(float, WS_PARTD), S.nfull / (D / 256), S.tail_panels() * 256};
                TP_BEGIN(3); TP_BEGIN(400); TP_BEGIN(401);
                pg8::gemm_phase<pg8::EpiSplitWT, pg8::PubOrder<pg8::SplitOrder>, PG8_ALIGN, PG8_SP2>(F.lds, g, S, E, F.wave);
                TP_END(3);
            } else {
                pg8::PubOrder<pg8::StaticOrder> S; S.init(M, D, F.G, F.bx); S.cntr = PCNT(PC_WOUT1); S.pend = -1;
                pg8::EpiBf16WT E{WSQ(bf16, WS_O32), D, 1 << 20};
                TP_BEGIN(7);
                pg8::gemm_phase<pg8::EpiBf16WT, pg8::PubOrder<pg8::StaticOrder>, PG8_ALIGN, PG8_SP2>(F.lds, g, S, E, F.wave);
                TP_END(7);
            }
#endif
        } }
#ifdef KEEP_SEAMS
        SEAM(pb + 4);
#endif
        if (l == 0) {
            if (IN(pb + 5)) { const Params Q = load_params(); const Frame F = make_frame(lds0, wave0); pg8::SplitOrder T; T.np = MT / 256; T.nct = D / 256; T.G = F.G; T.init_split(WOUT_SPLIT); const bool sp = T.S > 1;
                TP_BEGIN(4); phase_post<0, true, false, true>(Q, F, MT, 0, 2048, 1, Q.in[I_CTX], 0, 2, 4096, 3072, PCNT(PC_WOUT0), PNEED, sp ? T.tail_panels() * T.nct * T.S : tail_busy(T.np * T.nct, F.G),
                    (int)((long)MT * EXCL_WOUT0 / 256), WSQ(float, WS_PARTD), sp ? (T.nfull / T.nct) * 256 : 0x7fffffff, T.S, T.tail_panels() * 256); TP_END(4); __syncthreads(); TP_END(400); }
            SEAM(pb + 5); TP_END(401);
            for (int rep_ = 0; rep_ < NREP(pb + 6); ++rep_) { if (rep_) GRID_BARRIER();
            if (IN(pb + 6)) {
            const Params Q = load_params(); const Frame F = make_frame(lds0, wave0);
                pg8::Gemm g{WSQ(bf16, WS_H), WSQ(bf16, WS_WGU), MT, 2 * DFF, D}; pg8::StaticOrder S; S.init(MT, 2 * DFF, F.G, F.bx);
                pg8::EpiSwiglu E{WSQ(bf16, WS_Z), DFF, 0, 1 << 20};
                TP_BEGIN(100 + pb + 6);
                pg8::gemm_phase<pg8::EpiSwiglu, pg8::StaticOrder, PG8_ALIGN, PG8_SP2>(F.lds, g, S, E, F.wave);
                TP_END(100 + pb + 6);
            } }
            SEAM(pb + 6);
            for (int rep_ = 0; rep_ < NREP(pb + 7); ++rep_) { if (rep_) GRID_BARRIER();
            if (IN(pb + 7)) {
            const Params Q = load_params(); const Frame F = make_frame(lds0, wave0);
#ifdef PROD_OLD
                pg8::Gemm g{WSQ(bf16, WS_Z), WSQ(bf16, WS_WDN), MT, D, DFF}; pg8::StaticOrder S; S.init(MT, D, F.G, F.bx);
                pg8::EpiBf16<0> E{WSQ(bf16, WS_O32), D, nullptr, 0, 0, 1.f};
                pg8::gemm_phase<pg8::EpiBf16<0>, pg8::StaticOrder, PG8_ALIGN, PG8_SP2>(F.lds, g, S, E, F.wave);
#else
                pg8::Gemm g{WSQ(bf16, WS_Z), WSQ(bf16, WS_WDN), MT, D, DFF};
                pg8::PubOrder<pg8::SplitOrder> S; S.p0 = 0; S.np = MT / 256; S.nct = D / 256; S.G = F.G; S.c = F.bx; S.pb[0] = 0;
#pragma unroll
                for (int j = 1; j < 9; ++j) S.pb[j] = 1 << 20;
                S.init_split(DOWN_SPLIT); S.cntr = PCNT(PC_DOWN0); S.pend = -1;
                pg8::EpiSplitWT E{WSQ(bf16, WS_O32), D, D / 256, WSQ(float, WS_PARTD), S.nfull / (D / 256), S.tail_panels() * 256};
                TP_BEGIN(1); TP_BEGIN(402);
                pg8::gemm_phase<pg8::EpiSplitWT, pg8::PubOrder<pg8::SplitOrder>, PG8_ALIGN, PG8_SP2>(F.lds, g, S, E, F.wave);
                TP_END(1);
#endif
            } }
#ifdef KEEP_SEAMS
            SEAM(pb + 7);
#endif
            if (IN(pb + 8)) { const Params Q = load_params(); const Frame F = make_frame(lds0, wave0); pg8::SplitOrder T; T.np = MT / 256; T.nct = D / 256; T.G = F.G; T.init_split(DOWN_SPLIT); const bool sp = T.S > 1;
                TP_BEGIN(2); phase_post<0, true, false>(Q, F, MT, 0, 5120, 3, (const float*)(Q.ws + WS_XC), 1, 0, 1024, 0, PCNT(PC_DOWN0), PNEED, sp ? T.tail_panels() * T.nct * T.S : tail_busy(T.np * T.nct, F.G),
                    (int)((long)MT * (sp ? EXCL_DOWN : EXCL_WOUT0) / 256), WSQ(float, WS_PARTD), sp ? (T.nfull / T.nct) * 256 : 0x7fffffff, T.S, T.tail_panels() * 256); TP_END(2); }
            SEAM(pb + 8); TP_END(402);
        } else {
            if (IN(pb + 5)) { const Params Q = load_params(); const Frame F = make_frame(lds0, wave0); TP_BEGIN(8); phase_post<0, true, true>(Q, F, NT, 1, 2048, 1, nullptr, 1, 2, 4096, 3072, PCNT(PC_WOUT1), PNEED, tail_busy((NT / 256) * (D / 256), F.G), 0); TP_END(8); }
            SEAM(pb + 5);
            if (IN(pb + 6)) { const Params Q = load_params(); const Frame F = make_frame(lds0, wave0); TP_BEGIN(220); for (int rep_ = 0; rep_ < NREP(15); ++rep_) convert_moe_weights(Q, F); TP_END(220); TP_BEGIN(221); moe_assign_gather(Q, F); TP_END(221); }
            SEAM(pb + 6);
            if (IN(pb + 7)) {
            const Params Q = load_params(); const Frame F = make_frame(lds0, wave0);
                if (F.tid == 0) { MoePlan M; int cnt[NE]; moe_plan(Q, M, cnt);
#pragma unroll
                    for (int j = 0; j < 9; ++j) MISC[16 + j] = (unsigned)M.pb[j]; }
                __syncthreads();
                const int ptot = (int)MISC[16 + 8], gq = (F.G >= 256 && Q.act_cap_panels >= 128) ? 128 : (Q.act_cap_panels < 64 ? Q.act_cap_panels : 64);
                const MoeTail mt = moe_tail(ptot, Q.act_cap_panels, gq, F.G);
                int p0 = 0;
                while (p0 < ptot) {
                    int np = ptot - p0; if (np > Q.act_cap_panels) np = gq;
                    if (np > 0) {
                        for (int rep_ = 0; rep_ < NREP(16); ++rep_) { if (rep_) GRID_BARRIER();
                            pg8::Gemm g{WSQ(bf16, WS_XG), WSQ(bf16, WS_WMGU), 0, 0, D};
                            pg8::MoeOrder S; S.p0 = p0; S.np = np; S.nct = 2 * DFE / 256; S.G = F.G; S.c = F.bx;
#pragma unroll
                            for (int j = 0; j < 9; ++j) S.pb[j] = (int)MISC[16 + j];
                            pg8::EpiSwiglu E{WSQ(bf16, WS_ACTM), DFE, p0, 2 * DFE / 256};
                            TP_BEGIN(222);
                            pg8::gemm_phase<pg8::EpiSwiglu, pg8::MoeOrder, PG8_ALIGN, PG8_SP2>(F.lds, g, S, E, F.wave);
                            TP_END(222);
                        }
                        GRID_BARRIER();
                        for (int rep_ = 0; rep_ < NREP(17); ++rep_) { if (rep_) GRID_BARRIER();
                            pg8::Gemm g{WSQ(bf16, WS_ACTM) - (size_t)p0 * 256 * DFE, WSQ(bf16, WS_WMDN), 0, 0, DFE};
#ifdef PROD_OLD
                            pg8::MoeOrder S; S.p0 = p0; S.np = np; S.nct = D / 256; S.G = F.G; S.c = F.bx;
#pragma unroll
                            for (int j = 0; j < 9; ++j) S.pb[j] = (int)MISC[16 + j];
                            pg8::EpiBf16Mod E{WSQ(bf16, WS_XG), D, D / 256};
                            pg8::gemm_phase<pg8::EpiBf16Mod, pg8::MoeOrder, PG8_ALIGN, PG8_SP2>(F.lds, g, S, E, F.wave);
#else
                            pg8::PubOrder<pg8::SplitOrder> S; S.p0 = p0; S.np = np; S.nct = D / 256; S.G = F.G; S.c = F.bx; S.cntr = PCNT(PC_MOE); S.pend = -1;
#pragma unroll
                            for (int j = 0; j < 9; ++j) S.pb[j] = (int)MISC[16 + j];
                            S.init_split(p0 == mt.p0 ? mt.S : 1);
                            pg8::EpiSplitWT E{WSQ(bf16, WS_XG), D, D / 256, (float*)(Q.ws + mt.part_off), p0 + S.nfull / (D / 256), S.tail_panels() * 256};
                            TP_BEGIN(5); if (p0 == mt.p0) TP_BEGIN(403);
                            pg8::gemm_phase<pg8::EpiSplitWT, pg8::PubOrder<pg8::SplitOrder>, PG8_ALIGN, PG8_SP2>(F.lds, g, S, E, F.wave);
                            TP_END(5);
#endif
                        }
#ifdef KEEP_SEAMS
                        GRID_BARRIER();
#else
                        if (p0 + np < ptot) GRID_BARRIER();
#endif
                    }
                    p0 += np;
                }
            }
            if (IN(pb + 8)) { const Params Q = load_params(); const Frame F = make_frame(lds0, wave0);
                MoePlan M; int cnt[NE]; moe_plan_block(Q, F, M, cnt);
                const int ptot = M.pb[8], gq = (F.G >= 256 && Q.act_cap_panels >= 128) ? 128 : (Q.act_cap_panels < 64 ? Q.act_cap_panels : 64);
                const MoeTail mt = moe_tail(ptot, Q.act_cap_panels, gq, F.G); const bool sp = mt.S > 1;
                TP_BEGIN(6); phase_post<1, false, false>(Q, F, NT, 1, 5120, 3, nullptr, 1, 0, 0, 0, PCNT(PC_MOE), PNEED, sp ? mt.tp * (D / 256) * mt.S : tail_busy(mt.np * (D / 256), F.G),
                    (int)((long)NT * (sp ? EXCL_MOE : 200) / 256), (const float*)(Q.ws + mt.part_off), sp ? (mt.p0 + mt.nfull / (D / 256)) * 256 : 0x7fffffff, mt.S, mt.tp * 256); TP_END(6); __syncthreads(); TP_END(403); }
        }
    }
constexpr int N_PHASES = 18;
__global__ void __launch_bounds__(NTHR, 2) fwd_kernel(Params P) {
    extern __shared__ __attribute__((aligned(16))) unsigned char lds_raw[];
    LAS unsigned char* const lds0 = (LAS unsigned char*)lds_raw;
    volatile LAS unsigned* MISC = (volatile LAS unsigned*)(lds0 + MISC_OFF);
    const int wave0 = __builtin_amdgcn_readfirstlane((int)threadIdx.x >> 6);
    if (wave0 == 0) MISC[__builtin_amdgcn_mbcnt_hi(~0u, __builtin_amdgcn_mbcnt_lo(~0u, 0u))] = 0u;
    __syncthreads();
    unsigned* ctl = (unsigned*)(P.ws + WS_CTL);
    XcdBarrier bar = xcd_barrier_post(ctl + CW_BAR + P.li * XCD_BAR_WORDS, MISC + 8, wave0 == 0 ? 1u : 0u);
    const int lo = P.ph_lo, hi = P.ph_hi;
    for (int rep_ = 0; rep_ < NREP(0); ++rep_) { if (rep_) GRID_BARRIER(); if (IN(0)) { const Params Q = load_params(); const Frame F = make_frame(lds0, wave0); TP_BEGIN(210); p0_adaln(Q, F); TP_END(210); TP_BEGIN(211); p0_small_weights(Q, F); TP_END(211); TP_BEGIN(212); p0_tables(Q, F); TP_END(212); } }
    SEAM(0);
#ifdef PROBE_FN_NOSTORE
    for (int rep_ = 0; rep_ < 2; ++rep_) { if (rep_) GRID_BARRIER(); if (IN(1)) { const Params Q = load_params(); const Frame F = make_frame(lds0, wave0); phase_first_norm(Q, F); } }
#else
    for (int rep_ = 0; rep_ < NREP(1); ++rep_) { if (rep_) GRID_BARRIER(); if (IN(1)) { const Params Q = load_params(); const Frame F = make_frame(lds0, wave0); TP_BEGIN(101); phase_first_norm(Q, F); TP_END(101); } }
#endif
    SEAM(1);
#ifdef PROBE_BAR
    for (int prb_ = 0; prb_ < 20; ++prb_) GRID_BARRIER();
#endif
    layer_phases<0>(bar, lds0, MISC, lo, hi, wave0);
    layer_phases<1>(bar, lds0, MISC, lo, hi, wave0);
#ifdef TPROBE
    if ((int)blockIdx.x == (TPROBE_BLK) && wave0 == 0) { const unsigned long long t0 = __builtin_amdgcn_s_memrealtime(), dt = (unsigned long long)MISC[40] * (TPROBE_SCALE);
        while (__builtin_amdgcn_s_memrealtime() - t0 < dt) __builtin_amdgcn_s_sleep(8); }
#endif
#undef IN
#undef SEAM
}

#ifndef MK_PER_PHASE
#define MK_PER_PHASE 0
#endif
extern "C" void kernel_launch(void* const* d_in, const int* in_sizes, int n_in, void* d_out, int out_size, void* d_ws, size_t ws_size, hipStream_t stream) {
    static int grid = 0;
    if (grid == 0) {
        if (n_in != N_IN || in_sizes[0] != NT * D || out_size != NT * D || ws_size < WS_NEED) {
            fprintf(stderr, "kernel_launch: unexpected shapes (n_in %d, in0 %d, out %d, ws %zu); nothing launched\n", n_in, n_in > 0 ? in_sizes[0] : -1, out_size, ws_size); grid = -1; return; }
        int dev = 0, cus = 0, per_cu = 0;
        if (hipGetDevice(&dev) != hipSuccess || hipDeviceGetAttribute(&cus, hipDeviceAttributeMultiprocessorCount, dev) != hipSuccess) { grid = -1; return; }
        if (hipFuncSetAttribute((const void*)fwd_kernel, hipFuncAttributeMaxDynamicSharedMemorySize, LDS_BYTES) != hipSuccess) { fprintf(stderr, "kernel_launch: hipFuncSetAttribute failed\n"); grid = -1; return; }
        if (hipOccupancyMaxActiveBlocksPerMultiprocessor(&per_cu, (const void*)fwd_kernel, NTHR, LDS_BYTES) != hipSuccess || per_cu < 1)
            fprintf(stderr, "kernel_launch: occupancy query reports %d workgroups per CU\n", per_cu);
        (void)hipGetLastError();
        grid = cus;
    }
    if (grid < 0) return;
    if (hipMemsetAsync((char*)d_ws + WS_CTL, 0, CTL_ZERO_BYTES, stream) != hipSuccess) return;
    Params p{};
    for (int i = 0; i < N_IN; ++i) p.in[i] = (const float*)d_in[i];
    p.out = (float*)d_out; p.ws = (unsigned char*)d_ws;
    { size_t avail = ws_size - WS_ACTM; size_t cap = avail / ((size_t)256 * DFE * 2); if (cap > 264) cap = 264; p.act_cap_panels = (int)cap; }
#if MK_PER_PHASE
    int li = 0;
    for (int ph = 0; ph < N_PHASES; ++ph) {
        p.ph_lo = ph; p.ph_hi = ph + 1; p.li = li++;
        hipLaunchKernelGGL(fwd_kernel, dim3(grid), dim3(NTHR), LDS_BYTES, stream, p);
    }
#else
    p.ph_lo = 0; p.ph_hi = N_PHASES; p.li = 0;
    hipLaunchKernelGGL(fwd_kernel, dim3(grid), dim3(NTHR), LDS_BYTES, stream, p);
#endif
}
```
